# Optimizing an MI355X kernel written in HIP

```python
import math
import jax, jax.numpy as jnp
from jax import lax
import numpy as np

D_MODEL = 1024
BATCH = 32
SEQ = 2048
DEPTH = 2

N_MEM = 256
HEAD_DIM = 64
SB_HEADS = 6
DSA_HEADS = 6
MEM_HEADS = 4
SB_W = SB_HEADS * HEAD_DIM
DSA_W = DSA_HEADS * HEAD_DIM
MEM_W = MEM_HEADS * HEAD_DIM
MIX_W = SB_W + DSA_W + MEM_W
KV_RANK = 128
IDX_HEADS = 8
IDX_DIM = 32
TOPK_MAX = 256
N_BUCKETS = 32
MAX_DISTANCE = 128
BLOCK_Q = 128
RMS_EPS = 1e-6
IN_SPLITS = (SB_W, SB_W, SB_W, SB_W,
             DSA_W, KV_RANK, DSA_W, IDX_HEADS * IDX_DIM, IDX_DIM, IDX_HEADS,
             MEM_W, MEM_W)
IN_COLS = sum(IN_SPLITS)

kernel_name = "hymba_sb_dsa_mem_hybrid"


def rmsnorm(x, g):
    xf = x.astype(jnp.float32)
    y = xf * lax.rsqrt(jnp.mean(xf * xf, axis=-1, keepdims=True) + RMS_EPS)
    return (y * g.astype(jnp.float32)).astype(x.dtype)


def t5_causal_bucket(rel):
    n = jnp.maximum(rel, 0)
    max_exact = N_BUCKETS // 2
    nf = jnp.maximum(n, 1).astype(jnp.float32)
    large = max_exact + (jnp.log(nf / max_exact) / math.log(MAX_DISTANCE / max_exact)
                         * (N_BUCKETS - max_exact)).astype(jnp.int32)
    large = jnp.minimum(large, N_BUCKETS - 1)
    return jnp.where(n < max_exact, n, large)


def stick_breaking_attention(q, k, v):
    S = q.shape[1]
    scale = q.shape[-1] ** -0.5
    outs = []
    for start in range(0, S, BLOCK_Q):
        end = start + BLOCK_Q
        z = jnp.einsum('bqhd,bkhd->bhqk', q[:, start:end], k[:, :end]).astype(jnp.float32) * scale
        t_pos = jnp.arange(start, end)[:, None]
        s_pos = jnp.arange(end)[None, :]
        causal = s_pos < t_pos
        log_1m = jnp.where(causal, jax.nn.log_sigmoid(-z), 0.0)
        suffix = lax.cumsum(log_1m, axis=3, reverse=True) - log_1m
        a = jnp.where(causal, jnp.exp(jax.nn.log_sigmoid(z) + suffix), 0.0)
        outs.append(jnp.einsum('bhqk,bkhd->bqhd', a.astype(v.dtype), v[:, :end]))
    return jnp.concatenate(outs, axis=1)


def dsa_sparse_attention(q, c_kv, w_uk, w_uv, iq, ik, iw, rel_bias, topk):
    S = q.shape[1]
    scale = q.shape[-1] ** -0.5
    q_lat = jnp.einsum('bshd,rhd->bshr', q, w_uk)
    gather = jax.vmap(lambda c, i: c[i])
    outs = []
    for start in range(0, S, BLOCK_Q):
        end = start + BLOCK_Q
        kv_len = min(S, max(end, topk))
        t_pos = jnp.arange(start, end)
        s_pos = jnp.arange(kv_len)
        dots = jnp.einsum('bqhd,bkd->bqhk', iq[:, start:end], ik[:, :kv_len])
        score = jnp.einsum('bqh,bqhk->bqk', iw[:, start:end], jax.nn.relu(dots)).astype(jnp.float32)
        score = jnp.where(s_pos[None, None, :] <= t_pos[None, :, None], score, -jnp.inf)
        _, idx = lax.top_k(score, topk)
        rel = t_pos[None, :, None] - idx
        valid = rel >= 0
        c_sel = gather(c_kv[:, :kv_len], idx)
        logits = jnp.einsum('bqhr,bqkr->bhqk', q_lat[:, start:end], c_sel).astype(jnp.float32) * scale
        bias = rel_bias.astype(jnp.float32)[t5_causal_bucket(rel)]
        logits = logits + jnp.transpose(bias, (0, 3, 1, 2))
        logits = jnp.where(valid[:, None], logits, -jnp.inf)
        p = jax.nn.softmax(logits, axis=-1)
        o_lat = jnp.einsum('bhqk,bqkr->bqhr', p.astype(c_sel.dtype), c_sel)
        outs.append(jnp.einsum('bqhr,rhd->bqhd', o_lat, w_uv))
    return jnp.concatenate(outs, axis=1)


def memory_attention(q, mem_k, mem_v):
    logits = jnp.einsum('bshd,bmhd->bhsm', q, mem_k).astype(jnp.float32) * (q.shape[-1] ** -0.5)
    p = jax.nn.softmax(logits, axis=-1)
    return jnp.einsum('bhsm,bmhd->bshd', p.astype(mem_v.dtype), mem_v)


def hybrid_layer(x, mem, pre_g, post_g, w_in, w_uk, w_uv, kv_g, w_mem_kv, w_out, rel_bias, topk):
    B, S, _ = x.shape
    M = mem.shape[1]
    h = rmsnorm(x, pre_g)
    proj = h @ w_in
    split_points = [int(p) for p in np.cumsum(IN_SPLITS)[:-1]]
    (sb_q, sb_k, sb_v, sb_gate,
     dsa_q, dsa_ckv, dsa_gate, idx_q, idx_k, idx_w,
     mem_q, mem_gate) = jnp.split(proj, split_points, axis=-1)
    heads = lambda t, n: t.reshape(B, S, n, HEAD_DIM)

    sb = stick_breaking_attention(heads(sb_q, SB_HEADS), heads(sb_k, SB_HEADS), heads(sb_v, SB_HEADS))
    sb = sb.reshape(B, S, SB_W) * jax.nn.silu(sb_gate)

    c_kv = rmsnorm(dsa_ckv, kv_g)
    iq = idx_q.reshape(B, S, IDX_HEADS, IDX_DIM)
    iw = idx_w * ((IDX_HEADS * IDX_DIM) ** -0.5)
    ds = dsa_sparse_attention(heads(dsa_q, DSA_HEADS), c_kv, w_uk, w_uv, iq, idx_k, iw, rel_bias, topk)
    ds = ds.reshape(B, S, DSA_W) * jax.nn.silu(dsa_gate)

    mem_k, mem_v = jnp.split(mem @ w_mem_kv, 2, axis=-1)
    mo = memory_attention(heads(mem_q, MEM_HEADS),
                          mem_k.reshape(B, M, MEM_HEADS, HEAD_DIM),
                          mem_v.reshape(B, M, MEM_HEADS, HEAD_DIM))
    mo = mo.reshape(B, S, MEM_W) * jax.nn.silu(mem_gate)

    y = jnp.concatenate([sb, ds, mo], axis=-1) @ w_out
    return x + rmsnorm(y, post_g)


def setup_inputs(seed: int = 0) -> dict:
    key = jax.random.key(seed)
    ks = jax.random.split(key, 12)
    f32 = jnp.float32
    x = jax.random.normal(ks[0], (BATCH, SEQ, D_MODEL), f32)
    mem = jax.random.normal(ks[1], (BATCH, N_MEM, D_MODEL), f32)
    pre_norm_g = 1.0 + 0.05 * jax.random.normal(ks[2], (DEPTH, D_MODEL), f32)
    post_norm_g = 1.0 + 0.05 * jax.random.normal(ks[3], (DEPTH, D_MODEL), f32)
    w_in = jax.random.normal(ks[4], (DEPTH, D_MODEL, IN_COLS), f32) * D_MODEL ** -0.5
    w_uk = jax.random.normal(ks[5], (DEPTH, KV_RANK, DSA_HEADS, HEAD_DIM), f32) * KV_RANK ** -0.5
    w_uv = jax.random.normal(ks[6], (DEPTH, KV_RANK, DSA_HEADS, HEAD_DIM), f32) * KV_RANK ** -0.5
    kv_norm_g = 1.0 + 0.05 * jax.random.normal(ks[7], (DEPTH, KV_RANK), f32)
    w_mem_kv = jax.random.normal(ks[8], (DEPTH, D_MODEL, 2 * MEM_W), f32) * D_MODEL ** -0.5
    w_out = jax.random.normal(ks[9], (DEPTH, MIX_W, D_MODEL), f32) * MIX_W ** -0.5
    rel_bias = 0.5 * jax.random.normal(ks[10], (N_BUCKETS, DSA_HEADS), f32)
    return {"x": x, "mem": mem, "pre_norm_g": pre_norm_g, "post_norm_g": post_norm_g,
            "w_in": w_in, "w_uk": w_uk, "w_uv": w_uv, "kv_norm_g": kv_norm_g,
            "w_mem_kv": w_mem_kv, "w_out": w_out, "rel_bias": rel_bias}


def reference(x, mem, pre_norm_g, post_norm_g, w_in, w_uk, w_uv, kv_norm_g, w_mem_kv, w_out, rel_bias):
    seq = x.shape[1]
    topk = min(TOPK_MAX, seq // 4)
    for layer in range(DEPTH):
        x = hybrid_layer(x, mem, pre_norm_g[layer], post_norm_g[layer], w_in[layer],
                         w_uk[layer], w_uv[layer], kv_norm_g[layer], w_mem_kv[layer],
                         w_out[layer], rel_bias, topk)
    return x
```

```cpp
#include <hip/hip_runtime.h>
#include <stdint.h>
#include <math.h>

typedef unsigned short bf16_t;
constexpr int DM = 1024, NB = 32, SEQ = 2048, NTOK = NB * SEQ, NMEM = 256;
constexpr int LDP = 3328;
constexpr int C_SBQ = 0, C_SBK = 384, C_SBV = 768, C_SBG = 1152, C_DSQ = 1536, C_CKV = 1920, C_DSG = 2048,
              C_IDQ = 2432, C_IDK = 2688, C_IDW = 2720, C_MQ = 2728, C_MG = 2984, NCOL = 3240;
constexpr float EPS = 1e-6f;
constexpr size_t MiB = 1u << 20;
constexpr size_t WS_CTL = 0;
constexpr size_t WS_RSTD = 1 * MiB;
constexpr size_t WS_PROJ = 2 * MiB;
constexpr size_t WS_MIX = WS_PROJ + 416 * MiB;
constexpr size_t WS_Y = WS_MIX + 128 * MiB;
constexpr size_t WS_CKVN = WS_Y + 128 * MiB;
constexpr size_t WS_MEMKV = WS_CKVN + 16 * MiB;
constexpr size_t WS_MASK = WS_MEMKV + 16 * MiB;
constexpr size_t WS_END = WS_MASK + 16 * MiB;

__device__ __forceinline__ float bf2f(bf16_t v) { return __uint_as_float(((unsigned)v) << 16); }
__device__ __forceinline__ bf16_t f2bf(float f) { unsigned u = __float_as_uint(f); u += 0x7fffu + ((u >> 16) & 1u); return (bf16_t)(u >> 16); }

__device__ const unsigned char T5TAB[128] = {0, 1, 2, 3, 4, 5, 6, 7, 8, 9, 10, 11, 12, 13, 14, 15, 16, 16, 16, 17, 17, 18, 18, 18, 19, 19, 19, 20, 20, 20, 20, 21, 21, 21, 21, 22, 22, 22, 22, 22, 23, 23, 23, 23, 23, 23, 24, 24, 24, 24, 24, 24, 25, 25, 25, 25, 25, 25, 25, 26, 26, 26, 26, 26, 26, 26, 26, 27, 27, 27, 27, 27, 27, 27, 27, 27, 27, 28, 28, 28, 28, 28, 28, 28, 28, 28, 28, 29, 29, 29, 29, 29, 29, 29, 29, 29, 29, 29, 29, 30, 30, 30, 30, 30, 30, 30, 30, 30, 30, 30, 30, 30, 30, 31, 31, 31, 31, 31, 31, 31, 31, 31, 31, 31, 31, 31, 31, 31};

__global__ __launch_bounds__(256) void rowstat_k(const float* x, float* rstd) {
    const int row = blockIdx.x * 4 + (threadIdx.x >> 6), lane = threadIdx.x & 63;
    const float4* p = (const float4*)(x + (size_t)row * DM);
    float s = 0.f;
#pragma unroll
    for (int j = 0; j < 4; ++j) { float4 v = p[lane + 64 * j]; s += v.x * v.x + v.y * v.y + v.z * v.z + v.w * v.w; }
#pragma unroll
    for (int o = 1; o < 64; o <<= 1) s += __shfl_xor(s, o);
    if (lane == 0) rstd[row] = 1.0f / sqrtf(s * (1.0f / DM) + EPS);
}

template <int AMODE>
__global__ __launch_bounds__(256) void sgemm_k(const void* A_, int lda, const float* rs, const float* cs, const float* B, int ldb,
                                               bf16_t* C, int ldc, int M, int N, int K) {
    __shared__ float As[16][132];
    __shared__ float Bs[16][132];
    const int tid = threadIdx.x, bm = blockIdx.y * 128, bn = blockIdx.x * 128;
    const int tx = tid & 15, ty = tid >> 4;
    float acc[8][8];
#pragma unroll
    for (int i = 0; i < 8; ++i)
#pragma unroll
        for (int j = 0; j < 8; ++j) acc[i][j] = 0.f;
    const int ar = tid >> 1, ak = (tid & 1) * 8;
    const int bk = tid >> 4, bc = (tid & 15) * 8;
    const float rsc = (AMODE == 0) ? rs[bm + ar] : 1.f;
    for (int k0 = 0; k0 < K; k0 += 16) {
        float a[8];
        if (AMODE == 2) {
            const bf16_t* ap = (const bf16_t*)A_ + (size_t)(bm + ar) * lda + k0 + ak;
            uint4 v = *(const uint4*)ap;
            a[0] = __uint_as_float(v.x << 16); a[1] = __uint_as_float(v.x & 0xffff0000u);
            a[2] = __uint_as_float(v.y << 16); a[3] = __uint_as_float(v.y & 0xffff0000u);
            a[4] = __uint_as_float(v.z << 16); a[5] = __uint_as_float(v.z & 0xffff0000u);
            a[6] = __uint_as_float(v.w << 16); a[7] = __uint_as_float(v.w & 0xffff0000u);
        } else {
            const float* ap = (const float*)A_ + (size_t)(bm + ar) * lda + k0 + ak;
            float4 v0 = *(const float4*)ap, v1 = *(const float4*)(ap + 4);
            a[0] = v0.x; a[1] = v0.y; a[2] = v0.z; a[3] = v0.w; a[4] = v1.x; a[5] = v1.y; a[6] = v1.z; a[7] = v1.w;
            if (AMODE == 0) {
                float4 c0 = *(const float4*)(cs + k0 + ak), c1 = *(const float4*)(cs + k0 + ak + 4);
                a[0] *= rsc * c0.x; a[1] *= rsc * c0.y; a[2] *= rsc * c0.z; a[3] *= rsc * c0.w;
                a[4] *= rsc * c1.x; a[5] *= rsc * c1.y; a[6] *= rsc * c1.z; a[7] *= rsc * c1.w;
            }
        }
        float b[8];
        {
            const float* bp = B + (size_t)(k0 + bk) * ldb + bn + bc;
            if (bn + bc + 7 < N) { float4 v0 = *(const float4*)bp, v1 = *(const float4*)(bp + 4); b[0] = v0.x; b[1] = v0.y; b[2] = v0.z; b[3] = v0.w; b[4] = v1.x; b[5] = v1.y; b[6] = v1.z; b[7] = v1.w; }
            else {
#pragma unroll
                for (int j = 0; j < 8; ++j) b[j] = (bn + bc + j < N) ? bp[j] : 0.f;
            }
        }
        __syncthreads();
#pragma unroll
        for (int i = 0; i < 8; ++i) As[ak + i][ar] = a[i];
#pragma unroll
        for (int j = 0; j < 8; ++j) Bs[bk][bc + j] = b[j];
        __syncthreads();
#pragma unroll
        for (int kk = 0; kk < 16; ++kk) {
            float av[8], bv[8];
#pragma unroll
            for (int i = 0; i < 8; ++i) av[i] = As[kk][ty * 8 + i];
#pragma unroll
            for (int j = 0; j < 8; ++j) bv[j] = Bs[kk][tx * 8 + j];
#pragma unroll
            for (int i = 0; i < 8; ++i)
#pragma unroll
                for (int j = 0; j < 8; ++j) acc[i][j] += av[i] * bv[j];
        }
    }
#pragma unroll
    for (int i = 0; i < 8; ++i) {
        const int r = bm + ty * 8 + i;
#pragma unroll
        for (int j = 0; j < 8; ++j) { const int c = bn + tx * 8 + j; if (c < N) C[(size_t)r * ldc + c] = f2bf(acc[i][j]); }
    }
}

__global__ __launch_bounds__(256) void ckvnorm_k(const bf16_t* PROJ, const float* kvg, bf16_t* CKVN) {
    const int row = blockIdx.x * 4 + (threadIdx.x >> 6), lane = threadIdx.x & 63;
    const bf16_t* p = PROJ + (size_t)row * LDP + C_CKV;
    float a = bf2f(p[lane]), b = bf2f(p[lane + 64]);
    float s = a * a + b * b;
#pragma unroll
    for (int o = 1; o < 64; o <<= 1) s += __shfl_xor(s, o);
    const float r = 1.0f / sqrtf(s * (1.0f / 128.f) + EPS);
    CKVN[(size_t)row * 128 + lane] = f2bf(a * r * kvg[lane]);
    CKVN[(size_t)row * 128 + lane + 64] = f2bf(b * r * kvg[lane + 64]);
}

__global__ __launch_bounds__(64) void sb_naive_k(const bf16_t* PROJ, bf16_t* MIX) {
    const int blk = blockIdx.x, chunk = blk & 31, bh = blk >> 5, h = bh % 6, b = bh / 6, lane = threadIdx.x, t = chunk * 64 + lane;
    const bf16_t* base = PROJ + (size_t)b * SEQ * LDP;
    float q[64], o[64];
    {
        const bf16_t* qp = base + (size_t)t * LDP + C_SBQ + h * 64;
#pragma unroll
        for (int d = 0; d < 64; ++d) { q[d] = bf2f(qp[d]) * 0.125f; o[d] = 0.f; }
    }
    float L = 0.f;
    const int tmax = chunk * 64 + 63;
    for (int s = tmax - 1; s >= 0; --s) {
        const bf16_t* kp = base + (size_t)s * LDP + C_SBK + h * 64;
        float z = 0.f;
#pragma unroll
        for (int d = 0; d < 64; ++d) z += q[d] * bf2f(kp[d]);
        const bool act = s < t;
        const float sp = fmaxf(z, 0.f) + log1pf(expf(-fabsf(z)));
        const float a = act ? expf((z - sp) + L) : 0.f;
        if (act) L -= sp;
        const bf16_t* vp = base + (size_t)s * LDP + C_SBV + h * 64;
#pragma unroll
        for (int d = 0; d < 64; ++d) o[d] += a * bf2f(vp[d]);
    }
    const bf16_t* gp = base + (size_t)t * LDP + C_SBG + h * 64;
    bf16_t* op = MIX + ((size_t)b * SEQ + t) * DM + h * 64;
#pragma unroll
    for (int d = 0; d < 64; ++d) { const float g = bf2f(gp[d]); op[d] = f2bf(o[d] * (g / (1.f + expf(-g)))); }
}

__device__ __forceinline__ unsigned ordkey(float f) { unsigned u = __float_as_uint(f); return (u & 0x80000000u) ? ~u : (u | 0x80000000u); }
__global__ __launch_bounds__(64) void sel_naive_k(const bf16_t* PROJ, unsigned* MASK) {
    __shared__ float iq[256];
    __shared__ float iw[8];
    __shared__ unsigned long long bal[32];
    const int gq = blockIdx.x, b = gq >> 11, t = gq & 2047, lane = threadIdx.x;
    const bf16_t* row = PROJ + ((size_t)b * SEQ + t) * LDP;
    for (int i = lane; i < 256; i += 64) iq[i] = bf2f(row[C_IDQ + i]);
    if (lane < 8) iw[lane] = bf2f(row[C_IDW + lane]) * 0.0625f;
    __syncthreads();
    unsigned key[32];
#pragma unroll
    for (int j = 0; j < 32; ++j) {
        key[j] = 0u;
        if (j * 64 <= t) {
            const int s = j * 64 + lane;
            const bf16_t* kr = PROJ + ((size_t)b * SEQ + s) * LDP + C_IDK;
            float kd[32];
#pragma unroll
            for (int d = 0; d < 32; ++d) kd[d] = bf2f(kr[d]);
            float acc = 0.f;
            for (int hh = 0; hh < 8; ++hh) {
                float dt = 0.f;
#pragma unroll
                for (int d = 0; d < 32; ++d) dt += iq[hh * 32 + d] * kd[d];
                acc += iw[hh] * fmaxf(dt, 0.f);
            }
            key[j] = (s <= t) ? ordkey(acc) : 0u;
        }
    }
    const bool need_sel = (t + 1) > 256;
    unsigned tau = 0u; int need = 0;
    if (need_sel) {
        unsigned prefix = 0u;
        for (int bit = 31; bit >= 0; --bit) {
            const unsigned cand = prefix | (1u << bit);
            int cnt = 0;
#pragma unroll
            for (int j = 0; j < 32; ++j) cnt += __popcll(__ballot(key[j] >= cand));
            if (cnt >= 256) prefix = cand;
        }
        tau = prefix;
        int cgt = 0;
#pragma unroll
        for (int j = 0; j < 32; ++j) cgt += __popcll(__ballot(key[j] > tau));
        need = 256 - cgt;
    }
    int tiesbefore = 0;
    const unsigned long long lt_mask = (lane == 0) ? 0ull : (~0ull >> (64 - lane));
#pragma unroll
    for (int j = 0; j < 32; ++j) {
        bool sel;
        if (!need_sel) sel = (j * 64 + lane) <= t;
        else {
            const bool gt = key[j] > tau, eq = key[j] == tau;
            const unsigned long long be = __ballot(eq);
            const int rank = tiesbefore + __popcll(be & lt_mask);
            sel = gt || (eq && rank < need);
            tiesbefore += __popcll(be);
        }
        const unsigned long long bs = __ballot(sel);
        if (lane == 0) bal[j] = bs;
    }
    __syncthreads();
    {
        const int kt = lane;
        const unsigned long long bb = bal[kt >> 1];
        const unsigned nat = (unsigned)(bb >> (32 * (kt & 1)));
        unsigned w = 0u;
#pragma unroll
        for (int n = 0; n < 8; ++n) { const unsigned nib = (nat >> (4 * n)) & 0xfu; const int on = 4 * (n & 1) + (n >> 1); w |= nib << (4 * on); }
        MASK[((((size_t)b * 64 + (t >> 5)) * 64 + kt) * 32) + (t & 31)] = w;
    }
}

__global__ __launch_bounds__(64) void dsa_naive_k(const bf16_t* PROJ, const bf16_t* CKVN, const unsigned* MASK, const float* w_uk, const float* w_uv,
                                                  const float* rel_bias, bf16_t* MIX) {
    __shared__ float ql[128 * 64];
    const int blk = blockIdx.x, chunk = blk & 31, bh = blk >> 5, h = bh % 6, b = bh / 6, lane = threadIdx.x, t = chunk * 64 + lane;
    {
        float q[64];
        const bf16_t* qp = PROJ + ((size_t)b * SEQ + t) * LDP + C_DSQ + h * 64;
#pragma unroll
        for (int d = 0; d < 64; ++d) q[d] = bf2f(qp[d]);
        for (int r = 0; r < 128; ++r) {
            const float* wp = w_uk + ((size_t)r * 6 + h) * 64;
            float a = 0.f;
#pragma unroll
            for (int d = 0; d < 64; ++d) a += q[d] * wp[d];
            ql[r * 64 + lane] = a * 0.125f;
        }
    }
    float o[128];
#pragma unroll
    for (int r = 0; r < 128; ++r) o[r] = 0.f;
    float m = -INFINITY, l = 0.f;
    const int tmax = chunk * 64 + 63, qt = t >> 5;
    for (int kt = 0; kt <= (tmax >> 5); ++kt) {
        unsigned w = 0u;
        if (kt <= qt) w = MASK[((((size_t)b * 64 + qt) * 64 + kt) * 32) + (t & 31)];
        for (int i = 0; i < 32; ++i) {
            const int hf = (i >> 2) & 1, a8 = i >> 3, c = i & 3, bit = 16 * hf + 4 * a8 + c;
            const bool sel = (w >> bit) & 1u;
            if (!__any(sel)) continue;
            const int s = kt * 32 + i;
            const bf16_t* cr = CKVN + ((size_t)b * SEQ + s) * 128;
            float lg = 0.f;
            for (int r = 0; r < 128; ++r) lg += ql[r * 64 + lane] * bf2f(cr[r]);
            int rel = t - s; rel = rel < 0 ? 0 : rel;
            const int bk = rel < 128 ? (int)T5TAB[rel] : 31;
            lg += rel_bias[bk * 6 + h];
            if (sel) {
                const float mn = fmaxf(m, lg), sc = expf(m - mn), p = expf(lg - mn);
                l = l * sc + p; m = mn;
#pragma unroll
                for (int r = 0; r < 128; ++r) o[r] = o[r] * sc + p * bf2f(cr[r]);
            }
        }
    }
    const float il = 1.f / l;
    __syncthreads();
#pragma unroll
    for (int r = 0; r < 128; ++r) ql[r * 64 + lane] = o[r] * il;
    __syncthreads();
    const bf16_t* gp = PROJ + ((size_t)b * SEQ + t) * LDP + C_DSG + h * 64;
    bf16_t* op = MIX + ((size_t)b * SEQ + t) * DM + 384 + h * 64;
    for (int d0 = 0; d0 < 64; d0 += 16) {
        float acc[16];
#pragma unroll
        for (int j = 0; j < 16; ++j) acc[j] = 0.f;
        for (int r = 0; r < 128; ++r) {
            const float ol = ql[r * 64 + lane];
            const float* wp = w_uv + ((size_t)r * 6 + h) * 64 + d0;
#pragma unroll
            for (int j = 0; j < 16; ++j) acc[j] += ol * wp[j];
        }
#pragma unroll
        for (int j = 0; j < 16; ++j) { const float g = bf2f(gp[d0 + j]); op[d0 + j] = f2bf(acc[j] * (g / (1.f + expf(-g)))); }
    }
}

__global__ __launch_bounds__(64) void mem_naive_k(const bf16_t* PROJ, const bf16_t* MEMKV, bf16_t* MIX) {
    const int blk = blockIdx.x, chunk = blk & 31, bh = blk >> 5, h = bh & 3, b = bh >> 2, lane = threadIdx.x, t = chunk * 64 + lane;
    float q[64], o[64];
    const bf16_t* qp = PROJ + ((size_t)b * SEQ + t) * LDP + C_MQ + h * 64;
#pragma unroll
    for (int d = 0; d < 64; ++d) { q[d] = bf2f(qp[d]) * 0.125f; o[d] = 0.f; }
    float m = -INFINITY, l = 0.f;
    for (int s = 0; s < NMEM; ++s) {
        const bf16_t* kp = MEMKV + ((size_t)b * NMEM + s) * 512 + h * 64;
        float z = 0.f;
#pragma unroll
        for (int d = 0; d < 64; ++d) z += q[d] * bf2f(kp[d]);
        const float mn = fmaxf(m, z), sc = expf(m - mn), p = expf(z - mn);
        l = l * sc + p; m = mn;
        const bf16_t* vp = kp + 256;
#pragma unroll
        for (int d = 0; d < 64; ++d) o[d] = o[d] * sc + p * bf2f(vp[d]);
    }
    const float il = 1.f / l;
    const bf16_t* gp = PROJ + ((size_t)b * SEQ + t) * LDP + C_MG + h * 64;
    bf16_t* op = MIX + ((size_t)b * SEQ + t) * DM + 768 + h * 64;
#pragma unroll
    for (int d = 0; d < 64; ++d) { const float g = bf2f(gp[d]); op[d] = f2bf(o[d] * il * (g / (1.f + expf(-g)))); }
}

__global__ __launch_bounds__(256) void post_k(const float* xin, const bf16_t* Y, const float* g, float* xout) {
    const int row = blockIdx.x * 4 + (threadIdx.x >> 6), lane = threadIdx.x & 63;
    const bf16_t* yp = Y + (size_t)row * DM;
    float yv[16]; float s = 0.f;
#pragma unroll
    for (int j = 0; j < 4; ++j) {
        const uint2 v = *(const uint2*)(yp + (lane + 64 * j) * 4);
        yv[4 * j + 0] = __uint_as_float(v.x << 16); yv[4 * j + 1] = __uint_as_float(v.x & 0xffff0000u);
        yv[4 * j + 2] = __uint_as_float(v.y << 16); yv[4 * j + 3] = __uint_as_float(v.y & 0xffff0000u);
        s += yv[4 * j] * yv[4 * j] + yv[4 * j + 1] * yv[4 * j + 1] + yv[4 * j + 2] * yv[4 * j + 2] + yv[4 * j + 3] * yv[4 * j + 3];
    }
#pragma unroll
    for (int o = 1; o < 64; o <<= 1) s += __shfl_xor(s, o);
    const float r = 1.0f / sqrtf(s * (1.0f / DM) + EPS);
#pragma unroll
    for (int j = 0; j < 4; ++j) {
        const int c = (lane + 64 * j) * 4;
        const float4 xv = *(const float4*)(xin + (size_t)row * DM + c);
        const float4 gv = *(const float4*)(g + c);
        float4 ov; ov.x = xv.x + yv[4 * j] * r * gv.x; ov.y = xv.y + yv[4 * j + 1] * r * gv.y; ov.z = xv.z + yv[4 * j + 2] * r * gv.z; ov.w = xv.w + yv[4 * j + 3] * r * gv.w;
        *(float4*)(xout + (size_t)row * DM + c) = ov;
    }
}

extern "C" void kernel_launch(void* const* d_in, const int* in_sizes, int n_in, void* d_out, int out_size, void* d_ws, size_t ws_size, hipStream_t stream) {
    const float* x = (const float*)d_in[0];
    const float* mem = (const float*)d_in[1];
    const float* pre_g = (const float*)d_in[2];
    const float* post_g = (const float*)d_in[3];
    const float* w_in = (const float*)d_in[4];
    const float* w_uk = (const float*)d_in[5];
    const float* w_uv = (const float*)d_in[6];
    const float* kv_g = (const float*)d_in[7];
    const float* w_mem = (const float*)d_in[8];
    const float* w_out = (const float*)d_in[9];
    const float* rel_bias = (const float*)d_in[10];
    float* out = (float*)d_out;
    char* ws = (char*)d_ws;
    if (ws_size < WS_END) return;
    float* RSTD = (float*)(ws + WS_RSTD);
    bf16_t* PROJ = (bf16_t*)(ws + WS_PROJ);
    bf16_t* MIX = (bf16_t*)(ws + WS_MIX);
    bf16_t* Y = (bf16_t*)(ws + WS_Y);
    bf16_t* CKVN = (bf16_t*)(ws + WS_CKVN);
    bf16_t* MEMKV = (bf16_t*)(ws + WS_MEMKV);
    unsigned* MASK = (unsigned*)(ws + WS_MASK);
    for (int l = 0; l < 2; ++l) {
        const float* xin = (l == 0) ? x : out;
        rowstat_k<<<NTOK / 4, 256, 0, stream>>>(xin, RSTD);
        sgemm_k<0><<<dim3((NCOL + 127) / 128, NTOK / 128), 256, 0, stream>>>(xin, DM, RSTD, pre_g + l * DM, w_in + (size_t)l * DM * NCOL, NCOL, PROJ, LDP, NTOK, NCOL, DM);
        sgemm_k<1><<<dim3(512 / 128, (NB * NMEM) / 128), 256, 0, stream>>>(mem, DM, nullptr, nullptr, w_mem + (size_t)l * DM * 512, 512, MEMKV, 512, NB * NMEM, 512, DM);
        ckvnorm_k<<<NTOK / 4, 256, 0, stream>>>(PROJ, kv_g + l * 128, CKVN);
        sb_naive_k<<<NB * 6 * 32, 64, 0, stream>>>(PROJ, MIX);
        sel_naive_k<<<NTOK, 64, 0, stream>>>(PROJ, MASK);
        dsa_naive_k<<<NB * 6 * 32, 64, 0, stream>>>(PROJ, CKVN, MASK, w_uk + (size_t)l * 128 * 384, w_uv + (size_t)l * 128 * 384, rel_bias, MIX);
        mem_naive_k<<<NB * 4 * 32, 64, 0, stream>>>(PROJ, MEMKV, MIX);
        sgemm_k<2><<<dim3(DM / 128, NTOK / 128), 256, 0, stream>>>(MIX, DM, nullptr, nullptr, w_out + (size_t)l * DM * DM, DM, Y, DM, NTOK, DM, DM);
        post_k<<<NTOK / 4, 256, 0, stream>>>(xin, Y, post_g + l * DM, out);
    }
}
```

```cpp
#include <hip/hip_runtime.h>
#include <hip/hip_cooperative_groups.h>
#include <stdint.h>
#include <math.h>
#include <cstdio>
namespace cg = cooperative_groups;
namespace pg8 {
#define PG8_LAS __attribute__((address_space(3)))
typedef unsigned short bf16_t;
typedef short bf16x8 __attribute__((ext_vector_type(8)));
typedef float f32x4 __attribute__((ext_vector_type(4)));
typedef unsigned u32x4 __attribute__((ext_vector_type(4)));
constexpr int BM = 256, BK = 64, HALF = 128, HTB = HALF * BK * 2  , STAGE_BYTES = 8 * HTB, NXCD = 8, WGM = 8;

__host__ __device__ __forceinline__ int lds_byte(int r, int c) { const int st = (r >> 4) * 2 + (c >> 5), rr = r & 15, cc = c & 31, ob = rr * 64 + cc * 2; return st * 1024 + (ob ^ (((ob >> 9) & 1) << 5)); }
__host__ __device__ __forceinline__ void stage_rc(int b, int& R, int& C) { const int st = b / 1024, sb = b % 1024, swz = sb ^ (((sb >> 9) & 1) << 5); R = (st >> 1) * 16 + swz / 64; C = (st & 1) * 32 + (swz % 64) / 2; }
__host__ __device__ __forceinline__ int perm32(int rho) { const int n = rho >> 4, i = rho & 15; return 8 * (i >> 2) + 4 * n + (i & 3); }

struct Unit { int pm, pn; };
struct Gemm { const bf16_t* A; const bf16_t* Bt; int M, N, K; };

struct StaticOrder {
    int nM, nN, nwg, G, c;
    __host__ __device__ void init(int M, int N, int G_, int c_) { nM = M / BM; nN = N / BM; nwg = nM * nN; G = G_; c = c_; }
    __host__ __device__ bool next(int i, Unit& u) const {
        const long L = (long)i * G + c; if (L >= nwg) return false;
        int wgid = (int)L; { const int q = nwg / NXCD, r = nwg % NXCD, xcd = wgid % NXCD, off = wgid / NXCD; wgid = (xcd < r ? xcd * (q + 1) : r * (q + 1) + (xcd - r) * q) + off; }
        const int nig = WGM * nN, gid = wgid / nig, fm = gid * WGM, gsz = (nM - fm) < WGM ? (nM - fm) : WGM;
        u.pm = fm + ((wgid % nig) % gsz); u.pn = (wgid % nig) / gsz; return true;
    }
    __device__ __forceinline__ void a_ready(const Unit&) const {}
    __device__ __forceinline__ void done(const Unit&) const {}
};

__device__ __forceinline__ unsigned cvt_pk_bf16(float lo, float hi) { unsigned r; asm volatile("v_cvt_pk_bf16_f32 %0, %1, %2" : "=v"(r) : "v"(lo), "v"(hi)); return r; }
typedef float f32x2 __attribute__((ext_vector_type(2)));
__device__ __forceinline__ f32x2 gelu_pk(f32x2 v) {
    const f32x2 av = __builtin_elementwise_abs(v), d = av * 0.2316418882f + 1.0f;
    f32x2 t; t.x = __builtin_amdgcn_rcpf(d.x); t.y = __builtin_amdgcn_rcpf(d.y);
    f32x2 q = t * 0.5307027145f + (-0.7265760135f); q = q * t + 0.7107068705f; q = q * t + (-0.142248368f); q = q * t + 0.127414796f; q = q * t;
    const f32x2 s = (v * v) * (-0.72134752044f);
    f32x2 e; e.x = __builtin_amdgcn_exp2f(s.x); e.y = __builtin_amdgcn_exp2f(s.y);
    const f32x2 m = v * (q * e), r = v - m;
    f32x2 o; o.x = v.x < 0.f ? m.x : r.x; o.y = v.y < 0.f ? m.y : r.y; return o;
}

template <int ACT  > struct EpiBf16 {
    static constexpr bool PERM = true, AFTER_DRAIN = false; static_assert(ACT == 0 || ACT == 1, "EpiBf16: ACT is 0 (none) or 1 (gelu_pk)");
    bf16_t* O; int ldc; const float* bias; int split_cols; size_t split_stride; float scale0;
    __device__ __forceinline__ void operator()(const f32x4 (&acc)[2][2][4][2], const Unit& u, int wr, int wc, int fr, int fq) const {
        const int row0 = u.pm * BM + wr * 64 + fr; int colt = u.pn * BM; bf16_t* base = O;
        float sc = 1.f; if (split_cols) { const int t = colt / split_cols; base += (size_t)t * split_stride; colt -= t * split_cols; if (t == 0) sc = scale0; }
        const int col0 = colt + wc * 32 + 8 * fq, bcol0 = u.pn * BM + wc * 32 + 8 * fq;
        f32x4 bv[2][2];
#pragma unroll
        for (int bj = 0; bj < 2; ++bj)
#pragma unroll
            for (int n = 0; n < 2; ++n) bv[bj][n] = bias ? *(const f32x4*)(bias + bcol0 + bj * HALF + 4 * n) : (f32x4){0.f, 0.f, 0.f, 0.f};
#pragma unroll
        for (int ai = 0; ai < 2; ++ai)
#pragma unroll
            for (int m = 0; m < 4; ++m) { bf16_t* rowp = base + (size_t)(row0 + ai * HALF + m * 16) * ldc + col0;
#pragma unroll
                for (int bj = 0; bj < 2; ++bj) { f32x4 v0 = acc[ai][bj][m][0] + bv[bj][0], v1 = acc[ai][bj][m][1] + bv[bj][1];
                    if (ACT == 1) { f32x2 a = gelu_pk((f32x2){v0[0], v0[1]}), b = gelu_pk((f32x2){v0[2], v0[3]}), c = gelu_pk((f32x2){v1[0], v1[1]}), d = gelu_pk((f32x2){v1[2], v1[3]});
                        v0 = (f32x4){a.x, a.y, b.x, b.y}; v1 = (f32x4){c.x, c.y, d.x, d.y}; }
                    v0 = v0 * sc; v1 = v1 * sc; u32x4 w; w.x = cvt_pk_bf16(v0[0], v0[1]); w.y = cvt_pk_bf16(v0[2], v0[3]); w.z = cvt_pk_bf16(v1[0], v1[1]); w.w = cvt_pk_bf16(v1[2], v1[3]);
                    *(u32x4*)(rowp + bj * HALF) = w; } }
    }
};
template <class Epi, class Sched, bool ALIGN_EPI = false, bool SP2 = false>
__device__ __forceinline__ void gemm_phase(PG8_LAS unsigned char* lds, const Gemm g, const Sched& S, const Epi& E) {
    int tid_ = threadIdx.x; asm volatile("" : "+v"(tid_));
    const int tid = tid_, wid = __builtin_amdgcn_readfirstlane(tid >> 6), lane = tid & 63, wr = wid >> 2, wc = wid & 3, fr = lane & 15, fq = lane >> 4;
    const int K = g.K, nt = K / BK;
    unsigned voffA[2], voffB[2];
#pragma unroll
    for (int i = 0; i < 2; ++i) { int R, C; stage_rc(tid * 16 + i * 8192, R, C); const int Rb = Epi::PERM ? ((R & ~31) + perm32(R & 31)) : R;
        voffA[i] = (unsigned)(R * K + C) * 2u; voffB[i] = (unsigned)(Rb * K + C) * 2u; }
    const size_t kstep = (size_t)(BK * 2);
    const size_t hstep = (size_t)HALF * K * 2;
    const size_t tstep = 2 * hstep;
    const unsigned ldsw = (unsigned)wid * 1024u;
    const int aoff = lds_byte(wr * 64 + fr, fq * 8), boff = lds_byte(wc * 32 + fr, fq * 8);
#define PG8_SA(b, h) (((b) * 2 + (h)) * HTB)
#define PG8_SB(b, h) ((4 + (b) * 2 + (h)) * HTB)
#define PG8_STAGE(bufoff, gbase, voff) do { _Pragma("unroll") for (int _i = 0; _i < 2; ++_i) \
        __builtin_amdgcn_global_load_lds((const unsigned*)((const char*)(gbase) + (voff)[_i]), (PG8_LAS unsigned*)(lds + (bufoff) + ldsw + _i * 8192), 16, 0, 0); } while (0)
#define PG8_LDA(dst, b, h) do { _Pragma("unroll") for (int m = 0; m < 4; ++m) _Pragma("unroll") for (int k = 0; k < 2; ++k) dst[m][k] = *(const PG8_LAS bf16x8*)(lds + PG8_SA(b, h) + aoff + m * 2048 + k * 1024); } while (0)
#define PG8_LDB(dst, b, h) do { _Pragma("unroll") for (int n = 0; n < 2; ++n) _Pragma("unroll") for (int k = 0; k < 2; ++k) dst[n][k] = *(const PG8_LAS bf16x8*)(lds + PG8_SB(b, h) + boff + n * 2048 + k * 1024); } while (0)
#define PG8_MMA(ai, bj, At, Bt) do { __builtin_amdgcn_s_setprio(1); _Pragma("unroll") for (int m = 0; m < 4; ++m) _Pragma("unroll") for (int n = 0; n < 2; ++n) _Pragma("unroll") for (int k = 0; k < 2; ++k) \
        acc[ai][bj][m][n] = __builtin_amdgcn_mfma_f32_16x16x32_bf16(Bt[n][k], At[m][k], acc[ai][bj][m][n], 0, 0, 0); __builtin_amdgcn_s_setprio(0); } while (0)
#define PG8_WAIT_V(n) asm volatile("s_waitcnt vmcnt(" #n ")" ::: "memory")
#define PG8_WAIT_L(n) asm volatile("s_waitcnt lgkmcnt(" #n ")" ::: "memory")
#define PG8_BAR __builtin_amdgcn_s_barrier()
#define PG8_SCHED __builtin_amdgcn_sched_barrier(0)
    Unit cur, nxt; int ui = 0;
    if (!S.next(0, cur)) return;
    f32x4 acc[2][2][4][2];
#pragma unroll
    for (int a = 0; a < 2; ++a)
#pragma unroll
        for (int b = 0; b < 2; ++b)
#pragma unroll
            for (int m = 0; m < 4; ++m)
#pragma unroll
                for (int n = 0; n < 2; ++n) acc[a][b][m][n] = (f32x4){0.f, 0.f, 0.f, 0.f};
    bf16x8 At[4][2], B0[2][2], B1[2][2];
    const char* cA = (const char*)g.A + (size_t)cur.pm * tstep; const char* cB = (const char*)g.Bt + (size_t)cur.pn * tstep;
    S.a_ready(cur);
    if constexpr (SP2) {
        PG8_STAGE(PG8_SB(0, 0), cB, voffB); PG8_STAGE(PG8_SB(0, 1), cB + hstep, voffB); PG8_STAGE(PG8_SA(0, 0), cA, voffA); PG8_STAGE(PG8_SA(0, 1), cA + hstep, voffA);
        if (wr == 1) PG8_BAR;
        PG8_WAIT_V(2); PG8_BAR;
        PG8_STAGE(PG8_SB(1, 0), cB + kstep, voffB); PG8_STAGE(PG8_SA(1, 0), cA + kstep, voffA); PG8_STAGE(PG8_SB(1, 1), cB + hstep + kstep, voffB);
        PG8_WAIT_V(6); PG8_BAR;
    } else {
        PG8_STAGE(PG8_SB(0, 0), cB, voffB); PG8_STAGE(PG8_SA(0, 0), cA, voffA); PG8_STAGE(PG8_SB(0, 1), cB + hstep, voffB); PG8_STAGE(PG8_SA(0, 1), cA + hstep, voffA);
        if (wr == 1) PG8_BAR;
        PG8_WAIT_V(4); PG8_BAR;
        PG8_STAGE(PG8_SB(1, 0), cB + kstep, voffB); PG8_STAGE(PG8_SA(1, 0), cA + kstep, voffA); PG8_STAGE(PG8_SB(1, 1), cB + hstep + kstep, voffB);
        PG8_WAIT_V(6); PG8_BAR;
    }
    for (;;) {
        const bool has_next = S.next(ui + 1, nxt);
        const char* nA = has_next ? (const char*)g.A + (size_t)nxt.pm * tstep : cA; const char* nB = has_next ? (const char*)g.Bt + (size_t)nxt.pn * tstep : cB;
        for (int t = 0; t < nt; t += 2) {
            const bool last = (t == nt - 2);
            const char* a1 = cA + (size_t)(t + 1) * kstep;
            const char* a2 = last ? nA : cA + (size_t)(t + 2) * kstep; const char* b2 = last ? nB : cB + (size_t)(t + 2) * kstep;
            const char* a3 = a2 + kstep; const char* b3 = b2 + kstep;
            if (last && has_next) S.a_ready(nxt);
            if constexpr (SP2) {
            PG8_LDB(B0, 0, 0); PG8_LDB(B1, 0, 1); PG8_SCHED; PG8_LDA(At, 0, 0); PG8_STAGE(PG8_SA(1, 1), a1 + hstep, voffA);
            PG8_WAIT_V(8); PG8_WAIT_L(0); PG8_BAR; PG8_MMA(0, 0, At, B0); PG8_MMA(0, 1, At, B1); PG8_BAR; PG8_SCHED;
            PG8_LDA(At, 0, 1); PG8_STAGE(PG8_SB(0, 0), b2, voffB); PG8_STAGE(PG8_SB(0, 1), b2 + hstep, voffB); PG8_STAGE(PG8_SA(0, 0), a2, voffA);
            PG8_WAIT_V(8); PG8_WAIT_L(0); PG8_BAR; PG8_MMA(1, 0, At, B0); PG8_MMA(1, 1, At, B1); PG8_BAR; PG8_SCHED;
            PG8_LDB(B0, 1, 0); PG8_LDB(B1, 1, 1); PG8_SCHED; PG8_LDA(At, 1, 0); PG8_STAGE(PG8_SA(0, 1), a2 + hstep, voffA);
            PG8_WAIT_V(8); PG8_WAIT_L(0); PG8_BAR; PG8_MMA(0, 0, At, B0); PG8_MMA(0, 1, At, B1); PG8_BAR; PG8_SCHED;
            PG8_LDA(At, 1, 1); PG8_STAGE(PG8_SB(1, 0), b3, voffB); PG8_STAGE(PG8_SB(1, 1), b3 + hstep, voffB); PG8_STAGE(PG8_SA(1, 0), a3, voffA);
            PG8_WAIT_V(8); PG8_WAIT_L(0); PG8_BAR; PG8_MMA(1, 0, At, B0); PG8_MMA(1, 1, At, B1); PG8_BAR; PG8_SCHED;
            } else {
            PG8_LDB(B0, 0, 0); PG8_SCHED; PG8_LDA(At, 0, 0); PG8_STAGE(PG8_SA(1, 1), a1 + hstep, voffA);
            PG8_WAIT_L(8); PG8_BAR; PG8_WAIT_L(0); PG8_MMA(0, 0, At, B0); PG8_BAR; PG8_SCHED;
            PG8_LDB(B1, 0, 1); PG8_STAGE(PG8_SB(0, 0), b2, voffB);
            PG8_BAR; PG8_WAIT_L(0); PG8_MMA(0, 1, At, B1); PG8_BAR;
            PG8_LDA(At, 0, 1); PG8_STAGE(PG8_SA(0, 0), a2, voffA);
            PG8_BAR; PG8_WAIT_L(0); PG8_MMA(1, 0, At, B0); PG8_BAR; PG8_SCHED;
            PG8_STAGE(PG8_SB(0, 1), b2 + hstep, voffB);
            PG8_WAIT_V(6); PG8_BAR; PG8_MMA(1, 1, At, B1); PG8_BAR;
            PG8_LDB(B0, 1, 0); PG8_SCHED; PG8_LDA(At, 1, 0); PG8_STAGE(PG8_SA(0, 1), a2 + hstep, voffA);
            PG8_WAIT_L(8); PG8_BAR; PG8_WAIT_L(0); PG8_MMA(0, 0, At, B0); PG8_BAR; PG8_SCHED;
            PG8_LDB(B1, 1, 1); PG8_STAGE(PG8_SB(1, 0), b3, voffB);
            PG8_BAR; PG8_WAIT_L(0); PG8_MMA(0, 1, At, B1); PG8_BAR;
            PG8_LDA(At, 1, 1); PG8_STAGE(PG8_SA(1, 0), a3, voffA);
            PG8_BAR; PG8_WAIT_L(0); PG8_MMA(1, 0, At, B0); PG8_BAR; PG8_SCHED;
            PG8_STAGE(PG8_SB(1, 1), b3 + hstep, voffB);
            PG8_WAIT_V(6); PG8_BAR; PG8_MMA(1, 1, At, B1); PG8_BAR;
            }
        }
        if constexpr (ALIGN_EPI) { if (wr == 0) PG8_BAR; }
        if constexpr (!Epi::AFTER_DRAIN) { E(acc, cur, wr, wc, fr, fq); S.done(cur); }
        if (!has_next) break;
#pragma unroll
        for (int a = 0; a < 2; ++a)
#pragma unroll
            for (int b = 0; b < 2; ++b)
#pragma unroll
                for (int m = 0; m < 4; ++m)
#pragma unroll
                    for (int n = 0; n < 2; ++n) acc[a][b][m][n] = (f32x4){0.f, 0.f, 0.f, 0.f};
        cur = nxt; cA = nA; cB = nB; ++ui;
        if constexpr (ALIGN_EPI) { if (wr == 1) PG8_BAR; }
    }
    PG8_WAIT_V(0);
    if constexpr (!ALIGN_EPI) { if (wr == 0) PG8_BAR; }
    PG8_BAR;
    if constexpr (Epi::AFTER_DRAIN) { E.fused(acc, cur, wr, wc, fr, fq, lds, wid, lane); S.done(cur); }
#undef PG8_SA
#undef PG8_SB
#undef PG8_STAGE
#undef PG8_LDA
#undef PG8_LDB
#undef PG8_MMA
#undef PG8_WAIT_V
#undef PG8_WAIT_L
#undef PG8_BAR
#undef PG8_SCHED
}
}
typedef unsigned short bf16_t;
#define LAS __attribute__((address_space(3)))
#define GAS __attribute__((address_space(1)))
typedef unsigned v4u __attribute__((ext_vector_type(4)));
typedef unsigned v2u __attribute__((ext_vector_type(2)));
typedef float f32x4 __attribute__((ext_vector_type(4)));
constexpr int DM = 1024, NB = 32, SEQ = 2048, NTOK = NB * SEQ, NMEM = 256;
constexpr int LDP = 3328;
constexpr int C_SBQ = 0, C_SBK = 384, C_SBV = 768, C_SBG = 1152, C_DSQ = 1536, C_CKV = 1920, C_DSG = 2048,
              C_IDQ = 2432, C_IDK = 2688, C_IDW = 2720, C_MQ = 2728, C_MG = 2984, NCOL = 3240;
constexpr float EPS = 1e-6f;
constexpr size_t MiB = 1u << 20;
constexpr size_t WS_CTL = 0;
constexpr size_t WS_WIN = 1 * MiB;
constexpr size_t WS_WOUT = 14 * MiB;
constexpr size_t WS_WMEM = 18 * MiB;
constexpr size_t WS_MEMB = 20 * MiB;
constexpr size_t WS_MEMKV = 36 * MiB;
constexpr size_t WS_CKVN = 52 * MiB;
constexpr size_t WS_MASK = 68 * MiB;
constexpr size_t WS_H = 84 * MiB;
constexpr size_t WS_MIX = WS_H;
constexpr size_t WS_PROJ = 212 * MiB;
constexpr size_t WS_Y = WS_PROJ;
constexpr size_t WS_END = 628 * MiB;
constexpr int LDS_BYTES = 135168;
constexpr int NWAVES = 8;

__device__ __forceinline__ float bf2f(bf16_t v) { return __uint_as_float(((unsigned)v) << 16); }
__device__ __forceinline__ unsigned f2bf(float f) { unsigned u = __float_as_uint(f); u += 0x7fffu + ((u >> 16) & 1u); return u >> 16; }
__device__ __forceinline__ unsigned pk2(float lo, float hi) { return f2bf(lo) | (f2bf(hi) << 16); }
#define WAVE_SYNC() do { asm volatile("s_waitcnt lgkmcnt(0)" ::: "memory"); __builtin_amdgcn_wave_barrier(); } while (0)
__device__ __forceinline__ float wave_sum(float v) {
#pragma unroll
    for (int o = 1; o < 64; o <<= 1) v += __shfl_xor(v, o);
    return v;
}

__device__ const unsigned char T5TAB[128] = {0, 1, 2, 3, 4, 5, 6, 7, 8, 9, 10, 11, 12, 13, 14, 15, 16, 16, 16, 17, 17, 18, 18, 18, 19, 19, 19, 20, 20, 20, 20, 21, 21, 21, 21, 22, 22, 22, 22, 22, 23, 23, 23, 23, 23, 23, 24, 24, 24, 24, 24, 24, 25, 25, 25, 25, 25, 25, 25, 26, 26, 26, 26, 26, 26, 26, 26, 27, 27, 27, 27, 27, 27, 27, 27, 27, 27, 28, 28, 28, 28, 28, 28, 28, 28, 28, 28, 29, 29, 29, 29, 29, 29, 29, 29, 29, 29, 29, 29, 30, 30, 30, 30, 30, 30, 30, 30, 30, 30, 30, 30, 30, 30, 31, 31, 31, 31, 31, 31, 31, 31, 31, 31, 31, 31, 31, 31, 31};

struct Args { const float* in[11]; float* out; unsigned char* ws; int ph_lo, ph_hi; };

__device__ __forceinline__ void p0_transpose_item(const float* W, int K, int N, int Npad, bf16_t* WT, const float* g, LAS float* scr, int item, int lane) {
    const int nblk = Npad / 32, kb = item / nblk, nb = item % nblk, k0 = 64 * kb, n0 = 32 * nb;
    const int nn = n0 + (lane & 31);
#pragma unroll 8
    for (int i = 0; i < 32; ++i) { const int kk = 2 * i + (lane >> 5); float v = (nn < N) ? W[(size_t)(k0 + kk) * N + nn] : 0.f; if (g) v *= g[k0 + kk]; scr[kk * 33 + (lane & 31)] = v; }
    WAVE_SYNC();
    const int c = lane & 7;
#pragma unroll
    for (int j = 0; j < 4; ++j) { const int n = (lane >> 3) + 8 * j; const LAS float* s = scr + (8 * c) * 33 + n;
        v4u o; o.x = pk2(s[0 * 33], s[1 * 33]); o.y = pk2(s[2 * 33], s[3 * 33]); o.z = pk2(s[4 * 33], s[5 * 33]); o.w = pk2(s[6 * 33], s[7 * 33]);
        *(v4u*)(WT + (size_t)(n0 + n) * K + k0 + 8 * c) = o; }
    WAVE_SYNC();
}
template <bool NORM> __device__ __forceinline__ void row_to_bf16(const float* xrow, bf16_t* orow, int lane) {
    const f32x4* xr = (const f32x4*)xrow + lane;
    f32x4 v[4]; float s = 0.f;
#pragma unroll
    for (int j = 0; j < 4; ++j) { v[j] = xr[64 * j]; s += (v[j].x * v[j].x + v[j].y * v[j].y) + (v[j].z * v[j].z + v[j].w * v[j].w); }
    float r = 1.f;
    if (NORM) r = 1.0f / sqrtf(wave_sum(s) * (1.f / DM) + EPS);
    v2u* o8 = (v2u*)orow + lane;
#pragma unroll
    for (int j = 0; j < 4; ++j) { v2u w; w.x = pk2(v[j].x * r, v[j].y * r); w.y = pk2(v[j].z * r, v[j].w * r); o8[64 * j] = w; }
}

__device__ __forceinline__ void ckvnorm_wave(const bf16_t* PROJ, const float* kvg, bf16_t* CKVN, int row, int lane) {
    const bf16_t* p = PROJ + (size_t)row * LDP + C_CKV;
    const float a = bf2f(p[lane]), b = bf2f(p[lane + 64]);
    const float s = wave_sum(a * a + b * b);
    const float r = 1.0f / sqrtf(s * (1.0f / 128.f) + EPS);
    CKVN[(size_t)row * 128 + lane] = (bf16_t)f2bf(a * r * kvg[lane]);
    CKVN[(size_t)row * 128 + lane + 64] = (bf16_t)f2bf(b * r * kvg[lane + 64]);
}

__device__ __forceinline__ void sb_naive_wave(const bf16_t* PROJ, bf16_t* MIX, int blk, int lane) {
    const int chunk = blk & 31, bh = blk >> 5, h = bh % 6, b = bh / 6, t = chunk * 64 + lane;
    const bf16_t* base = PROJ + (size_t)b * SEQ * LDP;
    float q[64], o[64];
    {
        const bf16_t* qp = base + (size_t)t * LDP + C_SBQ + h * 64;
#pragma unroll
        for (int d = 0; d < 64; ++d) { q[d] = bf2f(qp[d]) * 0.125f; o[d] = 0.f; }
    }
    float L = 0.f;
    const int tmax = chunk * 64 + 63;
    for (int s = tmax - 1; s >= 0; --s) {
        const bf16_t* kp = base + (size_t)s * LDP + C_SBK + h * 64;
        float z = 0.f;
#pragma unroll
        for (int d = 0; d < 64; ++d) z += q[d] * bf2f(kp[d]);
        const bool act = s < t;
        const float sp = fmaxf(z, 0.f) + log1pf(expf(-fabsf(z)));
        const float a = act ? expf((z - sp) + L) : 0.f;
        if (act) L -= sp;
        const bf16_t* vp = base + (size_t)s * LDP + C_SBV + h * 64;
#pragma unroll
        for (int d = 0; d < 64; ++d) o[d] += a * bf2f(vp[d]);
    }
    const bf16_t* gp = base + (size_t)t * LDP + C_SBG + h * 64;
    bf16_t* op = MIX + ((size_t)b * SEQ + t) * DM + h * 64;
#pragma unroll
    for (int d = 0; d < 64; ++d) { const float g = bf2f(gp[d]); op[d] = (bf16_t)f2bf(o[d] * (g / (1.f + expf(-g)))); }
}

__device__ __forceinline__ unsigned ordkey(float f) { unsigned u = __float_as_uint(f); return (u & 0x80000000u) ? ~u : (u | 0x80000000u); }
__device__ __forceinline__ void sel_naive_wave(const bf16_t* PROJ, unsigned* MASK, int gq, int lane, LAS unsigned char* wl) {
    LAS float* iq = (LAS float*)wl; LAS float* iw = (LAS float*)(wl + 1024); LAS unsigned long long* bal = (LAS unsigned long long*)(wl + 1280); LAS unsigned* scl = (LAS unsigned*)(wl + 2048);
    const int b = gq >> 11, t = gq & 2047;
    const bf16_t* row = PROJ + ((size_t)b * SEQ + t) * LDP;
    for (int i = lane; i < 256; i += 64) iq[i] = bf2f(row[C_IDQ + i]);
    if (lane < 8) iw[lane] = bf2f(row[C_IDW + lane]) * 0.0625f;
    WAVE_SYNC();
    for (int j = 0; j < 32; ++j) {
        unsigned kv = 0u;
        if (j * 64 <= t) {
            const int s = j * 64 + lane;
            const bf16_t* kr = PROJ + ((size_t)b * SEQ + s) * LDP + C_IDK;
            float kd[32];
#pragma unroll
            for (int d = 0; d < 32; ++d) kd[d] = bf2f(kr[d]);
            float acc = 0.f;
            unsigned iqo = 0; asm volatile("" : "+v"(iqo));
            const LAS float* iqj = iq + iqo;
#pragma unroll 1
            for (int hh = 0; hh < 8; ++hh) {
                float dt = 0.f;
#pragma unroll
                for (int d = 0; d < 32; ++d) dt += iqj[hh * 32 + d] * kd[d];
                acc += iw[hh] * fmaxf(dt, 0.f);
            }
            kv = (s <= t) ? ordkey(acc) : 0u;
        }
        scl[j * 64 + lane] = kv;
    }
    WAVE_SYNC();
    unsigned key[32];
#pragma unroll
    for (int j = 0; j < 32; ++j) key[j] = scl[j * 64 + lane];
    const bool need_sel = (t + 1) > 256;
    unsigned tau = 0u; int need = 0;
    if (need_sel) {
        unsigned prefix = 0u;
        for (int bit = 31; bit >= 0; --bit) {
            const unsigned cand = prefix | (1u << bit);
            int cnt = 0;
#pragma unroll
            for (int j = 0; j < 32; ++j) cnt += __popcll(__ballot(key[j] >= cand));
            if (cnt >= 256) prefix = cand;
        }
        tau = prefix;
        int cgt = 0;
#pragma unroll
        for (int j = 0; j < 32; ++j) cgt += __popcll(__ballot(key[j] > tau));
        need = 256 - cgt;
    }
    int tiesbefore = 0;
    const unsigned long long lt_mask = (lane == 0) ? 0ull : (~0ull >> (64 - lane));
#pragma unroll
    for (int j = 0; j < 32; ++j) {
        bool sel;
        if (!need_sel) sel = (j * 64 + lane) <= t;
        else {
            const bool gt = key[j] > tau, eq = key[j] == tau;
            const unsigned long long be = __ballot(eq);
            const int rank = tiesbefore + __popcll(be & lt_mask);
            sel = gt || (eq && rank < need);
            tiesbefore += __popcll(be);
        }
        const unsigned long long bs = __ballot(sel);
        if (lane == 0) bal[j] = bs;
    }
    WAVE_SYNC();
    {
        const int kt = lane;
        const unsigned long long bb = bal[kt >> 1];
        const unsigned nat = (unsigned)(bb >> (32 * (kt & 1)));
        unsigned w = 0u;
#pragma unroll
        for (int n = 0; n < 8; ++n) { const unsigned nib = (nat >> (4 * n)) & 0xfu; const int on = 4 * (n & 1) + (n >> 1); w |= nib << (4 * on); }
        MASK[((((size_t)b * 64 + (t >> 5)) * 64 + kt) * 32) + (t & 31)] = w;
    }
    WAVE_SYNC();
}

__device__ __forceinline__ void dsa_naive_wave(const bf16_t* PROJ, const bf16_t* CKVN, const unsigned* MASK, const float* w_uk, const float* w_uv,
                                               const float* rel_bias, bf16_t* MIX, int blk, int lane, LAS float* ql) {
    const int chunk = blk & 31, bh = blk >> 5, h = bh % 6, b = bh / 6, t = chunk * 64 + lane;
    {
        float q[64];
        const bf16_t* qp = PROJ + ((size_t)b * SEQ + t) * LDP + C_DSQ + h * 64;
#pragma unroll
        for (int d = 0; d < 64; ++d) q[d] = bf2f(qp[d]);
        for (int r = 0; r < 128; ++r) {
            const float* wp = w_uk + ((size_t)r * 6 + h) * 64;
            float a = 0.f;
#pragma unroll
            for (int d = 0; d < 64; ++d) a += q[d] * wp[d];
            ql[r * 64 + lane] = a * 0.125f;
        }
    }
    WAVE_SYNC();
    float o[128];
#pragma unroll
    for (int r = 0; r < 128; ++r) o[r] = 0.f;
    float m = -INFINITY, l = 0.f;
    const int tmax = chunk * 64 + 63, qt = t >> 5;
    for (int kt = 0; kt <= (tmax >> 5); ++kt) {
        unsigned w = 0u;
        if (kt <= qt) w = MASK[((((size_t)b * 64 + qt) * 64 + kt) * 32) + (t & 31)];
        for (int i = 0; i < 32; ++i) {
            const int hf = (i >> 2) & 1, a8 = i >> 3, c = i & 3, bit = 16 * hf + 4 * a8 + c;
            const bool sel = (w >> bit) & 1u;
            if (!__any(sel)) continue;
            const int s = kt * 32 + i;
            const bf16_t* cr = CKVN + ((size_t)b * SEQ + s) * 128;
            float lg = 0.f;
            for (int r = 0; r < 128; ++r) lg += ql[r * 64 + lane] * bf2f(cr[r]);
            int rel = t - s; rel = rel < 0 ? 0 : rel;
            const int bk = rel < 128 ? (int)T5TAB[rel] : 31;
            lg += rel_bias[bk * 6 + h];
            if (sel) {
                const float mn = fmaxf(m, lg), sc = expf(m - mn), p = expf(lg - mn);
                l = l * sc + p; m = mn;
#pragma unroll
                for (int r = 0; r < 128; ++r) o[r] = o[r] * sc + p * bf2f(cr[r]);
            }
        }
    }
    const float il = 1.f / l;
    WAVE_SYNC();
#pragma unroll
    for (int r = 0; r < 128; ++r) ql[r * 64 + lane] = o[r] * il;
    WAVE_SYNC();
    const bf16_t* gp = PROJ + ((size_t)b * SEQ + t) * LDP + C_DSG + h * 64;
    bf16_t* op = MIX + ((size_t)b * SEQ + t) * DM + 384 + h * 64;
    for (int d0 = 0; d0 < 64; d0 += 16) {
        float acc[16];
#pragma unroll
        for (int j = 0; j < 16; ++j) acc[j] = 0.f;
        for (int r = 0; r < 128; ++r) {
            const float ol = ql[r * 64 + lane];
            const float* wp = w_uv + ((size_t)r * 6 + h) * 64 + d0;
#pragma unroll
            for (int j = 0; j < 16; ++j) acc[j] += ol * wp[j];
        }
#pragma unroll
        for (int j = 0; j < 16; ++j) { const float g = bf2f(gp[d0 + j]); op[d0 + j] = (bf16_t)f2bf(acc[j] * (g / (1.f + expf(-g)))); }
    }
    WAVE_SYNC();
}

__device__ __forceinline__ void mem_naive_wave(const bf16_t* PROJ, const bf16_t* MEMKV  , bf16_t* MIX, int blk, int lane) {
    const int chunk = blk & 31, bh = blk >> 5, h = bh & 3, b = bh >> 2, t = chunk * 64 + lane;
    float q[64], o[64];
    const bf16_t* qp = PROJ + ((size_t)b * SEQ + t) * LDP + C_MQ + h * 64;
#pragma unroll
    for (int d = 0; d < 64; ++d) { q[d] = bf2f(qp[d]) * 0.125f; o[d] = 0.f; }
    float m = -INFINITY, l = 0.f;
    for (int s = 0; s < NMEM; ++s) {
        const bf16_t* kp = MEMKV + ((size_t)b * NMEM + s) * 1024 + h * 64;
        float z = 0.f;
#pragma unroll
        for (int d = 0; d < 64; ++d) z += q[d] * bf2f(kp[d]);
        const float mn = fmaxf(m, z), sc = expf(m - mn), p = expf(z - mn);
        l = l * sc + p; m = mn;
        const bf16_t* vp = kp + 256;
#pragma unroll
        for (int d = 0; d < 64; ++d) o[d] = o[d] * sc + p * bf2f(vp[d]);
    }
    const float il = 1.f / l;
    const bf16_t* gp = PROJ + ((size_t)b * SEQ + t) * LDP + C_MG + h * 64;
    bf16_t* op = MIX + ((size_t)b * SEQ + t) * DM + 768 + h * 64;
#pragma unroll
    for (int d = 0; d < 64; ++d) { const float g = bf2f(gp[d]); op[d] = (bf16_t)f2bf(o[d] * il * (g / (1.f + expf(-g)))); }
}

__device__ __forceinline__ void post_row(const float* xin, const bf16_t* Y, const float* g, float* xout, bf16_t* Hn, int row, int lane) {
    const bf16_t* yp = Y + (size_t)row * DM;
    float yv[16]; float s = 0.f;
#pragma unroll
    for (int j = 0; j < 4; ++j) {
        const v2u v = *(const v2u*)(yp + (lane + 64 * j) * 4);
        yv[4 * j + 0] = __uint_as_float(v.x << 16); yv[4 * j + 1] = __uint_as_float(v.x & 0xffff0000u);
        yv[4 * j + 2] = __uint_as_float(v.y << 16); yv[4 * j + 3] = __uint_as_float(v.y & 0xffff0000u);
        s += yv[4 * j] * yv[4 * j] + yv[4 * j + 1] * yv[4 * j + 1] + yv[4 * j + 2] * yv[4 * j + 2] + yv[4 * j + 3] * yv[4 * j + 3];
    }
    const float r = 1.0f / sqrtf(wave_sum(s) * (1.0f / DM) + EPS);
    f32x4 ov[4]; float s2 = 0.f;
#pragma unroll
    for (int j = 0; j < 4; ++j) {
        const int c = (lane + 64 * j) * 4;
        const f32x4 xv = *(const f32x4*)(xin + (size_t)row * DM + c);
        const f32x4 gv = *(const f32x4*)(g + c);
        ov[j].x = xv.x + yv[4 * j] * r * gv.x; ov[j].y = xv.y + yv[4 * j + 1] * r * gv.y; ov[j].z = xv.z + yv[4 * j + 2] * r * gv.z; ov[j].w = xv.w + yv[4 * j + 3] * r * gv.w;
        *(f32x4*)(xout + (size_t)row * DM + c) = ov[j];
        s2 += (ov[j].x * ov[j].x + ov[j].y * ov[j].y) + (ov[j].z * ov[j].z + ov[j].w * ov[j].w);
    }
    if (Hn) {
        const float r2 = 1.0f / sqrtf(wave_sum(s2) * (1.f / DM) + EPS);
        v2u* o8 = (v2u*)(Hn + (size_t)row * DM) + lane;
#pragma unroll
        for (int j = 0; j < 4; ++j) { v2u w; w.x = pk2(ov[j].x * r2, ov[j].y * r2); w.y = pk2(ov[j].z * r2, ov[j].w * r2); o8[64 * j] = w; }
    }
}

#ifndef MK_MULTI
#define MK_MULTI 0
#endif
constexpr int NPHASE = 11;
__global__ void __launch_bounds__(NWAVES * 64, 2) mk_fwd(Args args) {
    extern __shared__ __attribute__((aligned(16))) unsigned char lds_raw[];
    LAS unsigned char* lds = (LAS unsigned char*)lds_raw;
    const int tid = threadIdx.x, lane = tid & 63, wave = __builtin_amdgcn_readfirstlane(tid >> 6);
    const int G = gridDim.x, bid = blockIdx.x;
    const int gw = bid * NWAVES + wave, NGW = G * NWAVES;
    unsigned char* ws = args.ws;
    const float* x = args.in[0]; const float* mem = args.in[1]; const float* pre_g = args.in[2]; const float* post_g = args.in[3];
    const float* w_in = args.in[4]; const float* w_uk = args.in[5]; const float* w_uv = args.in[6]; const float* kv_g = args.in[7];
    const float* w_mem = args.in[8]; const float* w_out = args.in[9]; const float* rel_bias = args.in[10];
    float* out = args.out;
    bf16_t* WIN = (bf16_t*)(ws + WS_WIN); bf16_t* WOUT = (bf16_t*)(ws + WS_WOUT); bf16_t* WMEM = (bf16_t*)(ws + WS_WMEM);
    bf16_t* MEMB = (bf16_t*)(ws + WS_MEMB); bf16_t* MEMKV = (bf16_t*)(ws + WS_MEMKV); bf16_t* CKVN = (bf16_t*)(ws + WS_CKVN);
    unsigned* MASK = (unsigned*)(ws + WS_MASK); bf16_t* H = (bf16_t*)(ws + WS_H); bf16_t* MIX = (bf16_t*)(ws + WS_MIX);
    bf16_t* PROJ = (bf16_t*)(ws + WS_PROJ); bf16_t* Y = (bf16_t*)(ws + WS_Y);
    const int lo = args.ph_lo, hi = args.ph_hi;
#define IN(k) (lo <= (k) && (k) < hi)
#define SEAM(k) do { if (IN(k) && IN((k) + 1)) { cg::this_grid().sync(); } } while (0)

    if (IN(0)) {
        LAS float* scr = (LAS float*)(lds + wave * 16384);
        constexpr int I_IN = 16 * (LDP / 32), I_OUT = 16 * 32, I_MEM = 16 * 16;
        constexpr int NITEMS = 2 * I_IN + 2 * I_OUT + 2 * I_MEM;
        for (int it = gw; it < NITEMS; it += NGW) {
            int r = it;
            if (r < 2 * I_IN) { const int l = r / I_IN; r -= l * I_IN; p0_transpose_item(w_in + (size_t)l * DM * NCOL, DM, NCOL, LDP, WIN + (size_t)l * LDP * DM, pre_g + l * DM, scr, r, lane); continue; }
            r -= 2 * I_IN;
            if (r < 2 * I_OUT) { const int l = r / I_OUT; r -= l * I_OUT; p0_transpose_item(w_out + (size_t)l * DM * DM, DM, DM, DM, WOUT + (size_t)l * DM * DM, nullptr, scr, r, lane); continue; }
            r -= 2 * I_OUT;
            { const int l = r / I_MEM; r -= l * I_MEM; p0_transpose_item(w_mem + (size_t)l * DM * 512, DM, 512, 512, WMEM + (size_t)l * 512 * DM, nullptr, scr, r, lane); }
        }
        for (int m = gw; m < NB * NMEM; m += NGW) row_to_bf16<false>(mem + (size_t)m * DM, MEMB + (size_t)m * DM, lane);
        for (int m = gw; m < NTOK; m += NGW) row_to_bf16<true>(x + (size_t)m * DM, H + (size_t)m * DM, lane);
    }
    SEAM(0);
#pragma unroll 1
    for (int l = 0; l < 2; ++l) {
        const int pb = 1 + 5 * l;
        const float* xin = (l == 0) ? x : out;
        if (IN(pb)) {
            { pg8::Gemm g{H, WIN + (size_t)l * LDP * DM, NTOK, LDP, DM}; pg8::StaticOrder S; S.init(NTOK, LDP, G, bid);
              pg8::EpiBf16<0> E{PROJ, LDP, nullptr, 0, 0, 1.f};
              pg8::gemm_phase<pg8::EpiBf16<0>, pg8::StaticOrder, true, true>(lds, g, S, E); }
            if (l == 0) {
              pg8::Gemm g{MEMB, WMEM, NB * NMEM, 1024, DM}; pg8::StaticOrder S; S.init(NB * NMEM, 1024, G, bid);
              pg8::EpiBf16<0> E{MEMKV, 1024, nullptr, 0, 0, 1.f};
              pg8::gemm_phase<pg8::EpiBf16<0>, pg8::StaticOrder, true, true>(lds, g, S, E); }
        }
        SEAM(pb);
        if (IN(pb + 1)) {

#ifndef SKIP_CKV
            for (int m = gw; m < NTOK; m += NGW) ckvnorm_wave(PROJ, kv_g + l * 128, CKVN, m, lane);
#endif
#ifndef SKIP_SB
            for (int vb = gw; vb < NB * 6 * 32; vb += NGW) sb_naive_wave(PROJ, MIX, vb, lane);
#endif
#ifndef SKIP_SEL
            for (int vb = gw; vb < NTOK; vb += NGW) sel_naive_wave(PROJ, MASK, vb, lane, lds + wave * 10240);
#endif
#ifndef SKIP_MEM
            for (int vb = gw; vb < NB * 4 * 32; vb += NGW) mem_naive_wave(PROJ, MEMKV + l * 512, MIX, vb, lane);
#endif
        }
        SEAM(pb + 1);
        if (IN(pb + 2)) {
#ifndef SKIP_DSA
            if (wave < 4) for (int vb = bid * 4 + wave; vb < NB * 6 * 32; vb += G * 4)
                dsa_naive_wave(PROJ, CKVN, MASK, w_uk + (size_t)l * 128 * 384, w_uv + (size_t)l * 128 * 384, rel_bias, MIX, vb, lane, (LAS float*)(lds + wave * 32768));
#endif
        }
        SEAM(pb + 2);
        if (IN(pb + 3)) {
            __syncthreads();
            pg8::Gemm g{MIX, WOUT + (size_t)l * DM * DM, NTOK, DM, DM}; pg8::StaticOrder S; S.init(NTOK, DM, G, bid);
            pg8::EpiBf16<0> E{Y, DM, nullptr, 0, 0, 1.f};
            pg8::gemm_phase<pg8::EpiBf16<0>, pg8::StaticOrder, true, true>(lds, g, S, E);
        }
        SEAM(pb + 3);
        if (IN(pb + 4)) {
            for (int m = gw; m < NTOK; m += NGW) post_row(xin, Y, post_g + l * DM, out, (l == 0) ? H : (bf16_t*)nullptr, m, lane);
        }
        SEAM(pb + 4);
    }
#undef IN
#undef SEAM
}

extern "C" void kernel_launch(void* const* d_in, const int* in_sizes, int n_in, void* d_out, int out_size, void* d_ws, size_t ws_size, hipStream_t stream) {
    static int grid = 0;
    if (grid == 0) {
        if (n_in != 11 || ws_size < WS_END) { fprintf(stderr, "kernel_launch: unexpected n_in %d / ws_size %zu\n", n_in, ws_size); grid = -1; return; }
        int dev = 0, cus = 0, per_cu = 0;
        hipGetDevice(&dev);
        hipDeviceGetAttribute(&cus, hipDeviceAttributeMultiprocessorCount, dev);
        hipFuncSetAttribute((const void*)mk_fwd, hipFuncAttributeMaxDynamicSharedMemorySize, LDS_BYTES);
        hipOccupancyMaxActiveBlocksPerMultiprocessor(&per_cu, (const void*)mk_fwd, NWAVES * 64, LDS_BYTES);
        if (per_cu < 1) { fprintf(stderr, "kernel_launch: occupancy query says %d blocks per CU\n", per_cu); per_cu = 1; }
        grid = cus * 1;
        (void)hipGetLastError();
    }
    if (grid < 0) return;
    Args a{};
    for (int i = 0; i < 11; ++i) a.in[i] = (const float*)d_in[i];
    a.out = (float*)d_out; a.ws = (unsigned char*)d_ws;
#if MK_MULTI
    for (int p = 0; p < NPHASE; ++p) { a.ph_lo = p; a.ph_hi = p + 1; hipLaunchKernelGGL(mk_fwd, dim3(grid), dim3(NWAVES * 64), LDS_BYTES, stream, a); }
#else
    a.ph_lo = 0; a.ph_hi = NPHASE;
    void* kargs[] = {&a};
    hipError_t e = hipLaunchCooperativeKernel((const void*)mk_fwd, dim3(grid), dim3(NWAVES * 64), kargs, LDS_BYTES, stream);
    if (e != hipSuccess) fprintf(stderr, "cooperative launch failed: %s (grid %d)\n", hipGetErrorString(e), grid);
#endif
}
```

```cpp
#include <hip/hip_runtime.h>
#include <hip/hip_cooperative_groups.h>
#include <stdint.h>
#include <math.h>
#include <cstdio>
namespace cg = cooperative_groups;
namespace pg8 {
#define PG8_LAS __attribute__((address_space(3)))
typedef unsigned short bf16_t;
typedef short bf16x8 __attribute__((ext_vector_type(8)));
typedef float f32x4 __attribute__((ext_vector_type(4)));
typedef unsigned u32x4 __attribute__((ext_vector_type(4)));
constexpr int BM = 256, BK = 64, HALF = 128, HTB = HALF * BK * 2  , STAGE_BYTES = 8 * HTB, NXCD = 8, WGM = 8;

__host__ __device__ __forceinline__ int lds_byte(int r, int c) { const int st = (r >> 4) * 2 + (c >> 5), rr = r & 15, cc = c & 31, ob = rr * 64 + cc * 2; return st * 1024 + (ob ^ (((ob >> 9) & 1) << 5)); }
__host__ __device__ __forceinline__ void stage_rc(int b, int& R, int& C) { const int st = b / 1024, sb = b % 1024, swz = sb ^ (((sb >> 9) & 1) << 5); R = (st >> 1) * 16 + swz / 64; C = (st & 1) * 32 + (swz % 64) / 2; }
__host__ __device__ __forceinline__ int perm32(int rho) { const int n = rho >> 4, i = rho & 15; return 8 * (i >> 2) + 4 * n + (i & 3); }

struct Unit { int pm, pn; };
struct Gemm { const bf16_t* A; const bf16_t* Bt; int M, N, K; };

struct StaticOrder {
    int nM, nN, nwg, G, c;
    __host__ __device__ void init(int M, int N, int G_, int c_) { nM = M / BM; nN = N / BM; nwg = nM * nN; G = G_; c = c_; }
    __host__ __device__ bool next(int i, Unit& u) const {
        const long L = (long)i * G + c; if (L >= nwg) return false;
        int wgid = (int)L; { const int q = nwg / NXCD, r = nwg % NXCD, xcd = wgid % NXCD, off = wgid / NXCD; wgid = (xcd < r ? xcd * (q + 1) : r * (q + 1) + (xcd - r) * q) + off; }
        const int nig = WGM * nN, gid = wgid / nig, fm = gid * WGM, gsz = (nM - fm) < WGM ? (nM - fm) : WGM;
        u.pm = fm + ((wgid % nig) % gsz); u.pn = (wgid % nig) / gsz; return true;
    }
    __device__ __forceinline__ void a_ready(const Unit&) const {}
    __device__ __forceinline__ void done(const Unit&) const {}
};

__device__ __forceinline__ unsigned cvt_pk_bf16(float lo, float hi) { unsigned r; asm volatile("v_cvt_pk_bf16_f32 %0, %1, %2" : "=v"(r) : "v"(lo), "v"(hi)); return r; }
typedef float f32x2 __attribute__((ext_vector_type(2)));
__device__ __forceinline__ f32x2 gelu_pk(f32x2 v) {
    const f32x2 av = __builtin_elementwise_abs(v), d = av * 0.2316418882f + 1.0f;
    f32x2 t; t.x = __builtin_amdgcn_rcpf(d.x); t.y = __builtin_amdgcn_rcpf(d.y);
    f32x2 q = t * 0.5307027145f + (-0.7265760135f); q = q * t + 0.7107068705f; q = q * t + (-0.142248368f); q = q * t + 0.127414796f; q = q * t;
    const f32x2 s = (v * v) * (-0.72134752044f);
    f32x2 e; e.x = __builtin_amdgcn_exp2f(s.x); e.y = __builtin_amdgcn_exp2f(s.y);
    const f32x2 m = v * (q * e), r = v - m;
    f32x2 o; o.x = v.x < 0.f ? m.x : r.x; o.y = v.y < 0.f ? m.y : r.y; return o;
}

template <int ACT  > struct EpiBf16 {
    static constexpr bool PERM = true, AFTER_DRAIN = false; static_assert(ACT == 0 || ACT == 1, "EpiBf16: ACT is 0 (none) or 1 (gelu_pk)");
    bf16_t* O; int ldc; const float* bias; int split_cols; size_t split_stride; float scale0;
    __device__ __forceinline__ void operator()(const f32x4 (&acc)[2][2][4][2], const Unit& u, int wr, int wc, int fr, int fq) const {
        const int row0 = u.pm * BM + wr * 64 + fr; int colt = u.pn * BM; bf16_t* base = O;
        float sc = 1.f; if (split_cols) { const int t = colt / split_cols; base += (size_t)t * split_stride; colt -= t * split_cols; if (t == 0) sc = scale0; }
        const int col0 = colt + wc * 32 + 8 * fq, bcol0 = u.pn * BM + wc * 32 + 8 * fq;
        f32x4 bv[2][2];
#pragma unroll
        for (int bj = 0; bj < 2; ++bj)
#pragma unroll
            for (int n = 0; n < 2; ++n) bv[bj][n] = bias ? *(const f32x4*)(bias + bcol0 + bj * HALF + 4 * n) : (f32x4){0.f, 0.f, 0.f, 0.f};
#pragma unroll
        for (int ai = 0; ai < 2; ++ai)
#pragma unroll
            for (int m = 0; m < 4; ++m) { bf16_t* rowp = base + (size_t)(row0 + ai * HALF + m * 16) * ldc + col0;
#pragma unroll
                for (int bj = 0; bj < 2; ++bj) { f32x4 v0 = acc[ai][bj][m][0] + bv[bj][0], v1 = acc[ai][bj][m][1] + bv[bj][1];
                    if (ACT == 1) { f32x2 a = gelu_pk((f32x2){v0[0], v0[1]}), b = gelu_pk((f32x2){v0[2], v0[3]}), c = gelu_pk((f32x2){v1[0], v1[1]}), d = gelu_pk((f32x2){v1[2], v1[3]});
                        v0 = (f32x4){a.x, a.y, b.x, b.y}; v1 = (f32x4){c.x, c.y, d.x, d.y}; }
                    v0 = v0 * sc; v1 = v1 * sc; u32x4 w; w.x = cvt_pk_bf16(v0[0], v0[1]); w.y = cvt_pk_bf16(v0[2], v0[3]); w.z = cvt_pk_bf16(v1[0], v1[1]); w.w = cvt_pk_bf16(v1[2], v1[3]);
                    *(u32x4*)(rowp + bj * HALF) = w; } }
    }
};
template <class Epi, class Sched, bool ALIGN_EPI = false, bool SP2 = false>
__device__ __forceinline__ void gemm_phase(PG8_LAS unsigned char* lds, const Gemm g, const Sched& S, const Epi& E) {
    int tid_ = threadIdx.x; asm volatile("" : "+v"(tid_));
    const int tid = tid_, wid = __builtin_amdgcn_readfirstlane(tid >> 6), lane = tid & 63, wr = wid >> 2, wc = wid & 3, fr = lane & 15, fq = lane >> 4;
    const int K = g.K, nt = K / BK;
    unsigned voffA[2], voffB[2];
#pragma unroll
    for (int i = 0; i < 2; ++i) { int R, C; stage_rc(tid * 16 + i * 8192, R, C); const int Rb = Epi::PERM ? ((R & ~31) + perm32(R & 31)) : R;
        voffA[i] = (unsigned)(R * K + C) * 2u; voffB[i] = (unsigned)(Rb * K + C) * 2u; }
    const size_t kstep = (size_t)(BK * 2);
    const size_t hstep = (size_t)HALF * K * 2;
    const size_t tstep = 2 * hstep;
    const unsigned ldsw = (unsigned)wid * 1024u;
    const int aoff = lds_byte(wr * 64 + fr, fq * 8), boff = lds_byte(wc * 32 + fr, fq * 8);
#define PG8_SA(b, h) (((b) * 2 + (h)) * HTB)
#define PG8_SB(b, h) ((4 + (b) * 2 + (h)) * HTB)
#define PG8_STAGE(bufoff, gbase, voff) do { _Pragma("unroll") for (int _i = 0; _i < 2; ++_i) \
        __builtin_amdgcn_global_load_lds((const unsigned*)((const char*)(gbase) + (voff)[_i]), (PG8_LAS unsigned*)(lds + (bufoff) + ldsw + _i * 8192), 16, 0, 0); } while (0)
#define PG8_LDA(dst, b, h) do { _Pragma("unroll") for (int m = 0; m < 4; ++m) _Pragma("unroll") for (int k = 0; k < 2; ++k) dst[m][k] = *(const PG8_LAS bf16x8*)(lds + PG8_SA(b, h) + aoff + m * 2048 + k * 1024); } while (0)
#define PG8_LDB(dst, b, h) do { _Pragma("unroll") for (int n = 0; n < 2; ++n) _Pragma("unroll") for (int k = 0; k < 2; ++k) dst[n][k] = *(const PG8_LAS bf16x8*)(lds + PG8_SB(b, h) + boff + n * 2048 + k * 1024); } while (0)
#define PG8_MMA(ai, bj, At, Bt) do { __builtin_amdgcn_s_setprio(1); _Pragma("unroll") for (int m = 0; m < 4; ++m) _Pragma("unroll") for (int n = 0; n < 2; ++n) _Pragma("unroll") for (int k = 0; k < 2; ++k) \
        acc[ai][bj][m][n] = __builtin_amdgcn_mfma_f32_16x16x32_bf16(Bt[n][k], At[m][k], acc[ai][bj][m][n], 0, 0, 0); __builtin_amdgcn_s_setprio(0); } while (0)
#define PG8_WAIT_V(n) asm volatile("s_waitcnt vmcnt(" #n ")" ::: "memory")
#define PG8_WAIT_L(n) asm volatile("s_waitcnt lgkmcnt(" #n ")" ::: "memory")
#define PG8_BAR __builtin_amdgcn_s_barrier()
#define PG8_SCHED __builtin_amdgcn_sched_barrier(0)
    Unit cur, nxt; int ui = 0;
    if (!S.next(0, cur)) return;
    f32x4 acc[2][2][4][2];
#pragma unroll
    for (int a = 0; a < 2; ++a)
#pragma unroll
        for (int b = 0; b < 2; ++b)
#pragma unroll
            for (int m = 0; m < 4; ++m)
#pragma unroll
                for (int n = 0; n < 2; ++n) acc[a][b][m][n] = (f32x4){0.f, 0.f, 0.f, 0.f};
    bf16x8 At[4][2], B0[2][2], B1[2][2];
    const char* cA = (const char*)g.A + (size_t)cur.pm * tstep; const char* cB = (const char*)g.Bt + (size_t)cur.pn * tstep;
    S.a_ready(cur);
    if constexpr (SP2) {
        PG8_STAGE(PG8_SB(0, 0), cB, voffB); PG8_STAGE(PG8_SB(0, 1), cB + hstep, voffB); PG8_STAGE(PG8_SA(0, 0), cA, voffA); PG8_STAGE(PG8_SA(0, 1), cA + hstep, voffA);
        if (wr == 1) PG8_BAR;
        PG8_WAIT_V(2); PG8_BAR;
        PG8_STAGE(PG8_SB(1, 0), cB + kstep, voffB); PG8_STAGE(PG8_SA(1, 0), cA + kstep, voffA); PG8_STAGE(PG8_SB(1, 1), cB + hstep + kstep, voffB);
        PG8_WAIT_V(6); PG8_BAR;
    } else {
        PG8_STAGE(PG8_SB(0, 0), cB, voffB); PG8_STAGE(PG8_SA(0, 0), cA, voffA); PG8_STAGE(PG8_SB(0, 1), cB + hstep, voffB); PG8_STAGE(PG8_SA(0, 1), cA + hstep, voffA);
        if (wr == 1) PG8_BAR;
        PG8_WAIT_V(4); PG8_BAR;
        PG8_STAGE(PG8_SB(1, 0), cB + kstep, voffB); PG8_STAGE(PG8_SA(1, 0), cA + kstep, voffA); PG8_STAGE(PG8_SB(1, 1), cB + hstep + kstep, voffB);
        PG8_WAIT_V(6); PG8_BAR;
    }
    for (;;) {
        const bool has_next = S.next(ui + 1, nxt);
        const char* nA = has_next ? (const char*)g.A + (size_t)nxt.pm * tstep : cA; const char* nB = has_next ? (const char*)g.Bt + (size_t)nxt.pn * tstep : cB;
        for (int t = 0; t < nt; t += 2) {
            const bool last = (t == nt - 2);
            const char* a1 = cA + (size_t)(t + 1) * kstep;
            const char* a2 = last ? nA : cA + (size_t)(t + 2) * kstep; const char* b2 = last ? nB : cB + (size_t)(t + 2) * kstep;
            const char* a3 = a2 + kstep; const char* b3 = b2 + kstep;
            if (last && has_next) S.a_ready(nxt);
            if constexpr (SP2) {
            PG8_LDB(B0, 0, 0); PG8_LDB(B1, 0, 1); PG8_SCHED; PG8_LDA(At, 0, 0); PG8_STAGE(PG8_SA(1, 1), a1 + hstep, voffA);
            PG8_WAIT_V(8); PG8_WAIT_L(0); PG8_BAR; PG8_MMA(0, 0, At, B0); PG8_MMA(0, 1, At, B1); PG8_BAR; PG8_SCHED;
            PG8_LDA(At, 0, 1); PG8_STAGE(PG8_SB(0, 0), b2, voffB); PG8_STAGE(PG8_SB(0, 1), b2 + hstep, voffB); PG8_STAGE(PG8_SA(0, 0), a2, voffA);
            PG8_WAIT_V(8); PG8_WAIT_L(0); PG8_BAR; PG8_MMA(1, 0, At, B0); PG8_MMA(1, 1, At, B1); PG8_BAR; PG8_SCHED;
            PG8_LDB(B0, 1, 0); PG8_LDB(B1, 1, 1); PG8_SCHED; PG8_LDA(At, 1, 0); PG8_STAGE(PG8_SA(0, 1), a2 + hstep, voffA);
            PG8_WAIT_V(8); PG8_WAIT_L(0); PG8_BAR; PG8_MMA(0, 0, At, B0); PG8_MMA(0, 1, At, B1); PG8_BAR; PG8_SCHED;
            PG8_LDA(At, 1, 1); PG8_STAGE(PG8_SB(1, 0), b3, voffB); PG8_STAGE(PG8_SB(1, 1), b3 + hstep, voffB); PG8_STAGE(PG8_SA(1, 0), a3, voffA);
            PG8_WAIT_V(8); PG8_WAIT_L(0); PG8_BAR; PG8_MMA(1, 0, At, B0); PG8_MMA(1, 1, At, B1); PG8_BAR; PG8_SCHED;
            } else {
            PG8_LDB(B0, 0, 0); PG8_SCHED; PG8_LDA(At, 0, 0); PG8_STAGE(PG8_SA(1, 1), a1 + hstep, voffA);
            PG8_WAIT_L(8); PG8_BAR; PG8_WAIT_L(0); PG8_MMA(0, 0, At, B0); PG8_BAR; PG8_SCHED;
            PG8_LDB(B1, 0, 1); PG8_STAGE(PG8_SB(0, 0), b2, voffB);
            PG8_BAR; PG8_WAIT_L(0); PG8_MMA(0, 1, At, B1); PG8_BAR;
            PG8_LDA(At, 0, 1); PG8_STAGE(PG8_SA(0, 0), a2, voffA);
            PG8_BAR; PG8_WAIT_L(0); PG8_MMA(1, 0, At, B0); PG8_BAR; PG8_SCHED;
            PG8_STAGE(PG8_SB(0, 1), b2 + hstep, voffB);
            PG8_WAIT_V(6); PG8_BAR; PG8_MMA(1, 1, At, B1); PG8_BAR;
            PG8_LDB(B0, 1, 0); PG8_SCHED; PG8_LDA(At, 1, 0); PG8_STAGE(PG8_SA(0, 1), a2 + hstep, voffA);
            PG8_WAIT_L(8); PG8_BAR; PG8_WAIT_L(0); PG8_MMA(0, 0, At, B0); PG8_BAR; PG8_SCHED;
            PG8_LDB(B1, 1, 1); PG8_STAGE(PG8_SB(1, 0), b3, voffB);
            PG8_BAR; PG8_WAIT_L(0); PG8_MMA(0, 1, At, B1); PG8_BAR;
            PG8_LDA(At, 1, 1); PG8_STAGE(PG8_SA(1, 0), a3, voffA);
            PG8_BAR; PG8_WAIT_L(0); PG8_MMA(1, 0, At, B0); PG8_BAR; PG8_SCHED;
            PG8_STAGE(PG8_SB(1, 1), b3 + hstep, voffB);
            PG8_WAIT_V(6); PG8_BAR; PG8_MMA(1, 1, At, B1); PG8_BAR;
            }
        }
        if constexpr (ALIGN_EPI) { if (wr == 0) PG8_BAR; }
        if constexpr (!Epi::AFTER_DRAIN) { E(acc, cur, wr, wc, fr, fq); S.done(cur); }
        if (!has_next) break;
#pragma unroll
        for (int a = 0; a < 2; ++a)
#pragma unroll
            for (int b = 0; b < 2; ++b)
#pragma unroll
                for (int m = 0; m < 4; ++m)
#pragma unroll
                    for (int n = 0; n < 2; ++n) acc[a][b][m][n] = (f32x4){0.f, 0.f, 0.f, 0.f};
        cur = nxt; cA = nA; cB = nB; ++ui;
        if constexpr (ALIGN_EPI) { if (wr == 1) PG8_BAR; }
    }
    PG8_WAIT_V(0);
    if constexpr (!ALIGN_EPI) { if (wr == 0) PG8_BAR; }
    PG8_BAR;
    if constexpr (Epi::AFTER_DRAIN) { E.fused(acc, cur, wr, wc, fr, fq, lds, wid, lane); S.done(cur); }
#undef PG8_SA
#undef PG8_SB
#undef PG8_STAGE
#undef PG8_LDA
#undef PG8_LDB
#undef PG8_MMA
#undef PG8_WAIT_V
#undef PG8_WAIT_L
#undef PG8_BAR
#undef PG8_SCHED
}
}
typedef unsigned short bf16_t;
#define LAS __attribute__((address_space(3)))
#define GAS __attribute__((address_space(1)))
typedef unsigned v4u __attribute__((ext_vector_type(4)));
typedef unsigned v2u __attribute__((ext_vector_type(2)));
typedef float f32x4 __attribute__((ext_vector_type(4)));
constexpr int DM = 1024, NB = 32, SEQ = 2048, NTOK = NB * SEQ, NMEM = 256;
constexpr int LDP = 3328;
constexpr int C_SBQ = 0, C_SBK = 384, C_SBV = 768, C_SBG = 1152, C_DSQ = 1536, C_CKV = 1920, C_DSG = 2048,
              C_IDQ = 2432, C_IDK = 2688, C_IDW = 2720, C_MQ = 2728, C_MG = 2984, NCOL = 3240;
constexpr float EPS = 1e-6f;
constexpr size_t MiB = 1u << 20;
constexpr size_t WS_CTL = 0;
constexpr size_t WS_WIN = 1 * MiB;
constexpr size_t WS_WOUT = 14 * MiB;
constexpr size_t WS_WMEM = 18 * MiB;
constexpr size_t WS_MEMB = 20 * MiB;
constexpr size_t WS_MEMKV = 36 * MiB;
constexpr size_t WS_CKVN = 52 * MiB;
constexpr size_t WS_MASK = 68 * MiB;
constexpr size_t WS_H = 84 * MiB;
constexpr size_t WS_MIX = WS_H;
constexpr size_t WS_PROJ = 212 * MiB;
constexpr size_t WS_Y = WS_PROJ;
constexpr size_t WS_END = 628 * MiB;
constexpr int LDS_BYTES = 135168;
constexpr int NWAVES = 8;

__device__ __forceinline__ float bf2f(bf16_t v) { return __uint_as_float(((unsigned)v) << 16); }
__device__ __forceinline__ unsigned f2bf(float f) { unsigned u = __float_as_uint(f); u += 0x7fffu + ((u >> 16) & 1u); return u >> 16; }
__device__ __forceinline__ unsigned pk2(float lo, float hi) { return f2bf(lo) | (f2bf(hi) << 16); }
#define WAVE_SYNC() do { asm volatile("s_waitcnt lgkmcnt(0)" ::: "memory"); __builtin_amdgcn_wave_barrier(); } while (0)
__device__ __forceinline__ float wave_sum(float v) {
#pragma unroll
    for (int o = 1; o < 64; o <<= 1) v += __shfl_xor(v, o);
    return v;
}

__device__ const unsigned char T5TAB[128] = {0, 1, 2, 3, 4, 5, 6, 7, 8, 9, 10, 11, 12, 13, 14, 15, 16, 16, 16, 17, 17, 18, 18, 18, 19, 19, 19, 20, 20, 20, 20, 21, 21, 21, 21, 22, 22, 22, 22, 22, 23, 23, 23, 23, 23, 23, 24, 24, 24, 24, 24, 24, 25, 25, 25, 25, 25, 25, 25, 26, 26, 26, 26, 26, 26, 26, 26, 27, 27, 27, 27, 27, 27, 27, 27, 27, 27, 28, 28, 28, 28, 28, 28, 28, 28, 28, 28, 29, 29, 29, 29, 29, 29, 29, 29, 29, 29, 29, 29, 30, 30, 30, 30, 30, 30, 30, 30, 30, 30, 30, 30, 30, 30, 31, 31, 31, 31, 31, 31, 31, 31, 31, 31, 31, 31, 31, 31, 31};

struct Args { const float* in[11]; float* out; unsigned char* ws; int ph_lo, ph_hi; };

__device__ __forceinline__ void p0_transpose_item(const float* W, int K, int N, int Npad, bf16_t* WT, const float* g, LAS float* scr, int item, int lane) {
    const int nblk = Npad / 32, kb = item / nblk, nb = item % nblk, k0 = 64 * kb, n0 = 32 * nb;
    const int nn = n0 + (lane & 31);
#pragma unroll 8
    for (int i = 0; i < 32; ++i) { const int kk = 2 * i + (lane >> 5); float v = (nn < N) ? W[(size_t)(k0 + kk) * N + nn] : 0.f; if (g) v *= g[k0 + kk]; scr[kk * 33 + (lane & 31)] = v; }
    WAVE_SYNC();
    const int c = lane & 7;
#pragma unroll
    for (int j = 0; j < 4; ++j) { const int n = (lane >> 3) + 8 * j; const LAS float* s = scr + (8 * c) * 33 + n;
        v4u o; o.x = pk2(s[0 * 33], s[1 * 33]); o.y = pk2(s[2 * 33], s[3 * 33]); o.z = pk2(s[4 * 33], s[5 * 33]); o.w = pk2(s[6 * 33], s[7 * 33]);
        *(v4u*)(WT + (size_t)(n0 + n) * K + k0 + 8 * c) = o; }
    WAVE_SYNC();
}
template <bool NORM> __device__ __forceinline__ void row_to_bf16(const float* xrow, bf16_t* orow, int lane) {
    const f32x4* xr = (const f32x4*)xrow + lane;
    f32x4 v[4]; float s = 0.f;
#pragma unroll
    for (int j = 0; j < 4; ++j) { v[j] = xr[64 * j]; s += (v[j].x * v[j].x + v[j].y * v[j].y) + (v[j].z * v[j].z + v[j].w * v[j].w); }
    float r = 1.f;
    if (NORM) r = 1.0f / sqrtf(wave_sum(s) * (1.f / DM) + EPS);
    v2u* o8 = (v2u*)orow + lane;
#pragma unroll
    for (int j = 0; j < 4; ++j) { v2u w; w.x = pk2(v[j].x * r, v[j].y * r); w.y = pk2(v[j].z * r, v[j].w * r); o8[64 * j] = w; }
}

__device__ __forceinline__ void ckvnorm_wave(const bf16_t* PROJ, const float* kvg, bf16_t* CKVN, int row, int lane) {
    const bf16_t* p = PROJ + (size_t)row * LDP + C_CKV;
    const float a = bf2f(p[lane]), b = bf2f(p[lane + 64]);
    const float s = wave_sum(a * a + b * b);
    const float r = 1.0f / sqrtf(s * (1.0f / 128.f) + EPS);
    CKVN[(size_t)row * 128 + lane] = (bf16_t)f2bf(a * r * kvg[lane]);
    CKVN[(size_t)row * 128 + lane + 64] = (bf16_t)f2bf(b * r * kvg[lane + 64]);
}

__device__ __forceinline__ void sb_naive_wave(const bf16_t* PROJ, bf16_t* MIX, int blk, int lane) {
    const int chunk = blk & 31, bh = blk >> 5, h = bh % 6, b = bh / 6, t = chunk * 64 + lane;
    const bf16_t* base = PROJ + (size_t)b * SEQ * LDP;
    float q[64], o[64];
    {
        const bf16_t* qp = base + (size_t)t * LDP + C_SBQ + h * 64;
#pragma unroll
        for (int d = 0; d < 64; ++d) { q[d] = bf2f(qp[d]) * 0.125f; o[d] = 0.f; }
    }
    float L = 0.f;
    const int tmax = chunk * 64 + 63;
    for (int s = tmax - 1; s >= 0; --s) {
        const bf16_t* kp = base + (size_t)s * LDP + C_SBK + h * 64;
        float z = 0.f;
#pragma unroll
        for (int d = 0; d < 64; ++d) z += q[d] * bf2f(kp[d]);
        const bool act = s < t;
        const float sp = fmaxf(z, 0.f) + log1pf(expf(-fabsf(z)));
        const float a = act ? expf((z - sp) + L) : 0.f;
        if (act) L -= sp;
        const bf16_t* vp = base + (size_t)s * LDP + C_SBV + h * 64;
#pragma unroll
        for (int d = 0; d < 64; ++d) o[d] += a * bf2f(vp[d]);
    }
    const bf16_t* gp = base + (size_t)t * LDP + C_SBG + h * 64;
    bf16_t* op = MIX + ((size_t)b * SEQ + t) * DM + h * 64;
#pragma unroll
    for (int d = 0; d < 64; ++d) { const float g = bf2f(gp[d]); op[d] = (bf16_t)f2bf(o[d] * (g / (1.f + expf(-g)))); }
}

__device__ __forceinline__ unsigned ordkey(float f) { unsigned u = __float_as_uint(f); return (u & 0x80000000u) ? ~u : (u | 0x80000000u); }
__device__ __forceinline__ void sel_naive_wave(const bf16_t* PROJ, unsigned* MASK, int gq, int lane, LAS unsigned char* wl) {
    LAS float* iq = (LAS float*)wl; LAS float* iw = (LAS float*)(wl + 1024); LAS unsigned long long* bal = (LAS unsigned long long*)(wl + 1280); LAS unsigned* scl = (LAS unsigned*)(wl + 2048);
    const int b = gq >> 11, t = gq & 2047;
    const bf16_t* row = PROJ + ((size_t)b * SEQ + t) * LDP;
    for (int i = lane; i < 256; i += 64) iq[i] = bf2f(row[C_IDQ + i]);
    if (lane < 8) iw[lane] = bf2f(row[C_IDW + lane]) * 0.0625f;
    WAVE_SYNC();
    for (int j = 0; j < 32; ++j) {
        unsigned kv = 0u;
        if (j * 64 <= t) {
            const int s = j * 64 + lane;
            const bf16_t* kr = PROJ + ((size_t)b * SEQ + s) * LDP + C_IDK;
            float kd[32];
#pragma unroll
            for (int d = 0; d < 32; ++d) kd[d] = bf2f(kr[d]);
            float acc = 0.f;
            unsigned iqo = 0; asm volatile("" : "+v"(iqo));
            const LAS float* iqj = iq + iqo;
#pragma unroll 1
            for (int hh = 0; hh < 8; ++hh) {
                float dt = 0.f;
#pragma unroll
                for (int d = 0; d < 32; ++d) dt += iqj[hh * 32 + d] * kd[d];
                acc += iw[hh] * fmaxf(dt, 0.f);
            }
            kv = (s <= t) ? ordkey(acc) : 0u;
        }
        scl[j * 64 + lane] = kv;
    }
    WAVE_SYNC();
    unsigned key[32];
#pragma unroll
    for (int j = 0; j < 32; ++j) key[j] = scl[j * 64 + lane];
    const bool need_sel = (t + 1) > 256;
    unsigned tau = 0u; int need = 0;
    if (need_sel) {
        unsigned prefix = 0u;
        for (int bit = 31; bit >= 0; --bit) {
            const unsigned cand = prefix | (1u << bit);
            int cnt = 0;
#pragma unroll
            for (int j = 0; j < 32; ++j) cnt += __popcll(__ballot(key[j] >= cand));
            if (cnt >= 256) prefix = cand;
        }
        tau = prefix;
        int cgt = 0;
#pragma unroll
        for (int j = 0; j < 32; ++j) cgt += __popcll(__ballot(key[j] > tau));
        need = 256 - cgt;
    }
    int tiesbefore = 0;
    const unsigned long long lt_mask = (lane == 0) ? 0ull : (~0ull >> (64 - lane));
#pragma unroll
    for (int j = 0; j < 32; ++j) {
        bool sel;
        if (!need_sel) sel = (j * 64 + lane) <= t;
        else {
            const bool gt = key[j] > tau, eq = key[j] == tau;
            const unsigned long long be = __ballot(eq);
            const int rank = tiesbefore + __popcll(be & lt_mask);
            sel = gt || (eq && rank < need);
            tiesbefore += __popcll(be);
        }
        const unsigned long long bs = __ballot(sel);
        if (lane == 0) bal[j] = bs;
    }
    WAVE_SYNC();
    {
        const int kt = lane;
        const unsigned long long bb = bal[kt >> 1];
        const unsigned nat = (unsigned)(bb >> (32 * (kt & 1)));
        unsigned w = 0u;
#pragma unroll
        for (int n = 0; n < 8; ++n) { const unsigned nib = (nat >> (4 * n)) & 0xfu; const int on = 4 * (n & 1) + (n >> 1); w |= nib << (4 * on); }
        MASK[((((size_t)b * 64 + (t >> 5)) * 64 + kt) * 32) + (t & 31)] = w;
    }
    WAVE_SYNC();
}

__device__ __forceinline__ void dsa_naive_wave(const bf16_t* PROJ, const bf16_t* CKVN, const unsigned* MASK, const float* w_uk, const float* w_uv,
                                               const float* rel_bias, bf16_t* MIX, int blk, int lane, LAS float* ql) {
    const int chunk = blk & 31, bh = blk >> 5, h = bh % 6, b = bh / 6, t = chunk * 64 + lane;
    {
        float q[64];
        const bf16_t* qp = PROJ + ((size_t)b * SEQ + t) * LDP + C_DSQ + h * 64;
#pragma unroll
        for (int d = 0; d < 64; ++d) q[d] = bf2f(qp[d]);
        for (int r = 0; r < 128; ++r) {
            const float* wp = w_uk + ((size_t)r * 6 + h) * 64;
            float a = 0.f;
#pragma unroll
            for (int d = 0; d < 64; ++d) a += q[d] * wp[d];
            ql[r * 64 + lane] = a * 0.125f;
        }
    }
    WAVE_SYNC();
    float o[128];
#pragma unroll
    for (int r = 0; r < 128; ++r) o[r] = 0.f;
    float m = -INFINITY, l = 0.f;
    const int tmax = chunk * 64 + 63, qt = t >> 5;
    for (int kt = 0; kt <= (tmax >> 5); ++kt) {
        unsigned w = 0u;
        if (kt <= qt) w = MASK[((((size_t)b * 64 + qt) * 64 + kt) * 32) + (t & 31)];
        for (int i = 0; i < 32; ++i) {
            const int hf = (i >> 2) & 1, a8 = i >> 3, c = i & 3, bit = 16 * hf + 4 * a8 + c;
            const bool sel = (w >> bit) & 1u;
            if (!__any(sel)) continue;
            const int s = kt * 32 + i;
            const bf16_t* cr = CKVN + ((size_t)b * SEQ + s) * 128;
            float lg = 0.f;
            for (int r = 0; r < 128; ++r) lg += ql[r * 64 + lane] * bf2f(cr[r]);
            int rel = t - s; rel = rel < 0 ? 0 : rel;
            const int bk = rel < 128 ? (int)T5TAB[rel] : 31;
            lg += rel_bias[bk * 6 + h];
            if (sel) {
                const float mn = fmaxf(m, lg), sc = expf(m - mn), p = expf(lg - mn);
                l = l * sc + p; m = mn;
#pragma unroll
                for (int r = 0; r < 128; ++r) o[r] = o[r] * sc + p * bf2f(cr[r]);
            }
        }
    }
    const float il = 1.f / l;
    WAVE_SYNC();
#pragma unroll
    for (int r = 0; r < 128; ++r) ql[r * 64 + lane] = o[r] * il;
    WAVE_SYNC();
    const bf16_t* gp = PROJ + ((size_t)b * SEQ + t) * LDP + C_DSG + h * 64;
    bf16_t* op = MIX + ((size_t)b * SEQ + t) * DM + 384 + h * 64;
    for (int d0 = 0; d0 < 64; d0 += 16) {
        float acc[16];
#pragma unroll
        for (int j = 0; j < 16; ++j) acc[j] = 0.f;
        for (int r = 0; r < 128; ++r) {
            const float ol = ql[r * 64 + lane];
            const float* wp = w_uv + ((size_t)r * 6 + h) * 64 + d0;
#pragma unroll
            for (int j = 0; j < 16; ++j) acc[j] += ol * wp[j];
        }
#pragma unroll
        for (int j = 0; j < 16; ++j) { const float g = bf2f(gp[d0 + j]); op[d0 + j] = (bf16_t)f2bf(acc[j] * (g / (1.f + expf(-g)))); }
    }
    WAVE_SYNC();
}

__device__ __forceinline__ void mem_naive_wave(const bf16_t* PROJ, const bf16_t* MEMKV  , bf16_t* MIX, int blk, int lane) {
    const int chunk = blk & 31, bh = blk >> 5, h = bh & 3, b = bh >> 2, t = chunk * 64 + lane;
    float q[64], o[64];
    const bf16_t* qp = PROJ + ((size_t)b * SEQ + t) * LDP + C_MQ + h * 64;
#pragma unroll
    for (int d = 0; d < 64; ++d) { q[d] = bf2f(qp[d]) * 0.125f; o[d] = 0.f; }
    float m = -INFINITY, l = 0.f;
    for (int s = 0; s < NMEM; ++s) {
        const bf16_t* kp = MEMKV + ((size_t)b * NMEM + s) * 1024 + h * 64;
        float z = 0.f;
#pragma unroll
        for (int d = 0; d < 64; ++d) z += q[d] * bf2f(kp[d]);
        const float mn = fmaxf(m, z), sc = expf(m - mn), p = expf(z - mn);
        l = l * sc + p; m = mn;
        const bf16_t* vp = kp + 256;
#pragma unroll
        for (int d = 0; d < 64; ++d) o[d] = o[d] * sc + p * bf2f(vp[d]);
    }
    const float il = 1.f / l;
    const bf16_t* gp = PROJ + ((size_t)b * SEQ + t) * LDP + C_MG + h * 64;
    bf16_t* op = MIX + ((size_t)b * SEQ + t) * DM + 768 + h * 64;
#pragma unroll
    for (int d = 0; d < 64; ++d) { const float g = bf2f(gp[d]); op[d] = (bf16_t)f2bf(o[d] * il * (g / (1.f + expf(-g)))); }
}

__device__ __forceinline__ void post_row(const float* xin, const bf16_t* Y, const float* g, float* xout, bf16_t* Hn, int row, int lane) {
    const bf16_t* yp = Y + (size_t)row * DM;
    float yv[16]; float s = 0.f;
#pragma unroll
    for (int j = 0; j < 4; ++j) {
        const v2u v = *(const v2u*)(yp + (lane + 64 * j) * 4);
        yv[4 * j + 0] = __uint_as_float(v.x << 16); yv[4 * j + 1] = __uint_as_float(v.x & 0xffff0000u);
        yv[4 * j + 2] = __uint_as_float(v.y << 16); yv[4 * j + 3] = __uint_as_float(v.y & 0xffff0000u);
        s += yv[4 * j] * yv[4 * j] + yv[4 * j + 1] * yv[4 * j + 1] + yv[4 * j + 2] * yv[4 * j + 2] + yv[4 * j + 3] * yv[4 * j + 3];
    }
    const float r = 1.0f / sqrtf(wave_sum(s) * (1.0f / DM) + EPS);
    f32x4 ov[4]; float s2 = 0.f;
#pragma unroll
    for (int j = 0; j < 4; ++j) {
        const int c = (lane + 64 * j) * 4;
        const f32x4 xv = *(const f32x4*)(xin + (size_t)row * DM + c);
        const f32x4 gv = *(const f32x4*)(g + c);
        ov[j].x = xv.x + yv[4 * j] * r * gv.x; ov[j].y = xv.y + yv[4 * j + 1] * r * gv.y; ov[j].z = xv.z + yv[4 * j + 2] * r * gv.z; ov[j].w = xv.w + yv[4 * j + 3] * r * gv.w;
        *(f32x4*)(xout + (size_t)row * DM + c) = ov[j];
        s2 += (ov[j].x * ov[j].x + ov[j].y * ov[j].y) + (ov[j].z * ov[j].z + ov[j].w * ov[j].w);
    }
    if (Hn) {
        const float r2 = 1.0f / sqrtf(wave_sum(s2) * (1.f / DM) + EPS);
        v2u* o8 = (v2u*)(Hn + (size_t)row * DM) + lane;
#pragma unroll
        for (int j = 0; j < 4; ++j) { v2u w; w.x = pk2(ov[j].x * r2, ov[j].y * r2); w.y = pk2(ov[j].z * r2, ov[j].w * r2); o8[64 * j] = w; }
    }
}

typedef short bf16x8 __attribute__((ext_vector_type(8)));
typedef short s16x4 __attribute__((ext_vector_type(4)));
typedef float f32x16 __attribute__((ext_vector_type(16)));
typedef float f32x2_t __attribute__((ext_vector_type(2)));
typedef __bf16 bf16x2_t __attribute__((ext_vector_type(2)));
#define MFMA32(a, b, c) __builtin_amdgcn_mfma_f32_32x32x16_bf16((a), (b), (c), 0, 0, 0)
__device__ __forceinline__ unsigned cvtpk(float lo, float hi) { f32x2_t v = {lo, hi}; bf16x2_t b = __builtin_convertvector(v, bf16x2_t); return __builtin_bit_cast(unsigned, b); }
__device__ __forceinline__ s16x4 vtr(const LAS unsigned char* p) { return __builtin_bit_cast(s16x4, __builtin_amdgcn_ds_read_tr16_b64_v4i16((LAS s16x4*)p)); }
__device__ __forceinline__ int crow(int r, int hi) { return (r & 3) + 8 * (r >> 2) + 4 * hi; }
__device__ __forceinline__ bf16x8 pack8(const f32x16& x, int s) {
    v4u p; p.x = cvtpk(x[8 * s + 0], x[8 * s + 1]); p.y = cvtpk(x[8 * s + 2], x[8 * s + 3]); p.z = cvtpk(x[8 * s + 4], x[8 * s + 5]); p.w = cvtpk(x[8 * s + 6], x[8 * s + 7]);
    return __builtin_bit_cast(bf16x8, p);
}
__device__ __forceinline__ bf16x8 cat44(s16x4 lo, s16x4 hi) { return __builtin_shufflevector(lo, hi, 0, 1, 2, 3, 4, 5, 6, 7); }
constexpr int VT_PITCH = 192;
constexpr float LOG2E = 1.4426950408889634f;

__device__ __forceinline__ void pv_tile(f32x16 (&O)[2], const LAS unsigned char* vrd, bf16x8 p0, bf16x8 p1) {
#pragma unroll
    for (int c = 0; c < 2; ++c) {
        const bf16x8 a0 = cat44(vtr(vrd + 0 * VT_PITCH + 64 * c), vtr(vrd + 8 * VT_PITCH + 64 * c));
        const bf16x8 a1 = cat44(vtr(vrd + 16 * VT_PITCH + 64 * c), vtr(vrd + 24 * VT_PITCH + 64 * c));
        O[c] = MFMA32(a0, p0, O[c]);
        O[c] = MFMA32(a1, p1, O[c]);
    }
}
__device__ __forceinline__ void gate_store(const f32x16 (&O)[2], float scale, const bf16_t* grow, bf16_t* orow, int hi) {
#pragma unroll
    for (int c = 0; c < 2; ++c)
#pragma unroll
        for (int g = 0; g < 4; ++g) {
            const int d = 32 * c + 8 * g + 4 * hi;
            const v2u gv = *(const v2u*)(grow + d);
            float gt[4] = {__uint_as_float(gv.x << 16), __uint_as_float(gv.x & 0xffff0000u), __uint_as_float(gv.y << 16), __uint_as_float(gv.y & 0xffff0000u)};
            float ov[4];
#pragma unroll
            for (int j = 0; j < 4; ++j) ov[j] = O[c][4 * g + j] * scale * gt[j] * __builtin_amdgcn_rcpf(1.f + __builtin_amdgcn_exp2f(-gt[j] * LOG2E));
            v2u w; w.x = cvtpk(ov[0], ov[1]); w.y = cvtpk(ov[2], ov[3]);
            *(v2u*)(orow + d) = w;
        }
}

__device__ __forceinline__ void sb_item(const bf16_t* PROJ, bf16_t* MIX, int b, int h, int qt, int lane, LAS unsigned char* wl) {
    const int r32 = lane & 31, hi = lane >> 5;
    const bf16_t* base = PROJ + (size_t)b * SEQ * LDP;
    const int t = 32 * qt + r32;
    bf16x8 qf[4];
#pragma unroll
    for (int ks = 0; ks < 4; ++ks) qf[ks] = *(const bf16x8*)(base + (size_t)t * LDP + C_SBQ + h * 64 + 16 * ks + 8 * hi);
    const int vrow = lane >> 3, vch = lane & 7;
    LAS unsigned char* vwr = wl + vrow * VT_PITCH + vch * 16;
    const LAS unsigned char* vrd = wl + (4 * hi + ((lane & 15) >> 2)) * VT_PITCH + (16 * ((lane >> 4) & 1) + 4 * (lane & 3)) * 2;
    bf16x8 kc[4], vc[4];
    {
        const bf16_t* kp = base + (size_t)(32 * qt + r32) * LDP + C_SBK + h * 64 + 8 * hi;
#pragma unroll
        for (int ks = 0; ks < 4; ++ks) kc[ks] = *(const bf16x8*)(kp + 16 * ks);
        const bf16_t* vp = base + (size_t)(32 * qt + vrow) * LDP + C_SBV + h * 64 + 8 * vch;
#pragma unroll
        for (int i = 0; i < 4; ++i) vc[i] = *(const bf16x8*)(vp + (size_t)(8 * i) * LDP);
    }
    f32x16 O[2];
#pragma unroll
    for (int r = 0; r < 16; ++r) { O[0][r] = 0.f; O[1][r] = 0.f; }
    float R = 1.f;
    for (int kt = qt; kt >= 0; --kt) {
        bf16x8 kn[4], vn[4];
        {
            const int ktn = kt > 0 ? kt - 1 : 0;
            const bf16_t* kp = base + (size_t)(32 * ktn + r32) * LDP + C_SBK + h * 64 + 8 * hi;
#pragma unroll
            for (int ks = 0; ks < 4; ++ks) kn[ks] = *(const bf16x8*)(kp + 16 * ks);
            const bf16_t* vp = base + (size_t)(32 * ktn + vrow) * LDP + C_SBV + h * 64 + 8 * vch;
#pragma unroll
            for (int i = 0; i < 4; ++i) vn[i] = *(const bf16x8*)(vp + (size_t)(8 * i) * LDP);
        }
        f32x16 acc;
#pragma unroll
        for (int r = 0; r < 16; ++r) acc[r] = 0.f;
#pragma unroll
        for (int ks = 0; ks < 4; ++ks) acc = MFMA32(kc[ks], qf[ks], acc);
#pragma unroll
        for (int i = 0; i < 4; ++i) *(LAS bf16x8*)(vwr + (8 * i) * VT_PITCH) = vc[i];
        float be[16], om[16];
        const bool diag = (kt == qt);
#pragma unroll
        for (int r = 0; r < 16; ++r) {
            const float e = __builtin_amdgcn_exp2f(fminf(acc[r] * (-0.125f * LOG2E), 115.f));
            float bt = __builtin_amdgcn_rcpf(1.f + e), o1 = e * bt;
            if (diag && !(crow(r, hi) < r32)) { bt = 0.f; o1 = 1.f; }
            be[r] = bt; om[r] = o1;
        }
        float Gp[4], Gq[4];
#pragma unroll
        for (int g = 0; g < 4; ++g) { Gp[g] = (om[4 * g] * om[4 * g + 1]) * (om[4 * g + 2] * om[4 * g + 3]); Gq[g] = __shfl_xor(Gp[g], 32); }
        const float T1 = Gp[1] * Gq[1], T2 = Gp[2] * Gq[2], T3 = Gp[3] * Gq[3], T0 = Gp[0] * Gq[0];
        float tail[4]; tail[3] = R; tail[2] = R * T3; tail[1] = tail[2] * T2; tail[0] = tail[1] * T1;
        const float Rn = tail[0] * T0;
#pragma unroll
        for (int g = 0; g < 4; ++g) {
            float sfx = tail[g] * (hi == 0 ? Gq[g] : 1.f);
            acc[4 * g + 3] = be[4 * g + 3] * sfx; sfx *= om[4 * g + 3];
            acc[4 * g + 2] = be[4 * g + 2] * sfx; sfx *= om[4 * g + 2];
            acc[4 * g + 1] = be[4 * g + 1] * sfx; sfx *= om[4 * g + 1];
            acc[4 * g + 0] = be[4 * g + 0] * sfx;
        }
        R = Rn;
        const bf16x8 p0 = pack8(acc, 0), p1 = pack8(acc, 1);
        pv_tile(O, vrd, p0, p1);
#pragma unroll
        for (int i = 0; i < 4; ++i) { kc[i] = kn[i]; vc[i] = vn[i]; }
    }
    gate_store(O, 1.f, base + (size_t)t * LDP + C_SBG + h * 64, MIX + ((size_t)b * SEQ + t) * DM + h * 64, hi);
}

__device__ __forceinline__ void mem_item(const bf16_t* PROJ, const bf16_t* KV, bf16_t* MIX, int b, int h, int qt, int lane, LAS unsigned char* wl) {
    const int r32 = lane & 31, hi = lane >> 5;
    const int t = 32 * qt + r32;
    const bf16_t* prow = PROJ + ((size_t)b * SEQ + t) * LDP;
    bf16x8 qf[4];
#pragma unroll
    for (int ks = 0; ks < 4; ++ks) qf[ks] = *(const bf16x8*)(prow + C_MQ + h * 64 + 16 * ks + 8 * hi);
    const int vrow = lane >> 3, vch = lane & 7;
    LAS unsigned char* vwr = wl + vrow * VT_PITCH + vch * 16;
    const LAS unsigned char* vrd = wl + (4 * hi + ((lane & 15) >> 2)) * VT_PITCH + (16 * ((lane >> 4) & 1) + 4 * (lane & 3)) * 2;
    const bf16_t* kvb = KV + (size_t)b * NMEM * 1024 + h * 64;
    f32x16 O[2];
#pragma unroll
    for (int r = 0; r < 16; ++r) { O[0][r] = 0.f; O[1][r] = 0.f; }
    float mrun = -INFINITY, lrun = 0.f;
    for (int kt = 0; kt < NMEM / 32; ++kt) {
        bf16x8 kc[4], vc[4];
        const bf16_t* kp = kvb + (size_t)(32 * kt + r32) * 1024 + 8 * hi;
#pragma unroll
        for (int ks = 0; ks < 4; ++ks) kc[ks] = *(const bf16x8*)(kp + 16 * ks);
        const bf16_t* vp = kvb + (size_t)(32 * kt + vrow) * 1024 + 256 + 8 * vch;
#pragma unroll
        for (int i = 0; i < 4; ++i) vc[i] = *(const bf16x8*)(vp + (size_t)(8 * i) * 1024);
        f32x16 acc;
#pragma unroll
        for (int r = 0; r < 16; ++r) acc[r] = 0.f;
#pragma unroll
        for (int ks = 0; ks < 4; ++ks) acc = MFMA32(kc[ks], qf[ks], acc);
#pragma unroll
        for (int i = 0; i < 4; ++i) *(LAS bf16x8*)(vwr + (8 * i) * VT_PITCH) = vc[i];
        float mx = acc[0];
#pragma unroll
        for (int r = 1; r < 16; ++r) mx = fmaxf(mx, acc[r]);
        mx *= 0.125f * LOG2E;
        mx = fmaxf(mx, __shfl_xor(mx, 32));
        const float mn = fmaxf(mrun, mx), alpha = __builtin_amdgcn_exp2f(mrun - mn);
        float ps = 0.f;
#pragma unroll
        for (int r = 0; r < 16; ++r) { acc[r] = __builtin_amdgcn_exp2f(acc[r] * (0.125f * LOG2E) - mn); ps += acc[r]; }
        lrun = lrun * alpha + ps; mrun = mn;
#pragma unroll
        for (int r = 0; r < 16; ++r) { O[0][r] *= alpha; O[1][r] *= alpha; }
        const bf16x8 p0 = pack8(acc, 0), p1 = pack8(acc, 1);
        pv_tile(O, vrd, p0, p1);
    }
    const float lt = lrun + __shfl_xor(lrun, 32);
    gate_store(O, 1.f / lt, prow + C_MG + h * 64, MIX + ((size_t)b * SEQ + t) * DM + 768 + h * 64, hi);
}

#ifndef MK_MULTI
#define MK_MULTI 0
#endif
constexpr int NPHASE = 11;
__global__ void __launch_bounds__(NWAVES * 64, 2) mk_fwd(Args args) {
    extern __shared__ __attribute__((aligned(16))) unsigned char lds_raw[];
    LAS unsigned char* lds = (LAS unsigned char*)lds_raw;
    const int tid0 = threadIdx.x;
    const int wave = __builtin_amdgcn_readfirstlane(tid0 >> 6);
    const int G = gridDim.x, bid = blockIdx.x;
    const int lo = args.ph_lo, hi = args.ph_hi;
#define IN(k) (lo <= (k) && (k) < hi)
#define SEAM(k) do { if (IN(k) && IN((k) + 1)) { cg::this_grid().sync(); } } while (0)
#define PH_BEGIN int lane = tid0 & 63; unsigned char* ws = args.ws; asm volatile("" : "+v"(lane), "+s"(ws)); \
    const int gw = bid * NWAVES + wave, NGW = G * NWAVES; (void)gw; (void)NGW; \
    const int vcu = (bid & 7) * (G >> 3) + (bid >> 3); const int bb = vcu >> 3, w64 = (vcu & 7) * 8 + wave; (void)bb; (void)w64;
#define P_WIN ((bf16_t*)(ws + WS_WIN))
#define P_WOUT ((bf16_t*)(ws + WS_WOUT))
#define P_WMEM ((bf16_t*)(ws + WS_WMEM))
#define P_MEMB ((bf16_t*)(ws + WS_MEMB))
#define P_MEMKV ((bf16_t*)(ws + WS_MEMKV))
#define P_CKVN ((bf16_t*)(ws + WS_CKVN))
#define P_MASK ((unsigned*)(ws + WS_MASK))
#define P_H ((bf16_t*)(ws + WS_H))
#define P_MIX ((bf16_t*)(ws + WS_MIX))
#define P_PROJ ((bf16_t*)(ws + WS_PROJ))
#define P_Y ((bf16_t*)(ws + WS_Y))

    if (IN(0)) {
        PH_BEGIN
        const float* x = args.in[0]; const float* mem = args.in[1]; const float* pre_g = args.in[2];
        const float* w_in = args.in[4]; const float* w_mem = args.in[8]; const float* w_out = args.in[9];
        LAS float* scr = (LAS float*)(lds + wave * 16384);
        constexpr int I_IN = 16 * (LDP / 32), I_OUT = 16 * 32, I_MEM = 16 * 16;
        constexpr int NITEMS = 2 * I_IN + 2 * I_OUT + 2 * I_MEM;
        for (int it = gw; it < NITEMS; it += NGW) {
            int r = it;
            if (r < 2 * I_IN) { const int l = r / I_IN; r -= l * I_IN; p0_transpose_item(w_in + (size_t)l * DM * NCOL, DM, NCOL, LDP, P_WIN + (size_t)l * LDP * DM, pre_g + l * DM, scr, r, lane); continue; }
            r -= 2 * I_IN;
            if (r < 2 * I_OUT) { const int l = r / I_OUT; r -= l * I_OUT; p0_transpose_item(w_out + (size_t)l * DM * DM, DM, DM, DM, P_WOUT + (size_t)l * DM * DM, nullptr, scr, r, lane); continue; }
            r -= 2 * I_OUT;
            { const int l = r / I_MEM; r -= l * I_MEM; p0_transpose_item(w_mem + (size_t)l * DM * 512, DM, 512, 512, P_WMEM + (size_t)l * 512 * DM, nullptr, scr, r, lane); }
        }
        for (int m = gw; m < NB * NMEM; m += NGW) row_to_bf16<false>(mem + (size_t)m * DM, P_MEMB + (size_t)m * DM, lane);
        for (int m = gw; m < NTOK; m += NGW) row_to_bf16<true>(x + (size_t)m * DM, P_H + (size_t)m * DM, lane);
    }
    SEAM(0);
#pragma unroll 1
    for (int l = 0; l < 2; ++l) {
        const int pb = 1 + 5 * l;
        if (IN(pb)) {
            PH_BEGIN
            { pg8::Gemm g{P_H, P_WIN + (size_t)l * LDP * DM, NTOK, LDP, DM}; pg8::StaticOrder S; S.init(NTOK, LDP, G, bid);
              pg8::EpiBf16<0> E{P_PROJ, LDP, nullptr, 0, 0, 1.f};
              pg8::gemm_phase<pg8::EpiBf16<0>, pg8::StaticOrder, true, true>(lds, g, S, E); }
            if (l == 0) {
              pg8::Gemm g{P_MEMB, P_WMEM, NB * NMEM, 1024, DM}; pg8::StaticOrder S; S.init(NB * NMEM, 1024, G, bid);
              pg8::EpiBf16<0> E{P_MEMKV, 1024, nullptr, 0, 0, 1.f};
              pg8::gemm_phase<pg8::EpiBf16<0>, pg8::StaticOrder, true, true>(lds, g, S, E); }
        }
        SEAM(pb);
        if (IN(pb + 1)) {
            { PH_BEGIN
              const float* kv_g = args.in[7];
              for (int m = gw; m < NTOK; m += NGW) ckvnorm_wave(P_PROJ, kv_g + l * 128, P_CKVN, m, lane); }
#ifndef SKIP_SB
            { PH_BEGIN
              for (int i = 0; i < 6; ++i) { const int qt = (i & 1) ? 63 - w64 : w64; sb_item(P_PROJ, P_MIX, bb, i, qt, lane, lds + wave * 16384); } }
#endif
#ifndef SKIP_SEL
            { PH_BEGIN
              for (int vb = gw; vb < NTOK; vb += NGW) sel_naive_wave(P_PROJ, P_MASK, vb, lane, lds + wave * 16384); }
#endif
#ifndef SKIP_MEM
            { PH_BEGIN
              for (int i = 0; i < 4; ++i) mem_item(P_PROJ, P_MEMKV + l * 512, P_MIX, bb, i, w64, lane, lds + wave * 16384); }
#endif
        }
        SEAM(pb + 1);
        if (IN(pb + 2)) {
#ifndef SKIP_DSA
            PH_BEGIN
            const float* w_uk = args.in[5]; const float* w_uv = args.in[6]; const float* rel_bias = args.in[10];
            if (wave < 4) for (int vb = bid * 4 + wave; vb < NB * 6 * 32; vb += G * 4)
                dsa_naive_wave(P_PROJ, P_CKVN, P_MASK, w_uk + (size_t)l * 128 * 384, w_uv + (size_t)l * 128 * 384, rel_bias, P_MIX, vb, lane, (LAS float*)(lds + wave * 32768));
#endif
        }
        SEAM(pb + 2);
        if (IN(pb + 3)) {
            PH_BEGIN
            __syncthreads();
            pg8::Gemm g{P_MIX, P_WOUT + (size_t)l * DM * DM, NTOK, DM, DM}; pg8::StaticOrder S; S.init(NTOK, DM, G, bid);
            pg8::EpiBf16<0> E{P_Y, DM, nullptr, 0, 0, 1.f};
            pg8::gemm_phase<pg8::EpiBf16<0>, pg8::StaticOrder, true, true>(lds, g, S, E);
        }
        SEAM(pb + 3);
        if (IN(pb + 4)) {
            PH_BEGIN
            const float* xin = (l == 0) ? args.in[0] : args.out; const float* post_g = args.in[3];
            for (int m = gw; m < NTOK; m += NGW) post_row(xin, P_Y, post_g + l * DM, args.out, (l == 0) ? P_H : (bf16_t*)nullptr, m, lane);
        }
        SEAM(pb + 4);
    }
#undef IN
#undef SEAM
}

extern "C" void kernel_launch(void* const* d_in, const int* in_sizes, int n_in, void* d_out, int out_size, void* d_ws, size_t ws_size, hipStream_t stream) {
    static int grid = 0;
    if (grid == 0) {
        if (n_in != 11 || ws_size < WS_END) { fprintf(stderr, "kernel_launch: unexpected n_in %d / ws_size %zu\n", n_in, ws_size); grid = -1; return; }
        int dev = 0, cus = 0, per_cu = 0;
        hipGetDevice(&dev);
        hipDeviceGetAttribute(&cus, hipDeviceAttributeMultiprocessorCount, dev);
        hipFuncSetAttribute((const void*)mk_fwd, hipFuncAttributeMaxDynamicSharedMemorySize, LDS_BYTES);
        hipOccupancyMaxActiveBlocksPerMultiprocessor(&per_cu, (const void*)mk_fwd, NWAVES * 64, LDS_BYTES);
        if (per_cu < 1) { fprintf(stderr, "kernel_launch: occupancy query says %d blocks per CU\n", per_cu); per_cu = 1; }
        grid = cus * 1;
        (void)hipGetLastError();
    }
    if (grid < 0) return;
    Args a{};
    for (int i = 0; i < 11; ++i) a.in[i] = (const float*)d_in[i];
    a.out = (float*)d_out; a.ws = (unsigned char*)d_ws;
#if MK_MULTI
    for (int p = 0; p < NPHASE; ++p) { a.ph_lo = p; a.ph_hi = p + 1; hipLaunchKernelGGL(mk_fwd, dim3(grid), dim3(NWAVES * 64), LDS_BYTES, stream, a); }
#else
    a.ph_lo = 0; a.ph_hi = NPHASE;
    void* kargs[] = {&a};
    hipError_t e = hipLaunchCooperativeKernel((const void*)mk_fwd, dim3(grid), dim3(NWAVES * 64), kargs, LDS_BYTES, stream);
    if (e != hipSuccess) fprintf(stderr, "cooperative launch failed: %s (grid %d)\n", hipGetErrorString(e), grid);
#endif
}
```

```cpp
#include <hip/hip_runtime.h>
#include <hip/hip_cooperative_groups.h>
#include <stdint.h>
#include <math.h>
#include <cstdio>
namespace cg = cooperative_groups;
__device__ __forceinline__ int lane_id_v() { int l; asm volatile("v_mbcnt_lo_u32_b32 %0, -1, 0\n\tv_mbcnt_hi_u32_b32 %0, -1, %0" : "=v"(l)); return l; }
namespace pg8 {
#define PG8_LAS __attribute__((address_space(3)))
typedef unsigned short bf16_t;
typedef short bf16x8 __attribute__((ext_vector_type(8)));
typedef float f32x4 __attribute__((ext_vector_type(4)));
typedef unsigned u32x4 __attribute__((ext_vector_type(4)));
constexpr int BM = 256, BK = 64, HALF = 128, HTB = HALF * BK * 2  , STAGE_BYTES = 8 * HTB, NXCD = 8, WGM = 8;

__host__ __device__ __forceinline__ int lds_byte(int r, int c) { const int st = (r >> 4) * 2 + (c >> 5), rr = r & 15, cc = c & 31, ob = rr * 64 + cc * 2; return st * 1024 + (ob ^ (((ob >> 9) & 1) << 5)); }
__host__ __device__ __forceinline__ void stage_rc(int b, int& R, int& C) { const int st = b / 1024, sb = b % 1024, swz = sb ^ (((sb >> 9) & 1) << 5); R = (st >> 1) * 16 + swz / 64; C = (st & 1) * 32 + (swz % 64) / 2; }
__host__ __device__ __forceinline__ int perm32(int rho) { const int n = rho >> 4, i = rho & 15; return 8 * (i >> 2) + 4 * n + (i & 3); }

struct Unit { int pm, pn; };
struct Gemm { const bf16_t* A; const bf16_t* Bt; int M, N, K; };

struct StaticOrder {
    int nM, nN, nwg, G, c;
    __host__ __device__ void init(int M, int N, int G_, int c_) { nM = M / BM; nN = N / BM; nwg = nM * nN; G = G_; c = c_; }
    __host__ __device__ bool next(int i, Unit& u) const {
        const long L = (long)i * G + c; if (L >= nwg) return false;
        int wgid = (int)L; { const int q = nwg / NXCD, r = nwg % NXCD, xcd = wgid % NXCD, off = wgid / NXCD; wgid = (xcd < r ? xcd * (q + 1) : r * (q + 1) + (xcd - r) * q) + off; }
        const int nig = WGM * nN, gid = wgid / nig, fm = gid * WGM, gsz = (nM - fm) < WGM ? (nM - fm) : WGM;
        u.pm = fm + ((wgid % nig) % gsz); u.pn = (wgid % nig) / gsz; return true;
    }
    __device__ __forceinline__ void a_ready(const Unit&) const {}
    __device__ __forceinline__ void done(const Unit&) const {}
};

__device__ __forceinline__ unsigned cvt_pk_bf16(float lo, float hi) { unsigned r; asm volatile("v_cvt_pk_bf16_f32 %0, %1, %2" : "=v"(r) : "v"(lo), "v"(hi)); return r; }
typedef float f32x2 __attribute__((ext_vector_type(2)));
__device__ __forceinline__ f32x2 gelu_pk(f32x2 v) {
    const f32x2 av = __builtin_elementwise_abs(v), d = av * 0.2316418882f + 1.0f;
    f32x2 t; t.x = __builtin_amdgcn_rcpf(d.x); t.y = __builtin_amdgcn_rcpf(d.y);
    f32x2 q = t * 0.5307027145f + (-0.7265760135f); q = q * t + 0.7107068705f; q = q * t + (-0.142248368f); q = q * t + 0.127414796f; q = q * t;
    const f32x2 s = (v * v) * (-0.72134752044f);
    f32x2 e; e.x = __builtin_amdgcn_exp2f(s.x); e.y = __builtin_amdgcn_exp2f(s.y);
    const f32x2 m = v * (q * e), r = v - m;
    f32x2 o; o.x = v.x < 0.f ? m.x : r.x; o.y = v.y < 0.f ? m.y : r.y; return o;
}

template <int ACT  > struct EpiBf16 {
    static constexpr bool PERM = true, AFTER_DRAIN = false; static_assert(ACT == 0 || ACT == 1, "EpiBf16: ACT is 0 (none) or 1 (gelu_pk)");
    bf16_t* O; int ldc; const float* bias; int split_cols; size_t split_stride; float scale0;
    __device__ __forceinline__ void operator()(const f32x4 (&acc)[2][2][4][2], const Unit& u, int wr, int wc, int fr, int fq) const {
        const int row0 = u.pm * BM + wr * 64 + fr; int colt = u.pn * BM; bf16_t* base = O;
        float sc = 1.f; if (split_cols) { const int t = colt / split_cols; base += (size_t)t * split_stride; colt -= t * split_cols; if (t == 0) sc = scale0; }
        const int col0 = colt + wc * 32 + 8 * fq, bcol0 = u.pn * BM + wc * 32 + 8 * fq;
        f32x4 bv[2][2];
#pragma unroll
        for (int bj = 0; bj < 2; ++bj)
#pragma unroll
            for (int n = 0; n < 2; ++n) bv[bj][n] = bias ? *(const f32x4*)(bias + bcol0 + bj * HALF + 4 * n) : (f32x4){0.f, 0.f, 0.f, 0.f};
#pragma unroll
        for (int ai = 0; ai < 2; ++ai)
#pragma unroll
            for (int m = 0; m < 4; ++m) { bf16_t* rowp = base + (size_t)(row0 + ai * HALF + m * 16) * ldc + col0;
#pragma unroll
                for (int bj = 0; bj < 2; ++bj) { f32x4 v0 = acc[ai][bj][m][0] + bv[bj][0], v1 = acc[ai][bj][m][1] + bv[bj][1];
                    if (ACT == 1) { f32x2 a = gelu_pk((f32x2){v0[0], v0[1]}), b = gelu_pk((f32x2){v0[2], v0[3]}), c = gelu_pk((f32x2){v1[0], v1[1]}), d = gelu_pk((f32x2){v1[2], v1[3]});
                        v0 = (f32x4){a.x, a.y, b.x, b.y}; v1 = (f32x4){c.x, c.y, d.x, d.y}; }
                    v0 = v0 * sc; v1 = v1 * sc; u32x4 w; w.x = cvt_pk_bf16(v0[0], v0[1]); w.y = cvt_pk_bf16(v0[2], v0[3]); w.z = cvt_pk_bf16(v1[0], v1[1]); w.w = cvt_pk_bf16(v1[2], v1[3]);
                    *(u32x4*)(rowp + bj * HALF) = w; } }
    }
};
template <class Epi, class Sched, bool ALIGN_EPI = false, bool SP2 = false>
__device__ __forceinline__ void gemm_phase(PG8_LAS unsigned char* lds, const Gemm g, const Sched& S, const Epi& E, int wave_id) {
    int tid_ = wave_id * 64 + lane_id_v();
    const int tid = tid_, wid = __builtin_amdgcn_readfirstlane(tid >> 6), lane = tid & 63, wr = wid >> 2, wc = wid & 3, fr = lane & 15, fq = lane >> 4;
    const int K = g.K, nt = K / BK;
    unsigned voffA[2], voffB[2];
#pragma unroll
    for (int i = 0; i < 2; ++i) { int R, C; stage_rc(tid * 16 + i * 8192, R, C); const int Rb = Epi::PERM ? ((R & ~31) + perm32(R & 31)) : R;
        voffA[i] = (unsigned)(R * K + C) * 2u; voffB[i] = (unsigned)(Rb * K + C) * 2u; }
    const size_t kstep = (size_t)(BK * 2);
    const size_t hstep = (size_t)HALF * K * 2;
    const size_t tstep = 2 * hstep;
    const unsigned ldsw = (unsigned)wid * 1024u;
    const int aoff = lds_byte(wr * 64 + fr, fq * 8), boff = lds_byte(wc * 32 + fr, fq * 8);
#define PG8_SA(b, h) (((b) * 2 + (h)) * HTB)
#define PG8_SB(b, h) ((4 + (b) * 2 + (h)) * HTB)
#define PG8_STAGE(bufoff, gbase, voff) do { _Pragma("unroll") for (int _i = 0; _i < 2; ++_i) \
        __builtin_amdgcn_global_load_lds((const unsigned*)((const char*)(gbase) + (voff)[_i]), (PG8_LAS unsigned*)(lds + (bufoff) + ldsw + _i * 8192), 16, 0, 0); } while (0)
#define PG8_LDA(dst, b, h) do { _Pragma("unroll") for (int m = 0; m < 4; ++m) _Pragma("unroll") for (int k = 0; k < 2; ++k) dst[m][k] = *(const PG8_LAS bf16x8*)(lds + PG8_SA(b, h) + aoff + m * 2048 + k * 1024); } while (0)
#define PG8_LDB(dst, b, h) do { _Pragma("unroll") for (int n = 0; n < 2; ++n) _Pragma("unroll") for (int k = 0; k < 2; ++k) dst[n][k] = *(const PG8_LAS bf16x8*)(lds + PG8_SB(b, h) + boff + n * 2048 + k * 1024); } while (0)
#define PG8_MMA(ai, bj, At, Bt) do { __builtin_amdgcn_s_setprio(1); _Pragma("unroll") for (int m = 0; m < 4; ++m) _Pragma("unroll") for (int n = 0; n < 2; ++n) _Pragma("unroll") for (int k = 0; k < 2; ++k) \
        acc[ai][bj][m][n] = __builtin_amdgcn_mfma_f32_16x16x32_bf16(Bt[n][k], At[m][k], acc[ai][bj][m][n], 0, 0, 0); __builtin_amdgcn_s_setprio(0); } while (0)
#define PG8_WAIT_V(n) asm volatile("s_waitcnt vmcnt(" #n ")" ::: "memory")
#define PG8_WAIT_L(n) asm volatile("s_waitcnt lgkmcnt(" #n ")" ::: "memory")
#define PG8_BAR __builtin_amdgcn_s_barrier()
#define PG8_SCHED __builtin_amdgcn_sched_barrier(0)
    Unit cur, nxt; int ui = 0;
    if (!S.next(0, cur)) return;
    f32x4 acc[2][2][4][2];
#pragma unroll
    for (int a = 0; a < 2; ++a)
#pragma unroll
        for (int b = 0; b < 2; ++b)
#pragma unroll
            for (int m = 0; m < 4; ++m)
#pragma unroll
                for (int n = 0; n < 2; ++n) acc[a][b][m][n] = (f32x4){0.f, 0.f, 0.f, 0.f};
    bf16x8 At[4][2], B0[2][2], B1[2][2];
    const char* cA = (const char*)g.A + (size_t)cur.pm * tstep; const char* cB = (const char*)g.Bt + (size_t)cur.pn * tstep;
    S.a_ready(cur);
    if constexpr (SP2) {
        PG8_STAGE(PG8_SB(0, 0), cB, voffB); PG8_STAGE(PG8_SB(0, 1), cB + hstep, voffB); PG8_STAGE(PG8_SA(0, 0), cA, voffA); PG8_STAGE(PG8_SA(0, 1), cA + hstep, voffA);
        if (wr == 1) PG8_BAR;
        PG8_WAIT_V(2); PG8_BAR;
        PG8_STAGE(PG8_SB(1, 0), cB + kstep, voffB); PG8_STAGE(PG8_SA(1, 0), cA + kstep, voffA); PG8_STAGE(PG8_SB(1, 1), cB + hstep + kstep, voffB);
        PG8_WAIT_V(6); PG8_BAR;
    } else {
        PG8_STAGE(PG8_SB(0, 0), cB, voffB); PG8_STAGE(PG8_SA(0, 0), cA, voffA); PG8_STAGE(PG8_SB(0, 1), cB + hstep, voffB); PG8_STAGE(PG8_SA(0, 1), cA + hstep, voffA);
        if (wr == 1) PG8_BAR;
        PG8_WAIT_V(4); PG8_BAR;
        PG8_STAGE(PG8_SB(1, 0), cB + kstep, voffB); PG8_STAGE(PG8_SA(1, 0), cA + kstep, voffA); PG8_STAGE(PG8_SB(1, 1), cB + hstep + kstep, voffB);
        PG8_WAIT_V(6); PG8_BAR;
    }
    for (;;) {
        const bool has_next = S.next(ui + 1, nxt);
        const char* nA = has_next ? (const char*)g.A + (size_t)nxt.pm * tstep : cA; const char* nB = has_next ? (const char*)g.Bt + (size_t)nxt.pn * tstep : cB;
        for (int t = 0; t < nt; t += 2) {
            const bool last = (t == nt - 2);
            const char* a1 = cA + (size_t)(t + 1) * kstep;
            const char* a2 = last ? nA : cA + (size_t)(t + 2) * kstep; const char* b2 = last ? nB : cB + (size_t)(t + 2) * kstep;
            const char* a3 = a2 + kstep; const char* b3 = b2 + kstep;
            if (last && has_next) S.a_ready(nxt);
            if constexpr (SP2) {
            PG8_LDB(B0, 0, 0); PG8_LDB(B1, 0, 1); PG8_SCHED; PG8_LDA(At, 0, 0); PG8_STAGE(PG8_SA(1, 1), a1 + hstep, voffA);
            PG8_WAIT_V(8); PG8_WAIT_L(0); PG8_BAR; PG8_MMA(0, 0, At, B0); PG8_MMA(0, 1, At, B1); PG8_BAR; PG8_SCHED;
            PG8_LDA(At, 0, 1); PG8_STAGE(PG8_SB(0, 0), b2, voffB); PG8_STAGE(PG8_SB(0, 1), b2 + hstep, voffB); PG8_STAGE(PG8_SA(0, 0), a2, voffA);
            PG8_WAIT_V(8); PG8_WAIT_L(0); PG8_BAR; PG8_MMA(1, 0, At, B0); PG8_MMA(1, 1, At, B1); PG8_BAR; PG8_SCHED;
            PG8_LDB(B0, 1, 0); PG8_LDB(B1, 1, 1); PG8_SCHED; PG8_LDA(At, 1, 0); PG8_STAGE(PG8_SA(0, 1), a2 + hstep, voffA);
            PG8_WAIT_V(8); PG8_WAIT_L(0); PG8_BAR; PG8_MMA(0, 0, At, B0); PG8_MMA(0, 1, At, B1); PG8_BAR; PG8_SCHED;
            PG8_LDA(At, 1, 1); PG8_STAGE(PG8_SB(1, 0), b3, voffB); PG8_STAGE(PG8_SB(1, 1), b3 + hstep, voffB); PG8_STAGE(PG8_SA(1, 0), a3, voffA);
            PG8_WAIT_V(8); PG8_WAIT_L(0); PG8_BAR; PG8_MMA(1, 0, At, B0); PG8_MMA(1, 1, At, B1); PG8_BAR; PG8_SCHED;
            } else {
            PG8_LDB(B0, 0, 0); PG8_SCHED; PG8_LDA(At, 0, 0); PG8_STAGE(PG8_SA(1, 1), a1 + hstep, voffA);
            PG8_WAIT_L(8); PG8_BAR; PG8_WAIT_L(0); PG8_MMA(0, 0, At, B0); PG8_BAR; PG8_SCHED;
            PG8_LDB(B1, 0, 1); PG8_STAGE(PG8_SB(0, 0), b2, voffB);
            PG8_BAR; PG8_WAIT_L(0); PG8_MMA(0, 1, At, B1); PG8_BAR;
            PG8_LDA(At, 0, 1); PG8_STAGE(PG8_SA(0, 0), a2, voffA);
            PG8_BAR; PG8_WAIT_L(0); PG8_MMA(1, 0, At, B0); PG8_BAR; PG8_SCHED;
            PG8_STAGE(PG8_SB(0, 1), b2 + hstep, voffB);
            PG8_WAIT_V(6); PG8_BAR; PG8_MMA(1, 1, At, B1); PG8_BAR;
            PG8_LDB(B0, 1, 0); PG8_SCHED; PG8_LDA(At, 1, 0); PG8_STAGE(PG8_SA(0, 1), a2 + hstep, voffA);
            PG8_WAIT_L(8); PG8_BAR; PG8_WAIT_L(0); PG8_MMA(0, 0, At, B0); PG8_BAR; PG8_SCHED;
            PG8_LDB(B1, 1, 1); PG8_STAGE(PG8_SB(1, 0), b3, voffB);
            PG8_BAR; PG8_WAIT_L(0); PG8_MMA(0, 1, At, B1); PG8_BAR;
            PG8_LDA(At, 1, 1); PG8_STAGE(PG8_SA(1, 0), a3, voffA);
            PG8_BAR; PG8_WAIT_L(0); PG8_MMA(1, 0, At, B0); PG8_BAR; PG8_SCHED;
            PG8_STAGE(PG8_SB(1, 1), b3 + hstep, voffB);
            PG8_WAIT_V(6); PG8_BAR; PG8_MMA(1, 1, At, B1); PG8_BAR;
            }
        }
        if constexpr (ALIGN_EPI) { if (wr == 0) PG8_BAR; }
        if constexpr (!Epi::AFTER_DRAIN) { E(acc, cur, wr, wc, fr, fq); S.done(cur); }
        if (!has_next) break;
#pragma unroll
        for (int a = 0; a < 2; ++a)
#pragma unroll
            for (int b = 0; b < 2; ++b)
#pragma unroll
                for (int m = 0; m < 4; ++m)
#pragma unroll
                    for (int n = 0; n < 2; ++n) acc[a][b][m][n] = (f32x4){0.f, 0.f, 0.f, 0.f};
        cur = nxt; cA = nA; cB = nB; ++ui;
        if constexpr (ALIGN_EPI) { if (wr == 1) PG8_BAR; }
    }
    PG8_WAIT_V(0);
    if constexpr (!ALIGN_EPI) { if (wr == 0) PG8_BAR; }
    PG8_BAR;
    if constexpr (Epi::AFTER_DRAIN) { E.fused(acc, cur, wr, wc, fr, fq, lds, wid, lane); S.done(cur); }
#undef PG8_SA
#undef PG8_SB
#undef PG8_STAGE
#undef PG8_LDA
#undef PG8_LDB
#undef PG8_MMA
#undef PG8_WAIT_V
#undef PG8_WAIT_L
#undef PG8_BAR
#undef PG8_SCHED
}
}
typedef unsigned short bf16_t;
#define LAS __attribute__((address_space(3)))
#define GAS __attribute__((address_space(1)))
typedef unsigned v4u __attribute__((ext_vector_type(4)));
typedef unsigned v2u __attribute__((ext_vector_type(2)));
typedef float f32x4 __attribute__((ext_vector_type(4)));
constexpr int DM = 1024, NB = 32, SEQ = 2048, NTOK = NB * SEQ, NMEM = 256;
constexpr int LDP = 3328;
constexpr int C_SBQ = 0, C_SBK = 384, C_SBV = 768, C_SBG = 1152, C_DSQ = 1536, C_CKV = 1920, C_DSG = 2048,
              C_IDQ = 2432, C_IDK = 2688, C_IDW = 2720, C_MQ = 2728, C_MG = 2984, NCOL = 3240;
constexpr float EPS = 1e-6f;
constexpr size_t MiB = 1u << 20;
constexpr size_t WS_CTL = 0;
constexpr size_t WS_WIN = 1 * MiB;
constexpr size_t WS_WOUT = 14 * MiB;
constexpr size_t WS_WMEM = 18 * MiB;
constexpr size_t WS_MEMB = 20 * MiB;
constexpr size_t WS_MEMKV = 36 * MiB;
constexpr size_t WS_CKVN = 52 * MiB;
constexpr size_t WS_MASK = 68 * MiB;
constexpr size_t WS_H = 84 * MiB;
constexpr size_t WS_MIX = WS_H;
constexpr size_t WS_PROJ = 212 * MiB;
constexpr size_t WS_Y = WS_PROJ;
constexpr size_t WS_END = 628 * MiB;
constexpr int LDS_BYTES = 135168;
constexpr int NWAVES = 8;

__device__ __forceinline__ float bf2f(bf16_t v) { return __uint_as_float(((unsigned)v) << 16); }
__device__ __forceinline__ unsigned f2bf(float f) { unsigned u = __float_as_uint(f); u += 0x7fffu + ((u >> 16) & 1u); return u >> 16; }
__device__ __forceinline__ unsigned pk2(float lo, float hi) { return f2bf(lo) | (f2bf(hi) << 16); }
#define WAVE_SYNC() do { asm volatile("s_waitcnt lgkmcnt(0)" ::: "memory"); __builtin_amdgcn_wave_barrier(); } while (0)
__device__ __forceinline__ float wave_sum(float v) {
#pragma unroll
    for (int o = 1; o < 64; o <<= 1) v += __shfl_xor(v, o);
    return v;
}

__device__ const unsigned char T5TAB[128] = {0, 1, 2, 3, 4, 5, 6, 7, 8, 9, 10, 11, 12, 13, 14, 15, 16, 16, 16, 17, 17, 18, 18, 18, 19, 19, 19, 20, 20, 20, 20, 21, 21, 21, 21, 22, 22, 22, 22, 22, 23, 23, 23, 23, 23, 23, 24, 24, 24, 24, 24, 24, 25, 25, 25, 25, 25, 25, 25, 26, 26, 26, 26, 26, 26, 26, 26, 27, 27, 27, 27, 27, 27, 27, 27, 27, 27, 28, 28, 28, 28, 28, 28, 28, 28, 28, 28, 29, 29, 29, 29, 29, 29, 29, 29, 29, 29, 29, 29, 30, 30, 30, 30, 30, 30, 30, 30, 30, 30, 30, 30, 30, 30, 31, 31, 31, 31, 31, 31, 31, 31, 31, 31, 31, 31, 31, 31, 31};

struct Args { const float* in[11]; float* out; unsigned char* ws; int ph_lo, ph_hi; };

__device__ __forceinline__ void p0_transpose_item(const float* W, int K, int N, int Npad, bf16_t* WT, const float* g, LAS float* scr, int item, int lane) {
    const int nblk = Npad / 32, kb = item / nblk, nb = item % nblk, k0 = 64 * kb, n0 = 32 * nb;
    const int nn = n0 + (lane & 31);
#pragma unroll 8
    for (int i = 0; i < 32; ++i) { const int kk = 2 * i + (lane >> 5); float v = (nn < N) ? W[(size_t)(k0 + kk) * N + nn] : 0.f; if (g) v *= g[k0 + kk]; scr[kk * 33 + (lane & 31)] = v; }
    WAVE_SYNC();
    const int c = lane & 7;
#pragma unroll
    for (int j = 0; j < 4; ++j) { const int n = (lane >> 3) + 8 * j; const LAS float* s = scr + (8 * c) * 33 + n;
        v4u o; o.x = pk2(s[0 * 33], s[1 * 33]); o.y = pk2(s[2 * 33], s[3 * 33]); o.z = pk2(s[4 * 33], s[5 * 33]); o.w = pk2(s[6 * 33], s[7 * 33]);
        *(v4u*)(WT + (size_t)(n0 + n) * K + k0 + 8 * c) = o; }
    WAVE_SYNC();
}
template <bool NORM> __device__ __forceinline__ void row_to_bf16(const float* xrow, bf16_t* orow, int lane) {
    const f32x4* xr = (const f32x4*)xrow + lane;
    f32x4 v[4]; float s = 0.f;
#pragma unroll
    for (int j = 0; j < 4; ++j) { v[j] = xr[64 * j]; s += (v[j].x * v[j].x + v[j].y * v[j].y) + (v[j].z * v[j].z + v[j].w * v[j].w); }
    float r = 1.f;
    if (NORM) r = 1.0f / sqrtf(wave_sum(s) * (1.f / DM) + EPS);
    v2u* o8 = (v2u*)orow + lane;
#pragma unroll
    for (int j = 0; j < 4; ++j) { v2u w; w.x = pk2(v[j].x * r, v[j].y * r); w.y = pk2(v[j].z * r, v[j].w * r); o8[64 * j] = w; }
}

__device__ __forceinline__ void ckvnorm_wave(const bf16_t* PROJ, const float* kvg, bf16_t* CKVN, int row, int lane) {
    const bf16_t* p = PROJ + (size_t)row * LDP + C_CKV;
    const float a = bf2f(p[lane]), b = bf2f(p[lane + 64]);
    const float s = wave_sum(a * a + b * b);
    const float r = 1.0f / sqrtf(s * (1.0f / 128.f) + EPS);
    CKVN[(size_t)row * 128 + lane] = (bf16_t)f2bf(a * r * kvg[lane]);
    CKVN[(size_t)row * 128 + lane + 64] = (bf16_t)f2bf(b * r * kvg[lane + 64]);
}

__device__ __forceinline__ void sb_naive_wave(const bf16_t* PROJ, bf16_t* MIX, int blk, int lane) {
    const int chunk = blk & 31, bh = blk >> 5, h = bh % 6, b = bh / 6, t = chunk * 64 + lane;
    const bf16_t* base = PROJ + (size_t)b * SEQ * LDP;
    float q[64], o[64];
    {
        const bf16_t* qp = base + (size_t)t * LDP + C_SBQ + h * 64;
#pragma unroll
        for (int d = 0; d < 64; ++d) { q[d] = bf2f(qp[d]) * 0.125f; o[d] = 0.f; }
    }
    float L = 0.f;
    const int tmax = chunk * 64 + 63;
    for (int s = tmax - 1; s >= 0; --s) {
        const bf16_t* kp = base + (size_t)s * LDP + C_SBK + h * 64;
        float z = 0.f;
#pragma unroll
        for (int d = 0; d < 64; ++d) z += q[d] * bf2f(kp[d]);
        const bool act = s < t;
        const float sp = fmaxf(z, 0.f) + log1pf(expf(-fabsf(z)));
        const float a = act ? expf((z - sp) + L) : 0.f;
        if (act) L -= sp;
        const bf16_t* vp = base + (size_t)s * LDP + C_SBV + h * 64;
#pragma unroll
        for (int d = 0; d < 64; ++d) o[d] += a * bf2f(vp[d]);
    }
    const bf16_t* gp = base + (size_t)t * LDP + C_SBG + h * 64;
    bf16_t* op = MIX + ((size_t)b * SEQ + t) * DM + h * 64;
#pragma unroll
    for (int d = 0; d < 64; ++d) { const float g = bf2f(gp[d]); op[d] = (bf16_t)f2bf(o[d] * (g / (1.f + expf(-g)))); }
}

__device__ __forceinline__ unsigned ordkey(float f) { unsigned u = __float_as_uint(f); return (u & 0x80000000u) ? ~u : (u | 0x80000000u); }
__device__ __forceinline__ void sel_naive_wave(const bf16_t* PROJ, unsigned* MASK, int gq, int lane, LAS unsigned char* wl) {
    LAS float* iq = (LAS float*)wl; LAS float* iw = (LAS float*)(wl + 1024); LAS unsigned long long* bal = (LAS unsigned long long*)(wl + 1280); LAS unsigned* scl = (LAS unsigned*)(wl + 2048);
    const int b = gq >> 11, t = gq & 2047;
    const bf16_t* row = PROJ + ((size_t)b * SEQ + t) * LDP;
    for (int i = lane; i < 256; i += 64) iq[i] = bf2f(row[C_IDQ + i]);
    if (lane < 8) iw[lane] = bf2f(row[C_IDW + lane]) * 0.0625f;
    WAVE_SYNC();
    for (int j = 0; j < 32; ++j) {
        unsigned kv = 0u;
        if (j * 64 <= t) {
            const int s = j * 64 + lane;
            const bf16_t* kr = PROJ + ((size_t)b * SEQ + s) * LDP + C_IDK;
            float kd[32];
#pragma unroll
            for (int d = 0; d < 32; ++d) kd[d] = bf2f(kr[d]);
            float acc = 0.f;
            unsigned iqo = 0; asm volatile("" : "+v"(iqo));
            const LAS float* iqj = iq + iqo;
#pragma unroll 1
            for (int hh = 0; hh < 8; ++hh) {
                float dt = 0.f;
#pragma unroll
                for (int d = 0; d < 32; ++d) dt += iqj[hh * 32 + d] * kd[d];
                acc += iw[hh] * fmaxf(dt, 0.f);
            }
            kv = (s <= t) ? ordkey(acc) : 0u;
        }
        scl[j * 64 + lane] = kv;
    }
    WAVE_SYNC();
    unsigned key[32];
#pragma unroll
    for (int j = 0; j < 32; ++j) key[j] = scl[j * 64 + lane];
    const bool need_sel = (t + 1) > 256;
    unsigned tau = 0u; int need = 0;
    if (need_sel) {
        unsigned prefix = 0u;
        for (int bit = 31; bit >= 0; --bit) {
            const unsigned cand = prefix | (1u << bit);
            int cnt = 0;
#pragma unroll
            for (int j = 0; j < 32; ++j) cnt += __popcll(__ballot(key[j] >= cand));
            if (cnt >= 256) prefix = cand;
        }
        tau = prefix;
        int cgt = 0;
#pragma unroll
        for (int j = 0; j < 32; ++j) cgt += __popcll(__ballot(key[j] > tau));
        need = 256 - cgt;
    }
    int tiesbefore = 0;
    const unsigned long long lt_mask = (lane == 0) ? 0ull : (~0ull >> (64 - lane));
#pragma unroll
    for (int j = 0; j < 32; ++j) {
        bool sel;
        if (!need_sel) sel = (j * 64 + lane) <= t;
        else {
            const bool gt = key[j] > tau, eq = key[j] == tau;
            const unsigned long long be = __ballot(eq);
            const int rank = tiesbefore + __popcll(be & lt_mask);
            sel = gt || (eq && rank < need);
            tiesbefore += __popcll(be);
        }
        const unsigned long long bs = __ballot(sel);
        if (lane == 0) bal[j] = bs;
    }
    WAVE_SYNC();
    {
        const int kt = lane;
        const unsigned long long bb = bal[kt >> 1];
        const unsigned nat = (unsigned)(bb >> (32 * (kt & 1)));
        unsigned w = 0u;
#pragma unroll
        for (int n = 0; n < 8; ++n) { const unsigned nib = (nat >> (4 * n)) & 0xfu; const int on = 4 * (n & 1) + (n >> 1); w |= nib << (4 * on); }
        MASK[((((size_t)b * 64 + (t >> 5)) * 64 + kt) * 32) + (t & 31)] = w;
    }
    WAVE_SYNC();
}

__device__ __forceinline__ void dsa_naive_wave(const bf16_t* PROJ, const bf16_t* CKVN, const unsigned* MASK, const float* w_uk, const float* w_uv,
                                               const float* rel_bias, bf16_t* MIX, int blk, int lane, LAS float* ql) {
    const int chunk = blk & 31, bh = blk >> 5, h = bh % 6, b = bh / 6, t = chunk * 64 + lane;
    {
        float q[64];
        const bf16_t* qp = PROJ + ((size_t)b * SEQ + t) * LDP + C_DSQ + h * 64;
#pragma unroll
        for (int d = 0; d < 64; ++d) q[d] = bf2f(qp[d]);
        for (int r = 0; r < 128; ++r) {
            const float* wp = w_uk + ((size_t)r * 6 + h) * 64;
            float a = 0.f;
#pragma unroll
            for (int d = 0; d < 64; ++d) a += q[d] * wp[d];
            ql[r * 64 + lane] = a * 0.125f;
        }
    }
    WAVE_SYNC();
    float o[128];
#pragma unroll
    for (int r = 0; r < 128; ++r) o[r] = 0.f;
    float m = -INFINITY, l = 0.f;
    const int tmax = chunk * 64 + 63, qt = t >> 5;
    for (int kt = 0; kt <= (tmax >> 5); ++kt) {
        unsigned w = 0u;
        if (kt <= qt) w = MASK[((((size_t)b * 64 + qt) * 64 + kt) * 32) + (t & 31)];
        for (int i = 0; i < 32; ++i) {
            const int hf = (i >> 2) & 1, a8 = i >> 3, c = i & 3, bit = 16 * hf + 4 * a8 + c;
            const bool sel = (w >> bit) & 1u;
            if (!__any(sel)) continue;
            const int s = kt * 32 + i;
            const bf16_t* cr = CKVN + ((size_t)b * SEQ + s) * 128;
            float lg = 0.f;
            for (int r = 0; r < 128; ++r) lg += ql[r * 64 + lane] * bf2f(cr[r]);
            int rel = t - s; rel = rel < 0 ? 0 : rel;
            const int bk = rel < 128 ? (int)T5TAB[rel] : 31;
            lg += rel_bias[bk * 6 + h];
            if (sel) {
                const float mn = fmaxf(m, lg), sc = expf(m - mn), p = expf(lg - mn);
                l = l * sc + p; m = mn;
#pragma unroll
                for (int r = 0; r < 128; ++r) o[r] = o[r] * sc + p * bf2f(cr[r]);
            }
        }
    }
    const float il = 1.f / l;
    WAVE_SYNC();
#pragma unroll
    for (int r = 0; r < 128; ++r) ql[r * 64 + lane] = o[r] * il;
    WAVE_SYNC();
    const bf16_t* gp = PROJ + ((size_t)b * SEQ + t) * LDP + C_DSG + h * 64;
    bf16_t* op = MIX + ((size_t)b * SEQ + t) * DM + 384 + h * 64;
    for (int d0 = 0; d0 < 64; d0 += 16) {
        float acc[16];
#pragma unroll
        for (int j = 0; j < 16; ++j) acc[j] = 0.f;
        for (int r = 0; r < 128; ++r) {
            const float ol = ql[r * 64 + lane];
            const float* wp = w_uv + ((size_t)r * 6 + h) * 64 + d0;
#pragma unroll
            for (int j = 0; j < 16; ++j) acc[j] += ol * wp[j];
        }
#pragma unroll
        for (int j = 0; j < 16; ++j) { const float g = bf2f(gp[d0 + j]); op[d0 + j] = (bf16_t)f2bf(acc[j] * (g / (1.f + expf(-g)))); }
    }
    WAVE_SYNC();
}

__device__ __forceinline__ void mem_naive_wave(const bf16_t* PROJ, const bf16_t* MEMKV  , bf16_t* MIX, int blk, int lane) {
    const int chunk = blk & 31, bh = blk >> 5, h = bh & 3, b = bh >> 2, t = chunk * 64 + lane;
    float q[64], o[64];
    const bf16_t* qp = PROJ + ((size_t)b * SEQ + t) * LDP + C_MQ + h * 64;
#pragma unroll
    for (int d = 0; d < 64; ++d) { q[d] = bf2f(qp[d]) * 0.125f; o[d] = 0.f; }
    float m = -INFINITY, l = 0.f;
    for (int s = 0; s < NMEM; ++s) {
        const bf16_t* kp = MEMKV + ((size_t)b * NMEM + s) * 1024 + h * 64;
        float z = 0.f;
#pragma unroll
        for (int d = 0; d < 64; ++d) z += q[d] * bf2f(kp[d]);
        const float mn = fmaxf(m, z), sc = expf(m - mn), p = expf(z - mn);
        l = l * sc + p; m = mn;
        const bf16_t* vp = kp + 256;
#pragma unroll
        for (int d = 0; d < 64; ++d) o[d] = o[d] * sc + p * bf2f(vp[d]);
    }
    const float il = 1.f / l;
    const bf16_t* gp = PROJ + ((size_t)b * SEQ + t) * LDP + C_MG + h * 64;
    bf16_t* op = MIX + ((size_t)b * SEQ + t) * DM + 768 + h * 64;
#pragma unroll
    for (int d = 0; d < 64; ++d) { const float g = bf2f(gp[d]); op[d] = (bf16_t)f2bf(o[d] * il * (g / (1.f + expf(-g)))); }
}

__device__ __forceinline__ void post_row(const float* xin, const bf16_t* Y, const float* g, float* xout, bf16_t* Hn, int row, int lane) {
    const bf16_t* yp = Y + (size_t)row * DM;
    float yv[16]; float s = 0.f;
#pragma unroll
    for (int j = 0; j < 4; ++j) {
        const v2u v = *(const v2u*)(yp + (lane + 64 * j) * 4);
        yv[4 * j + 0] = __uint_as_float(v.x << 16); yv[4 * j + 1] = __uint_as_float(v.x & 0xffff0000u);
        yv[4 * j + 2] = __uint_as_float(v.y << 16); yv[4 * j + 3] = __uint_as_float(v.y & 0xffff0000u);
        s += yv[4 * j] * yv[4 * j] + yv[4 * j + 1] * yv[4 * j + 1] + yv[4 * j + 2] * yv[4 * j + 2] + yv[4 * j + 3] * yv[4 * j + 3];
    }
    const float r = 1.0f / sqrtf(wave_sum(s) * (1.0f / DM) + EPS);
    f32x4 ov[4]; float s2 = 0.f;
#pragma unroll
    for (int j = 0; j < 4; ++j) {
        const int c = (lane + 64 * j) * 4;
        const f32x4 xv = *(const f32x4*)(xin + (size_t)row * DM + c);
        const f32x4 gv = *(const f32x4*)(g + c);
        ov[j].x = xv.x + yv[4 * j] * r * gv.x; ov[j].y = xv.y + yv[4 * j + 1] * r * gv.y; ov[j].z = xv.z + yv[4 * j + 2] * r * gv.z; ov[j].w = xv.w + yv[4 * j + 3] * r * gv.w;
        *(f32x4*)(xout + (size_t)row * DM + c) = ov[j];
        s2 += (ov[j].x * ov[j].x + ov[j].y * ov[j].y) + (ov[j].z * ov[j].z + ov[j].w * ov[j].w);
    }
    if (Hn) {
        const float r2 = 1.0f / sqrtf(wave_sum(s2) * (1.f / DM) + EPS);
        v2u* o8 = (v2u*)(Hn + (size_t)row * DM) + lane;
#pragma unroll
        for (int j = 0; j < 4; ++j) { v2u w; w.x = pk2(ov[j].x * r2, ov[j].y * r2); w.y = pk2(ov[j].z * r2, ov[j].w * r2); o8[64 * j] = w; }
    }
}

typedef short bf16x8 __attribute__((ext_vector_type(8)));
typedef short s16x4 __attribute__((ext_vector_type(4)));
typedef float f32x16 __attribute__((ext_vector_type(16)));
typedef float f32x2_t __attribute__((ext_vector_type(2)));
typedef __bf16 bf16x2_t __attribute__((ext_vector_type(2)));
#define MFMA32(a, b, c) __builtin_amdgcn_mfma_f32_32x32x16_bf16((a), (b), (c), 0, 0, 0)
__device__ __forceinline__ unsigned cvtpk(float lo, float hi) { f32x2_t v = {lo, hi}; bf16x2_t b = __builtin_convertvector(v, bf16x2_t); return __builtin_bit_cast(unsigned, b); }
__device__ __forceinline__ s16x4 vtr(const LAS unsigned char* p) { return __builtin_bit_cast(s16x4, __builtin_amdgcn_ds_read_tr16_b64_v4i16((LAS s16x4*)p)); }
__device__ __forceinline__ int crow(int r, int hi) { return (r & 3) + 8 * (r >> 2) + 4 * hi; }
__device__ __forceinline__ bf16x8 pack8(const f32x16& x, int s) {
    v4u p; p.x = cvtpk(x[8 * s + 0], x[8 * s + 1]); p.y = cvtpk(x[8 * s + 2], x[8 * s + 3]); p.z = cvtpk(x[8 * s + 4], x[8 * s + 5]); p.w = cvtpk(x[8 * s + 6], x[8 * s + 7]);
    return __builtin_bit_cast(bf16x8, p);
}
__device__ __forceinline__ bf16x8 cat44(s16x4 lo, s16x4 hi) { return __builtin_shufflevector(lo, hi, 0, 1, 2, 3, 4, 5, 6, 7); }
constexpr int VT_PITCH = 192;
constexpr float LOG2E = 1.4426950408889634f;

__device__ __forceinline__ void pv_tile(f32x16 (&O)[2], const LAS unsigned char* vrd, bf16x8 p0, bf16x8 p1) {
#pragma unroll
    for (int c = 0; c < 2; ++c) {
        const bf16x8 a0 = cat44(vtr(vrd + 0 * VT_PITCH + 64 * c), vtr(vrd + 8 * VT_PITCH + 64 * c));
        const bf16x8 a1 = cat44(vtr(vrd + 16 * VT_PITCH + 64 * c), vtr(vrd + 24 * VT_PITCH + 64 * c));
        O[c] = MFMA32(a0, p0, O[c]);
        O[c] = MFMA32(a1, p1, O[c]);
    }
}
__device__ __forceinline__ void gate_store(const f32x16 (&O)[2], float scale, const bf16_t* grow, bf16_t* orow, int hi) {
#pragma unroll
    for (int c = 0; c < 2; ++c)
#pragma unroll
        for (int g = 0; g < 4; ++g) {
            const int d = 32 * c + 8 * g + 4 * hi;
            const v2u gv = *(const v2u*)(grow + d);
            float gt[4] = {__uint_as_float(gv.x << 16), __uint_as_float(gv.x & 0xffff0000u), __uint_as_float(gv.y << 16), __uint_as_float(gv.y & 0xffff0000u)};
            float ov[4];
#pragma unroll
            for (int j = 0; j < 4; ++j) ov[j] = O[c][4 * g + j] * scale * gt[j] * __builtin_amdgcn_rcpf(1.f + __builtin_amdgcn_exp2f(-gt[j] * LOG2E));
            v2u w; w.x = cvtpk(ov[0], ov[1]); w.y = cvtpk(ov[2], ov[3]);
            *(v2u*)(orow + d) = w;
        }
}

__device__ __forceinline__ void sb_item(const bf16_t* PROJ, bf16_t* MIX, int b, int h, int qt, int lane, LAS unsigned char* wl) {
    asm volatile("" : "+v"(lane));
    const int r32 = lane & 31, hi = lane >> 5;
    const bf16_t* base = PROJ + (size_t)b * SEQ * LDP;
    const int t = 32 * qt + r32;
    bf16x8 qf[4];
#pragma unroll
    for (int ks = 0; ks < 4; ++ks) qf[ks] = *(const bf16x8*)(base + (size_t)t * LDP + C_SBQ + h * 64 + 16 * ks + 8 * hi);
    const int vrow = lane >> 3, vch = lane & 7;
    LAS unsigned char* vwr = wl + vrow * VT_PITCH + vch * 16;
    const LAS unsigned char* vrd = wl + (4 * hi + ((lane & 15) >> 2)) * VT_PITCH + (16 * ((lane >> 4) & 1) + 4 * (lane & 3)) * 2;
    bf16x8 kc[4], vc[4];
    {
        const bf16_t* kp = base + (size_t)(32 * qt + r32) * LDP + C_SBK + h * 64 + 8 * hi;
#pragma unroll
        for (int ks = 0; ks < 4; ++ks) kc[ks] = *(const bf16x8*)(kp + 16 * ks);
        const bf16_t* vp = base + (size_t)(32 * qt + vrow) * LDP + C_SBV + h * 64 + 8 * vch;
#pragma unroll
        for (int i = 0; i < 4; ++i) vc[i] = *(const bf16x8*)(vp + (size_t)(8 * i) * LDP);
    }
    f32x16 O[2];
#pragma unroll
    for (int r = 0; r < 16; ++r) { O[0][r] = 0.f; O[1][r] = 0.f; }
    float R = 1.f;
    for (int kt = qt; kt >= 0; --kt) {
        bf16x8 kn[4], vn[4];
        {
            const int ktn = kt > 0 ? kt - 1 : 0;
            const bf16_t* kp = base + (size_t)(32 * ktn + r32) * LDP + C_SBK + h * 64 + 8 * hi;
#pragma unroll
            for (int ks = 0; ks < 4; ++ks) kn[ks] = *(const bf16x8*)(kp + 16 * ks);
            const bf16_t* vp = base + (size_t)(32 * ktn + vrow) * LDP + C_SBV + h * 64 + 8 * vch;
#pragma unroll
            for (int i = 0; i < 4; ++i) vn[i] = *(const bf16x8*)(vp + (size_t)(8 * i) * LDP);
        }
        f32x16 acc;
#pragma unroll
        for (int r = 0; r < 16; ++r) acc[r] = 0.f;
#pragma unroll
        for (int ks = 0; ks < 4; ++ks) acc = MFMA32(kc[ks], qf[ks], acc);
#pragma unroll
        for (int i = 0; i < 4; ++i) *(LAS bf16x8*)(vwr + (8 * i) * VT_PITCH) = vc[i];
        float be[16], om[16];
        const bool diag = (kt == qt);
#pragma unroll
        for (int r = 0; r < 16; ++r) {
            const float e = __builtin_amdgcn_exp2f(fminf(acc[r] * (-0.125f * LOG2E), 115.f));
            float bt = __builtin_amdgcn_rcpf(1.f + e), o1 = e * bt;
            if (diag && !(crow(r, hi) < r32)) { bt = 0.f; o1 = 1.f; }
            be[r] = bt; om[r] = o1;
        }
        float Gp[4], Gq[4];
#pragma unroll
        for (int g = 0; g < 4; ++g) { Gp[g] = (om[4 * g] * om[4 * g + 1]) * (om[4 * g + 2] * om[4 * g + 3]); Gq[g] = __shfl_xor(Gp[g], 32); }
        const float T1 = Gp[1] * Gq[1], T2 = Gp[2] * Gq[2], T3 = Gp[3] * Gq[3], T0 = Gp[0] * Gq[0];
        float tail[4]; tail[3] = R; tail[2] = R * T3; tail[1] = tail[2] * T2; tail[0] = tail[1] * T1;
        const float Rn = tail[0] * T0;
#pragma unroll
        for (int g = 0; g < 4; ++g) {
            float sfx = tail[g] * (hi == 0 ? Gq[g] : 1.f);
            acc[4 * g + 3] = be[4 * g + 3] * sfx; sfx *= om[4 * g + 3];
            acc[4 * g + 2] = be[4 * g + 2] * sfx; sfx *= om[4 * g + 2];
            acc[4 * g + 1] = be[4 * g + 1] * sfx; sfx *= om[4 * g + 1];
            acc[4 * g + 0] = be[4 * g + 0] * sfx;
        }
        R = Rn;
        const bf16x8 p0 = pack8(acc, 0), p1 = pack8(acc, 1);
        pv_tile(O, vrd, p0, p1);
#pragma unroll
        for (int i = 0; i < 4; ++i) { kc[i] = kn[i]; vc[i] = vn[i]; }
    }
    gate_store(O, 1.f, base + (size_t)t * LDP + C_SBG + h * 64, MIX + ((size_t)b * SEQ + t) * DM + h * 64, hi);
}

__device__ __forceinline__ void mem_item(const bf16_t* PROJ, const bf16_t* KV, bf16_t* MIX, int b, int h, int qt, int lane, LAS unsigned char* wl) {
    asm volatile("" : "+v"(lane));
    const int r32 = lane & 31, hi = lane >> 5;
    const int t = 32 * qt + r32;
    const bf16_t* prow = PROJ + ((size_t)b * SEQ + t) * LDP;
    bf16x8 qf[4];
#pragma unroll
    for (int ks = 0; ks < 4; ++ks) qf[ks] = *(const bf16x8*)(prow + C_MQ + h * 64 + 16 * ks + 8 * hi);
    const int vrow = lane >> 3, vch = lane & 7;
    LAS unsigned char* vwr = wl + vrow * VT_PITCH + vch * 16;
    const LAS unsigned char* vrd = wl + (4 * hi + ((lane & 15) >> 2)) * VT_PITCH + (16 * ((lane >> 4) & 1) + 4 * (lane & 3)) * 2;
    const bf16_t* kvb = KV + (size_t)b * NMEM * 1024 + h * 64;
    f32x16 O[2];
#pragma unroll
    for (int r = 0; r < 16; ++r) { O[0][r] = 0.f; O[1][r] = 0.f; }
    float mrun = -INFINITY, lrun = 0.f;
    for (int kt = 0; kt < NMEM / 32; ++kt) {
        bf16x8 kc[4], vc[4];
        const bf16_t* kp = kvb + (size_t)(32 * kt + r32) * 1024 + 8 * hi;
#pragma unroll
        for (int ks = 0; ks < 4; ++ks) kc[ks] = *(const bf16x8*)(kp + 16 * ks);
        const bf16_t* vp = kvb + (size_t)(32 * kt + vrow) * 1024 + 256 + 8 * vch;
#pragma unroll
        for (int i = 0; i < 4; ++i) vc[i] = *(const bf16x8*)(vp + (size_t)(8 * i) * 1024);
        f32x16 acc;
#pragma unroll
        for (int r = 0; r < 16; ++r) acc[r] = 0.f;
#pragma unroll
        for (int ks = 0; ks < 4; ++ks) acc = MFMA32(kc[ks], qf[ks], acc);
#pragma unroll
        for (int i = 0; i < 4; ++i) *(LAS bf16x8*)(vwr + (8 * i) * VT_PITCH) = vc[i];
        float mx = acc[0];
#pragma unroll
        for (int r = 1; r < 16; ++r) mx = fmaxf(mx, acc[r]);
        mx *= 0.125f * LOG2E;
        mx = fmaxf(mx, __shfl_xor(mx, 32));
        const float mn = fmaxf(mrun, mx), alpha = __builtin_amdgcn_exp2f(mrun - mn);
        float ps = 0.f;
#pragma unroll
        for (int r = 0; r < 16; ++r) { acc[r] = __builtin_amdgcn_exp2f(acc[r] * (0.125f * LOG2E) - mn); ps += acc[r]; }
        lrun = lrun * alpha + ps; mrun = mn;
#pragma unroll
        for (int r = 0; r < 16; ++r) { O[0][r] *= alpha; O[1][r] *= alpha; }
        const bf16x8 p0 = pack8(acc, 0), p1 = pack8(acc, 1);
        pv_tile(O, vrd, p0, p1);
    }
    const float lt = lrun + __shfl_xor(lrun, 32);
    gate_store(O, 1.f / lt, prow + C_MG + h * 64, MIX + ((size_t)b * SEQ + t) * DM + 768 + h * 64, hi);
}

constexpr int SEL_IQ_PITCH = 528, SEL_CNT_OFF = 17408;
__device__ __forceinline__ unsigned ordkey(float f);
template <int PRED  >
__device__ __forceinline__ unsigned sel_count_round(const unsigned (&key)[8][16], unsigned c, unsigned tau, int idx0, int r32, int hi, int wave, LAS unsigned* cb) {
    int n = 0;
#pragma unroll
    for (int i = 0; i < 8; ++i) {
#pragma unroll
        for (int r = 0; r < 16; ++r) {
            if (PRED == 0) n += (key[i][r] >= c) ? 1 : 0;
            else if (PRED == 1) n += (key[i][r] > c) ? 1 : 0;
            else n += (key[i][r] == tau && (unsigned)(idx0 + 256 * i + (r & 3) + 8 * (r >> 2)) <= c) ? 1 : 0;
            if ((r & 7) == 7) asm volatile("" : "+v"(n));
        }
    }
    n += __shfl_xor(n, 32);
    if (hi == 0) cb[wave * 32 + r32] = (unsigned)n;
    __syncthreads();
    unsigned tot = 0;
#pragma unroll
    for (int w = 0; w < 8; ++w) tot += cb[w * 32 + r32];
    return tot;
}
__device__ __forceinline__ void sel_item(const bf16_t* PROJ, unsigned* MASK, int b, int qt, int lane, int wave, LAS unsigned char* L) {
    asm volatile("" : "+v"(lane));
    const int r32 = lane & 31, hi = lane >> 5, tid = wave * 64 + lane;
    LAS unsigned* cntb = (LAS unsigned*)(L + SEL_CNT_OFF);
    const bf16_t* base = PROJ + (size_t)b * SEQ * LDP;
    unsigned* mrow = MASK + (((size_t)b * 64 + qt) * 64) * 32;
    const bool need_sel = qt >= 8;
    if (!need_sel) {
#pragma unroll
        for (int i = 0; i < 8; ++i) {
            const int kt = wave + 8 * i;
            if (kt <= qt) {
                unsigned bits = 0u;
#pragma unroll
                for (int r = 0; r < 16; ++r) bits |= ((kt < qt) || (crow(r, hi) <= r32)) ? (1u << r) : 0u;
                const unsigned other = __shfl_xor(bits, 32);
                if (hi == 0) mrow[kt * 32 + r32] = bits | (other << 16);
            }
        }
        return;
    }
    for (int n = tid; n < 1024; n += 512) { const int row = n >> 5, ch = n & 31;
        const v4u v = *(const v4u*)(base + (size_t)(32 * qt + row) * LDP + C_IDQ + ch * 8);
        *(LAS v4u*)(L + row * SEL_IQ_PITCH + ch * 16) = v; }
    float w8[8];
    { const v4u wv = *(const v4u*)(base + (size_t)(32 * qt + r32) * LDP + C_IDW);
      w8[0] = __uint_as_float(wv.x << 16) * 0.0625f; w8[1] = __uint_as_float(wv.x & 0xffff0000u) * 0.0625f; w8[2] = __uint_as_float(wv.y << 16) * 0.0625f; w8[3] = __uint_as_float(wv.y & 0xffff0000u) * 0.0625f;
      w8[4] = __uint_as_float(wv.z << 16) * 0.0625f; w8[5] = __uint_as_float(wv.z & 0xffff0000u) * 0.0625f; w8[6] = __uint_as_float(wv.w << 16) * 0.0625f; w8[7] = __uint_as_float(wv.w & 0xffff0000u) * 0.0625f; }
    __syncthreads();
    unsigned key[8][16];
    const LAS unsigned char* iqp = L + r32 * SEL_IQ_PITCH + 16 * hi;
#pragma unroll
    for (int i = 0; i < 8; ++i) {
        const int kt = wave + 8 * i;
        const bf16_t* kp = base + (size_t)(32 * kt + r32) * LDP + C_IDK + 8 * hi;
        const bf16x8 k0 = *(const bf16x8*)kp, k1 = *(const bf16x8*)(kp + 16);
        float sc[16];
#pragma unroll
        for (int r = 0; r < 16; ++r) sc[r] = 0.f;
        unsigned iqo = 0; asm volatile("" : "+v"(iqo));
        const LAS unsigned char* iqt = iqp + iqo;
#pragma unroll
        for (int h = 0; h < 8; ++h) {
            const bf16x8 q0 = *(const LAS bf16x8*)(iqt + h * 64), q1 = *(const LAS bf16x8*)(iqt + h * 64 + 32);
            bf16x8 q0p = q0, q1p = q1;
            asm volatile("" : "+v"(q0p), "+v"(q1p) : "v"(sc[15]));
            f32x16 D;
#pragma unroll
            for (int r = 0; r < 16; ++r) D[r] = 0.f;
            D = MFMA32(k0, q0p, D); D = MFMA32(k1, q1p, D);
#pragma unroll
            for (int r = 0; r < 16; ++r) sc[r] += w8[h] * fmaxf(D[r], 0.f);
            asm volatile("" : "+v"(sc[0]), "+v"(sc[1]), "+v"(sc[2]), "+v"(sc[3]), "+v"(sc[4]), "+v"(sc[5]), "+v"(sc[6]), "+v"(sc[7]),
                              "+v"(sc[8]), "+v"(sc[9]), "+v"(sc[10]), "+v"(sc[11]), "+v"(sc[12]), "+v"(sc[13]), "+v"(sc[14]), "+v"(sc[15]));
        }
        int thr = (kt < qt) ? 64 : ((kt == qt) ? (r32 - 4 * hi) : -1);
        asm volatile("" : "+v"(thr));
#pragma unroll
        for (int r = 0; r < 16; ++r) key[i][r] = ((r & 3) + 8 * (r >> 2) <= thr) ? ordkey(sc[r]) : 0u;
    }
    unsigned prefix = 0u, cge = 0u;
    for (int bit = 31; bit >= 0; --bit) {
        const unsigned cand = prefix | (1u << bit);
        const unsigned tot = sel_count_round<0>(key, cand, 0u, 0, r32, hi, wave, cntb + (bit & 1) * 256);
        if (tot >= 256u) { prefix = cand; cge = tot; }
    }
    const unsigned tau = prefix;
    unsigned cut = 0xffffffffu;
    if (__any(cge != 256u)) {
        const unsigned cgt = sel_count_round<1>(key, tau, 0u, 0, r32, hi, wave, cntb);
        const unsigned need = 256u - cgt;
        const int idx0 = 32 * wave + 4 * hi;
        unsigned lo_ = 0u, hi_ = 2047u;
        for (int it = 0; it < 11; ++it) {
            const unsigned mid = (lo_ + hi_) >> 1;
            const unsigned f = sel_count_round<2>(key, mid, tau, idx0, r32, hi, wave, cntb + ((it + 1) & 1) * 256);
            if (f >= need) hi_ = mid; else lo_ = mid + 1;
        }
        cut = hi_;
    }
    {
        const int idx0 = 32 * wave + 4 * hi;
#pragma unroll
        for (int i = 0; i < 8; ++i) {
            const int kt = wave + 8 * i;
            if (kt <= qt) {
                unsigned bits = 0u;
#pragma unroll
                for (int r = 0; r < 16; ++r) {
                    const bool s = (key[i][r] > tau) || (key[i][r] == tau && (unsigned)(idx0 + 256 * i + (r & 3) + 8 * (r >> 2)) <= cut);
                    bits |= s ? (1u << r) : 0u;
                }
                const unsigned other = __shfl_xor(bits, 32);
                if (hi == 0) mrow[kt * 32 + r32] = bits | (other << 16);
            }
        }
    }
    __syncthreads();
}

constexpr int WS_WUK = 0;
constexpr int WS_WUV = 256 * 1024;
constexpr int DSA_BIAS_OFF = 16384;
__device__ __forceinline__ unsigned dsa_off(unsigned row, unsigned ch) { return 256u * row + 16u * (ch ^ (((row & 3u) << 2) | ((row >> 2) & 3u))); }
__device__ __forceinline__ void dsa_round(const bf16_t* PROJ, const bf16_t* CKVN, const unsigned* MASK, const bf16_t* WUKp  , const bf16_t* WUVp  ,
                                          const float* rel_bias, bf16_t* MIX, int b, int o, int h, int lane, int wave, LAS unsigned char* L) {
    asm volatile("" : "+v"(lane));
    const int r32 = lane & 31, hi = lane >> 5, tid = wave * 64 + lane;
    const int qt = 8 * o + wave, KT = 8 * o + 7, t = 32 * qt + r32;
    LAS float* biasT = (LAS float*)(L + DSA_BIAS_OFF);
    if (tid < 192) { const int bk = tid < 128 ? (int)T5TAB[tid] : 31; biasT[tid] = rel_bias[bk * 6 + h] * LOG2E; }
    const float bias31 = rel_bias[31 * 6 + h] * LOG2E;
    bf16x8 qlf[8];
    {
        const bf16_t* qrow = PROJ + ((size_t)b * SEQ + t) * LDP + C_DSQ + h * 64 + 8 * hi;
        bf16x8 qf[4];
#pragma unroll
        for (int ks = 0; ks < 4; ++ks) qf[ks] = *(const bf16x8*)(qrow + 16 * ks);
#pragma unroll
        for (int rt = 0; rt < 4; ++rt) {
            f32x16 X;
#pragma unroll
            for (int r = 0; r < 16; ++r) X[r] = 0.f;
            const bf16_t* wp = WUKp + (rt * 32 + r32) * 64 + 8 * hi;
#pragma unroll
            for (int ks = 0; ks < 4; ++ks) X = MFMA32(*(const bf16x8*)(wp + 16 * ks), qf[ks], X);
#pragma unroll
            for (int r = 0; r < 16; ++r) X[r] *= 0.125f * LOG2E;
            qlf[2 * rt] = pack8(X, 0); qlf[2 * rt + 1] = pack8(X, 1);
        }
    }
    f32x16 O[4];
#pragma unroll
    for (int c = 0; c < 4; ++c)
#pragma unroll
        for (int r = 0; r < 16; ++r) O[c][r] = 0.f;
    float mrun = -INFINITY, lrun = 0.f;
    const int srow = tid >> 4, sch = tid & 15;
    const bf16_t* csrc = CKVN + ((size_t)b * SEQ + srow) * 128 + 8 * sch;
    const unsigned sdst = dsa_off(srow, sch);
    const unsigned rrd = 256u * r32;
    const unsigned rx = (((unsigned)r32 & 3u) << 2) | (((unsigned)r32 >> 2) & 3u);
    const unsigned tq = (lane & 15) >> 2, tp = lane & 3, tblk = (lane >> 4) & 1;
    const unsigned* mrow = MASK + (((size_t)b * 64 + qt) * 64) * 32 + r32;
    {
        const v4u v0 = *(const v4u*)csrc;
        *(LAS v4u*)(L + sdst) = v0;
    }
    for (int kt = 0; kt <= KT; ++kt) {
        v4u vn;
        if (kt < KT) vn = *(const v4u*)(csrc + (size_t)(32 * (kt + 1)) * 128);
        __syncthreads();
        const LAS unsigned char* Cb = L + (kt & 1) * 8192;
        if (kt <= qt) {
            f32x16 S;
#pragma unroll
            for (int r = 0; r < 16; ++r) S[r] = 0.f;
#pragma unroll
            for (int ks = 0; ks < 8; ++ks) {
                const bf16x8 a = *(const LAS bf16x8*)(Cb + rrd + 16u * ((unsigned)(2 * ks + hi) ^ rx));
                S = MFMA32(a, qlf[ks], S);
            }
            const unsigned mw = mrow[kt * 32] >> (16 * hi);
            const int dq = qt - kt;
            if (dq >= 5) {
#pragma unroll
                for (int r = 0; r < 16; ++r) S[r] = ((mw >> r) & 1u) ? S[r] + bias31 : -INFINITY;
            } else {
                const int rel0 = 32 * dq + r32 - 4 * hi;
#pragma unroll
                for (int r = 0; r < 16; ++r) {
                    int rel = rel0 - ((r & 3) + 8 * (r >> 2)); rel = rel < 0 ? 0 : rel;
                    S[r] = ((mw >> r) & 1u) ? S[r] + biasT[rel] : -INFINITY;
                }
            }
            float mx = S[0];
#pragma unroll
            for (int r = 1; r < 16; ++r) mx = fmaxf(mx, S[r]);
            mx = fmaxf(mx, __shfl_xor(mx, 32));
            const float mn = fmaxf(mrun, mx);
            const float ms = (mn == -INFINITY) ? 0.f : mn;
            const float alpha = __builtin_amdgcn_exp2f(mrun - ms);
            float ps = 0.f;
#pragma unroll
            for (int r = 0; r < 16; ++r) { S[r] = __builtin_amdgcn_exp2f(S[r] - ms); ps += S[r]; }
            lrun = lrun * alpha + ps; mrun = mn;
#pragma unroll
            for (int c = 0; c < 4; ++c)
#pragma unroll
                for (int r = 0; r < 16; ++r) O[c][r] *= alpha;
            const bf16x8 p0 = pack8(S, 0), p1 = pack8(S, 1);
#pragma unroll
            for (int c = 0; c < 4; ++c) {
                s16x4 f[4];
#pragma unroll
                for (int st = 0; st < 4; ++st) {
                    const unsigned row = 16u * (st >> 1) + 8u * (st & 1) + 4u * hi + tq;
                    f[st] = vtr(Cb + dsa_off(row, 4u * c + 2u * tblk + (tp >> 1)) + 8u * (tp & 1));
                }
                O[c] = MFMA32(cat44(f[0], f[1]), p0, O[c]);
                O[c] = MFMA32(cat44(f[2], f[3]), p1, O[c]);
            }
        }
        if (kt < KT) *(LAS v4u*)(L + ((kt + 1) & 1) * 8192 + sdst) = vn;
    }
    const float lt = lrun + __shfl_xor(lrun, 32);
    const float il = 1.f / lt;
    f32x16 Y[2];
#pragma unroll
    for (int r = 0; r < 16; ++r) { Y[0][r] = 0.f; Y[1][r] = 0.f; }
#pragma unroll
    for (int rt = 0; rt < 4; ++rt) {
#pragma unroll
        for (int r = 0; r < 16; ++r) O[rt][r] *= il;
        const bf16x8 x0 = pack8(O[rt], 0), x1 = pack8(O[rt], 1);
#pragma unroll
        for (int c = 0; c < 2; ++c) {
            const bf16_t* wp = WUVp + ((((c * 4 + rt) * 2 + 0) * 32 + r32) * 2 + hi) * 8;
            Y[c] = MFMA32(*(const bf16x8*)wp, x0, Y[c]);
            Y[c] = MFMA32(*(const bf16x8*)(wp + 32 * 2 * 8), x1, Y[c]);
        }
    }
    gate_store(Y, 1.f, PROJ + ((size_t)b * SEQ + t) * LDP + C_DSG + h * 64, MIX + ((size_t)b * SEQ + t) * DM + 384 + h * 64, hi);
    __syncthreads();
}

#ifndef MK_MULTI
#define MK_MULTI 0
#endif
constexpr int NPHASE = 11;
__global__ void __launch_bounds__(NWAVES * 64, 2) mk_fwd(Args args) {
    extern __shared__ __attribute__((aligned(16))) unsigned char lds_raw[];
    LAS unsigned char* lds = (LAS unsigned char*)lds_raw;
    const int tid0 = threadIdx.x;
    const int wave = __builtin_amdgcn_readfirstlane(tid0 >> 6);
    const int G = gridDim.x, bid = blockIdx.x;
    const int lo = args.ph_lo, hi = args.ph_hi;
#define IN(k) (lo <= (k) && (k) < hi)
#define SEAM(k) do { if (IN(k) && IN((k) + 1)) { cg::this_grid().sync(); } } while (0)
#define PH_BEGIN int lane = lane_id_v(); unsigned char* ws = args.ws; asm volatile("" : "+s"(ws)); \
    const int gw = bid * NWAVES + wave, NGW = G * NWAVES; (void)gw; (void)NGW; \
    const int vcu = (bid & 7) * (G >> 3) + (bid >> 3); const int bb = vcu >> 3, w64 = (vcu & 7) * 8 + wave; (void)bb; (void)w64;
#define P_WIN ((bf16_t*)(ws + WS_WIN))
#define P_WOUT ((bf16_t*)(ws + WS_WOUT))
#define P_WMEM ((bf16_t*)(ws + WS_WMEM))
#define P_MEMB ((bf16_t*)(ws + WS_MEMB))
#define P_MEMKV ((bf16_t*)(ws + WS_MEMKV))
#define P_CKVN ((bf16_t*)(ws + WS_CKVN))
#define P_MASK ((unsigned*)(ws + WS_MASK))
#define P_H ((bf16_t*)(ws + WS_H))
#define P_MIX ((bf16_t*)(ws + WS_MIX))
#define P_PROJ ((bf16_t*)(ws + WS_PROJ))
#define P_Y ((bf16_t*)(ws + WS_Y))

    if (IN(0)) {
        PH_BEGIN
        const float* x = args.in[0]; const float* mem = args.in[1]; const float* pre_g = args.in[2];
        const float* w_in = args.in[4]; const float* w_mem = args.in[8]; const float* w_out = args.in[9];
        LAS float* scr = (LAS float*)(lds + wave * 16384);
        constexpr int I_IN = 16 * (LDP / 32), I_OUT = 16 * 32, I_MEM = 16 * 16;
        constexpr int NITEMS = 2 * I_IN + 2 * I_OUT + 2 * I_MEM;
        for (int it = gw; it < NITEMS; it += NGW) {
            int r = it;
            if (r < 2 * I_IN) { const int l = r / I_IN; r -= l * I_IN; p0_transpose_item(w_in + (size_t)l * DM * NCOL, DM, NCOL, LDP, P_WIN + (size_t)l * LDP * DM, pre_g + l * DM, scr, r, lane); continue; }
            r -= 2 * I_IN;
            if (r < 2 * I_OUT) { const int l = r / I_OUT; r -= l * I_OUT; p0_transpose_item(w_out + (size_t)l * DM * DM, DM, DM, DM, P_WOUT + (size_t)l * DM * DM, nullptr, scr, r, lane); continue; }
            r -= 2 * I_OUT;
            { const int l = r / I_MEM; r -= l * I_MEM; p0_transpose_item(w_mem + (size_t)l * DM * 512, DM, 512, 512, P_WMEM + (size_t)l * 512 * DM, nullptr, scr, r, lane); }
        }
        {
            const float* w_uk = args.in[5]; const float* w_uv = args.in[6];
            bf16_t* WUKp = (bf16_t*)(ws + WS_WUK); bf16_t* WUVp = (bf16_t*)(ws + WS_WUV);
            for (int e = gw * 64 + lane; e < 2 * 6 * 8192; e += NGW * 64) {
                const int lh = e >> 13, l = lh / 6, h = lh % 6, w = e & 8191;
                { const int rt = w >> 11, rho = (w >> 6) & 31, d = w & 63; const int r = 32 * rt + ((rho & 0x13) | ((rho & 4) << 1) | ((rho & 8) >> 1));
                  WUKp[e] = (bf16_t)f2bf(w_uk[(((size_t)l * 128 + r) * 6 + h) * 64 + d]); }
                { const int j = w & 7, hh = (w >> 3) & 1, d32 = (w >> 4) & 31, s = (w >> 9) & 1, rt = (w >> 10) & 3, c = (w >> 12) & 1;
                  const int r = 32 * rt + 16 * s + 8 * (j >> 2) + 4 * hh + (j & 3), d = 32 * c + d32;
                  WUVp[e] = (bf16_t)f2bf(w_uv[(((size_t)l * 128 + r) * 6 + h) * 64 + d]); }
            }
        }
        for (int m = gw; m < NB * NMEM; m += NGW) row_to_bf16<false>(mem + (size_t)m * DM, P_MEMB + (size_t)m * DM, lane);
        for (int m = gw; m < NTOK; m += NGW) row_to_bf16<true>(x + (size_t)m * DM, P_H + (size_t)m * DM, lane);
    }
    SEAM(0);
#pragma unroll 1
    for (int l = 0; l < 2; ++l) {
        const int pb = 1 + 5 * l;
        if (IN(pb)) {
            PH_BEGIN
            { pg8::Gemm g{P_H, P_WIN + (size_t)l * LDP * DM, NTOK, LDP, DM}; pg8::StaticOrder S; S.init(NTOK, LDP, G, bid);
              pg8::EpiBf16<0> E{P_PROJ, LDP, nullptr, 0, 0, 1.f};
              pg8::gemm_phase<pg8::EpiBf16<0>, pg8::StaticOrder, true, true>(lds, g, S, E, wave); }
            if (l == 0) {
              pg8::Gemm g{P_MEMB, P_WMEM, NB * NMEM, 1024, DM}; pg8::StaticOrder S; S.init(NB * NMEM, 1024, G, bid);
              pg8::EpiBf16<0> E{P_MEMKV, 1024, nullptr, 0, 0, 1.f};
              pg8::gemm_phase<pg8::EpiBf16<0>, pg8::StaticOrder, true, true>(lds, g, S, E, wave); }
        }
        SEAM(pb);
        if (IN(pb + 1)) {
            { PH_BEGIN
              const float* kv_g = args.in[7];
              for (int m = gw; m < NTOK; m += NGW) ckvnorm_wave(P_PROJ, kv_g + l * 128, P_CKVN, m, lane); }
#ifndef SKIP_SB
            { PH_BEGIN
              for (int i = 0; i < 6; ++i) { const int qt = (i & 1) ? 63 - w64 : w64; sb_item(P_PROJ, P_MIX, bb, i, qt, lane, lds + wave * 16384); } }
#endif
#ifndef SKIP_SEL
            __syncthreads();
            { PH_BEGIN
              const int s8 = vcu & 7;
              for (int j = 0; j < 8; ++j) { const int qt = 8 * j + ((j & 1) ? 7 - s8 : s8); sel_item(P_PROJ, P_MASK, bb, qt, lane, wave, lds); } }
            __syncthreads();
#endif
#ifndef SKIP_MEM
            { PH_BEGIN
              for (int i = 0; i < 4; ++i) mem_item(P_PROJ, P_MEMKV + l * 512, P_MIX, bb, i, w64, lane, lds + wave * 16384); }
#endif
        }
        SEAM(pb + 1);
        if (IN(pb + 2)) {
            PH_BEGIN
            const float* rel_bias = args.in[10];
            const int s8 = vcu & 7, hs = (s8 < 4) ? 0 : 3;
            __syncthreads();
            for (int oi = 0; oi < 2; ++oi) {
                const int o = oi ? 7 - (s8 & 3) : (s8 & 3);
                for (int hh = 0; hh < 3; ++hh) {
                    const int h = hs + hh;
                    dsa_round(P_PROJ, P_CKVN, P_MASK, (const bf16_t*)(ws + WS_WUK) + (size_t)(l * 6 + h) * 8192, (const bf16_t*)(ws + WS_WUV) + (size_t)(l * 6 + h) * 8192,
                              rel_bias, P_MIX, bb, o, h, lane, wave, lds);
                }
            }
        }
        SEAM(pb + 2);
        if (IN(pb + 3)) {
            PH_BEGIN
            __syncthreads();
            pg8::Gemm g{P_MIX, P_WOUT + (size_t)l * DM * DM, NTOK, DM, DM}; pg8::StaticOrder S; S.init(NTOK, DM, G, bid);
            pg8::EpiBf16<0> E{P_Y, DM, nullptr, 0, 0, 1.f};
            pg8::gemm_phase<pg8::EpiBf16<0>, pg8::StaticOrder, true, true>(lds, g, S, E, wave);
        }
        SEAM(pb + 3);
        if (IN(pb + 4)) {
            PH_BEGIN
            const float* xin = (l == 0) ? args.in[0] : args.out; const float* post_g = args.in[3];
            for (int m = gw; m < NTOK; m += NGW) post_row(xin, P_Y, post_g + l * DM, args.out, (l == 0) ? P_H : (bf16_t*)nullptr, m, lane);
        }
        SEAM(pb + 4);
    }
#undef IN
#undef SEAM
}

extern "C" void kernel_launch(void* const* d_in, const int* in_sizes, int n_in, void* d_out, int out_size, void* d_ws, size_t ws_size, hipStream_t stream) {
    static int grid = 0;
    if (grid == 0) {
        if (n_in != 11 || ws_size < WS_END) { fprintf(stderr, "kernel_launch: unexpected n_in %d / ws_size %zu\n", n_in, ws_size); grid = -1; return; }
        int dev = 0, cus = 0, per_cu = 0;
        hipGetDevice(&dev);
        hipDeviceGetAttribute(&cus, hipDeviceAttributeMultiprocessorCount, dev);
        hipFuncSetAttribute((const void*)mk_fwd, hipFuncAttributeMaxDynamicSharedMemorySize, LDS_BYTES);
        hipOccupancyMaxActiveBlocksPerMultiprocessor(&per_cu, (const void*)mk_fwd, NWAVES * 64, LDS_BYTES);
        if (per_cu < 1) { fprintf(stderr, "kernel_launch: occupancy query says %d blocks per CU\n", per_cu); per_cu = 1; }
        grid = cus * 1;
        (void)hipGetLastError();
    }
    if (grid < 0) return;
    Args a{};
    for (int i = 0; i < 11; ++i) a.in[i] = (const float*)d_in[i];
    a.out = (float*)d_out; a.ws = (unsigned char*)d_ws;
#if MK_MULTI
    for (int p = 0; p < NPHASE; ++p) { a.ph_lo = p; a.ph_hi = p + 1; hipLaunchKernelGGL(mk_fwd, dim3(grid), dim3(NWAVES * 64), LDS_BYTES, stream, a); }
#else
    a.ph_lo = 0; a.ph_hi = NPHASE;
    void* kargs[] = {&a};
    hipError_t e = hipLaunchCooperativeKernel((const void*)mk_fwd, dim3(grid), dim3(NWAVES * 64), kargs, LDS_BYTES, stream);
    if (e != hipSuccess) fprintf(stderr, "cooperative launch failed: %s (grid %d)\n", hipGetErrorString(e), grid);
#endif
}
```

```cpp
#include <hip/hip_runtime.h>
#include <hip/hip_cooperative_groups.h>
#include <stdint.h>
#include <math.h>
#include <cstdio>
namespace cg = cooperative_groups;
#ifndef PROBE_DUP
#define PROBE_DUP 0
#endif
#define DUPN(k) ((PROBE_DUP >> (k)) & 1 ? 2 : 1)
__device__ __forceinline__ int lane_id_v() { int l; asm volatile("v_mbcnt_lo_u32_b32 %0, -1, 0\n\tv_mbcnt_hi_u32_b32 %0, -1, %0" : "=v"(l)); return l; }
namespace pg8 {
#define PG8_LAS __attribute__((address_space(3)))
typedef unsigned short bf16_t;
typedef short bf16x8 __attribute__((ext_vector_type(8)));
typedef float f32x4 __attribute__((ext_vector_type(4)));
typedef unsigned u32x4 __attribute__((ext_vector_type(4)));
constexpr int BM = 256, BK = 64, HALF = 128, HTB = HALF * BK * 2  , STAGE_BYTES = 8 * HTB, NXCD = 8, WGM = 8;

__host__ __device__ __forceinline__ int lds_byte(int r, int c) { const int st = (r >> 4) * 2 + (c >> 5), rr = r & 15, cc = c & 31, ob = rr * 64 + cc * 2; return st * 1024 + (ob ^ (((ob >> 9) & 1) << 5)); }
__host__ __device__ __forceinline__ void stage_rc(int b, int& R, int& C) { const int st = b / 1024, sb = b % 1024, swz = sb ^ (((sb >> 9) & 1) << 5); R = (st >> 1) * 16 + swz / 64; C = (st & 1) * 32 + (swz % 64) / 2; }
__host__ __device__ __forceinline__ int perm32(int rho) { const int n = rho >> 4, i = rho & 15; return 8 * (i >> 2) + 4 * n + (i & 3); }

struct Unit { int pm, pn; };
struct Gemm { const bf16_t* A; const bf16_t* Bt; int M, N, K; };

struct StaticOrder {
    int nM, nN, nwg, G, c;
    __host__ __device__ void init(int M, int N, int G_, int c_) { nM = M / BM; nN = N / BM; nwg = nM * nN; G = G_; c = c_; }
    __host__ __device__ bool next(int i, Unit& u) const {
        const long L = (long)i * G + c; if (L >= nwg) return false;
        int wgid = (int)L; { const int q = nwg / NXCD, r = nwg % NXCD, xcd = wgid % NXCD, off = wgid / NXCD; wgid = (xcd < r ? xcd * (q + 1) : r * (q + 1) + (xcd - r) * q) + off; }
        const int nig = WGM * nN, gid = wgid / nig, fm = gid * WGM, gsz = (nM - fm) < WGM ? (nM - fm) : WGM;
        u.pm = fm + ((wgid % nig) % gsz); u.pn = (wgid % nig) / gsz; return true;
    }
    __device__ __forceinline__ void a_ready(const Unit&) const {}
    __device__ __forceinline__ void done(const Unit&) const {}
};

__device__ __forceinline__ unsigned cvt_pk_bf16(float lo, float hi) { unsigned r; asm volatile("v_cvt_pk_bf16_f32 %0, %1, %2" : "=v"(r) : "v"(lo), "v"(hi)); return r; }
typedef float f32x2 __attribute__((ext_vector_type(2)));
__device__ __forceinline__ f32x2 gelu_pk(f32x2 v) {
    const f32x2 av = __builtin_elementwise_abs(v), d = av * 0.2316418882f + 1.0f;
    f32x2 t; t.x = __builtin_amdgcn_rcpf(d.x); t.y = __builtin_amdgcn_rcpf(d.y);
    f32x2 q = t * 0.5307027145f + (-0.7265760135f); q = q * t + 0.7107068705f; q = q * t + (-0.142248368f); q = q * t + 0.127414796f; q = q * t;
    const f32x2 s = (v * v) * (-0.72134752044f);
    f32x2 e; e.x = __builtin_amdgcn_exp2f(s.x); e.y = __builtin_amdgcn_exp2f(s.y);
    const f32x2 m = v * (q * e), r = v - m;
    f32x2 o; o.x = v.x < 0.f ? m.x : r.x; o.y = v.y < 0.f ? m.y : r.y; return o;
}

template <int ACT  > struct EpiBf16 {
    static constexpr bool PERM = true, AFTER_DRAIN = false; static_assert(ACT == 0 || ACT == 1, "EpiBf16: ACT is 0 (none) or 1 (gelu_pk)");
    bf16_t* O; int ldc; const float* bias; int split_cols; size_t split_stride; float scale0;
    __device__ __forceinline__ void operator()(const f32x4 (&acc)[2][2][4][2], const Unit& u, int wr, int wc, int fr, int fq) const {
        const int row0 = u.pm * BM + wr * 64 + fr; int colt = u.pn * BM; bf16_t* base = O;
        float sc = 1.f; if (split_cols) { const int t = colt / split_cols; base += (size_t)t * split_stride; colt -= t * split_cols; if (t == 0) sc = scale0; }
        const int col0 = colt + wc * 32 + 8 * fq, bcol0 = u.pn * BM + wc * 32 + 8 * fq;
        f32x4 bv[2][2];
#pragma unroll
        for (int bj = 0; bj < 2; ++bj)
#pragma unroll
            for (int n = 0; n < 2; ++n) bv[bj][n] = bias ? *(const f32x4*)(bias + bcol0 + bj * HALF + 4 * n) : (f32x4){0.f, 0.f, 0.f, 0.f};
#pragma unroll
        for (int ai = 0; ai < 2; ++ai)
#pragma unroll
            for (int m = 0; m < 4; ++m) { bf16_t* rowp = base + (size_t)(row0 + ai * HALF + m * 16) * ldc + col0;
#pragma unroll
                for (int bj = 0; bj < 2; ++bj) { f32x4 v0 = acc[ai][bj][m][0] + bv[bj][0], v1 = acc[ai][bj][m][1] + bv[bj][1];
                    if (ACT == 1) { f32x2 a = gelu_pk((f32x2){v0[0], v0[1]}), b = gelu_pk((f32x2){v0[2], v0[3]}), c = gelu_pk((f32x2){v1[0], v1[1]}), d = gelu_pk((f32x2){v1[2], v1[3]});
                        v0 = (f32x4){a.x, a.y, b.x, b.y}; v1 = (f32x4){c.x, c.y, d.x, d.y}; }
                    v0 = v0 * sc; v1 = v1 * sc; u32x4 w; w.x = cvt_pk_bf16(v0[0], v0[1]); w.y = cvt_pk_bf16(v0[2], v0[3]); w.z = cvt_pk_bf16(v1[0], v1[1]); w.w = cvt_pk_bf16(v1[2], v1[3]);
                    *(u32x4*)(rowp + bj * HALF) = w; } }
    }
};
template <class Epi, class Sched, bool ALIGN_EPI = false, bool SP2 = false>
__device__ __forceinline__ void gemm_phase(PG8_LAS unsigned char* lds, const Gemm g, const Sched& S, const Epi& E, int wave_id) {
    int tid_ = wave_id * 64 + lane_id_v();
    const int tid = tid_, wid = __builtin_amdgcn_readfirstlane(tid >> 6), lane = tid & 63, wr = wid >> 2, wc = wid & 3, fr = lane & 15, fq = lane >> 4;
    const int K = g.K, nt = K / BK;
    unsigned voffA[2], voffB[2];
#pragma unroll
    for (int i = 0; i < 2; ++i) { int R, C; stage_rc(tid * 16 + i * 8192, R, C); const int Rb = Epi::PERM ? ((R & ~31) + perm32(R & 31)) : R;
        voffA[i] = (unsigned)(R * K + C) * 2u; voffB[i] = (unsigned)(Rb * K + C) * 2u; }
    const size_t kstep = (size_t)(BK * 2);
    const size_t hstep = (size_t)HALF * K * 2;
    const size_t tstep = 2 * hstep;
    const unsigned ldsw = (unsigned)wid * 1024u;
    const int aoff = lds_byte(wr * 64 + fr, fq * 8), boff = lds_byte(wc * 32 + fr, fq * 8);
#define PG8_SA(b, h) (((b) * 2 + (h)) * HTB)
#define PG8_SB(b, h) ((4 + (b) * 2 + (h)) * HTB)
#define PG8_STAGE(bufoff, gbase, voff) do { _Pragma("unroll") for (int _i = 0; _i < 2; ++_i) \
        __builtin_amdgcn_global_load_lds((const unsigned*)((const char*)(gbase) + (voff)[_i]), (PG8_LAS unsigned*)(lds + (bufoff) + ldsw + _i * 8192), 16, 0, 0); } while (0)
#define PG8_LDA(dst, b, h) do { _Pragma("unroll") for (int m = 0; m < 4; ++m) _Pragma("unroll") for (int k = 0; k < 2; ++k) dst[m][k] = *(const PG8_LAS bf16x8*)(lds + PG8_SA(b, h) + aoff + m * 2048 + k * 1024); } while (0)
#define PG8_LDB(dst, b, h) do { _Pragma("unroll") for (int n = 0; n < 2; ++n) _Pragma("unroll") for (int k = 0; k < 2; ++k) dst[n][k] = *(const PG8_LAS bf16x8*)(lds + PG8_SB(b, h) + boff + n * 2048 + k * 1024); } while (0)
#define PG8_MMA(ai, bj, At, Bt) do { __builtin_amdgcn_s_setprio(1); _Pragma("unroll") for (int m = 0; m < 4; ++m) _Pragma("unroll") for (int n = 0; n < 2; ++n) _Pragma("unroll") for (int k = 0; k < 2; ++k) \
        acc[ai][bj][m][n] = __builtin_amdgcn_mfma_f32_16x16x32_bf16(Bt[n][k], At[m][k], acc[ai][bj][m][n], 0, 0, 0); __builtin_amdgcn_s_setprio(0); } while (0)
#define PG8_WAIT_V(n) asm volatile("s_waitcnt vmcnt(" #n ")" ::: "memory")
#define PG8_WAIT_L(n) asm volatile("s_waitcnt lgkmcnt(" #n ")" ::: "memory")
#define PG8_BAR __builtin_amdgcn_s_barrier()
#define PG8_SCHED __builtin_amdgcn_sched_barrier(0)
    Unit cur, nxt; int ui = 0;
    if (!S.next(0, cur)) return;
    f32x4 acc[2][2][4][2];
#pragma unroll
    for (int a = 0; a < 2; ++a)
#pragma unroll
        for (int b = 0; b < 2; ++b)
#pragma unroll
            for (int m = 0; m < 4; ++m)
#pragma unroll
                for (int n = 0; n < 2; ++n) acc[a][b][m][n] = (f32x4){0.f, 0.f, 0.f, 0.f};
    bf16x8 At[4][2], B0[2][2], B1[2][2];
    const char* cA = (const char*)g.A + (size_t)cur.pm * tstep; const char* cB = (const char*)g.Bt + (size_t)cur.pn * tstep;
    S.a_ready(cur);
    if constexpr (SP2) {
        PG8_STAGE(PG8_SB(0, 0), cB, voffB); PG8_STAGE(PG8_SB(0, 1), cB + hstep, voffB); PG8_STAGE(PG8_SA(0, 0), cA, voffA); PG8_STAGE(PG8_SA(0, 1), cA + hstep, voffA);
        if (wr == 1) PG8_BAR;
        PG8_WAIT_V(2); PG8_BAR;
        PG8_STAGE(PG8_SB(1, 0), cB + kstep, voffB); PG8_STAGE(PG8_SA(1, 0), cA + kstep, voffA); PG8_STAGE(PG8_SB(1, 1), cB + hstep + kstep, voffB);
        PG8_WAIT_V(6); PG8_BAR;
    } else {
        PG8_STAGE(PG8_SB(0, 0), cB, voffB); PG8_STAGE(PG8_SA(0, 0), cA, voffA); PG8_STAGE(PG8_SB(0, 1), cB + hstep, voffB); PG8_STAGE(PG8_SA(0, 1), cA + hstep, voffA);
        if (wr == 1) PG8_BAR;
        PG8_WAIT_V(4); PG8_BAR;
        PG8_STAGE(PG8_SB(1, 0), cB + kstep, voffB); PG8_STAGE(PG8_SA(1, 0), cA + kstep, voffA); PG8_STAGE(PG8_SB(1, 1), cB + hstep + kstep, voffB);
        PG8_WAIT_V(6); PG8_BAR;
    }
    for (;;) {
        const bool has_next = S.next(ui + 1, nxt);
        const char* nA = has_next ? (const char*)g.A + (size_t)nxt.pm * tstep : cA; const char* nB = has_next ? (const char*)g.Bt + (size_t)nxt.pn * tstep : cB;
        for (int t = 0; t < nt; t += 2) {
            const bool last = (t == nt - 2);
            const char* a1 = cA + (size_t)(t + 1) * kstep;
            const char* a2 = last ? nA : cA + (size_t)(t + 2) * kstep; const char* b2 = last ? nB : cB + (size_t)(t + 2) * kstep;
            const char* a3 = a2 + kstep; const char* b3 = b2 + kstep;
            if (last && has_next) S.a_ready(nxt);
            if constexpr (SP2) {
            PG8_LDB(B0, 0, 0); PG8_LDB(B1, 0, 1); PG8_SCHED; PG8_LDA(At, 0, 0); PG8_STAGE(PG8_SA(1, 1), a1 + hstep, voffA);
            PG8_WAIT_V(8); PG8_WAIT_L(0); PG8_BAR; PG8_MMA(0, 0, At, B0); PG8_MMA(0, 1, At, B1); PG8_BAR; PG8_SCHED;
            PG8_LDA(At, 0, 1); PG8_STAGE(PG8_SB(0, 0), b2, voffB); PG8_STAGE(PG8_SB(0, 1), b2 + hstep, voffB); PG8_STAGE(PG8_SA(0, 0), a2, voffA);
            PG8_WAIT_V(8); PG8_WAIT_L(0); PG8_BAR; PG8_MMA(1, 0, At, B0); PG8_MMA(1, 1, At, B1); PG8_BAR; PG8_SCHED;
            PG8_LDB(B0, 1, 0); PG8_LDB(B1, 1, 1); PG8_SCHED; PG8_LDA(At, 1, 0); PG8_STAGE(PG8_SA(0, 1), a2 + hstep, voffA);
            PG8_WAIT_V(8); PG8_WAIT_L(0); PG8_BAR; PG8_MMA(0, 0, At, B0); PG8_MMA(0, 1, At, B1); PG8_BAR; PG8_SCHED;
            PG8_LDA(At, 1, 1); PG8_STAGE(PG8_SB(1, 0), b3, voffB); PG8_STAGE(PG8_SB(1, 1), b3 + hstep, voffB); PG8_STAGE(PG8_SA(1, 0), a3, voffA);
            PG8_WAIT_V(8); PG8_WAIT_L(0); PG8_BAR; PG8_MMA(1, 0, At, B0); PG8_MMA(1, 1, At, B1); PG8_BAR; PG8_SCHED;
            } else {
            PG8_LDB(B0, 0, 0); PG8_SCHED; PG8_LDA(At, 0, 0); PG8_STAGE(PG8_SA(1, 1), a1 + hstep, voffA);
            PG8_WAIT_L(8); PG8_BAR; PG8_WAIT_L(0); PG8_MMA(0, 0, At, B0); PG8_BAR; PG8_SCHED;
            PG8_LDB(B1, 0, 1); PG8_STAGE(PG8_SB(0, 0), b2, voffB);
            PG8_BAR; PG8_WAIT_L(0); PG8_MMA(0, 1, At, B1); PG8_BAR;
            PG8_LDA(At, 0, 1); PG8_STAGE(PG8_SA(0, 0), a2, voffA);
            PG8_BAR; PG8_WAIT_L(0); PG8_MMA(1, 0, At, B0); PG8_BAR; PG8_SCHED;
            PG8_STAGE(PG8_SB(0, 1), b2 + hstep, voffB);
            PG8_WAIT_V(6); PG8_BAR; PG8_MMA(1, 1, At, B1); PG8_BAR;
            PG8_LDB(B0, 1, 0); PG8_SCHED; PG8_LDA(At, 1, 0); PG8_STAGE(PG8_SA(0, 1), a2 + hstep, voffA);
            PG8_WAIT_L(8); PG8_BAR; PG8_WAIT_L(0); PG8_MMA(0, 0, At, B0); PG8_BAR; PG8_SCHED;
            PG8_LDB(B1, 1, 1); PG8_STAGE(PG8_SB(1, 0), b3, voffB);
            PG8_BAR; PG8_WAIT_L(0); PG8_MMA(0, 1, At, B1); PG8_BAR;
            PG8_LDA(At, 1, 1); PG8_STAGE(PG8_SA(1, 0), a3, voffA);
            PG8_BAR; PG8_WAIT_L(0); PG8_MMA(1, 0, At, B0); PG8_BAR; PG8_SCHED;
            PG8_STAGE(PG8_SB(1, 1), b3 + hstep, voffB);
            PG8_WAIT_V(6); PG8_BAR; PG8_MMA(1, 1, At, B1); PG8_BAR;
            }
        }
        if constexpr (ALIGN_EPI) { if (wr == 0) PG8_BAR; }
        if constexpr (!Epi::AFTER_DRAIN) { E(acc, cur, wr, wc, fr, fq); S.done(cur); }
        if (!has_next) break;
#pragma unroll
        for (int a = 0; a < 2; ++a)
#pragma unroll
            for (int b = 0; b < 2; ++b)
#pragma unroll
                for (int m = 0; m < 4; ++m)
#pragma unroll
                    for (int n = 0; n < 2; ++n) acc[a][b][m][n] = (f32x4){0.f, 0.f, 0.f, 0.f};
        cur = nxt; cA = nA; cB = nB; ++ui;
        if constexpr (ALIGN_EPI) { if (wr == 1) PG8_BAR; }
    }
    PG8_WAIT_V(0);
    if constexpr (!ALIGN_EPI) { if (wr == 0) PG8_BAR; }
    PG8_BAR;
    if constexpr (Epi::AFTER_DRAIN) { E.fused(acc, cur, wr, wc, fr, fq, lds, wid, lane); S.done(cur); }
#undef PG8_SA
#undef PG8_SB
#undef PG8_STAGE
#undef PG8_LDA
#undef PG8_LDB
#undef PG8_MMA
#undef PG8_WAIT_V
#undef PG8_WAIT_L
#undef PG8_BAR
#undef PG8_SCHED
}
}
typedef unsigned short bf16_t;
#define LAS __attribute__((address_space(3)))
#define GAS __attribute__((address_space(1)))
typedef unsigned v4u __attribute__((ext_vector_type(4)));
typedef unsigned v2u __attribute__((ext_vector_type(2)));
typedef float f32x4 __attribute__((ext_vector_type(4)));
constexpr int DM = 1024, NB = 32, SEQ = 2048, NTOK = NB * SEQ, NMEM = 256;
constexpr int LDP = 3328;
constexpr int C_SBQ = 0, C_SBK = 384, C_SBV = 768, C_SBG = 1152, C_DSQ = 1536, C_CKV = 1920, C_DSG = 2048,
              C_IDQ = 2432, C_IDK = 2688, C_IDW = 2720, C_MQ = 2728, C_MG = 2984, NCOL = 3240;
constexpr float EPS = 1e-6f;
constexpr size_t MiB = 1u << 20;
constexpr size_t WS_CTL = 0;
constexpr size_t WS_WIN = 1 * MiB;
constexpr size_t WS_WOUT = 14 * MiB;
constexpr size_t WS_WMEM = 18 * MiB;
constexpr size_t WS_MEMB = 20 * MiB;
constexpr size_t WS_MEMKV = 36 * MiB;
constexpr size_t WS_CKVN = 52 * MiB;
constexpr size_t WS_MASK = 68 * MiB;
constexpr size_t WS_H = 84 * MiB;
constexpr size_t WS_MIX = WS_H;
constexpr size_t WS_PROJ = 212 * MiB;
constexpr size_t WS_Y = WS_PROJ;
constexpr size_t WS_END = 628 * MiB;
constexpr int LDS_BYTES = 135168;
constexpr int NWAVES = 8;

__device__ __forceinline__ float bf2f(bf16_t v) { return __uint_as_float(((unsigned)v) << 16); }
__device__ __forceinline__ unsigned f2bf(float f) { unsigned u = __float_as_uint(f); u += 0x7fffu + ((u >> 16) & 1u); return u >> 16; }
__device__ __forceinline__ unsigned pk2(float lo, float hi) { return f2bf(lo) | (f2bf(hi) << 16); }
#define WAVE_SYNC() do { asm volatile("s_waitcnt lgkmcnt(0)" ::: "memory"); __builtin_amdgcn_wave_barrier(); } while (0)
__device__ __forceinline__ float wave_sum(float v) {
#pragma unroll
    for (int o = 1; o < 64; o <<= 1) v += __shfl_xor(v, o);
    return v;
}

__device__ const unsigned char T5TAB[128] = {0, 1, 2, 3, 4, 5, 6, 7, 8, 9, 10, 11, 12, 13, 14, 15, 16, 16, 16, 17, 17, 18, 18, 18, 19, 19, 19, 20, 20, 20, 20, 21, 21, 21, 21, 22, 22, 22, 22, 22, 23, 23, 23, 23, 23, 23, 24, 24, 24, 24, 24, 24, 25, 25, 25, 25, 25, 25, 25, 26, 26, 26, 26, 26, 26, 26, 26, 27, 27, 27, 27, 27, 27, 27, 27, 27, 27, 28, 28, 28, 28, 28, 28, 28, 28, 28, 28, 29, 29, 29, 29, 29, 29, 29, 29, 29, 29, 29, 29, 30, 30, 30, 30, 30, 30, 30, 30, 30, 30, 30, 30, 30, 30, 31, 31, 31, 31, 31, 31, 31, 31, 31, 31, 31, 31, 31, 31, 31};

struct Args { const float* in[11]; float* out; unsigned char* ws; int ph_lo, ph_hi; };

__device__ __forceinline__ void p0_transpose_item(const float* W, int K, int N, int Npad, bf16_t* WT, const float* g, LAS float* scr, int item, int lane) {
    const int nblk = Npad / 32, kb = item / nblk, nb = item % nblk, k0 = 64 * kb, n0 = 32 * nb;
    const int nn = n0 + (lane & 31);
#pragma unroll 8
    for (int i = 0; i < 32; ++i) { const int kk = 2 * i + (lane >> 5); float v = (nn < N) ? W[(size_t)(k0 + kk) * N + nn] : 0.f; if (g) v *= g[k0 + kk]; scr[kk * 33 + (lane & 31)] = v; }
    WAVE_SYNC();
    const int c = lane & 7;
#pragma unroll
    for (int j = 0; j < 4; ++j) { const int n = (lane >> 3) + 8 * j; const LAS float* s = scr + (8 * c) * 33 + n;
        v4u o; o.x = pk2(s[0 * 33], s[1 * 33]); o.y = pk2(s[2 * 33], s[3 * 33]); o.z = pk2(s[4 * 33], s[5 * 33]); o.w = pk2(s[6 * 33], s[7 * 33]);
        *(v4u*)(WT + (size_t)(n0 + n) * K + k0 + 8 * c) = o; }
    WAVE_SYNC();
}
template <bool NORM> __device__ __forceinline__ void row_to_bf16(const float* xrow, bf16_t* orow, int lane) {
    const f32x4* xr = (const f32x4*)xrow + lane;
    f32x4 v[4]; float s = 0.f;
#pragma unroll
    for (int j = 0; j < 4; ++j) { v[j] = xr[64 * j]; s += (v[j].x * v[j].x + v[j].y * v[j].y) + (v[j].z * v[j].z + v[j].w * v[j].w); }
    float r = 1.f;
    if (NORM) r = 1.0f / sqrtf(wave_sum(s) * (1.f / DM) + EPS);
    v2u* o8 = (v2u*)orow + lane;
#pragma unroll
    for (int j = 0; j < 4; ++j) { v2u w; w.x = pk2(v[j].x * r, v[j].y * r); w.y = pk2(v[j].z * r, v[j].w * r); o8[64 * j] = w; }
}

__device__ __forceinline__ void ckvnorm_wave(const bf16_t* PROJ, const float* kvg, bf16_t* CKVN, int row, int lane) {
    const bf16_t* p = PROJ + (size_t)row * LDP + C_CKV;
    const float a = bf2f(p[lane]), b = bf2f(p[lane + 64]);
    const float s = wave_sum(a * a + b * b);
    const float r = 1.0f / sqrtf(s * (1.0f / 128.f) + EPS);
    CKVN[(size_t)row * 128 + lane] = (bf16_t)f2bf(a * r * kvg[lane]);
    CKVN[(size_t)row * 128 + lane + 64] = (bf16_t)f2bf(b * r * kvg[lane + 64]);
}

__device__ __forceinline__ void sb_naive_wave(const bf16_t* PROJ, bf16_t* MIX, int blk, int lane) {
    const int chunk = blk & 31, bh = blk >> 5, h = bh % 6, b = bh / 6, t = chunk * 64 + lane;
    const bf16_t* base = PROJ + (size_t)b * SEQ * LDP;
    float q[64], o[64];
    {
        const bf16_t* qp = base + (size_t)t * LDP + C_SBQ + h * 64;
#pragma unroll
        for (int d = 0; d < 64; ++d) { q[d] = bf2f(qp[d]) * 0.125f; o[d] = 0.f; }
    }
    float L = 0.f;
    const int tmax = chunk * 64 + 63;
    for (int s = tmax - 1; s >= 0; --s) {
        const bf16_t* kp = base + (size_t)s * LDP + C_SBK + h * 64;
        float z = 0.f;
#pragma unroll
        for (int d = 0; d < 64; ++d) z += q[d] * bf2f(kp[d]);
        const bool act = s < t;
        const float sp = fmaxf(z, 0.f) + log1pf(expf(-fabsf(z)));
        const float a = act ? expf((z - sp) + L) : 0.f;
        if (act) L -= sp;
        const bf16_t* vp = base + (size_t)s * LDP + C_SBV + h * 64;
#pragma unroll
        for (int d = 0; d < 64; ++d) o[d] += a * bf2f(vp[d]);
    }
    const bf16_t* gp = base + (size_t)t * LDP + C_SBG + h * 64;
    bf16_t* op = MIX + ((size_t)b * SEQ + t) * DM + h * 64;
#pragma unroll
    for (int d = 0; d < 64; ++d) { const float g = bf2f(gp[d]); op[d] = (bf16_t)f2bf(o[d] * (g / (1.f + expf(-g)))); }
}

__device__ __forceinline__ unsigned ordkey(float f) { unsigned u = __float_as_uint(f); return (u & 0x80000000u) ? ~u : (u | 0x80000000u); }
__device__ __forceinline__ void sel_naive_wave(const bf16_t* PROJ, unsigned* MASK, int gq, int lane, LAS unsigned char* wl) {
    LAS float* iq = (LAS float*)wl; LAS float* iw = (LAS float*)(wl + 1024); LAS unsigned long long* bal = (LAS unsigned long long*)(wl + 1280); LAS unsigned* scl = (LAS unsigned*)(wl + 2048);
    const int b = gq >> 11, t = gq & 2047;
    const bf16_t* row = PROJ + ((size_t)b * SEQ + t) * LDP;
    for (int i = lane; i < 256; i += 64) iq[i] = bf2f(row[C_IDQ + i]);
    if (lane < 8) iw[lane] = bf2f(row[C_IDW + lane]) * 0.0625f;
    WAVE_SYNC();
    for (int j = 0; j < 32; ++j) {
        unsigned kv = 0u;
        if (j * 64 <= t) {
            const int s = j * 64 + lane;
            const bf16_t* kr = PROJ + ((size_t)b * SEQ + s) * LDP + C_IDK;
            float kd[32];
#pragma unroll
            for (int d = 0; d < 32; ++d) kd[d] = bf2f(kr[d]);
            float acc = 0.f;
            unsigned iqo = 0; asm volatile("" : "+v"(iqo));
            const LAS float* iqj = iq + iqo;
#pragma unroll 1
            for (int hh = 0; hh < 8; ++hh) {
                float dt = 0.f;
#pragma unroll
                for (int d = 0; d < 32; ++d) dt += iqj[hh * 32 + d] * kd[d];
                acc += iw[hh] * fmaxf(dt, 0.f);
            }
            kv = (s <= t) ? ordkey(acc) : 0u;
        }
        scl[j * 64 + lane] = kv;
    }
    WAVE_SYNC();
    unsigned key[32];
#pragma unroll
    for (int j = 0; j < 32; ++j) key[j] = scl[j * 64 + lane];
    const bool need_sel = (t + 1) > 256;
    unsigned tau = 0u; int need = 0;
    if (need_sel) {
        unsigned prefix = 0u;
        for (int bit = 31; bit >= 0; --bit) {
            const unsigned cand = prefix | (1u << bit);
            int cnt = 0;
#pragma unroll
            for (int j = 0; j < 32; ++j) cnt += __popcll(__ballot(key[j] >= cand));
            if (cnt >= 256) prefix = cand;
        }
        tau = prefix;
        int cgt = 0;
#pragma unroll
        for (int j = 0; j < 32; ++j) cgt += __popcll(__ballot(key[j] > tau));
        need = 256 - cgt;
    }
    int tiesbefore = 0;
    const unsigned long long lt_mask = (lane == 0) ? 0ull : (~0ull >> (64 - lane));
#pragma unroll
    for (int j = 0; j < 32; ++j) {
        bool sel;
        if (!need_sel) sel = (j * 64 + lane) <= t;
        else {
            const bool gt = key[j] > tau, eq = key[j] == tau;
            const unsigned long long be = __ballot(eq);
            const int rank = tiesbefore + __popcll(be & lt_mask);
            sel = gt || (eq && rank < need);
            tiesbefore += __popcll(be);
        }
        const unsigned long long bs = __ballot(sel);
        if (lane == 0) bal[j] = bs;
    }
    WAVE_SYNC();
    {
        const int kt = lane;
        const unsigned long long bb = bal[kt >> 1];
        const unsigned nat = (unsigned)(bb >> (32 * (kt & 1)));
        unsigned w = 0u;
#pragma unroll
        for (int n = 0; n < 8; ++n) { const unsigned nib = (nat >> (4 * n)) & 0xfu; const int on = 4 * (n & 1) + (n >> 1); w |= nib << (4 * on); }
        MASK[((((size_t)b * 64 + (t >> 5)) * 64 + kt) * 32) + (t & 31)] = w;
    }
    WAVE_SYNC();
}

__device__ __forceinline__ void dsa_naive_wave(const bf16_t* PROJ, const bf16_t* CKVN, const unsigned* MASK, const float* w_uk, const float* w_uv,
                                               const float* rel_bias, bf16_t* MIX, int blk, int lane, LAS float* ql) {
    const int chunk = blk & 31, bh = blk >> 5, h = bh % 6, b = bh / 6, t = chunk * 64 + lane;
    {
        float q[64];
        const bf16_t* qp = PROJ + ((size_t)b * SEQ + t) * LDP + C_DSQ + h * 64;
#pragma unroll
        for (int d = 0; d < 64; ++d) q[d] = bf2f(qp[d]);
        for (int r = 0; r < 128; ++r) {
            const float* wp = w_uk + ((size_t)r * 6 + h) * 64;
            float a = 0.f;
#pragma unroll
            for (int d = 0; d < 64; ++d) a += q[d] * wp[d];
            ql[r * 64 + lane] = a * 0.125f;
        }
    }
    WAVE_SYNC();
    float o[128];
#pragma unroll
    for (int r = 0; r < 128; ++r) o[r] = 0.f;
    float m = -INFINITY, l = 0.f;
    const int tmax = chunk * 64 + 63, qt = t >> 5;
    for (int kt = 0; kt <= (tmax >> 5); ++kt) {
        unsigned w = 0u;
        if (kt <= qt) w = MASK[((((size_t)b * 64 + qt) * 64 + kt) * 32) + (t & 31)];
        for (int i = 0; i < 32; ++i) {
            const int hf = (i >> 2) & 1, a8 = i >> 3, c = i & 3, bit = 16 * hf + 4 * a8 + c;
            const bool sel = (w >> bit) & 1u;
            if (!__any(sel)) continue;
            const int s = kt * 32 + i;
            const bf16_t* cr = CKVN + ((size_t)b * SEQ + s) * 128;
            float lg = 0.f;
            for (int r = 0; r < 128; ++r) lg += ql[r * 64 + lane] * bf2f(cr[r]);
            int rel = t - s; rel = rel < 0 ? 0 : rel;
            const int bk = rel < 128 ? (int)T5TAB[rel] : 31;
            lg += rel_bias[bk * 6 + h];
            if (sel) {
                const float mn = fmaxf(m, lg), sc = expf(m - mn), p = expf(lg - mn);
                l = l * sc + p; m = mn;
#pragma unroll
                for (int r = 0; r < 128; ++r) o[r] = o[r] * sc + p * bf2f(cr[r]);
            }
        }
    }
    const float il = 1.f / l;
    WAVE_SYNC();
#pragma unroll
    for (int r = 0; r < 128; ++r) ql[r * 64 + lane] = o[r] * il;
    WAVE_SYNC();
    const bf16_t* gp = PROJ + ((size_t)b * SEQ + t) * LDP + C_DSG + h * 64;
    bf16_t* op = MIX + ((size_t)b * SEQ + t) * DM + 384 + h * 64;
    for (int d0 = 0; d0 < 64; d0 += 16) {
        float acc[16];
#pragma unroll
        for (int j = 0; j < 16; ++j) acc[j] = 0.f;
        for (int r = 0; r < 128; ++r) {
            const float ol = ql[r * 64 + lane];
            const float* wp = w_uv + ((size_t)r * 6 + h) * 64 + d0;
#pragma unroll
            for (int j = 0; j < 16; ++j) acc[j] += ol * wp[j];
        }
#pragma unroll
        for (int j = 0; j < 16; ++j) { const float g = bf2f(gp[d0 + j]); op[d0 + j] = (bf16_t)f2bf(acc[j] * (g / (1.f + expf(-g)))); }
    }
    WAVE_SYNC();
}

__device__ __forceinline__ void mem_naive_wave(const bf16_t* PROJ, const bf16_t* MEMKV  , bf16_t* MIX, int blk, int lane) {
    const int chunk = blk & 31, bh = blk >> 5, h = bh & 3, b = bh >> 2, t = chunk * 64 + lane;
    float q[64], o[64];
    const bf16_t* qp = PROJ + ((size_t)b * SEQ + t) * LDP + C_MQ + h * 64;
#pragma unroll
    for (int d = 0; d < 64; ++d) { q[d] = bf2f(qp[d]) * 0.125f; o[d] = 0.f; }
    float m = -INFINITY, l = 0.f;
    for (int s = 0; s < NMEM; ++s) {
        const bf16_t* kp = MEMKV + ((size_t)b * NMEM + s) * 1024 + h * 64;
        float z = 0.f;
#pragma unroll
        for (int d = 0; d < 64; ++d) z += q[d] * bf2f(kp[d]);
        const float mn = fmaxf(m, z), sc = expf(m - mn), p = expf(z - mn);
        l = l * sc + p; m = mn;
        const bf16_t* vp = kp + 256;
#pragma unroll
        for (int d = 0; d < 64; ++d) o[d] = o[d] * sc + p * bf2f(vp[d]);
    }
    const float il = 1.f / l;
    const bf16_t* gp = PROJ + ((size_t)b * SEQ + t) * LDP + C_MG + h * 64;
    bf16_t* op = MIX + ((size_t)b * SEQ + t) * DM + 768 + h * 64;
#pragma unroll
    for (int d = 0; d < 64; ++d) { const float g = bf2f(gp[d]); op[d] = (bf16_t)f2bf(o[d] * il * (g / (1.f + expf(-g)))); }
}

__device__ __forceinline__ void post_row(const float* xin, const bf16_t* Y, const float* g, float* xout, bf16_t* Hn, int row, int lane) {
    const bf16_t* yp = Y + (size_t)row * DM;
    float yv[16]; float s = 0.f;
#pragma unroll
    for (int j = 0; j < 4; ++j) {
        const v2u v = *(const v2u*)(yp + (lane + 64 * j) * 4);
        yv[4 * j + 0] = __uint_as_float(v.x << 16); yv[4 * j + 1] = __uint_as_float(v.x & 0xffff0000u);
        yv[4 * j + 2] = __uint_as_float(v.y << 16); yv[4 * j + 3] = __uint_as_float(v.y & 0xffff0000u);
        s += yv[4 * j] * yv[4 * j] + yv[4 * j + 1] * yv[4 * j + 1] + yv[4 * j + 2] * yv[4 * j + 2] + yv[4 * j + 3] * yv[4 * j + 3];
    }
    const float r = 1.0f / sqrtf(wave_sum(s) * (1.0f / DM) + EPS);
    f32x4 ov[4]; float s2 = 0.f;
#pragma unroll
    for (int j = 0; j < 4; ++j) {
        const int c = (lane + 64 * j) * 4;
        const f32x4 xv = *(const f32x4*)(xin + (size_t)row * DM + c);
        const f32x4 gv = *(const f32x4*)(g + c);
        ov[j].x = xv.x + yv[4 * j] * r * gv.x; ov[j].y = xv.y + yv[4 * j + 1] * r * gv.y; ov[j].z = xv.z + yv[4 * j + 2] * r * gv.z; ov[j].w = xv.w + yv[4 * j + 3] * r * gv.w;
        *(f32x4*)(xout + (size_t)row * DM + c) = ov[j];
        s2 += (ov[j].x * ov[j].x + ov[j].y * ov[j].y) + (ov[j].z * ov[j].z + ov[j].w * ov[j].w);
    }
    if (Hn) {
        const float r2 = 1.0f / sqrtf(wave_sum(s2) * (1.f / DM) + EPS);
        v2u* o8 = (v2u*)(Hn + (size_t)row * DM) + lane;
#pragma unroll
        for (int j = 0; j < 4; ++j) { v2u w; w.x = pk2(ov[j].x * r2, ov[j].y * r2); w.y = pk2(ov[j].z * r2, ov[j].w * r2); o8[64 * j] = w; }
    }
}

typedef short bf16x8 __attribute__((ext_vector_type(8)));
typedef short s16x4 __attribute__((ext_vector_type(4)));
typedef float f32x16 __attribute__((ext_vector_type(16)));
typedef float f32x2_t __attribute__((ext_vector_type(2)));
typedef __bf16 bf16x2_t __attribute__((ext_vector_type(2)));
#define MFMA32(a, b, c) __builtin_amdgcn_mfma_f32_32x32x16_bf16((a), (b), (c), 0, 0, 0)
__device__ __forceinline__ unsigned cvtpk(float lo, float hi) { f32x2_t v = {lo, hi}; bf16x2_t b = __builtin_convertvector(v, bf16x2_t); return __builtin_bit_cast(unsigned, b); }
__device__ __forceinline__ s16x4 vtr(const LAS unsigned char* p) { return __builtin_bit_cast(s16x4, __builtin_amdgcn_ds_read_tr16_b64_v4i16((LAS s16x4*)p)); }
__device__ __forceinline__ int crow(int r, int hi) { return (r & 3) + 8 * (r >> 2) + 4 * hi; }
__device__ __forceinline__ bf16x8 pack8(const f32x16& x, int s) {
    v4u p; p.x = cvtpk(x[8 * s + 0], x[8 * s + 1]); p.y = cvtpk(x[8 * s + 2], x[8 * s + 3]); p.z = cvtpk(x[8 * s + 4], x[8 * s + 5]); p.w = cvtpk(x[8 * s + 6], x[8 * s + 7]);
    return __builtin_bit_cast(bf16x8, p);
}
__device__ __forceinline__ bf16x8 cat44(s16x4 lo, s16x4 hi) { return __builtin_shufflevector(lo, hi, 0, 1, 2, 3, 4, 5, 6, 7); }
constexpr int VT_PITCH = 192;
constexpr float LOG2E = 1.4426950408889634f;

__device__ __forceinline__ void pv_tile(f32x16 (&O)[2], const LAS unsigned char* vrd, bf16x8 p0, bf16x8 p1) {
#pragma unroll
    for (int c = 0; c < 2; ++c) {
        const bf16x8 a0 = cat44(vtr(vrd + 0 * VT_PITCH + 64 * c), vtr(vrd + 8 * VT_PITCH + 64 * c));
        const bf16x8 a1 = cat44(vtr(vrd + 16 * VT_PITCH + 64 * c), vtr(vrd + 24 * VT_PITCH + 64 * c));
        O[c] = MFMA32(a0, p0, O[c]);
        O[c] = MFMA32(a1, p1, O[c]);
    }
}
__device__ __forceinline__ void gate_store(const f32x16 (&O)[2], float scale, const bf16_t* grow, bf16_t* orow, int hi) {
#pragma unroll
    for (int c = 0; c < 2; ++c)
#pragma unroll
        for (int g = 0; g < 4; ++g) {
            const int d = 32 * c + 8 * g + 4 * hi;
            const v2u gv = *(const v2u*)(grow + d);
            float gt[4] = {__uint_as_float(gv.x << 16), __uint_as_float(gv.x & 0xffff0000u), __uint_as_float(gv.y << 16), __uint_as_float(gv.y & 0xffff0000u)};
            float ov[4];
#pragma unroll
            for (int j = 0; j < 4; ++j) ov[j] = O[c][4 * g + j] * scale * gt[j] * __builtin_amdgcn_rcpf(1.f + __builtin_amdgcn_exp2f(-gt[j] * LOG2E));
            v2u w; w.x = cvtpk(ov[0], ov[1]); w.y = cvtpk(ov[2], ov[3]);
            *(v2u*)(orow + d) = w;
        }
}

__device__ __forceinline__ void sb_item(const bf16_t* PROJ, bf16_t* MIX, int b, int h, int qt, int lane, LAS unsigned char* wl) {
    asm volatile("" : "+v"(lane));
    const int r32 = lane & 31, hi = lane >> 5;
    const bf16_t* base = PROJ + (size_t)b * SEQ * LDP;
    const int t = 32 * qt + r32;
    bf16x8 qf[4];
#pragma unroll
    for (int ks = 0; ks < 4; ++ks) qf[ks] = *(const bf16x8*)(base + (size_t)t * LDP + C_SBQ + h * 64 + 16 * ks + 8 * hi);
    const int vrow = lane >> 3, vch = lane & 7;
    LAS unsigned char* vwr = wl + vrow * VT_PITCH + vch * 16;
    const LAS unsigned char* vrd = wl + (4 * hi + ((lane & 15) >> 2)) * VT_PITCH + (16 * ((lane >> 4) & 1) + 4 * (lane & 3)) * 2;
    bf16x8 kc[4], vc[4];
    {
        const bf16_t* kp = base + (size_t)(32 * qt + r32) * LDP + C_SBK + h * 64 + 8 * hi;
#pragma unroll
        for (int ks = 0; ks < 4; ++ks) kc[ks] = *(const bf16x8*)(kp + 16 * ks);
        const bf16_t* vp = base + (size_t)(32 * qt + vrow) * LDP + C_SBV + h * 64 + 8 * vch;
#pragma unroll
        for (int i = 0; i < 4; ++i) vc[i] = *(const bf16x8*)(vp + (size_t)(8 * i) * LDP);
    }
    f32x16 O[2];
#pragma unroll
    for (int r = 0; r < 16; ++r) { O[0][r] = 0.f; O[1][r] = 0.f; }
    float R = 1.f;
    for (int kt = qt; kt >= 0; --kt) {
        bf16x8 kn[4], vn[4];
        {
            const int ktn = kt > 0 ? kt - 1 : 0;
            const bf16_t* kp = base + (size_t)(32 * ktn + r32) * LDP + C_SBK + h * 64 + 8 * hi;
#pragma unroll
            for (int ks = 0; ks < 4; ++ks) kn[ks] = *(const bf16x8*)(kp + 16 * ks);
            const bf16_t* vp = base + (size_t)(32 * ktn + vrow) * LDP + C_SBV + h * 64 + 8 * vch;
#pragma unroll
            for (int i = 0; i < 4; ++i) vn[i] = *(const bf16x8*)(vp + (size_t)(8 * i) * LDP);
        }
        f32x16 acc;
#pragma unroll
        for (int r = 0; r < 16; ++r) acc[r] = 0.f;
#pragma unroll
        for (int ks = 0; ks < 4; ++ks) acc = MFMA32(kc[ks], qf[ks], acc);
#pragma unroll
        for (int i = 0; i < 4; ++i) *(LAS bf16x8*)(vwr + (8 * i) * VT_PITCH) = vc[i];
        float be[16], om[16];
        const bool diag = (kt == qt);
#pragma unroll
        for (int r = 0; r < 16; ++r) {
            const float e = __builtin_amdgcn_exp2f(fminf(acc[r] * (-0.125f * LOG2E), 115.f));
            float bt = __builtin_amdgcn_rcpf(1.f + e), o1 = e * bt;
            if (diag && !(crow(r, hi) < r32)) { bt = 0.f; o1 = 1.f; }
            be[r] = bt; om[r] = o1;
        }
        float Gp[4], Gq[4];
#pragma unroll
        for (int g = 0; g < 4; ++g) { Gp[g] = (om[4 * g] * om[4 * g + 1]) * (om[4 * g + 2] * om[4 * g + 3]); Gq[g] = __shfl_xor(Gp[g], 32); }
        const float T1 = Gp[1] * Gq[1], T2 = Gp[2] * Gq[2], T3 = Gp[3] * Gq[3], T0 = Gp[0] * Gq[0];
        float tail[4]; tail[3] = R; tail[2] = R * T3; tail[1] = tail[2] * T2; tail[0] = tail[1] * T1;
        const float Rn = tail[0] * T0;
#pragma unroll
        for (int g = 0; g < 4; ++g) {
            float sfx = tail[g] * (hi == 0 ? Gq[g] : 1.f);
            acc[4 * g + 3] = be[4 * g + 3] * sfx; sfx *= om[4 * g + 3];
            acc[4 * g + 2] = be[4 * g + 2] * sfx; sfx *= om[4 * g + 2];
            acc[4 * g + 1] = be[4 * g + 1] * sfx; sfx *= om[4 * g + 1];
            acc[4 * g + 0] = be[4 * g + 0] * sfx;
        }
        R = Rn;
        const bf16x8 p0 = pack8(acc, 0), p1 = pack8(acc, 1);
        pv_tile(O, vrd, p0, p1);
        if (__all(R < 7.8886e-31f)) break;
#pragma unroll
        for (int i = 0; i < 4; ++i) { kc[i] = kn[i]; vc[i] = vn[i]; }
    }
    gate_store(O, 1.f, base + (size_t)t * LDP + C_SBG + h * 64, MIX + ((size_t)b * SEQ + t) * DM + h * 64, hi);
}

__device__ __forceinline__ void mem_item(const bf16_t* PROJ, const bf16_t* KV, bf16_t* MIX, int b, int h, int qt, int lane, LAS unsigned char* wl) {
    asm volatile("" : "+v"(lane));
    const int r32 = lane & 31, hi = lane >> 5;
    const int t = 32 * qt + r32;
    const bf16_t* prow = PROJ + ((size_t)b * SEQ + t) * LDP;
    bf16x8 qf[4];
#pragma unroll
    for (int ks = 0; ks < 4; ++ks) qf[ks] = *(const bf16x8*)(prow + C_MQ + h * 64 + 16 * ks + 8 * hi);
    const int vrow = lane >> 3, vch = lane & 7;
    LAS unsigned char* vwr = wl + vrow * VT_PITCH + vch * 16;
    const LAS unsigned char* vrd = wl + (4 * hi + ((lane & 15) >> 2)) * VT_PITCH + (16 * ((lane >> 4) & 1) + 4 * (lane & 3)) * 2;
    const bf16_t* kvb = KV + (size_t)b * NMEM * 1024 + h * 64;
    f32x16 O[2];
#pragma unroll
    for (int r = 0; r < 16; ++r) { O[0][r] = 0.f; O[1][r] = 0.f; }
    float mrun = -INFINITY, lrun = 0.f;
    for (int kt = 0; kt < NMEM / 32; ++kt) {
        bf16x8 kc[4], vc[4];
        const bf16_t* kp = kvb + (size_t)(32 * kt + r32) * 1024 + 8 * hi;
#pragma unroll
        for (int ks = 0; ks < 4; ++ks) kc[ks] = *(const bf16x8*)(kp + 16 * ks);
        const bf16_t* vp = kvb + (size_t)(32 * kt + vrow) * 1024 + 256 + 8 * vch;
#pragma unroll
        for (int i = 0; i < 4; ++i) vc[i] = *(const bf16x8*)(vp + (size_t)(8 * i) * 1024);
        f32x16 acc;
#pragma unroll
        for (int r = 0; r < 16; ++r) acc[r] = 0.f;
#pragma unroll
        for (int ks = 0; ks < 4; ++ks) acc = MFMA32(kc[ks], qf[ks], acc);
#pragma unroll
        for (int i = 0; i < 4; ++i) *(LAS bf16x8*)(vwr + (8 * i) * VT_PITCH) = vc[i];
        float mx = acc[0];
#pragma unroll
        for (int r = 1; r < 16; ++r) mx = fmaxf(mx, acc[r]);
        mx *= 0.125f * LOG2E;
        mx = fmaxf(mx, __shfl_xor(mx, 32));
        const float mn = fmaxf(mrun, mx), alpha = __builtin_amdgcn_exp2f(mrun - mn);
        float ps = 0.f;
#pragma unroll
        for (int r = 0; r < 16; ++r) { acc[r] = __builtin_amdgcn_exp2f(acc[r] * (0.125f * LOG2E) - mn); ps += acc[r]; }
        lrun = lrun * alpha + ps; mrun = mn;
#pragma unroll
        for (int r = 0; r < 16; ++r) { O[0][r] *= alpha; O[1][r] *= alpha; }
        const bf16x8 p0 = pack8(acc, 0), p1 = pack8(acc, 1);
        pv_tile(O, vrd, p0, p1);
    }
    const float lt = lrun + __shfl_xor(lrun, 32);
    gate_store(O, 1.f / lt, prow + C_MG + h * 64, MIX + ((size_t)b * SEQ + t) * DM + 768 + h * 64, hi);
}

constexpr int SEL_IQ_PITCH = 528, SEL_CNT_OFF = 17408;
__device__ __forceinline__ unsigned ordkey(float f);
template <int PRED  >
__device__ __forceinline__ unsigned sel_count_round(const unsigned (&key)[8][16], unsigned c, unsigned tau, int idx0, int r32, int hi, int wave, LAS unsigned* cb) {
    int n = 0;
#pragma unroll
    for (int i = 0; i < 8; ++i) {
#pragma unroll
        for (int r = 0; r < 16; ++r) {
            if (PRED == 0) n += (key[i][r] >= c) ? 1 : 0;
            else if (PRED == 1) n += (key[i][r] > c) ? 1 : 0;
            else n += (key[i][r] == tau && (unsigned)(idx0 + 256 * i + (r & 3) + 8 * (r >> 2)) <= c) ? 1 : 0;
            if ((r & 7) == 7) asm volatile("" : "+v"(n));
        }
    }
    n += __shfl_xor(n, 32);
    if (hi == 0) cb[wave * 32 + r32] = (unsigned)n;
    __syncthreads();
    unsigned tot = 0;
#pragma unroll
    for (int w = 0; w < 8; ++w) tot += cb[w * 32 + r32];
    return tot;
}
__device__ __forceinline__ void sel_item(const bf16_t* PROJ, unsigned* MASK, int b, int qt, int lane, int wave, LAS unsigned char* L) {
    asm volatile("" : "+v"(lane));
    const int r32 = lane & 31, hi = lane >> 5, tid = wave * 64 + lane;
    LAS unsigned* cntb = (LAS unsigned*)(L + SEL_CNT_OFF);
    const bf16_t* base = PROJ + (size_t)b * SEQ * LDP;
    unsigned* mrow = MASK + (((size_t)b * 64 + qt) * 64) * 32;
    const bool need_sel = qt >= 8;
    if (!need_sel) {
#pragma unroll
        for (int i = 0; i < 8; ++i) {
            const int kt = wave + 8 * i;
            if (kt <= qt) {
                unsigned bits = 0u;
#pragma unroll
                for (int r = 0; r < 16; ++r) bits |= ((kt < qt) || (crow(r, hi) <= r32)) ? (1u << r) : 0u;
                const unsigned other = __shfl_xor(bits, 32);
                if (hi == 0) mrow[kt * 32 + r32] = bits | (other << 16);
            }
        }
        return;
    }
    for (int n = tid; n < 1024; n += 512) { const int row = n >> 5, ch = n & 31;
        const v4u v = *(const v4u*)(base + (size_t)(32 * qt + row) * LDP + C_IDQ + ch * 8);
        *(LAS v4u*)(L + row * SEL_IQ_PITCH + ch * 16) = v; }
    float w8[8];
    { const v4u wv = *(const v4u*)(base + (size_t)(32 * qt + r32) * LDP + C_IDW);
      w8[0] = __uint_as_float(wv.x << 16) * 0.0625f; w8[1] = __uint_as_float(wv.x & 0xffff0000u) * 0.0625f; w8[2] = __uint_as_float(wv.y << 16) * 0.0625f; w8[3] = __uint_as_float(wv.y & 0xffff0000u) * 0.0625f;
      w8[4] = __uint_as_float(wv.z << 16) * 0.0625f; w8[5] = __uint_as_float(wv.z & 0xffff0000u) * 0.0625f; w8[6] = __uint_as_float(wv.w << 16) * 0.0625f; w8[7] = __uint_as_float(wv.w & 0xffff0000u) * 0.0625f; }
    __syncthreads();
    unsigned key[8][16];
    const LAS unsigned char* iqp = L + r32 * SEL_IQ_PITCH + 16 * hi;
#pragma unroll
    for (int i = 0; i < 8; ++i) {
        const int kt = wave + 8 * i;
        const bf16_t* kp = base + (size_t)(32 * kt + r32) * LDP + C_IDK + 8 * hi;
        const bf16x8 k0 = *(const bf16x8*)kp, k1 = *(const bf16x8*)(kp + 16);
        float sc[16];
#pragma unroll
        for (int r = 0; r < 16; ++r) sc[r] = 0.f;
        unsigned iqo = 0; asm volatile("" : "+v"(iqo));
        const LAS unsigned char* iqt = iqp + iqo;
#pragma unroll
        for (int h = 0; h < 8; ++h) {
            const bf16x8 q0 = *(const LAS bf16x8*)(iqt + h * 64), q1 = *(const LAS bf16x8*)(iqt + h * 64 + 32);
            bf16x8 q0p = q0, q1p = q1;
            asm volatile("" : "+v"(q0p), "+v"(q1p) : "v"(sc[15]));
            f32x16 D;
#pragma unroll
            for (int r = 0; r < 16; ++r) D[r] = 0.f;
            D = MFMA32(k0, q0p, D); D = MFMA32(k1, q1p, D);
#pragma unroll
            for (int r = 0; r < 16; ++r) sc[r] += w8[h] * fmaxf(D[r], 0.f);
            asm volatile("" : "+v"(sc[0]), "+v"(sc[1]), "+v"(sc[2]), "+v"(sc[3]), "+v"(sc[4]), "+v"(sc[5]), "+v"(sc[6]), "+v"(sc[7]),
                              "+v"(sc[8]), "+v"(sc[9]), "+v"(sc[10]), "+v"(sc[11]), "+v"(sc[12]), "+v"(sc[13]), "+v"(sc[14]), "+v"(sc[15]));
        }
        int thr = (kt < qt) ? 64 : ((kt == qt) ? (r32 - 4 * hi) : -1);
        asm volatile("" : "+v"(thr));
#pragma unroll
        for (int r = 0; r < 16; ++r) key[i][r] = ((r & 3) + 8 * (r >> 2) <= thr) ? ordkey(sc[r]) : 0u;
    }
    unsigned prefix = 0u, cge = 0u;
    for (int bit = 31; bit >= 0; --bit) {
        const unsigned cand = prefix | (1u << bit);
        const unsigned tot = sel_count_round<0>(key, cand, 0u, 0, r32, hi, wave, cntb + (bit & 1) * 256);
        if (tot >= 256u) { prefix = cand; cge = tot; }
    }
    const unsigned tau = prefix;
    unsigned cut = 0xffffffffu;
    if (__any(cge != 256u)) {
        const unsigned cgt = sel_count_round<1>(key, tau, 0u, 0, r32, hi, wave, cntb);
        const unsigned need = 256u - cgt;
        const int idx0 = 32 * wave + 4 * hi;
        unsigned lo_ = 0u, hi_ = 2047u;
        for (int it = 0; it < 11; ++it) {
            const unsigned mid = (lo_ + hi_) >> 1;
            const unsigned f = sel_count_round<2>(key, mid, tau, idx0, r32, hi, wave, cntb + ((it + 1) & 1) * 256);
            if (f >= need) hi_ = mid; else lo_ = mid + 1;
        }
        cut = hi_;
    }
    {
        const int idx0 = 32 * wave + 4 * hi;
#pragma unroll
        for (int i = 0; i < 8; ++i) {
            const int kt = wave + 8 * i;
            if (kt <= qt) {
                unsigned bits = 0u;
#pragma unroll
                for (int r = 0; r < 16; ++r) {
                    const bool s = (key[i][r] > tau) || (key[i][r] == tau && (unsigned)(idx0 + 256 * i + (r & 3) + 8 * (r >> 2)) <= cut);
                    bits |= s ? (1u << r) : 0u;
                }
                const unsigned other = __shfl_xor(bits, 32);
                if (hi == 0) mrow[kt * 32 + r32] = bits | (other << 16);
            }
        }
    }
    __syncthreads();
}

constexpr int WS_WUK = 0;
constexpr int WS_WUV = 256 * 1024;
constexpr int DSA_BIAS_OFF = 16384;
__device__ __forceinline__ unsigned dsa_off(unsigned row, unsigned ch) { return 256u * row + 16u * (ch ^ (((row & 3u) << 2) | ((row >> 2) & 3u))); }
__device__ __forceinline__ void dsa_round(const bf16_t* PROJ, const bf16_t* CKVN, const unsigned* MASK, const bf16_t* WUKp  , const bf16_t* WUVp  ,
                                          const float* rel_bias, bf16_t* MIX, int b, int o, int h, int lane, int wave, LAS unsigned char* L) {
    asm volatile("" : "+v"(lane));
    const int r32 = lane & 31, hi = lane >> 5, tid = wave * 64 + lane;
    const int qt = 8 * o + wave, KT = 8 * o + 7, t = 32 * qt + r32;
    LAS float* biasT = (LAS float*)(L + DSA_BIAS_OFF);
    if (tid < 192) { const int bk = tid < 128 ? (int)T5TAB[tid] : 31; biasT[tid] = rel_bias[bk * 6 + h] * LOG2E; }
    const float bias31 = rel_bias[31 * 6 + h] * LOG2E;
    bf16x8 qlf[8];
    {
        const bf16_t* qrow = PROJ + ((size_t)b * SEQ + t) * LDP + C_DSQ + h * 64 + 8 * hi;
        bf16x8 qf[4];
#pragma unroll
        for (int ks = 0; ks < 4; ++ks) qf[ks] = *(const bf16x8*)(qrow + 16 * ks);
#pragma unroll
        for (int rt = 0; rt < 4; ++rt) {
            f32x16 X;
#pragma unroll
            for (int r = 0; r < 16; ++r) X[r] = 0.f;
            const bf16_t* wp = WUKp + (rt * 32 + r32) * 64 + 8 * hi;
#pragma unroll
            for (int ks = 0; ks < 4; ++ks) X = MFMA32(*(const bf16x8*)(wp + 16 * ks), qf[ks], X);
#pragma unroll
            for (int r = 0; r < 16; ++r) X[r] *= 0.125f * LOG2E;
            qlf[2 * rt] = pack8(X, 0); qlf[2 * rt + 1] = pack8(X, 1);
        }
    }
    f32x16 O[4];
#pragma unroll
    for (int c = 0; c < 4; ++c)
#pragma unroll
        for (int r = 0; r < 16; ++r) O[c][r] = 0.f;
    float mrun = -INFINITY, lrun = 0.f;
    const int srow = tid >> 4, sch = tid & 15;
    const bf16_t* csrc = CKVN + ((size_t)b * SEQ + srow) * 128 + 8 * sch;
    const unsigned sdst = dsa_off(srow, sch);
    const unsigned rrd = 256u * r32;
    const unsigned rx = (((unsigned)r32 & 3u) << 2) | (((unsigned)r32 >> 2) & 3u);
    const unsigned tq = (lane & 15) >> 2, tp = lane & 3, tblk = (lane >> 4) & 1;
    const unsigned* mrow = MASK + (((size_t)b * 64 + qt) * 64) * 32 + r32;
    {
        const v4u v0 = *(const v4u*)csrc;
        *(LAS v4u*)(L + sdst) = v0;
    }
    unsigned mwn = mrow[0];
    for (int kt = 0; kt <= KT; ++kt) {
        v4u vn;
        if (kt < KT) vn = *(const v4u*)(csrc + (size_t)(32 * (kt + 1)) * 128);
        const unsigned mwc = mwn;
        if (kt < qt) mwn = mrow[(kt + 1) * 32];
        __syncthreads();
        const LAS unsigned char* Cb = L + (kt & 1) * 8192;
        if (kt <= qt) {
            f32x16 S;
#pragma unroll
            for (int r = 0; r < 16; ++r) S[r] = 0.f;
#pragma unroll
            for (int ks = 0; ks < 8; ++ks) {
                const bf16x8 a = *(const LAS bf16x8*)(Cb + rrd + 16u * ((unsigned)(2 * ks + hi) ^ rx));
                S = MFMA32(a, qlf[ks], S);
            }
            const unsigned mw = mwc >> (16 * hi);
            const int dq = qt - kt;
            if (dq >= 5) {
#pragma unroll
                for (int r = 0; r < 16; ++r) S[r] = ((mw >> r) & 1u) ? S[r] + bias31 : -INFINITY;
            } else {
                const int rel0 = 32 * dq + r32 - 4 * hi;
#pragma unroll
                for (int r = 0; r < 16; ++r) {
                    int rel = rel0 - ((r & 3) + 8 * (r >> 2)); rel = rel < 0 ? 0 : rel;
                    S[r] = ((mw >> r) & 1u) ? S[r] + biasT[rel] : -INFINITY;
                }
            }
            float mx = S[0];
#pragma unroll
            for (int r = 1; r < 16; ++r) mx = fmaxf(mx, S[r]);
            mx = fmaxf(mx, __shfl_xor(mx, 32));
            const float mn = fmaxf(mrun, mx);
            const float ms = (mn == -INFINITY) ? 0.f : mn;
            const float alpha = __builtin_amdgcn_exp2f(mrun - ms);
            float ps = 0.f;
#pragma unroll
            for (int r = 0; r < 16; ++r) { S[r] = __builtin_amdgcn_exp2f(S[r] - ms); ps += S[r]; }
            lrun = lrun * alpha + ps; mrun = mn;
#pragma unroll
            for (int c = 0; c < 4; ++c)
#pragma unroll
                for (int r = 0; r < 16; ++r) O[c][r] *= alpha;
            const bf16x8 p0 = pack8(S, 0), p1 = pack8(S, 1);
#pragma unroll
            for (int c = 0; c < 4; ++c) {
                s16x4 f[4];
#pragma unroll
                for (int st = 0; st < 4; ++st) {
                    const unsigned row = 16u * (st >> 1) + 8u * (st & 1) + 4u * hi + tq;
                    f[st] = vtr(Cb + dsa_off(row, 4u * c + 2u * tblk + (tp >> 1)) + 8u * (tp & 1));
                }
                O[c] = MFMA32(cat44(f[0], f[1]), p0, O[c]);
                O[c] = MFMA32(cat44(f[2], f[3]), p1, O[c]);
            }
        }
        if (kt < KT) *(LAS v4u*)(L + ((kt + 1) & 1) * 8192 + sdst) = vn;
    }
    const float lt = lrun + __shfl_xor(lrun, 32);
    const float il = 1.f / lt;
    f32x16 Y[2];
#pragma unroll
    for (int r = 0; r < 16; ++r) { Y[0][r] = 0.f; Y[1][r] = 0.f; }
#pragma unroll
    for (int rt = 0; rt < 4; ++rt) {
#pragma unroll
        for (int r = 0; r < 16; ++r) O[rt][r] *= il;
        const bf16x8 x0 = pack8(O[rt], 0), x1 = pack8(O[rt], 1);
#pragma unroll
        for (int c = 0; c < 2; ++c) {
            const bf16_t* wp = WUVp + ((((c * 4 + rt) * 2 + 0) * 32 + r32) * 2 + hi) * 8;
            Y[c] = MFMA32(*(const bf16x8*)wp, x0, Y[c]);
            Y[c] = MFMA32(*(const bf16x8*)(wp + 32 * 2 * 8), x1, Y[c]);
        }
    }
    gate_store(Y, 1.f, PROJ + ((size_t)b * SEQ + t) * LDP + C_DSG + h * 64, MIX + ((size_t)b * SEQ + t) * DM + 384 + h * 64, hi);
    __syncthreads();
}

typedef GAS unsigned gu32;
#define RLX_AGENT __ATOMIC_RELAXED, __HIP_MEMORY_SCOPE_AGENT
constexpr size_t WS_BAR = 512 * 1024;
#define XB_TMO      128
#define XB_XCNT(j)  (256  + 64 * (j))
#define XB_XSUB(j)  (1280 + 64 * (j))
#define XB_XGEN(j)  (2304 + 64 * (j))
#define XB_TOP      3328
#define XB_TOPGEN   3392
#define XCD_BAR_WORDS 3456
#define XB_SPIN_CAP (1u << 18)

__device__ __forceinline__ unsigned xb_ld(unsigned* p)              { return __hip_atomic_load(p, __ATOMIC_RELAXED, __HIP_MEMORY_SCOPE_AGENT); }
__device__ __forceinline__ unsigned xb_add(unsigned* p, unsigned v) { return __hip_atomic_fetch_add(p, v, __ATOMIC_RELAXED, __HIP_MEMORY_SCOPE_AGENT); }
__device__ __forceinline__ unsigned xb_xcc_id() { return (unsigned)__builtin_amdgcn_s_getreg((3 << 11) | 20) & 0xFu; }
#define XB_SPIN(cond, bar) do { unsigned _sp = 0; while (cond) { __builtin_amdgcn_s_sleep(1); \
    if ((++_sp & 255u) == 0u) { if (xb_ld(&(bar)[XB_TMO])) break; if (_sp > XB_SPIN_CAP) { atomicAdd(&(bar)[XB_TMO], 1u); break; } } } } while (0)

struct XcdBarrier {
    unsigned* bar; unsigned x;
    volatile LAS unsigned* st;
};

__device__ __forceinline__ XcdBarrier xcd_barrier_post(unsigned* bar, volatile LAS unsigned* st) {
    XcdBarrier b; b.bar = bar; b.x = xb_xcc_id(); b.st = st;
    if (threadIdx.x == 0) (void)xb_add(&bar[XB_XCNT(b.x)], 1u);
    return b;
}
__device__ __forceinline__ void xcd_barrier_complete(unsigned* bar, unsigned x, unsigned& nloc, unsigned& nx) {
    const unsigned G = gridDim.x * gridDim.y * gridDim.z;
    unsigned sum, cnt, mine, sp = 0u;
    for (;;) {
        sum = 0u; cnt = 0u; mine = 0u;
#pragma unroll
        for (unsigned j = 0; j < 16; ++j) { const unsigned c = xb_ld(&bar[XB_XCNT(j)]); sum += c; cnt += (c > 0u) ? 1u : 0u; mine = (j == x) ? c : mine; }
        if (sum == G) break;
        __builtin_amdgcn_s_sleep(1);
        if ((++sp & 255u) == 0u) { if (xb_ld(&bar[XB_TMO])) break; if (sp > XB_SPIN_CAP) { atomicAdd(&bar[XB_TMO], 1u); break; } }
    }
    nloc = mine > 0u ? mine : 1u; nx = cnt > 0u ? cnt : 1u;
}

__device__ __forceinline__ void xcd_barrier(const XcdBarrier& b) {
    asm volatile("s_waitcnt vmcnt(0)" ::: "memory");
    __syncthreads();
    if (threadIdx.x == 0) {
        unsigned* bar = b.bar;
        __builtin_amdgcn_s_waitcnt(0);
        unsigned nloc = b.st[0], nx = b.st[1];
        if (nloc == 0u) { xcd_barrier_complete(bar, b.x, nloc, nx); b.st[0] = nloc; b.st[1] = nx; }
        const unsigned old = xb_add(&bar[XB_XSUB(b.x)], 1u);
        const unsigned gen = old / nloc;
        if (old + 1u == (gen + 1u) * nloc) {
            __builtin_amdgcn_fence(__ATOMIC_RELEASE, "agent");
            asm volatile("s_waitcnt vmcnt(0)" ::: "memory");
            const unsigned og = xb_add(&bar[XB_TOP], 1u);
            const unsigned tg = og / nx;
            if (og + 1u == (tg + 1u) * nx) xb_add(&bar[XB_TOPGEN], 1u);
            else XB_SPIN(xb_ld(&bar[XB_TOPGEN]) == tg, bar);
            __builtin_amdgcn_fence(__ATOMIC_ACQUIRE, "agent");
            xb_add(&bar[XB_XGEN(b.x)], 1u);
            asm volatile("s_waitcnt vmcnt(0)" ::: "memory");
        } else {
            XB_SPIN(xb_ld(&bar[XB_XGEN(b.x)]) == gen, bar);
            __builtin_amdgcn_fence(__ATOMIC_ACQUIRE, "agent");
            asm volatile("s_waitcnt vmcnt(0)" ::: "memory");
        }
    }
    __syncthreads();
}

#ifndef MK_MULTI
#define MK_MULTI 0
#endif
constexpr int NPHASE = 11;
__global__ void __launch_bounds__(NWAVES * 64, 2) mk_fwd(Args args) {
    extern __shared__ __attribute__((aligned(16))) unsigned char lds_raw[];
    LAS unsigned char* lds = (LAS unsigned char*)lds_raw;
    const int tid0 = threadIdx.x;
    const int wave = __builtin_amdgcn_readfirstlane(tid0 >> 6);
    const int G = gridDim.x, bid = blockIdx.x;
    for (int u = tid0; u < 16; u += NWAVES * 64) ((LAS unsigned*)(lds + 131072))[u] = 0u;
    __syncthreads();
    const XcdBarrier xbar = xcd_barrier_post((unsigned*)(args.ws + WS_BAR), (volatile LAS unsigned*)(lds + 131072));
    const int lo = args.ph_lo, hi = args.ph_hi;
#define IN(k) (lo <= (k) && (k) < hi)
#define SEAM(k) do { if (IN(k) && IN((k) + 1)) { if ((k) == 0) cg::this_grid().sync(); else xcd_barrier(xbar); } } while (0)
#define PH_BEGIN int lane = lane_id_v(); unsigned char* ws = args.ws; asm volatile("" : "+s"(ws)); \
    const int gw = bid * NWAVES + wave, NGW = G * NWAVES; (void)gw; (void)NGW; \
    const int vcu = (bid & 7) * (G >> 3) + (bid >> 3); const int bb = vcu >> 3, w64 = (vcu & 7) * 8 + wave; (void)bb; (void)w64;
#define P_WIN ((bf16_t*)(ws + WS_WIN))
#define P_WOUT ((bf16_t*)(ws + WS_WOUT))
#define P_WMEM ((bf16_t*)(ws + WS_WMEM))
#define P_MEMB ((bf16_t*)(ws + WS_MEMB))
#define P_MEMKV ((bf16_t*)(ws + WS_MEMKV))
#define P_CKVN ((bf16_t*)(ws + WS_CKVN))
#define P_MASK ((unsigned*)(ws + WS_MASK))
#define P_H ((bf16_t*)(ws + WS_H))
#define P_MIX ((bf16_t*)(ws + WS_MIX))
#define P_PROJ ((bf16_t*)(ws + WS_PROJ))
#define P_Y ((bf16_t*)(ws + WS_Y))

    if (IN(0)) for (int rep_ = 0; rep_ < DUPN(0); ++rep_) {
        PH_BEGIN
        const float* x = args.in[0]; const float* mem = args.in[1]; const float* pre_g = args.in[2];
        const float* w_in = args.in[4]; const float* w_mem = args.in[8]; const float* w_out = args.in[9];
        LAS float* scr = (LAS float*)(lds + wave * 16384);
        constexpr int I_IN = 16 * (LDP / 32), I_OUT = 16 * 32, I_MEM = 16 * 16;
        constexpr int NITEMS = 2 * I_IN + 2 * I_OUT + 2 * I_MEM;
        for (int it = gw; it < NITEMS; it += NGW) {
            int r = it;
            if (r < 2 * I_IN) { const int l = r / I_IN; r -= l * I_IN; p0_transpose_item(w_in + (size_t)l * DM * NCOL, DM, NCOL, LDP, P_WIN + (size_t)l * LDP * DM, pre_g + l * DM, scr, r, lane); continue; }
            r -= 2 * I_IN;
            if (r < 2 * I_OUT) { const int l = r / I_OUT; r -= l * I_OUT; p0_transpose_item(w_out + (size_t)l * DM * DM, DM, DM, DM, P_WOUT + (size_t)l * DM * DM, nullptr, scr, r, lane); continue; }
            r -= 2 * I_OUT;
            { const int l = r / I_MEM; r -= l * I_MEM; p0_transpose_item(w_mem + (size_t)l * DM * 512, DM, 512, 512, P_WMEM + (size_t)l * 512 * DM, nullptr, scr, r, lane); }
        }
        {
            const float* w_uk = args.in[5]; const float* w_uv = args.in[6];
            bf16_t* WUKp = (bf16_t*)(ws + WS_WUK); bf16_t* WUVp = (bf16_t*)(ws + WS_WUV);
            for (int e = gw * 64 + lane; e < 2 * 6 * 8192; e += NGW * 64) {
                const int lh = e >> 13, l = lh / 6, h = lh % 6, w = e & 8191;
                { const int rt = w >> 11, rho = (w >> 6) & 31, d = w & 63; const int r = 32 * rt + ((rho & 0x13) | ((rho & 4) << 1) | ((rho & 8) >> 1));
                  WUKp[e] = (bf16_t)f2bf(w_uk[(((size_t)l * 128 + r) * 6 + h) * 64 + d]); }
                { const int j = w & 7, hh = (w >> 3) & 1, d32 = (w >> 4) & 31, s = (w >> 9) & 1, rt = (w >> 10) & 3, c = (w >> 12) & 1;
                  const int r = 32 * rt + 16 * s + 8 * (j >> 2) + 4 * hh + (j & 3), d = 32 * c + d32;
                  WUVp[e] = (bf16_t)f2bf(w_uv[(((size_t)l * 128 + r) * 6 + h) * 64 + d]); }
            }
        }
        for (int m = gw; m < NB * NMEM; m += NGW) row_to_bf16<false>(mem + (size_t)m * DM, P_MEMB + (size_t)m * DM, lane);
        for (int m = gw; m < NTOK; m += NGW) row_to_bf16<true>(x + (size_t)m * DM, P_H + (size_t)m * DM, lane);
    }
    SEAM(0);
#pragma unroll 1
    for (int l = 0; l < 2; ++l) {
        const int pb = 1 + 5 * l;
        if (IN(pb)) for (int rep_ = 0; rep_ < DUPN(1); ++rep_) {
            PH_BEGIN
            { pg8::Gemm g{P_H, P_WIN + (size_t)l * LDP * DM, NTOK, LDP, DM}; pg8::StaticOrder S; S.init(NTOK, LDP, G, bid);
              pg8::EpiBf16<0> E{P_PROJ, LDP, nullptr, 0, 0, 1.f};
              pg8::gemm_phase<pg8::EpiBf16<0>, pg8::StaticOrder, true, true>(lds, g, S, E, wave); }
            if (l == 0) {
              pg8::Gemm g{P_MEMB, P_WMEM, NB * NMEM, 1024, DM}; pg8::StaticOrder S; S.init(NB * NMEM, 1024, G, bid);
              pg8::EpiBf16<0> E{P_MEMKV, 1024, nullptr, 0, 0, 1.f};
              pg8::gemm_phase<pg8::EpiBf16<0>, pg8::StaticOrder, true, true>(lds, g, S, E, wave); }
        }
        SEAM(pb);
        if (IN(pb + 1)) {
            for (int rep_ = 0; rep_ < DUPN(2); ++rep_) { PH_BEGIN
              const float* kv_g = args.in[7];
              for (int m = gw; m < NTOK; m += NGW) ckvnorm_wave(P_PROJ, kv_g + l * 128, P_CKVN, m, lane); }
#ifndef SKIP_SB
            for (int rep_ = 0; rep_ < DUPN(3); ++rep_) { PH_BEGIN
              for (int i = 0; i < 6; ++i) { const int qt = (i & 1) ? 63 - w64 : w64; sb_item(P_PROJ, P_MIX, bb, i, qt, lane, lds + wave * 16384); } }
#endif
#ifndef SKIP_SEL
            __syncthreads();
            for (int rep_ = 0; rep_ < DUPN(4); ++rep_) { PH_BEGIN
              const int s8 = vcu & 7;
              for (int j = 0; j < 8; ++j) { const int qt = 8 * j + ((j & 1) ? 7 - s8 : s8); sel_item(P_PROJ, P_MASK, bb, qt, lane, wave, lds); } }
            __syncthreads();
#endif
#ifndef SKIP_MEM
            for (int rep_ = 0; rep_ < DUPN(5); ++rep_) { PH_BEGIN
              for (int i = 0; i < 4; ++i) mem_item(P_PROJ, P_MEMKV + l * 512, P_MIX, bb, i, w64, lane, lds + wave * 16384); }
#endif
        }
        SEAM(pb + 1);
        if (IN(pb + 2)) for (int rep_ = 0; rep_ < DUPN(6); ++rep_) {
            PH_BEGIN
            const float* rel_bias = args.in[10];
            const int s8 = vcu & 7, hs = (s8 < 4) ? 0 : 3;
            __syncthreads();
            for (int oi = 0; oi < 2; ++oi) {
                const int o = oi ? 7 - (s8 & 3) : (s8 & 3);
                for (int hh = 0; hh < 3; ++hh) {
                    const int h = hs + hh;
                    dsa_round(P_PROJ, P_CKVN, P_MASK, (const bf16_t*)(ws + WS_WUK) + (size_t)(l * 6 + h) * 8192, (const bf16_t*)(ws + WS_WUV) + (size_t)(l * 6 + h) * 8192,
                              rel_bias, P_MIX, bb, o, h, lane, wave, lds);
                }
            }
        }
        SEAM(pb + 2);
        if (IN(pb + 3)) for (int rep_ = 0; rep_ < DUPN(7); ++rep_) {
            PH_BEGIN
            __syncthreads();
            pg8::Gemm g{P_MIX, P_WOUT + (size_t)l * DM * DM, NTOK, DM, DM}; pg8::StaticOrder S; S.init(NTOK, DM, G, bid);
            pg8::EpiBf16<0> E{P_Y, DM, nullptr, 0, 0, 1.f};
            pg8::gemm_phase<pg8::EpiBf16<0>, pg8::StaticOrder, true, true>(lds, g, S, E, wave);
        }
        SEAM(pb + 3);
        if (IN(pb + 4)) for (int rep_ = 0; rep_ < ((l == 0) ? DUPN(8) : 1); ++rep_) {
            PH_BEGIN
            const float* xin = (l == 0) ? args.in[0] : args.out; const float* post_g = args.in[3];
            for (int m = gw; m < NTOK; m += NGW) post_row(xin, P_Y, post_g + l * DM, args.out, (l == 0) ? P_H : (bf16_t*)nullptr, m, lane);
        }
        SEAM(pb + 4);
    }
#undef IN
#undef SEAM
}

extern "C" void kernel_launch(void* const* d_in, const int* in_sizes, int n_in, void* d_out, int out_size, void* d_ws, size_t ws_size, hipStream_t stream) {
    static int grid = 0;
    if (grid == 0) {
        if (n_in != 11 || ws_size < WS_END) { fprintf(stderr, "kernel_launch: unexpected n_in %d / ws_size %zu\n", n_in, ws_size); grid = -1; return; }
        int dev = 0, cus = 0, per_cu = 0;
        hipGetDevice(&dev);
        hipDeviceGetAttribute(&cus, hipDeviceAttributeMultiprocessorCount, dev);
        hipFuncSetAttribute((const void*)mk_fwd, hipFuncAttributeMaxDynamicSharedMemorySize, LDS_BYTES);
        hipOccupancyMaxActiveBlocksPerMultiprocessor(&per_cu, (const void*)mk_fwd, NWAVES * 64, LDS_BYTES);
        if (per_cu < 1) { fprintf(stderr, "kernel_launch: occupancy query says %d blocks per CU\n", per_cu); per_cu = 1; }
        grid = cus * 1;
        (void)hipGetLastError();
    }
    if (grid < 0) return;
    (void)hipMemsetAsync((char*)d_ws + WS_BAR, 0, 16384, stream);
    Args a{};
    for (int i = 0; i < 11; ++i) a.in[i] = (const float*)d_in[i];
    a.out = (float*)d_out; a.ws = (unsigned char*)d_ws;
#if MK_MULTI
    for (int p = 0; p < NPHASE; ++p) { a.ph_lo = p; a.ph_hi = p + 1; hipLaunchKernelGGL(mk_fwd, dim3(grid), dim3(NWAVES * 64), LDS_BYTES, stream, a); }
#else
    a.ph_lo = 0; a.ph_hi = NPHASE;
    void* kargs[] = {&a};
    hipError_t e = hipLaunchCooperativeKernel((const void*)mk_fwd, dim3(grid), dim3(NWAVES * 64), kargs, LDS_BYTES, stream);
    if (e != hipSuccess) fprintf(stderr, "cooperative launch failed: %s (grid %d)\n", hipGetErrorString(e), grid);
#endif
}
```

```cpp
#include <hip/hip_runtime.h>
#include <hip/hip_cooperative_groups.h>
#include <stdint.h>
#include <math.h>
#include <cstdio>
namespace cg = cooperative_groups;
#ifndef PROBE_DUP
#define PROBE_DUP 0
#endif
#define DUPN(k) ((PROBE_DUP >> (k)) & 1 ? 2 : 1)
__device__ __forceinline__ int lane_id_v() { int l; asm volatile("v_mbcnt_lo_u32_b32 %0, -1, 0\n\tv_mbcnt_hi_u32_b32 %0, -1, %0" : "=v"(l)); return l; }
namespace pg8 {
#define PG8_LAS __attribute__((address_space(3)))
typedef unsigned short bf16_t;
typedef short bf16x8 __attribute__((ext_vector_type(8)));
typedef float f32x4 __attribute__((ext_vector_type(4)));
typedef unsigned u32x4 __attribute__((ext_vector_type(4)));
constexpr int BM = 256, BK = 64, HALF = 128, HTB = HALF * BK * 2  , STAGE_BYTES = 8 * HTB, NXCD = 8, WGM = 8;

__host__ __device__ __forceinline__ int lds_byte(int r, int c) { const int st = (r >> 4) * 2 + (c >> 5), rr = r & 15, cc = c & 31, ob = rr * 64 + cc * 2; return st * 1024 + (ob ^ (((ob >> 9) & 1) << 5)); }
__host__ __device__ __forceinline__ void stage_rc(int b, int& R, int& C) { const int st = b / 1024, sb = b % 1024, swz = sb ^ (((sb >> 9) & 1) << 5); R = (st >> 1) * 16 + swz / 64; C = (st & 1) * 32 + (swz % 64) / 2; }
__host__ __device__ __forceinline__ int perm32(int rho) { const int n = rho >> 4, i = rho & 15; return 8 * (i >> 2) + 4 * n + (i & 3); }

struct Unit { int pm, pn; };
struct Gemm { const bf16_t* A; const bf16_t* Bt; int M, N, K; };

struct StaticOrder {
    int nM, nN, nwg, G, c;
    __host__ __device__ void init(int M, int N, int G_, int c_) { nM = M / BM; nN = N / BM; nwg = nM * nN; G = G_; c = c_; }
    __host__ __device__ bool next(int i, Unit& u) const {
        const long L = (long)i * G + c; if (L >= nwg) return false;
        int wgid = (int)L; { const int q = nwg / NXCD, r = nwg % NXCD, xcd = wgid % NXCD, off = wgid / NXCD; wgid = (xcd < r ? xcd * (q + 1) : r * (q + 1) + (xcd - r) * q) + off; }
        const int nig = WGM * nN, gid = wgid / nig, fm = gid * WGM, gsz = (nM - fm) < WGM ? (nM - fm) : WGM;
        u.pm = fm + ((wgid % nig) % gsz); u.pn = (wgid % nig) / gsz; return true;
    }
    __device__ __forceinline__ void a_ready(const Unit&) const {}
    __device__ __forceinline__ void done(const Unit&) const {}
};

__device__ __forceinline__ unsigned cvt_pk_bf16(float lo, float hi) { unsigned r; asm volatile("v_cvt_pk_bf16_f32 %0, %1, %2" : "=v"(r) : "v"(lo), "v"(hi)); return r; }
typedef float f32x2 __attribute__((ext_vector_type(2)));
__device__ __forceinline__ f32x2 gelu_pk(f32x2 v) {
    const f32x2 av = __builtin_elementwise_abs(v), d = av * 0.2316418882f + 1.0f;
    f32x2 t; t.x = __builtin_amdgcn_rcpf(d.x); t.y = __builtin_amdgcn_rcpf(d.y);
    f32x2 q = t * 0.5307027145f + (-0.7265760135f); q = q * t + 0.7107068705f; q = q * t + (-0.142248368f); q = q * t + 0.127414796f; q = q * t;
    const f32x2 s = (v * v) * (-0.72134752044f);
    f32x2 e; e.x = __builtin_amdgcn_exp2f(s.x); e.y = __builtin_amdgcn_exp2f(s.y);
    const f32x2 m = v * (q * e), r = v - m;
    f32x2 o; o.x = v.x < 0.f ? m.x : r.x; o.y = v.y < 0.f ? m.y : r.y; return o;
}

template <int ACT  > struct EpiBf16 {
    static constexpr bool PERM = true, AFTER_DRAIN = false; static_assert(ACT == 0 || ACT == 1, "EpiBf16: ACT is 0 (none) or 1 (gelu_pk)");
    bf16_t* O; int ldc; const float* bias; int split_cols; size_t split_stride; float scale0;
    __device__ __forceinline__ void operator()(const f32x4 (&acc)[2][2][4][2], const Unit& u, int wr, int wc, int fr, int fq) const {
        const int row0 = u.pm * BM + wr * 64 + fr; int colt = u.pn * BM; bf16_t* base = O;
        float sc = 1.f; if (split_cols) { const int t = colt / split_cols; base += (size_t)t * split_stride; colt -= t * split_cols; if (t == 0) sc = scale0; }
        const int col0 = colt + wc * 32 + 8 * fq, bcol0 = u.pn * BM + wc * 32 + 8 * fq;
        f32x4 bv[2][2];
#pragma unroll
        for (int bj = 0; bj < 2; ++bj)
#pragma unroll
            for (int n = 0; n < 2; ++n) bv[bj][n] = bias ? *(const f32x4*)(bias + bcol0 + bj * HALF + 4 * n) : (f32x4){0.f, 0.f, 0.f, 0.f};
#pragma unroll
        for (int ai = 0; ai < 2; ++ai)
#pragma unroll
            for (int m = 0; m < 4; ++m) { bf16_t* rowp = base + (size_t)(row0 + ai * HALF + m * 16) * ldc + col0;
#pragma unroll
                for (int bj = 0; bj < 2; ++bj) { f32x4 v0 = acc[ai][bj][m][0] + bv[bj][0], v1 = acc[ai][bj][m][1] + bv[bj][1];
                    if (ACT == 1) { f32x2 a = gelu_pk((f32x2){v0[0], v0[1]}), b = gelu_pk((f32x2){v0[2], v0[3]}), c = gelu_pk((f32x2){v1[0], v1[1]}), d = gelu_pk((f32x2){v1[2], v1[3]});
                        v0 = (f32x4){a.x, a.y, b.x, b.y}; v1 = (f32x4){c.x, c.y, d.x, d.y}; }
                    v0 = v0 * sc; v1 = v1 * sc; u32x4 w; w.x = cvt_pk_bf16(v0[0], v0[1]); w.y = cvt_pk_bf16(v0[2], v0[3]); w.z = cvt_pk_bf16(v1[0], v1[1]); w.w = cvt_pk_bf16(v1[2], v1[3]);
                    *(u32x4*)(rowp + bj * HALF) = w; } }
    }
};
template <class Epi, class Sched, bool ALIGN_EPI = false, bool SP2 = false>
__device__ __forceinline__ void gemm_phase(PG8_LAS unsigned char* lds, const Gemm g, const Sched& S, const Epi& E, int wave_id) {
    int tid_ = wave_id * 64 + lane_id_v();
    const int tid = tid_, wid = __builtin_amdgcn_readfirstlane(tid >> 6), lane = tid & 63, wr = wid >> 2, wc = wid & 3, fr = lane & 15, fq = lane >> 4;
    const int K = g.K, nt = K / BK;
    unsigned voffA[2], voffB[2];
#pragma unroll
    for (int i = 0; i < 2; ++i) { int R, C; stage_rc(tid * 16 + i * 8192, R, C); const int Rb = Epi::PERM ? ((R & ~31) + perm32(R & 31)) : R;
        voffA[i] = (unsigned)(R * K + C) * 2u; voffB[i] = (unsigned)(Rb * K + C) * 2u; }
    const size_t kstep = (size_t)(BK * 2);
    const size_t hstep = (size_t)HALF * K * 2;
    const size_t tstep = 2 * hstep;
    const unsigned ldsw = (unsigned)wid * 1024u;
    const int aoff = lds_byte(wr * 64 + fr, fq * 8), boff = lds_byte(wc * 32 + fr, fq * 8);
#define PG8_SA(b, h) (((b) * 2 + (h)) * HTB)
#define PG8_SB(b, h) ((4 + (b) * 2 + (h)) * HTB)
#define PG8_STAGE(bufoff, gbase, voff) do { _Pragma("unroll") for (int _i = 0; _i < 2; ++_i) \
        __builtin_amdgcn_global_load_lds((const unsigned*)((const char*)(gbase) + (voff)[_i]), (PG8_LAS unsigned*)(lds + (bufoff) + ldsw + _i * 8192), 16, 0, 0); } while (0)
#define PG8_LDA(dst, b, h) do { _Pragma("unroll") for (int m = 0; m < 4; ++m) _Pragma("unroll") for (int k = 0; k < 2; ++k) dst[m][k] = *(const PG8_LAS bf16x8*)(lds + PG8_SA(b, h) + aoff + m * 2048 + k * 1024); } while (0)
#define PG8_LDB(dst, b, h) do { _Pragma("unroll") for (int n = 0; n < 2; ++n) _Pragma("unroll") for (int k = 0; k < 2; ++k) dst[n][k] = *(const PG8_LAS bf16x8*)(lds + PG8_SB(b, h) + boff + n * 2048 + k * 1024); } while (0)
#define PG8_MMA(ai, bj, At, Bt) do { __builtin_amdgcn_s_setprio(1); _Pragma("unroll") for (int m = 0; m < 4; ++m) _Pragma("unroll") for (int n = 0; n < 2; ++n) _Pragma("unroll") for (int k = 0; k < 2; ++k) \
        acc[ai][bj][m][n] = __builtin_amdgcn_mfma_f32_16x16x32_bf16(Bt[n][k], At[m][k], acc[ai][bj][m][n], 0, 0, 0); __builtin_amdgcn_s_setprio(0); } while (0)
#define PG8_WAIT_V(n) asm volatile("s_waitcnt vmcnt(" #n ")" ::: "memory")
#define PG8_WAIT_L(n) asm volatile("s_waitcnt lgkmcnt(" #n ")" ::: "memory")
#define PG8_BAR __builtin_amdgcn_s_barrier()
#define PG8_SCHED __builtin_amdgcn_sched_barrier(0)
    Unit cur, nxt; int ui = 0;
    if (!S.next(0, cur)) return;
    f32x4 acc[2][2][4][2];
#pragma unroll
    for (int a = 0; a < 2; ++a)
#pragma unroll
        for (int b = 0; b < 2; ++b)
#pragma unroll
            for (int m = 0; m < 4; ++m)
#pragma unroll
                for (int n = 0; n < 2; ++n) acc[a][b][m][n] = (f32x4){0.f, 0.f, 0.f, 0.f};
    bf16x8 At[4][2], B0[2][2], B1[2][2];
    const char* cA = (const char*)g.A + (size_t)cur.pm * tstep; const char* cB = (const char*)g.Bt + (size_t)cur.pn * tstep;
    S.a_ready(cur);
    if constexpr (SP2) {
        PG8_STAGE(PG8_SB(0, 0), cB, voffB); PG8_STAGE(PG8_SB(0, 1), cB + hstep, voffB); PG8_STAGE(PG8_SA(0, 0), cA, voffA); PG8_STAGE(PG8_SA(0, 1), cA + hstep, voffA);
        if (wr == 1) PG8_BAR;
        PG8_WAIT_V(2); PG8_BAR;
        PG8_STAGE(PG8_SB(1, 0), cB + kstep, voffB); PG8_STAGE(PG8_SA(1, 0), cA + kstep, voffA); PG8_STAGE(PG8_SB(1, 1), cB + hstep + kstep, voffB);
        PG8_WAIT_V(6); PG8_BAR;
    } else {
        PG8_STAGE(PG8_SB(0, 0), cB, voffB); PG8_STAGE(PG8_SA(0, 0), cA, voffA); PG8_STAGE(PG8_SB(0, 1), cB + hstep, voffB); PG8_STAGE(PG8_SA(0, 1), cA + hstep, voffA);
        if (wr == 1) PG8_BAR;
        PG8_WAIT_V(4); PG8_BAR;
        PG8_STAGE(PG8_SB(1, 0), cB + kstep, voffB); PG8_STAGE(PG8_SA(1, 0), cA + kstep, voffA); PG8_STAGE(PG8_SB(1, 1), cB + hstep + kstep, voffB);
        PG8_WAIT_V(6); PG8_BAR;
    }
    for (;;) {
        const bool has_next = S.next(ui + 1, nxt);
        const char* nA = has_next ? (const char*)g.A + (size_t)nxt.pm * tstep : cA; const char* nB = has_next ? (const char*)g.Bt + (size_t)nxt.pn * tstep : cB;
        for (int t = 0; t < nt; t += 2) {
            const bool last = (t == nt - 2);
            const char* a1 = cA + (size_t)(t + 1) * kstep;
            const char* a2 = last ? nA : cA + (size_t)(t + 2) * kstep; const char* b2 = last ? nB : cB + (size_t)(t + 2) * kstep;
            const char* a3 = a2 + kstep; const char* b3 = b2 + kstep;
            if (last && has_next) S.a_ready(nxt);
            if constexpr (SP2) {
            PG8_LDB(B0, 0, 0); PG8_LDB(B1, 0, 1); PG8_SCHED; PG8_LDA(At, 0, 0); PG8_STAGE(PG8_SA(1, 1), a1 + hstep, voffA);
            PG8_WAIT_V(8); PG8_WAIT_L(0); PG8_BAR; PG8_MMA(0, 0, At, B0); PG8_MMA(0, 1, At, B1); PG8_BAR; PG8_SCHED;
            PG8_LDA(At, 0, 1); PG8_STAGE(PG8_SB(0, 0), b2, voffB); PG8_STAGE(PG8_SB(0, 1), b2 + hstep, voffB); PG8_STAGE(PG8_SA(0, 0), a2, voffA);
            PG8_WAIT_V(8); PG8_WAIT_L(0); PG8_BAR; PG8_MMA(1, 0, At, B0); PG8_MMA(1, 1, At, B1); PG8_BAR; PG8_SCHED;
            PG8_LDB(B0, 1, 0); PG8_LDB(B1, 1, 1); PG8_SCHED; PG8_LDA(At, 1, 0); PG8_STAGE(PG8_SA(0, 1), a2 + hstep, voffA);
            PG8_WAIT_V(8); PG8_WAIT_L(0); PG8_BAR; PG8_MMA(0, 0, At, B0); PG8_MMA(0, 1, At, B1); PG8_BAR; PG8_SCHED;
            PG8_LDA(At, 1, 1); PG8_STAGE(PG8_SB(1, 0), b3, voffB); PG8_STAGE(PG8_SB(1, 1), b3 + hstep, voffB); PG8_STAGE(PG8_SA(1, 0), a3, voffA);
            PG8_WAIT_V(8); PG8_WAIT_L(0); PG8_BAR; PG8_MMA(1, 0, At, B0); PG8_MMA(1, 1, At, B1); PG8_BAR; PG8_SCHED;
            } else {
            PG8_LDB(B0, 0, 0); PG8_SCHED; PG8_LDA(At, 0, 0); PG8_STAGE(PG8_SA(1, 1), a1 + hstep, voffA);
            PG8_WAIT_L(8); PG8_BAR; PG8_WAIT_L(0); PG8_MMA(0, 0, At, B0); PG8_BAR; PG8_SCHED;
            PG8_LDB(B1, 0, 1); PG8_STAGE(PG8_SB(0, 0), b2, voffB);
            PG8_BAR; PG8_WAIT_L(0); PG8_MMA(0, 1, At, B1); PG8_BAR;
            PG8_LDA(At, 0, 1); PG8_STAGE(PG8_SA(0, 0), a2, voffA);
            PG8_BAR; PG8_WAIT_L(0); PG8_MMA(1, 0, At, B0); PG8_BAR; PG8_SCHED;
            PG8_STAGE(PG8_SB(0, 1), b2 + hstep, voffB);
            PG8_WAIT_V(6); PG8_BAR; PG8_MMA(1, 1, At, B1); PG8_BAR;
            PG8_LDB(B0, 1, 0); PG8_SCHED; PG8_LDA(At, 1, 0); PG8_STAGE(PG8_SA(0, 1), a2 + hstep, voffA);
            PG8_WAIT_L(8); PG8_BAR; PG8_WAIT_L(0); PG8_MMA(0, 0, At, B0); PG8_BAR; PG8_SCHED;
            PG8_LDB(B1, 1, 1); PG8_STAGE(PG8_SB(1, 0), b3, voffB);
            PG8_BAR; PG8_WAIT_L(0); PG8_MMA(0, 1, At, B1); PG8_BAR;
            PG8_LDA(At, 1, 1); PG8_STAGE(PG8_SA(1, 0), a3, voffA);
            PG8_BAR; PG8_WAIT_L(0); PG8_MMA(1, 0, At, B0); PG8_BAR; PG8_SCHED;
            PG8_STAGE(PG8_SB(1, 1), b3 + hstep, voffB);
            PG8_WAIT_V(6); PG8_BAR; PG8_MMA(1, 1, At, B1); PG8_BAR;
            }
        }
        if constexpr (ALIGN_EPI) { if (wr == 0) PG8_BAR; }
        if constexpr (!Epi::AFTER_DRAIN) { E(acc, cur, wr, wc, fr, fq); S.done(cur); }
        if (!has_next) break;
#pragma unroll
        for (int a = 0; a < 2; ++a)
#pragma unroll
            for (int b = 0; b < 2; ++b)
#pragma unroll
                for (int m = 0; m < 4; ++m)
#pragma unroll
                    for (int n = 0; n < 2; ++n) acc[a][b][m][n] = (f32x4){0.f, 0.f, 0.f, 0.f};
        cur = nxt; cA = nA; cB = nB; ++ui;
        if constexpr (ALIGN_EPI) { if (wr == 1) PG8_BAR; }
    }
    PG8_WAIT_V(0);
    if constexpr (!ALIGN_EPI) { if (wr == 0) PG8_BAR; }
    PG8_BAR;
    if constexpr (Epi::AFTER_DRAIN) { E.fused(acc, cur, wr, wc, fr, fq, lds, wid, lane); S.done(cur); }
#undef PG8_SA
#undef PG8_SB
#undef PG8_STAGE
#undef PG8_LDA
#undef PG8_LDB
#undef PG8_MMA
#undef PG8_WAIT_V
#undef PG8_WAIT_L
#undef PG8_BAR
#undef PG8_SCHED
}
}
typedef unsigned short bf16_t;
#define LAS __attribute__((address_space(3)))
#define GAS __attribute__((address_space(1)))
typedef unsigned v4u __attribute__((ext_vector_type(4)));
typedef unsigned v2u __attribute__((ext_vector_type(2)));
typedef float f32x4 __attribute__((ext_vector_type(4)));
constexpr int DM = 1024, NB = 32, SEQ = 2048, NTOK = NB * SEQ, NMEM = 256;
constexpr int LDP = 3328;
constexpr int C_SBQ = 0, C_SBK = 384, C_SBV = 768, C_SBG = 1152, C_DSQ = 1536, C_CKV = 1920, C_DSG = 2048,
              C_IDQ = 2432, C_IDK = 2688, C_IDW = 2720, C_MQ = 2728, C_MG = 2984, NCOL = 3240;
constexpr float EPS = 1e-6f;
constexpr size_t MiB = 1u << 20;
constexpr size_t WS_CTL = 0;
constexpr size_t WS_WIN = 1 * MiB;
constexpr size_t WS_WOUT = 14 * MiB;
constexpr size_t WS_WMEM = 18 * MiB;
constexpr size_t WS_MEMB = 20 * MiB;
constexpr size_t WS_MEMKV = 36 * MiB;
constexpr size_t WS_CKVN = 52 * MiB;
constexpr size_t WS_MASK = 68 * MiB;
constexpr size_t WS_H = 84 * MiB;
constexpr size_t WS_MIX = WS_H;
constexpr size_t WS_PROJ = 212 * MiB;
constexpr size_t WS_Y = WS_PROJ;
constexpr size_t WS_END = 628 * MiB;
constexpr int LDS_BYTES = 135168;
constexpr int NWAVES = 8;

__device__ __forceinline__ float bf2f(bf16_t v) { return __uint_as_float(((unsigned)v) << 16); }
__device__ __forceinline__ unsigned f2bf(float f) { unsigned u = __float_as_uint(f); u += 0x7fffu + ((u >> 16) & 1u); return u >> 16; }
__device__ __forceinline__ unsigned pk2(float lo, float hi) { return f2bf(lo) | (f2bf(hi) << 16); }
#define WAVE_SYNC() do { asm volatile("s_waitcnt lgkmcnt(0)" ::: "memory"); __builtin_amdgcn_wave_barrier(); } while (0)
__device__ __forceinline__ float wave_sum(float v) {
#pragma unroll
    for (int o = 1; o < 64; o <<= 1) v += __shfl_xor(v, o);
    return v;
}

__device__ const unsigned char T5TAB[128] = {0, 1, 2, 3, 4, 5, 6, 7, 8, 9, 10, 11, 12, 13, 14, 15, 16, 16, 16, 17, 17, 18, 18, 18, 19, 19, 19, 20, 20, 20, 20, 21, 21, 21, 21, 22, 22, 22, 22, 22, 23, 23, 23, 23, 23, 23, 24, 24, 24, 24, 24, 24, 25, 25, 25, 25, 25, 25, 25, 26, 26, 26, 26, 26, 26, 26, 26, 27, 27, 27, 27, 27, 27, 27, 27, 27, 27, 28, 28, 28, 28, 28, 28, 28, 28, 28, 28, 29, 29, 29, 29, 29, 29, 29, 29, 29, 29, 29, 29, 30, 30, 30, 30, 30, 30, 30, 30, 30, 30, 30, 30, 30, 30, 31, 31, 31, 31, 31, 31, 31, 31, 31, 31, 31, 31, 31, 31, 31};

struct Args { const float* in[11]; float* out; unsigned char* ws; int ph_lo, ph_hi; };

__device__ __forceinline__ void p0_transpose_item(const float* W, int K, int N, int Npad, bf16_t* WT, const float* g, LAS float* scr, int item, int lane) {
    const int nblk = Npad / 32, kb = item / nblk, nb = item % nblk, k0 = 64 * kb, n0 = 32 * nb;
    const int nn = n0 + (lane & 31);
#pragma unroll 8
    for (int i = 0; i < 32; ++i) { const int kk = 2 * i + (lane >> 5); float v = (nn < N) ? W[(size_t)(k0 + kk) * N + nn] : 0.f; if (g) v *= g[k0 + kk]; scr[kk * 33 + (lane & 31)] = v; }
    WAVE_SYNC();
    const int c = lane & 7;
#pragma unroll
    for (int j = 0; j < 4; ++j) { const int n = (lane >> 3) + 8 * j; const LAS float* s = scr + (8 * c) * 33 + n;
        v4u o; o.x = pk2(s[0 * 33], s[1 * 33]); o.y = pk2(s[2 * 33], s[3 * 33]); o.z = pk2(s[4 * 33], s[5 * 33]); o.w = pk2(s[6 * 33], s[7 * 33]);
        *(v4u*)(WT + (size_t)(n0 + n) * K + k0 + 8 * c) = o; }
    WAVE_SYNC();
}
template <bool NORM> __device__ __forceinline__ void row_to_bf16(const float* xrow, bf16_t* orow, int lane) {
    const f32x4* xr = (const f32x4*)xrow + lane;
    f32x4 v[4]; float s = 0.f;
#pragma unroll
    for (int j = 0; j < 4; ++j) { v[j] = xr[64 * j]; s += (v[j].x * v[j].x + v[j].y * v[j].y) + (v[j].z * v[j].z + v[j].w * v[j].w); }
    float r = 1.f;
    if (NORM) r = 1.0f / sqrtf(wave_sum(s) * (1.f / DM) + EPS);
    v2u* o8 = (v2u*)orow + lane;
#pragma unroll
    for (int j = 0; j < 4; ++j) { v2u w; w.x = pk2(v[j].x * r, v[j].y * r); w.y = pk2(v[j].z * r, v[j].w * r); o8[64 * j] = w; }
}

__device__ __forceinline__ void ckvnorm_wave(const bf16_t* PROJ, const float* kvg, bf16_t* CKVN, int row, int lane) {
    const bf16_t* p = PROJ + (size_t)row * LDP + C_CKV;
    const float a = bf2f(p[lane]), b = bf2f(p[lane + 64]);
    const float s = wave_sum(a * a + b * b);
    const float r = 1.0f / sqrtf(s * (1.0f / 128.f) + EPS);
    CKVN[(size_t)row * 128 + lane] = (bf16_t)f2bf(a * r * kvg[lane]);
    CKVN[(size_t)row * 128 + lane + 64] = (bf16_t)f2bf(b * r * kvg[lane + 64]);
}

__device__ __forceinline__ void sb_naive_wave(const bf16_t* PROJ, bf16_t* MIX, int blk, int lane) {
    const int chunk = blk & 31, bh = blk >> 5, h = bh % 6, b = bh / 6, t = chunk * 64 + lane;
    const bf16_t* base = PROJ + (size_t)b * SEQ * LDP;
    float q[64], o[64];
    {
        const bf16_t* qp = base + (size_t)t * LDP + C_SBQ + h * 64;
#pragma unroll
        for (int d = 0; d < 64; ++d) { q[d] = bf2f(qp[d]) * 0.125f; o[d] = 0.f; }
    }
    float L = 0.f;
    const int tmax = chunk * 64 + 63;
    for (int s = tmax - 1; s >= 0; --s) {
        const bf16_t* kp = base + (size_t)s * LDP + C_SBK + h * 64;
        float z = 0.f;
#pragma unroll
        for (int d = 0; d < 64; ++d) z += q[d] * bf2f(kp[d]);
        const bool act = s < t;
        const float sp = fmaxf(z, 0.f) + log1pf(expf(-fabsf(z)));
        const float a = act ? expf((z - sp) + L) : 0.f;
        if (act) L -= sp;
        const bf16_t* vp = base + (size_t)s * LDP + C_SBV + h * 64;
#pragma unroll
        for (int d = 0; d < 64; ++d) o[d] += a * bf2f(vp[d]);
    }
    const bf16_t* gp = base + (size_t)t * LDP + C_SBG + h * 64;
    bf16_t* op = MIX + ((size_t)b * SEQ + t) * DM + h * 64;
#pragma unroll
    for (int d = 0; d < 64; ++d) { const float g = bf2f(gp[d]); op[d] = (bf16_t)f2bf(o[d] * (g / (1.f + expf(-g)))); }
}

__device__ __forceinline__ unsigned ordkey(float f) { unsigned u = __float_as_uint(f); return (u & 0x80000000u) ? ~u : (u | 0x80000000u); }
__device__ __forceinline__ void sel_naive_wave(const bf16_t* PROJ, unsigned* MASK, int gq, int lane, LAS unsigned char* wl) {
    LAS float* iq = (LAS float*)wl; LAS float* iw = (LAS float*)(wl + 1024); LAS unsigned long long* bal = (LAS unsigned long long*)(wl + 1280); LAS unsigned* scl = (LAS unsigned*)(wl + 2048);
    const int b = gq >> 11, t = gq & 2047;
    const bf16_t* row = PROJ + ((size_t)b * SEQ + t) * LDP;
    for (int i = lane; i < 256; i += 64) iq[i] = bf2f(row[C_IDQ + i]);
    if (lane < 8) iw[lane] = bf2f(row[C_IDW + lane]) * 0.0625f;
    WAVE_SYNC();
    for (int j = 0; j < 32; ++j) {
        unsigned kv = 0u;
        if (j * 64 <= t) {
            const int s = j * 64 + lane;
            const bf16_t* kr = PROJ + ((size_t)b * SEQ + s) * LDP + C_IDK;
            float kd[32];
#pragma unroll
            for (int d = 0; d < 32; ++d) kd[d] = bf2f(kr[d]);
            float acc = 0.f;
            unsigned iqo = 0; asm volatile("" : "+v"(iqo));
            const LAS float* iqj = iq + iqo;
#pragma unroll 1
            for (int hh = 0; hh < 8; ++hh) {
                float dt = 0.f;
#pragma unroll
                for (int d = 0; d < 32; ++d) dt += iqj[hh * 32 + d] * kd[d];
                acc += iw[hh] * fmaxf(dt, 0.f);
            }
            kv = (s <= t) ? ordkey(acc) : 0u;
        }
        scl[j * 64 + lane] = kv;
    }
    WAVE_SYNC();
    unsigned key[32];
#pragma unroll
    for (int j = 0; j < 32; ++j) key[j] = scl[j * 64 + lane];
    const bool need_sel = (t + 1) > 256;
    unsigned tau = 0u; int need = 0;
    if (need_sel) {
        unsigned prefix = 0u;
        for (int bit = 31; bit >= 0; --bit) {
            const unsigned cand = prefix | (1u << bit);
            int cnt = 0;
#pragma unroll
            for (int j = 0; j < 32; ++j) cnt += __popcll(__ballot(key[j] >= cand));
            if (cnt >= 256) prefix = cand;
        }
        tau = prefix;
        int cgt = 0;
#pragma unroll
        for (int j = 0; j < 32; ++j) cgt += __popcll(__ballot(key[j] > tau));
        need = 256 - cgt;
    }
    int tiesbefore = 0;
    const unsigned long long lt_mask = (lane == 0) ? 0ull : (~0ull >> (64 - lane));
#pragma unroll
    for (int j = 0; j < 32; ++j) {
        bool sel;
        if (!need_sel) sel = (j * 64 + lane) <= t;
        else {
            const bool gt = key[j] > tau, eq = key[j] == tau;
            const unsigned long long be = __ballot(eq);
            const int rank = tiesbefore + __popcll(be & lt_mask);
            sel = gt || (eq && rank < need);
            tiesbefore += __popcll(be);
        }
        const unsigned long long bs = __ballot(sel);
        if (lane == 0) bal[j] = bs;
    }
    WAVE_SYNC();
    {
        const int kt = lane;
        const unsigned long long bb = bal[kt >> 1];
        const unsigned nat = (unsigned)(bb >> (32 * (kt & 1)));
        unsigned w = 0u;
#pragma unroll
        for (int n = 0; n < 8; ++n) { const unsigned nib = (nat >> (4 * n)) & 0xfu; const int on = 4 * (n & 1) + (n >> 1); w |= nib << (4 * on); }
        MASK[((((size_t)b * 64 + (t >> 5)) * 64 + kt) * 32) + (t & 31)] = w;
    }
    WAVE_SYNC();
}

__device__ __forceinline__ void dsa_naive_wave(const bf16_t* PROJ, const bf16_t* CKVN, const unsigned* MASK, const float* w_uk, const float* w_uv,
                                               const float* rel_bias, bf16_t* MIX, int blk, int lane, LAS float* ql) {
    const int chunk = blk & 31, bh = blk >> 5, h = bh % 6, b = bh / 6, t = chunk * 64 + lane;
    {
        float q[64];
        const bf16_t* qp = PROJ + ((size_t)b * SEQ + t) * LDP + C_DSQ + h * 64;
#pragma unroll
        for (int d = 0; d < 64; ++d) q[d] = bf2f(qp[d]);
        for (int r = 0; r < 128; ++r) {
            const float* wp = w_uk + ((size_t)r * 6 + h) * 64;
            float a = 0.f;
#pragma unroll
            for (int d = 0; d < 64; ++d) a += q[d] * wp[d];
            ql[r * 64 + lane] = a * 0.125f;
        }
    }
    WAVE_SYNC();
    float o[128];
#pragma unroll
    for (int r = 0; r < 128; ++r) o[r] = 0.f;
    float m = -INFINITY, l = 0.f;
    const int tmax = chunk * 64 + 63, qt = t >> 5;
    for (int kt = 0; kt <= (tmax >> 5); ++kt) {
        unsigned w = 0u;
        if (kt <= qt) w = MASK[((((size_t)b * 64 + qt) * 64 + kt) * 32) + (t & 31)];
        for (int i = 0; i < 32; ++i) {
            const int hf = (i >> 2) & 1, a8 = i >> 3, c = i & 3, bit = 16 * hf + 4 * a8 + c;
            const bool sel = (w >> bit) & 1u;
            if (!__any(sel)) continue;
            const int s = kt * 32 + i;
            const bf16_t* cr = CKVN + ((size_t)b * SEQ + s) * 128;
            float lg = 0.f;
            for (int r = 0; r < 128; ++r) lg += ql[r * 64 + lane] * bf2f(cr[r]);
            int rel = t - s; rel = rel < 0 ? 0 : rel;
            const int bk = rel < 128 ? (int)T5TAB[rel] : 31;
            lg += rel_bias[bk * 6 + h];
            if (sel) {
                const float mn = fmaxf(m, lg), sc = expf(m - mn), p = expf(lg - mn);
                l = l * sc + p; m = mn;
#pragma unroll
                for (int r = 0; r < 128; ++r) o[r] = o[r] * sc + p * bf2f(cr[r]);
            }
        }
    }
    const float il = 1.f / l;
    WAVE_SYNC();
#pragma unroll
    for (int r = 0; r < 128; ++r) ql[r * 64 + lane] = o[r] * il;
    WAVE_SYNC();
    const bf16_t* gp = PROJ + ((size_t)b * SEQ + t) * LDP + C_DSG + h * 64;
    bf16_t* op = MIX + ((size_t)b * SEQ + t) * DM + 384 + h * 64;
    for (int d0 = 0; d0 < 64; d0 += 16) {
        float acc[16];
#pragma unroll
        for (int j = 0; j < 16; ++j) acc[j] = 0.f;
        for (int r = 0; r < 128; ++r) {
            const float ol = ql[r * 64 + lane];
            const float* wp = w_uv + ((size_t)r * 6 + h) * 64 + d0;
#pragma unroll
            for (int j = 0; j < 16; ++j) acc[j] += ol * wp[j];
        }
#pragma unroll
        for (int j = 0; j < 16; ++j) { const float g = bf2f(gp[d0 + j]); op[d0 + j] = (bf16_t)f2bf(acc[j] * (g / (1.f + expf(-g)))); }
    }
    WAVE_SYNC();
}

__device__ __forceinline__ void mem_naive_wave(const bf16_t* PROJ, const bf16_t* MEMKV  , bf16_t* MIX, int blk, int lane) {
    const int chunk = blk & 31, bh = blk >> 5, h = bh & 3, b = bh >> 2, t = chunk * 64 + lane;
    float q[64], o[64];
    const bf16_t* qp = PROJ + ((size_t)b * SEQ + t) * LDP + C_MQ + h * 64;
#pragma unroll
    for (int d = 0; d < 64; ++d) { q[d] = bf2f(qp[d]) * 0.125f; o[d] = 0.f; }
    float m = -INFINITY, l = 0.f;
    for (int s = 0; s < NMEM; ++s) {
        const bf16_t* kp = MEMKV + ((size_t)b * NMEM + s) * 1024 + h * 64;
        float z = 0.f;
#pragma unroll
        for (int d = 0; d < 64; ++d) z += q[d] * bf2f(kp[d]);
        const float mn = fmaxf(m, z), sc = expf(m - mn), p = expf(z - mn);
        l = l * sc + p; m = mn;
        const bf16_t* vp = kp + 256;
#pragma unroll
        for (int d = 0; d < 64; ++d) o[d] = o[d] * sc + p * bf2f(vp[d]);
    }
    const float il = 1.f / l;
    const bf16_t* gp = PROJ + ((size_t)b * SEQ + t) * LDP + C_MG + h * 64;
    bf16_t* op = MIX + ((size_t)b * SEQ + t) * DM + 768 + h * 64;
#pragma unroll
    for (int d = 0; d < 64; ++d) { const float g = bf2f(gp[d]); op[d] = (bf16_t)f2bf(o[d] * il * (g / (1.f + expf(-g)))); }
}

__device__ __forceinline__ void post_row(const float* xin, const bf16_t* Y, const float* g, float* xout, bf16_t* Hn, int row, int lane) {
    const bf16_t* yp = Y + (size_t)row * DM;
    float yv[16]; float s = 0.f;
#pragma unroll
    for (int j = 0; j < 4; ++j) {
        const v2u v = *(const v2u*)(yp + (lane + 64 * j) * 4);
        yv[4 * j + 0] = __uint_as_float(v.x << 16); yv[4 * j + 1] = __uint_as_float(v.x & 0xffff0000u);
        yv[4 * j + 2] = __uint_as_float(v.y << 16); yv[4 * j + 3] = __uint_as_float(v.y & 0xffff0000u);
        s += yv[4 * j] * yv[4 * j] + yv[4 * j + 1] * yv[4 * j + 1] + yv[4 * j + 2] * yv[4 * j + 2] + yv[4 * j + 3] * yv[4 * j + 3];
    }
    const float r = 1.0f / sqrtf(wave_sum(s) * (1.0f / DM) + EPS);
    f32x4 ov[4]; float s2 = 0.f;
#pragma unroll
    for (int j = 0; j < 4; ++j) {
        const int c = (lane + 64 * j) * 4;
        const f32x4 xv = *(const f32x4*)(xin + (size_t)row * DM + c);
        const f32x4 gv = *(const f32x4*)(g + c);
        ov[j].x = xv.x + yv[4 * j] * r * gv.x; ov[j].y = xv.y + yv[4 * j + 1] * r * gv.y; ov[j].z = xv.z + yv[4 * j + 2] * r * gv.z; ov[j].w = xv.w + yv[4 * j + 3] * r * gv.w;
        *(f32x4*)(xout + (size_t)row * DM + c) = ov[j];
        s2 += (ov[j].x * ov[j].x + ov[j].y * ov[j].y) + (ov[j].z * ov[j].z + ov[j].w * ov[j].w);
    }
    if (Hn) {
        const float r2 = 1.0f / sqrtf(wave_sum(s2) * (1.f / DM) + EPS);
        v2u* o8 = (v2u*)(Hn + (size_t)row * DM) + lane;
#pragma unroll
        for (int j = 0; j < 4; ++j) { v2u w; w.x = pk2(ov[j].x * r2, ov[j].y * r2); w.y = pk2(ov[j].z * r2, ov[j].w * r2); o8[64 * j] = w; }
    }
}

typedef short bf16x8 __attribute__((ext_vector_type(8)));
typedef short s16x4 __attribute__((ext_vector_type(4)));
typedef float f32x16 __attribute__((ext_vector_type(16)));
typedef float f32x2_t __attribute__((ext_vector_type(2)));
typedef __bf16 bf16x2_t __attribute__((ext_vector_type(2)));
#define MFMA32(a, b, c) __builtin_amdgcn_mfma_f32_32x32x16_bf16((a), (b), (c), 0, 0, 0)
__device__ __forceinline__ unsigned cvtpk(float lo, float hi) { f32x2_t v = {lo, hi}; bf16x2_t b = __builtin_convertvector(v, bf16x2_t); return __builtin_bit_cast(unsigned, b); }
__device__ __forceinline__ s16x4 vtr(const LAS unsigned char* p) { return __builtin_bit_cast(s16x4, __builtin_amdgcn_ds_read_tr16_b64_v4i16((LAS s16x4*)p)); }
__device__ __forceinline__ int crow(int r, int hi) { return (r & 3) + 8 * (r >> 2) + 4 * hi; }
__device__ __forceinline__ bf16x8 pack8(const f32x16& x, int s) {
    v4u p; p.x = cvtpk(x[8 * s + 0], x[8 * s + 1]); p.y = cvtpk(x[8 * s + 2], x[8 * s + 3]); p.z = cvtpk(x[8 * s + 4], x[8 * s + 5]); p.w = cvtpk(x[8 * s + 6], x[8 * s + 7]);
    return __builtin_bit_cast(bf16x8, p);
}
__device__ __forceinline__ f32x16 zero16() { float z; asm volatile("v_mov_b32 %0, 0" : "=v"(z)); return (f32x16){z, z, z, z, z, z, z, z, z, z, z, z, z, z, z, z}; }
__device__ __forceinline__ bf16x8 cat44(s16x4 lo, s16x4 hi) { return __builtin_shufflevector(lo, hi, 0, 1, 2, 3, 4, 5, 6, 7); }
constexpr int VT_PITCH = 192;
constexpr float LOG2E = 1.4426950408889634f;

__device__ __forceinline__ void pv_tile(f32x16 (&O)[2], const LAS unsigned char* vrd, bf16x8 p0, bf16x8 p1) {
#pragma unroll
    for (int c = 0; c < 2; ++c) {
        const bf16x8 a0 = cat44(vtr(vrd + 0 * VT_PITCH + 64 * c), vtr(vrd + 8 * VT_PITCH + 64 * c));
        const bf16x8 a1 = cat44(vtr(vrd + 16 * VT_PITCH + 64 * c), vtr(vrd + 24 * VT_PITCH + 64 * c));
        O[c] = MFMA32(a0, p0, O[c]);
        O[c] = MFMA32(a1, p1, O[c]);
    }
}
__device__ __forceinline__ void gate_store(const f32x16 (&O)[2], float scale, const bf16_t* grow, bf16_t* orow, int hi) {
#pragma unroll
    for (int c = 0; c < 2; ++c)
#pragma unroll
        for (int g = 0; g < 4; ++g) {
            const int d = 32 * c + 8 * g + 4 * hi;
            const v2u gv = *(const v2u*)(grow + d);
            float gt[4] = {__uint_as_float(gv.x << 16), __uint_as_float(gv.x & 0xffff0000u), __uint_as_float(gv.y << 16), __uint_as_float(gv.y & 0xffff0000u)};
            float ov[4];
#pragma unroll
            for (int j = 0; j < 4; ++j) ov[j] = O[c][4 * g + j] * scale * gt[j] * __builtin_amdgcn_rcpf(1.f + __builtin_amdgcn_exp2f(-gt[j] * LOG2E));
            v2u w; w.x = cvtpk(ov[0], ov[1]); w.y = cvtpk(ov[2], ov[3]);
            *(v2u*)(orow + d) = w;
        }
}

__device__ __forceinline__ void sb_item(const bf16_t* PROJ, bf16_t* MIX, int b, int h, int qt, int lane, LAS unsigned char* wl) {
    asm volatile("" : "+v"(lane));
    const int r32 = lane & 31, hi = lane >> 5;
    const bf16_t* base = PROJ + (size_t)b * SEQ * LDP;
    const int t = 32 * qt + r32;
    bf16x8 qf[4];
#pragma unroll
    for (int ks = 0; ks < 4; ++ks) qf[ks] = *(const bf16x8*)(base + (size_t)t * LDP + C_SBQ + h * 64 + 16 * ks + 8 * hi);
    const int vrow = lane >> 3, vch = lane & 7;
    LAS unsigned char* vwr = wl + vrow * VT_PITCH + vch * 16;
    const LAS unsigned char* vrd = wl + (4 * hi + ((lane & 15) >> 2)) * VT_PITCH + (16 * ((lane >> 4) & 1) + 4 * (lane & 3)) * 2;
    bf16x8 kc[4], vc[4];
    {
        const bf16_t* kp = base + (size_t)(32 * qt + r32) * LDP + C_SBK + h * 64 + 8 * hi;
#pragma unroll
        for (int ks = 0; ks < 4; ++ks) kc[ks] = *(const bf16x8*)(kp + 16 * ks);
        const bf16_t* vp = base + (size_t)(32 * qt + vrow) * LDP + C_SBV + h * 64 + 8 * vch;
#pragma unroll
        for (int i = 0; i < 4; ++i) vc[i] = *(const bf16x8*)(vp + (size_t)(8 * i) * LDP);
    }
    f32x16 O[2];
#pragma unroll
    for (int r = 0; r < 16; ++r) { O[0][r] = 0.f; O[1][r] = 0.f; }
    float R = 1.f;
    for (int kt = qt; kt >= 0; --kt) {
        bf16x8 kn[4], vn[4];
        {
            const int ktn = kt > 0 ? kt - 1 : 0;
            const bf16_t* kp = base + (size_t)(32 * ktn + r32) * LDP + C_SBK + h * 64 + 8 * hi;
#pragma unroll
            for (int ks = 0; ks < 4; ++ks) kn[ks] = *(const bf16x8*)(kp + 16 * ks);
            const bf16_t* vp = base + (size_t)(32 * ktn + vrow) * LDP + C_SBV + h * 64 + 8 * vch;
#pragma unroll
            for (int i = 0; i < 4; ++i) vn[i] = *(const bf16x8*)(vp + (size_t)(8 * i) * LDP);
        }
        f32x16 acc;
#pragma unroll
        for (int r = 0; r < 16; ++r) acc[r] = 0.f;
#pragma unroll
        for (int ks = 0; ks < 4; ++ks) acc = MFMA32(kc[ks], qf[ks], acc);
#pragma unroll
        for (int i = 0; i < 4; ++i) *(LAS bf16x8*)(vwr + (8 * i) * VT_PITCH) = vc[i];
        float be[16], om[16];
        const bool diag = (kt == qt);
#pragma unroll
        for (int r = 0; r < 16; ++r) {
            const float e = __builtin_amdgcn_exp2f(fminf(acc[r] * (-0.125f * LOG2E), 115.f));
            float bt = __builtin_amdgcn_rcpf(1.f + e), o1 = e * bt;
            if (diag && !(crow(r, hi) < r32)) { bt = 0.f; o1 = 1.f; }
            be[r] = bt; om[r] = o1;
        }
        float Gp[4], Gq[4];
#pragma unroll
        for (int g = 0; g < 4; ++g) { Gp[g] = (om[4 * g] * om[4 * g + 1]) * (om[4 * g + 2] * om[4 * g + 3]); Gq[g] = __shfl_xor(Gp[g], 32); }
        const float T1 = Gp[1] * Gq[1], T2 = Gp[2] * Gq[2], T3 = Gp[3] * Gq[3], T0 = Gp[0] * Gq[0];
        float tail[4]; tail[3] = R; tail[2] = R * T3; tail[1] = tail[2] * T2; tail[0] = tail[1] * T1;
        const float Rn = tail[0] * T0;
#pragma unroll
        for (int g = 0; g < 4; ++g) {
            float sfx = tail[g] * (hi == 0 ? Gq[g] : 1.f);
            acc[4 * g + 3] = be[4 * g + 3] * sfx; sfx *= om[4 * g + 3];
            acc[4 * g + 2] = be[4 * g + 2] * sfx; sfx *= om[4 * g + 2];
            acc[4 * g + 1] = be[4 * g + 1] * sfx; sfx *= om[4 * g + 1];
            acc[4 * g + 0] = be[4 * g + 0] * sfx;
        }
        R = Rn;
        const bf16x8 p0 = pack8(acc, 0), p1 = pack8(acc, 1);
        pv_tile(O, vrd, p0, p1);
        if (__all(R < 7.8886e-31f)) break;
#pragma unroll
        for (int i = 0; i < 4; ++i) { kc[i] = kn[i]; vc[i] = vn[i]; }
    }
    gate_store(O, 1.f, base + (size_t)t * LDP + C_SBG + h * 64, MIX + ((size_t)b * SEQ + t) * DM + h * 64, hi);
}

__device__ __forceinline__ void mem_item(const bf16_t* PROJ, const bf16_t* KV, bf16_t* MIX, int b, int h, int qt, int lane, LAS unsigned char* wl) {
    asm volatile("" : "+v"(lane));
    float NINF; asm volatile("v_mov_b32 %0, 0xff800000" : "=v"(NINF));
    const int r32 = lane & 31, hi = lane >> 5;
    const int t = 32 * qt + r32;
    const bf16_t* prow = PROJ + ((size_t)b * SEQ + t) * LDP;
    bf16x8 qf[4];
#pragma unroll
    for (int ks = 0; ks < 4; ++ks) qf[ks] = *(const bf16x8*)(prow + C_MQ + h * 64 + 16 * ks + 8 * hi);
    const int vrow = lane >> 3, vch = lane & 7;
    LAS unsigned char* vwr = wl + vrow * VT_PITCH + vch * 16;
    const LAS unsigned char* vrd = wl + (4 * hi + ((lane & 15) >> 2)) * VT_PITCH + (16 * ((lane >> 4) & 1) + 4 * (lane & 3)) * 2;
    const bf16_t* kvb = KV + (size_t)b * NMEM * 1024 + h * 64;
    f32x16 O[2];
#pragma unroll
    for (int r = 0; r < 16; ++r) { O[0][r] = 0.f; O[1][r] = 0.f; }
    float mrun = NINF, lrun = 0.f;
    for (int kt = 0; kt < NMEM / 32; ++kt) {
        bf16x8 kc[4], vc[4];
        const bf16_t* kp = kvb + (size_t)(32 * kt + r32) * 1024 + 8 * hi;
#pragma unroll
        for (int ks = 0; ks < 4; ++ks) kc[ks] = *(const bf16x8*)(kp + 16 * ks);
        const bf16_t* vp = kvb + (size_t)(32 * kt + vrow) * 1024 + 256 + 8 * vch;
#pragma unroll
        for (int i = 0; i < 4; ++i) vc[i] = *(const bf16x8*)(vp + (size_t)(8 * i) * 1024);
        f32x16 acc;
#pragma unroll
        for (int r = 0; r < 16; ++r) acc[r] = 0.f;
#pragma unroll
        for (int ks = 0; ks < 4; ++ks) acc = MFMA32(kc[ks], qf[ks], acc);
#pragma unroll
        for (int i = 0; i < 4; ++i) *(LAS bf16x8*)(vwr + (8 * i) * VT_PITCH) = vc[i];
        float mx = acc[0];
#pragma unroll
        for (int r = 1; r < 16; ++r) mx = fmaxf(mx, acc[r]);
        mx *= 0.125f * LOG2E;
        mx = fmaxf(mx, __shfl_xor(mx, 32));
        const float mn = fmaxf(mrun, mx), alpha = __builtin_amdgcn_exp2f(mrun - mn);
        float ps = 0.f;
#pragma unroll
        for (int r = 0; r < 16; ++r) { acc[r] = __builtin_amdgcn_exp2f(acc[r] * (0.125f * LOG2E) - mn); ps += acc[r]; }
        lrun = lrun * alpha + ps; mrun = mn;
#pragma unroll
        for (int r = 0; r < 16; ++r) { O[0][r] *= alpha; O[1][r] *= alpha; }
        const bf16x8 p0 = pack8(acc, 0), p1 = pack8(acc, 1);
        pv_tile(O, vrd, p0, p1);
    }
    const float lt = lrun + __shfl_xor(lrun, 32);
    gate_store(O, 1.f / lt, prow + C_MG + h * 64, MIX + ((size_t)b * SEQ + t) * DM + 768 + h * 64, hi);
}

constexpr int SEL_IQ_PITCH = 528, SEL_CNT_OFF = 17408;
__device__ __forceinline__ unsigned ordkey(float f);
template <int PRED  >
__device__ __forceinline__ unsigned sel_count_round(const unsigned (&key)[8][16], unsigned c, unsigned tau, int idx0, int r32, int hi, int wave, LAS unsigned* cb) {
    int n = 0;
#pragma unroll
    for (int i = 0; i < 8; ++i) {
#pragma unroll
        for (int r = 0; r < 16; ++r) {
            if (PRED == 0) n += (key[i][r] >= c) ? 1 : 0;
            else if (PRED == 1) n += (key[i][r] > c) ? 1 : 0;
            else n += (key[i][r] == tau && (unsigned)(idx0 + 256 * i + (r & 3) + 8 * (r >> 2)) <= c) ? 1 : 0;
            if ((r & 7) == 7) asm volatile("" : "+v"(n));
        }
    }
    n += __shfl_xor(n, 32);
    if (hi == 0) cb[wave * 32 + r32] = (unsigned)n;
    __syncthreads();
    unsigned tot = 0;
#pragma unroll
    for (int w = 0; w < 8; ++w) tot += cb[w * 32 + r32];
    return tot;
}
__device__ __forceinline__ void sel_item(const bf16_t* PROJ, unsigned* MASK, int b, int qt, int lane, int wave, LAS unsigned char* L) {
    asm volatile("" : "+v"(lane));
    const int r32 = lane & 31, hi = lane >> 5, tid = wave * 64 + lane;
    LAS unsigned* cntb = (LAS unsigned*)(L + SEL_CNT_OFF);
    const bf16_t* base = PROJ + (size_t)b * SEQ * LDP;
    unsigned* mrow = MASK + (((size_t)b * 64 + qt) * 64) * 32;
    const bool need_sel = qt >= 8;
    if (!need_sel) {
#pragma unroll
        for (int i = 0; i < 8; ++i) {
            const int kt = wave + 8 * i;
            if (kt <= qt) {
                unsigned bits = 0u;
#pragma unroll
                for (int r = 0; r < 16; ++r) bits |= ((kt < qt) || (crow(r, hi) <= r32)) ? (1u << r) : 0u;
                const unsigned other = __shfl_xor(bits, 32);
                if (hi == 0) mrow[kt * 32 + r32] = bits | (other << 16);
            }
        }
        return;
    }
    for (int n = tid; n < 1024; n += 512) { const int row = n >> 5, ch = n & 31;
        const v4u v = *(const v4u*)(base + (size_t)(32 * qt + row) * LDP + C_IDQ + ch * 8);
        *(LAS v4u*)(L + row * SEL_IQ_PITCH + ch * 16) = v; }
    float w8[8];
    { const v4u wv = *(const v4u*)(base + (size_t)(32 * qt + r32) * LDP + C_IDW);
      w8[0] = __uint_as_float(wv.x << 16) * 0.0625f; w8[1] = __uint_as_float(wv.x & 0xffff0000u) * 0.0625f; w8[2] = __uint_as_float(wv.y << 16) * 0.0625f; w8[3] = __uint_as_float(wv.y & 0xffff0000u) * 0.0625f;
      w8[4] = __uint_as_float(wv.z << 16) * 0.0625f; w8[5] = __uint_as_float(wv.z & 0xffff0000u) * 0.0625f; w8[6] = __uint_as_float(wv.w << 16) * 0.0625f; w8[7] = __uint_as_float(wv.w & 0xffff0000u) * 0.0625f; }
    __syncthreads();
    unsigned key[8][16];
    const LAS unsigned char* iqp = L + r32 * SEL_IQ_PITCH + 16 * hi;
#pragma unroll
    for (int i = 0; i < 8; ++i) {
        const int kt = wave + 8 * i;
        const bf16_t* kp = base + (size_t)(32 * kt + r32) * LDP + C_IDK + 8 * hi;
        const bf16x8 k0 = *(const bf16x8*)kp, k1 = *(const bf16x8*)(kp + 16);
        float sc[16];
#pragma unroll
        for (int r = 0; r < 16; ++r) sc[r] = 0.f;
        unsigned iqo = 0; asm volatile("" : "+v"(iqo));
        const LAS unsigned char* iqt = iqp + iqo;
#pragma unroll
        for (int h = 0; h < 8; ++h) {
            const bf16x8 q0 = *(const LAS bf16x8*)(iqt + h * 64), q1 = *(const LAS bf16x8*)(iqt + h * 64 + 32);
            bf16x8 q0p = q0, q1p = q1;
            asm volatile("" : "+v"(q0p), "+v"(q1p) : "v"(sc[15]));
            f32x16 D;
#pragma unroll
            for (int r = 0; r < 16; ++r) D[r] = 0.f;
            D = MFMA32(k0, q0p, D); D = MFMA32(k1, q1p, D);
#pragma unroll
            for (int r = 0; r < 16; ++r) sc[r] += w8[h] * fmaxf(D[r], 0.f);
            asm volatile("" : "+v"(sc[0]), "+v"(sc[1]), "+v"(sc[2]), "+v"(sc[3]), "+v"(sc[4]), "+v"(sc[5]), "+v"(sc[6]), "+v"(sc[7]),
                              "+v"(sc[8]), "+v"(sc[9]), "+v"(sc[10]), "+v"(sc[11]), "+v"(sc[12]), "+v"(sc[13]), "+v"(sc[14]), "+v"(sc[15]));
        }
        int thr = (kt < qt) ? 64 : ((kt == qt) ? (r32 - 4 * hi) : -1);
        asm volatile("" : "+v"(thr));
#pragma unroll
        for (int r = 0; r < 16; ++r) key[i][r] = ((r & 3) + 8 * (r >> 2) <= thr) ? ordkey(sc[r]) : 0u;
    }
    unsigned prefix = 0u, cge = 0u;
    for (int bit = 31; bit >= 0; --bit) {
        const unsigned cand = prefix | (1u << bit);
        const unsigned tot = sel_count_round<0>(key, cand, 0u, 0, r32, hi, wave, cntb + (bit & 1) * 256);
        if (tot >= 256u) { prefix = cand; cge = tot; }
    }
    const unsigned tau = prefix;
    unsigned cut = 0xffffffffu;
    if (__any(cge != 256u)) {
        const unsigned cgt = sel_count_round<1>(key, tau, 0u, 0, r32, hi, wave, cntb + 256);
        const unsigned need = 256u - cgt;
        const int idx0 = 32 * wave + 4 * hi;
        unsigned lo_ = 0u, hi_ = 2047u;
        for (int it = 0; it < 11; ++it) {
            const unsigned mid = (lo_ + hi_) >> 1;
            const unsigned f = sel_count_round<2>(key, mid, tau, idx0, r32, hi, wave, cntb + (it & 1) * 256);
            if (f >= need) hi_ = mid; else lo_ = mid + 1;
        }
        cut = hi_;
    }
    {
        const int idx0 = 32 * wave + 4 * hi;
#pragma unroll
        for (int i = 0; i < 8; ++i) {
            const int kt = wave + 8 * i;
            if (kt <= qt) {
                unsigned bits = 0u;
#pragma unroll
                for (int r = 0; r < 16; ++r) {
                    const bool s = (key[i][r] > tau) || (key[i][r] == tau && (unsigned)(idx0 + 256 * i + (r & 3) + 8 * (r >> 2)) <= cut);
                    bits |= s ? (1u << r) : 0u;
                }
                const unsigned other = __shfl_xor(bits, 32);
                if (hi == 0) mrow[kt * 32 + r32] = bits | (other << 16);
            }
        }
    }
    __syncthreads();
}

constexpr int SEL_CAP = 64, SEL_DONE = 16;
__device__ __forceinline__ float key2f(unsigned k) { return __uint_as_float((k & 0x80000000u) ? (k & 0x7fffffffu) : ~k); }
__device__ __forceinline__ unsigned sel_count_lane(const unsigned (&key)[8][16], unsigned c) {
    int n = 0;
#pragma unroll
    for (int i = 0; i < 8; ++i) {
#pragma unroll
        for (int r = 0; r < 16; ++r) {
            n += (key[i][r] >= c) ? 1 : 0;
            if ((r & 7) == 7) asm volatile("" : "+v"(n));
        }
    }
    return (unsigned)n;
}
__device__ __forceinline__ unsigned sel_exchange(unsigned nl, int r32, int hi, int wave, LAS unsigned* cb) {
    const unsigned n2 = nl + (unsigned)__shfl_xor((int)nl, 32);
    if (hi == 0) cb[wave * 32 + r32] = n2;
    __syncthreads();
    unsigned tot = 0;
#pragma unroll
    for (int w = 0; w < 8; ++w) tot += cb[w * 32 + r32];
    return tot;
}
__device__ __forceinline__ void sel_item2(const bf16_t* PROJ, unsigned* MASK, int b, int qt, int lane, int wave, LAS unsigned char* L) {
    asm volatile("" : "+v"(lane));
    const int r32 = lane & 31, hi = lane >> 5, tid = wave * 64 + lane;
    LAS unsigned* cntb = (LAS unsigned*)(L + SEL_CNT_OFF);
    const bf16_t* base = PROJ + (size_t)b * SEQ * LDP;
    unsigned* mrow = MASK + (((size_t)b * 64 + qt) * 64) * 32;
    if (qt < 8) {
#pragma unroll
        for (int i = 0; i < 8; ++i) {
            const int kt = wave + 8 * i;
            if (kt <= qt) {
                unsigned bits = 0u;
#pragma unroll
                for (int r = 0; r < 16; ++r) bits |= ((kt < qt) || (crow(r, hi) <= r32)) ? (1u << r) : 0u;
                const unsigned other = __shfl_xor(bits, 32);
                if (hi == 0) mrow[kt * 32 + r32] = bits | (other << 16);
            }
        }
        return;
    }
    for (int n = tid; n < 1024; n += 512) { const int row = n >> 5, ch = n & 31;
        const v4u v = *(const v4u*)(base + (size_t)(32 * qt + row) * LDP + C_IDQ + ch * 8);
        *(LAS v4u*)(L + row * SEL_IQ_PITCH + ch * 16) = v; }
    float w8[8];
    { const v4u wv = *(const v4u*)(base + (size_t)(32 * qt + r32) * LDP + C_IDW);
      w8[0] = __uint_as_float(wv.x << 16) * 0.0625f; w8[1] = __uint_as_float(wv.x & 0xffff0000u) * 0.0625f; w8[2] = __uint_as_float(wv.y << 16) * 0.0625f; w8[3] = __uint_as_float(wv.y & 0xffff0000u) * 0.0625f;
      w8[4] = __uint_as_float(wv.z << 16) * 0.0625f; w8[5] = __uint_as_float(wv.z & 0xffff0000u) * 0.0625f; w8[6] = __uint_as_float(wv.w << 16) * 0.0625f; w8[7] = __uint_as_float(wv.w & 0xffff0000u) * 0.0625f; }
    __syncthreads();
    unsigned key[8][16];
    const LAS unsigned char* iqp = L + r32 * SEL_IQ_PITCH + 16 * hi;
    unsigned kmn = 0xffffffffu, kmx = 0u;
#pragma unroll
    for (int i = 0; i < 8; ++i) {
        const int kt = wave + 8 * i;
        if (kt <= qt) {
            const bf16_t* kp = base + (size_t)(32 * kt + r32) * LDP + C_IDK + 8 * hi;
            const bf16x8 k0 = *(const bf16x8*)kp, k1 = *(const bf16x8*)(kp + 16);
            float sc[16];
#pragma unroll
            for (int r = 0; r < 16; ++r) sc[r] = 0.f;
            unsigned iqo = 0; asm volatile("" : "+v"(iqo));
            const LAS unsigned char* iqt = iqp + iqo;
#pragma unroll
            for (int h = 0; h < 8; ++h) {
                const bf16x8 q0 = *(const LAS bf16x8*)(iqt + h * 64), q1 = *(const LAS bf16x8*)(iqt + h * 64 + 32);
                bf16x8 q0p = q0, q1p = q1;
                asm volatile("" : "+v"(q0p), "+v"(q1p) : "v"(sc[15]));
                f32x16 D = MFMA32(k0, q0p, zero16());
                D = MFMA32(k1, q1p, D);
#pragma unroll
                for (int r = 0; r < 16; ++r) sc[r] += w8[h] * fmaxf(D[r], 0.f);
                asm volatile("" : "+v"(sc[0]), "+v"(sc[1]), "+v"(sc[2]), "+v"(sc[3]), "+v"(sc[4]), "+v"(sc[5]), "+v"(sc[6]), "+v"(sc[7]),
                                  "+v"(sc[8]), "+v"(sc[9]), "+v"(sc[10]), "+v"(sc[11]), "+v"(sc[12]), "+v"(sc[13]), "+v"(sc[14]), "+v"(sc[15]));
            }
            int thr = (kt < qt) ? 64 : (r32 - 4 * hi);
            asm volatile("" : "+v"(thr));
#pragma unroll
            for (int r = 0; r < 16; ++r) { const bool v = ((r & 3) + 8 * (r >> 2) <= thr); const unsigned k = ordkey(sc[r]); key[i][r] = v ? k : 0u; kmx = max(kmx, v ? k : 0u); kmn = min(kmn, v ? k : 0xffffffffu); }
        } else {
#pragma unroll
            for (int r = 0; r < 16; ++r) key[i][r] = 0u;
        }
    }
    unsigned lo_key, hi_key, clo, chi = 0u, nlo_l, nhi_l = 0u;
    {
        int nv = 0;
#pragma unroll
        for (int i = 0; i < 8; ++i) { const int kt = wave + 8 * i; nv += (kt < qt) ? 16 : 0; }
        if ((qt & 7) == wave) { const int thr = r32 - 4 * hi;
#pragma unroll
            for (int r = 0; r < 16; ++r) nv += ((r & 3) + 8 * (r >> 2) <= thr) ? 1 : 0; }
        nlo_l = (unsigned)nv;
        kmn = min(kmn, (unsigned)__shfl_xor((int)kmn, 32)); kmx = max(kmx, (unsigned)__shfl_xor((int)kmx, 32));
        if (hi == 0) { cntb[wave * 32 + r32] = kmn; cntb[256 + wave * 32 + r32] = kmx; }
        __syncthreads();
        unsigned a = 0xffffffffu, bmx = 0u;
#pragma unroll
        for (int w = 0; w < 8; ++w) { a = min(a, cntb[w * 32 + r32]); bmx = max(bmx, cntb[256 + w * 32 + r32]); }
        lo_key = a; hi_key = bmx + 1u; clo = (unsigned)(32 * qt + r32 + 1);
        __syncthreads();
    }
    int round = 0;
    for (;;) {
        const bool done = (clo - chi <= (unsigned)SEL_DONE) || (hi_key - lo_key <= 1u);
        if (__all(done)) break;
        unsigned p;
        if ((round & 3) == 3) p = lo_key + ((hi_key - lo_key) >> 1);
        else p = ordkey(0.5f * key2f(lo_key) + 0.5f * key2f(hi_key));
        p = min(max(p, lo_key + 1u), hi_key - 1u);
        if (done) p = lo_key;
        const unsigned nl = sel_count_lane(key, p);
        const unsigned tot = sel_exchange(nl, r32, hi, wave, cntb + (round & 1) * 256);
        if (!done) { if (tot >= 256u) { lo_key = p; clo = tot; nlo_l = nl; } else { hi_key = p; chi = tot; nhi_l = nl; } }
        ++round;
    }
    unsigned tau, cut;
    const bool many = (clo - chi > (unsigned)SEL_CAP);
    {
        LAS unsigned* lanecnt = (LAS unsigned*)L; LAS unsigned* meta = (LAS unsigned*)(L + 2048); LAS unsigned* result = (LAS unsigned*)(L + 2304); LAS unsigned* list = (LAS unsigned*)(L + 20480);
        const int slot = wave * 2 + hi;
        lanecnt[r32 * 16 + slot] = many ? 0u : (nlo_l - nhi_l);
        if (slot == 0) { meta[2 * r32] = many ? 0u : (clo - chi); meta[2 * r32 + 1] = 256u - chi; }
        __syncthreads();
        unsigned bs = 0u;
#pragma unroll
        for (int s2 = 0; s2 < 16; ++s2) { const unsigned v = lanecnt[r32 * 16 + s2]; bs += (s2 < slot) ? v : 0u; }
        if (!many) {
            const int idx0 = 32 * wave + 4 * hi;
            LAS unsigned* lp = list + (r32 * SEL_CAP + bs) * 2;
#pragma unroll
            for (int i = 0; i < 8; ++i)
#pragma unroll
                for (int r = 0; r < 16; ++r) {
                    const unsigned k = key[i][r];
                    if (k >= lo_key && k < hi_key) { lp[0] = k; lp[1] = (unsigned)(idx0 + 256 * i + (r & 3) + 8 * (r >> 2)); lp += 2; }
                }
        }
        __syncthreads();
        for (int j = 0; j < 4; ++j) {
            const int q = 4 * wave + j;
            const unsigned ncand = (unsigned)__builtin_amdgcn_readfirstlane((int)meta[2 * q]), need = (unsigned)__builtin_amdgcn_readfirstlane((int)meta[2 * q + 1]);
            const LAS unsigned* lq = list + q * SEL_CAP * 2;
            const bool mine = (unsigned)lane < ncand;
            const unsigned kc = mine ? lq[2 * lane] : 0u, ic = mine ? lq[2 * lane + 1] : 0u;
            unsigned rank = 0u;
            for (unsigned c2 = 0; c2 < ncand; ++c2) { const unsigned k2 = lq[2 * c2], i2 = lq[2 * c2 + 1]; rank += (k2 > kc || (k2 == kc && i2 < ic)) ? 1u : 0u; }
            if (mine && rank == need - 1u) { result[2 * q] = kc; result[2 * q + 1] = ic; }
        }
        __syncthreads();
        tau = result[2 * r32]; cut = result[2 * r32 + 1];
    }
    if (__any(many)) {
        const unsigned need = 256u - chi;
        const int idx0 = 32 * wave + 4 * hi;
        unsigned lo_ = 0u, hi_ = 2047u;
        for (int it = 0; it < 11; ++it) {
            const unsigned mid = (lo_ + hi_) >> 1;
            const unsigned f = sel_count_round<2>(key, mid, lo_key, idx0, r32, hi, wave, cntb + (it & 1) * 256);
            if (f >= need) hi_ = mid; else lo_ = mid + 1;
        }
        if (many) { tau = lo_key; cut = hi_; }
    }
    {
        const int idx0 = 32 * wave + 4 * hi;
#pragma unroll
        for (int i = 0; i < 8; ++i) {
            const int kt = wave + 8 * i;
            if (kt <= qt) {
                unsigned bits = 0u;
#pragma unroll
                for (int r = 0; r < 16; ++r) {
                    const bool s = (key[i][r] > tau) || (key[i][r] == tau && (unsigned)(idx0 + 256 * i + (r & 3) + 8 * (r >> 2)) <= cut);
                    bits |= s ? (1u << r) : 0u;
                }
                const unsigned other = __shfl_xor(bits, 32);
                if (hi == 0) mrow[kt * 32 + r32] = bits | (other << 16);
            }
        }
    }
    __syncthreads();
}

constexpr int WS_WUK = 0;
constexpr int WS_WUV = 256 * 1024;
constexpr int DSA_BIAS_OFF = 16384;
__device__ __forceinline__ float xhalf_max(float v) { auto rr = __builtin_amdgcn_permlane32_swap(__float_as_uint(v), __float_as_uint(v), false, false); return fmaxf(__uint_as_float(rr[0]), __uint_as_float(rr[1])); }
__device__ __forceinline__ float xhalf_sum(float v) { auto rr = __builtin_amdgcn_permlane32_swap(__float_as_uint(v), __float_as_uint(v), false, false); return __uint_as_float(rr[0]) + __uint_as_float(rr[1]); }
__device__ __forceinline__ unsigned dsa_off(unsigned row, unsigned ch) { return 256u * row + 16u * (ch ^ (((row & 3u) << 2) | ((row >> 2) & 3u))); }
__device__ __forceinline__ void dsa_round(const bf16_t* PROJ, const bf16_t* CKVN, const unsigned* MASK, const bf16_t* WUKp  , const bf16_t* WUVp  ,
                                          const float* rel_bias, bf16_t* MIX, int b, int o, int h, int lane, int wave, LAS unsigned char* L) {
    asm volatile("" : "+v"(lane));
    float NINF; asm volatile("v_mov_b32 %0, 0xff800000" : "=v"(NINF));
    const int r32 = lane & 31, hi = lane >> 5, tid = wave * 64 + lane;
    const int qt = 8 * o + wave, KT = 8 * o + 7, t = 32 * qt + r32;
    LAS float* biasT = (LAS float*)(L + DSA_BIAS_OFF);
    if (tid < 192) { const int bk = tid < 128 ? (int)T5TAB[tid] : 31; biasT[tid] = rel_bias[bk * 6 + h] * LOG2E; }
    const float bias31 = rel_bias[31 * 6 + h] * LOG2E;
    bf16x8 qlf[8];
    {
        const bf16_t* qrow = PROJ + ((size_t)b * SEQ + t) * LDP + C_DSQ + h * 64 + 8 * hi;
        bf16x8 qf[4];
#pragma unroll
        for (int ks = 0; ks < 4; ++ks) qf[ks] = *(const bf16x8*)(qrow + 16 * ks);
#pragma unroll
        for (int rt = 0; rt < 4; ++rt) {
            f32x16 X;
#pragma unroll
            for (int r = 0; r < 16; ++r) X[r] = 0.f;
            const GAS bf16_t* wp = (const GAS bf16_t*)WUKp + (rt * 32 + r32) * 64 + 8 * hi;
#pragma unroll
            for (int ks = 0; ks < 4; ++ks) X = MFMA32(*(const GAS bf16x8*)(wp + 16 * ks), qf[ks], X);
#pragma unroll
            for (int r = 0; r < 16; ++r) X[r] *= 0.125f * LOG2E;
            qlf[2 * rt] = pack8(X, 0); qlf[2 * rt + 1] = pack8(X, 1);
        }
    }
    f32x16 O[4];
#pragma unroll
    for (int c = 0; c < 4; ++c)
#pragma unroll
        for (int r = 0; r < 16; ++r) O[c][r] = 0.f;
    float mref = NINF, lrun = 0.f;
    const int srow = tid >> 4, sch = tid & 15;
    const bf16_t* csrc = CKVN + ((size_t)b * SEQ + srow) * 128 + 8 * sch;
    const unsigned sdst = 2048u * (srow >> 3) + 512u * (sch >> 2) + 64u * (srow & 7) + 16u * ((sch & 3) ^ ((srow >> 2) & 3));
    const unsigned x2 = ((unsigned)r32 >> 2) & 3u;
    const unsigned rb_e = 2048u * ((unsigned)r32 >> 3) + 64u * ((unsigned)r32 & 7u) + 16u * ((unsigned)hi ^ x2);
    const unsigned rb_o = 2048u * ((unsigned)r32 >> 3) + 64u * ((unsigned)r32 & 7u) + 16u * ((2u + (unsigned)hi) ^ x2);
    const unsigned tq = (lane & 15) >> 2, tp = lane & 3, tblk = (lane >> 4) & 1;
    const unsigned tb0 = 64u * (4u * hi + tq) + 16u * ((2u * tblk + (tp >> 1)) ^ ((unsigned)hi & 3u)) + 8u * (tp & 1);
    const unsigned tb1 = 64u * (4u * hi + tq) + 16u * ((2u * tblk + (tp >> 1)) ^ ((2u + (unsigned)hi) & 3u)) + 8u * (tp & 1);
    const unsigned* mrow = MASK + (((size_t)b * 64 + qt) * 64) * 32 + r32;
    {
        const v4u v0 = *(const v4u*)csrc;
        *(LAS v4u*)(L + sdst) = v0;
    }
    unsigned mwn = mrow[0];
    for (int kt = 0; kt <= KT; ++kt) {
        v4u vn;
        if (kt < KT) vn = *(const v4u*)(csrc + (size_t)(32 * (kt + 1)) * 128);
        const unsigned mwc = mwn;
        if (kt < qt) mwn = mrow[(kt + 1) * 32];
        __syncthreads();
        const LAS unsigned char* Cb = L + (kt & 1) * 8192;
        if (kt <= qt) {
            f32x16 S;
#pragma unroll
            for (int r = 0; r < 16; ++r) S[r] = 0.f;
#pragma unroll
            for (int ks = 0; ks < 8; ++ks) {
                const bf16x8 a = *(const LAS bf16x8*)(Cb + ((ks & 1) ? rb_o : rb_e) + 512u * (ks >> 1));
                S = MFMA32(a, qlf[ks], S);
            }
            const unsigned mw = mwc >> (16 * hi);
            const int dq = qt - kt;
            float cb = bias31;
            if (dq < 5) {
                cb = 0.f;
                const int rel0 = 32 * dq + r32 - 4 * hi;
#pragma unroll
                for (int r = 0; r < 16; ++r) { int rel = rel0 - ((r & 3) + 8 * (r >> 2)); rel = rel < 0 ? 0 : rel; S[r] += biasT[rel]; }
            }
            float mx = fmaxf(S[0], S[1]);
#pragma unroll
            for (int r = 2; r < 16; ++r) mx = fmaxf(mx, S[r]);
            mx = xhalf_max(mx) + cb;
            if (__any(mx > mref + 8.f)) {
                float mm = NINF;
#pragma unroll
                for (int r = 0; r < 16; ++r) mm = fmaxf(mm, ((mw >> r) & 1u) ? S[r] : NINF);
                mm = xhalf_max(mm) + cb;
                const float mn = fmaxf(mref, mm);
                if (mn > mref) {
                    const float alpha = __builtin_amdgcn_exp2f(mref - mn);
                    lrun *= alpha;
#pragma unroll
                    for (int c = 0; c < 4; ++c)
#pragma unroll
                        for (int r = 0; r < 16; ++r) O[c][r] *= alpha;
                    mref = mn;
                }
            }
            const float off = ((mref == NINF) ? 0.f : mref) - cb;
            float ps = 0.f;
#pragma unroll
            for (int r = 0; r < 16; ++r) {
                const float e = __builtin_amdgcn_exp2f(S[r] - off);
                const int m1 = __builtin_amdgcn_sbfe((int)mw, r, 1);
                S[r] = __uint_as_float(__float_as_uint(e) & (unsigned)m1);
                ps += S[r];
            }
            lrun += ps;
            const bf16x8 p0 = pack8(S, 0), p1 = pack8(S, 1);
#pragma unroll
            for (int c = 0; c < 4; ++c) {
                s16x4 f[4];
#pragma unroll
                for (int st = 0; st < 4; ++st) {
                    f[st] = vtr(Cb + ((st & 1) ? tb1 : tb0) + 2048u * st + 512u * c);
                }
                O[c] = MFMA32(cat44(f[0], f[1]), p0, O[c]);
                O[c] = MFMA32(cat44(f[2], f[3]), p1, O[c]);
            }
        }
        if (kt < KT) *(LAS v4u*)(L + ((kt + 1) & 1) * 8192 + sdst) = vn;
    }
    const float lt = xhalf_sum(lrun);
    const float il = 1.f / lt;
    f32x16 Y[2];
#pragma unroll
    for (int r = 0; r < 16; ++r) { Y[0][r] = 0.f; Y[1][r] = 0.f; }
#pragma unroll
    for (int rt = 0; rt < 4; ++rt) {
#pragma unroll
        for (int r = 0; r < 16; ++r) O[rt][r] *= il;
        const bf16x8 x0 = pack8(O[rt], 0), x1 = pack8(O[rt], 1);
#pragma unroll
        for (int c = 0; c < 2; ++c) {
            int l3 = lane; asm volatile("" : "+v"(l3));
            const GAS bf16_t* wp = (const GAS bf16_t*)WUVp + ((((c * 4 + rt) * 2 + 0) * 32 + (l3 & 31)) * 2 + (l3 >> 5)) * 8;
            Y[c] = MFMA32(*(const GAS bf16x8*)wp, x0, Y[c]);
            Y[c] = MFMA32(*(const GAS bf16x8*)(wp + 32 * 2 * 8), x1, Y[c]);
        }
    }
    {
        int l2 = lane; asm volatile("" : "+v"(l2));
        const int t2 = 32 * qt + (l2 & 31);
        gate_store(Y, 1.f, PROJ + ((size_t)b * SEQ + t2) * LDP + C_DSG + h * 64, MIX + ((size_t)b * SEQ + t2) * DM + 384 + h * 64, l2 >> 5);
    }
    __syncthreads();
}

constexpr int DSA2_BIAS_OFF = 32768;

__device__ __forceinline__ void dsa_round2(const bf16_t* PROJ, const bf16_t* CKVN, const unsigned* MASK, const bf16_t* WUKp, const bf16_t* WUVp,
                                           const float* rel_bias, bf16_t* MIX, int b, int o, int h, int lane, int wave, LAS unsigned char* L) {
    asm volatile("" : "+v"(lane));
    const int r32 = lane & 31, hi = lane >> 5, tid = wave * 64 + lane;
    const int qt = 8 * o + wave, NS = 4 * o + 4, t = 32 * qt + r32;
    LAS float* biasT = (LAS float*)(L + DSA2_BIAS_OFF);
    if (tid < 192) { const int bk = tid < 128 ? (int)T5TAB[tid] : 31; biasT[tid] = rel_bias[bk * 6 + h] * LOG2E; }
    const float bias31 = rel_bias[31 * 6 + h] * LOG2E;
    bf16x8 qlf[8];
    {
        const bf16_t* qrow = PROJ + ((size_t)b * SEQ + t) * LDP + C_DSQ + h * 64 + 8 * hi;
        bf16x8 qf[4];
#pragma unroll
        for (int ks = 0; ks < 4; ++ks) qf[ks] = *(const bf16x8*)(qrow + 16 * ks);
#pragma unroll
        for (int rt = 0; rt < 4; ++rt) {
            f32x16 X = zero16();
            const GAS bf16_t* wp = (const GAS bf16_t*)WUKp + (rt * 32 + r32) * 64 + 8 * hi;
#pragma unroll
            for (int ks = 0; ks < 4; ++ks) X = MFMA32(*(const GAS bf16x8*)(wp + 16 * ks), qf[ks], X);
#pragma unroll
            for (int r = 0; r < 16; ++r) X[r] *= 0.125f * LOG2E;
            qlf[2 * rt] = pack8(X, 0); qlf[2 * rt + 1] = pack8(X, 1);
        }
    }
    f32x16 O[4];
#pragma unroll
    for (int c = 0; c < 4; ++c) O[c] = zero16();
    float mref = -INFINITY, lrun = 0.f;
    const int srow = tid >> 4, sch = tid & 15;
    const bf16_t* csrc = CKVN + ((size_t)b * SEQ + srow) * 128 + 8 * sch;
    const unsigned sdst = 2048u * (srow >> 3) + 512u * (sch >> 2) + 64u * (srow & 7) + 16u * ((sch & 3) ^ ((srow >> 2) & 3));
    const unsigned x2 = ((unsigned)r32 >> 2) & 3u;
    const unsigned rb_e = 2048u * ((unsigned)r32 >> 3) + 64u * ((unsigned)r32 & 7u) + 16u * ((unsigned)hi ^ x2);
    const unsigned rb_o = 2048u * ((unsigned)r32 >> 3) + 64u * ((unsigned)r32 & 7u) + 16u * ((2u + (unsigned)hi) ^ x2);
    const unsigned tq = (lane & 15) >> 2, tp = lane & 3, tblk = (lane >> 4) & 1;
    const unsigned tb0 = 64u * (4u * hi + tq) + 16u * ((2u * tblk + (tp >> 1)) ^ ((unsigned)hi & 3u)) + 8u * (tp & 1);
    const unsigned tb1 = 64u * (4u * hi + tq) + 16u * ((2u * tblk + (tp >> 1)) ^ ((2u + (unsigned)hi) & 3u)) + 8u * (tp & 1);
    const unsigned* mrow = MASK + (((size_t)b * 64 + qt) * 64) * 32 + r32;
    {
        const v4u v0 = *(const v4u*)csrc, v1 = *(const v4u*)(csrc + 32 * 128);
        *(LAS v4u*)(L + sdst) = v0; *(LAS v4u*)(L + 8192 + sdst) = v1;
    }
    unsigned mw0n = mrow[0], mw1n = (1 <= qt) ? mrow[32] : 0u;
    for (int st = 0; st < NS; ++st) {
        v4u vn0, vn1;
        if (st + 1 < NS) { vn0 = *(const v4u*)(csrc + (size_t)(64 * (st + 1)) * 128); vn1 = *(const v4u*)(csrc + (size_t)(64 * (st + 1) + 32) * 128); }
        const unsigned mwa = mw0n >> (16 * hi), mwb = mw1n >> (16 * hi);
        { const int k0 = 2 * st + 2, k1 = 2 * st + 3; mw0n = (k0 <= qt) ? mrow[k0 * 32] : 0u; mw1n = (k1 <= qt) ? mrow[k1 * 32] : 0u; }
        __syncthreads();
        const LAS unsigned char* Cb = L + (st & 1) * 16384;
#define DSA2_TILE(MW, TOFF, DQ) do { if ((DQ) >= 0) { \
            f32x16 Sa, Sb; \
            { const bf16x8 a0 = *(const LAS bf16x8*)(Cb + (TOFF) + rb_e), a1 = *(const LAS bf16x8*)(Cb + (TOFF) + rb_o); Sa = MFMA32(a0, qlf[0], zero16()); Sb = MFMA32(a1, qlf[1], zero16()); } \
            _Pragma("unroll") for (int k2 = 1; k2 < 4; ++k2) { \
                const bf16x8 a0 = *(const LAS bf16x8*)(Cb + (TOFF) + rb_e + 512u * k2), a1 = *(const LAS bf16x8*)(Cb + (TOFF) + rb_o + 512u * k2); \
                Sa = MFMA32(a0, qlf[2 * k2], Sa); Sb = MFMA32(a1, qlf[2 * k2 + 1], Sb); } \
            if ((DQ) >= 5) { _Pragma("unroll") for (int r = 0; r < 16; ++r) Sa[r] = (Sa[r] + Sb[r]) + bias31; } \
            else { const int rel0 = 32 * (DQ) + r32 - 4 * hi; \
                _Pragma("unroll") for (int r = 0; r < 16; ++r) { int rel = rel0 - ((r & 3) + 8 * (r >> 2)); rel = rel < 0 ? 0 : rel; Sa[r] = (Sa[r] + Sb[r]) + biasT[rel]; } } \
            float mx = Sa[0]; \
            _Pragma("unroll") for (int r = 1; r < 16; ++r) mx = fmaxf(mx, Sa[r]); \
            mx = xhalf_max(mx); \
            if (__any(mx > mref + 8.f)) { \
                float mm = -INFINITY; \
                _Pragma("unroll") for (int r = 0; r < 16; ++r) mm = fmaxf(mm, ((MW >> r) & 1u) ? Sa[r] : -INFINITY); \
                mm = xhalf_max(mm); \
                const float mn = fmaxf(mref, mm); \
                if (mn > mref) { const float alpha = __builtin_amdgcn_exp2f(mref - mn); lrun *= alpha; \
                    _Pragma("unroll") for (int c = 0; c < 4; ++c) _Pragma("unroll") for (int r = 0; r < 16; ++r) O[c][r] *= alpha; \
                    mref = mn; } } \
            const float ms = (mref == -INFINITY) ? 0.f : mref; \
            float ps = 0.f; \
            _Pragma("unroll") for (int r = 0; r < 16; ++r) { const float e = __builtin_amdgcn_exp2f(Sa[r] - ms); Sa[r] = ((MW >> r) & 1u) ? e : 0.f; ps += Sa[r]; } \
            lrun += ps; \
            const bf16x8 pa = pack8(Sa, 0), pb = pack8(Sa, 1); \
            _Pragma("unroll") for (int c = 0; c < 4; ++c) { s16x4 f[4]; \
                _Pragma("unroll") for (int st2 = 0; st2 < 4; ++st2) f[st2] = vtr(Cb + (TOFF) + ((st2 & 1) ? tb1 : tb0) + 2048u * st2 + 512u * c); \
                O[c] = MFMA32(cat44(f[0], f[1]), pa, O[c]); O[c] = MFMA32(cat44(f[2], f[3]), pb, O[c]); } } } while (0)
        { const int dq0 = qt - 2 * st, dq1 = dq0 - 1;
          DSA2_TILE(mwa, 0, dq0);
          DSA2_TILE(mwb, 8192, dq1); }
#undef DSA2_TILE
        if (st + 1 < NS) { LAS unsigned char* nb = L + ((st + 1) & 1) * 16384; *(LAS v4u*)(nb + sdst) = vn0; *(LAS v4u*)(nb + 8192 + sdst) = vn1; }
    }
    const float lt = xhalf_sum(lrun);
    const float il = 1.f / lt;
    f32x16 Y[2];
    Y[0] = zero16(); Y[1] = zero16();
#pragma unroll
    for (int rt = 0; rt < 4; ++rt) {
#pragma unroll
        for (int r = 0; r < 16; ++r) O[rt][r] *= il;
        const bf16x8 x0 = pack8(O[rt], 0), x1 = pack8(O[rt], 1);
#pragma unroll
        for (int c = 0; c < 2; ++c) {
            int l3 = lane; asm volatile("" : "+v"(l3));
            const GAS bf16_t* wp = (const GAS bf16_t*)WUVp + ((((c * 4 + rt) * 2 + 0) * 32 + (l3 & 31)) * 2 + (l3 >> 5)) * 8;
            Y[c] = MFMA32(*(const GAS bf16x8*)wp, x0, Y[c]);
            Y[c] = MFMA32(*(const GAS bf16x8*)(wp + 32 * 2 * 8), x1, Y[c]);
        }
    }
    {
        int l2 = lane; asm volatile("" : "+v"(l2));
        const int t2 = 32 * qt + (l2 & 31);
        gate_store(Y, 1.f, PROJ + ((size_t)b * SEQ + t2) * LDP + C_DSG + h * 64, MIX + ((size_t)b * SEQ + t2) * DM + 384 + h * 64, l2 >> 5);
    }
    __syncthreads();
}

typedef GAS unsigned gu32;
#define RLX_AGENT __ATOMIC_RELAXED, __HIP_MEMORY_SCOPE_AGENT
constexpr size_t WS_BAR = 512 * 1024;
#define XB_TMO      128
#define XB_XCNT(j)  (256  + 64 * (j))
#define XB_XSUB(j)  (1280 + 64 * (j))
#define XB_XGEN(j)  (2304 + 64 * (j))
#define XB_TOP      3328
#define XB_TOPGEN   3392
#define XCD_BAR_WORDS 3456
#define XB_SPIN_CAP (1u << 18)

__device__ __forceinline__ unsigned xb_ld(unsigned* p)              { return __hip_atomic_load(p, __ATOMIC_RELAXED, __HIP_MEMORY_SCOPE_AGENT); }
__device__ __forceinline__ unsigned xb_add(unsigned* p, unsigned v) { return __hip_atomic_fetch_add(p, v, __ATOMIC_RELAXED, __HIP_MEMORY_SCOPE_AGENT); }
__device__ __forceinline__ unsigned xb_xcc_id() { return (unsigned)__builtin_amdgcn_s_getreg((3 << 11) | 20) & 0xFu; }
#define XB_SPIN(cond, bar) do { unsigned _sp = 0; while (cond) { __builtin_amdgcn_s_sleep(1); \
    if ((++_sp & 255u) == 0u) { if (xb_ld(&(bar)[XB_TMO])) break; if (_sp > XB_SPIN_CAP) { atomicAdd(&(bar)[XB_TMO], 1u); break; } } } } while (0)

struct XcdBarrier {
    unsigned* bar; unsigned x;
    volatile LAS unsigned* st;
};

__device__ __forceinline__ XcdBarrier xcd_barrier_post(unsigned* bar, volatile LAS unsigned* st) {
    XcdBarrier b; b.bar = bar; b.x = xb_xcc_id(); b.st = st;
    if (threadIdx.x == 0) (void)xb_add(&bar[XB_XCNT(b.x)], 1u);
    return b;
}
__device__ __forceinline__ void xcd_barrier_complete(unsigned* bar, unsigned x, unsigned& nloc, unsigned& nx) {
    const unsigned G = gridDim.x * gridDim.y * gridDim.z;
    unsigned sum, cnt, mine, sp = 0u;
    for (;;) {
        sum = 0u; cnt = 0u; mine = 0u;
#pragma unroll
        for (unsigned j = 0; j < 16; ++j) { const unsigned c = xb_ld(&bar[XB_XCNT(j)]); sum += c; cnt += (c > 0u) ? 1u : 0u; mine = (j == x) ? c : mine; }
        if (sum == G) break;
        __builtin_amdgcn_s_sleep(1);
        if ((++sp & 255u) == 0u) { if (xb_ld(&bar[XB_TMO])) break; if (sp > XB_SPIN_CAP) { atomicAdd(&bar[XB_TMO], 1u); break; } }
    }
    nloc = mine > 0u ? mine : 1u; nx = cnt > 0u ? cnt : 1u;
}

__device__ __forceinline__ void xcd_barrier(const XcdBarrier& b) {
    asm volatile("s_waitcnt vmcnt(0)" ::: "memory");
    __syncthreads();
    if (threadIdx.x == 0) {
        unsigned* bar = b.bar;
        __builtin_amdgcn_s_waitcnt(0);
        unsigned nloc = b.st[0], nx = b.st[1];
        if (nloc == 0u) { xcd_barrier_complete(bar, b.x, nloc, nx); b.st[0] = nloc; b.st[1] = nx; }
        const unsigned old = xb_add(&bar[XB_XSUB(b.x)], 1u);
        const unsigned gen = old / nloc;
        if (old + 1u == (gen + 1u) * nloc) {
            __builtin_amdgcn_fence(__ATOMIC_RELEASE, "agent");
            asm volatile("s_waitcnt vmcnt(0)" ::: "memory");
            const unsigned og = xb_add(&bar[XB_TOP], 1u);
            const unsigned tg = og / nx;
            if (og + 1u == (tg + 1u) * nx) xb_add(&bar[XB_TOPGEN], 1u);
            else XB_SPIN(xb_ld(&bar[XB_TOPGEN]) == tg, bar);
            __builtin_amdgcn_fence(__ATOMIC_ACQUIRE, "agent");
            xb_add(&bar[XB_XGEN(b.x)], 1u);
            asm volatile("s_waitcnt vmcnt(0)" ::: "memory");
        } else {
            XB_SPIN(xb_ld(&bar[XB_XGEN(b.x)]) == gen, bar);
            __builtin_amdgcn_fence(__ATOMIC_ACQUIRE, "agent");
            asm volatile("s_waitcnt vmcnt(0)" ::: "memory");
        }
    }
    __syncthreads();
}

#ifndef MK_MULTI
#define MK_MULTI 0
#endif
constexpr int NPHASE = 11;
__global__ void __launch_bounds__(NWAVES * 64, 2) mk_fwd(Args args) {
    extern __shared__ __attribute__((aligned(16))) unsigned char lds_raw[];
    LAS unsigned char* lds = (LAS unsigned char*)lds_raw;
    const int tid0 = threadIdx.x;
    int wave_ = __builtin_amdgcn_readfirstlane(tid0 >> 6); asm volatile("" : "+s"(wave_));
    const int wave = wave_;
    const int G = gridDim.x, bid = blockIdx.x;
    for (int u = tid0; u < 16; u += NWAVES * 64) ((LAS unsigned*)(lds + 131072))[u] = 0u;
    __syncthreads();
    const XcdBarrier xbar = xcd_barrier_post((unsigned*)(args.ws + WS_BAR), (volatile LAS unsigned*)(lds + 131072));
    const int lo = args.ph_lo, hi = args.ph_hi;
#define IN(k) (lo <= (k) && (k) < hi)
#define SEAM(k) do { if (IN(k) && IN((k) + 1)) { if ((k) == 0) cg::this_grid().sync(); else xcd_barrier(xbar); } } while (0)
#define PH_BEGIN int lane = lane_id_v(); unsigned char* ws_ = args.ws; asm volatile("" : "+s"(ws_)); GAS unsigned char* ws = (GAS unsigned char*)ws_;     \
    const int gw = bid * NWAVES + wave, NGW = G * NWAVES; (void)gw; (void)NGW; \
    const int vcu = (bid & 7) * (G >> 3) + (bid >> 3); const int bb = vcu >> 3, w64 = (vcu & 7) * 8 + wave; (void)bb; (void)w64;
#define P_WIN ((bf16_t*)(ws + WS_WIN))
#define P_WOUT ((bf16_t*)(ws + WS_WOUT))
#define P_WMEM ((bf16_t*)(ws + WS_WMEM))
#define P_MEMB ((bf16_t*)(ws + WS_MEMB))
#define P_MEMKV ((bf16_t*)(ws + WS_MEMKV))
#define P_CKVN ((bf16_t*)(ws + WS_CKVN))
#define P_MASK ((unsigned*)(ws + WS_MASK))
#define P_H ((bf16_t*)(ws + WS_H))
#define P_MIX ((bf16_t*)(ws + WS_MIX))
#define P_PROJ ((bf16_t*)(ws + WS_PROJ))
#define P_Y ((bf16_t*)(ws + WS_Y))

    if (IN(0)) for (int rep_ = 0; rep_ < DUPN(0); ++rep_) {
        PH_BEGIN
        const float* x = args.in[0]; const float* mem = args.in[1]; const float* pre_g = args.in[2];
        const float* w_in = args.in[4]; const float* w_mem = args.in[8]; const float* w_out = args.in[9];
        LAS float* scr = (LAS float*)(lds + wave * 16384);
        constexpr int I_IN = 16 * (LDP / 32), I_OUT = 16 * 32, I_MEM = 16 * 16;
        constexpr int NITEMS = 2 * I_IN + 2 * I_OUT + 2 * I_MEM;
        for (int it = gw; it < NITEMS; it += NGW) {
            int r = it;
            if (r < 2 * I_IN) { const int l = r / I_IN; r -= l * I_IN; p0_transpose_item(w_in + (size_t)l * DM * NCOL, DM, NCOL, LDP, P_WIN + (size_t)l * LDP * DM, pre_g + l * DM, scr, r, lane); continue; }
            r -= 2 * I_IN;
            if (r < 2 * I_OUT) { const int l = r / I_OUT; r -= l * I_OUT; p0_transpose_item(w_out + (size_t)l * DM * DM, DM, DM, DM, P_WOUT + (size_t)l * DM * DM, nullptr, scr, r, lane); continue; }
            r -= 2 * I_OUT;
            { const int l = r / I_MEM; r -= l * I_MEM; p0_transpose_item(w_mem + (size_t)l * DM * 512, DM, 512, 512, P_WMEM + (size_t)l * 512 * DM, nullptr, scr, r, lane); }
        }
        {
            const float* w_uk = args.in[5]; const float* w_uv = args.in[6];
            bf16_t* WUKp = (bf16_t*)(ws + WS_WUK); bf16_t* WUVp = (bf16_t*)(ws + WS_WUV);
            for (int e = gw * 64 + lane; e < 2 * 6 * 8192; e += NGW * 64) {
                const int lh = e >> 13, l = lh / 6, h = lh % 6, w = e & 8191;
                { const int rt = w >> 11, rho = (w >> 6) & 31, d = w & 63; const int r = 32 * rt + ((rho & 0x13) | ((rho & 4) << 1) | ((rho & 8) >> 1));
                  WUKp[e] = (bf16_t)f2bf(w_uk[(((size_t)l * 128 + r) * 6 + h) * 64 + d]); }
                { const int j = w & 7, hh = (w >> 3) & 1, d32 = (w >> 4) & 31, s = (w >> 9) & 1, rt = (w >> 10) & 3, c = (w >> 12) & 1;
                  const int r = 32 * rt + 16 * s + 8 * (j >> 2) + 4 * hh + (j & 3), d = 32 * c + d32;
                  WUVp[e] = (bf16_t)f2bf(w_uv[(((size_t)l * 128 + r) * 6 + h) * 64 + d]); }
            }
        }
        for (int m = gw; m < NB * NMEM; m += NGW) row_to_bf16<false>(mem + (size_t)m * DM, P_MEMB + (size_t)m * DM, lane);
        for (int m = gw; m < NTOK; m += NGW) row_to_bf16<true>(x + (size_t)m * DM, P_H + (size_t)m * DM, lane);
    }
    SEAM(0);
#pragma unroll 1
    for (int l = 0; l < 2; ++l) {
        const int pb = 1 + 5 * l;
        if (IN(pb)) for (int rep_ = 0; rep_ < DUPN(1); ++rep_) {
            PH_BEGIN
            { pg8::Gemm g{P_H, P_WIN + (size_t)l * LDP * DM, NTOK, LDP, DM}; pg8::StaticOrder S; S.init(NTOK, LDP, G, bid);
              pg8::EpiBf16<0> E{P_PROJ, LDP, nullptr, 0, 0, 1.f};
              pg8::gemm_phase<pg8::EpiBf16<0>, pg8::StaticOrder, true, true>(lds, g, S, E, wave); }
            if (l == 0) {
              pg8::Gemm g{P_MEMB, P_WMEM, NB * NMEM, 1024, DM}; pg8::StaticOrder S; S.init(NB * NMEM, 1024, G, bid);
              pg8::EpiBf16<0> E{P_MEMKV, 1024, nullptr, 0, 0, 1.f};
              pg8::gemm_phase<pg8::EpiBf16<0>, pg8::StaticOrder, true, true>(lds, g, S, E, wave); }
        }
        SEAM(pb);
        if (IN(pb + 1)) {
            for (int rep_ = 0; rep_ < DUPN(2); ++rep_) { PH_BEGIN
              const float* kv_g = args.in[7];
              for (int m = gw; m < NTOK; m += NGW) ckvnorm_wave(P_PROJ, kv_g + l * 128, P_CKVN, m, lane); }
#ifndef SKIP_SB
            for (int rep_ = 0; rep_ < DUPN(3); ++rep_) { PH_BEGIN
              for (int i = 0; i < 6; ++i) { const int qt = (i & 1) ? 63 - w64 : w64; sb_item(P_PROJ, P_MIX, bb, i, qt, lane, lds + wave * 16384); } }
#endif
#ifndef SKIP_SEL
            __syncthreads();
            for (int rep_ = 0; rep_ < DUPN(4); ++rep_) { PH_BEGIN
              const int s8 = vcu & 7;
              for (int j = 0; j < 8; ++j) { const int qt = 8 * j + ((j & 1) ? 7 - s8 : s8); sel_item2(P_PROJ, P_MASK, bb, qt, lane, wave, lds); } }
            __syncthreads();
#endif
#ifndef SKIP_MEM
            for (int rep_ = 0; rep_ < DUPN(5); ++rep_) { PH_BEGIN
              for (int i = 0; i < 4; ++i) mem_item(P_PROJ, P_MEMKV + l * 512, P_MIX, bb, i, w64, lane, lds + wave * 16384); }
#endif
        }
        SEAM(pb + 1);
        if (IN(pb + 2)) for (int rep_ = 0; rep_ < DUPN(6); ++rep_) {
            PH_BEGIN
            const float* rel_bias = args.in[10];
            const int s8 = vcu & 7, hs = (s8 < 4) ? 0 : 3;
            __syncthreads();
            for (int oi = 0; oi < 2; ++oi) {
                const int o = oi ? 7 - (s8 & 3) : (s8 & 3);
                for (int hh = 0; hh < 3; ++hh) {
                    const int h = hs + hh;
                    dsa_round(P_PROJ, P_CKVN, P_MASK, (const bf16_t*)(ws + WS_WUK) + (size_t)(l * 6 + h) * 8192, (const bf16_t*)(ws + WS_WUV) + (size_t)(l * 6 + h) * 8192,
                              rel_bias, P_MIX, bb, o, h, lane, wave, lds);
                }
            }
        }
        SEAM(pb + 2);
        if (IN(pb + 3)) for (int rep_ = 0; rep_ < DUPN(7); ++rep_) {
            PH_BEGIN
            __syncthreads();
            pg8::Gemm g{P_MIX, P_WOUT + (size_t)l * DM * DM, NTOK, DM, DM}; pg8::StaticOrder S; S.init(NTOK, DM, G, bid);
            pg8::EpiBf16<0> E{P_Y, DM, nullptr, 0, 0, 1.f};
            pg8::gemm_phase<pg8::EpiBf16<0>, pg8::StaticOrder, true, true>(lds, g, S, E, wave);
        }
        SEAM(pb + 3);
        if (IN(pb + 4)) for (int rep_ = 0; rep_ < ((l == 0) ? DUPN(8) : 1); ++rep_) {
            PH_BEGIN
            const float* xin = (l == 0) ? args.in[0] : args.out; const float* post_g = args.in[3];
            for (int m = gw; m < NTOK; m += NGW) post_row(xin, P_Y, post_g + l * DM, args.out, (l == 0) ? P_H : (bf16_t*)nullptr, m, lane);
        }
        SEAM(pb + 4);
    }
#undef IN
#undef SEAM
}

extern "C" void kernel_launch(void* const* d_in, const int* in_sizes, int n_in, void* d_out, int out_size, void* d_ws, size_t ws_size, hipStream_t stream) {
    static int grid = 0;
    if (grid == 0) {
        if (n_in != 11 || ws_size < WS_END) { fprintf(stderr, "kernel_launch: unexpected n_in %d / ws_size %zu\n", n_in, ws_size); grid = -1; return; }
        int dev = 0, cus = 0, per_cu = 0;
        hipGetDevice(&dev);
        hipDeviceGetAttribute(&cus, hipDeviceAttributeMultiprocessorCount, dev);
        hipFuncSetAttribute((const void*)mk_fwd, hipFuncAttributeMaxDynamicSharedMemorySize, LDS_BYTES);
        hipOccupancyMaxActiveBlocksPerMultiprocessor(&per_cu, (const void*)mk_fwd, NWAVES * 64, LDS_BYTES);
        if (per_cu < 1) { fprintf(stderr, "kernel_launch: occupancy query says %d blocks per CU\n", per_cu); per_cu = 1; }
        grid = cus * 1;
        (void)hipGetLastError();
    }
    if (grid < 0) return;
    (void)hipMemsetAsync((char*)d_ws + WS_BAR, 0, 16384, stream);
    Args a{};
    for (int i = 0; i < 11; ++i) a.in[i] = (const float*)d_in[i];
    a.out = (float*)d_out; a.ws = (unsigned char*)d_ws;
#if MK_MULTI
    for (int p = 0; p < NPHASE; ++p) { a.ph_lo = p; a.ph_hi = p + 1; hipLaunchKernelGGL(mk_fwd, dim3(grid), dim3(NWAVES * 64), LDS_BYTES, stream, a); }
#else
    a.ph_lo = 0; a.ph_hi = NPHASE;
    void* kargs[] = {&a};
    hipError_t e = hipLaunchCooperativeKernel((const void*)mk_fwd, dim3(grid), dim3(NWAVES * 64), kargs, LDS_BYTES, stream);
    if (e != hipSuccess) fprintf(stderr, "cooperative launch failed: %s (grid %d)\n", hipGetErrorString(e), grid);
#endif
}
```

```cpp
#include <hip/hip_runtime.h>
#include <hip/hip_cooperative_groups.h>
#include <stdint.h>
#include <math.h>
#include <cstdio>
namespace cg = cooperative_groups;
__device__ __forceinline__ int lane_id_v() { int l; asm volatile("v_mbcnt_lo_u32_b32 %0, -1, 0\n\tv_mbcnt_hi_u32_b32 %0, -1, %0" : "=v"(l)); return l; }
namespace pg8 {
#define PG8_LAS __attribute__((address_space(3)))
typedef unsigned short bf16_t;
typedef short bf16x8 __attribute__((ext_vector_type(8)));
typedef float f32x4 __attribute__((ext_vector_type(4)));
typedef unsigned u32x4 __attribute__((ext_vector_type(4)));
constexpr int BM = 256, BK = 64, HALF = 128, HTB = HALF * BK * 2  , STAGE_BYTES = 8 * HTB, NXCD = 8, WGM = 8;

__host__ __device__ __forceinline__ int lds_byte(int r, int c) { const int st = (r >> 4) * 2 + (c >> 5), rr = r & 15, cc = c & 31, ob = rr * 64 + cc * 2; return st * 1024 + (ob ^ (((ob >> 9) & 1) << 5)); }
__host__ __device__ __forceinline__ void stage_rc(int b, int& R, int& C) { const int st = b / 1024, sb = b % 1024, swz = sb ^ (((sb >> 9) & 1) << 5); R = (st >> 1) * 16 + swz / 64; C = (st & 1) * 32 + (swz % 64) / 2; }
__host__ __device__ __forceinline__ int perm32(int rho) { const int n = rho >> 4, i = rho & 15; return 8 * (i >> 2) + 4 * n + (i & 3); }

struct Unit { int pm, pn; };
struct Gemm { const bf16_t* A; const bf16_t* Bt; int M, N, K; };

struct StaticOrder {
    int nM, nN, nwg, G, c;
    __host__ __device__ void init(int M, int N, int G_, int c_) { nM = M / BM; nN = N / BM; nwg = nM * nN; G = G_; c = c_; }
    __host__ __device__ bool next(int i, Unit& u) const {
        const long L = (long)i * G + c; if (L >= nwg) return false;
        int wgid = (int)L; { const int q = nwg / NXCD, r = nwg % NXCD, xcd = wgid % NXCD, off = wgid / NXCD; wgid = (xcd < r ? xcd * (q + 1) : r * (q + 1) + (xcd - r) * q) + off; }
        const int nig = WGM * nN, gid = wgid / nig, fm = gid * WGM, gsz = (nM - fm) < WGM ? (nM - fm) : WGM;
        u.pm = fm + ((wgid % nig) % gsz); u.pn = (wgid % nig) / gsz; return true;
    }
    __device__ __forceinline__ void a_ready(const Unit&) const {}
    __device__ __forceinline__ void done(const Unit&) const {}
};

__device__ __forceinline__ unsigned cvt_pk_bf16(float lo, float hi) { unsigned r; asm volatile("v_cvt_pk_bf16_f32 %0, %1, %2" : "=v"(r) : "v"(lo), "v"(hi)); return r; }
typedef float f32x2 __attribute__((ext_vector_type(2)));
__device__ __forceinline__ f32x2 gelu_pk(f32x2 v) {
    const f32x2 av = __builtin_elementwise_abs(v), d = av * 0.2316418882f + 1.0f;
    f32x2 t; t.x = __builtin_amdgcn_rcpf(d.x); t.y = __builtin_amdgcn_rcpf(d.y);
    f32x2 q = t * 0.5307027145f + (-0.7265760135f); q = q * t + 0.7107068705f; q = q * t + (-0.142248368f); q = q * t + 0.127414796f; q = q * t;
    const f32x2 s = (v * v) * (-0.72134752044f);
    f32x2 e; e.x = __builtin_amdgcn_exp2f(s.x); e.y = __builtin_amdgcn_exp2f(s.y);
    const f32x2 m = v * (q * e), r = v - m;
    f32x2 o; o.x = v.x < 0.f ? m.x : r.x; o.y = v.y < 0.f ? m.y : r.y; return o;
}

template <int ACT  > struct EpiBf16 {
    static constexpr bool PERM = true, AFTER_DRAIN = false; static_assert(ACT == 0 || ACT == 1, "EpiBf16: ACT is 0 (none) or 1 (gelu_pk)");
    bf16_t* O; int ldc; const float* bias; int split_cols; size_t split_stride; float scale0;
    __device__ __forceinline__ void operator()(const f32x4 (&acc)[2][2][4][2], const Unit& u, int wr, int wc, int fr, int fq) const {
        const int row0 = u.pm * BM + wr * 64 + fr; int colt = u.pn * BM; bf16_t* base = O;
        float sc = 1.f; if (split_cols) { const int t = colt / split_cols; base += (size_t)t * split_stride; colt -= t * split_cols; if (t == 0) sc = scale0; }
        const int col0 = colt + wc * 32 + 8 * fq, bcol0 = u.pn * BM + wc * 32 + 8 * fq;
        f32x4 bv[2][2];
#pragma unroll
        for (int bj = 0; bj < 2; ++bj)
#pragma unroll
            for (int n = 0; n < 2; ++n) bv[bj][n] = bias ? *(const f32x4*)(bias + bcol0 + bj * HALF + 4 * n) : (f32x4){0.f, 0.f, 0.f, 0.f};
#pragma unroll
        for (int ai = 0; ai < 2; ++ai)
#pragma unroll
            for (int m = 0; m < 4; ++m) { bf16_t* rowp = base + (size_t)(row0 + ai * HALF + m * 16) * ldc + col0;
#pragma unroll
                for (int bj = 0; bj < 2; ++bj) { f32x4 v0 = acc[ai][bj][m][0] + bv[bj][0], v1 = acc[ai][bj][m][1] + bv[bj][1];
                    if (ACT == 1) { f32x2 a = gelu_pk((f32x2){v0[0], v0[1]}), b = gelu_pk((f32x2){v0[2], v0[3]}), c = gelu_pk((f32x2){v1[0], v1[1]}), d = gelu_pk((f32x2){v1[2], v1[3]});
                        v0 = (f32x4){a.x, a.y, b.x, b.y}; v1 = (f32x4){c.x, c.y, d.x, d.y}; }
                    v0 = v0 * sc; v1 = v1 * sc; u32x4 w; w.x = cvt_pk_bf16(v0[0], v0[1]); w.y = cvt_pk_bf16(v0[2], v0[3]); w.z = cvt_pk_bf16(v1[0], v1[1]); w.w = cvt_pk_bf16(v1[2], v1[3]);
                    *(u32x4*)(rowp + bj * HALF) = w; } }
    }
};
template <class Epi, class Sched, bool ALIGN_EPI = false, bool SP2 = false>
__device__ __forceinline__ void gemm_phase(PG8_LAS unsigned char* lds, const Gemm g, const Sched& S, const Epi& E, int wave_id) {
    int tid_ = wave_id * 64 + lane_id_v();
    const int tid = tid_, wid = __builtin_amdgcn_readfirstlane(tid >> 6), lane = tid & 63, wr = wid >> 2, wc = wid & 3, fr = lane & 15, fq = lane >> 4;
    const int K = g.K, nt = K / BK;
    unsigned voffA[2], voffB[2];
#pragma unroll
    for (int i = 0; i < 2; ++i) { int R, C; stage_rc(tid * 16 + i * 8192, R, C); const int Rb = Epi::PERM ? ((R & ~31) + perm32(R & 31)) : R;
        voffA[i] = (unsigned)(R * K + C) * 2u; voffB[i] = (unsigned)(Rb * K + C) * 2u; }
    const size_t kstep = (size_t)(BK * 2);
    const size_t hstep = (size_t)HALF * K * 2;
    const size_t tstep = 2 * hstep;
    const unsigned ldsw = (unsigned)wid * 1024u;
    const int aoff = lds_byte(wr * 64 + fr, fq * 8), boff = lds_byte(wc * 32 + fr, fq * 8);
#define PG8_SA(b, h) (((b) * 2 + (h)) * HTB)
#define PG8_SB(b, h) ((4 + (b) * 2 + (h)) * HTB)
#define PG8_STAGE(bufoff, gbase, voff) do { _Pragma("unroll") for (int _i = 0; _i < 2; ++_i) \
        __builtin_amdgcn_global_load_lds((const unsigned*)((const char*)(gbase) + (voff)[_i]), (PG8_LAS unsigned*)(lds + (bufoff) + ldsw + _i * 8192), 16, 0, 0); } while (0)
#define PG8_LDA(dst, b, h) do { _Pragma("unroll") for (int m = 0; m < 4; ++m) _Pragma("unroll") for (int k = 0; k < 2; ++k) dst[m][k] = *(const PG8_LAS bf16x8*)(lds + PG8_SA(b, h) + aoff + m * 2048 + k * 1024); } while (0)
#define PG8_LDB(dst, b, h) do { _Pragma("unroll") for (int n = 0; n < 2; ++n) _Pragma("unroll") for (int k = 0; k < 2; ++k) dst[n][k] = *(const PG8_LAS bf16x8*)(lds + PG8_SB(b, h) + boff + n * 2048 + k * 1024); } while (0)
#define PG8_MMA(ai, bj, At, Bt) do { __builtin_amdgcn_s_setprio(1); _Pragma("unroll") for (int m = 0; m < 4; ++m) _Pragma("unroll") for (int n = 0; n < 2; ++n) _Pragma("unroll") for (int k = 0; k < 2; ++k) \
        acc[ai][bj][m][n] = __builtin_amdgcn_mfma_f32_16x16x32_bf16(Bt[n][k], At[m][k], acc[ai][bj][m][n], 0, 0, 0); __builtin_amdgcn_s_setprio(0); } while (0)
#define PG8_WAIT_V(n) asm volatile("s_waitcnt vmcnt(" #n ")" ::: "memory")
#define PG8_WAIT_L(n) asm volatile("s_waitcnt lgkmcnt(" #n ")" ::: "memory")
#define PG8_BAR __builtin_amdgcn_s_barrier()
#define PG8_SCHED __builtin_amdgcn_sched_barrier(0)
    Unit cur, nxt; int ui = 0;
    if (!S.next(0, cur)) return;
    f32x4 acc[2][2][4][2];
#pragma unroll
    for (int a = 0; a < 2; ++a)
#pragma unroll
        for (int b = 0; b < 2; ++b)
#pragma unroll
            for (int m = 0; m < 4; ++m)
#pragma unroll
                for (int n = 0; n < 2; ++n) acc[a][b][m][n] = (f32x4){0.f, 0.f, 0.f, 0.f};
    bf16x8 At[4][2], B0[2][2], B1[2][2];
    const char* cA = (const char*)g.A + (size_t)cur.pm * tstep; const char* cB = (const char*)g.Bt + (size_t)cur.pn * tstep;
    S.a_ready(cur);
    if constexpr (SP2) {
        PG8_STAGE(PG8_SB(0, 0), cB, voffB); PG8_STAGE(PG8_SB(0, 1), cB + hstep, voffB); PG8_STAGE(PG8_SA(0, 0), cA, voffA); PG8_STAGE(PG8_SA(0, 1), cA + hstep, voffA);
        if (wr == 1) PG8_BAR;
        PG8_WAIT_V(2); PG8_BAR;
        PG8_STAGE(PG8_SB(1, 0), cB + kstep, voffB); PG8_STAGE(PG8_SA(1, 0), cA + kstep, voffA); PG8_STAGE(PG8_SB(1, 1), cB + hstep + kstep, voffB);
        PG8_WAIT_V(6); PG8_BAR;
    } else {
        PG8_STAGE(PG8_SB(0, 0), cB, voffB); PG8_STAGE(PG8_SA(0, 0), cA, voffA); PG8_STAGE(PG8_SB(0, 1), cB + hstep, voffB); PG8_STAGE(PG8_SA(0, 1), cA + hstep, voffA);
        if (wr == 1) PG8_BAR;
        PG8_WAIT_V(4); PG8_BAR;
        PG8_STAGE(PG8_SB(1, 0), cB + kstep, voffB); PG8_STAGE(PG8_SA(1, 0), cA + kstep, voffA); PG8_STAGE(PG8_SB(1, 1), cB + hstep + kstep, voffB);
        PG8_WAIT_V(6); PG8_BAR;
    }
    for (;;) {
        const bool has_next = S.next(ui + 1, nxt);
        const char* nA = has_next ? (const char*)g.A + (size_t)nxt.pm * tstep : cA; const char* nB = has_next ? (const char*)g.Bt + (size_t)nxt.pn * tstep : cB;
        for (int t = 0; t < nt; t += 2) {
            const bool last = (t == nt - 2);
            const char* a1 = cA + (size_t)(t + 1) * kstep;
            const char* a2 = last ? nA : cA + (size_t)(t + 2) * kstep; const char* b2 = last ? nB : cB + (size_t)(t + 2) * kstep;
            const char* a3 = a2 + kstep; const char* b3 = b2 + kstep;
            if (last && has_next) S.a_ready(nxt);
            if constexpr (SP2) {
            PG8_LDB(B0, 0, 0); PG8_LDB(B1, 0, 1); PG8_SCHED; PG8_LDA(At, 0, 0); PG8_STAGE(PG8_SA(1, 1), a1 + hstep, voffA);
            PG8_WAIT_V(8); PG8_WAIT_L(0); PG8_BAR; PG8_MMA(0, 0, At, B0); PG8_MMA(0, 1, At, B1); PG8_BAR; PG8_SCHED;
            PG8_LDA(At, 0, 1); PG8_STAGE(PG8_SB(0, 0), b2, voffB); PG8_STAGE(PG8_SB(0, 1), b2 + hstep, voffB); PG8_STAGE(PG8_SA(0, 0), a2, voffA);
            PG8_WAIT_V(8); PG8_WAIT_L(0); PG8_BAR; PG8_MMA(1, 0, At, B0); PG8_MMA(1, 1, At, B1); PG8_BAR; PG8_SCHED;
            PG8_LDB(B0, 1, 0); PG8_LDB(B1, 1, 1); PG8_SCHED; PG8_LDA(At, 1, 0); PG8_STAGE(PG8_SA(0, 1), a2 + hstep, voffA);
            PG8_WAIT_V(8); PG8_WAIT_L(0); PG8_BAR; PG8_MMA(0, 0, At, B0); PG8_MMA(0, 1, At, B1); PG8_BAR; PG8_SCHED;
            PG8_LDA(At, 1, 1); PG8_STAGE(PG8_SB(1, 0), b3, voffB); PG8_STAGE(PG8_SB(1, 1), b3 + hstep, voffB); PG8_STAGE(PG8_SA(1, 0), a3, voffA);
            PG8_WAIT_V(8); PG8_WAIT_L(0); PG8_BAR; PG8_MMA(1, 0, At, B0); PG8_MMA(1, 1, At, B1); PG8_BAR; PG8_SCHED;
            } else {
            PG8_LDB(B0, 0, 0); PG8_SCHED; PG8_LDA(At, 0, 0); PG8_STAGE(PG8_SA(1, 1), a1 + hstep, voffA);
            PG8_WAIT_L(8); PG8_BAR; PG8_WAIT_L(0); PG8_MMA(0, 0, At, B0); PG8_BAR; PG8_SCHED;
            PG8_LDB(B1, 0, 1); PG8_STAGE(PG8_SB(0, 0), b2, voffB);
            PG8_BAR; PG8_WAIT_L(0); PG8_MMA(0, 1, At, B1); PG8_BAR;
            PG8_LDA(At, 0, 1); PG8_STAGE(PG8_SA(0, 0), a2, voffA);
            PG8_BAR; PG8_WAIT_L(0); PG8_MMA(1, 0, At, B0); PG8_BAR; PG8_SCHED;
            PG8_STAGE(PG8_SB(0, 1), b2 + hstep, voffB);
            PG8_WAIT_V(6); PG8_BAR; PG8_MMA(1, 1, At, B1); PG8_BAR;
            PG8_LDB(B0, 1, 0); PG8_SCHED; PG8_LDA(At, 1, 0); PG8_STAGE(PG8_SA(0, 1), a2 + hstep, voffA);
            PG8_WAIT_L(8); PG8_BAR; PG8_WAIT_L(0); PG8_MMA(0, 0, At, B0); PG8_BAR; PG8_SCHED;
            PG8_LDB(B1, 1, 1); PG8_STAGE(PG8_SB(1, 0), b3, voffB);
            PG8_BAR; PG8_WAIT_L(0); PG8_MMA(0, 1, At, B1); PG8_BAR;
            PG8_LDA(At, 1, 1); PG8_STAGE(PG8_SA(1, 0), a3, voffA);
            PG8_BAR; PG8_WAIT_L(0); PG8_MMA(1, 0, At, B0); PG8_BAR; PG8_SCHED;
            PG8_STAGE(PG8_SB(1, 1), b3 + hstep, voffB);
            PG8_WAIT_V(6); PG8_BAR; PG8_MMA(1, 1, At, B1); PG8_BAR;
            }
        }
        if constexpr (ALIGN_EPI) { if (wr == 0) PG8_BAR; }
        if constexpr (!Epi::AFTER_DRAIN) { E(acc, cur, wr, wc, fr, fq); S.done(cur); }
        if (!has_next) break;
#pragma unroll
        for (int a = 0; a < 2; ++a)
#pragma unroll
            for (int b = 0; b < 2; ++b)
#pragma unroll
                for (int m = 0; m < 4; ++m)
#pragma unroll
                    for (int n = 0; n < 2; ++n) acc[a][b][m][n] = (f32x4){0.f, 0.f, 0.f, 0.f};
        cur = nxt; cA = nA; cB = nB; ++ui;
        if constexpr (ALIGN_EPI) { if (wr == 1) PG8_BAR; }
    }
    PG8_WAIT_V(0);
    if constexpr (!ALIGN_EPI) { if (wr == 0) PG8_BAR; }
    PG8_BAR;
    if constexpr (Epi::AFTER_DRAIN) { E.fused(acc, cur, wr, wc, fr, fq, lds, wid, lane); S.done(cur); }
#undef PG8_SA
#undef PG8_SB
#undef PG8_STAGE
#undef PG8_LDA
#undef PG8_LDB
#undef PG8_MMA
#undef PG8_WAIT_V
#undef PG8_WAIT_L
#undef PG8_BAR
#undef PG8_SCHED
}
}
typedef unsigned short bf16_t;
#define LAS __attribute__((address_space(3)))
#define GAS __attribute__((address_space(1)))
typedef unsigned v4u __attribute__((ext_vector_type(4)));
typedef unsigned v2u __attribute__((ext_vector_type(2)));
typedef float f32x4 __attribute__((ext_vector_type(4)));
constexpr int DM = 1024, NB = 32, SEQ = 2048, NTOK = NB * SEQ, NMEM = 256;
constexpr int LDP = 3328;
constexpr int C_SBQ = 0, C_SBK = 384, C_SBV = 768, C_SBG = 1152, C_DSQ = 1536, C_CKV = 1920, C_DSG = 2048,
              C_IDQ = 2432, C_IDK = 2688, C_IDW = 2720, C_MQ = 2728, C_MG = 2984, NCOL = 3240;
constexpr float EPS = 1e-6f;
constexpr size_t MiB = 1u << 20;
constexpr size_t WS_CTL = 0;
constexpr size_t WS_WIN = 1 * MiB;
constexpr size_t WS_WOUT = 14 * MiB;
constexpr size_t WS_WMEM = 18 * MiB;
constexpr size_t WS_MEMB = 20 * MiB;
constexpr size_t WS_MEMKV = 36 * MiB;
constexpr size_t WS_CKVN = 52 * MiB;
constexpr size_t WS_MASK = 68 * MiB;
constexpr size_t WS_H = 84 * MiB;
constexpr size_t WS_MIX = WS_H;
constexpr size_t WS_PROJ = 212 * MiB;
constexpr size_t WS_Y = WS_PROJ;
constexpr size_t WS_END = 628 * MiB;
constexpr int LDS_BYTES = 135168;
constexpr int NWAVES = 8;

__device__ __forceinline__ float bf2f(bf16_t v) { return __uint_as_float(((unsigned)v) << 16); }
__device__ __forceinline__ unsigned f2bf(float f) { unsigned u = __float_as_uint(f); u += 0x7fffu + ((u >> 16) & 1u); return u >> 16; }
__device__ __forceinline__ unsigned pk2(float lo, float hi) { return f2bf(lo) | (f2bf(hi) << 16); }
#define WAVE_SYNC() do { asm volatile("s_waitcnt lgkmcnt(0)" ::: "memory"); __builtin_amdgcn_wave_barrier(); } while (0)
__device__ __forceinline__ float wave_sum(float v) {
#pragma unroll
    for (int o = 1; o < 64; o <<= 1) v += __shfl_xor(v, o);
    return v;
}

__device__ const unsigned char T5TAB[128] = {0, 1, 2, 3, 4, 5, 6, 7, 8, 9, 10, 11, 12, 13, 14, 15, 16, 16, 16, 17, 17, 18, 18, 18, 19, 19, 19, 20, 20, 20, 20, 21, 21, 21, 21, 22, 22, 22, 22, 22, 23, 23, 23, 23, 23, 23, 24, 24, 24, 24, 24, 24, 25, 25, 25, 25, 25, 25, 25, 26, 26, 26, 26, 26, 26, 26, 26, 27, 27, 27, 27, 27, 27, 27, 27, 27, 27, 28, 28, 28, 28, 28, 28, 28, 28, 28, 28, 29, 29, 29, 29, 29, 29, 29, 29, 29, 29, 29, 29, 30, 30, 30, 30, 30, 30, 30, 30, 30, 30, 30, 30, 30, 30, 31, 31, 31, 31, 31, 31, 31, 31, 31, 31, 31, 31, 31, 31, 31};

struct Args { const float* in[11]; float* out; unsigned char* ws; int ph_lo, ph_hi; };

__device__ __forceinline__ void p0_transpose_item(const float* W, int K, int N, int Npad, bf16_t* WT, const float* g, LAS float* scr, int item, int lane) {
    const int nblk = Npad / 32, kb = item / nblk, nb = item % nblk, k0 = 64 * kb, n0 = 32 * nb;
    const int nn = n0 + (lane & 31);
#pragma unroll 8
    for (int i = 0; i < 32; ++i) { const int kk = 2 * i + (lane >> 5); float v = (nn < N) ? W[(size_t)(k0 + kk) * N + nn] : 0.f; if (g) v *= g[k0 + kk]; scr[kk * 33 + (lane & 31)] = v; }
    WAVE_SYNC();
    const int c = lane & 7;
#pragma unroll
    for (int j = 0; j < 4; ++j) { const int n = (lane >> 3) + 8 * j; const LAS float* s = scr + (8 * c) * 33 + n;
        v4u o; o.x = pk2(s[0 * 33], s[1 * 33]); o.y = pk2(s[2 * 33], s[3 * 33]); o.z = pk2(s[4 * 33], s[5 * 33]); o.w = pk2(s[6 * 33], s[7 * 33]);
        *(v4u*)(WT + (size_t)(n0 + n) * K + k0 + 8 * c) = o; }
    WAVE_SYNC();
}
template <bool NORM> __device__ __forceinline__ void row_to_bf16(const float* xrow, bf16_t* orow, int lane) {
    const f32x4* xr = (const f32x4*)xrow + lane;
    f32x4 v[4]; float s = 0.f;
#pragma unroll
    for (int j = 0; j < 4; ++j) { v[j] = xr[64 * j]; s += (v[j].x * v[j].x + v[j].y * v[j].y) + (v[j].z * v[j].z + v[j].w * v[j].w); }
    float r = 1.f;
    if (NORM) r = 1.0f / sqrtf(wave_sum(s) * (1.f / DM) + EPS);
    v2u* o8 = (v2u*)orow + lane;
#pragma unroll
    for (int j = 0; j < 4; ++j) { v2u w; w.x = pk2(v[j].x * r, v[j].y * r); w.y = pk2(v[j].z * r, v[j].w * r); o8[64 * j] = w; }
}

__device__ __forceinline__ void ckvnorm4(const bf16_t* PROJ, const float* kvg, bf16_t* CKVN, int row0, int lane) {
    const int row = row0 + (lane >> 4), c8 = (lane & 15) * 8;
    const v4u v = *(const v4u*)(PROJ + (size_t)row * LDP + C_CKV + c8);
    float f[8] = {__uint_as_float(v.x << 16), __uint_as_float(v.x & 0xffff0000u), __uint_as_float(v.y << 16), __uint_as_float(v.y & 0xffff0000u),
                  __uint_as_float(v.z << 16), __uint_as_float(v.z & 0xffff0000u), __uint_as_float(v.w << 16), __uint_as_float(v.w & 0xffff0000u)};
    float s = 0.f;
#pragma unroll
    for (int j = 0; j < 8; ++j) s += f[j] * f[j];
    s += __shfl_xor(s, 1); s += __shfl_xor(s, 2); s += __shfl_xor(s, 4); s += __shfl_xor(s, 8);
    const float r = 1.0f / sqrtf(s * (1.0f / 128.f) + EPS);
    const f32x4 g0 = *(const f32x4*)(kvg + c8), g1 = *(const f32x4*)(kvg + c8 + 4);
    v4u o; o.x = pk2(f[0] * r * g0.x, f[1] * r * g0.y); o.y = pk2(f[2] * r * g0.z, f[3] * r * g0.w); o.z = pk2(f[4] * r * g1.x, f[5] * r * g1.y); o.w = pk2(f[6] * r * g1.z, f[7] * r * g1.w);
    *(v4u*)(CKVN + (size_t)row * 128 + c8) = o;
}
__device__ __forceinline__ unsigned ordkey(float f) { unsigned u = __float_as_uint(f); return (u & 0x80000000u) ? ~u : (u | 0x80000000u); }
__device__ __forceinline__ void post_row(const float* xin, const bf16_t* Y, const float* g, float* xout, bf16_t* Hn, int row, int lane) {
    const bf16_t* yp = Y + (size_t)row * DM;
    float yv[16]; float s = 0.f;
#pragma unroll
    for (int j = 0; j < 4; ++j) {
        const v2u v = *(const v2u*)(yp + (lane + 64 * j) * 4);
        yv[4 * j + 0] = __uint_as_float(v.x << 16); yv[4 * j + 1] = __uint_as_float(v.x & 0xffff0000u);
        yv[4 * j + 2] = __uint_as_float(v.y << 16); yv[4 * j + 3] = __uint_as_float(v.y & 0xffff0000u);
        s += yv[4 * j] * yv[4 * j] + yv[4 * j + 1] * yv[4 * j + 1] + yv[4 * j + 2] * yv[4 * j + 2] + yv[4 * j + 3] * yv[4 * j + 3];
    }
    const float r = 1.0f / sqrtf(wave_sum(s) * (1.0f / DM) + EPS);
    f32x4 ov[4]; float s2 = 0.f;
#pragma unroll
    for (int j = 0; j < 4; ++j) {
        const int c = (lane + 64 * j) * 4;
        const f32x4 xv = *(const f32x4*)(xin + (size_t)row * DM + c);
        const f32x4 gv = *(const f32x4*)(g + c);
        ov[j].x = xv.x + yv[4 * j] * r * gv.x; ov[j].y = xv.y + yv[4 * j + 1] * r * gv.y; ov[j].z = xv.z + yv[4 * j + 2] * r * gv.z; ov[j].w = xv.w + yv[4 * j + 3] * r * gv.w;
        *(f32x4*)(xout + (size_t)row * DM + c) = ov[j];
        s2 += (ov[j].x * ov[j].x + ov[j].y * ov[j].y) + (ov[j].z * ov[j].z + ov[j].w * ov[j].w);
    }
    if (Hn) {
        const float r2 = 1.0f / sqrtf(wave_sum(s2) * (1.f / DM) + EPS);
        v2u* o8 = (v2u*)(Hn + (size_t)row * DM) + lane;
#pragma unroll
        for (int j = 0; j < 4; ++j) { v2u w; w.x = pk2(ov[j].x * r2, ov[j].y * r2); w.y = pk2(ov[j].z * r2, ov[j].w * r2); o8[64 * j] = w; }
    }
}

typedef short bf16x8 __attribute__((ext_vector_type(8)));
typedef short s16x4 __attribute__((ext_vector_type(4)));
typedef float f32x16 __attribute__((ext_vector_type(16)));
typedef float f32x2_t __attribute__((ext_vector_type(2)));
typedef __bf16 bf16x2_t __attribute__((ext_vector_type(2)));
#define MFMA32(a, b, c) __builtin_amdgcn_mfma_f32_32x32x16_bf16((a), (b), (c), 0, 0, 0)
__device__ __forceinline__ unsigned cvtpk(float lo, float hi) { f32x2_t v = {lo, hi}; bf16x2_t b = __builtin_convertvector(v, bf16x2_t); return __builtin_bit_cast(unsigned, b); }
__device__ __forceinline__ s16x4 vtr(const LAS unsigned char* p) { return __builtin_bit_cast(s16x4, __builtin_amdgcn_ds_read_tr16_b64_v4i16((LAS s16x4*)p)); }
__device__ __forceinline__ int crow(int r, int hi) { return (r & 3) + 8 * (r >> 2) + 4 * hi; }
__device__ __forceinline__ bf16x8 pack8(const f32x16& x, int s) {
    v4u p; p.x = cvtpk(x[8 * s + 0], x[8 * s + 1]); p.y = cvtpk(x[8 * s + 2], x[8 * s + 3]); p.z = cvtpk(x[8 * s + 4], x[8 * s + 5]); p.w = cvtpk(x[8 * s + 6], x[8 * s + 7]);
    return __builtin_bit_cast(bf16x8, p);
}
__device__ __forceinline__ f32x16 zero16() { float z; asm volatile("v_mov_b32 %0, 0" : "=v"(z)); return (f32x16){z, z, z, z, z, z, z, z, z, z, z, z, z, z, z, z}; }
__device__ __forceinline__ bf16x8 cat44(s16x4 lo, s16x4 hi) { return __builtin_shufflevector(lo, hi, 0, 1, 2, 3, 4, 5, 6, 7); }
constexpr int VT_PITCH = 192;
constexpr float LOG2E = 1.4426950408889634f;

__device__ __forceinline__ void pv_tile(f32x16 (&O)[2], const LAS unsigned char* vrd, bf16x8 p0, bf16x8 p1) {
#pragma unroll
    for (int c = 0; c < 2; ++c) {
        const bf16x8 a0 = cat44(vtr(vrd + 0 * VT_PITCH + 64 * c), vtr(vrd + 8 * VT_PITCH + 64 * c));
        const bf16x8 a1 = cat44(vtr(vrd + 16 * VT_PITCH + 64 * c), vtr(vrd + 24 * VT_PITCH + 64 * c));
        O[c] = MFMA32(a0, p0, O[c]);
        O[c] = MFMA32(a1, p1, O[c]);
    }
}
__device__ __forceinline__ void gate_store(const f32x16 (&O)[2], float scale, const bf16_t* grow, bf16_t* orow, int hi) {
#pragma unroll
    for (int c = 0; c < 2; ++c)
#pragma unroll
        for (int g = 0; g < 4; ++g) {
            const int d = 32 * c + 8 * g + 4 * hi;
            const v2u gv = *(const v2u*)(grow + d);
            float gt[4] = {__uint_as_float(gv.x << 16), __uint_as_float(gv.x & 0xffff0000u), __uint_as_float(gv.y << 16), __uint_as_float(gv.y & 0xffff0000u)};
            float ov[4];
#pragma unroll
            for (int j = 0; j < 4; ++j) ov[j] = O[c][4 * g + j] * scale * gt[j] * __builtin_amdgcn_rcpf(1.f + __builtin_amdgcn_exp2f(-gt[j] * LOG2E));
            v2u w; w.x = cvtpk(ov[0], ov[1]); w.y = cvtpk(ov[2], ov[3]);
            *(v2u*)(orow + d) = w;
        }
}

__device__ __forceinline__ void gate_load(v2u (&gw)[8], const bf16_t* grow, int hi) {
#pragma unroll
    for (int c = 0; c < 2; ++c)
#pragma unroll
        for (int g = 0; g < 4; ++g) gw[c * 4 + g] = *(const v2u*)(grow + 32 * c + 8 * g + 4 * hi);
}
__device__ __forceinline__ void gate_store_pre(const f32x16 (&O)[2], float scale, const v2u (&gw)[8], bf16_t* orow, int hi) {
#pragma unroll
    for (int c = 0; c < 2; ++c)
#pragma unroll
        for (int g = 0; g < 4; ++g) {
            const int d = 32 * c + 8 * g + 4 * hi;
            const v2u gv = gw[c * 4 + g];
            float gt[4] = {__uint_as_float(gv.x << 16), __uint_as_float(gv.x & 0xffff0000u), __uint_as_float(gv.y << 16), __uint_as_float(gv.y & 0xffff0000u)};
            float ov[4];
#pragma unroll
            for (int j = 0; j < 4; ++j) ov[j] = O[c][4 * g + j] * scale * gt[j] * __builtin_amdgcn_rcpf(1.f + __builtin_amdgcn_exp2f(-gt[j] * LOG2E));
            v2u w; w.x = cvtpk(ov[0], ov[1]); w.y = cvtpk(ov[2], ov[3]);
            *(v2u*)(orow + d) = w;
        }
}

__device__ __forceinline__ void sb_item(const bf16_t* PROJ, bf16_t* MIX, int b, int h, int qt, int lane, LAS unsigned char* wl) {
    asm volatile("" : "+v"(lane));
    const int r32 = lane & 31, hi = lane >> 5;
    const bf16_t* base = PROJ + (size_t)b * SEQ * LDP;
    const int t = 32 * qt + r32;
    bf16x8 qf[4];
#pragma unroll
    for (int ks = 0; ks < 4; ++ks) qf[ks] = *(const bf16x8*)(base + (size_t)t * LDP + C_SBQ + h * 64 + 16 * ks + 8 * hi);
    v2u gw[8]; gate_load(gw, base + (size_t)t * LDP + C_SBG + h * 64, hi);
    const int vrow = lane >> 3, vch = lane & 7;
    LAS unsigned char* vwr = wl + vrow * VT_PITCH + vch * 16;
    const LAS unsigned char* vrd = wl + (4 * hi + ((lane & 15) >> 2)) * VT_PITCH + (16 * ((lane >> 4) & 1) + 4 * (lane & 3)) * 2;
    bf16x8 kc[4], vc[4];
    {
        const bf16_t* kp = base + (size_t)(32 * qt + r32) * LDP + C_SBK + h * 64 + 8 * hi;
#pragma unroll
        for (int ks = 0; ks < 4; ++ks) kc[ks] = *(const bf16x8*)(kp + 16 * ks);
        const bf16_t* vp = base + (size_t)(32 * qt + vrow) * LDP + C_SBV + h * 64 + 8 * vch;
#pragma unroll
        for (int i = 0; i < 4; ++i) vc[i] = *(const bf16x8*)(vp + (size_t)(8 * i) * LDP);
    }
    f32x16 O[2];
#pragma unroll
    for (int r = 0; r < 16; ++r) { O[0][r] = 0.f; O[1][r] = 0.f; }
    float R = 1.f;
    for (int kt = qt; kt >= 0; --kt) {
        bf16x8 kn[4], vn[4];
        {
            const int ktn = kt > 0 ? kt - 1 : 0;
            const bf16_t* kp = base + (size_t)(32 * ktn + r32) * LDP + C_SBK + h * 64 + 8 * hi;
#pragma unroll
            for (int ks = 0; ks < 4; ++ks) kn[ks] = *(const bf16x8*)(kp + 16 * ks);
            const bf16_t* vp = base + (size_t)(32 * ktn + vrow) * LDP + C_SBV + h * 64 + 8 * vch;
#pragma unroll
            for (int i = 0; i < 4; ++i) vn[i] = *(const bf16x8*)(vp + (size_t)(8 * i) * LDP);
        }
        f32x16 acc;
#pragma unroll
        for (int r = 0; r < 16; ++r) acc[r] = 0.f;
#pragma unroll
        for (int ks = 0; ks < 4; ++ks) acc = MFMA32(kc[ks], qf[ks], acc);
#pragma unroll
        for (int i = 0; i < 4; ++i) *(LAS bf16x8*)(vwr + (8 * i) * VT_PITCH) = vc[i];
        float be[16], om[16];
        const bool diag = (kt == qt);
#pragma unroll
        for (int r = 0; r < 16; ++r) {
            const float e = __builtin_amdgcn_exp2f(fminf(acc[r] * (-0.125f * LOG2E), 115.f));
            float bt = __builtin_amdgcn_rcpf(1.f + e), o1 = e * bt;
            if (diag && !(crow(r, hi) < r32)) { bt = 0.f; o1 = 1.f; }
            be[r] = bt; om[r] = o1;
        }
        float Gp[4], Gq[4];
#pragma unroll
        for (int g = 0; g < 4; ++g) { Gp[g] = (om[4 * g] * om[4 * g + 1]) * (om[4 * g + 2] * om[4 * g + 3]); Gq[g] = __shfl_xor(Gp[g], 32); }
        const float T1 = Gp[1] * Gq[1], T2 = Gp[2] * Gq[2], T3 = Gp[3] * Gq[3], T0 = Gp[0] * Gq[0];
        float tail[4]; tail[3] = R; tail[2] = R * T3; tail[1] = tail[2] * T2; tail[0] = tail[1] * T1;
        const float Rn = tail[0] * T0;
#pragma unroll
        for (int g = 0; g < 4; ++g) {
            float sfx = tail[g] * (hi == 0 ? Gq[g] : 1.f);
            acc[4 * g + 3] = be[4 * g + 3] * sfx; sfx *= om[4 * g + 3];
            acc[4 * g + 2] = be[4 * g + 2] * sfx; sfx *= om[4 * g + 2];
            acc[4 * g + 1] = be[4 * g + 1] * sfx; sfx *= om[4 * g + 1];
            acc[4 * g + 0] = be[4 * g + 0] * sfx;
        }
        R = Rn;
        const bf16x8 p0 = pack8(acc, 0), p1 = pack8(acc, 1);
        pv_tile(O, vrd, p0, p1);
        if (__all(R < 7.8886e-31f)) break;
#pragma unroll
        for (int i = 0; i < 4; ++i) { kc[i] = kn[i]; vc[i] = vn[i]; }
    }
    gate_store_pre(O, 1.f, gw, MIX + ((size_t)b * SEQ + t) * DM + h * 64, hi);
}

__device__ __forceinline__ void mem_item(const bf16_t* PROJ, const bf16_t* KV, bf16_t* MIX, int b, int h, int qt, int lane, LAS unsigned char* wl) {
    asm volatile("" : "+v"(lane));
    float NINF; asm volatile("v_mov_b32 %0, 0xff800000" : "=v"(NINF));
    const int r32 = lane & 31, hi = lane >> 5;
    const int t = 32 * qt + r32;
    const bf16_t* prow = PROJ + ((size_t)b * SEQ + t) * LDP;
    bf16x8 qf[4];
#pragma unroll
    for (int ks = 0; ks < 4; ++ks) qf[ks] = *(const bf16x8*)(prow + C_MQ + h * 64 + 16 * ks + 8 * hi);
    const int vrow = lane >> 3, vch = lane & 7;
    LAS unsigned char* vwr = wl + vrow * VT_PITCH + vch * 16;
    const LAS unsigned char* vrd = wl + (4 * hi + ((lane & 15) >> 2)) * VT_PITCH + (16 * ((lane >> 4) & 1) + 4 * (lane & 3)) * 2;
    const bf16_t* kvb = KV + (size_t)b * NMEM * 1024 + h * 64;
    f32x16 O[2];
#pragma unroll
    for (int r = 0; r < 16; ++r) { O[0][r] = 0.f; O[1][r] = 0.f; }
    float mrun = NINF, lrun = 0.f;
    v2u gw[8]; gate_load(gw, prow + C_MG + h * 64, hi);
    bf16x8 kc[4], vc[4];
    {
        const bf16_t* kp = kvb + (size_t)r32 * 1024 + 8 * hi;
#pragma unroll
        for (int ks = 0; ks < 4; ++ks) kc[ks] = *(const bf16x8*)(kp + 16 * ks);
        const bf16_t* vp = kvb + (size_t)vrow * 1024 + 256 + 8 * vch;
#pragma unroll
        for (int i = 0; i < 4; ++i) vc[i] = *(const bf16x8*)(vp + (size_t)(8 * i) * 1024);
    }
    for (int kt = 0; kt < NMEM / 32; ++kt) {
        bf16x8 kn[4], vn[4];
        {
            const int ktn = kt < NMEM / 32 - 1 ? kt + 1 : kt;
            const bf16_t* kp = kvb + (size_t)(32 * ktn + r32) * 1024 + 8 * hi;
#pragma unroll
            for (int ks = 0; ks < 4; ++ks) kn[ks] = *(const bf16x8*)(kp + 16 * ks);
            const bf16_t* vp = kvb + (size_t)(32 * ktn + vrow) * 1024 + 256 + 8 * vch;
#pragma unroll
            for (int i = 0; i < 4; ++i) vn[i] = *(const bf16x8*)(vp + (size_t)(8 * i) * 1024);
        }
        f32x16 acc;
#pragma unroll
        for (int r = 0; r < 16; ++r) acc[r] = 0.f;
#pragma unroll
        for (int ks = 0; ks < 4; ++ks) acc = MFMA32(kc[ks], qf[ks], acc);
#pragma unroll
        for (int i = 0; i < 4; ++i) *(LAS bf16x8*)(vwr + (8 * i) * VT_PITCH) = vc[i];
        float mx = acc[0];
#pragma unroll
        for (int r = 1; r < 16; ++r) mx = fmaxf(mx, acc[r]);
        mx *= 0.125f * LOG2E;
        mx = fmaxf(mx, __shfl_xor(mx, 32));
        const float mn = fmaxf(mrun, mx), alpha = __builtin_amdgcn_exp2f(mrun - mn);
        float ps = 0.f;
#pragma unroll
        for (int r = 0; r < 16; ++r) { acc[r] = __builtin_amdgcn_exp2f(acc[r] * (0.125f * LOG2E) - mn); ps += acc[r]; }
        lrun = lrun * alpha + ps; mrun = mn;
#pragma unroll
        for (int r = 0; r < 16; ++r) { O[0][r] *= alpha; O[1][r] *= alpha; }
        const bf16x8 p0 = pack8(acc, 0), p1 = pack8(acc, 1);
        pv_tile(O, vrd, p0, p1);
#pragma unroll
        for (int i = 0; i < 4; ++i) { kc[i] = kn[i]; vc[i] = vn[i]; }
    }
    const float lt = lrun + __shfl_xor(lrun, 32);
    gate_store_pre(O, 1.f / lt, gw, MIX + ((size_t)b * SEQ + t) * DM + 768 + h * 64, hi);
}

constexpr int SEL_IQ_PITCH = 528, SEL_CNT_OFF = 17408;
__device__ __forceinline__ unsigned ordkey(float f);
template <int PRED  >
__device__ __forceinline__ unsigned sel_count_round(const unsigned (&key)[8][16], unsigned c, unsigned tau, int idx0, int r32, int hi, int wave, LAS unsigned* cb) {
    int n = 0;
#pragma unroll
    for (int i = 0; i < 8; ++i) {
#pragma unroll
        for (int r = 0; r < 16; ++r) {
            if (PRED == 0) n += (key[i][r] >= c) ? 1 : 0;
            else if (PRED == 1) n += (key[i][r] > c) ? 1 : 0;
            else n += (key[i][r] == tau && (unsigned)(idx0 + 256 * i + (r & 3) + 8 * (r >> 2)) <= c) ? 1 : 0;
            if ((r & 7) == 7) asm volatile("" : "+v"(n));
        }
    }
    n += __shfl_xor(n, 32);
    if (hi == 0) cb[wave * 32 + r32] = (unsigned)n;
    __syncthreads();
    unsigned tot = 0;
#pragma unroll
    for (int w = 0; w < 8; ++w) tot += cb[w * 32 + r32];
    return tot;
}
constexpr int SEL_CAP = 64, SEL_DONE = 16;
__device__ __forceinline__ float key2f(unsigned k) { return __uint_as_float((k & 0x80000000u) ? (k & 0x7fffffffu) : ~k); }
__device__ __forceinline__ unsigned sel_count_lane(const unsigned (&key)[8][16], unsigned c) {
    int n = 0;
#pragma unroll
    for (int i = 0; i < 8; ++i) {
#pragma unroll
        for (int r = 0; r < 16; ++r) {
            n += (key[i][r] >= c) ? 1 : 0;
            if ((r & 7) == 7) asm volatile("" : "+v"(n));
        }
    }
    return (unsigned)n;
}
__device__ __forceinline__ unsigned sel_exchange(unsigned nl, int r32, int hi, int wave, LAS unsigned* cb) {
    const unsigned n2 = nl + (unsigned)__shfl_xor((int)nl, 32);
    if (hi == 0) cb[wave * 32 + r32] = n2;
    __syncthreads();
    unsigned tot = 0;
#pragma unroll
    for (int w = 0; w < 8; ++w) tot += cb[w * 32 + r32];
    return tot;
}
__device__ __forceinline__ void sel_item2(const bf16_t* PROJ, unsigned* MASK, int b, int qt, int lane, int wave, LAS unsigned char* L) {
    asm volatile("" : "+v"(lane));
    const int r32 = lane & 31, hi = lane >> 5, tid = wave * 64 + lane;
    LAS unsigned* cntb = (LAS unsigned*)(L + SEL_CNT_OFF);
    const bf16_t* base = PROJ + (size_t)b * SEQ * LDP;
    unsigned* mrow = MASK + (((size_t)b * 64 + qt) * 64) * 32;
    if (qt < 8) {
#pragma unroll
        for (int i = 0; i < 8; ++i) {
            const int kt = wave + 8 * i;
            if (kt <= qt) {
                unsigned bits = 0u;
#pragma unroll
                for (int r = 0; r < 16; ++r) bits |= ((kt < qt) || (crow(r, hi) <= r32)) ? (1u << r) : 0u;
                const unsigned other = __shfl_xor(bits, 32);
                if (hi == 0) mrow[kt * 32 + r32] = bits | (other << 16);
            }
        }
        return;
    }
    for (int n = tid; n < 1024; n += 512) { const int row = n >> 5, ch = n & 31;
        const v4u v = *(const v4u*)(base + (size_t)(32 * qt + row) * LDP + C_IDQ + ch * 8);
        *(LAS v4u*)(L + row * SEL_IQ_PITCH + ch * 16) = v; }
    float w8[8];
    { const v4u wv = *(const v4u*)(base + (size_t)(32 * qt + r32) * LDP + C_IDW);
      w8[0] = __uint_as_float(wv.x << 16) * 0.0625f; w8[1] = __uint_as_float(wv.x & 0xffff0000u) * 0.0625f; w8[2] = __uint_as_float(wv.y << 16) * 0.0625f; w8[3] = __uint_as_float(wv.y & 0xffff0000u) * 0.0625f;
      w8[4] = __uint_as_float(wv.z << 16) * 0.0625f; w8[5] = __uint_as_float(wv.z & 0xffff0000u) * 0.0625f; w8[6] = __uint_as_float(wv.w << 16) * 0.0625f; w8[7] = __uint_as_float(wv.w & 0xffff0000u) * 0.0625f; }
    __syncthreads();
    unsigned key[8][16];
    const LAS unsigned char* iqp = L + r32 * SEL_IQ_PITCH + 16 * hi;
    unsigned kmn = 0xffffffffu, kmx = 0u;
#pragma unroll
    for (int i = 0; i < 8; ++i) {
        const int kt = wave + 8 * i;
        if (kt <= qt) {
            const bf16_t* kp = base + (size_t)(32 * kt + r32) * LDP + C_IDK + 8 * hi;
            const bf16x8 k0 = *(const bf16x8*)kp, k1 = *(const bf16x8*)(kp + 16);
            float sc[16];
#pragma unroll
            for (int r = 0; r < 16; ++r) sc[r] = 0.f;
            unsigned iqo = 0; asm volatile("" : "+v"(iqo));
            const LAS unsigned char* iqt = iqp + iqo;
#pragma unroll
            for (int h = 0; h < 8; ++h) {
                const bf16x8 q0 = *(const LAS bf16x8*)(iqt + h * 64), q1 = *(const LAS bf16x8*)(iqt + h * 64 + 32);
                bf16x8 q0p = q0, q1p = q1;
                asm volatile("" : "+v"(q0p), "+v"(q1p) : "v"(sc[15]));
                f32x16 D = MFMA32(k0, q0p, zero16());
                D = MFMA32(k1, q1p, D);
#pragma unroll
                for (int r = 0; r < 16; ++r) sc[r] += w8[h] * fmaxf(D[r], 0.f);
                asm volatile("" : "+v"(sc[0]), "+v"(sc[1]), "+v"(sc[2]), "+v"(sc[3]), "+v"(sc[4]), "+v"(sc[5]), "+v"(sc[6]), "+v"(sc[7]),
                                  "+v"(sc[8]), "+v"(sc[9]), "+v"(sc[10]), "+v"(sc[11]), "+v"(sc[12]), "+v"(sc[13]), "+v"(sc[14]), "+v"(sc[15]));
            }
            int thr = (kt < qt) ? 64 : (r32 - 4 * hi);
            asm volatile("" : "+v"(thr));
#pragma unroll
            for (int r = 0; r < 16; ++r) { const bool v = ((r & 3) + 8 * (r >> 2) <= thr); const unsigned k = ordkey(sc[r]); key[i][r] = v ? k : 0u; kmx = max(kmx, v ? k : 0u); kmn = min(kmn, v ? k : 0xffffffffu); }
        } else {
#pragma unroll
            for (int r = 0; r < 16; ++r) key[i][r] = 0u;
        }
    }
    unsigned lo_key, hi_key, clo, chi = 0u, nlo_l, nhi_l = 0u;
    {
        int nv = 0;
#pragma unroll
        for (int i = 0; i < 8; ++i) { const int kt = wave + 8 * i; nv += (kt < qt) ? 16 : 0; }
        if ((qt & 7) == wave) { const int thr = r32 - 4 * hi;
#pragma unroll
            for (int r = 0; r < 16; ++r) nv += ((r & 3) + 8 * (r >> 2) <= thr) ? 1 : 0; }
        nlo_l = (unsigned)nv;
        kmn = min(kmn, (unsigned)__shfl_xor((int)kmn, 32)); kmx = max(kmx, (unsigned)__shfl_xor((int)kmx, 32));
        if (hi == 0) { cntb[wave * 32 + r32] = kmn; cntb[256 + wave * 32 + r32] = kmx; }
        __syncthreads();
        unsigned a = 0xffffffffu, bmx = 0u;
#pragma unroll
        for (int w = 0; w < 8; ++w) { a = min(a, cntb[w * 32 + r32]); bmx = max(bmx, cntb[256 + w * 32 + r32]); }
        lo_key = a; hi_key = bmx + 1u; clo = (unsigned)(32 * qt + r32 + 1);
        __syncthreads();
    }
    int round = 0;
    for (;;) {
        const bool done = (clo - chi <= (unsigned)SEL_DONE) || (hi_key - lo_key <= 1u);
        if (__all(done)) break;
        unsigned p;
        if ((round & 3) == 3) p = lo_key + ((hi_key - lo_key) >> 1);
        else p = ordkey(0.5f * key2f(lo_key) + 0.5f * key2f(hi_key));
        p = min(max(p, lo_key + 1u), hi_key - 1u);
        if (done) p = lo_key;
        const unsigned nl = sel_count_lane(key, p);
        const unsigned tot = sel_exchange(nl, r32, hi, wave, cntb + (round & 1) * 256);
        if (!done) { if (tot >= 256u) { lo_key = p; clo = tot; nlo_l = nl; } else { hi_key = p; chi = tot; nhi_l = nl; } }
        ++round;
    }
    unsigned tau, cut;
    const bool many = (clo - chi > (unsigned)SEL_CAP);
    {
        LAS unsigned* lanecnt = (LAS unsigned*)L; LAS unsigned* meta = (LAS unsigned*)(L + 2048); LAS unsigned* result = (LAS unsigned*)(L + 2304); LAS unsigned* list = (LAS unsigned*)(L + 20480);
        const int slot = wave * 2 + hi;
        lanecnt[r32 * 16 + slot] = many ? 0u : (nlo_l - nhi_l);
        if (slot == 0) { meta[2 * r32] = many ? 0u : (clo - chi); meta[2 * r32 + 1] = 256u - chi; }
        __syncthreads();
        unsigned bs = 0u;
#pragma unroll
        for (int s2 = 0; s2 < 16; ++s2) { const unsigned v = lanecnt[r32 * 16 + s2]; bs += (s2 < slot) ? v : 0u; }
        if (!many) {
            const int idx0 = 32 * wave + 4 * hi;
            LAS unsigned* lp = list + (r32 * SEL_CAP + bs) * 2;
#pragma unroll
            for (int i = 0; i < 8; ++i)
#pragma unroll
                for (int r = 0; r < 16; ++r) {
                    const unsigned k = key[i][r];
                    if (k >= lo_key && k < hi_key) { lp[0] = k; lp[1] = (unsigned)(idx0 + 256 * i + (r & 3) + 8 * (r >> 2)); lp += 2; }
                }
        }
        __syncthreads();
        for (int j = 0; j < 4; ++j) {
            const int q = 4 * wave + j;
            const unsigned ncand = (unsigned)__builtin_amdgcn_readfirstlane((int)meta[2 * q]), need = (unsigned)__builtin_amdgcn_readfirstlane((int)meta[2 * q + 1]);
            const LAS unsigned* lq = list + q * SEL_CAP * 2;
            const bool mine = (unsigned)lane < ncand;
            const unsigned kc = mine ? lq[2 * lane] : 0u, ic = mine ? lq[2 * lane + 1] : 0u;
            unsigned rank = 0u;
            for (unsigned c2 = 0; c2 < ncand; ++c2) { const unsigned k2 = lq[2 * c2], i2 = lq[2 * c2 + 1]; rank += (k2 > kc || (k2 == kc && i2 < ic)) ? 1u : 0u; }
            if (mine && rank == need - 1u) { result[2 * q] = kc; result[2 * q + 1] = ic; }
        }
        __syncthreads();
        tau = result[2 * r32]; cut = result[2 * r32 + 1];
    }
    if (__any(many)) {
        const unsigned need = 256u - chi;
        const int idx0 = 32 * wave + 4 * hi;
        unsigned lo_ = 0u, hi_ = 2047u;
        for (int it = 0; it < 11; ++it) {
            const unsigned mid = (lo_ + hi_) >> 1;
            const unsigned f = sel_count_round<2>(key, mid, lo_key, idx0, r32, hi, wave, cntb + (it & 1) * 256);
            if (f >= need) hi_ = mid; else lo_ = mid + 1;
        }
        if (many) { tau = lo_key; cut = hi_; }
    }
    {
        const int idx0 = 32 * wave + 4 * hi;
#pragma unroll
        for (int i = 0; i < 8; ++i) {
            const int kt = wave + 8 * i;
            if (kt <= qt) {
                unsigned bits = 0u;
#pragma unroll
                for (int r = 0; r < 16; ++r) {
                    const bool s = (key[i][r] > tau) || (key[i][r] == tau && (unsigned)(idx0 + 256 * i + (r & 3) + 8 * (r >> 2)) <= cut);
                    bits |= s ? (1u << r) : 0u;
                }
                const unsigned other = __shfl_xor(bits, 32);
                if (hi == 0) mrow[kt * 32 + r32] = bits | (other << 16);
            }
        }
    }
    __syncthreads();
}

constexpr int WS_WUK = 0;
constexpr int WS_WUV = 256 * 1024;
constexpr int DSA_BIAS_OFF = 16384;
__device__ __forceinline__ float xhalf_max(float v) { auto rr = __builtin_amdgcn_permlane32_swap(__float_as_uint(v), __float_as_uint(v), false, false); return fmaxf(__uint_as_float(rr[0]), __uint_as_float(rr[1])); }
__device__ __forceinline__ float xhalf_sum(float v) { auto rr = __builtin_amdgcn_permlane32_swap(__float_as_uint(v), __float_as_uint(v), false, false); return __uint_as_float(rr[0]) + __uint_as_float(rr[1]); }
__device__ __forceinline__ unsigned dsa_off(unsigned row, unsigned ch) { return 256u * row + 16u * (ch ^ (((row & 3u) << 2) | ((row >> 2) & 3u))); }
__device__ __forceinline__ void dsa_round(const bf16_t* PROJ, const bf16_t* CKVN, const unsigned* MASK, const bf16_t* WUKp  , const bf16_t* WUVp  ,
                                          const float* rel_bias, bf16_t* MIX, int b, int o, int h, int lane, int wave, LAS unsigned char* L) {
    asm volatile("" : "+v"(lane));
    float NINF; asm volatile("v_mov_b32 %0, 0xff800000" : "=v"(NINF));
    const int r32 = lane & 31, hi = lane >> 5, tid = wave * 64 + lane;
    const int qt = 8 * o + wave, KT = 8 * o + 7, t = 32 * qt + r32;
    LAS float* biasT = (LAS float*)(L + DSA_BIAS_OFF);
    if (tid < 192) { const int bk = tid < 128 ? (int)T5TAB[tid] : 31; biasT[tid] = rel_bias[bk * 6 + h] * LOG2E; }
    const float bias31 = rel_bias[31 * 6 + h] * LOG2E;
    bf16x8 qlf[8];
    {
        const bf16_t* qrow = PROJ + ((size_t)b * SEQ + t) * LDP + C_DSQ + h * 64 + 8 * hi;
        bf16x8 qf[4];
#pragma unroll
        for (int ks = 0; ks < 4; ++ks) qf[ks] = *(const bf16x8*)(qrow + 16 * ks);
#pragma unroll
        for (int rt = 0; rt < 4; ++rt) {
            f32x16 X;
#pragma unroll
            for (int r = 0; r < 16; ++r) X[r] = 0.f;
            const GAS bf16_t* wp = (const GAS bf16_t*)WUKp + (rt * 32 + r32) * 64 + 8 * hi;
#pragma unroll
            for (int ks = 0; ks < 4; ++ks) X = MFMA32(*(const GAS bf16x8*)(wp + 16 * ks), qf[ks], X);
#pragma unroll
            for (int r = 0; r < 16; ++r) X[r] *= 0.125f * LOG2E;
            qlf[2 * rt] = pack8(X, 0); qlf[2 * rt + 1] = pack8(X, 1);
        }
    }
    f32x16 O[4];
#pragma unroll
    for (int c = 0; c < 4; ++c)
#pragma unroll
        for (int r = 0; r < 16; ++r) O[c][r] = 0.f;
    float mref = NINF, lrun = 0.f;
    const int srow = tid >> 4, sch = tid & 15;
    const bf16_t* csrc = CKVN + ((size_t)b * SEQ + srow) * 128 + 8 * sch;
    const unsigned sdst = 2048u * (srow >> 3) + 512u * (sch >> 2) + 64u * (srow & 7) + 16u * ((sch & 3) ^ ((srow >> 2) & 3));
    const unsigned x2 = ((unsigned)r32 >> 2) & 3u;
    const unsigned rb_e = 2048u * ((unsigned)r32 >> 3) + 64u * ((unsigned)r32 & 7u) + 16u * ((unsigned)hi ^ x2);
    const unsigned rb_o = 2048u * ((unsigned)r32 >> 3) + 64u * ((unsigned)r32 & 7u) + 16u * ((2u + (unsigned)hi) ^ x2);
    const unsigned tq = (lane & 15) >> 2, tp = lane & 3, tblk = (lane >> 4) & 1;
    const unsigned tb0 = 64u * (4u * hi + tq) + 16u * ((2u * tblk + (tp >> 1)) ^ ((unsigned)hi & 3u)) + 8u * (tp & 1);
    const unsigned tb1 = 64u * (4u * hi + tq) + 16u * ((2u * tblk + (tp >> 1)) ^ ((2u + (unsigned)hi) & 3u)) + 8u * (tp & 1);
    const unsigned* mrow = MASK + (((size_t)b * 64 + qt) * 64) * 32 + r32;
    v4u vn1;
    {
        const v4u v0 = *(const v4u*)csrc;
        vn1 = *(const v4u*)(csrc + (size_t)32 * 128);
        *(LAS v4u*)(L + sdst) = v0;
    }
    unsigned mwn = mrow[0], mwn2 = (1 <= qt) ? mrow[32] : 0u;
    for (int kt = 0; kt <= KT; ++kt) {
        v4u vn2;
        if (kt + 2 <= KT) vn2 = *(const v4u*)(csrc + (size_t)(32 * (kt + 2)) * 128);
        const unsigned mwc = mwn;
        mwn = mwn2;
        if (kt + 2 <= qt) mwn2 = mrow[(kt + 2) * 32];
        __syncthreads();
        const LAS unsigned char* Cb = L + (kt & 1) * 8192;
        if (kt <= qt) {
            f32x16 S;
#pragma unroll
            for (int r = 0; r < 16; ++r) S[r] = 0.f;
#pragma unroll
            for (int ks = 0; ks < 8; ++ks) {
                const bf16x8 a = *(const LAS bf16x8*)(Cb + ((ks & 1) ? rb_o : rb_e) + 512u * (ks >> 1));
                S = MFMA32(a, qlf[ks], S);
            }
            const unsigned mw = mwc >> (16 * hi);
            const int dq = qt - kt;
            float cb = bias31;
            if (dq < 5) {
                cb = 0.f;
                const int rel0 = 32 * dq + r32 - 4 * hi;
#pragma unroll
                for (int r = 0; r < 16; ++r) { int rel = rel0 - ((r & 3) + 8 * (r >> 2)); rel = rel < 0 ? 0 : rel; S[r] += biasT[rel]; }
            }
            float mx = fmaxf(S[0], S[1]);
#pragma unroll
            for (int r = 2; r < 16; ++r) mx = fmaxf(mx, S[r]);
            mx = xhalf_max(mx) + cb;
            float alpha = 1.f;
            if (__any(mx > mref + 8.f)) {
                float mm = NINF;
#pragma unroll
                for (int r = 0; r < 16; ++r) mm = fmaxf(mm, ((mw >> r) & 1u) ? S[r] : NINF);
                mm = xhalf_max(mm) + cb;
                const float mn = fmaxf(mref, mm);
                alpha = (mn > mref) ? __builtin_amdgcn_exp2f(mref - mn) : 1.f;
                mref = mn;
            }
            lrun *= alpha;
#pragma unroll
            for (int c = 0; c < 4; ++c)
#pragma unroll
                for (int r = 0; r < 16; ++r) O[c][r] *= alpha;
            const float off = ((mref == NINF) ? 0.f : mref) - cb;
            float ps = 0.f;
#pragma unroll
            for (int r = 0; r < 16; ++r) {
                const float e = __builtin_amdgcn_exp2f(S[r] - off);
                const int m1 = __builtin_amdgcn_sbfe((int)mw, r, 1);
                S[r] = __uint_as_float(__float_as_uint(e) & (unsigned)m1);
                ps += S[r];
            }
            lrun += ps;
            const bf16x8 p0 = pack8(S, 0), p1 = pack8(S, 1);
#pragma unroll
            for (int c = 0; c < 4; ++c) {
                s16x4 f[4];
#pragma unroll
                for (int st = 0; st < 4; ++st) {
                    f[st] = vtr(Cb + ((st & 1) ? tb1 : tb0) + 2048u * st + 512u * c);
                }
                O[c] = MFMA32(cat44(f[0], f[1]), p0, O[c]);
                O[c] = MFMA32(cat44(f[2], f[3]), p1, O[c]);
            }
        }
        if (kt < KT) *(LAS v4u*)(L + ((kt + 1) & 1) * 8192 + sdst) = vn1;
        vn1 = vn2;
    }
    const float lt = xhalf_sum(lrun);
    const float il = 1.f / lt;
    f32x16 Y[2];
#pragma unroll
    for (int r = 0; r < 16; ++r) { Y[0][r] = 0.f; Y[1][r] = 0.f; }
#pragma unroll
    for (int rt = 0; rt < 4; ++rt) {
#pragma unroll
        for (int r = 0; r < 16; ++r) O[rt][r] *= il;
        const bf16x8 x0 = pack8(O[rt], 0), x1 = pack8(O[rt], 1);
#pragma unroll
        for (int c = 0; c < 2; ++c) {
            int l3 = lane; asm volatile("" : "+v"(l3));
            const GAS bf16_t* wp = (const GAS bf16_t*)WUVp + ((((c * 4 + rt) * 2 + 0) * 32 + (l3 & 31)) * 2 + (l3 >> 5)) * 8;
            Y[c] = MFMA32(*(const GAS bf16x8*)wp, x0, Y[c]);
            Y[c] = MFMA32(*(const GAS bf16x8*)(wp + 32 * 2 * 8), x1, Y[c]);
        }
    }
    {
        int l2 = lane; asm volatile("" : "+v"(l2));
        const int t2 = 32 * qt + (l2 & 31);
        gate_store(Y, 1.f, PROJ + ((size_t)b * SEQ + t2) * LDP + C_DSG + h * 64, MIX + ((size_t)b * SEQ + t2) * DM + 384 + h * 64, l2 >> 5);
    }
    __syncthreads();
}

typedef GAS unsigned gu32;
#define RLX_AGENT __ATOMIC_RELAXED, __HIP_MEMORY_SCOPE_AGENT
constexpr size_t WS_BAR = 512 * 1024;
#define XB_TMO      128
#define XB_XCNT(j)  (256  + 64 * (j))
#define XB_XSUB(j)  (1280 + 64 * (j))
#define XB_XGEN(j)  (2304 + 64 * (j))
#define XB_TOP      3328
#define XB_TOPGEN   3392
#define XCD_BAR_WORDS 3456
#define XB_SPIN_CAP (1u << 18)

__device__ __forceinline__ unsigned xb_ld(unsigned* p)              { return __hip_atomic_load(p, __ATOMIC_RELAXED, __HIP_MEMORY_SCOPE_AGENT); }
__device__ __forceinline__ unsigned xb_add(unsigned* p, unsigned v) { return __hip_atomic_fetch_add(p, v, __ATOMIC_RELAXED, __HIP_MEMORY_SCOPE_AGENT); }
__device__ __forceinline__ unsigned xb_xcc_id() { return (unsigned)__builtin_amdgcn_s_getreg((3 << 11) | 20) & 0xFu; }
#define XB_SPIN(cond, bar) do { unsigned _sp = 0; while (cond) { __builtin_amdgcn_s_sleep(1); \
    if ((++_sp & 255u) == 0u) { if (xb_ld(&(bar)[XB_TMO])) break; if (_sp > XB_SPIN_CAP) { atomicAdd(&(bar)[XB_TMO], 1u); break; } } } } while (0)

struct XcdBarrier {
    unsigned* bar; unsigned x;
    volatile LAS unsigned* st;
};

__device__ __forceinline__ XcdBarrier xcd_barrier_post(unsigned* bar, volatile LAS unsigned* st) {
    XcdBarrier b; b.bar = bar; b.x = xb_xcc_id(); b.st = st;
    if (threadIdx.x == 0) (void)xb_add(&bar[XB_XCNT(b.x)], 1u);
    return b;
}
__device__ __forceinline__ void xcd_barrier_complete(unsigned* bar, unsigned x, unsigned& nloc, unsigned& nx) {
    const unsigned G = gridDim.x * gridDim.y * gridDim.z;
    unsigned sum, cnt, mine, sp = 0u;
    for (;;) {
        sum = 0u; cnt = 0u; mine = 0u;
#pragma unroll
        for (unsigned j = 0; j < 16; ++j) { const unsigned c = xb_ld(&bar[XB_XCNT(j)]); sum += c; cnt += (c > 0u) ? 1u : 0u; mine = (j == x) ? c : mine; }
        if (sum == G) break;
        __builtin_amdgcn_s_sleep(1);
        if ((++sp & 255u) == 0u) { if (xb_ld(&bar[XB_TMO])) break; if (sp > XB_SPIN_CAP) { atomicAdd(&bar[XB_TMO], 1u); break; } }
    }
    nloc = mine > 0u ? mine : 1u; nx = cnt > 0u ? cnt : 1u;
}

__device__ __forceinline__ void xcd_barrier(const XcdBarrier& b) {
    asm volatile("s_waitcnt vmcnt(0)" ::: "memory");
    __syncthreads();
    if (threadIdx.x == 0) {
        unsigned* bar = b.bar;
        __builtin_amdgcn_s_waitcnt(0);
        unsigned nloc = b.st[0], nx = b.st[1];
        if (nloc == 0u) { xcd_barrier_complete(bar, b.x, nloc, nx); b.st[0] = nloc; b.st[1] = nx; }
        const unsigned old = xb_add(&bar[XB_XSUB(b.x)], 1u);
        const unsigned gen = old / nloc;
        if (old + 1u == (gen + 1u) * nloc) {
            __builtin_amdgcn_fence(__ATOMIC_RELEASE, "agent");
            asm volatile("s_waitcnt vmcnt(0)" ::: "memory");
            const unsigned og = xb_add(&bar[XB_TOP], 1u);
            const unsigned tg = og / nx;
            if (og + 1u == (tg + 1u) * nx) xb_add(&bar[XB_TOPGEN], 1u);
            else XB_SPIN(xb_ld(&bar[XB_TOPGEN]) == tg, bar);
            __builtin_amdgcn_fence(__ATOMIC_ACQUIRE, "agent");
            xb_add(&bar[XB_XGEN(b.x)], 1u);
            asm volatile("s_waitcnt vmcnt(0)" ::: "memory");
        } else {
            XB_SPIN(xb_ld(&bar[XB_XGEN(b.x)]) == gen, bar);
            __builtin_amdgcn_fence(__ATOMIC_ACQUIRE, "agent");
            asm volatile("s_waitcnt vmcnt(0)" ::: "memory");
        }
    }
    __syncthreads();
}

#ifndef MK_MULTI
#define MK_MULTI 0
#endif
constexpr int NPHASE = 11;
__global__ void __launch_bounds__(NWAVES * 64, 2) mk_fwd(Args args) {
    extern __shared__ __attribute__((aligned(16))) unsigned char lds_raw[];
    LAS unsigned char* lds = (LAS unsigned char*)lds_raw;
    const int tid0 = threadIdx.x;
    int wave_ = __builtin_amdgcn_readfirstlane(tid0 >> 6); asm volatile("" : "+s"(wave_));
    const int wave = wave_;
    const int G = gridDim.x, bid = blockIdx.x;
    for (int u = tid0; u < 16; u += NWAVES * 64) ((LAS unsigned*)(lds + 131072))[u] = 0u;
    __syncthreads();
    const XcdBarrier xbar = xcd_barrier_post((unsigned*)(args.ws + WS_BAR), (volatile LAS unsigned*)(lds + 131072));
    const int lo = args.ph_lo, hi = args.ph_hi;
#define IN(k) (lo <= (k) && (k) < hi)
#define SEAM(k) do { if (IN(k) && IN((k) + 1)) { if ((k) == 0) cg::this_grid().sync(); else xcd_barrier(xbar); } } while (0)
#define PH_BEGIN int lane = lane_id_v(); unsigned char* ws_ = args.ws; asm volatile("" : "+s"(ws_)); GAS unsigned char* ws = (GAS unsigned char*)ws_;     \
    const int gw = bid * NWAVES + wave, NGW = G * NWAVES; (void)gw; (void)NGW;
#define VCU_LOOP for (int vcu = vcu0; vcu < 256; vcu += G)
#define VCU_IDS const int bb = vcu >> 3, w64 = (vcu & 7) * 8 + wave; (void)bb; (void)w64;
#define P_WIN ((bf16_t*)(ws + WS_WIN))
#define P_WOUT ((bf16_t*)(ws + WS_WOUT))
#define P_WMEM ((bf16_t*)(ws + WS_WMEM))
#define P_MEMB ((bf16_t*)(ws + WS_MEMB))
#define P_MEMKV ((bf16_t*)(ws + WS_MEMKV))
#define P_CKVN ((bf16_t*)(ws + WS_CKVN))
#define P_MASK ((unsigned*)(ws + WS_MASK))
#define P_H ((bf16_t*)(ws + WS_H))
#define P_MIX ((bf16_t*)(ws + WS_MIX))
#define P_PROJ ((bf16_t*)(ws + WS_PROJ))
#define P_Y ((bf16_t*)(ws + WS_Y))
    const int vcu0 = (G % 8 == 0) ? (bid & 7) * (G >> 3) + (bid >> 3) : bid;

    if (IN(0)) {
        PH_BEGIN
        const float* x = args.in[0]; const float* mem = args.in[1]; const float* pre_g = args.in[2];
        const float* w_in = args.in[4]; const float* w_mem = args.in[8]; const float* w_out = args.in[9];
        LAS float* scr = (LAS float*)(lds + wave * 16384);
        constexpr int I_IN = 16 * (LDP / 32), I_OUT = 16 * 32, I_MEM = 16 * 16;
        constexpr int NITEMS = 2 * I_IN + 2 * I_OUT + 2 * I_MEM;
        for (int it = gw; it < NITEMS; it += NGW) {
            int r = it;
            if (r < 2 * I_IN) { const int l = r / I_IN; r -= l * I_IN; p0_transpose_item(w_in + (size_t)l * DM * NCOL, DM, NCOL, LDP, P_WIN + (size_t)l * LDP * DM, pre_g + l * DM, scr, r, lane); continue; }
            r -= 2 * I_IN;
            if (r < 2 * I_OUT) { const int l = r / I_OUT; r -= l * I_OUT; p0_transpose_item(w_out + (size_t)l * DM * DM, DM, DM, DM, P_WOUT + (size_t)l * DM * DM, nullptr, scr, r, lane); continue; }
            r -= 2 * I_OUT;
            { const int l = r / I_MEM; r -= l * I_MEM; p0_transpose_item(w_mem + (size_t)l * DM * 512, DM, 512, 512, P_WMEM + (size_t)l * 512 * DM, nullptr, scr, r, lane); }
        }
        {
            const float* w_uk = args.in[5]; const float* w_uv = args.in[6];
            bf16_t* WUKp = (bf16_t*)(ws + WS_WUK); bf16_t* WUVp = (bf16_t*)(ws + WS_WUV);
            for (int e = gw * 64 + lane; e < 2 * 6 * 8192; e += NGW * 64) {
                const int lh = e >> 13, l = lh / 6, h = lh % 6, w = e & 8191;
                { const int rt = w >> 11, rho = (w >> 6) & 31, d = w & 63; const int r = 32 * rt + ((rho & 0x13) | ((rho & 4) << 1) | ((rho & 8) >> 1));
                  WUKp[e] = (bf16_t)f2bf(w_uk[(((size_t)l * 128 + r) * 6 + h) * 64 + d]); }
                { const int j = w & 7, hh = (w >> 3) & 1, d32 = (w >> 4) & 31, s = (w >> 9) & 1, rt = (w >> 10) & 3, c = (w >> 12) & 1;
                  const int r = 32 * rt + 16 * s + 8 * (j >> 2) + 4 * hh + (j & 3), d = 32 * c + d32;
                  WUVp[e] = (bf16_t)f2bf(w_uv[(((size_t)l * 128 + r) * 6 + h) * 64 + d]); }
            }
        }
        for (int m = gw; m < NB * NMEM; m += NGW) row_to_bf16<false>(mem + (size_t)m * DM, P_MEMB + (size_t)m * DM, lane);
        for (int m = gw * 2; m < NTOK; m += NGW * 2) { row_to_bf16<true>(x + (size_t)m * DM, P_H + (size_t)m * DM, lane); row_to_bf16<true>(x + (size_t)(m + 1) * DM, P_H + (size_t)(m + 1) * DM, lane); }
    }
    SEAM(0);
#pragma unroll 1
    for (int l = 0; l < 2; ++l) {
        const int pb = 1 + 5 * l;
        if (IN(pb)) {
            PH_BEGIN
            { pg8::Gemm g{P_H, P_WIN + (size_t)l * LDP * DM, NTOK, LDP, DM}; pg8::StaticOrder S; S.init(NTOK, LDP, G, bid);
              pg8::EpiBf16<0> E{P_PROJ, LDP, nullptr, 0, 0, 1.f};
              pg8::gemm_phase<pg8::EpiBf16<0>, pg8::StaticOrder, true, true>(lds, g, S, E, wave); }
            if (l == 0) {
              pg8::Gemm g{P_MEMB, P_WMEM, NB * NMEM, 1024, DM}; pg8::StaticOrder S; S.init(NB * NMEM, 1024, G, bid);
              pg8::EpiBf16<0> E{P_MEMKV, 1024, nullptr, 0, 0, 1.f};
              pg8::gemm_phase<pg8::EpiBf16<0>, pg8::StaticOrder, true, true>(lds, g, S, E, wave); }
        }
        SEAM(pb);
        if (IN(pb + 1)) {
            { PH_BEGIN
              const float* kv_g = args.in[7];
              for (int m = gw * 8; m < NTOK; m += NGW * 8) { ckvnorm4(P_PROJ, kv_g + l * 128, P_CKVN, m, lane); ckvnorm4(P_PROJ, kv_g + l * 128, P_CKVN, m + 4, lane); } }
            VCU_LOOP { PH_BEGIN VCU_IDS
              for (int i = 0; i < 6; ++i) { const int qt = (i & 1) ? 63 - w64 : w64; sb_item(P_PROJ, P_MIX, bb, i, qt, lane, lds + wave * 16384); } }
            __syncthreads();
            VCU_LOOP { PH_BEGIN VCU_IDS
              const int s8 = vcu & 7;
              for (int j = 0; j < 8; ++j) { const int qt = 8 * j + ((j & 1) ? 7 - s8 : s8); sel_item2(P_PROJ, P_MASK, bb, qt, lane, wave, lds); } }
            __syncthreads();
            VCU_LOOP { PH_BEGIN VCU_IDS
              for (int i = 0; i < 4; ++i) mem_item(P_PROJ, P_MEMKV + l * 512, P_MIX, bb, i, w64, lane, lds + wave * 16384); }
        }
        SEAM(pb + 1);
        if (IN(pb + 2)) {
            __syncthreads();
            VCU_LOOP { PH_BEGIN VCU_IDS
              const float* rel_bias = args.in[10];
              const int s8 = vcu & 7, hs = (s8 < 4) ? 0 : 3;
              for (int oi = 0; oi < 2; ++oi) {
                  const int o = oi ? 7 - (s8 & 3) : (s8 & 3);
                  for (int hh = 0; hh < 3; ++hh) {
                      const int h = hs + hh;
                      dsa_round(P_PROJ, P_CKVN, P_MASK, (const bf16_t*)(ws + WS_WUK) + (size_t)(l * 6 + h) * 8192, (const bf16_t*)(ws + WS_WUV) + (size_t)(l * 6 + h) * 8192,
                                rel_bias, P_MIX, bb, o, h, lane, wave, lds);
                  }
              } }
        }
        SEAM(pb + 2);
        if (IN(pb + 3)) {
            PH_BEGIN
            __syncthreads();
            pg8::Gemm g{P_MIX, P_WOUT + (size_t)l * DM * DM, NTOK, DM, DM}; pg8::StaticOrder S; S.init(NTOK, DM, G, bid);
            pg8::EpiBf16<0> E{P_Y, DM, nullptr, 0, 0, 1.f};
            pg8::gemm_phase<pg8::EpiBf16<0>, pg8::StaticOrder, true, true>(lds, g, S, E, wave);
        }
        SEAM(pb + 3);
        if (IN(pb + 4)) {
            PH_BEGIN
            const float* xin = (l == 0) ? args.in[0] : args.out; const float* post_g = args.in[3];
            for (int m = gw * 2; m < NTOK; m += NGW * 2) { post_row(xin, P_Y, post_g + l * DM, args.out, (l == 0) ? P_H : (bf16_t*)nullptr, m, lane); post_row(xin, P_Y, post_g + l * DM, args.out, (l == 0) ? P_H : (bf16_t*)nullptr, m + 1, lane); }
        }
        SEAM(pb + 4);
    }
#undef IN
#undef SEAM
}

extern "C" void kernel_launch(void* const* d_in, const int* in_sizes, int n_in, void* d_out, int out_size, void* d_ws, size_t ws_size, hipStream_t stream) {
    static int grid = 0;
    if (grid == 0) {
        if (n_in != 11 || ws_size < WS_END) { fprintf(stderr, "kernel_launch: unexpected n_in %d / ws_size %zu\n", n_in, ws_size); grid = -1; return; }
        int dev = 0, cus = 0, per_cu = 0;
        hipGetDevice(&dev);
        hipDeviceGetAttribute(&cus, hipDeviceAttributeMultiprocessorCount, dev);
        hipFuncSetAttribute((const void*)mk_fwd, hipFuncAttributeMaxDynamicSharedMemorySize, LDS_BYTES);
        hipOccupancyMaxActiveBlocksPerMultiprocessor(&per_cu, (const void*)mk_fwd, NWAVES * 64, LDS_BYTES);
        if (per_cu < 1) { fprintf(stderr, "kernel_launch: occupancy query says %d blocks per CU\n", per_cu); per_cu = 1; }
        grid = cus * 1;
        (void)hipGetLastError();
    }
    if (grid < 0) return;
    (void)hipMemsetAsync((char*)d_ws + WS_BAR, 0, 16384, stream);
    Args a{};
    for (int i = 0; i < 11; ++i) a.in[i] = (const float*)d_in[i];
    a.out = (float*)d_out; a.ws = (unsigned char*)d_ws;
#if MK_MULTI
    for (int p = 0; p < NPHASE; ++p) { a.ph_lo = p; a.ph_hi = p + 1; hipLaunchKernelGGL(mk_fwd, dim3(grid), dim3(NWAVES * 64), LDS_BYTES, stream, a); }
#else
    a.ph_lo = 0; a.ph_hi = NPHASE;
    void* kargs[] = {&a};
    hipError_t e = hipLaunchCooperativeKernel((const void*)mk_fwd, dim3(grid), dim3(NWAVES * 64), kargs, LDS_BYTES, stream);
    if (e != hipSuccess) fprintf(stderr, "cooperative launch failed: %s (grid %d)\n", hipGetErrorString(e), grid);
#endif
}
```

```cpp
#include <hip/hip_runtime.h>
#include <hip/hip_cooperative_groups.h>
#include <stdint.h>
#include <math.h>
#include <cstdio>
namespace cg = cooperative_groups;
__device__ __forceinline__ int lane_id_v() { int l; asm volatile("v_mbcnt_lo_u32_b32 %0, -1, 0\n\tv_mbcnt_hi_u32_b32 %0, -1, %0" : "=v"(l)); return l; }
namespace pg8 {
#define PG8_LAS __attribute__((address_space(3)))
typedef unsigned short bf16_t;
typedef short bf16x8 __attribute__((ext_vector_type(8)));
typedef float f32x4 __attribute__((ext_vector_type(4)));
typedef unsigned u32x4 __attribute__((ext_vector_type(4)));
constexpr int BM = 256, BK = 64, HALF = 128, HTB = HALF * BK * 2  , STAGE_BYTES = 8 * HTB, NXCD = 8, WGM = 8;

__host__ __device__ __forceinline__ int lds_byte(int r, int c) { const int st = (r >> 4) * 2 + (c >> 5), rr = r & 15, cc = c & 31, ob = rr * 64 + cc * 2; return st * 1024 + (ob ^ (((ob >> 9) & 1) << 5)); }
__host__ __device__ __forceinline__ void stage_rc(int b, int& R, int& C) { const int st = b / 1024, sb = b % 1024, swz = sb ^ (((sb >> 9) & 1) << 5); R = (st >> 1) * 16 + swz / 64; C = (st & 1) * 32 + (swz % 64) / 2; }
__host__ __device__ __forceinline__ int perm32(int rho) { const int n = rho >> 4, i = rho & 15; return 8 * (i >> 2) + 4 * n + (i & 3); }

struct Unit { int pm, pn; };
struct Gemm { const bf16_t* A; const bf16_t* Bt; int M, N, K; };

struct StaticOrder {
    int nM, nN, nwg, G, c;
    __host__ __device__ void init(int M, int N, int G_, int c_) { nM = M / BM; nN = N / BM; nwg = nM * nN; G = G_; c = c_; }
    __host__ __device__ bool next(int i, Unit& u) const {
        const long L = (long)i * G + c; if (L >= nwg) return false;
        int wgid = (int)L; { const int q = nwg / NXCD, r = nwg % NXCD, xcd = wgid % NXCD, off = wgid / NXCD; wgid = (xcd < r ? xcd * (q + 1) : r * (q + 1) + (xcd - r) * q) + off; }
        const int nig = WGM * nN, gid = wgid / nig, fm = gid * WGM, gsz = (nM - fm) < WGM ? (nM - fm) : WGM;
        u.pm = fm + ((wgid % nig) % gsz); u.pn = (wgid % nig) / gsz; return true;
    }
    __device__ __forceinline__ void a_ready(const Unit&) const {}
    __device__ __forceinline__ void done(const Unit&) const {}
};

__device__ __forceinline__ unsigned cvt_pk_bf16(float lo, float hi) { unsigned r; asm volatile("v_cvt_pk_bf16_f32 %0, %1, %2" : "=v"(r) : "v"(lo), "v"(hi)); return r; }
typedef float f32x2 __attribute__((ext_vector_type(2)));
__device__ __forceinline__ f32x2 gelu_pk(f32x2 v) {
    const f32x2 av = __builtin_elementwise_abs(v), d = av * 0.2316418882f + 1.0f;
    f32x2 t; t.x = __builtin_amdgcn_rcpf(d.x); t.y = __builtin_amdgcn_rcpf(d.y);
    f32x2 q = t * 0.5307027145f + (-0.7265760135f); q = q * t + 0.7107068705f; q = q * t + (-0.142248368f); q = q * t + 0.127414796f; q = q * t;
    const f32x2 s = (v * v) * (-0.72134752044f);
    f32x2 e; e.x = __builtin_amdgcn_exp2f(s.x); e.y = __builtin_amdgcn_exp2f(s.y);
    const f32x2 m = v * (q * e), r = v - m;
    f32x2 o; o.x = v.x < 0.f ? m.x : r.x; o.y = v.y < 0.f ? m.y : r.y; return o;
}

template <int ACT  > struct EpiBf16 {
    static constexpr bool PERM = true, AFTER_DRAIN = false; static_assert(ACT == 0 || ACT == 1, "EpiBf16: ACT is 0 (none) or 1 (gelu_pk)");
    bf16_t* O; int ldc; const float* bias; int split_cols; size_t split_stride; float scale0;
    __device__ __forceinline__ void operator()(const f32x4 (&acc)[2][2][4][2], const Unit& u, int wr, int wc, int fr, int fq) const {
        const int row0 = u.pm * BM + wr * 64 + fr; int colt = u.pn * BM; bf16_t* base = O;
        float sc = 1.f; if (split_cols) { const int t = colt / split_cols; base += (size_t)t * split_stride; colt -= t * split_cols; if (t == 0) sc = scale0; }
        const int col0 = colt + wc * 32 + 8 * fq, bcol0 = u.pn * BM + wc * 32 + 8 * fq;
        f32x4 bv[2][2];
#pragma unroll
        for (int bj = 0; bj < 2; ++bj)
#pragma unroll
            for (int n = 0; n < 2; ++n) bv[bj][n] = bias ? *(const f32x4*)(bias + bcol0 + bj * HALF + 4 * n) : (f32x4){0.f, 0.f, 0.f, 0.f};
#pragma unroll
        for (int ai = 0; ai < 2; ++ai)
#pragma unroll
            for (int m = 0; m < 4; ++m) { bf16_t* rowp = base + (size_t)(row0 + ai * HALF + m * 16) * ldc + col0;
#pragma unroll
                for (int bj = 0; bj < 2; ++bj) { f32x4 v0 = acc[ai][bj][m][0] + bv[bj][0], v1 = acc[ai][bj][m][1] + bv[bj][1];
                    if (ACT == 1) { f32x2 a = gelu_pk((f32x2){v0[0], v0[1]}), b = gelu_pk((f32x2){v0[2], v0[3]}), c = gelu_pk((f32x2){v1[0], v1[1]}), d = gelu_pk((f32x2){v1[2], v1[3]});
                        v0 = (f32x4){a.x, a.y, b.x, b.y}; v1 = (f32x4){c.x, c.y, d.x, d.y}; }
                    v0 = v0 * sc; v1 = v1 * sc; u32x4 w; w.x = cvt_pk_bf16(v0[0], v0[1]); w.y = cvt_pk_bf16(v0[2], v0[3]); w.z = cvt_pk_bf16(v1[0], v1[1]); w.w = cvt_pk_bf16(v1[2], v1[3]);
                    *(u32x4*)(rowp + bj * HALF) = w; } }
    }
};
template <class Epi, class Sched, bool ALIGN_EPI = false, bool SP2 = false>
__device__ __forceinline__ void gemm_phase(PG8_LAS unsigned char* lds, const Gemm g, const Sched& S, const Epi& E, int wave_id) {
    int tid_ = wave_id * 64 + lane_id_v();
    const int tid = tid_, wid = __builtin_amdgcn_readfirstlane(tid >> 6), lane = tid & 63, wr = wid >> 2, wc = wid & 3, fr = lane & 15, fq = lane >> 4;
    const int K = g.K, nt = K / BK;
    unsigned voffA[2], voffB[2];
#pragma unroll
    for (int i = 0; i < 2; ++i) { int R, C; stage_rc(tid * 16 + i * 8192, R, C); const int Rb = Epi::PERM ? ((R & ~31) + perm32(R & 31)) : R;
        voffA[i] = (unsigned)(R * K + C) * 2u; voffB[i] = (unsigned)(Rb * K + C) * 2u; }
    const size_t kstep = (size_t)(BK * 2);
    const size_t hstep = (size_t)HALF * K * 2;
    const size_t tstep = 2 * hstep;
    const unsigned ldsw = (unsigned)wid * 1024u;
    const int aoff = lds_byte(wr * 64 + fr, fq * 8), boff = lds_byte(wc * 32 + fr, fq * 8);
#define PG8_SA(b, h) (((b) * 2 + (h)) * HTB)
#define PG8_SB(b, h) ((4 + (b) * 2 + (h)) * HTB)
#define PG8_STAGE(bufoff, gbase, voff) do { _Pragma("unroll") for (int _i = 0; _i < 2; ++_i) \
        __builtin_amdgcn_global_load_lds((const unsigned*)((const char*)(gbase) + (voff)[_i]), (PG8_LAS unsigned*)(lds + (bufoff) + ldsw + _i * 8192), 16, 0, 0); } while (0)
#define PG8_LDA(dst, b, h) do { _Pragma("unroll") for (int m = 0; m < 4; ++m) _Pragma("unroll") for (int k = 0; k < 2; ++k) dst[m][k] = *(const PG8_LAS bf16x8*)(lds + PG8_SA(b, h) + aoff + m * 2048 + k * 1024); } while (0)
#define PG8_LDB(dst, b, h) do { _Pragma("unroll") for (int n = 0; n < 2; ++n) _Pragma("unroll") for (int k = 0; k < 2; ++k) dst[n][k] = *(const PG8_LAS bf16x8*)(lds + PG8_SB(b, h) + boff + n * 2048 + k * 1024); } while (0)
#define PG8_MMA(ai, bj, At, Bt) do { __builtin_amdgcn_s_setprio(1); _Pragma("unroll") for (int m = 0; m < 4; ++m) _Pragma("unroll") for (int n = 0; n < 2; ++n) _Pragma("unroll") for (int k = 0; k < 2; ++k) \
        acc[ai][bj][m][n] = __builtin_amdgcn_mfma_f32_16x16x32_bf16(Bt[n][k], At[m][k], acc[ai][bj][m][n], 0, 0, 0); __builtin_amdgcn_s_setprio(0); } while (0)
#define PG8_WAIT_V(n) asm volatile("s_waitcnt vmcnt(" #n ")" ::: "memory")
#define PG8_WAIT_L(n) asm volatile("s_waitcnt lgkmcnt(" #n ")" ::: "memory")
#define PG8_BAR __builtin_amdgcn_s_barrier()
#define PG8_SCHED __builtin_amdgcn_sched_barrier(0)
    Unit cur, nxt; int ui = 0;
    if (!S.next(0, cur)) return;
    f32x4 acc[2][2][4][2];
#pragma unroll
    for (int a = 0; a < 2; ++a)
#pragma unroll
        for (int b = 0; b < 2; ++b)
#pragma unroll
            for (int m = 0; m < 4; ++m)
#pragma unroll
                for (int n = 0; n < 2; ++n) acc[a][b][m][n] = (f32x4){0.f, 0.f, 0.f, 0.f};
    bf16x8 At[4][2], B0[2][2], B1[2][2];
    const char* cA = (const char*)g.A + (size_t)cur.pm * tstep; const char* cB = (const char*)g.Bt + (size_t)cur.pn * tstep;
    S.a_ready(cur);
    if constexpr (SP2) {
        PG8_STAGE(PG8_SB(0, 0), cB, voffB); PG8_STAGE(PG8_SB(0, 1), cB + hstep, voffB); PG8_STAGE(PG8_SA(0, 0), cA, voffA); PG8_STAGE(PG8_SA(0, 1), cA + hstep, voffA);
        if (wr == 1) PG8_BAR;
        PG8_WAIT_V(2); PG8_BAR;
        PG8_STAGE(PG8_SB(1, 0), cB + kstep, voffB); PG8_STAGE(PG8_SA(1, 0), cA + kstep, voffA); PG8_STAGE(PG8_SB(1, 1), cB + hstep + kstep, voffB);
        PG8_WAIT_V(6); PG8_BAR;
    } else {
        PG8_STAGE(PG8_SB(0, 0), cB, voffB); PG8_STAGE(PG8_SA(0, 0), cA, voffA); PG8_STAGE(PG8_SB(0, 1), cB + hstep, voffB); PG8_STAGE(PG8_SA(0, 1), cA + hstep, voffA);
        if (wr == 1) PG8_BAR;
        PG8_WAIT_V(4); PG8_BAR;
        PG8_STAGE(PG8_SB(1, 0), cB + kstep, voffB); PG8_STAGE(PG8_SA(1, 0), cA + kstep, voffA); PG8_STAGE(PG8_SB(1, 1), cB + hstep + kstep, voffB);
        PG8_WAIT_V(6); PG8_BAR;
    }
    for (;;) {
        const bool has_next = S.next(ui + 1, nxt);
        const char* nA = has_next ? (const char*)g.A + (size_t)nxt.pm * tstep : cA; const char* nB = has_next ? (const char*)g.Bt + (size_t)nxt.pn * tstep : cB;
        for (int t = 0; t < nt; t += 2) {
            const bool last = (t == nt - 2);
            const char* a1 = cA + (size_t)(t + 1) * kstep;
            const char* a2 = last ? nA : cA + (size_t)(t + 2) * kstep; const char* b2 = last ? nB : cB + (size_t)(t + 2) * kstep;
            const char* a3 = a2 + kstep; const char* b3 = b2 + kstep;
            if (last && has_next) S.a_ready(nxt);
            if constexpr (SP2) {
            PG8_LDB(B0, 0, 0); PG8_LDB(B1, 0, 1); PG8_SCHED; PG8_LDA(At, 0, 0); PG8_STAGE(PG8_SA(1, 1), a1 + hstep, voffA);
            PG8_WAIT_V(8); PG8_WAIT_L(0); PG8_BAR; PG8_MMA(0, 0, At, B0); PG8_MMA(0, 1, At, B1); PG8_BAR; PG8_SCHED;
            PG8_LDA(At, 0, 1); PG8_STAGE(PG8_SB(0, 0), b2, voffB); PG8_STAGE(PG8_SB(0, 1), b2 + hstep, voffB); PG8_STAGE(PG8_SA(0, 0), a2, voffA);
            PG8_WAIT_V(8); PG8_WAIT_L(0); PG8_BAR; PG8_MMA(1, 0, At, B0); PG8_MMA(1, 1, At, B1); PG8_BAR; PG8_SCHED;
            PG8_LDB(B0, 1, 0); PG8_LDB(B1, 1, 1); PG8_SCHED; PG8_LDA(At, 1, 0); PG8_STAGE(PG8_SA(0, 1), a2 + hstep, voffA);
            PG8_WAIT_V(8); PG8_WAIT_L(0); PG8_BAR; PG8_MMA(0, 0, At, B0); PG8_MMA(0, 1, At, B1); PG8_BAR; PG8_SCHED;
            PG8_LDA(At, 1, 1); PG8_STAGE(PG8_SB(1, 0), b3, voffB); PG8_STAGE(PG8_SB(1, 1), b3 + hstep, voffB); PG8_STAGE(PG8_SA(1, 0), a3, voffA);
            PG8_WAIT_V(8); PG8_WAIT_L(0); PG8_BAR; PG8_MMA(1, 0, At, B0); PG8_MMA(1, 1, At, B1); PG8_BAR; PG8_SCHED;
            } else {
            PG8_LDB(B0, 0, 0); PG8_SCHED; PG8_LDA(At, 0, 0); PG8_STAGE(PG8_SA(1, 1), a1 + hstep, voffA);
            PG8_WAIT_L(8); PG8_BAR; PG8_WAIT_L(0); PG8_MMA(0, 0, At, B0); PG8_BAR; PG8_SCHED;
            PG8_LDB(B1, 0, 1); PG8_STAGE(PG8_SB(0, 0), b2, voffB);
            PG8_BAR; PG8_WAIT_L(0); PG8_MMA(0, 1, At, B1); PG8_BAR;
            PG8_LDA(At, 0, 1); PG8_STAGE(PG8_SA(0, 0), a2, voffA);
            PG8_BAR; PG8_WAIT_L(0); PG8_MMA(1, 0, At, B0); PG8_BAR; PG8_SCHED;
            PG8_STAGE(PG8_SB(0, 1), b2 + hstep, voffB);
            PG8_WAIT_V(6); PG8_BAR; PG8_MMA(1, 1, At, B1); PG8_BAR;
            PG8_LDB(B0, 1, 0); PG8_SCHED; PG8_LDA(At, 1, 0); PG8_STAGE(PG8_SA(0, 1), a2 + hstep, voffA);
            PG8_WAIT_L(8); PG8_BAR; PG8_WAIT_L(0); PG8_MMA(0, 0, At, B0); PG8_BAR; PG8_SCHED;
            PG8_LDB(B1, 1, 1); PG8_STAGE(PG8_SB(1, 0), b3, voffB);
            PG8_BAR; PG8_WAIT_L(0); PG8_MMA(0, 1, At, B1); PG8_BAR;
            PG8_LDA(At, 1, 1); PG8_STAGE(PG8_SA(1, 0), a3, voffA);
            PG8_BAR; PG8_WAIT_L(0); PG8_MMA(1, 0, At, B0); PG8_BAR; PG8_SCHED;
            PG8_STAGE(PG8_SB(1, 1), b3 + hstep, voffB);
            PG8_WAIT_V(6); PG8_BAR; PG8_MMA(1, 1, At, B1); PG8_BAR;
            }
        }
        if constexpr (ALIGN_EPI) { if (wr == 0) PG8_BAR; }
        if constexpr (!Epi::AFTER_DRAIN) { E(acc, cur, wr, wc, fr, fq); S.done(cur); }
        if (!has_next) break;
#pragma unroll
        for (int a = 0; a < 2; ++a)
#pragma unroll
            for (int b = 0; b < 2; ++b)
#pragma unroll
                for (int m = 0; m < 4; ++m)
#pragma unroll
                    for (int n = 0; n < 2; ++n) acc[a][b][m][n] = (f32x4){0.f, 0.f, 0.f, 0.f};
        cur = nxt; cA = nA; cB = nB; ++ui;
        if constexpr (ALIGN_EPI) { if (wr == 1) PG8_BAR; }
    }
    PG8_WAIT_V(0);
    if constexpr (!ALIGN_EPI) { if (wr == 0) PG8_BAR; }
    PG8_BAR;
    if constexpr (Epi::AFTER_DRAIN) { E.fused(acc, cur, wr, wc, fr, fq, lds, wid, lane); S.done(cur); }
#undef PG8_SA
#undef PG8_SB
#undef PG8_STAGE
#undef PG8_LDA
#undef PG8_LDB
#undef PG8_MMA
#undef PG8_WAIT_V
#undef PG8_WAIT_L
#undef PG8_BAR
#undef PG8_SCHED
}
}
typedef unsigned short bf16_t;
#define LAS __attribute__((address_space(3)))
#define GAS __attribute__((address_space(1)))
typedef unsigned v4u __attribute__((ext_vector_type(4)));
typedef unsigned v2u __attribute__((ext_vector_type(2)));
typedef float f32x4 __attribute__((ext_vector_type(4)));
constexpr int DM = 1024, NB = 32, SEQ = 2048, NTOK = NB * SEQ, NMEM = 256;
constexpr int LDP = 3328;
constexpr int C_SBQ = 0, C_SBK = 384, C_SBV = 768, C_SBG = 1152, C_DSQ = 1536, C_CKV = 1920, C_DSG = 2048,
              C_IDQ = 2432, C_IDK = 2688, C_IDW = 2720, C_MQ = 2728, C_MG = 2984, NCOL = 3240;
constexpr float EPS = 1e-6f;
constexpr size_t MiB = 1u << 20;
constexpr size_t WS_CTL = 0;
constexpr size_t WS_WIN = 1 * MiB;
constexpr size_t WS_WOUT = 14 * MiB;
constexpr size_t WS_WMEM = 18 * MiB;
constexpr size_t WS_MEMB = 20 * MiB;
constexpr size_t WS_MEMKV = 36 * MiB;
constexpr size_t WS_CKVN = 52 * MiB;
constexpr size_t WS_MASK = 68 * MiB;
constexpr size_t WS_H = 84 * MiB;
constexpr size_t WS_MIX = WS_H;
constexpr size_t WS_PROJ = 212 * MiB;
constexpr size_t WS_Y = WS_PROJ;
constexpr size_t WS_END = 628 * MiB;
constexpr int LDS_BYTES = 135168;
constexpr int NWAVES = 8;

__device__ __forceinline__ float bf2f(bf16_t v) { return __uint_as_float(((unsigned)v) << 16); }
__device__ __forceinline__ unsigned f2bf(float f) { unsigned u = __float_as_uint(f); u += 0x7fffu + ((u >> 16) & 1u); return u >> 16; }
__device__ __forceinline__ unsigned pk2(float lo, float hi) { return f2bf(lo) | (f2bf(hi) << 16); }
#define WAVE_SYNC() do { asm volatile("s_waitcnt lgkmcnt(0)" ::: "memory"); __builtin_amdgcn_wave_barrier(); } while (0)
__device__ __forceinline__ float wave_sum(float v) {
#pragma unroll
    for (int o = 1; o < 64; o <<= 1) v += __shfl_xor(v, o);
    return v;
}

__device__ const unsigned char T5TAB[128] = {0, 1, 2, 3, 4, 5, 6, 7, 8, 9, 10, 11, 12, 13, 14, 15, 16, 16, 16, 17, 17, 18, 18, 18, 19, 19, 19, 20, 20, 20, 20, 21, 21, 21, 21, 22, 22, 22, 22, 22, 23, 23, 23, 23, 23, 23, 24, 24, 24, 24, 24, 24, 25, 25, 25, 25, 25, 25, 25, 26, 26, 26, 26, 26, 26, 26, 26, 27, 27, 27, 27, 27, 27, 27, 27, 27, 27, 28, 28, 28, 28, 28, 28, 28, 28, 28, 28, 29, 29, 29, 29, 29, 29, 29, 29, 29, 29, 29, 29, 30, 30, 30, 30, 30, 30, 30, 30, 30, 30, 30, 30, 30, 30, 31, 31, 31, 31, 31, 31, 31, 31, 31, 31, 31, 31, 31, 31, 31};

struct Args { const float* in[11]; float* out; unsigned char* ws; int ph_lo, ph_hi; };

__device__ __forceinline__ void p0_transpose_item(const float* W, int K, int N, int Npad, bf16_t* WT, const float* g, LAS float* scr, int item, int lane) {
    const int nblk = Npad / 32, kb = item / nblk, nb = item % nblk, k0 = 64 * kb, n0 = 32 * nb;
    const int nn = n0 + (lane & 31);
#pragma unroll 8
    for (int i = 0; i < 32; ++i) { const int kk = 2 * i + (lane >> 5); float v = (nn < N) ? W[(size_t)(k0 + kk) * N + nn] : 0.f; if (g) v *= g[k0 + kk]; scr[kk * 33 + (lane & 31)] = v; }
    WAVE_SYNC();
    const int c = lane & 7;
#pragma unroll
    for (int j = 0; j < 4; ++j) { const int n = (lane >> 3) + 8 * j; const LAS float* s = scr + (8 * c) * 33 + n;
        v4u o; o.x = pk2(s[0 * 33], s[1 * 33]); o.y = pk2(s[2 * 33], s[3 * 33]); o.z = pk2(s[4 * 33], s[5 * 33]); o.w = pk2(s[6 * 33], s[7 * 33]);
        *(v4u*)(WT + (size_t)(n0 + n) * K + k0 + 8 * c) = o; }
    WAVE_SYNC();
}
template <bool NORM> __device__ __forceinline__ void row_to_bf16(const float* xrow, bf16_t* orow, int lane) {
    const f32x4* xr = (const f32x4*)xrow + lane;
    f32x4 v[4]; float s = 0.f;
#pragma unroll
    for (int j = 0; j < 4; ++j) { v[j] = xr[64 * j]; s += (v[j].x * v[j].x + v[j].y * v[j].y) + (v[j].z * v[j].z + v[j].w * v[j].w); }
    float r = 1.f;
    if (NORM) r = 1.0f / sqrtf(wave_sum(s) * (1.f / DM) + EPS);
    v2u* o8 = (v2u*)orow + lane;
#pragma unroll
    for (int j = 0; j < 4; ++j) { v2u w; w.x = pk2(v[j].x * r, v[j].y * r); w.y = pk2(v[j].z * r, v[j].w * r); o8[64 * j] = w; }
}

__device__ __forceinline__ void ckvnorm4(const bf16_t* PROJ, const float* kvg, bf16_t* CKVN, int row0, int lane) {
    const int row = row0 + (lane >> 4), c8 = (lane & 15) * 8;
    const v4u v = *(const v4u*)(PROJ + (size_t)row * LDP + C_CKV + c8);
    float f[8] = {__uint_as_float(v.x << 16), __uint_as_float(v.x & 0xffff0000u), __uint_as_float(v.y << 16), __uint_as_float(v.y & 0xffff0000u),
                  __uint_as_float(v.z << 16), __uint_as_float(v.z & 0xffff0000u), __uint_as_float(v.w << 16), __uint_as_float(v.w & 0xffff0000u)};
    float s = 0.f;
#pragma unroll
    for (int j = 0; j < 8; ++j) s += f[j] * f[j];
    s += __shfl_xor(s, 1); s += __shfl_xor(s, 2); s += __shfl_xor(s, 4); s += __shfl_xor(s, 8);
    const float r = 1.0f / sqrtf(s * (1.0f / 128.f) + EPS);
    const f32x4 g0 = *(const f32x4*)(kvg + c8), g1 = *(const f32x4*)(kvg + c8 + 4);
    v4u o; o.x = pk2(f[0] * r * g0.x, f[1] * r * g0.y); o.y = pk2(f[2] * r * g0.z, f[3] * r * g0.w); o.z = pk2(f[4] * r * g1.x, f[5] * r * g1.y); o.w = pk2(f[6] * r * g1.z, f[7] * r * g1.w);
    *(v4u*)(CKVN + (size_t)row * 128 + c8) = o;
}
__device__ __forceinline__ unsigned ordkey(float f) { unsigned u = __float_as_uint(f); return (u & 0x80000000u) ? ~u : (u | 0x80000000u); }
__device__ __forceinline__ void post_row(const float* xin, const bf16_t* Y, const float* g, float* xout, bf16_t* Hn, int row, int lane) {
    const bf16_t* yp = Y + (size_t)row * DM;
    float yv[16]; float s = 0.f;
#pragma unroll
    for (int j = 0; j < 4; ++j) {
        const v2u v = *(const v2u*)(yp + (lane + 64 * j) * 4);
        yv[4 * j + 0] = __uint_as_float(v.x << 16); yv[4 * j + 1] = __uint_as_float(v.x & 0xffff0000u);
        yv[4 * j + 2] = __uint_as_float(v.y << 16); yv[4 * j + 3] = __uint_as_float(v.y & 0xffff0000u);
        s += yv[4 * j] * yv[4 * j] + yv[4 * j + 1] * yv[4 * j + 1] + yv[4 * j + 2] * yv[4 * j + 2] + yv[4 * j + 3] * yv[4 * j + 3];
    }
    const float r = 1.0f / sqrtf(wave_sum(s) * (1.0f / DM) + EPS);
    f32x4 ov[4]; float s2 = 0.f;
#pragma unroll
    for (int j = 0; j < 4; ++j) {
        const int c = (lane + 64 * j) * 4;
        const f32x4 xv = *(const f32x4*)(xin + (size_t)row * DM + c);
        const f32x4 gv = *(const f32x4*)(g + c);
        ov[j].x = xv.x + yv[4 * j] * r * gv.x; ov[j].y = xv.y + yv[4 * j + 1] * r * gv.y; ov[j].z = xv.z + yv[4 * j + 2] * r * gv.z; ov[j].w = xv.w + yv[4 * j + 3] * r * gv.w;
        *(f32x4*)(xout + (size_t)row * DM + c) = ov[j];
        s2 += (ov[j].x * ov[j].x + ov[j].y * ov[j].y) + (ov[j].z * ov[j].z + ov[j].w * ov[j].w);
    }
    if (Hn) {
        const float r2 = 1.0f / sqrtf(wave_sum(s2) * (1.f / DM) + EPS);
        v2u* o8 = (v2u*)(Hn + (size_t)row * DM) + lane;
#pragma unroll
        for (int j = 0; j < 4; ++j) { v2u w; w.x = pk2(ov[j].x * r2, ov[j].y * r2); w.y = pk2(ov[j].z * r2, ov[j].w * r2); o8[64 * j] = w; }
    }
}

typedef short bf16x8 __attribute__((ext_vector_type(8)));
typedef short s16x4 __attribute__((ext_vector_type(4)));
typedef float f32x16 __attribute__((ext_vector_type(16)));
typedef float f32x2_t __attribute__((ext_vector_type(2)));
typedef __bf16 bf16x2_t __attribute__((ext_vector_type(2)));
#define MFMA32(a, b, c) __builtin_amdgcn_mfma_f32_32x32x16_bf16((a), (b), (c), 0, 0, 0)
__device__ __forceinline__ unsigned cvtpk(float lo, float hi) { f32x2_t v = {lo, hi}; bf16x2_t b = __builtin_convertvector(v, bf16x2_t); return __builtin_bit_cast(unsigned, b); }
__device__ __forceinline__ s16x4 vtr(const LAS unsigned char* p) { return __builtin_bit_cast(s16x4, __builtin_amdgcn_ds_read_tr16_b64_v4i16((LAS s16x4*)p)); }
__device__ __forceinline__ int crow(int r, int hi) { return (r & 3) + 8 * (r >> 2) + 4 * hi; }
__device__ __forceinline__ bf16x8 pack8(const f32x16& x, int s) {
    v4u p; p.x = cvtpk(x[8 * s + 0], x[8 * s + 1]); p.y = cvtpk(x[8 * s + 2], x[8 * s + 3]); p.z = cvtpk(x[8 * s + 4], x[8 * s + 5]); p.w = cvtpk(x[8 * s + 6], x[8 * s + 7]);
    return __builtin_bit_cast(bf16x8, p);
}
__device__ __forceinline__ f32x16 zero16() { float z; asm volatile("v_mov_b32 %0, 0" : "=v"(z)); return (f32x16){z, z, z, z, z, z, z, z, z, z, z, z, z, z, z, z}; }
__device__ __forceinline__ bf16x8 cat44(s16x4 lo, s16x4 hi) { return __builtin_shufflevector(lo, hi, 0, 1, 2, 3, 4, 5, 6, 7); }
__device__ __forceinline__ float xhalf_max(float v) { auto rr = __builtin_amdgcn_permlane32_swap(__float_as_uint(v), __float_as_uint(v), false, false); return fmaxf(__uint_as_float(rr[0]), __uint_as_float(rr[1])); }
__device__ __forceinline__ float xhalf_sum(float v) { auto rr = __builtin_amdgcn_permlane32_swap(__float_as_uint(v), __float_as_uint(v), false, false); return __uint_as_float(rr[0]) + __uint_as_float(rr[1]); }
__device__ __forceinline__ unsigned xhalf_other_u(unsigned v, int hi) { auto rr = __builtin_amdgcn_permlane32_swap(v, v, false, false); return hi ? rr[0] : rr[1]; }
__device__ __forceinline__ float xhalf_other(float v, int hi) { return __uint_as_float(xhalf_other_u(__float_as_uint(v), hi)); }
constexpr int VT_PITCH = 192;
constexpr float LOG2E = 1.4426950408889634f;

__device__ __forceinline__ void pv_tile(f32x16 (&O)[2], const LAS unsigned char* vrd, bf16x8 p0, bf16x8 p1) {
#pragma unroll
    for (int c = 0; c < 2; ++c) {
        const bf16x8 a0 = cat44(vtr(vrd + 0 * VT_PITCH + 64 * c), vtr(vrd + 8 * VT_PITCH + 64 * c));
        const bf16x8 a1 = cat44(vtr(vrd + 16 * VT_PITCH + 64 * c), vtr(vrd + 24 * VT_PITCH + 64 * c));
        O[c] = MFMA32(a0, p0, O[c]);
        O[c] = MFMA32(a1, p1, O[c]);
    }
}
__device__ __forceinline__ void gate_store(const f32x16 (&O)[2], float scale, const bf16_t* grow, bf16_t* orow, int hi) {
#pragma unroll
    for (int c = 0; c < 2; ++c)
#pragma unroll
        for (int g = 0; g < 4; ++g) {
            const int d = 32 * c + 8 * g + 4 * hi;
            const v2u gv = *(const v2u*)(grow + d);
            float gt[4] = {__uint_as_float(gv.x << 16), __uint_as_float(gv.x & 0xffff0000u), __uint_as_float(gv.y << 16), __uint_as_float(gv.y & 0xffff0000u)};
            float ov[4];
#pragma unroll
            for (int j = 0; j < 4; ++j) ov[j] = O[c][4 * g + j] * scale * gt[j] * __builtin_amdgcn_rcpf(1.f + __builtin_amdgcn_exp2f(-gt[j] * LOG2E));
            v2u w; w.x = cvtpk(ov[0], ov[1]); w.y = cvtpk(ov[2], ov[3]);
            *(v2u*)(orow + d) = w;
        }
}

__device__ __forceinline__ void gate_load(v2u (&gw)[8], const bf16_t* grow, int hi) {
#pragma unroll
    for (int c = 0; c < 2; ++c)
#pragma unroll
        for (int g = 0; g < 4; ++g) gw[c * 4 + g] = *(const v2u*)(grow + 32 * c + 8 * g + 4 * hi);
}
__device__ __forceinline__ void gate_store_pre(const f32x16 (&O)[2], float scale, const v2u (&gw)[8], bf16_t* orow, int hi) {
#pragma unroll
    for (int c = 0; c < 2; ++c)
#pragma unroll
        for (int g = 0; g < 4; ++g) {
            const int d = 32 * c + 8 * g + 4 * hi;
            const v2u gv = gw[c * 4 + g];
            float gt[4] = {__uint_as_float(gv.x << 16), __uint_as_float(gv.x & 0xffff0000u), __uint_as_float(gv.y << 16), __uint_as_float(gv.y & 0xffff0000u)};
            float ov[4];
#pragma unroll
            for (int j = 0; j < 4; ++j) ov[j] = O[c][4 * g + j] * scale * gt[j] * __builtin_amdgcn_rcpf(1.f + __builtin_amdgcn_exp2f(-gt[j] * LOG2E));
            v2u w; w.x = cvtpk(ov[0], ov[1]); w.y = cvtpk(ov[2], ov[3]);
            *(v2u*)(orow + d) = w;
        }
}

__device__ __forceinline__ void sb_item(const bf16_t* PROJ, bf16_t* MIX, int b, int h, int qt, int lane, LAS unsigned char* wl) {
    asm volatile("" : "+v"(lane));
    const int r32 = lane & 31, hi = lane >> 5;
    const bf16_t* base = PROJ + (size_t)b * SEQ * LDP;
    const int t = 32 * qt + r32;
    bf16x8 qf[4];
#pragma unroll
    for (int ks = 0; ks < 4; ++ks) qf[ks] = *(const bf16x8*)(base + (size_t)t * LDP + C_SBQ + h * 64 + 16 * ks + 8 * hi);
    v2u gw[8]; gate_load(gw, base + (size_t)t * LDP + C_SBG + h * 64, hi);
    const int vrow = lane >> 3, vch = lane & 7;
    LAS unsigned char* vwr = wl + vrow * VT_PITCH + vch * 16;
    const LAS unsigned char* vrd = wl + (4 * hi + ((lane & 15) >> 2)) * VT_PITCH + (16 * ((lane >> 4) & 1) + 4 * (lane & 3)) * 2;
    bf16x8 kc[4], vc[4];
    {
        const bf16_t* kp = base + (size_t)(32 * qt + r32) * LDP + C_SBK + h * 64 + 8 * hi;
#pragma unroll
        for (int ks = 0; ks < 4; ++ks) kc[ks] = *(const bf16x8*)(kp + 16 * ks);
        const bf16_t* vp = base + (size_t)(32 * qt + vrow) * LDP + C_SBV + h * 64 + 8 * vch;
#pragma unroll
        for (int i = 0; i < 4; ++i) vc[i] = *(const bf16x8*)(vp + (size_t)(8 * i) * LDP);
    }
    f32x16 O[2];
#pragma unroll
    for (int r = 0; r < 16; ++r) { O[0][r] = 0.f; O[1][r] = 0.f; }
    float R = 1.f;
    for (int kt = qt; kt >= 0; --kt) {
        bf16x8 kn[4], vn[4];
        {
            const int ktn = kt > 0 ? kt - 1 : 0;
            const bf16_t* kp = base + (size_t)(32 * ktn + r32) * LDP + C_SBK + h * 64 + 8 * hi;
#pragma unroll
            for (int ks = 0; ks < 4; ++ks) kn[ks] = *(const bf16x8*)(kp + 16 * ks);
            const bf16_t* vp = base + (size_t)(32 * ktn + vrow) * LDP + C_SBV + h * 64 + 8 * vch;
#pragma unroll
            for (int i = 0; i < 4; ++i) vn[i] = *(const bf16x8*)(vp + (size_t)(8 * i) * LDP);
        }
        f32x16 acc;
#pragma unroll
        for (int r = 0; r < 16; ++r) acc[r] = 0.f;
#pragma unroll
        for (int ks = 0; ks < 4; ++ks) acc = MFMA32(kc[ks], qf[ks], acc);
#pragma unroll
        for (int i = 0; i < 4; ++i) *(LAS bf16x8*)(vwr + (8 * i) * VT_PITCH) = vc[i];
        float be[16], om[16];
        const bool diag = (kt == qt);
#pragma unroll
        for (int r = 0; r < 16; ++r) {
            const float e = __builtin_amdgcn_exp2f(fminf(acc[r] * (-0.125f * LOG2E), 115.f));
            float bt = __builtin_amdgcn_rcpf(1.f + e), o1 = e * bt;
            if (diag && !(crow(r, hi) < r32)) { bt = 0.f; o1 = 1.f; }
            be[r] = bt; om[r] = o1;
        }
        float Gp[4], Gq[4];
#pragma unroll
        for (int g = 0; g < 4; ++g) { Gp[g] = (om[4 * g] * om[4 * g + 1]) * (om[4 * g + 2] * om[4 * g + 3]); Gq[g] = xhalf_other(Gp[g], hi); }
        const float T1 = Gp[1] * Gq[1], T2 = Gp[2] * Gq[2], T3 = Gp[3] * Gq[3], T0 = Gp[0] * Gq[0];
        float tail[4]; tail[3] = R; tail[2] = R * T3; tail[1] = tail[2] * T2; tail[0] = tail[1] * T1;
        const float Rn = tail[0] * T0;
#pragma unroll
        for (int g = 0; g < 4; ++g) {
            float sfx = tail[g] * (hi == 0 ? Gq[g] : 1.f);
            acc[4 * g + 3] = be[4 * g + 3] * sfx; sfx *= om[4 * g + 3];
            acc[4 * g + 2] = be[4 * g + 2] * sfx; sfx *= om[4 * g + 2];
            acc[4 * g + 1] = be[4 * g + 1] * sfx; sfx *= om[4 * g + 1];
            acc[4 * g + 0] = be[4 * g + 0] * sfx;
        }
        R = Rn;
        const bf16x8 p0 = pack8(acc, 0), p1 = pack8(acc, 1);
        pv_tile(O, vrd, p0, p1);
        if (__all(R < 7.8886e-31f)) break;
#pragma unroll
        for (int i = 0; i < 4; ++i) { kc[i] = kn[i]; vc[i] = vn[i]; }
    }
    gate_store_pre(O, 1.f, gw, MIX + ((size_t)b * SEQ + t) * DM + h * 64, hi);
}

__device__ __forceinline__ void mem_item(const bf16_t* PROJ, const bf16_t* KV, bf16_t* MIX, int b, int h, int qt, int lane, LAS unsigned char* wl) {
    asm volatile("" : "+v"(lane));
    float NINF; asm volatile("v_mov_b32 %0, 0xff800000" : "=v"(NINF));
    const int r32 = lane & 31, hi = lane >> 5;
    const int t = 32 * qt + r32;
    const bf16_t* prow = PROJ + ((size_t)b * SEQ + t) * LDP;
    bf16x8 qf[4];
#pragma unroll
    for (int ks = 0; ks < 4; ++ks) qf[ks] = *(const bf16x8*)(prow + C_MQ + h * 64 + 16 * ks + 8 * hi);
    const int vrow = lane >> 3, vch = lane & 7;
    LAS unsigned char* vwr = wl + vrow * VT_PITCH + vch * 16;
    const LAS unsigned char* vrd = wl + (4 * hi + ((lane & 15) >> 2)) * VT_PITCH + (16 * ((lane >> 4) & 1) + 4 * (lane & 3)) * 2;
    const bf16_t* kvb = KV + (size_t)b * NMEM * 1024 + h * 64;
    f32x16 O[2];
#pragma unroll
    for (int r = 0; r < 16; ++r) { O[0][r] = 0.f; O[1][r] = 0.f; }
    float mrun = NINF, lrun = 0.f;
    v2u gw[8]; gate_load(gw, prow + C_MG + h * 64, hi);
    bf16x8 kc[4], vc[4];
    {
        const bf16_t* kp = kvb + (size_t)r32 * 1024 + 8 * hi;
#pragma unroll
        for (int ks = 0; ks < 4; ++ks) kc[ks] = *(const bf16x8*)(kp + 16 * ks);
        const bf16_t* vp = kvb + (size_t)vrow * 1024 + 256 + 8 * vch;
#pragma unroll
        for (int i = 0; i < 4; ++i) vc[i] = *(const bf16x8*)(vp + (size_t)(8 * i) * 1024);
    }
    for (int kt = 0; kt < NMEM / 32; ++kt) {
        bf16x8 kn[4], vn[4];
        {
            const int ktn = kt < NMEM / 32 - 1 ? kt + 1 : kt;
            const bf16_t* kp = kvb + (size_t)(32 * ktn + r32) * 1024 + 8 * hi;
#pragma unroll
            for (int ks = 0; ks < 4; ++ks) kn[ks] = *(const bf16x8*)(kp + 16 * ks);
            const bf16_t* vp = kvb + (size_t)(32 * ktn + vrow) * 1024 + 256 + 8 * vch;
#pragma unroll
            for (int i = 0; i < 4; ++i) vn[i] = *(const bf16x8*)(vp + (size_t)(8 * i) * 1024);
        }
        f32x16 acc;
#pragma unroll
        for (int r = 0; r < 16; ++r) acc[r] = 0.f;
#pragma unroll
        for (int ks = 0; ks < 4; ++ks) acc = MFMA32(kc[ks], qf[ks], acc);
#pragma unroll
        for (int i = 0; i < 4; ++i) *(LAS bf16x8*)(vwr + (8 * i) * VT_PITCH) = vc[i];
        float mx = acc[0];
#pragma unroll
        for (int r = 1; r < 16; ++r) mx = fmaxf(mx, acc[r]);
        mx *= 0.125f * LOG2E;
        mx = xhalf_max(mx);
        const float mn = fmaxf(mrun, mx), alpha = __builtin_amdgcn_exp2f(mrun - mn);
        float ps = 0.f;
#pragma unroll
        for (int r = 0; r < 16; ++r) { acc[r] = __builtin_amdgcn_exp2f(acc[r] * (0.125f * LOG2E) - mn); ps += acc[r]; }
        lrun = lrun * alpha + ps; mrun = mn;
#pragma unroll
        for (int r = 0; r < 16; ++r) { O[0][r] *= alpha; O[1][r] *= alpha; }
        const bf16x8 p0 = pack8(acc, 0), p1 = pack8(acc, 1);
        pv_tile(O, vrd, p0, p1);
#pragma unroll
        for (int i = 0; i < 4; ++i) { kc[i] = kn[i]; vc[i] = vn[i]; }
    }
    const float lt = xhalf_sum(lrun);
    gate_store_pre(O, 1.f / lt, gw, MIX + ((size_t)b * SEQ + t) * DM + 768 + h * 64, hi);
}

constexpr int SEL_IQ_PITCH = 528, SEL_CNT_OFF = 17408;
__device__ __forceinline__ unsigned ordkey(float f);
template <int PRED  >
__device__ __forceinline__ unsigned sel_count_round(const unsigned (&key)[8][16], unsigned c, unsigned tau, int idx0, int r32, int hi, int wave, LAS unsigned* cb) {
    int n = 0;
#pragma unroll
    for (int i = 0; i < 8; ++i) {
#pragma unroll
        for (int r = 0; r < 16; ++r) {
            if (PRED == 0) n += (key[i][r] >= c) ? 1 : 0;
            else if (PRED == 1) n += (key[i][r] > c) ? 1 : 0;
            else n += (key[i][r] == tau && (unsigned)(idx0 + 256 * i + (r & 3) + 8 * (r >> 2)) <= c) ? 1 : 0;
            if ((r & 7) == 7) asm volatile("" : "+v"(n));
        }
    }
    n += __shfl_xor(n, 32);
    if (hi == 0) cb[wave * 32 + r32] = (unsigned)n;
    __syncthreads();
    unsigned tot = 0;
#pragma unroll
    for (int w = 0; w < 8; ++w) tot += cb[w * 32 + r32];
    return tot;
}
constexpr int SEL_CAP = 64, SEL_DONE = 16;
__device__ __forceinline__ float key2f(unsigned k) { return __uint_as_float((k & 0x80000000u) ? (k & 0x7fffffffu) : ~k); }
__device__ __forceinline__ unsigned sel_count_lane(const unsigned (&key)[8][16], unsigned c) {
    int n = 0;
#pragma unroll
    for (int i = 0; i < 8; ++i) {
#pragma unroll
        for (int r = 0; r < 16; ++r) {
            n += (key[i][r] >= c) ? 1 : 0;
            if ((r & 7) == 7) asm volatile("" : "+v"(n));
        }
    }
    return (unsigned)n;
}
__device__ __forceinline__ unsigned sel_exchange(unsigned nl, int r32, int hi, int wave, LAS unsigned* cb) {
    const unsigned n2 = nl + xhalf_other_u(nl, hi);
    if (hi == 0) cb[wave * 32 + r32] = n2;
    __syncthreads();
    unsigned tot = 0;
#pragma unroll
    for (int w = 0; w < 8; ++w) tot += cb[w * 32 + r32];
    return tot;
}
__device__ __forceinline__ void sel_item2(const bf16_t* PROJ, unsigned* MASK, int b, int qt, int lane, int wave, LAS unsigned char* L) {
    asm volatile("" : "+v"(lane));
    const int r32 = lane & 31, hi = lane >> 5, tid = wave * 64 + lane;
    LAS unsigned* cntb = (LAS unsigned*)(L + SEL_CNT_OFF);
    const bf16_t* base = PROJ + (size_t)b * SEQ * LDP;
    unsigned* mrow = MASK + (((size_t)b * 64 + qt) * 64) * 32;
    if (qt < 8) {
#pragma unroll
        for (int i = 0; i < 8; ++i) {
            const int kt = wave + 8 * i;
            if (kt <= qt) {
                unsigned bits = 0u;
#pragma unroll
                for (int r = 0; r < 16; ++r) bits |= ((kt < qt) || (crow(r, hi) <= r32)) ? (1u << r) : 0u;
                const unsigned other = xhalf_other_u(bits, hi);
                if (hi == 0) mrow[kt * 32 + r32] = bits | (other << 16);
            }
        }
        return;
    }
    for (int n = tid; n < 1024; n += 512) { const int row = n >> 5, ch = n & 31;
        const v4u v = *(const v4u*)(base + (size_t)(32 * qt + row) * LDP + C_IDQ + ch * 8);
        *(LAS v4u*)(L + row * SEL_IQ_PITCH + ch * 16) = v; }
    float w8[8];
    { const v4u wv = *(const v4u*)(base + (size_t)(32 * qt + r32) * LDP + C_IDW);
      w8[0] = __uint_as_float(wv.x << 16) * 0.0625f; w8[1] = __uint_as_float(wv.x & 0xffff0000u) * 0.0625f; w8[2] = __uint_as_float(wv.y << 16) * 0.0625f; w8[3] = __uint_as_float(wv.y & 0xffff0000u) * 0.0625f;
      w8[4] = __uint_as_float(wv.z << 16) * 0.0625f; w8[5] = __uint_as_float(wv.z & 0xffff0000u) * 0.0625f; w8[6] = __uint_as_float(wv.w << 16) * 0.0625f; w8[7] = __uint_as_float(wv.w & 0xffff0000u) * 0.0625f; }
    __syncthreads();
    unsigned key[8][16];
    const LAS unsigned char* iqp = L + r32 * SEL_IQ_PITCH + 16 * hi;
    unsigned kmn = 0xffffffffu, kmx = 0u;
#pragma unroll
    for (int i = 0; i < 8; ++i) {
        const int kt = wave + 8 * i;
        if (kt <= qt) {
            const bf16_t* kp = base + (size_t)(32 * kt + r32) * LDP + C_IDK + 8 * hi;
            const bf16x8 k0 = *(const bf16x8*)kp, k1 = *(const bf16x8*)(kp + 16);
            float sc[16];
#pragma unroll
            for (int r = 0; r < 16; ++r) sc[r] = 0.f;
            unsigned iqo = 0; asm volatile("" : "+v"(iqo));
            const LAS unsigned char* iqt = iqp + iqo;
#pragma unroll
            for (int h = 0; h < 8; ++h) {
                const bf16x8 q0 = *(const LAS bf16x8*)(iqt + h * 64), q1 = *(const LAS bf16x8*)(iqt + h * 64 + 32);
                bf16x8 q0p = q0, q1p = q1;
                asm volatile("" : "+v"(q0p), "+v"(q1p) : "v"(sc[15]));
                f32x16 D = MFMA32(k0, q0p, zero16());
                D = MFMA32(k1, q1p, D);
#pragma unroll
                for (int r = 0; r < 16; ++r) sc[r] += w8[h] * fmaxf(D[r], 0.f);
                asm volatile("" : "+v"(sc[0]), "+v"(sc[1]), "+v"(sc[2]), "+v"(sc[3]), "+v"(sc[4]), "+v"(sc[5]), "+v"(sc[6]), "+v"(sc[7]),
                                  "+v"(sc[8]), "+v"(sc[9]), "+v"(sc[10]), "+v"(sc[11]), "+v"(sc[12]), "+v"(sc[13]), "+v"(sc[14]), "+v"(sc[15]));
            }
            int thr = (kt < qt) ? 64 : (r32 - 4 * hi);
            asm volatile("" : "+v"(thr));
#pragma unroll
            for (int r = 0; r < 16; ++r) { const bool v = ((r & 3) + 8 * (r >> 2) <= thr); const unsigned k = ordkey(sc[r]); key[i][r] = v ? k : 0u; kmx = max(kmx, v ? k : 0u); kmn = min(kmn, v ? k : 0xffffffffu); }
        } else {
#pragma unroll
            for (int r = 0; r < 16; ++r) key[i][r] = 0u;
        }
    }
    unsigned lo_key, hi_key, clo, chi = 0u, nlo_l, nhi_l = 0u;
    {
        int nv = 0;
#pragma unroll
        for (int i = 0; i < 8; ++i) { const int kt = wave + 8 * i; nv += (kt < qt) ? 16 : 0; }
        if ((qt & 7) == wave) { const int thr = r32 - 4 * hi;
#pragma unroll
            for (int r = 0; r < 16; ++r) nv += ((r & 3) + 8 * (r >> 2) <= thr) ? 1 : 0; }
        nlo_l = (unsigned)nv;
        kmn = min(kmn, xhalf_other_u(kmn, hi)); kmx = max(kmx, xhalf_other_u(kmx, hi));
        if (hi == 0) { cntb[wave * 32 + r32] = kmn; cntb[256 + wave * 32 + r32] = kmx; }
        __syncthreads();
        unsigned a = 0xffffffffu, bmx = 0u;
#pragma unroll
        for (int w = 0; w < 8; ++w) { a = min(a, cntb[w * 32 + r32]); bmx = max(bmx, cntb[256 + w * 32 + r32]); }
        lo_key = a; hi_key = bmx + 1u; clo = (unsigned)(32 * qt + r32 + 1);
        __syncthreads();
    }
    int round = 0;
    for (;;) {
        const bool done = (clo - chi <= (unsigned)SEL_DONE) || (hi_key - lo_key <= 1u);
        if (__all(done)) break;
        unsigned p;
        if ((round & 3) == 3) p = lo_key + ((hi_key - lo_key) >> 1);
        else p = ordkey(0.5f * key2f(lo_key) + 0.5f * key2f(hi_key));
        p = min(max(p, lo_key + 1u), hi_key - 1u);
        if (done) p = lo_key;
        const unsigned nl = sel_count_lane(key, p);
        const unsigned tot = sel_exchange(nl, r32, hi, wave, cntb + (round & 1) * 256);
        if (!done) { if (tot >= 256u) { lo_key = p; clo = tot; nlo_l = nl; } else { hi_key = p; chi = tot; nhi_l = nl; } }
        ++round;
    }
    unsigned tau, cut;
    const bool many = (clo - chi > (unsigned)SEL_CAP);
    {
        LAS unsigned* lanecnt = (LAS unsigned*)L; LAS unsigned* meta = (LAS unsigned*)(L + 2048); LAS unsigned* result = (LAS unsigned*)(L + 2304); LAS unsigned* list = (LAS unsigned*)(L + 20480);
        const int slot = wave * 2 + hi;
        lanecnt[r32 * 16 + slot] = many ? 0u : (nlo_l - nhi_l);
        if (slot == 0) { meta[2 * r32] = many ? 0u : (clo - chi); meta[2 * r32 + 1] = 256u - chi; }
        __syncthreads();
        unsigned bs = 0u;
#pragma unroll
        for (int s2 = 0; s2 < 16; ++s2) { const unsigned v = lanecnt[r32 * 16 + s2]; bs += (s2 < slot) ? v : 0u; }
        if (!many) {
            const int idx0 = 32 * wave + 4 * hi;
            LAS unsigned* lp = list + (r32 * SEL_CAP + bs) * 2;
#pragma unroll
            for (int i = 0; i < 8; ++i)
#pragma unroll
                for (int r = 0; r < 16; ++r) {
                    const unsigned k = key[i][r];
                    if (k >= lo_key && k < hi_key) { lp[0] = k; lp[1] = (unsigned)(idx0 + 256 * i + (r & 3) + 8 * (r >> 2)); lp += 2; }
                }
        }
        __syncthreads();
        for (int j = 0; j < 4; ++j) {
            const int q = 4 * wave + j;
            const unsigned ncand = (unsigned)__builtin_amdgcn_readfirstlane((int)meta[2 * q]), need = (unsigned)__builtin_amdgcn_readfirstlane((int)meta[2 * q + 1]);
            const LAS unsigned* lq = list + q * SEL_CAP * 2;
            const bool mine = (unsigned)lane < ncand;
            const unsigned kc = mine ? lq[2 * lane] : 0u, ic = mine ? lq[2 * lane + 1] : 0u;
            unsigned rank = 0u;
            for (unsigned c2 = 0; c2 < ncand; ++c2) { const unsigned k2 = lq[2 * c2], i2 = lq[2 * c2 + 1]; rank += (k2 > kc || (k2 == kc && i2 < ic)) ? 1u : 0u; }
            if (mine && rank == need - 1u) { result[2 * q] = kc; result[2 * q + 1] = ic; }
        }
        __syncthreads();
        tau = result[2 * r32]; cut = result[2 * r32 + 1];
    }
    if (__any(many)) {
        const unsigned need = 256u - chi;
        const int idx0 = 32 * wave + 4 * hi;
        unsigned lo_ = 0u, hi_ = 2047u;
        for (int it = 0; it < 11; ++it) {
            const unsigned mid = (lo_ + hi_) >> 1;
            const unsigned f = sel_count_round<2>(key, mid, lo_key, idx0, r32, hi, wave, cntb + (it & 1) * 256);
            if (f >= need) hi_ = mid; else lo_ = mid + 1;
        }
        if (many) { tau = lo_key; cut = hi_; }
    }
    {
        const int idx0 = 32 * wave + 4 * hi;
#pragma unroll
        for (int i = 0; i < 8; ++i) {
            const int kt = wave + 8 * i;
            if (kt <= qt) {
                unsigned bits = 0u;
#pragma unroll
                for (int r = 0; r < 16; ++r) {
                    const bool s = (key[i][r] > tau) || (key[i][r] == tau && (unsigned)(idx0 + 256 * i + (r & 3) + 8 * (r >> 2)) <= cut);
                    bits |= s ? (1u << r) : 0u;
                }
                const unsigned other = xhalf_other_u(bits, hi);
                if (hi == 0) mrow[kt * 32 + r32] = bits | (other << 16);
            }
        }
    }
    __syncthreads();
}

constexpr int WS_WUK = 0;
constexpr int WS_WUV = 256 * 1024;
constexpr int DSA_BIAS_OFF = 16384;
__device__ __forceinline__ unsigned dsa_off(unsigned row, unsigned ch) { return 256u * row + 16u * (ch ^ (((row & 3u) << 2) | ((row >> 2) & 3u))); }
__device__ __forceinline__ void dsa_round(const bf16_t* PROJ, const bf16_t* CKVN, const unsigned* MASK, const bf16_t* WUKp  , const bf16_t* WUVp  ,
                                          const float* rel_bias, bf16_t* MIX, int b, int o, int h, int lane, int wave, LAS unsigned char* L) {
    asm volatile("" : "+v"(lane));
    float NINF; asm volatile("v_mov_b32 %0, 0xff800000" : "=v"(NINF));
    const int r32 = lane & 31, hi = lane >> 5, tid = wave * 64 + lane;
    const int qt = 8 * o + wave, KT = 8 * o + 7, t = 32 * qt + r32;
    LAS float* biasT = (LAS float*)(L + DSA_BIAS_OFF);
    if (tid < 192) { const int bk = tid < 128 ? (int)T5TAB[tid] : 31; biasT[tid] = rel_bias[bk * 6 + h] * LOG2E; }
    const float bias31 = rel_bias[31 * 6 + h] * LOG2E;
    bf16x8 qlf[8];
    {
        const bf16_t* qrow = PROJ + ((size_t)b * SEQ + t) * LDP + C_DSQ + h * 64 + 8 * hi;
        bf16x8 qf[4];
#pragma unroll
        for (int ks = 0; ks < 4; ++ks) qf[ks] = *(const bf16x8*)(qrow + 16 * ks);
#pragma unroll
        for (int rt = 0; rt < 4; ++rt) {
            f32x16 X;
#pragma unroll
            for (int r = 0; r < 16; ++r) X[r] = 0.f;
            const GAS bf16_t* wp = (const GAS bf16_t*)WUKp + (rt * 32 + r32) * 64 + 8 * hi;
#pragma unroll
            for (int ks = 0; ks < 4; ++ks) X = MFMA32(*(const GAS bf16x8*)(wp + 16 * ks), qf[ks], X);
#pragma unroll
            for (int r = 0; r < 16; ++r) X[r] *= 0.125f * LOG2E;
            qlf[2 * rt] = pack8(X, 0); qlf[2 * rt + 1] = pack8(X, 1);
        }
    }
    f32x16 O[4];
#pragma unroll
    for (int c = 0; c < 4; ++c)
#pragma unroll
        for (int r = 0; r < 16; ++r) O[c][r] = 0.f;
    float mref = NINF, lrun = 0.f;
    const int srow = tid >> 4, sch = tid & 15;
    const bf16_t* csrc = CKVN + ((size_t)b * SEQ + srow) * 128 + 8 * sch;
    const unsigned sdst = 2048u * (srow >> 3) + 512u * (sch >> 2) + 64u * (srow & 7) + 16u * ((sch & 3) ^ ((srow >> 2) & 3));
    const unsigned x2 = ((unsigned)r32 >> 2) & 3u;
    const unsigned rb_e = 2048u * ((unsigned)r32 >> 3) + 64u * ((unsigned)r32 & 7u) + 16u * ((unsigned)hi ^ x2);
    const unsigned rb_o = 2048u * ((unsigned)r32 >> 3) + 64u * ((unsigned)r32 & 7u) + 16u * ((2u + (unsigned)hi) ^ x2);
    const unsigned tq = (lane & 15) >> 2, tp = lane & 3, tblk = (lane >> 4) & 1;
    const unsigned tb0 = 64u * (4u * hi + tq) + 16u * ((2u * tblk + (tp >> 1)) ^ ((unsigned)hi & 3u)) + 8u * (tp & 1);
    const unsigned tb1 = 64u * (4u * hi + tq) + 16u * ((2u * tblk + (tp >> 1)) ^ ((2u + (unsigned)hi) & 3u)) + 8u * (tp & 1);
    const unsigned* mrow = MASK + (((size_t)b * 64 + qt) * 64) * 32 + r32;
    v4u vn1;
    {
        const v4u v0 = *(const v4u*)csrc;
        vn1 = *(const v4u*)(csrc + (size_t)32 * 128);
        *(LAS v4u*)(L + sdst) = v0;
    }
    unsigned mwn = mrow[0], mwn2 = (1 <= qt) ? mrow[32] : 0u;
    for (int kt = 0; kt <= KT; ++kt) {
        v4u vn2;
        if (kt + 2 <= KT) vn2 = *(const v4u*)(csrc + (size_t)(32 * (kt + 2)) * 128);
        const unsigned mwc = mwn;
        mwn = mwn2;
        if (kt + 2 <= qt) mwn2 = mrow[(kt + 2) * 32];
        __syncthreads();
        const LAS unsigned char* Cb = L + (kt & 1) * 8192;
        if (kt <= qt) {
            f32x16 S;
#pragma unroll
            for (int r = 0; r < 16; ++r) S[r] = 0.f;
#pragma unroll
            for (int ks = 0; ks < 8; ++ks) {
                const bf16x8 a = *(const LAS bf16x8*)(Cb + ((ks & 1) ? rb_o : rb_e) + 512u * (ks >> 1));
                S = MFMA32(a, qlf[ks], S);
            }
            const unsigned mw = mwc >> (16 * hi);
            const int dq = qt - kt;
            float cb = bias31;
            if (dq < 5) {
                cb = 0.f;
                const int rel0 = 32 * dq + r32 - 4 * hi;
#pragma unroll
                for (int r = 0; r < 16; ++r) { int rel = rel0 - ((r & 3) + 8 * (r >> 2)); rel = rel < 0 ? 0 : rel; S[r] += biasT[rel]; }
            }
            float mx = fmaxf(S[0], S[1]);
#pragma unroll
            for (int r = 2; r < 16; ++r) mx = fmaxf(mx, S[r]);
            mx = xhalf_max(mx) + cb;
            float alpha = 1.f;
            if (__any(mx > mref + 8.f)) {
                float mm = NINF;
#pragma unroll
                for (int r = 0; r < 16; ++r) mm = fmaxf(mm, ((mw >> r) & 1u) ? S[r] : NINF);
                mm = xhalf_max(mm) + cb;
                const float mn = fmaxf(mref, mm);
                alpha = (mn > mref) ? __builtin_amdgcn_exp2f(mref - mn) : 1.f;
                mref = mn;
            }
            lrun *= alpha;
#pragma unroll
            for (int c = 0; c < 4; ++c)
#pragma unroll
                for (int r = 0; r < 16; ++r) O[c][r] *= alpha;
            const float off = ((mref == NINF) ? 0.f : mref) - cb;
            float ps = 0.f;
#pragma unroll
            for (int r = 0; r < 16; ++r) {
                const float e = __builtin_amdgcn_exp2f(S[r] - off);
                const int m1 = __builtin_amdgcn_sbfe((int)mw, r, 1);
                S[r] = __uint_as_float(__float_as_uint(e) & (unsigned)m1);
                ps += S[r];
            }
            lrun += ps;
            const bf16x8 p0 = pack8(S, 0), p1 = pack8(S, 1);
#pragma unroll
            for (int c = 0; c < 4; ++c) {
                s16x4 f[4];
#pragma unroll
                for (int st = 0; st < 4; ++st) {
                    f[st] = vtr(Cb + ((st & 1) ? tb1 : tb0) + 2048u * st + 512u * c);
                }
                O[c] = MFMA32(cat44(f[0], f[1]), p0, O[c]);
                O[c] = MFMA32(cat44(f[2], f[3]), p1, O[c]);
            }
        }
        if (kt < KT) *(LAS v4u*)(L + ((kt + 1) & 1) * 8192 + sdst) = vn1;
        vn1 = vn2;
    }
    const float lt = xhalf_sum(lrun);
    const float il = 1.f / lt;
    f32x16 Y[2];
#pragma unroll
    for (int r = 0; r < 16; ++r) { Y[0][r] = 0.f; Y[1][r] = 0.f; }
#pragma unroll
    for (int rt = 0; rt < 4; ++rt) {
#pragma unroll
        for (int r = 0; r < 16; ++r) O[rt][r] *= il;
        const bf16x8 x0 = pack8(O[rt], 0), x1 = pack8(O[rt], 1);
#pragma unroll
        for (int c = 0; c < 2; ++c) {
            int l3 = lane; asm volatile("" : "+v"(l3));
            const GAS bf16_t* wp = (const GAS bf16_t*)WUVp + ((((c * 4 + rt) * 2 + 0) * 32 + (l3 & 31)) * 2 + (l3 >> 5)) * 8;
            Y[c] = MFMA32(*(const GAS bf16x8*)wp, x0, Y[c]);
            Y[c] = MFMA32(*(const GAS bf16x8*)(wp + 32 * 2 * 8), x1, Y[c]);
        }
    }
    {
        int l2 = lane; asm volatile("" : "+v"(l2));
        const int t2 = 32 * qt + (l2 & 31);
        gate_store(Y, 1.f, PROJ + ((size_t)b * SEQ + t2) * LDP + C_DSG + h * 64, MIX + ((size_t)b * SEQ + t2) * DM + 384 + h * 64, l2 >> 5);
    }
    __syncthreads();
}

typedef GAS unsigned gu32;
#define RLX_AGENT __ATOMIC_RELAXED, __HIP_MEMORY_SCOPE_AGENT
constexpr size_t WS_BAR = 512 * 1024;
#define XB_TMO      128
#define XB_XCNT(j)  (256  + 64 * (j))
#define XB_XSUB(j)  (1280 + 64 * (j))
#define XB_XGEN(j)  (2304 + 64 * (j))
#define XB_TOP      3328
#define XB_TOPGEN   3392
#define XCD_BAR_WORDS 3456
#define XB_SPIN_CAP (1u << 18)

__device__ __forceinline__ unsigned xb_ld(unsigned* p)              { return __hip_atomic_load(p, __ATOMIC_RELAXED, __HIP_MEMORY_SCOPE_AGENT); }
__device__ __forceinline__ unsigned xb_add(unsigned* p, unsigned v) { return __hip_atomic_fetch_add(p, v, __ATOMIC_RELAXED, __HIP_MEMORY_SCOPE_AGENT); }
__device__ __forceinline__ unsigned xb_xcc_id() { return (unsigned)__builtin_amdgcn_s_getreg((3 << 11) | 20) & 0xFu; }
#define XB_SPIN(cond, bar) do { unsigned _sp = 0; while (cond) { __builtin_amdgcn_s_sleep(1); \
    if ((++_sp & 255u) == 0u) { if (xb_ld(&(bar)[XB_TMO])) break; if (_sp > XB_SPIN_CAP) { atomicAdd(&(bar)[XB_TMO], 1u); break; } } } } while (0)

struct XcdBarrier {
    unsigned* bar; unsigned x;
    volatile LAS unsigned* st;
};

__device__ __forceinline__ XcdBarrier xcd_barrier_post(unsigned* bar, volatile LAS unsigned* st) {
    XcdBarrier b; b.bar = bar; b.x = xb_xcc_id(); b.st = st;
    if (threadIdx.x == 0) (void)xb_add(&bar[XB_XCNT(b.x)], 1u);
    return b;
}
__device__ __forceinline__ void xcd_barrier_complete(unsigned* bar, unsigned x, unsigned& nloc, unsigned& nx) {
    const unsigned G = gridDim.x * gridDim.y * gridDim.z;
    unsigned sum, cnt, mine, sp = 0u;
    for (;;) {
        sum = 0u; cnt = 0u; mine = 0u;
#pragma unroll
        for (unsigned j = 0; j < 16; ++j) { const unsigned c = xb_ld(&bar[XB_XCNT(j)]); sum += c; cnt += (c > 0u) ? 1u : 0u; mine = (j == x) ? c : mine; }
        if (sum == G) break;
        __builtin_amdgcn_s_sleep(1);
        if ((++sp & 255u) == 0u) { if (xb_ld(&bar[XB_TMO])) break; if (sp > XB_SPIN_CAP) { atomicAdd(&bar[XB_TMO], 1u); break; } }
    }
    nloc = mine > 0u ? mine : 1u; nx = cnt > 0u ? cnt : 1u;
}

__device__ __forceinline__ void xcd_barrier(const XcdBarrier& b) {
    asm volatile("s_waitcnt vmcnt(0)" ::: "memory");
    __syncthreads();
    if (threadIdx.x == 0) {
        unsigned* bar = b.bar;
        __builtin_amdgcn_s_waitcnt(0);
        unsigned nloc = b.st[0], nx = b.st[1];
        if (nloc == 0u) { xcd_barrier_complete(bar, b.x, nloc, nx); b.st[0] = nloc; b.st[1] = nx; }
        const unsigned old = xb_add(&bar[XB_XSUB(b.x)], 1u);
        const unsigned gen = old / nloc;
        if (old + 1u == (gen + 1u) * nloc) {
            __builtin_amdgcn_fence(__ATOMIC_RELEASE, "agent");
            asm volatile("s_waitcnt vmcnt(0)" ::: "memory");
            const unsigned og = xb_add(&bar[XB_TOP], 1u);
            const unsigned tg = og / nx;
            if (og + 1u == (tg + 1u) * nx) xb_add(&bar[XB_TOPGEN], 1u);
            else XB_SPIN(xb_ld(&bar[XB_TOPGEN]) == tg, bar);
            __builtin_amdgcn_fence(__ATOMIC_ACQUIRE, "agent");
            xb_add(&bar[XB_XGEN(b.x)], 1u);
            asm volatile("s_waitcnt vmcnt(0)" ::: "memory");
        } else {
            XB_SPIN(xb_ld(&bar[XB_XGEN(b.x)]) == gen, bar);
            __builtin_amdgcn_fence(__ATOMIC_ACQUIRE, "agent");
            asm volatile("s_waitcnt vmcnt(0)" ::: "memory");
        }
    }
    __syncthreads();
}

#ifndef MK_MULTI
#define MK_MULTI 0
#endif
constexpr int NPHASE = 11;
__global__ void __launch_bounds__(NWAVES * 64, 2) mk_fwd(Args args) {
    extern __shared__ __attribute__((aligned(16))) unsigned char lds_raw[];
    LAS unsigned char* lds = (LAS unsigned char*)lds_raw;
    const int tid0 = threadIdx.x;
    int wave_ = __builtin_amdgcn_readfirstlane(tid0 >> 6); asm volatile("" : "+s"(wave_));
    const int wave = wave_;
    const int G = gridDim.x, bid = blockIdx.x;
    for (int u = tid0; u < 16; u += NWAVES * 64) ((LAS unsigned*)(lds + 131072))[u] = 0u;
    __syncthreads();
    const XcdBarrier xbar = xcd_barrier_post((unsigned*)(args.ws + WS_BAR), (volatile LAS unsigned*)(lds + 131072));
    const int lo = args.ph_lo, hi = args.ph_hi;
#define IN(k) (lo <= (k) && (k) < hi)
#define SEAM(k) do { if (IN(k) && IN((k) + 1)) { if ((k) == 0) cg::this_grid().sync(); else xcd_barrier(xbar); } } while (0)
#define PH_BEGIN int lane = lane_id_v(); unsigned char* ws_ = args.ws; asm volatile("" : "+s"(ws_)); GAS unsigned char* ws = (GAS unsigned char*)ws_;     \
    const int gw = bid * NWAVES + wave, NGW = G * NWAVES; (void)gw; (void)NGW;
#define VCU_LOOP for (int vcu = vcu0; vcu < 256; vcu += G)
#define VCU_IDS const int bb = vcu >> 3, w64 = (vcu & 7) * 8 + wave; (void)bb; (void)w64;
#define P_WIN ((bf16_t*)(ws + WS_WIN))
#define P_WOUT ((bf16_t*)(ws + WS_WOUT))
#define P_WMEM ((bf16_t*)(ws + WS_WMEM))
#define P_MEMB ((bf16_t*)(ws + WS_MEMB))
#define P_MEMKV ((bf16_t*)(ws + WS_MEMKV))
#define P_CKVN ((bf16_t*)(ws + WS_CKVN))
#define P_MASK ((unsigned*)(ws + WS_MASK))
#define P_H ((bf16_t*)(ws + WS_H))
#define P_MIX ((bf16_t*)(ws + WS_MIX))
#define P_PROJ ((bf16_t*)(ws + WS_PROJ))
#define P_Y ((bf16_t*)(ws + WS_Y))
    const int vcu0 = (G % 8 == 0) ? (bid & 7) * (G >> 3) + (bid >> 3) : bid;

    if (IN(0)) {
        PH_BEGIN
        const float* x = args.in[0]; const float* mem = args.in[1]; const float* pre_g = args.in[2];
        const float* w_in = args.in[4]; const float* w_mem = args.in[8]; const float* w_out = args.in[9];
        LAS float* scr = (LAS float*)(lds + wave * 16384);
        constexpr int I_IN = 16 * (LDP / 32), I_OUT = 16 * 32, I_MEM = 16 * 16;
        constexpr int NITEMS = 2 * I_IN + 2 * I_OUT + 2 * I_MEM;
        for (int it = gw; it < NITEMS; it += NGW) {
            int r = it;
            if (r < 2 * I_IN) { const int l = r / I_IN; r -= l * I_IN; p0_transpose_item(w_in + (size_t)l * DM * NCOL, DM, NCOL, LDP, P_WIN + (size_t)l * LDP * DM, pre_g + l * DM, scr, r, lane); continue; }
            r -= 2 * I_IN;
            if (r < 2 * I_OUT) { const int l = r / I_OUT; r -= l * I_OUT; p0_transpose_item(w_out + (size_t)l * DM * DM, DM, DM, DM, P_WOUT + (size_t)l * DM * DM, nullptr, scr, r, lane); continue; }
            r -= 2 * I_OUT;
            { const int l = r / I_MEM; r -= l * I_MEM; p0_transpose_item(w_mem + (size_t)l * DM * 512, DM, 512, 512, P_WMEM + (size_t)l * 512 * DM, nullptr, scr, r, lane); }
        }
        {
            const float* w_uk = args.in[5]; const float* w_uv = args.in[6];
            bf16_t* WUKp = (bf16_t*)(ws + WS_WUK); bf16_t* WUVp = (bf16_t*)(ws + WS_WUV);
            for (int e = gw * 64 + lane; e < 2 * 6 * 8192; e += NGW * 64) {
                const int lh = e >> 13, l = lh / 6, h = lh % 6, w = e & 8191;
                { const int rt = w >> 11, rho = (w >> 6) & 31, d = w & 63; const int r = 32 * rt + ((rho & 0x13) | ((rho & 4) << 1) | ((rho & 8) >> 1));
                  WUKp[e] = (bf16_t)f2bf(w_uk[(((size_t)l * 128 + r) * 6 + h) * 64 + d]); }
                { const int j = w & 7, hh = (w >> 3) & 1, d32 = (w >> 4) & 31, s = (w >> 9) & 1, rt = (w >> 10) & 3, c = (w >> 12) & 1;
                  const int r = 32 * rt + 16 * s + 8 * (j >> 2) + 4 * hh + (j & 3), d = 32 * c + d32;
                  WUVp[e] = (bf16_t)f2bf(w_uv[(((size_t)l * 128 + r) * 6 + h) * 64 + d]); }
            }
        }
        for (int m = gw; m < NB * NMEM; m += NGW) row_to_bf16<false>(mem + (size_t)m * DM, P_MEMB + (size_t)m * DM, lane);
        for (int m = gw * 2; m < NTOK; m += NGW * 2) { row_to_bf16<true>(x + (size_t)m * DM, P_H + (size_t)m * DM, lane); row_to_bf16<true>(x + (size_t)(m + 1) * DM, P_H + (size_t)(m + 1) * DM, lane); }
    }
    SEAM(0);
#pragma unroll 1
    for (int l = 0; l < 2; ++l) {
        const int pb = 1 + 5 * l;
        if (IN(pb)) {
            PH_BEGIN
            { pg8::Gemm g{P_H, P_WIN + (size_t)l * LDP * DM, NTOK, LDP, DM}; pg8::StaticOrder S; S.init(NTOK, LDP, G, bid);
              pg8::EpiBf16<0> E{P_PROJ, LDP, nullptr, 0, 0, 1.f};
              pg8::gemm_phase<pg8::EpiBf16<0>, pg8::StaticOrder, true, true>(lds, g, S, E, wave); }
            if (l == 0) {
              pg8::Gemm g{P_MEMB, P_WMEM, NB * NMEM, 1024, DM}; pg8::StaticOrder S; S.init(NB * NMEM, 1024, G, bid);
              pg8::EpiBf16<0> E{P_MEMKV, 1024, nullptr, 0, 0, 1.f};
              pg8::gemm_phase<pg8::EpiBf16<0>, pg8::StaticOrder, true, true>(lds, g, S, E, wave); }
        }
        SEAM(pb);
        if (IN(pb + 1)) {
            { PH_BEGIN
              const float* kv_g = args.in[7];
              for (int m = gw * 8; m < NTOK; m += NGW * 8) { ckvnorm4(P_PROJ, kv_g + l * 128, P_CKVN, m, lane); ckvnorm4(P_PROJ, kv_g + l * 128, P_CKVN, m + 4, lane); } }
            VCU_LOOP { PH_BEGIN VCU_IDS
              for (int i = 0; i < 6; ++i) { const int qt = (i & 1) ? 63 - w64 : w64; sb_item(P_PROJ, P_MIX, bb, i, qt, lane, lds + wave * 16384); } }
            __syncthreads();
            VCU_LOOP { PH_BEGIN VCU_IDS
              const int s8 = vcu & 7;
              for (int j = 0; j < 8; ++j) { const int qt = 8 * j + ((j & 1) ? 7 - s8 : s8); sel_item2(P_PROJ, P_MASK, bb, qt, lane, wave, lds); } }
            __syncthreads();
            VCU_LOOP { PH_BEGIN VCU_IDS
              for (int i = 0; i < 4; ++i) mem_item(P_PROJ, P_MEMKV + l * 512, P_MIX, bb, i, w64, lane, lds + wave * 16384); }
        }
        SEAM(pb + 1);
        if (IN(pb + 2)) {
            __syncthreads();
            VCU_LOOP { PH_BEGIN VCU_IDS
              const float* rel_bias = args.in[10];
              const int s8 = vcu & 7, hs = (s8 < 4) ? 0 : 3;
              for (int oi = 0; oi < 2; ++oi) {
                  const int o = oi ? 7 - (s8 & 3) : (s8 & 3);
                  for (int hh = 0; hh < 3; ++hh) {
                      const int h = hs + hh;
                      dsa_round(P_PROJ, P_CKVN, P_MASK, (const bf16_t*)(ws + WS_WUK) + (size_t)(l * 6 + h) * 8192, (const bf16_t*)(ws + WS_WUV) + (size_t)(l * 6 + h) * 8192,
                                rel_bias, P_MIX, bb, o, h, lane, wave, lds);
                  }
              } }
        }
        SEAM(pb + 2);
        if (IN(pb + 3)) {
            PH_BEGIN
            __syncthreads();
            pg8::Gemm g{P_MIX, P_WOUT + (size_t)l * DM * DM, NTOK, DM, DM}; pg8::StaticOrder S; S.init(NTOK, DM, G, bid);
            pg8::EpiBf16<0> E{P_Y, DM, nullptr, 0, 0, 1.f};
            pg8::gemm_phase<pg8::EpiBf16<0>, pg8::StaticOrder, true, true>(lds, g, S, E, wave);
        }
        SEAM(pb + 3);
        if (IN(pb + 4)) {
            PH_BEGIN
            const float* xin = (l == 0) ? args.in[0] : args.out; const float* post_g = args.in[3];
            for (int m = gw * 2; m < NTOK; m += NGW * 2) { post_row(xin, P_Y, post_g + l * DM, args.out, (l == 0) ? P_H : (bf16_t*)nullptr, m, lane); post_row(xin, P_Y, post_g + l * DM, args.out, (l == 0) ? P_H : (bf16_t*)nullptr, m + 1, lane); }
        }
        SEAM(pb + 4);
    }
#undef IN
#undef SEAM
}

extern "C" void kernel_launch(void* const* d_in, const int* in_sizes, int n_in, void* d_out, int out_size, void* d_ws, size_t ws_size, hipStream_t stream) {
    static int grid = 0;
    if (grid == 0) {
        if (n_in != 11 || ws_size < WS_END) { fprintf(stderr, "kernel_launch: unexpected n_in %d / ws_size %zu\n", n_in, ws_size); grid = -1; return; }
        int dev = 0, cus = 0, per_cu = 0;
        hipGetDevice(&dev);
        hipDeviceGetAttribute(&cus, hipDeviceAttributeMultiprocessorCount, dev);
        hipFuncSetAttribute((const void*)mk_fwd, hipFuncAttributeMaxDynamicSharedMemorySize, LDS_BYTES);
        hipOccupancyMaxActiveBlocksPerMultiprocessor(&per_cu, (const void*)mk_fwd, NWAVES * 64, LDS_BYTES);
        if (per_cu < 1) { fprintf(stderr, "kernel_launch: occupancy query says %d blocks per CU\n", per_cu); per_cu = 1; }
        grid = cus * 1;
        (void)hipGetLastError();
    }
    if (grid < 0) return;
    (void)hipMemsetAsync((char*)d_ws + WS_BAR, 0, 16384, stream);
    Args a{};
    for (int i = 0; i < 11; ++i) a.in[i] = (const float*)d_in[i];
    a.out = (float*)d_out; a.ws = (unsigned char*)d_ws;
#if MK_MULTI
    for (int p = 0; p < NPHASE; ++p) { a.ph_lo = p; a.ph_hi = p + 1; hipLaunchKernelGGL(mk_fwd, dim3(grid), dim3(NWAVES * 64), LDS_BYTES, stream, a); }
#else
    a.ph_lo = 0; a.ph_hi = NPHASE;
    void* kargs[] = {&a};
    hipError_t e = hipLaunchCooperativeKernel((const void*)mk_fwd, dim3(grid), dim3(NWAVES * 64), kargs, LDS_BYTES, stream);
    if (e != hipSuccess) fprintf(stderr, "cooperative launch failed: %s (grid %d)\n", hipGetErrorString(e), grid);
#endif
}
```

```cpp
#include <hip/hip_runtime.h>
#include <hip/hip_cooperative_groups.h>
#include <stdint.h>
#include <math.h>
#include <cstdio>
namespace cg = cooperative_groups;
__device__ __forceinline__ int lane_id_v() { int l; asm volatile("v_mbcnt_lo_u32_b32 %0, -1, 0\n\tv_mbcnt_hi_u32_b32 %0, -1, %0" : "=v"(l)); return l; }
namespace pg8 {
#define PG8_LAS __attribute__((address_space(3)))
typedef unsigned short bf16_t;
typedef short bf16x8 __attribute__((ext_vector_type(8)));
typedef float f32x4 __attribute__((ext_vector_type(4)));
typedef unsigned u32x4 __attribute__((ext_vector_type(4)));
constexpr int BM = 256, BK = 64, HALF = 128, HTB = HALF * BK * 2  , STAGE_BYTES = 8 * HTB, NXCD = 8, WGM = 8;

__host__ __device__ __forceinline__ int lds_byte(int r, int c) { const int st = (r >> 4) * 2 + (c >> 5), rr = r & 15, cc = c & 31, ob = rr * 64 + cc * 2; return st * 1024 + (ob ^ (((ob >> 9) & 1) << 5)); }
__host__ __device__ __forceinline__ void stage_rc(int b, int& R, int& C) { const int st = b / 1024, sb = b % 1024, swz = sb ^ (((sb >> 9) & 1) << 5); R = (st >> 1) * 16 + swz / 64; C = (st & 1) * 32 + (swz % 64) / 2; }
__host__ __device__ __forceinline__ int perm32(int rho) { const int n = rho >> 4, i = rho & 15; return 8 * (i >> 2) + 4 * n + (i & 3); }

struct Unit { int pm, pn; };
struct Gemm { const bf16_t* A; const bf16_t* Bt; int M, N, K; };

struct StaticOrder {
    int nM, nN, nwg, G, c;
    __host__ __device__ void init(int M, int N, int G_, int c_) { nM = M / BM; nN = N / BM; nwg = nM * nN; G = G_; c = c_; }
    __host__ __device__ bool next(int i, Unit& u) const {
        const long L = (long)i * G + c; if (L >= nwg) return false;
        int wgid = (int)L; { const int q = nwg / NXCD, r = nwg % NXCD, xcd = wgid % NXCD, off = wgid / NXCD; wgid = (xcd < r ? xcd * (q + 1) : r * (q + 1) + (xcd - r) * q) + off; }
        const int nig = WGM * nN, gid = wgid / nig, fm = gid * WGM, gsz = (nM - fm) < WGM ? (nM - fm) : WGM;
        u.pm = fm + ((wgid % nig) % gsz); u.pn = (wgid % nig) / gsz; return true;
    }
    __device__ __forceinline__ void a_ready(const Unit&) const {}
    __device__ __forceinline__ void done(const Unit&) const {}
};

__device__ __forceinline__ unsigned cvt_pk_bf16(float lo, float hi) { unsigned r; asm volatile("v_cvt_pk_bf16_f32 %0, %1, %2" : "=v"(r) : "v"(lo), "v"(hi)); return r; }
typedef float f32x2 __attribute__((ext_vector_type(2)));
__device__ __forceinline__ f32x2 gelu_pk(f32x2 v) {
    const f32x2 av = __builtin_elementwise_abs(v), d = av * 0.2316418882f + 1.0f;
    f32x2 t; t.x = __builtin_amdgcn_rcpf(d.x); t.y = __builtin_amdgcn_rcpf(d.y);
    f32x2 q = t * 0.5307027145f + (-0.7265760135f); q = q * t + 0.7107068705f; q = q * t + (-0.142248368f); q = q * t + 0.127414796f; q = q * t;
    const f32x2 s = (v * v) * (-0.72134752044f);
    f32x2 e; e.x = __builtin_amdgcn_exp2f(s.x); e.y = __builtin_amdgcn_exp2f(s.y);
    const f32x2 m = v * (q * e), r = v - m;
    f32x2 o; o.x = v.x < 0.f ? m.x : r.x; o.y = v.y < 0.f ? m.y : r.y; return o;
}

template <int ACT  > struct EpiBf16 {
    static constexpr bool PERM = true, AFTER_DRAIN = false; static_assert(ACT == 0 || ACT == 1, "EpiBf16: ACT is 0 (none) or 1 (gelu_pk)");
    bf16_t* O; int ldc; const float* bias; int split_cols; size_t split_stride; float scale0;
    __device__ __forceinline__ void operator()(const f32x4 (&acc)[2][2][4][2], const Unit& u, int wr, int wc, int fr, int fq) const {
        const int row0 = u.pm * BM + wr * 64 + fr; int colt = u.pn * BM; bf16_t* base = O;
        float sc = 1.f; if (split_cols) { const int t = colt / split_cols; base += (size_t)t * split_stride; colt -= t * split_cols; if (t == 0) sc = scale0; }
        const int col0 = colt + wc * 32 + 8 * fq, bcol0 = u.pn * BM + wc * 32 + 8 * fq;
        f32x4 bv[2][2];
#pragma unroll
        for (int bj = 0; bj < 2; ++bj)
#pragma unroll
            for (int n = 0; n < 2; ++n) bv[bj][n] = bias ? *(const f32x4*)(bias + bcol0 + bj * HALF + 4 * n) : (f32x4){0.f, 0.f, 0.f, 0.f};
#pragma unroll
        for (int ai = 0; ai < 2; ++ai)
#pragma unroll
            for (int m = 0; m < 4; ++m) { bf16_t* rowp = base + (size_t)(row0 + ai * HALF + m * 16) * ldc + col0;
#pragma unroll
                for (int bj = 0; bj < 2; ++bj) { f32x4 v0 = acc[ai][bj][m][0] + bv[bj][0], v1 = acc[ai][bj][m][1] + bv[bj][1];
                    if (ACT == 1) { f32x2 a = gelu_pk((f32x2){v0[0], v0[1]}), b = gelu_pk((f32x2){v0[2], v0[3]}), c = gelu_pk((f32x2){v1[0], v1[1]}), d = gelu_pk((f32x2){v1[2], v1[3]});
                        v0 = (f32x4){a.x, a.y, b.x, b.y}; v1 = (f32x4){c.x, c.y, d.x, d.y}; }
                    v0 = v0 * sc; v1 = v1 * sc; u32x4 w; w.x = cvt_pk_bf16(v0[0], v0[1]); w.y = cvt_pk_bf16(v0[2], v0[3]); w.z = cvt_pk_bf16(v1[0], v1[1]); w.w = cvt_pk_bf16(v1[2], v1[3]);
                    *(u32x4*)(rowp + bj * HALF) = w; } }
    }
};
template <class Epi, class Sched, bool ALIGN_EPI = false, bool SP2 = false>
__device__ __forceinline__ void gemm_phase(PG8_LAS unsigned char* lds, const Gemm g, const Sched& S, const Epi& E, int wave_id) {
    int tid_ = wave_id * 64 + lane_id_v();
    const int tid = tid_, wid = __builtin_amdgcn_readfirstlane(tid >> 6), lane = tid & 63, wr = wid >> 2, wc = wid & 3, fr = lane & 15, fq = lane >> 4;
    const int K = g.K, nt = K / BK;
    unsigned voffA[2], voffB[2];
#pragma unroll
    for (int i = 0; i < 2; ++i) { int R, C; stage_rc(tid * 16 + i * 8192, R, C); const int Rb = Epi::PERM ? ((R & ~31) + perm32(R & 31)) : R;
        voffA[i] = (unsigned)(R * K + C) * 2u; voffB[i] = (unsigned)(Rb * K + C) * 2u; }
    const size_t kstep = (size_t)(BK * 2);
    const size_t hstep = (size_t)HALF * K * 2;
    const size_t tstep = 2 * hstep;
    const unsigned ldsw = (unsigned)wid * 1024u;
    const int aoff = lds_byte(wr * 64 + fr, fq * 8), boff = lds_byte(wc * 32 + fr, fq * 8);
#define PG8_SA(b, h) (((b) * 2 + (h)) * HTB)
#define PG8_SB(b, h) ((4 + (b) * 2 + (h)) * HTB)
#define PG8_STAGE(bufoff, gbase, voff) do { _Pragma("unroll") for (int _i = 0; _i < 2; ++_i) \
        __builtin_amdgcn_global_load_lds((const unsigned*)((const char*)(gbase) + (voff)[_i]), (PG8_LAS unsigned*)(lds + (bufoff) + ldsw + _i * 8192), 16, 0, 0); } while (0)
#define PG8_LDA(dst, b, h) do { _Pragma("unroll") for (int m = 0; m < 4; ++m) _Pragma("unroll") for (int k = 0; k < 2; ++k) dst[m][k] = *(const PG8_LAS bf16x8*)(lds + PG8_SA(b, h) + aoff + m * 2048 + k * 1024); } while (0)
#define PG8_LDB(dst, b, h) do { _Pragma("unroll") for (int n = 0; n < 2; ++n) _Pragma("unroll") for (int k = 0; k < 2; ++k) dst[n][k] = *(const PG8_LAS bf16x8*)(lds + PG8_SB(b, h) + boff + n * 2048 + k * 1024); } while (0)
#define PG8_MMA(ai, bj, At, Bt) do { __builtin_amdgcn_s_setprio(1); _Pragma("unroll") for (int m = 0; m < 4; ++m) _Pragma("unroll") for (int n = 0; n < 2; ++n) _Pragma("unroll") for (int k = 0; k < 2; ++k) \
        acc[ai][bj][m][n] = __builtin_amdgcn_mfma_f32_16x16x32_bf16(Bt[n][k], At[m][k], acc[ai][bj][m][n], 0, 0, 0); __builtin_amdgcn_s_setprio(0); } while (0)
#define PG8_WAIT_V(n) asm volatile("s_waitcnt vmcnt(" #n ")" ::: "memory")
#define PG8_WAIT_L(n) asm volatile("s_waitcnt lgkmcnt(" #n ")" ::: "memory")
#define PG8_BAR __builtin_amdgcn_s_barrier()
#define PG8_SCHED __builtin_amdgcn_sched_barrier(0)
    Unit cur, nxt; int ui = 0;
    if (!S.next(0, cur)) return;
    f32x4 acc[2][2][4][2];
#pragma unroll
    for (int a = 0; a < 2; ++a)
#pragma unroll
        for (int b = 0; b < 2; ++b)
#pragma unroll
            for (int m = 0; m < 4; ++m)
#pragma unroll
                for (int n = 0; n < 2; ++n) acc[a][b][m][n] = (f32x4){0.f, 0.f, 0.f, 0.f};
    bf16x8 At[4][2], B0[2][2], B1[2][2];
    const char* cA = (const char*)g.A + (size_t)cur.pm * tstep; const char* cB = (const char*)g.Bt + (size_t)cur.pn * tstep;
    S.a_ready(cur);
    if constexpr (SP2) {
        PG8_STAGE(PG8_SB(0, 0), cB, voffB); PG8_STAGE(PG8_SB(0, 1), cB + hstep, voffB); PG8_STAGE(PG8_SA(0, 0), cA, voffA); PG8_STAGE(PG8_SA(0, 1), cA + hstep, voffA);
        if (wr == 1) PG8_BAR;
        PG8_WAIT_V(2); PG8_BAR;
        PG8_STAGE(PG8_SB(1, 0), cB + kstep, voffB); PG8_STAGE(PG8_SA(1, 0), cA + kstep, voffA); PG8_STAGE(PG8_SB(1, 1), cB + hstep + kstep, voffB);
        PG8_WAIT_V(6); PG8_BAR;
    } else {
        PG8_STAGE(PG8_SB(0, 0), cB, voffB); PG8_STAGE(PG8_SA(0, 0), cA, voffA); PG8_STAGE(PG8_SB(0, 1), cB + hstep, voffB); PG8_STAGE(PG8_SA(0, 1), cA + hstep, voffA);
        if (wr == 1) PG8_BAR;
        PG8_WAIT_V(4); PG8_BAR;
        PG8_STAGE(PG8_SB(1, 0), cB + kstep, voffB); PG8_STAGE(PG8_SA(1, 0), cA + kstep, voffA); PG8_STAGE(PG8_SB(1, 1), cB + hstep + kstep, voffB);
        PG8_WAIT_V(6); PG8_BAR;
    }
    for (;;) {
        const bool has_next = S.next(ui + 1, nxt);
        const char* nA = has_next ? (const char*)g.A + (size_t)nxt.pm * tstep : cA; const char* nB = has_next ? (const char*)g.Bt + (size_t)nxt.pn * tstep : cB;
        for (int t = 0; t < nt; t += 2) {
            const bool last = (t == nt - 2);
            const char* a1 = cA + (size_t)(t + 1) * kstep;
            const char* a2 = last ? nA : cA + (size_t)(t + 2) * kstep; const char* b2 = last ? nB : cB + (size_t)(t + 2) * kstep;
            const char* a3 = a2 + kstep; const char* b3 = b2 + kstep;
            if (last && has_next) S.a_ready(nxt);
            if constexpr (SP2) {
            PG8_LDB(B0, 0, 0); PG8_LDB(B1, 0, 1); PG8_SCHED; PG8_LDA(At, 0, 0); PG8_STAGE(PG8_SA(1, 1), a1 + hstep, voffA);
            PG8_WAIT_V(8); PG8_WAIT_L(0); PG8_BAR; PG8_MMA(0, 0, At, B0); PG8_MMA(0, 1, At, B1); PG8_BAR; PG8_SCHED;
            PG8_LDA(At, 0, 1); PG8_STAGE(PG8_SB(0, 0), b2, voffB); PG8_STAGE(PG8_SB(0, 1), b2 + hstep, voffB); PG8_STAGE(PG8_SA(0, 0), a2, voffA);
            PG8_WAIT_V(8); PG8_WAIT_L(0); PG8_BAR; PG8_MMA(1, 0, At, B0); PG8_MMA(1, 1, At, B1); PG8_BAR; PG8_SCHED;
            PG8_LDB(B0, 1, 0); PG8_LDB(B1, 1, 1); PG8_SCHED; PG8_LDA(At, 1, 0); PG8_STAGE(PG8_SA(0, 1), a2 + hstep, voffA);
            PG8_WAIT_V(8); PG8_WAIT_L(0); PG8_BAR; PG8_MMA(0, 0, At, B0); PG8_MMA(0, 1, At, B1); PG8_BAR; PG8_SCHED;
            PG8_LDA(At, 1, 1); PG8_STAGE(PG8_SB(1, 0), b3, voffB); PG8_STAGE(PG8_SB(1, 1), b3 + hstep, voffB); PG8_STAGE(PG8_SA(1, 0), a3, voffA);
            PG8_WAIT_V(8); PG8_WAIT_L(0); PG8_BAR; PG8_MMA(1, 0, At, B0); PG8_MMA(1, 1, At, B1); PG8_BAR; PG8_SCHED;
            } else {
            PG8_LDB(B0, 0, 0); PG8_SCHED; PG8_LDA(At, 0, 0); PG8_STAGE(PG8_SA(1, 1), a1 + hstep, voffA);
            PG8_WAIT_L(8); PG8_BAR; PG8_WAIT_L(0); PG8_MMA(0, 0, At, B0); PG8_BAR; PG8_SCHED;
            PG8_LDB(B1, 0, 1); PG8_STAGE(PG8_SB(0, 0), b2, voffB);
            PG8_BAR; PG8_WAIT_L(0); PG8_MMA(0, 1, At, B1); PG8_BAR;
            PG8_LDA(At, 0, 1); PG8_STAGE(PG8_SA(0, 0), a2, voffA);
            PG8_BAR; PG8_WAIT_L(0); PG8_MMA(1, 0, At, B0); PG8_BAR; PG8_SCHED;
            PG8_STAGE(PG8_SB(0, 1), b2 + hstep, voffB);
            PG8_WAIT_V(6); PG8_BAR; PG8_MMA(1, 1, At, B1); PG8_BAR;
            PG8_LDB(B0, 1, 0); PG8_SCHED; PG8_LDA(At, 1, 0); PG8_STAGE(PG8_SA(0, 1), a2 + hstep, voffA);
            PG8_WAIT_L(8); PG8_BAR; PG8_WAIT_L(0); PG8_MMA(0, 0, At, B0); PG8_BAR; PG8_SCHED;
            PG8_LDB(B1, 1, 1); PG8_STAGE(PG8_SB(1, 0), b3, voffB);
            PG8_BAR; PG8_WAIT_L(0); PG8_MMA(0, 1, At, B1); PG8_BAR;
            PG8_LDA(At, 1, 1); PG8_STAGE(PG8_SA(1, 0), a3, voffA);
            PG8_BAR; PG8_WAIT_L(0); PG8_MMA(1, 0, At, B0); PG8_BAR; PG8_SCHED;
            PG8_STAGE(PG8_SB(1, 1), b3 + hstep, voffB);
            PG8_WAIT_V(6); PG8_BAR; PG8_MMA(1, 1, At, B1); PG8_BAR;
            }
        }
        if constexpr (ALIGN_EPI) { if (wr == 0) PG8_BAR; }
        if constexpr (!Epi::AFTER_DRAIN) { E(acc, cur, wr, wc, fr, fq); S.done(cur); }
        if (!has_next) break;
#pragma unroll
        for (int a = 0; a < 2; ++a)
#pragma unroll
            for (int b = 0; b < 2; ++b)
#pragma unroll
                for (int m = 0; m < 4; ++m)
#pragma unroll
                    for (int n = 0; n < 2; ++n) acc[a][b][m][n] = (f32x4){0.f, 0.f, 0.f, 0.f};
        cur = nxt; cA = nA; cB = nB; ++ui;
        if constexpr (ALIGN_EPI) { if (wr == 1) PG8_BAR; }
    }
    PG8_WAIT_V(0);
    if constexpr (!ALIGN_EPI) { if (wr == 0) PG8_BAR; }
    PG8_BAR;
    if constexpr (Epi::AFTER_DRAIN) { E.fused(acc, cur, wr, wc, fr, fq, lds, wid, lane); S.done(cur); }
#undef PG8_SA
#undef PG8_SB
#undef PG8_STAGE
#undef PG8_LDA
#undef PG8_LDB
#undef PG8_MMA
#undef PG8_WAIT_V
#undef PG8_WAIT_L
#undef PG8_BAR
#undef PG8_SCHED
}
}
typedef unsigned short bf16_t;
#define LAS __attribute__((address_space(3)))
#define GAS __attribute__((address_space(1)))
typedef unsigned v4u __attribute__((ext_vector_type(4)));
typedef unsigned v2u __attribute__((ext_vector_type(2)));
typedef float f32x4 __attribute__((ext_vector_type(4)));
constexpr int DM = 1024, NB = 32, SEQ = 2048, NTOK = NB * SEQ, NMEM = 256;
constexpr int LDP = 3328;
constexpr int C_SBQ = 0, C_SBK = 384, C_SBV = 768, C_SBG = 1152, C_DSQ = 1536, C_CKV = 1920, C_DSG = 2048,
              C_IDQ = 2432, C_IDK = 2688, C_IDW = 2720, C_MQ = 2728, C_MG = 2984, NCOL = 3240;
constexpr float EPS = 1e-6f;
constexpr size_t MiB = 1u << 20;
constexpr size_t WS_CTL = 0;
constexpr size_t WS_WIN = 1 * MiB;
constexpr size_t WS_WOUT = 14 * MiB;
constexpr size_t WS_WMEM = 18 * MiB;
constexpr size_t WS_MEMB = 20 * MiB;
constexpr size_t WS_MEMKV = 36 * MiB;
constexpr size_t WS_CKVN = 52 * MiB;
constexpr size_t WS_MASK = 68 * MiB;
constexpr size_t WS_H = 84 * MiB;
constexpr size_t WS_MIX = WS_H;
constexpr size_t WS_PROJ = 212 * MiB;
constexpr size_t WS_Y = WS_PROJ;
constexpr size_t WS_END = 628 * MiB;
constexpr int LDS_BYTES = 135168;
constexpr int NWAVES = 8;

__device__ __forceinline__ float bf2f(bf16_t v) { return __uint_as_float(((unsigned)v) << 16); }
__device__ __forceinline__ unsigned f2bf(float f) { unsigned u = __float_as_uint(f); u += 0x7fffu + ((u >> 16) & 1u); return u >> 16; }
__device__ __forceinline__ unsigned pk2(float lo, float hi) { return f2bf(lo) | (f2bf(hi) << 16); }
#define WAVE_SYNC() do { asm volatile("s_waitcnt lgkmcnt(0)" ::: "memory"); __builtin_amdgcn_wave_barrier(); } while (0)
__device__ __forceinline__ float wave_sum(float v) {
#pragma unroll
    for (int o = 1; o < 64; o <<= 1) v += __shfl_xor(v, o);
    return v;
}

__device__ const unsigned char T5TAB[128] = {0, 1, 2, 3, 4, 5, 6, 7, 8, 9, 10, 11, 12, 13, 14, 15, 16, 16, 16, 17, 17, 18, 18, 18, 19, 19, 19, 20, 20, 20, 20, 21, 21, 21, 21, 22, 22, 22, 22, 22, 23, 23, 23, 23, 23, 23, 24, 24, 24, 24, 24, 24, 25, 25, 25, 25, 25, 25, 25, 26, 26, 26, 26, 26, 26, 26, 26, 27, 27, 27, 27, 27, 27, 27, 27, 27, 27, 28, 28, 28, 28, 28, 28, 28, 28, 28, 28, 29, 29, 29, 29, 29, 29, 29, 29, 29, 29, 29, 29, 30, 30, 30, 30, 30, 30, 30, 30, 30, 30, 30, 30, 30, 30, 31, 31, 31, 31, 31, 31, 31, 31, 31, 31, 31, 31, 31, 31, 31};

struct Args { const float* in[11]; float* out; unsigned char* ws; int ph_lo, ph_hi; };

__device__ __forceinline__ void p0_transpose_item(const float* W, int K, int N, int Npad, bf16_t* WT, const float* g, LAS float* scr, int item, int lane) {
    const int nblk = Npad / 32, kb = item / nblk, nb = item % nblk, k0 = 64 * kb, n0 = 32 * nb;
    const int nn = n0 + (lane & 31);
#pragma unroll 8
    for (int i = 0; i < 32; ++i) { const int kk = 2 * i + (lane >> 5); float v = (nn < N) ? W[(size_t)(k0 + kk) * N + nn] : 0.f; if (g) v *= g[k0 + kk]; scr[kk * 33 + (lane & 31)] = v; }
    WAVE_SYNC();
    const int c = lane & 7;
#pragma unroll
    for (int j = 0; j < 4; ++j) { const int n = (lane >> 3) + 8 * j; const LAS float* s = scr + (8 * c) * 33 + n;
        v4u o; o.x = pk2(s[0 * 33], s[1 * 33]); o.y = pk2(s[2 * 33], s[3 * 33]); o.z = pk2(s[4 * 33], s[5 * 33]); o.w = pk2(s[6 * 33], s[7 * 33]);
        *(v4u*)(WT + (size_t)(n0 + n) * K + k0 + 8 * c) = o; }
    WAVE_SYNC();
}
template <bool NORM> __device__ __forceinline__ void row_to_bf16(const float* xrow, bf16_t* orow, int lane) {
    const f32x4* xr = (const f32x4*)xrow + lane;
    f32x4 v[4]; float s = 0.f;
#pragma unroll
    for (int j = 0; j < 4; ++j) { v[j] = xr[64 * j]; s += (v[j].x * v[j].x + v[j].y * v[j].y) + (v[j].z * v[j].z + v[j].w * v[j].w); }
    float r = 1.f;
    if (NORM) r = 1.0f / sqrtf(wave_sum(s) * (1.f / DM) + EPS);
    v2u* o8 = (v2u*)orow + lane;
#pragma unroll
    for (int j = 0; j < 4; ++j) { v2u w; w.x = pk2(v[j].x * r, v[j].y * r); w.y = pk2(v[j].z * r, v[j].w * r); o8[64 * j] = w; }
}

__device__ __forceinline__ void ckvnorm4(const bf16_t* PROJ, const float* kvg, bf16_t* CKVN, int row0, int lane) {
    const int row = row0 + (lane >> 4), c8 = (lane & 15) * 8;
    const v4u v = *(const v4u*)(PROJ + (size_t)row * LDP + C_CKV + c8);
    float f[8] = {__uint_as_float(v.x << 16), __uint_as_float(v.x & 0xffff0000u), __uint_as_float(v.y << 16), __uint_as_float(v.y & 0xffff0000u),
                  __uint_as_float(v.z << 16), __uint_as_float(v.z & 0xffff0000u), __uint_as_float(v.w << 16), __uint_as_float(v.w & 0xffff0000u)};
    float s = 0.f;
#pragma unroll
    for (int j = 0; j < 8; ++j) s += f[j] * f[j];
    s += __shfl_xor(s, 1); s += __shfl_xor(s, 2); s += __shfl_xor(s, 4); s += __shfl_xor(s, 8);
    const float r = 1.0f / sqrtf(s * (1.0f / 128.f) + EPS);
    const f32x4 g0 = *(const f32x4*)(kvg + c8), g1 = *(const f32x4*)(kvg + c8 + 4);
    v4u o; o.x = pk2(f[0] * r * g0.x, f[1] * r * g0.y); o.y = pk2(f[2] * r * g0.z, f[3] * r * g0.w); o.z = pk2(f[4] * r * g1.x, f[5] * r * g1.y); o.w = pk2(f[6] * r * g1.z, f[7] * r * g1.w);
    *(v4u*)(CKVN + (size_t)row * 128 + c8) = o;
}
__device__ __forceinline__ unsigned ordkey(float f) { unsigned u = __float_as_uint(f); return (u & 0x80000000u) ? ~u : (u | 0x80000000u); }
__device__ __forceinline__ void post_row(const float* xin, const bf16_t* Y, const float* g, float* xout, bf16_t* Hn, int row, int lane) {
    const bf16_t* yp = Y + (size_t)row * DM;
    float yv[16]; float s = 0.f;
#pragma unroll
    for (int j = 0; j < 4; ++j) {
        const v2u v = *(const v2u*)(yp + (lane + 64 * j) * 4);
        yv[4 * j + 0] = __uint_as_float(v.x << 16); yv[4 * j + 1] = __uint_as_float(v.x & 0xffff0000u);
        yv[4 * j + 2] = __uint_as_float(v.y << 16); yv[4 * j + 3] = __uint_as_float(v.y & 0xffff0000u);
        s += yv[4 * j] * yv[4 * j] + yv[4 * j + 1] * yv[4 * j + 1] + yv[4 * j + 2] * yv[4 * j + 2] + yv[4 * j + 3] * yv[4 * j + 3];
    }
    const float r = 1.0f / sqrtf(wave_sum(s) * (1.0f / DM) + EPS);
    f32x4 ov[4]; float s2 = 0.f;
#pragma unroll
    for (int j = 0; j < 4; ++j) {
        const int c = (lane + 64 * j) * 4;
        const f32x4 xv = *(const f32x4*)(xin + (size_t)row * DM + c);
        const f32x4 gv = *(const f32x4*)(g + c);
        ov[j].x = xv.x + yv[4 * j] * r * gv.x; ov[j].y = xv.y + yv[4 * j + 1] * r * gv.y; ov[j].z = xv.z + yv[4 * j + 2] * r * gv.z; ov[j].w = xv.w + yv[4 * j + 3] * r * gv.w;
        *(f32x4*)(xout + (size_t)row * DM + c) = ov[j];
        s2 += (ov[j].x * ov[j].x + ov[j].y * ov[j].y) + (ov[j].z * ov[j].z + ov[j].w * ov[j].w);
    }
    if (Hn) {
        const float r2 = 1.0f / sqrtf(wave_sum(s2) * (1.f / DM) + EPS);
        v2u* o8 = (v2u*)(Hn + (size_t)row * DM) + lane;
#pragma unroll
        for (int j = 0; j < 4; ++j) { v2u w; w.x = pk2(ov[j].x * r2, ov[j].y * r2); w.y = pk2(ov[j].z * r2, ov[j].w * r2); o8[64 * j] = w; }
    }
}

typedef short bf16x8 __attribute__((ext_vector_type(8)));
typedef short s16x4 __attribute__((ext_vector_type(4)));
typedef float f32x16 __attribute__((ext_vector_type(16)));
typedef float f32x2_t __attribute__((ext_vector_type(2)));
typedef __bf16 bf16x2_t __attribute__((ext_vector_type(2)));
#define MFMA32(a, b, c) __builtin_amdgcn_mfma_f32_32x32x16_bf16((a), (b), (c), 0, 0, 0)
__device__ __forceinline__ unsigned cvtpk(float lo, float hi) { f32x2_t v = {lo, hi}; bf16x2_t b = __builtin_convertvector(v, bf16x2_t); return __builtin_bit_cast(unsigned, b); }
__device__ __forceinline__ s16x4 vtr(const LAS unsigned char* p) { return __builtin_bit_cast(s16x4, __builtin_amdgcn_ds_read_tr16_b64_v4i16((LAS s16x4*)p)); }
__device__ __forceinline__ int crow(int r, int hi) { return (r & 3) + 8 * (r >> 2) + 4 * hi; }
__device__ __forceinline__ bf16x8 pack8(const f32x16& x, int s) {
    v4u p; p.x = cvtpk(x[8 * s + 0], x[8 * s + 1]); p.y = cvtpk(x[8 * s + 2], x[8 * s + 3]); p.z = cvtpk(x[8 * s + 4], x[8 * s + 5]); p.w = cvtpk(x[8 * s + 6], x[8 * s + 7]);
    return __builtin_bit_cast(bf16x8, p);
}
__device__ __forceinline__ f32x16 zero16() { float z; asm volatile("v_mov_b32 %0, 0" : "=v"(z)); return (f32x16){z, z, z, z, z, z, z, z, z, z, z, z, z, z, z, z}; }
__device__ __forceinline__ bf16x8 cat44(s16x4 lo, s16x4 hi) { return __builtin_shufflevector(lo, hi, 0, 1, 2, 3, 4, 5, 6, 7); }
__device__ __forceinline__ float xhalf_max(float v) { auto rr = __builtin_amdgcn_permlane32_swap(__float_as_uint(v), __float_as_uint(v), false, false); return fmaxf(__uint_as_float(rr[0]), __uint_as_float(rr[1])); }
__device__ __forceinline__ float xhalf_sum(float v) { auto rr = __builtin_amdgcn_permlane32_swap(__float_as_uint(v), __float_as_uint(v), false, false); return __uint_as_float(rr[0]) + __uint_as_float(rr[1]); }
__device__ __forceinline__ unsigned xhalf_other_u(unsigned v, int hi) { auto rr = __builtin_amdgcn_permlane32_swap(v, v, false, false); return hi ? rr[0] : rr[1]; }
__device__ __forceinline__ float xhalf_other(float v, int hi) { return __uint_as_float(xhalf_other_u(__float_as_uint(v), hi)); }
constexpr int VT_PITCH = 192;
constexpr float LOG2E = 1.4426950408889634f;

__device__ __forceinline__ void pv_tile(f32x16 (&O)[2], const LAS unsigned char* vrd, bf16x8 p0, bf16x8 p1) {
#pragma unroll
    for (int c = 0; c < 2; ++c) {
        const bf16x8 a0 = cat44(vtr(vrd + 0 * VT_PITCH + 64 * c), vtr(vrd + 8 * VT_PITCH + 64 * c));
        const bf16x8 a1 = cat44(vtr(vrd + 16 * VT_PITCH + 64 * c), vtr(vrd + 24 * VT_PITCH + 64 * c));
        O[c] = MFMA32(a0, p0, O[c]);
        O[c] = MFMA32(a1, p1, O[c]);
    }
}
__device__ __forceinline__ void gate_store(const f32x16 (&O)[2], float scale, const bf16_t* grow, bf16_t* orow, int hi) {
#pragma unroll
    for (int c = 0; c < 2; ++c)
#pragma unroll
        for (int g = 0; g < 4; ++g) {
            const int d = 32 * c + 8 * g + 4 * hi;
            const v2u gv = *(const v2u*)(grow + d);
            float gt[4] = {__uint_as_float(gv.x << 16), __uint_as_float(gv.x & 0xffff0000u), __uint_as_float(gv.y << 16), __uint_as_float(gv.y & 0xffff0000u)};
            float ov[4];
#pragma unroll
            for (int j = 0; j < 4; ++j) ov[j] = O[c][4 * g + j] * scale * gt[j] * __builtin_amdgcn_rcpf(1.f + __builtin_amdgcn_exp2f(-gt[j] * LOG2E));
            v2u w; w.x = cvtpk(ov[0], ov[1]); w.y = cvtpk(ov[2], ov[3]);
            *(v2u*)(orow + d) = w;
        }
}

__device__ __forceinline__ void gate_load(v2u (&gw)[8], const bf16_t* grow, int hi) {
#pragma unroll
    for (int c = 0; c < 2; ++c)
#pragma unroll
        for (int g = 0; g < 4; ++g) gw[c * 4 + g] = *(const v2u*)(grow + 32 * c + 8 * g + 4 * hi);
}
__device__ __forceinline__ void gate_store_pre(const f32x16 (&O)[2], float scale, const v2u (&gw)[8], bf16_t* orow, int hi) {
#pragma unroll
    for (int c = 0; c < 2; ++c)
#pragma unroll
        for (int g = 0; g < 4; ++g) {
            const int d = 32 * c + 8 * g + 4 * hi;
            const v2u gv = gw[c * 4 + g];
            float gt[4] = {__uint_as_float(gv.x << 16), __uint_as_float(gv.x & 0xffff0000u), __uint_as_float(gv.y << 16), __uint_as_float(gv.y & 0xffff0000u)};
            float ov[4];
#pragma unroll
            for (int j = 0; j < 4; ++j) ov[j] = O[c][4 * g + j] * scale * gt[j] * __builtin_amdgcn_rcpf(1.f + __builtin_amdgcn_exp2f(-gt[j] * LOG2E));
            v2u w; w.x = cvtpk(ov[0], ov[1]); w.y = cvtpk(ov[2], ov[3]);
            *(v2u*)(orow + d) = w;
        }
}

__device__ __forceinline__ void sb_item(const bf16_t* PROJ, bf16_t* MIX, int b, int h, int qt, int lane, LAS unsigned char* wl) {
    asm volatile("" : "+v"(lane));
    const int r32 = lane & 31, hi = lane >> 5;
    const bf16_t* base = PROJ + (size_t)b * SEQ * LDP;
    const int t = 32 * qt + r32;
    bf16x8 qf[4];
#pragma unroll
    for (int ks = 0; ks < 4; ++ks) qf[ks] = *(const bf16x8*)(base + (size_t)t * LDP + C_SBQ + h * 64 + 16 * ks + 8 * hi);
    v2u gw[8]; gate_load(gw, base + (size_t)t * LDP + C_SBG + h * 64, hi);
    const int vrow = lane >> 3, vch = lane & 7;
    LAS unsigned char* vwr = wl + vrow * VT_PITCH + vch * 16;
    const LAS unsigned char* vrd = wl + (4 * hi + ((lane & 15) >> 2)) * VT_PITCH + (16 * ((lane >> 4) & 1) + 4 * (lane & 3)) * 2;
    bf16x8 kc[4], vc[4];
    {
        const bf16_t* kp = base + (size_t)(32 * qt + r32) * LDP + C_SBK + h * 64 + 8 * hi;
#pragma unroll
        for (int ks = 0; ks < 4; ++ks) kc[ks] = *(const bf16x8*)(kp + 16 * ks);
        const bf16_t* vp = base + (size_t)(32 * qt + vrow) * LDP + C_SBV + h * 64 + 8 * vch;
#pragma unroll
        for (int i = 0; i < 4; ++i) vc[i] = *(const bf16x8*)(vp + (size_t)(8 * i) * LDP);
    }
    f32x16 O[2];
#pragma unroll
    for (int r = 0; r < 16; ++r) { O[0][r] = 0.f; O[1][r] = 0.f; }
    float R = 1.f;
    for (int kt = qt; kt >= 0; --kt) {
        bf16x8 kn[4], vn[4];
        {
            const int ktn = kt > 0 ? kt - 1 : 0;
            const bf16_t* kp = base + (size_t)(32 * ktn + r32) * LDP + C_SBK + h * 64 + 8 * hi;
#pragma unroll
            for (int ks = 0; ks < 4; ++ks) kn[ks] = *(const bf16x8*)(kp + 16 * ks);
            const bf16_t* vp = base + (size_t)(32 * ktn + vrow) * LDP + C_SBV + h * 64 + 8 * vch;
#pragma unroll
            for (int i = 0; i < 4; ++i) vn[i] = *(const bf16x8*)(vp + (size_t)(8 * i) * LDP);
        }
        f32x16 acc;
#pragma unroll
        for (int r = 0; r < 16; ++r) acc[r] = 0.f;
#pragma unroll
        for (int ks = 0; ks < 4; ++ks) acc = MFMA32(kc[ks], qf[ks], acc);
#pragma unroll
        for (int i = 0; i < 4; ++i) *(LAS bf16x8*)(vwr + (8 * i) * VT_PITCH) = vc[i];
        float be[16], om[16];
        const bool diag = (kt == qt);
#pragma unroll
        for (int r = 0; r < 16; ++r) {
            const float e = __builtin_amdgcn_exp2f(fminf(acc[r] * (-0.125f * LOG2E), 115.f));
            float bt = __builtin_amdgcn_rcpf(1.f + e), o1 = e * bt;
            if (diag && !(crow(r, hi) < r32)) { bt = 0.f; o1 = 1.f; }
            be[r] = bt; om[r] = o1;
        }
        float Gp[4], Gq[4];
#pragma unroll
        for (int g = 0; g < 4; ++g) { Gp[g] = (om[4 * g] * om[4 * g + 1]) * (om[4 * g + 2] * om[4 * g + 3]); Gq[g] = xhalf_other(Gp[g], hi); }
        const float T1 = Gp[1] * Gq[1], T2 = Gp[2] * Gq[2], T3 = Gp[3] * Gq[3], T0 = Gp[0] * Gq[0];
        float tail[4]; tail[3] = R; tail[2] = R * T3; tail[1] = tail[2] * T2; tail[0] = tail[1] * T1;
        const float Rn = tail[0] * T0;
#pragma unroll
        for (int g = 0; g < 4; ++g) {
            float sfx = tail[g] * (hi == 0 ? Gq[g] : 1.f);
            acc[4 * g + 3] = be[4 * g + 3] * sfx; sfx *= om[4 * g + 3];
            acc[4 * g + 2] = be[4 * g + 2] * sfx; sfx *= om[4 * g + 2];
            acc[4 * g + 1] = be[4 * g + 1] * sfx; sfx *= om[4 * g + 1];
            acc[4 * g + 0] = be[4 * g + 0] * sfx;
        }
        R = Rn;
        const bf16x8 p0 = pack8(acc, 0), p1 = pack8(acc, 1);
        pv_tile(O, vrd, p0, p1);
        if (__all(R < 7.8886e-31f)) break;
#pragma unroll
        for (int i = 0; i < 4; ++i) { kc[i] = kn[i]; vc[i] = vn[i]; }
    }
    gate_store_pre(O, 1.f, gw, MIX + ((size_t)b * SEQ + t) * DM + h * 64, hi);
}

__device__ __forceinline__ void mem_item(const bf16_t* PROJ, const bf16_t* KV, bf16_t* MIX, int b, int h, int qt, int lane, LAS unsigned char* wl) {
    asm volatile("" : "+v"(lane));
    float NINF; asm volatile("v_mov_b32 %0, 0xff800000" : "=v"(NINF));
    const int r32 = lane & 31, hi = lane >> 5;
    const int t = 32 * qt + r32;
    const bf16_t* prow = PROJ + ((size_t)b * SEQ + t) * LDP;
    bf16x8 qf[4];
#pragma unroll
    for (int ks = 0; ks < 4; ++ks) qf[ks] = *(const bf16x8*)(prow + C_MQ + h * 64 + 16 * ks + 8 * hi);
    const int vrow = lane >> 3, vch = lane & 7;
    LAS unsigned char* vwr = wl + vrow * VT_PITCH + vch * 16;
    const LAS unsigned char* vrd = wl + (4 * hi + ((lane & 15) >> 2)) * VT_PITCH + (16 * ((lane >> 4) & 1) + 4 * (lane & 3)) * 2;
    const bf16_t* kvb = KV + (size_t)b * NMEM * 1024 + h * 64;
    f32x16 O[2];
#pragma unroll
    for (int r = 0; r < 16; ++r) { O[0][r] = 0.f; O[1][r] = 0.f; }
    float mrun = NINF, lrun = 0.f;
    v2u gw[8]; gate_load(gw, prow + C_MG + h * 64, hi);
    bf16x8 kc[4], vc[4];
    {
        const bf16_t* kp = kvb + (size_t)r32 * 1024 + 8 * hi;
#pragma unroll
        for (int ks = 0; ks < 4; ++ks) kc[ks] = *(const bf16x8*)(kp + 16 * ks);
        const bf16_t* vp = kvb + (size_t)vrow * 1024 + 256 + 8 * vch;
#pragma unroll
        for (int i = 0; i < 4; ++i) vc[i] = *(const bf16x8*)(vp + (size_t)(8 * i) * 1024);
    }
    for (int kt = 0; kt < NMEM / 32; ++kt) {
        bf16x8 kn[4], vn[4];
        {
            const int ktn = kt < NMEM / 32 - 1 ? kt + 1 : kt;
            const bf16_t* kp = kvb + (size_t)(32 * ktn + r32) * 1024 + 8 * hi;
#pragma unroll
            for (int ks = 0; ks < 4; ++ks) kn[ks] = *(const bf16x8*)(kp + 16 * ks);
            const bf16_t* vp = kvb + (size_t)(32 * ktn + vrow) * 1024 + 256 + 8 * vch;
#pragma unroll
            for (int i = 0; i < 4; ++i) vn[i] = *(const bf16x8*)(vp + (size_t)(8 * i) * 1024);
        }
        f32x16 acc;
#pragma unroll
        for (int r = 0; r < 16; ++r) acc[r] = 0.f;
#pragma unroll
        for (int ks = 0; ks < 4; ++ks) acc = MFMA32(kc[ks], qf[ks], acc);
#pragma unroll
        for (int i = 0; i < 4; ++i) *(LAS bf16x8*)(vwr + (8 * i) * VT_PITCH) = vc[i];
        float mx = acc[0];
#pragma unroll
        for (int r = 1; r < 16; ++r) mx = fmaxf(mx, acc[r]);
        mx *= 0.125f * LOG2E;
        mx = xhalf_max(mx);
        const float mn = fmaxf(mrun, mx), alpha = __builtin_amdgcn_exp2f(mrun - mn);
        float ps = 0.f;
#pragma unroll
        for (int r = 0; r < 16; ++r) { acc[r] = __builtin_amdgcn_exp2f(acc[r] * (0.125f * LOG2E) - mn); ps += acc[r]; }
        lrun = lrun * alpha + ps; mrun = mn;
#pragma unroll
        for (int r = 0; r < 16; ++r) { O[0][r] *= alpha; O[1][r] *= alpha; }
        const bf16x8 p0 = pack8(acc, 0), p1 = pack8(acc, 1);
        pv_tile(O, vrd, p0, p1);
#pragma unroll
        for (int i = 0; i < 4; ++i) { kc[i] = kn[i]; vc[i] = vn[i]; }
    }
    const float lt = xhalf_sum(lrun);
    gate_store_pre(O, 1.f / lt, gw, MIX + ((size_t)b * SEQ + t) * DM + 768 + h * 64, hi);
}

constexpr int MEML_V_OFF = 32768;
__device__ __forceinline__ void mem_stage(const bf16_t* KV, int b, int h, int tid, LAS unsigned char* L) {
    const bf16_t* kvb = KV + (size_t)b * NMEM * 1024 + h * 64;
#pragma unroll
    for (int i = 0; i < 4; ++i) {
        const int idx = tid + 512 * i, key = idx >> 3, ch = idx & 7;
        const v4u kx = *(const v4u*)(kvb + (size_t)key * 1024 + 8 * ch), vx = *(const v4u*)(kvb + (size_t)key * 1024 + 256 + 8 * ch);
        *(LAS v4u*)(L + 128 * key + 16 * (ch ^ ((key >> 1) & 7))) = kx;
        *(LAS v4u*)(L + MEML_V_OFF + (key >> 5) * (32 * VT_PITCH) + (key & 31) * VT_PITCH + 16 * ch) = vx;
    }
}
__device__ __forceinline__ void mem_item_lds(const bf16_t* PROJ, bf16_t* MIX, int b, int h, int qt, int lane, const LAS unsigned char* L) {
    asm volatile("" : "+v"(lane));
    float NINF; asm volatile("v_mov_b32 %0, 0xff800000" : "=v"(NINF));
    const int r32 = lane & 31, hi = lane >> 5;
    const int t = 32 * qt + r32;
    const bf16_t* prow = PROJ + ((size_t)b * SEQ + t) * LDP;
    bf16x8 qf[4];
#pragma unroll
    for (int ks = 0; ks < 4; ++ks) qf[ks] = *(const bf16x8*)(prow + C_MQ + h * 64 + 16 * ks + 8 * hi);
    v2u gw[8]; gate_load(gw, prow + C_MG + h * 64, hi);
    const unsigned kx = ((unsigned)r32 >> 1) & 7u;
    const LAS unsigned char* krd = L + 128 * r32;
    const LAS unsigned char* vrd = L + MEML_V_OFF + (4 * hi + ((lane & 15) >> 2)) * VT_PITCH + (16 * ((lane >> 4) & 1) + 4 * (lane & 3)) * 2;
    f32x16 O[2];
    O[0] = zero16(); O[1] = zero16();
    float mrun = NINF, lrun = 0.f;
#pragma unroll 2
    for (int kt = 0; kt < NMEM / 32; ++kt) {
        bf16x8 kc[4];
#pragma unroll
        for (int ks = 0; ks < 4; ++ks) kc[ks] = *(const LAS bf16x8*)(krd + 4096 * kt + 16 * ((unsigned)(2 * ks + hi) ^ kx));
        f32x16 acc = MFMA32(kc[0], qf[0], zero16());
#pragma unroll
        for (int ks = 1; ks < 4; ++ks) acc = MFMA32(kc[ks], qf[ks], acc);
        float mx = acc[0];
#pragma unroll
        for (int r = 1; r < 16; ++r) mx = fmaxf(mx, acc[r]);
        mx *= 0.125f * LOG2E;
        mx = xhalf_max(mx);
        const float mn = fmaxf(mrun, mx), alpha = __builtin_amdgcn_exp2f(mrun - mn);
        float ps = 0.f;
#pragma unroll
        for (int r = 0; r < 16; ++r) { acc[r] = __builtin_amdgcn_exp2f(acc[r] * (0.125f * LOG2E) - mn); ps += acc[r]; }
        lrun = lrun * alpha + ps; mrun = mn;
#pragma unroll
        for (int r = 0; r < 16; ++r) { O[0][r] *= alpha; O[1][r] *= alpha; }
        const bf16x8 p0 = pack8(acc, 0), p1 = pack8(acc, 1);
        pv_tile(O, vrd + kt * (32 * VT_PITCH), p0, p1);
    }
    const float lt = xhalf_sum(lrun);
    gate_store_pre(O, 1.f / lt, gw, MIX + ((size_t)b * SEQ + t) * DM + 768 + h * 64, hi);
}

constexpr int SEL_IQ_PITCH = 528, SEL_CNT_OFF = 17408;
__device__ __forceinline__ unsigned ordkey(float f);
template <int PRED  >
__device__ __forceinline__ unsigned sel_count_round(const unsigned (&key)[8][16], unsigned c, unsigned tau, int idx0, int r32, int hi, int wave, LAS unsigned* cb) {
    int n = 0;
#pragma unroll
    for (int i = 0; i < 8; ++i) {
#pragma unroll
        for (int r = 0; r < 16; ++r) {
            if (PRED == 0) n += (key[i][r] >= c) ? 1 : 0;
            else if (PRED == 1) n += (key[i][r] > c) ? 1 : 0;
            else n += (key[i][r] == tau && (unsigned)(idx0 + 256 * i + (r & 3) + 8 * (r >> 2)) <= c) ? 1 : 0;
            if ((r & 7) == 7) asm volatile("" : "+v"(n));
        }
    }
    n += __shfl_xor(n, 32);
    if (hi == 0) cb[wave * 32 + r32] = (unsigned)n;
    __syncthreads();
    unsigned tot = 0;
#pragma unroll
    for (int w = 0; w < 8; ++w) tot += cb[w * 32 + r32];
    return tot;
}
constexpr int SEL_CAP = 64, SEL_DONE = 16;
__device__ __forceinline__ float key2f(unsigned k) { return __uint_as_float((k & 0x80000000u) ? (k & 0x7fffffffu) : ~k); }
__device__ __forceinline__ unsigned sel_count_lane(const unsigned (&key)[8][16], unsigned c) {
    int n = 0;
#pragma unroll
    for (int i = 0; i < 8; ++i) {
#pragma unroll
        for (int r = 0; r < 16; ++r) {
            n += (key[i][r] >= c) ? 1 : 0;
            if ((r & 7) == 7) asm volatile("" : "+v"(n));
        }
    }
    return (unsigned)n;
}
__device__ __forceinline__ unsigned sel_exchange(unsigned nl, int r32, int hi, int wave, LAS unsigned* cb) {
    const unsigned n2 = nl + xhalf_other_u(nl, hi);
    if (hi == 0) cb[wave * 32 + r32] = n2;
    __syncthreads();
    unsigned tot = 0;
#pragma unroll
    for (int w = 0; w < 8; ++w) tot += cb[w * 32 + r32];
    return tot;
}
__device__ __forceinline__ void sel_item2(const bf16_t* PROJ, unsigned* MASK, int b, int qt, int lane, int wave, LAS unsigned char* L) {
    asm volatile("" : "+v"(lane));
    const int r32 = lane & 31, hi = lane >> 5, tid = wave * 64 + lane;
    LAS unsigned* cntb = (LAS unsigned*)(L + SEL_CNT_OFF);
    const bf16_t* base = PROJ + (size_t)b * SEQ * LDP;
    unsigned* mrow = MASK + (((size_t)b * 64 + qt) * 64) * 32;
    if (qt < 8) {
#pragma unroll
        for (int i = 0; i < 8; ++i) {
            const int kt = wave + 8 * i;
            if (kt <= qt) {
                unsigned bits = 0u;
#pragma unroll
                for (int r = 0; r < 16; ++r) bits |= ((kt < qt) || (crow(r, hi) <= r32)) ? (1u << r) : 0u;
                const unsigned other = xhalf_other_u(bits, hi);
                if (hi == 0) mrow[kt * 32 + r32] = bits | (other << 16);
            }
        }
        return;
    }
    for (int n = tid; n < 1024; n += 512) { const int row = n >> 5, ch = n & 31;
        const v4u v = *(const v4u*)(base + (size_t)(32 * qt + row) * LDP + C_IDQ + ch * 8);
        *(LAS v4u*)(L + row * SEL_IQ_PITCH + ch * 16) = v; }
    float w8[8];
    { const v4u wv = *(const v4u*)(base + (size_t)(32 * qt + r32) * LDP + C_IDW);
      w8[0] = __uint_as_float(wv.x << 16) * 0.0625f; w8[1] = __uint_as_float(wv.x & 0xffff0000u) * 0.0625f; w8[2] = __uint_as_float(wv.y << 16) * 0.0625f; w8[3] = __uint_as_float(wv.y & 0xffff0000u) * 0.0625f;
      w8[4] = __uint_as_float(wv.z << 16) * 0.0625f; w8[5] = __uint_as_float(wv.z & 0xffff0000u) * 0.0625f; w8[6] = __uint_as_float(wv.w << 16) * 0.0625f; w8[7] = __uint_as_float(wv.w & 0xffff0000u) * 0.0625f; }
    __syncthreads();
    unsigned key[8][16];
    const LAS unsigned char* iqp = L + r32 * SEL_IQ_PITCH + 16 * hi;
    unsigned kmn = 0xffffffffu, kmx = 0u;
#pragma unroll
    for (int i = 0; i < 8; ++i) {
        const int kt = wave + 8 * i;
        if (kt <= qt) {
            const bf16_t* kp = base + (size_t)(32 * kt + r32) * LDP + C_IDK + 8 * hi;
            const bf16x8 k0 = *(const bf16x8*)kp, k1 = *(const bf16x8*)(kp + 16);
            float sc[16];
#pragma unroll
            for (int r = 0; r < 16; ++r) sc[r] = 0.f;
            unsigned iqo = 0; asm volatile("" : "+v"(iqo));
            const LAS unsigned char* iqt = iqp + iqo;
#pragma unroll
            for (int hp = 0; hp < 4; ++hp) {
                const int h = 2 * hp;
                bf16x8 q0 = *(const LAS bf16x8*)(iqt + h * 64), q1 = *(const LAS bf16x8*)(iqt + h * 64 + 32);
                bf16x8 q2 = *(const LAS bf16x8*)(iqt + h * 64 + 64), q3 = *(const LAS bf16x8*)(iqt + h * 64 + 96);
                asm volatile("" : "+v"(q0), "+v"(q1), "+v"(q2), "+v"(q3) : "v"(sc[15]));
                f32x16 Da = MFMA32(k0, q0, zero16());
                f32x16 Db = MFMA32(k0, q2, zero16());
                Da = MFMA32(k1, q1, Da);
                Db = MFMA32(k1, q3, Db);
#pragma unroll
                for (int r = 0; r < 16; ++r) sc[r] += w8[h] * fmaxf(Da[r], 0.f);
#pragma unroll
                for (int r = 0; r < 16; ++r) sc[r] += w8[h + 1] * fmaxf(Db[r], 0.f);
                asm volatile("" : "+v"(sc[0]), "+v"(sc[1]), "+v"(sc[2]), "+v"(sc[3]), "+v"(sc[4]), "+v"(sc[5]), "+v"(sc[6]), "+v"(sc[7]),
                                  "+v"(sc[8]), "+v"(sc[9]), "+v"(sc[10]), "+v"(sc[11]), "+v"(sc[12]), "+v"(sc[13]), "+v"(sc[14]), "+v"(sc[15]));
            }
            int thr = (kt < qt) ? 64 : (r32 - 4 * hi);
            asm volatile("" : "+v"(thr));
#pragma unroll
            for (int r = 0; r < 16; ++r) { const bool v = ((r & 3) + 8 * (r >> 2) <= thr); const unsigned k = ordkey(sc[r]); key[i][r] = v ? k : 0u; kmx = max(kmx, v ? k : 0u); kmn = min(kmn, v ? k : 0xffffffffu); }
        } else {
#pragma unroll
            for (int r = 0; r < 16; ++r) key[i][r] = 0u;
        }
    }
    unsigned lo_key, hi_key, clo, chi = 0u, nlo_l, nhi_l = 0u;
    {
        int nv = 0;
#pragma unroll
        for (int i = 0; i < 8; ++i) { const int kt = wave + 8 * i; nv += (kt < qt) ? 16 : 0; }
        if ((qt & 7) == wave) { const int thr = r32 - 4 * hi;
#pragma unroll
            for (int r = 0; r < 16; ++r) nv += ((r & 3) + 8 * (r >> 2) <= thr) ? 1 : 0; }
        nlo_l = (unsigned)nv;
        kmn = min(kmn, xhalf_other_u(kmn, hi)); kmx = max(kmx, xhalf_other_u(kmx, hi));
        if (hi == 0) { cntb[wave * 32 + r32] = kmn; cntb[256 + wave * 32 + r32] = kmx; }
        __syncthreads();
        unsigned a = 0xffffffffu, bmx = 0u;
#pragma unroll
        for (int w = 0; w < 8; ++w) { a = min(a, cntb[w * 32 + r32]); bmx = max(bmx, cntb[256 + w * 32 + r32]); }
        lo_key = a; hi_key = bmx + 1u; clo = (unsigned)(32 * qt + r32 + 1);
        __syncthreads();
    }
    int round = 0;
    for (;;) {
        const bool done = (clo - chi <= (unsigned)SEL_DONE) || (hi_key - lo_key <= 1u);
        if (__all(done)) break;
        unsigned p;
        if ((round & 3) == 3) p = lo_key + ((hi_key - lo_key) >> 1);
        else p = ordkey(0.5f * key2f(lo_key) + 0.5f * key2f(hi_key));
        p = min(max(p, lo_key + 1u), hi_key - 1u);
        if (done) p = lo_key;
        const unsigned nl = sel_count_lane(key, p);
        const unsigned tot = sel_exchange(nl, r32, hi, wave, cntb + (round & 1) * 256);
        if (!done) { if (tot >= 256u) { lo_key = p; clo = tot; nlo_l = nl; } else { hi_key = p; chi = tot; nhi_l = nl; } }
        ++round;
    }
    unsigned tau, cut;
    const bool many = (clo - chi > (unsigned)SEL_CAP);
    {
        LAS unsigned* lanecnt = (LAS unsigned*)L; LAS unsigned* meta = (LAS unsigned*)(L + 2048); LAS unsigned* result = (LAS unsigned*)(L + 2304); LAS unsigned* list = (LAS unsigned*)(L + 20480);
        const int slot = wave * 2 + hi;
        lanecnt[r32 * 16 + slot] = many ? 0u : (nlo_l - nhi_l);
        if (slot == 0) { meta[2 * r32] = many ? 0u : (clo - chi); meta[2 * r32 + 1] = 256u - chi; }
        __syncthreads();
        unsigned bs = 0u;
#pragma unroll
        for (int s2 = 0; s2 < 16; ++s2) { const unsigned v = lanecnt[r32 * 16 + s2]; bs += (s2 < slot) ? v : 0u; }
        if (!many) {
            const int idx0 = 32 * wave + 4 * hi;
            LAS unsigned* lp = list + (r32 * SEL_CAP + bs) * 2;
#pragma unroll
            for (int i = 0; i < 8; ++i)
#pragma unroll
                for (int r = 0; r < 16; ++r) {
                    const unsigned k = key[i][r];
                    if (k >= lo_key && k < hi_key) { lp[0] = k; lp[1] = (unsigned)(idx0 + 256 * i + (r & 3) + 8 * (r >> 2)); lp += 2; }
                }
        }
        __syncthreads();
        for (int j = 0; j < 4; ++j) {
            const int q = 4 * wave + j;
            const unsigned ncand = (unsigned)__builtin_amdgcn_readfirstlane((int)meta[2 * q]), need = (unsigned)__builtin_amdgcn_readfirstlane((int)meta[2 * q + 1]);
            const LAS unsigned* lq = list + q * SEL_CAP * 2;
            const bool mine = (unsigned)lane < ncand;
            const unsigned kc = mine ? lq[2 * lane] : 0u, ic = mine ? lq[2 * lane + 1] : 0u;
            unsigned rank = 0u;
            for (unsigned c2 = 0; c2 < ncand; ++c2) {
                const unsigned k2 = (unsigned)__builtin_amdgcn_readlane((int)kc, (int)c2), i2 = (unsigned)__builtin_amdgcn_readlane((int)ic, (int)c2);
                rank += (k2 > kc || (k2 == kc && i2 < ic)) ? 1u : 0u;
            }
            if (mine && rank == need - 1u) { result[2 * q] = kc; result[2 * q + 1] = ic; }
        }
        __syncthreads();
        tau = result[2 * r32]; cut = result[2 * r32 + 1];
    }
    if (__any(many)) {
        const unsigned need = 256u - chi;
        const int idx0 = 32 * wave + 4 * hi;
        unsigned lo_ = 0u, hi_ = 2047u;
        for (int it = 0; it < 11; ++it) {
            const unsigned mid = (lo_ + hi_) >> 1;
            const unsigned f = sel_count_round<2>(key, mid, lo_key, idx0, r32, hi, wave, cntb + (it & 1) * 256);
            if (f >= need) hi_ = mid; else lo_ = mid + 1;
        }
        if (many) { tau = lo_key; cut = hi_; }
    }
    {
        const int idx0 = 32 * wave + 4 * hi;
#pragma unroll
        for (int i = 0; i < 8; ++i) {
            const int kt = wave + 8 * i;
            if (kt <= qt) {
                unsigned bits = 0u;
#pragma unroll
                for (int r = 0; r < 16; ++r) {
                    const bool s = (key[i][r] > tau) || (key[i][r] == tau && (unsigned)(idx0 + 256 * i + (r & 3) + 8 * (r >> 2)) <= cut);
                    bits |= s ? (1u << r) : 0u;
                }
                const unsigned other = xhalf_other_u(bits, hi);
                if (hi == 0) mrow[kt * 32 + r32] = bits | (other << 16);
            }
        }
    }
    __syncthreads();
}

constexpr int WS_WUK = 0;
constexpr int WS_WUV = 256 * 1024;
constexpr int DSA_BIAS_OFF = 16384;
__device__ __forceinline__ unsigned dsa_off(unsigned row, unsigned ch) { return 256u * row + 16u * (ch ^ (((row & 3u) << 2) | ((row >> 2) & 3u))); }
constexpr int DSA_NBUF = 4, DSA_MASK_OFF = 32768, DSA_BIAS2_OFF = 98304;
__device__ __forceinline__ void glds16(const void* gsrc, unsigned lds_dst) { unsigned keep;
    asm volatile("s_mov_b32 %0, m0\n\ts_mov_b32 m0, %2\n\ts_nop 0\n\tglobal_load_lds_dwordx4 %1, off\n\ts_mov_b32 m0, %0" : "=&s"(keep) : "v"(gsrc), "s"(lds_dst) : "memory"); }
__device__ __forceinline__ void dsa_round(const bf16_t* PROJ, const bf16_t* CKVN, const unsigned* MASK, const bf16_t* WUKp  , const bf16_t* WUVp  ,
                                          const float* rel_bias, bf16_t* MIX, int b, int o, int h, int lane, int wave, LAS unsigned char* L) {
    asm volatile("" : "+v"(lane));
    float NINF; asm volatile("v_mov_b32 %0, 0xff800000" : "=v"(NINF));
    const int r32 = lane & 31, hi = lane >> 5, tid = wave * 64 + lane;
    const int qt = 8 * o + wave, KT = 8 * o + 7, t = 32 * qt + r32;
    LAS float* biasT = (LAS float*)(L + DSA_BIAS2_OFF);
    if (tid < 192) { const int bk = tid < 128 ? (int)T5TAB[tid] : 31; biasT[tid] = rel_bias[bk * 6 + h] * LOG2E; }
    const float bias31 = rel_bias[31 * 6 + h] * LOG2E;
    bf16x8 qlf[8];
    {
        const bf16_t* qrow = PROJ + ((size_t)b * SEQ + t) * LDP + C_DSQ + h * 64 + 8 * hi;
        bf16x8 qf[4];
#pragma unroll
        for (int ks = 0; ks < 4; ++ks) qf[ks] = *(const bf16x8*)(qrow + 16 * ks);
#pragma unroll
        for (int rt = 0; rt < 4; ++rt) {
            f32x16 X;
#pragma unroll
            for (int r = 0; r < 16; ++r) X[r] = 0.f;
            const GAS bf16_t* wp = (const GAS bf16_t*)WUKp + (rt * 32 + r32) * 64 + 8 * hi;
#pragma unroll
            for (int ks = 0; ks < 4; ++ks) X = MFMA32(*(const GAS bf16x8*)(wp + 16 * ks), qf[ks], X);
#pragma unroll
            for (int r = 0; r < 16; ++r) X[r] *= 0.125f * LOG2E;
            qlf[2 * rt] = pack8(X, 0); qlf[2 * rt + 1] = pack8(X, 1);
        }
    }
    f32x16 O[4];
#pragma unroll
    for (int c = 0; c < 4; ++c)
#pragma unroll
        for (int r = 0; r < 16; ++r) O[c][r] = 0.f;
    float mref = NINF, lrun = 0.f;
    const int srow = 8 * (wave >> 1) + ((lane >> 2) & 7);
    const int sch = 4 * (2 * (wave & 1) + (lane >> 5)) + ((lane & 3) ^ ((2 * (wave >> 1) + ((lane >> 4) & 1)) & 3));
    const bf16_t* csrc = CKVN + ((size_t)b * SEQ + srow) * 128 + 8 * sch;
    const unsigned ring0 = (unsigned)__builtin_amdgcn_readfirstlane((int)(unsigned)(size_t)L) + 1024u * (unsigned)wave;
    const unsigned x2 = ((unsigned)r32 >> 2) & 3u;
    const unsigned rb_e = 2048u * ((unsigned)r32 >> 3) + 64u * ((unsigned)r32 & 7u) + 16u * ((unsigned)hi ^ x2);
    const unsigned rb_o = 2048u * ((unsigned)r32 >> 3) + 64u * ((unsigned)r32 & 7u) + 16u * ((2u + (unsigned)hi) ^ x2);
    const unsigned tq = (lane & 15) >> 2, tp = lane & 3, tblk = (lane >> 4) & 1;
    const unsigned tb0 = 64u * (4u * hi + tq) + 16u * ((2u * tblk + (tp >> 1)) ^ ((unsigned)hi & 3u)) + 8u * (tp & 1);
    const unsigned tb1 = 64u * (4u * hi + tq) + 16u * ((2u * tblk + (tp >> 1)) ^ ((2u + (unsigned)hi) & 3u)) + 8u * (tp & 1);
    LAS unsigned* maskL = (LAS unsigned*)(L + DSA_MASK_OFF + wave * 8192);
    {
        const unsigned char* msrc = (const unsigned char*)(MASK + (((size_t)b * 64 + qt) * 64) * 32) + 16 * lane;
        const unsigned mdst = (unsigned)__builtin_amdgcn_readfirstlane((int)(unsigned)(size_t)maskL);
        asm volatile("s_waitcnt vmcnt(0) lgkmcnt(0)" ::: "memory");
        for (int p = 0; 8 * p <= qt; ++p) glds16(msrc + 1024 * p, mdst + 1024u * (unsigned)p);
    }
    __syncthreads();
    asm volatile("s_waitcnt vmcnt(0) lgkmcnt(0)" ::: "memory");
    glds16(csrc, ring0); glds16(csrc + (size_t)32 * 128, ring0 + 8192u); glds16(csrc + (size_t)64 * 128, ring0 + 16384u);
    int bcur = 0;
    for (int kt = 0; kt <= KT; ++kt) {
        if (kt + 2 <= KT) asm volatile("s_waitcnt vmcnt(2)\n\ts_barrier" ::: "memory");
        else if (kt + 1 <= KT) asm volatile("s_waitcnt vmcnt(1)\n\ts_barrier" ::: "memory");
        else asm volatile("s_waitcnt vmcnt(0)\n\ts_barrier" ::: "memory");
        if (kt + 3 <= KT) glds16(csrc + (size_t)(32 * (kt + 3)) * 128, ring0 + 8192u * (unsigned)((bcur + 3) & 3));
        const unsigned mwc = maskL[kt * 32 + r32];
        const LAS unsigned char* Cb = L + bcur * 8192;
        bcur = (bcur + 1) & 3;
        if (kt <= qt) {
            f32x16 S;
#pragma unroll
            for (int r = 0; r < 16; ++r) S[r] = 0.f;
#pragma unroll
            for (int ks = 0; ks < 8; ++ks) {
                const bf16x8 a = *(const LAS bf16x8*)(Cb + ((ks & 1) ? rb_o : rb_e) + 512u * (ks >> 1));
                S = MFMA32(a, qlf[ks], S);
            }
            const unsigned mw = mwc >> (16 * hi);
            const int dq = qt - kt;
            float cb = bias31;
            if (__builtin_amdgcn_readfirstlane(dq) < 5) {
                asm volatile("" ::: "memory");
                cb = 0.f;
                const int rel0 = 32 * dq + r32 - 4 * hi;
#pragma unroll
                for (int r = 0; r < 16; ++r) { int rel = rel0 - ((r & 3) + 8 * (r >> 2)); rel = rel < 0 ? 0 : rel; S[r] += biasT[rel]; }
                asm volatile("" ::: "memory");
            }
            float mx = fmaxf(S[0], S[1]);
#pragma unroll
            for (int r = 2; r < 16; ++r) mx = fmaxf(mx, S[r]);
            mx = xhalf_max(mx) + cb;
            if (__any(mx > mref + 8.f)) {
                float mm = NINF;
                asm volatile("" : "+v"(mm));
#pragma unroll
                for (int r = 0; r < 16; ++r) mm = fmaxf(mm, ((mw >> r) & 1u) ? S[r] : NINF);
                mm = xhalf_max(mm) + cb;
                const float mn = fmaxf(mref, mm);
                const float alpha = (mn > mref) ? __builtin_amdgcn_exp2f(mref - mn) : 1.f;
                mref = mn; lrun *= alpha;
#pragma unroll
                for (int c = 0; c < 4; ++c)
#pragma unroll
                    for (int r = 0; r < 16; ++r) asm volatile("v_mul_f32 %0, %0, %1" : "+v"(O[c][r]) : "v"(alpha));
            }
            const float off = ((mref == NINF) ? 0.f : mref) - cb;
            float ps0 = 0.f, ps1 = 0.f;
#pragma unroll
            for (int r = 0; r < 16; ++r) {
                const float e = __builtin_amdgcn_exp2f(S[r] - off);
                int m1; asm("v_bfe_i32 %0, %1, %2, 1" : "=v"(m1) : "v"(mw), "n"(r));
                S[r] = __uint_as_float(__float_as_uint(e) & (unsigned)m1);
                if (r & 1) ps1 += S[r]; else ps0 += S[r];
            }
            lrun += ps0 + ps1;
            const bf16x8 p0 = pack8(S, 0), p1 = pack8(S, 1);
#pragma unroll
            for (int c = 0; c < 4; ++c) {
                s16x4 f[4];
#pragma unroll
                for (int st = 0; st < 4; ++st) {
                    f[st] = vtr(Cb + ((st & 1) ? tb1 : tb0) + 2048u * st + 512u * c);
                }
                O[c] = MFMA32(cat44(f[0], f[1]), p0, O[c]);
                O[c] = MFMA32(cat44(f[2], f[3]), p1, O[c]);
            }
        }
    }
    const float lt = xhalf_sum(lrun);
    const float il = 1.f / lt;
    f32x16 Y[2];
#pragma unroll
    for (int r = 0; r < 16; ++r) { Y[0][r] = 0.f; Y[1][r] = 0.f; }
#pragma unroll
    for (int rt = 0; rt < 4; ++rt) {
#pragma unroll
        for (int r = 0; r < 16; ++r) O[rt][r] *= il;
        const bf16x8 x0 = pack8(O[rt], 0), x1 = pack8(O[rt], 1);
#pragma unroll
        for (int c = 0; c < 2; ++c) {
            int l3 = lane; asm volatile("" : "+v"(l3));
            const GAS bf16_t* wp = (const GAS bf16_t*)WUVp + ((((c * 4 + rt) * 2 + 0) * 32 + (l3 & 31)) * 2 + (l3 >> 5)) * 8;
            Y[c] = MFMA32(*(const GAS bf16x8*)wp, x0, Y[c]);
            Y[c] = MFMA32(*(const GAS bf16x8*)(wp + 32 * 2 * 8), x1, Y[c]);
        }
    }
    {
        int l2 = lane; asm volatile("" : "+v"(l2));
        const int t2 = 32 * qt + (l2 & 31);
        gate_store(Y, 1.f, PROJ + ((size_t)b * SEQ + t2) * LDP + C_DSG + h * 64, MIX + ((size_t)b * SEQ + t2) * DM + 384 + h * 64, l2 >> 5);
    }
    __syncthreads();
}

typedef GAS unsigned gu32;
#define RLX_AGENT __ATOMIC_RELAXED, __HIP_MEMORY_SCOPE_AGENT
constexpr size_t WS_BAR = 512 * 1024;
#define XB_TMO      128
#define XB_XCNT(j)  (256  + 64 * (j))
#define XB_XSUB(j)  (1280 + 64 * (j))
#define XB_XGEN(j)  (2304 + 64 * (j))
#define XB_TOP      3328
#define XB_TOPGEN   3392
#define XCD_BAR_WORDS 3456
#define XB_SPIN_CAP (1u << 18)

__device__ __forceinline__ unsigned xb_ld(unsigned* p)              { return __hip_atomic_load(p, __ATOMIC_RELAXED, __HIP_MEMORY_SCOPE_AGENT); }
__device__ __forceinline__ unsigned xb_add(unsigned* p, unsigned v) { return __hip_atomic_fetch_add(p, v, __ATOMIC_RELAXED, __HIP_MEMORY_SCOPE_AGENT); }
__device__ __forceinline__ unsigned xb_xcc_id() { return (unsigned)__builtin_amdgcn_s_getreg((3 << 11) | 20) & 0xFu; }
#define XB_SPIN(cond, bar) do { unsigned _sp = 0; while (cond) { __builtin_amdgcn_s_sleep(1); \
    if ((++_sp & 255u) == 0u) { if (xb_ld(&(bar)[XB_TMO])) break; if (_sp > XB_SPIN_CAP) { atomicAdd(&(bar)[XB_TMO], 1u); break; } } } } while (0)

struct XcdBarrier {
    unsigned* bar; unsigned x;
    volatile LAS unsigned* st;
};

__device__ __forceinline__ XcdBarrier xcd_barrier_post(unsigned* bar, volatile LAS unsigned* st) {
    XcdBarrier b; b.bar = bar; b.x = xb_xcc_id(); b.st = st;
    if (threadIdx.x == 0) (void)xb_add(&bar[XB_XCNT(b.x)], 1u);
    return b;
}
__device__ __forceinline__ void xcd_barrier_complete(unsigned* bar, unsigned x, unsigned& nloc, unsigned& nx) {
    const unsigned G = gridDim.x * gridDim.y * gridDim.z;
    unsigned sum, cnt, mine, sp = 0u;
    for (;;) {
        sum = 0u; cnt = 0u; mine = 0u;
#pragma unroll
        for (unsigned j = 0; j < 16; ++j) { const unsigned c = xb_ld(&bar[XB_XCNT(j)]); sum += c; cnt += (c > 0u) ? 1u : 0u; mine = (j == x) ? c : mine; }
        if (sum == G) break;
        __builtin_amdgcn_s_sleep(1);
        if ((++sp & 255u) == 0u) { if (xb_ld(&bar[XB_TMO])) break; if (sp > XB_SPIN_CAP) { atomicAdd(&bar[XB_TMO], 1u); break; } }
    }
    nloc = mine > 0u ? mine : 1u; nx = cnt > 0u ? cnt : 1u;
}

__device__ __forceinline__ void xcd_barrier(const XcdBarrier& b) {
    asm volatile("s_waitcnt vmcnt(0)" ::: "memory");
    __syncthreads();
    if (threadIdx.x == 0) {
        unsigned* bar = b.bar;
        __builtin_amdgcn_s_waitcnt(0);
        unsigned nloc = b.st[0], nx = b.st[1];
        if (nloc == 0u) { xcd_barrier_complete(bar, b.x, nloc, nx); b.st[0] = nloc; b.st[1] = nx; }
        const unsigned old = xb_add(&bar[XB_XSUB(b.x)], 1u);
        const unsigned gen = old / nloc;
        if (old + 1u == (gen + 1u) * nloc) {
            __builtin_amdgcn_fence(__ATOMIC_RELEASE, "agent");
            asm volatile("s_waitcnt vmcnt(0)" ::: "memory");
            const unsigned og = xb_add(&bar[XB_TOP], 1u);
            const unsigned tg = og / nx;
            if (og + 1u == (tg + 1u) * nx) xb_add(&bar[XB_TOPGEN], 1u);
            else XB_SPIN(xb_ld(&bar[XB_TOPGEN]) == tg, bar);
            __builtin_amdgcn_fence(__ATOMIC_ACQUIRE, "agent");
            xb_add(&bar[XB_XGEN(b.x)], 1u);
            asm volatile("s_waitcnt vmcnt(0)" ::: "memory");
        } else {
            XB_SPIN(xb_ld(&bar[XB_XGEN(b.x)]) == gen, bar);
            __builtin_amdgcn_fence(__ATOMIC_ACQUIRE, "agent");
            asm volatile("s_waitcnt vmcnt(0)" ::: "memory");
        }
    }
    __syncthreads();
}

#ifndef MK_MULTI
#define MK_MULTI 0
#endif
constexpr int NPHASE = 11;
__global__ void __launch_bounds__(NWAVES * 64, 2) mk_fwd(Args args) {
    extern __shared__ __attribute__((aligned(16))) unsigned char lds_raw[];
    LAS unsigned char* lds = (LAS unsigned char*)lds_raw;
    const int tid0 = threadIdx.x;
    int wave_ = __builtin_amdgcn_readfirstlane(tid0 >> 6); asm volatile("" : "+s"(wave_));
    const int wave = wave_;
    const int G = gridDim.x, bid = blockIdx.x;
    for (int u = tid0; u < 16; u += NWAVES * 64) ((LAS unsigned*)(lds + 131072))[u] = 0u;
    __syncthreads();
    const XcdBarrier xbar = xcd_barrier_post((unsigned*)(args.ws + WS_BAR), (volatile LAS unsigned*)(lds + 131072));
    const int lo = args.ph_lo, hi = args.ph_hi;
#define IN(k) (lo <= (k) && (k) < hi)
#define SEAM(k) do { if (IN(k) && IN((k) + 1)) { if ((k) == 0) cg::this_grid().sync(); else xcd_barrier(xbar); } } while (0)
#define PH_BEGIN int lane = lane_id_v(); unsigned char* ws_ = args.ws; asm volatile("" : "+s"(ws_)); GAS unsigned char* ws = (GAS unsigned char*)ws_;     \
    const int gw = bid * NWAVES + wave, NGW = G * NWAVES; (void)gw; (void)NGW;
#define VCU_LOOP for (int vcu = vcu0; vcu < 256; vcu += G)
#define VCU_IDS const int bb = vcu >> 3, w64 = (vcu & 7) * 8 + wave; (void)bb; (void)w64;
#define P_WIN ((bf16_t*)(ws + WS_WIN))
#define P_WOUT ((bf16_t*)(ws + WS_WOUT))
#define P_WMEM ((bf16_t*)(ws + WS_WMEM))
#define P_MEMB ((bf16_t*)(ws + WS_MEMB))
#define P_MEMKV ((bf16_t*)(ws + WS_MEMKV))
#define P_CKVN ((bf16_t*)(ws + WS_CKVN))
#define P_MASK ((unsigned*)(ws + WS_MASK))
#define P_H ((bf16_t*)(ws + WS_H))
#define P_MIX ((bf16_t*)(ws + WS_MIX))
#define P_PROJ ((bf16_t*)(ws + WS_PROJ))
#define P_Y ((bf16_t*)(ws + WS_Y))
    const int vcu0 = (G % 8 == 0) ? (bid & 7) * (G >> 3) + (bid >> 3) : bid;

    if (IN(0)) {
        PH_BEGIN
        const float* x = args.in[0]; const float* mem = args.in[1]; const float* pre_g = args.in[2];
        const float* w_in = args.in[4]; const float* w_mem = args.in[8]; const float* w_out = args.in[9];
        LAS float* scr = (LAS float*)(lds + wave * 16384);
        constexpr int I_IN = 16 * (LDP / 32), I_OUT = 16 * 32, I_MEM = 16 * 16;
        constexpr int NITEMS = 2 * I_IN + 2 * I_OUT + 2 * I_MEM;
        for (int it = gw; it < NITEMS; it += NGW) {
            int r = it;
            if (r < 2 * I_IN) { const int l = r / I_IN; r -= l * I_IN; p0_transpose_item(w_in + (size_t)l * DM * NCOL, DM, NCOL, LDP, P_WIN + (size_t)l * LDP * DM, pre_g + l * DM, scr, r, lane); continue; }
            r -= 2 * I_IN;
            if (r < 2 * I_OUT) { const int l = r / I_OUT; r -= l * I_OUT; p0_transpose_item(w_out + (size_t)l * DM * DM, DM, DM, DM, P_WOUT + (size_t)l * DM * DM, nullptr, scr, r, lane); continue; }
            r -= 2 * I_OUT;
            { const int l = r / I_MEM; r -= l * I_MEM; p0_transpose_item(w_mem + (size_t)l * DM * 512, DM, 512, 512, P_WMEM + (size_t)l * 512 * DM, nullptr, scr, r, lane); }
        }
        {
            const float* w_uk = args.in[5]; const float* w_uv = args.in[6];
            bf16_t* WUKp = (bf16_t*)(ws + WS_WUK); bf16_t* WUVp = (bf16_t*)(ws + WS_WUV);
            for (int e = gw * 64 + lane; e < 2 * 6 * 8192; e += NGW * 64) {
                const int lh = e >> 13, l = lh / 6, h = lh % 6, w = e & 8191;
                { const int rt = w >> 11, rho = (w >> 6) & 31, d = w & 63; const int r = 32 * rt + ((rho & 0x13) | ((rho & 4) << 1) | ((rho & 8) >> 1));
                  WUKp[e] = (bf16_t)f2bf(w_uk[(((size_t)l * 128 + r) * 6 + h) * 64 + d]); }
                { const int j = w & 7, hh = (w >> 3) & 1, d32 = (w >> 4) & 31, s = (w >> 9) & 1, rt = (w >> 10) & 3, c = (w >> 12) & 1;
                  const int r = 32 * rt + 16 * s + 8 * (j >> 2) + 4 * hh + (j & 3), d = 32 * c + d32;
                  WUVp[e] = (bf16_t)f2bf(w_uv[(((size_t)l * 128 + r) * 6 + h) * 64 + d]); }
            }
        }
        for (int m = gw; m < NB * NMEM; m += NGW) row_to_bf16<false>(mem + (size_t)m * DM, P_MEMB + (size_t)m * DM, lane);
        for (int m = gw * 2; m < NTOK; m += NGW * 2) { row_to_bf16<true>(x + (size_t)m * DM, P_H + (size_t)m * DM, lane); row_to_bf16<true>(x + (size_t)(m + 1) * DM, P_H + (size_t)(m + 1) * DM, lane); }
    }
    SEAM(0);
#pragma unroll 1
    for (int l = 0; l < 2; ++l) {
        const int pb = 1 + 5 * l;
        if (IN(pb)) {
            PH_BEGIN
            { pg8::Gemm g{P_H, P_WIN + (size_t)l * LDP * DM, NTOK, LDP, DM}; pg8::StaticOrder S; S.init(NTOK, LDP, G, bid);
              pg8::EpiBf16<0> E{P_PROJ, LDP, nullptr, 0, 0, 1.f};
              pg8::gemm_phase<pg8::EpiBf16<0>, pg8::StaticOrder, true, true>(lds, g, S, E, wave); }
            if (l == 0) {
              pg8::Gemm g{P_MEMB, P_WMEM, NB * NMEM, 1024, DM}; pg8::StaticOrder S; S.init(NB * NMEM, 1024, G, bid);
              pg8::EpiBf16<0> E{P_MEMKV, 1024, nullptr, 0, 0, 1.f};
              pg8::gemm_phase<pg8::EpiBf16<0>, pg8::StaticOrder, true, true>(lds, g, S, E, wave); }
        }
        SEAM(pb);
        if (IN(pb + 1)) {
            { PH_BEGIN
              const float* kv_g = args.in[7];
              for (int m = gw * 8; m < NTOK; m += NGW * 8) { ckvnorm4(P_PROJ, kv_g + l * 128, P_CKVN, m, lane); ckvnorm4(P_PROJ, kv_g + l * 128, P_CKVN, m + 4, lane); } }
            VCU_LOOP { PH_BEGIN VCU_IDS
              for (int i = 0; i < 6; ++i) { const int qt = (i & 1) ? 63 - w64 : w64; sb_item(P_PROJ, P_MIX, bb, i, qt, lane, lds + wave * 16384); } }
            __syncthreads();
            VCU_LOOP { PH_BEGIN VCU_IDS
              const int s8 = vcu & 7;
              for (int j = 0; j < 8; ++j) { const int qt = 8 * j + ((j & 1) ? 7 - s8 : s8); sel_item2(P_PROJ, P_MASK, bb, qt, lane, wave, lds); } }
            __syncthreads();
            VCU_LOOP { PH_BEGIN VCU_IDS
              for (int i = 0; i < 4; ++i) {
                  __syncthreads();
                  mem_stage(P_MEMKV + l * 512, bb, i, wave * 64 + lane, lds);
                  __syncthreads();
                  mem_item_lds(P_PROJ, P_MIX, bb, i, w64, lane, lds);
              } }
        }
        SEAM(pb + 1);
        if (IN(pb + 2)) {
            __syncthreads();
            VCU_LOOP { PH_BEGIN VCU_IDS
              const float* rel_bias = args.in[10];
              const int s8 = vcu & 7, hs = (s8 < 4) ? 0 : 3;
              for (int oi = 0; oi < 2; ++oi) {
                  const int o = oi ? 7 - (s8 & 3) : (s8 & 3);
                  for (int hh = 0; hh < 3; ++hh) {
                      const int h = hs + hh;
                      dsa_round(P_PROJ, P_CKVN, P_MASK, (const bf16_t*)(ws + WS_WUK) + (size_t)(l * 6 + h) * 8192, (const bf16_t*)(ws + WS_WUV) + (size_t)(l * 6 + h) * 8192,
                                rel_bias, P_MIX, bb, o, h, lane, wave, lds);
                  }
              } }
        }
        SEAM(pb + 2);
        if (IN(pb + 3)) {
            PH_BEGIN
            __syncthreads();
            pg8::Gemm g{P_MIX, P_WOUT + (size_t)l * DM * DM, NTOK, DM, DM}; pg8::StaticOrder S; S.init(NTOK, DM, G, bid);
            pg8::EpiBf16<0> E{P_Y, DM, nullptr, 0, 0, 1.f};
            pg8::gemm_phase<pg8::EpiBf16<0>, pg8::StaticOrder, true, true>(lds, g, S, E, wave);
        }
        SEAM(pb + 3);
        if (IN(pb + 4)) {
            PH_BEGIN
            const float* xin = (l == 0) ? args.in[0] : args.out; const float* post_g = args.in[3];
            for (int m = gw * 2; m < NTOK; m += NGW * 2) { post_row(xin, P_Y, post_g + l * DM, args.out, (l == 0) ? P_H : (bf16_t*)nullptr, m, lane); post_row(xin, P_Y, post_g + l * DM, args.out, (l == 0) ? P_H : (bf16_t*)nullptr, m + 1, lane); }
        }
        SEAM(pb + 4);
    }
#undef IN
#undef SEAM
}

extern "C" void kernel_launch(void* const* d_in, const int* in_sizes, int n_in, void* d_out, int out_size, void* d_ws, size_t ws_size, hipStream_t stream) {
    static int grid = 0;
    if (grid == 0) {
        if (n_in != 11 || ws_size < WS_END) { fprintf(stderr, "kernel_launch: unexpected n_in %d / ws_size %zu\n", n_in, ws_size); grid = -1; return; }
        int dev = 0, cus = 0, per_cu = 0;
        hipGetDevice(&dev);
        hipDeviceGetAttribute(&cus, hipDeviceAttributeMultiprocessorCount, dev);
        hipFuncSetAttribute((const void*)mk_fwd, hipFuncAttributeMaxDynamicSharedMemorySize, LDS_BYTES);
        hipOccupancyMaxActiveBlocksPerMultiprocessor(&per_cu, (const void*)mk_fwd, NWAVES * 64, LDS_BYTES);
        if (per_cu < 1) { fprintf(stderr, "kernel_launch: occupancy query says %d blocks per CU\n", per_cu); per_cu = 1; }
        grid = cus * 1;
        (void)hipGetLastError();
    }
    if (grid < 0) return;
    (void)hipMemsetAsync((char*)d_ws + WS_BAR, 0, 16384, stream);
    Args a{};
    for (int i = 0; i < 11; ++i) a.in[i] = (const float*)d_in[i];
    a.out = (float*)d_out; a.ws = (unsigned char*)d_ws;
#if MK_MULTI
    for (int p = 0; p < NPHASE; ++p) { a.ph_lo = p; a.ph_hi = p + 1; hipLaunchKernelGGL(mk_fwd, dim3(grid), dim3(NWAVES * 64), LDS_BYTES, stream, a); }
#else
    a.ph_lo = 0; a.ph_hi = NPHASE;
    void* kargs[] = {&a};
    hipError_t e = hipLaunchCooperativeKernel((const void*)mk_fwd, dim3(grid), dim3(NWAVES * 64), kargs, LDS_BYTES, stream);
    if (e != hipSuccess) fprintf(stderr, "cooperative launch failed: %s (grid %d)\n", hipGetErrorString(e), grid);
#endif
}
```

```cpp
#include <hip/hip_runtime.h>
#include <hip/hip_cooperative_groups.h>
#include <stdint.h>
#include <math.h>
#include <cstdio>
namespace cg = cooperative_groups;
__device__ __forceinline__ int lane_id_v() { int l; asm volatile("v_mbcnt_lo_u32_b32 %0, -1, 0\n\tv_mbcnt_hi_u32_b32 %0, -1, %0" : "=v"(l)); return l; }
namespace pg8 {
#define PG8_LAS __attribute__((address_space(3)))
typedef unsigned short bf16_t;
typedef short bf16x8 __attribute__((ext_vector_type(8)));
typedef float f32x4 __attribute__((ext_vector_type(4)));
typedef unsigned u32x4 __attribute__((ext_vector_type(4)));
constexpr int BM = 256, BK = 64, HALF = 128, HTB = HALF * BK * 2  , STAGE_BYTES = 8 * HTB, NXCD = 8, WGM = 8;

__host__ __device__ __forceinline__ int lds_byte(int r, int c) { const int st = (r >> 4) * 2 + (c >> 5), rr = r & 15, cc = c & 31, ob = rr * 64 + cc * 2; return st * 1024 + (ob ^ (((ob >> 9) & 1) << 5)); }
__host__ __device__ __forceinline__ void stage_rc(int b, int& R, int& C) { const int st = b / 1024, sb = b % 1024, swz = sb ^ (((sb >> 9) & 1) << 5); R = (st >> 1) * 16 + swz / 64; C = (st & 1) * 32 + (swz % 64) / 2; }
__host__ __device__ __forceinline__ int perm32(int rho) { const int n = rho >> 4, i = rho & 15; return 8 * (i >> 2) + 4 * n + (i & 3); }

struct Unit { int pm, pn; };
struct Gemm { const bf16_t* A; const bf16_t* Bt; int M, N, K; };

struct StaticOrder {
    int nM, nN, nwg, G, c;
    __host__ __device__ void init(int M, int N, int G_, int c_) { nM = M / BM; nN = N / BM; nwg = nM * nN; G = G_; c = c_; }
    __host__ __device__ bool next(int i, Unit& u) const {
        const long L = (long)i * G + c; if (L >= nwg) return false;
        int wgid = (int)L; { const int q = nwg / NXCD, r = nwg % NXCD, xcd = wgid % NXCD, off = wgid / NXCD; wgid = (xcd < r ? xcd * (q + 1) : r * (q + 1) + (xcd - r) * q) + off; }
        const int nig = WGM * nN, gid = wgid / nig, fm = gid * WGM, gsz = (nM - fm) < WGM ? (nM - fm) : WGM;
        u.pm = fm + ((wgid % nig) % gsz); u.pn = (wgid % nig) / gsz; return true;
    }
    __device__ __forceinline__ void a_ready(const Unit&) const {}
    __device__ __forceinline__ void done(const Unit&) const {}
};

__device__ __forceinline__ unsigned cvt_pk_bf16(float lo, float hi) { unsigned r; asm volatile("v_cvt_pk_bf16_f32 %0, %1, %2" : "=v"(r) : "v"(lo), "v"(hi)); return r; }
typedef float f32x2 __attribute__((ext_vector_type(2)));
__device__ __forceinline__ f32x2 gelu_pk(f32x2 v) {
    const f32x2 av = __builtin_elementwise_abs(v), d = av * 0.2316418882f + 1.0f;
    f32x2 t; t.x = __builtin_amdgcn_rcpf(d.x); t.y = __builtin_amdgcn_rcpf(d.y);
    f32x2 q = t * 0.5307027145f + (-0.7265760135f); q = q * t + 0.7107068705f; q = q * t + (-0.142248368f); q = q * t + 0.127414796f; q = q * t;
    const f32x2 s = (v * v) * (-0.72134752044f);
    f32x2 e; e.x = __builtin_amdgcn_exp2f(s.x); e.y = __builtin_amdgcn_exp2f(s.y);
    const f32x2 m = v * (q * e), r = v - m;
    f32x2 o; o.x = v.x < 0.f ? m.x : r.x; o.y = v.y < 0.f ? m.y : r.y; return o;
}

template <int ACT  > struct EpiBf16 {
    static constexpr bool PERM = true, AFTER_DRAIN = false; static_assert(ACT == 0 || ACT == 1, "EpiBf16: ACT is 0 (none) or 1 (gelu_pk)");
    bf16_t* O; int ldc; const float* bias; int split_cols; size_t split_stride; float scale0;
    __device__ __forceinline__ void operator()(const f32x4 (&acc)[2][2][4][2], const Unit& u, int wr, int wc, int fr, int fq) const {
        const int row0 = u.pm * BM + wr * 64 + fr; int colt = u.pn * BM; bf16_t* base = O;
        float sc = 1.f; if (split_cols) { const int t = colt / split_cols; base += (size_t)t * split_stride; colt -= t * split_cols; if (t == 0) sc = scale0; }
        const int col0 = colt + wc * 32 + 8 * fq, bcol0 = u.pn * BM + wc * 32 + 8 * fq;
        f32x4 bv[2][2];
#pragma unroll
        for (int bj = 0; bj < 2; ++bj)
#pragma unroll
            for (int n = 0; n < 2; ++n) bv[bj][n] = bias ? *(const f32x4*)(bias + bcol0 + bj * HALF + 4 * n) : (f32x4){0.f, 0.f, 0.f, 0.f};
#pragma unroll
        for (int ai = 0; ai < 2; ++ai)
#pragma unroll
            for (int m = 0; m < 4; ++m) { bf16_t* rowp = base + (size_t)(row0 + ai * HALF + m * 16) * ldc + col0;
#pragma unroll
                for (int bj = 0; bj < 2; ++bj) { f32x4 v0 = acc[ai][bj][m][0] + bv[bj][0], v1 = acc[ai][bj][m][1] + bv[bj][1];
                    if (ACT == 1) { f32x2 a = gelu_pk((f32x2){v0[0], v0[1]}), b = gelu_pk((f32x2){v0[2], v0[3]}), c = gelu_pk((f32x2){v1[0], v1[1]}), d = gelu_pk((f32x2){v1[2], v1[3]});
                        v0 = (f32x4){a.x, a.y, b.x, b.y}; v1 = (f32x4){c.x, c.y, d.x, d.y}; }
                    v0 = v0 * sc; v1 = v1 * sc; u32x4 w; w.x = cvt_pk_bf16(v0[0], v0[1]); w.y = cvt_pk_bf16(v0[2], v0[3]); w.z = cvt_pk_bf16(v1[0], v1[1]); w.w = cvt_pk_bf16(v1[2], v1[3]);
                    *(u32x4*)(rowp + bj * HALF) = w; } }
    }
};
template <class Epi, class Sched, bool ALIGN_EPI = false, bool SP2 = false>
__device__ __forceinline__ void gemm_phase(PG8_LAS unsigned char* lds, const Gemm g, const Sched& S, const Epi& E, int wave_id) {
    int tid_ = wave_id * 64 + lane_id_v();
    const int tid = tid_, wid = __builtin_amdgcn_readfirstlane(tid >> 6), lane = tid & 63, wr = wid >> 2, wc = wid & 3, fr = lane & 15, fq = lane >> 4;
    const int K = g.K, nt = K / BK;
    unsigned voffA[2], voffB[2];
#pragma unroll
    for (int i = 0; i < 2; ++i) { int R, C; stage_rc(tid * 16 + i * 8192, R, C); const int Rb = Epi::PERM ? ((R & ~31) + perm32(R & 31)) : R;
        voffA[i] = (unsigned)(R * K + C) * 2u; voffB[i] = (unsigned)(Rb * K + C) * 2u; }
    const size_t kstep = (size_t)(BK * 2);
    const size_t hstep = (size_t)HALF * K * 2;
    const size_t tstep = 2 * hstep;
    const unsigned ldsw = (unsigned)wid * 1024u;
    const int aoff = lds_byte(wr * 64 + fr, fq * 8), boff = lds_byte(wc * 32 + fr, fq * 8);
#define PG8_SA(b, h) (((b) * 2 + (h)) * HTB)
#define PG8_SB(b, h) ((4 + (b) * 2 + (h)) * HTB)
#define PG8_STAGE(bufoff, gbase, voff) do { _Pragma("unroll") for (int _i = 0; _i < 2; ++_i) \
        __builtin_amdgcn_global_load_lds((const unsigned*)((const char*)(gbase) + (voff)[_i]), (PG8_LAS unsigned*)(lds + (bufoff) + ldsw + _i * 8192), 16, 0, 0); } while (0)
#define PG8_LDA(dst, b, h) do { _Pragma("unroll") for (int m = 0; m < 4; ++m) _Pragma("unroll") for (int k = 0; k < 2; ++k) dst[m][k] = *(const PG8_LAS bf16x8*)(lds + PG8_SA(b, h) + aoff + m * 2048 + k * 1024); } while (0)
#define PG8_LDB(dst, b, h) do { _Pragma("unroll") for (int n = 0; n < 2; ++n) _Pragma("unroll") for (int k = 0; k < 2; ++k) dst[n][k] = *(const PG8_LAS bf16x8*)(lds + PG8_SB(b, h) + boff + n * 2048 + k * 1024); } while (0)
#define PG8_MMA(ai, bj, At, Bt) do { __builtin_amdgcn_s_setprio(1); _Pragma("unroll") for (int m = 0; m < 4; ++m) _Pragma("unroll") for (int n = 0; n < 2; ++n) _Pragma("unroll") for (int k = 0; k < 2; ++k) \
        acc[ai][bj][m][n] = __builtin_amdgcn_mfma_f32_16x16x32_bf16(Bt[n][k], At[m][k], acc[ai][bj][m][n], 0, 0, 0); __builtin_amdgcn_s_setprio(0); } while (0)
#define PG8_WAIT_V(n) asm volatile("s_waitcnt vmcnt(" #n ")" ::: "memory")
#define PG8_WAIT_L(n) asm volatile("s_waitcnt lgkmcnt(" #n ")" ::: "memory")
#define PG8_BAR __builtin_amdgcn_s_barrier()
#define PG8_SCHED __builtin_amdgcn_sched_barrier(0)
    Unit cur, nxt; int ui = 0;
    if (!S.next(0, cur)) return;
    f32x4 acc[2][2][4][2];
#pragma unroll
    for (int a = 0; a < 2; ++a)
#pragma unroll
        for (int b = 0; b < 2; ++b)
#pragma unroll
            for (int m = 0; m < 4; ++m)
#pragma unroll
                for (int n = 0; n < 2; ++n) acc[a][b][m][n] = (f32x4){0.f, 0.f, 0.f, 0.f};
    bf16x8 At[4][2], B0[2][2], B1[2][2];
    const char* cA = (const char*)g.A + (size_t)cur.pm * tstep; const char* cB = (const char*)g.Bt + (size_t)cur.pn * tstep;
    S.a_ready(cur);
    if constexpr (SP2) {
        PG8_STAGE(PG8_SB(0, 0), cB, voffB); PG8_STAGE(PG8_SB(0, 1), cB + hstep, voffB); PG8_STAGE(PG8_SA(0, 0), cA, voffA); PG8_STAGE(PG8_SA(0, 1), cA + hstep, voffA);
        if (wr == 1) PG8_BAR;
        PG8_WAIT_V(2); PG8_BAR;
        PG8_STAGE(PG8_SB(1, 0), cB + kstep, voffB); PG8_STAGE(PG8_SA(1, 0), cA + kstep, voffA); PG8_STAGE(PG8_SB(1, 1), cB + hstep + kstep, voffB);
        PG8_WAIT_V(6); PG8_BAR;
    } else {
        PG8_STAGE(PG8_SB(0, 0), cB, voffB); PG8_STAGE(PG8_SA(0, 0), cA, voffA); PG8_STAGE(PG8_SB(0, 1), cB + hstep, voffB); PG8_STAGE(PG8_SA(0, 1), cA + hstep, voffA);
        if (wr == 1) PG8_BAR;
        PG8_WAIT_V(4); PG8_BAR;
        PG8_STAGE(PG8_SB(1, 0), cB + kstep, voffB); PG8_STAGE(PG8_SA(1, 0), cA + kstep, voffA); PG8_STAGE(PG8_SB(1, 1), cB + hstep + kstep, voffB);
        PG8_WAIT_V(6); PG8_BAR;
    }
    for (;;) {
        const bool has_next = S.next(ui + 1, nxt);
        const char* nA = has_next ? (const char*)g.A + (size_t)nxt.pm * tstep : cA; const char* nB = has_next ? (const char*)g.Bt + (size_t)nxt.pn * tstep : cB;
        for (int t = 0; t < nt; t += 2) {
            const bool last = (t == nt - 2);
            const char* a1 = cA + (size_t)(t + 1) * kstep;
            const char* a2 = last ? nA : cA + (size_t)(t + 2) * kstep; const char* b2 = last ? nB : cB + (size_t)(t + 2) * kstep;
            const char* a3 = a2 + kstep; const char* b3 = b2 + kstep;
            if (last && has_next) S.a_ready(nxt);
            if constexpr (SP2) {
            PG8_LDB(B0, 0, 0); PG8_LDB(B1, 0, 1); PG8_SCHED; PG8_LDA(At, 0, 0); PG8_STAGE(PG8_SA(1, 1), a1 + hstep, voffA);
            PG8_WAIT_V(8); PG8_WAIT_L(0); PG8_BAR; PG8_MMA(0, 0, At, B0); PG8_MMA(0, 1, At, B1); PG8_BAR; PG8_SCHED;
            PG8_LDA(At, 0, 1); PG8_STAGE(PG8_SB(0, 0), b2, voffB); PG8_STAGE(PG8_SB(0, 1), b2 + hstep, voffB); PG8_STAGE(PG8_SA(0, 0), a2, voffA);
            PG8_WAIT_V(8); PG8_WAIT_L(0); PG8_BAR; PG8_MMA(1, 0, At, B0); PG8_MMA(1, 1, At, B1); PG8_BAR; PG8_SCHED;
            PG8_LDB(B0, 1, 0); PG8_LDB(B1, 1, 1); PG8_SCHED; PG8_LDA(At, 1, 0); PG8_STAGE(PG8_SA(0, 1), a2 + hstep, voffA);
            PG8_WAIT_V(8); PG8_WAIT_L(0); PG8_BAR; PG8_MMA(0, 0, At, B0); PG8_MMA(0, 1, At, B1); PG8_BAR; PG8_SCHED;
            PG8_LDA(At, 1, 1); PG8_STAGE(PG8_SB(1, 0), b3, voffB); PG8_STAGE(PG8_SB(1, 1), b3 + hstep, voffB); PG8_STAGE(PG8_SA(1, 0), a3, voffA);
            PG8_WAIT_V(8); PG8_WAIT_L(0); PG8_BAR; PG8_MMA(1, 0, At, B0); PG8_MMA(1, 1, At, B1); PG8_BAR; PG8_SCHED;
            } else {
            PG8_LDB(B0, 0, 0); PG8_SCHED; PG8_LDA(At, 0, 0); PG8_STAGE(PG8_SA(1, 1), a1 + hstep, voffA);
            PG8_WAIT_L(8); PG8_BAR; PG8_WAIT_L(0); PG8_MMA(0, 0, At, B0); PG8_BAR; PG8_SCHED;
            PG8_LDB(B1, 0, 1); PG8_STAGE(PG8_SB(0, 0), b2, voffB);
            PG8_BAR; PG8_WAIT_L(0); PG8_MMA(0, 1, At, B1); PG8_BAR;
            PG8_LDA(At, 0, 1); PG8_STAGE(PG8_SA(0, 0), a2, voffA);
            PG8_BAR; PG8_WAIT_L(0); PG8_MMA(1, 0, At, B0); PG8_BAR; PG8_SCHED;
            PG8_STAGE(PG8_SB(0, 1), b2 + hstep, voffB);
            PG8_WAIT_V(6); PG8_BAR; PG8_MMA(1, 1, At, B1); PG8_BAR;
            PG8_LDB(B0, 1, 0); PG8_SCHED; PG8_LDA(At, 1, 0); PG8_STAGE(PG8_SA(0, 1), a2 + hstep, voffA);
            PG8_WAIT_L(8); PG8_BAR; PG8_WAIT_L(0); PG8_MMA(0, 0, At, B0); PG8_BAR; PG8_SCHED;
            PG8_LDB(B1, 1, 1); PG8_STAGE(PG8_SB(1, 0), b3, voffB);
            PG8_BAR; PG8_WAIT_L(0); PG8_MMA(0, 1, At, B1); PG8_BAR;
            PG8_LDA(At, 1, 1); PG8_STAGE(PG8_SA(1, 0), a3, voffA);
            PG8_BAR; PG8_WAIT_L(0); PG8_MMA(1, 0, At, B0); PG8_BAR; PG8_SCHED;
            PG8_STAGE(PG8_SB(1, 1), b3 + hstep, voffB);
            PG8_WAIT_V(6); PG8_BAR; PG8_MMA(1, 1, At, B1); PG8_BAR;
            }
        }
        if constexpr (ALIGN_EPI) { if (wr == 0) PG8_BAR; }
        if constexpr (!Epi::AFTER_DRAIN) { E(acc, cur, wr, wc, fr, fq); S.done(cur); }
        if (!has_next) break;
#pragma unroll
        for (int a = 0; a < 2; ++a)
#pragma unroll
            for (int b = 0; b < 2; ++b)
#pragma unroll
                for (int m = 0; m < 4; ++m)
#pragma unroll
                    for (int n = 0; n < 2; ++n) acc[a][b][m][n] = (f32x4){0.f, 0.f, 0.f, 0.f};
        cur = nxt; cA = nA; cB = nB; ++ui;
        if constexpr (ALIGN_EPI) { if (wr == 1) PG8_BAR; }
    }
    PG8_WAIT_V(0);
    if constexpr (!ALIGN_EPI) { if (wr == 0) PG8_BAR; }
    PG8_BAR;
    if constexpr (Epi::AFTER_DRAIN) { E.fused(acc, cur, wr, wc, fr, fq, lds, wid, lane); S.done(cur); }
#undef PG8_SA
#undef PG8_SB
#undef PG8_STAGE
#undef PG8_LDA
#undef PG8_LDB
#undef PG8_MMA
#undef PG8_WAIT_V
#undef PG8_WAIT_L
#undef PG8_BAR
#undef PG8_SCHED
}
}
typedef unsigned short bf16_t;
#define LAS __attribute__((address_space(3)))
#define GAS __attribute__((address_space(1)))
typedef unsigned v4u __attribute__((ext_vector_type(4)));
typedef unsigned v2u __attribute__((ext_vector_type(2)));
typedef float f32x4 __attribute__((ext_vector_type(4)));
constexpr int DM = 1024, NB = 32, SEQ = 2048, NTOK = NB * SEQ, NMEM = 256;
constexpr int LDP = 3328;
constexpr int C_SBQ = 0, C_SBK = 384, C_SBV = 768, C_SBG = 1152, C_DSQ = 1536, C_CKV = 1920, C_DSG = 2048,
              C_IDQ = 2432, C_IDK = 2688, C_IDW = 2720, C_MQ = 2728, C_MG = 2984, NCOL = 3240;
constexpr float EPS = 1e-6f;
constexpr size_t MiB = 1u << 20;
constexpr size_t WS_CTL = 0;
constexpr size_t WS_WIN = 1 * MiB;
constexpr size_t WS_WOUT = 14 * MiB;
constexpr size_t WS_WMEM = 18 * MiB;
constexpr size_t WS_MEMB = 20 * MiB;
constexpr size_t WS_MEMKV = 36 * MiB;
constexpr size_t WS_CKVN = 52 * MiB;
constexpr size_t WS_MASK = 68 * MiB;
constexpr size_t WS_H = 84 * MiB;
constexpr size_t WS_MIX = WS_H;
constexpr size_t WS_PROJ = 212 * MiB;
constexpr size_t WS_Y = WS_PROJ;
constexpr size_t WS_END = 628 * MiB;
constexpr int LDS_BYTES = 135168;
constexpr int NWAVES = 8;

__device__ __forceinline__ float bf2f(bf16_t v) { return __uint_as_float(((unsigned)v) << 16); }
__device__ __forceinline__ unsigned f2bf(float f) { unsigned u = __float_as_uint(f); u += 0x7fffu + ((u >> 16) & 1u); return u >> 16; }
__device__ __forceinline__ unsigned pk2(float lo, float hi) { return f2bf(lo) | (f2bf(hi) << 16); }
#define WAVE_SYNC() do { asm volatile("s_waitcnt lgkmcnt(0)" ::: "memory"); __builtin_amdgcn_wave_barrier(); } while (0)
__device__ __forceinline__ float wave_sum(float v) {
#pragma unroll
    for (int o = 1; o < 64; o <<= 1) v += __shfl_xor(v, o);
    return v;
}

__device__ const unsigned char T5TAB[128] = {0, 1, 2, 3, 4, 5, 6, 7, 8, 9, 10, 11, 12, 13, 14, 15, 16, 16, 16, 17, 17, 18, 18, 18, 19, 19, 19, 20, 20, 20, 20, 21, 21, 21, 21, 22, 22, 22, 22, 22, 23, 23, 23, 23, 23, 23, 24, 24, 24, 24, 24, 24, 25, 25, 25, 25, 25, 25, 25, 26, 26, 26, 26, 26, 26, 26, 26, 27, 27, 27, 27, 27, 27, 27, 27, 27, 27, 28, 28, 28, 28, 28, 28, 28, 28, 28, 28, 29, 29, 29, 29, 29, 29, 29, 29, 29, 29, 29, 29, 30, 30, 30, 30, 30, 30, 30, 30, 30, 30, 30, 30, 30, 30, 31, 31, 31, 31, 31, 31, 31, 31, 31, 31, 31, 31, 31, 31, 31};

struct Args { const float* in[11]; float* out; unsigned char* ws; int ph_lo, ph_hi; };

__device__ __forceinline__ void p0_transpose_item(const float* W, int K, int N, int Npad, bf16_t* WT, const float* g, LAS float* scr, int item, int lane) {
    const int nblk = Npad / 32, kb = item / nblk, nb = item % nblk, k0 = 64 * kb, n0 = 32 * nb;
    const int nn = n0 + (lane & 31);
#pragma unroll 8
    for (int i = 0; i < 32; ++i) { const int kk = 2 * i + (lane >> 5); float v = (nn < N) ? W[(size_t)(k0 + kk) * N + nn] : 0.f; if (g) v *= g[k0 + kk]; scr[kk * 33 + (lane & 31)] = v; }
    WAVE_SYNC();
    const int c = lane & 7;
#pragma unroll
    for (int j = 0; j < 4; ++j) { const int n = (lane >> 3) + 8 * j; const LAS float* s = scr + (8 * c) * 33 + n;
        v4u o; o.x = pk2(s[0 * 33], s[1 * 33]); o.y = pk2(s[2 * 33], s[3 * 33]); o.z = pk2(s[4 * 33], s[5 * 33]); o.w = pk2(s[6 * 33], s[7 * 33]);
        *(v4u*)(WT + (size_t)(n0 + n) * K + k0 + 8 * c) = o; }
    WAVE_SYNC();
}
template <bool NORM> __device__ __forceinline__ void row_to_bf16(const float* xrow, bf16_t* orow, int lane) {
    const f32x4* xr = (const f32x4*)xrow + lane;
    f32x4 v[4]; float s = 0.f;
#pragma unroll
    for (int j = 0; j < 4; ++j) { v[j] = xr[64 * j]; s += (v[j].x * v[j].x + v[j].y * v[j].y) + (v[j].z * v[j].z + v[j].w * v[j].w); }
    float r = 1.f;
    if (NORM) r = 1.0f / sqrtf(wave_sum(s) * (1.f / DM) + EPS);
    v2u* o8 = (v2u*)orow + lane;
#pragma unroll
    for (int j = 0; j < 4; ++j) { v2u w; w.x = pk2(v[j].x * r, v[j].y * r); w.y = pk2(v[j].z * r, v[j].w * r); o8[64 * j] = w; }
}

__device__ __forceinline__ void ckvnorm4(const bf16_t* PROJ, const float* kvg, bf16_t* CKVN, int row0, int lane) {
    const int row = row0 + (lane >> 4), c8 = (lane & 15) * 8;
    const v4u v = *(const v4u*)(PROJ + (size_t)row * LDP + C_CKV + c8);
    float f[8] = {__uint_as_float(v.x << 16), __uint_as_float(v.x & 0xffff0000u), __uint_as_float(v.y << 16), __uint_as_float(v.y & 0xffff0000u),
                  __uint_as_float(v.z << 16), __uint_as_float(v.z & 0xffff0000u), __uint_as_float(v.w << 16), __uint_as_float(v.w & 0xffff0000u)};
    float s = 0.f;
#pragma unroll
    for (int j = 0; j < 8; ++j) s += f[j] * f[j];
    s += __shfl_xor(s, 1); s += __shfl_xor(s, 2); s += __shfl_xor(s, 4); s += __shfl_xor(s, 8);
    const float r = 1.0f / sqrtf(s * (1.0f / 128.f) + EPS);
    const f32x4 g0 = *(const f32x4*)(kvg + c8), g1 = *(const f32x4*)(kvg + c8 + 4);
    v4u o; o.x = pk2(f[0] * r * g0.x, f[1] * r * g0.y); o.y = pk2(f[2] * r * g0.z, f[3] * r * g0.w); o.z = pk2(f[4] * r * g1.x, f[5] * r * g1.y); o.w = pk2(f[6] * r * g1.z, f[7] * r * g1.w);
    *(v4u*)(CKVN + (size_t)row * 128 + c8) = o;
}
__device__ __forceinline__ unsigned ordkey(float f) { unsigned u = __float_as_uint(f); return (u & 0x80000000u) ? ~u : (u | 0x80000000u); }
__device__ __forceinline__ void post_row(const float* xin, const bf16_t* Y, const float* g, float* xout, bf16_t* Hn, int row, int lane) {
    const bf16_t* yp = Y + (size_t)row * DM;
    float yv[16]; float s = 0.f;
#pragma unroll
    for (int j = 0; j < 4; ++j) {
        const v2u v = *(const v2u*)(yp + (lane + 64 * j) * 4);
        yv[4 * j + 0] = __uint_as_float(v.x << 16); yv[4 * j + 1] = __uint_as_float(v.x & 0xffff0000u);
        yv[4 * j + 2] = __uint_as_float(v.y << 16); yv[4 * j + 3] = __uint_as_float(v.y & 0xffff0000u);
        s += yv[4 * j] * yv[4 * j] + yv[4 * j + 1] * yv[4 * j + 1] + yv[4 * j + 2] * yv[4 * j + 2] + yv[4 * j + 3] * yv[4 * j + 3];
    }
    const float r = 1.0f / sqrtf(wave_sum(s) * (1.0f / DM) + EPS);
    f32x4 ov[4]; float s2 = 0.f;
#pragma unroll
    for (int j = 0; j < 4; ++j) {
        const int c = (lane + 64 * j) * 4;
        const f32x4 xv = *(const f32x4*)(xin + (size_t)row * DM + c);
        const f32x4 gv = *(const f32x4*)(g + c);
        ov[j].x = xv.x + yv[4 * j] * r * gv.x; ov[j].y = xv.y + yv[4 * j + 1] * r * gv.y; ov[j].z = xv.z + yv[4 * j + 2] * r * gv.z; ov[j].w = xv.w + yv[4 * j + 3] * r * gv.w;
        *(f32x4*)(xout + (size_t)row * DM + c) = ov[j];
        s2 += (ov[j].x * ov[j].x + ov[j].y * ov[j].y) + (ov[j].z * ov[j].z + ov[j].w * ov[j].w);
    }
    if (Hn) {
        const float r2 = 1.0f / sqrtf(wave_sum(s2) * (1.f / DM) + EPS);
        v2u* o8 = (v2u*)(Hn + (size_t)row * DM) + lane;
#pragma unroll
        for (int j = 0; j < 4; ++j) { v2u w; w.x = pk2(ov[j].x * r2, ov[j].y * r2); w.y = pk2(ov[j].z * r2, ov[j].w * r2); o8[64 * j] = w; }
    }
}

typedef short bf16x8 __attribute__((ext_vector_type(8)));
typedef short s16x4 __attribute__((ext_vector_type(4)));
typedef float f32x16 __attribute__((ext_vector_type(16)));
typedef float f32x2_t __attribute__((ext_vector_type(2)));
typedef __bf16 bf16x2_t __attribute__((ext_vector_type(2)));
#define MFMA32(a, b, c) __builtin_amdgcn_mfma_f32_32x32x16_bf16((a), (b), (c), 0, 0, 0)
__device__ __forceinline__ unsigned cvtpk(float lo, float hi) { f32x2_t v = {lo, hi}; bf16x2_t b = __builtin_convertvector(v, bf16x2_t); return __builtin_bit_cast(unsigned, b); }
__device__ __forceinline__ s16x4 vtr(const LAS unsigned char* p) { return __builtin_bit_cast(s16x4, __builtin_amdgcn_ds_read_tr16_b64_v4i16((LAS s16x4*)p)); }
__device__ __forceinline__ int crow(int r, int hi) { return (r & 3) + 8 * (r >> 2) + 4 * hi; }
__device__ __forceinline__ bf16x8 pack8(const f32x16& x, int s) {
    v4u p; p.x = cvtpk(x[8 * s + 0], x[8 * s + 1]); p.y = cvtpk(x[8 * s + 2], x[8 * s + 3]); p.z = cvtpk(x[8 * s + 4], x[8 * s + 5]); p.w = cvtpk(x[8 * s + 6], x[8 * s + 7]);
    return __builtin_bit_cast(bf16x8, p);
}
__device__ __forceinline__ f32x16 zero16() { float z; asm volatile("v_mov_b32 %0, 0" : "=v"(z)); return (f32x16){z, z, z, z, z, z, z, z, z, z, z, z, z, z, z, z}; }
__device__ __forceinline__ bf16x8 cat44(s16x4 lo, s16x4 hi) { return __builtin_shufflevector(lo, hi, 0, 1, 2, 3, 4, 5, 6, 7); }
__device__ __forceinline__ float xhalf_max(float v) { auto rr = __builtin_amdgcn_permlane32_swap(__float_as_uint(v), __float_as_uint(v), false, false); return fmaxf(__uint_as_float(rr[0]), __uint_as_float(rr[1])); }
__device__ __forceinline__ float xhalf_sum(float v) { auto rr = __builtin_amdgcn_permlane32_swap(__float_as_uint(v), __float_as_uint(v), false, false); return __uint_as_float(rr[0]) + __uint_as_float(rr[1]); }
__device__ __forceinline__ unsigned xhalf_other_u(unsigned v, int hi) { auto rr = __builtin_amdgcn_permlane32_swap(v, v, false, false); return hi ? rr[0] : rr[1]; }
__device__ __forceinline__ float xhalf_other(float v, int hi) { return __uint_as_float(xhalf_other_u(__float_as_uint(v), hi)); }
constexpr int VT_PITCH = 192;
constexpr float LOG2E = 1.4426950408889634f;

__device__ __forceinline__ void pv_tile(f32x16 (&O)[2], const LAS unsigned char* vrd, bf16x8 p0, bf16x8 p1) {
#pragma unroll
    for (int c = 0; c < 2; ++c) {
        const bf16x8 a0 = cat44(vtr(vrd + 0 * VT_PITCH + 64 * c), vtr(vrd + 8 * VT_PITCH + 64 * c));
        const bf16x8 a1 = cat44(vtr(vrd + 16 * VT_PITCH + 64 * c), vtr(vrd + 24 * VT_PITCH + 64 * c));
        O[c] = MFMA32(a0, p0, O[c]);
        O[c] = MFMA32(a1, p1, O[c]);
    }
}
__device__ __forceinline__ void gate_store(const f32x16 (&O)[2], float scale, const bf16_t* grow, bf16_t* orow, int hi) {
#pragma unroll
    for (int c = 0; c < 2; ++c)
#pragma unroll
        for (int g = 0; g < 4; ++g) {
            const int d = 32 * c + 8 * g + 4 * hi;
            const v2u gv = *(const v2u*)(grow + d);
            float gt[4] = {__uint_as_float(gv.x << 16), __uint_as_float(gv.x & 0xffff0000u), __uint_as_float(gv.y << 16), __uint_as_float(gv.y & 0xffff0000u)};
            float ov[4];
#pragma unroll
            for (int j = 0; j < 4; ++j) ov[j] = O[c][4 * g + j] * scale * gt[j] * __builtin_amdgcn_rcpf(1.f + __builtin_amdgcn_exp2f(-gt[j] * LOG2E));
            v2u w; w.x = cvtpk(ov[0], ov[1]); w.y = cvtpk(ov[2], ov[3]);
            *(v2u*)(orow + d) = w;
        }
}

__device__ __forceinline__ void gate_load(v2u (&gw)[8], const bf16_t* grow, int hi) {
#pragma unroll
    for (int c = 0; c < 2; ++c)
#pragma unroll
        for (int g = 0; g < 4; ++g) gw[c * 4 + g] = *(const v2u*)(grow + 32 * c + 8 * g + 4 * hi);
}
__device__ __forceinline__ void gate_store_pre(const f32x16 (&O)[2], float scale, const v2u (&gw)[8], bf16_t* orow, int hi) {
#pragma unroll
    for (int c = 0; c < 2; ++c)
#pragma unroll
        for (int g = 0; g < 4; ++g) {
            const int d = 32 * c + 8 * g + 4 * hi;
            const v2u gv = gw[c * 4 + g];
            float gt[4] = {__uint_as_float(gv.x << 16), __uint_as_float(gv.x & 0xffff0000u), __uint_as_float(gv.y << 16), __uint_as_float(gv.y & 0xffff0000u)};
            float ov[4];
#pragma unroll
            for (int j = 0; j < 4; ++j) ov[j] = O[c][4 * g + j] * scale * gt[j] * __builtin_amdgcn_rcpf(1.f + __builtin_amdgcn_exp2f(-gt[j] * LOG2E));
            v2u w; w.x = cvtpk(ov[0], ov[1]); w.y = cvtpk(ov[2], ov[3]);
            *(v2u*)(orow + d) = w;
        }
}

__device__ __forceinline__ void sb_item(const bf16_t* PROJ, bf16_t* MIX, int b, int h, int qt, int lane, LAS unsigned char* wl) {
    asm volatile("" : "+v"(lane));
    const int r32 = lane & 31, hi = lane >> 5;
    const bf16_t* base = PROJ + (size_t)b * SEQ * LDP;
    const int t = 32 * qt + r32;
    bf16x8 qf[4];
#pragma unroll
    for (int ks = 0; ks < 4; ++ks) qf[ks] = *(const bf16x8*)(base + (size_t)t * LDP + C_SBQ + h * 64 + 16 * ks + 8 * hi);
    v2u gw[8]; gate_load(gw, base + (size_t)t * LDP + C_SBG + h * 64, hi);
    const int vrow = lane >> 3, vch = lane & 7;
    LAS unsigned char* vwr = wl + vrow * VT_PITCH + vch * 16;
    const LAS unsigned char* vrd = wl + (4 * hi + ((lane & 15) >> 2)) * VT_PITCH + (16 * ((lane >> 4) & 1) + 4 * (lane & 3)) * 2;
    bf16x8 kc[4], vc[4];
    {
        const bf16_t* kp = base + (size_t)(32 * qt + r32) * LDP + C_SBK + h * 64 + 8 * hi;
#pragma unroll
        for (int ks = 0; ks < 4; ++ks) kc[ks] = *(const bf16x8*)(kp + 16 * ks);
        const bf16_t* vp = base + (size_t)(32 * qt + vrow) * LDP + C_SBV + h * 64 + 8 * vch;
#pragma unroll
        for (int i = 0; i < 4; ++i) vc[i] = *(const bf16x8*)(vp + (size_t)(8 * i) * LDP);
    }
    f32x16 O[2];
#pragma unroll
    for (int r = 0; r < 16; ++r) { O[0][r] = 0.f; O[1][r] = 0.f; }
    float R = 1.f;
    for (int kt = qt; kt >= 0; --kt) {
        bf16x8 kn[4], vn[4];
        {
            const int ktn = kt > 0 ? kt - 1 : 0;
            const bf16_t* kp = base + (size_t)(32 * ktn + r32) * LDP + C_SBK + h * 64 + 8 * hi;
#pragma unroll
            for (int ks = 0; ks < 4; ++ks) kn[ks] = *(const bf16x8*)(kp + 16 * ks);
            const bf16_t* vp = base + (size_t)(32 * ktn + vrow) * LDP + C_SBV + h * 64 + 8 * vch;
#pragma unroll
            for (int i = 0; i < 4; ++i) vn[i] = *(const bf16x8*)(vp + (size_t)(8 * i) * LDP);
        }
        f32x16 acc;
#pragma unroll
        for (int r = 0; r < 16; ++r) acc[r] = 0.f;
#pragma unroll
        for (int ks = 0; ks < 4; ++ks) acc = MFMA32(kc[ks], qf[ks], acc);
#pragma unroll
        for (int i = 0; i < 4; ++i) *(LAS bf16x8*)(vwr + (8 * i) * VT_PITCH) = vc[i];
        float be[16], om[16];
        const bool diag = (kt == qt);
#pragma unroll
        for (int r = 0; r < 16; ++r) {
            const float e = __builtin_amdgcn_exp2f(fminf(acc[r] * (-0.125f * LOG2E), 115.f));
            float bt = __builtin_amdgcn_rcpf(1.f + e), o1 = e * bt;
            if (diag && !(crow(r, hi) < r32)) { bt = 0.f; o1 = 1.f; }
            be[r] = bt; om[r] = o1;
        }
        float Gp[4], Gq[4];
#pragma unroll
        for (int g = 0; g < 4; ++g) { Gp[g] = (om[4 * g] * om[4 * g + 1]) * (om[4 * g + 2] * om[4 * g + 3]); Gq[g] = xhalf_other(Gp[g], hi); }
        const float T1 = Gp[1] * Gq[1], T2 = Gp[2] * Gq[2], T3 = Gp[3] * Gq[3], T0 = Gp[0] * Gq[0];
        float tail[4]; tail[3] = R; tail[2] = R * T3; tail[1] = tail[2] * T2; tail[0] = tail[1] * T1;
        const float Rn = tail[0] * T0;
#pragma unroll
        for (int g = 0; g < 4; ++g) {
            float sfx = tail[g] * (hi == 0 ? Gq[g] : 1.f);
            acc[4 * g + 3] = be[4 * g + 3] * sfx; sfx *= om[4 * g + 3];
            acc[4 * g + 2] = be[4 * g + 2] * sfx; sfx *= om[4 * g + 2];
            acc[4 * g + 1] = be[4 * g + 1] * sfx; sfx *= om[4 * g + 1];
            acc[4 * g + 0] = be[4 * g + 0] * sfx;
        }
        R = Rn;
        const bf16x8 p0 = pack8(acc, 0), p1 = pack8(acc, 1);
        pv_tile(O, vrd, p0, p1);
        if (__all(R < 7.8886e-31f)) break;
#pragma unroll
        for (int i = 0; i < 4; ++i) { kc[i] = kn[i]; vc[i] = vn[i]; }
    }
    gate_store_pre(O, 1.f, gw, MIX + ((size_t)b * SEQ + t) * DM + h * 64, hi);
}

__device__ __forceinline__ void mem_item(const bf16_t* PROJ, const bf16_t* KV, bf16_t* MIX, int b, int h, int qt, int lane, LAS unsigned char* wl) {
    asm volatile("" : "+v"(lane));
    float NINF; asm volatile("v_mov_b32 %0, 0xff800000" : "=v"(NINF));
    const int r32 = lane & 31, hi = lane >> 5;
    const int t = 32 * qt + r32;
    const bf16_t* prow = PROJ + ((size_t)b * SEQ + t) * LDP;
    bf16x8 qf[4];
#pragma unroll
    for (int ks = 0; ks < 4; ++ks) qf[ks] = *(const bf16x8*)(prow + C_MQ + h * 64 + 16 * ks + 8 * hi);
    const int vrow = lane >> 3, vch = lane & 7;
    LAS unsigned char* vwr = wl + vrow * VT_PITCH + vch * 16;
    const LAS unsigned char* vrd = wl + (4 * hi + ((lane & 15) >> 2)) * VT_PITCH + (16 * ((lane >> 4) & 1) + 4 * (lane & 3)) * 2;
    const bf16_t* kvb = KV + (size_t)b * NMEM * 1024 + h * 64;
    f32x16 O[2];
#pragma unroll
    for (int r = 0; r < 16; ++r) { O[0][r] = 0.f; O[1][r] = 0.f; }
    float mrun = NINF, lrun = 0.f;
    v2u gw[8]; gate_load(gw, prow + C_MG + h * 64, hi);
    bf16x8 kc[4], vc[4];
    {
        const bf16_t* kp = kvb + (size_t)r32 * 1024 + 8 * hi;
#pragma unroll
        for (int ks = 0; ks < 4; ++ks) kc[ks] = *(const bf16x8*)(kp + 16 * ks);
        const bf16_t* vp = kvb + (size_t)vrow * 1024 + 256 + 8 * vch;
#pragma unroll
        for (int i = 0; i < 4; ++i) vc[i] = *(const bf16x8*)(vp + (size_t)(8 * i) * 1024);
    }
    for (int kt = 0; kt < NMEM / 32; ++kt) {
        bf16x8 kn[4], vn[4];
        {
            const int ktn = kt < NMEM / 32 - 1 ? kt + 1 : kt;
            const bf16_t* kp = kvb + (size_t)(32 * ktn + r32) * 1024 + 8 * hi;
#pragma unroll
            for (int ks = 0; ks < 4; ++ks) kn[ks] = *(const bf16x8*)(kp + 16 * ks);
            const bf16_t* vp = kvb + (size_t)(32 * ktn + vrow) * 1024 + 256 + 8 * vch;
#pragma unroll
            for (int i = 0; i < 4; ++i) vn[i] = *(const bf16x8*)(vp + (size_t)(8 * i) * 1024);
        }
        f32x16 acc;
#pragma unroll
        for (int r = 0; r < 16; ++r) acc[r] = 0.f;
#pragma unroll
        for (int ks = 0; ks < 4; ++ks) acc = MFMA32(kc[ks], qf[ks], acc);
#pragma unroll
        for (int i = 0; i < 4; ++i) *(LAS bf16x8*)(vwr + (8 * i) * VT_PITCH) = vc[i];
        float mx = acc[0];
#pragma unroll
        for (int r = 1; r < 16; ++r) mx = fmaxf(mx, acc[r]);
        mx *= 0.125f * LOG2E;
        mx = xhalf_max(mx);
        const float mn = fmaxf(mrun, mx), alpha = __builtin_amdgcn_exp2f(mrun - mn);
        float ps = 0.f;
#pragma unroll
        for (int r = 0; r < 16; ++r) { acc[r] = __builtin_amdgcn_exp2f(acc[r] * (0.125f * LOG2E) - mn); ps += acc[r]; }
        lrun = lrun * alpha + ps; mrun = mn;
#pragma unroll
        for (int r = 0; r < 16; ++r) { O[0][r] *= alpha; O[1][r] *= alpha; }
        const bf16x8 p0 = pack8(acc, 0), p1 = pack8(acc, 1);
        pv_tile(O, vrd, p0, p1);
#pragma unroll
        for (int i = 0; i < 4; ++i) { kc[i] = kn[i]; vc[i] = vn[i]; }
    }
    const float lt = xhalf_sum(lrun);
    gate_store_pre(O, 1.f / lt, gw, MIX + ((size_t)b * SEQ + t) * DM + 768 + h * 64, hi);
}

constexpr int MEML_V_OFF = 32768;
__device__ __forceinline__ void mem_stage(const bf16_t* KV, int b, int h, int tid, LAS unsigned char* L) {
    const bf16_t* kvb = KV + (size_t)b * NMEM * 1024 + h * 64;
#pragma unroll
    for (int i = 0; i < 4; ++i) {
        const int idx = tid + 512 * i, key = idx >> 3, ch = idx & 7;
        const v4u kx = *(const v4u*)(kvb + (size_t)key * 1024 + 8 * ch), vx = *(const v4u*)(kvb + (size_t)key * 1024 + 256 + 8 * ch);
        *(LAS v4u*)(L + 128 * key + 16 * (ch ^ ((key >> 1) & 7))) = kx;
        *(LAS v4u*)(L + MEML_V_OFF + (key >> 5) * (32 * VT_PITCH) + (key & 31) * VT_PITCH + 16 * ch) = vx;
    }
}
__device__ __forceinline__ void mem_item_lds(const bf16_t* PROJ, bf16_t* MIX, int b, int h, int qt, int lane, const LAS unsigned char* L) {
    asm volatile("" : "+v"(lane));
    float NINF; asm volatile("v_mov_b32 %0, 0xff800000" : "=v"(NINF));
    const int r32 = lane & 31, hi = lane >> 5;
    const int t = 32 * qt + r32;
    const bf16_t* prow = PROJ + ((size_t)b * SEQ + t) * LDP;
    bf16x8 qf[4];
#pragma unroll
    for (int ks = 0; ks < 4; ++ks) qf[ks] = *(const bf16x8*)(prow + C_MQ + h * 64 + 16 * ks + 8 * hi);
    v2u gw[8]; gate_load(gw, prow + C_MG + h * 64, hi);
    const unsigned kx = ((unsigned)r32 >> 1) & 7u;
    const LAS unsigned char* krd = L + 128 * r32;
    const LAS unsigned char* vrd = L + MEML_V_OFF + (4 * hi + ((lane & 15) >> 2)) * VT_PITCH + (16 * ((lane >> 4) & 1) + 4 * (lane & 3)) * 2;
    f32x16 O[2];
    O[0] = zero16(); O[1] = zero16();
    float mrun = NINF, lrun = 0.f;
#pragma unroll 2
    for (int kt = 0; kt < NMEM / 32; ++kt) {
        bf16x8 kc[4];
#pragma unroll
        for (int ks = 0; ks < 4; ++ks) kc[ks] = *(const LAS bf16x8*)(krd + 4096 * kt + 16 * ((unsigned)(2 * ks + hi) ^ kx));
        f32x16 acc = MFMA32(kc[0], qf[0], zero16());
#pragma unroll
        for (int ks = 1; ks < 4; ++ks) acc = MFMA32(kc[ks], qf[ks], acc);
        float mx = acc[0];
#pragma unroll
        for (int r = 1; r < 16; ++r) mx = fmaxf(mx, acc[r]);
        mx *= 0.125f * LOG2E;
        mx = xhalf_max(mx);
        const float mn = fmaxf(mrun, mx), alpha = __builtin_amdgcn_exp2f(mrun - mn);
        float ps = 0.f;
#pragma unroll
        for (int r = 0; r < 16; ++r) { acc[r] = __builtin_amdgcn_exp2f(acc[r] * (0.125f * LOG2E) - mn); ps += acc[r]; }
        lrun = lrun * alpha + ps; mrun = mn;
#pragma unroll
        for (int r = 0; r < 16; ++r) { O[0][r] *= alpha; O[1][r] *= alpha; }
        const bf16x8 p0 = pack8(acc, 0), p1 = pack8(acc, 1);
        pv_tile(O, vrd + kt * (32 * VT_PITCH), p0, p1);
    }
    const float lt = xhalf_sum(lrun);
    gate_store_pre(O, 1.f / lt, gw, MIX + ((size_t)b * SEQ + t) * DM + 768 + h * 64, hi);
}

constexpr int SEL_IQ_PITCH = 528, SEL_CNT_OFF = 17408;
__device__ __forceinline__ unsigned ordkey(float f);
template <int PRED  >
__device__ __forceinline__ unsigned sel_count_round(const unsigned (&key)[8][16], unsigned c, unsigned tau, int idx0, int r32, int hi, int wave, LAS unsigned* cb) {
    int n = 0;
#pragma unroll
    for (int i = 0; i < 8; ++i) {
#pragma unroll
        for (int r = 0; r < 16; ++r) {
            if (PRED == 0) n += (key[i][r] >= c) ? 1 : 0;
            else if (PRED == 1) n += (key[i][r] > c) ? 1 : 0;
            else n += (key[i][r] == tau && (unsigned)(idx0 + 256 * i + (r & 3) + 8 * (r >> 2)) <= c) ? 1 : 0;
            if ((r & 7) == 7) asm volatile("" : "+v"(n));
        }
    }
    n += __shfl_xor(n, 32);
    if (hi == 0) cb[wave * 32 + r32] = (unsigned)n;
    __syncthreads();
    unsigned tot = 0;
#pragma unroll
    for (int w = 0; w < 8; ++w) tot += cb[w * 32 + r32];
    return tot;
}
constexpr int SEL_CAP = 64, SEL_DONE = 16;
__device__ __forceinline__ float key2f(unsigned k) { return __uint_as_float((k & 0x80000000u) ? (k & 0x7fffffffu) : ~k); }
__device__ __forceinline__ unsigned sel_count_lane(const unsigned (&key)[8][16], unsigned c) {
    int n = 0;
#pragma unroll
    for (int i = 0; i < 8; ++i) {
#pragma unroll
        for (int r = 0; r < 16; ++r) {
            n += (key[i][r] >= c) ? 1 : 0;
            if ((r & 7) == 7) asm volatile("" : "+v"(n));
        }
    }
    return (unsigned)n;
}
__device__ __forceinline__ unsigned sel_exchange(unsigned nl, int r32, int hi, int wave, LAS unsigned* cb) {
    const unsigned n2 = nl + xhalf_other_u(nl, hi);
    if (hi == 0) cb[wave * 32 + r32] = n2;
    __syncthreads();
    unsigned tot = 0;
#pragma unroll
    for (int w = 0; w < 8; ++w) tot += cb[w * 32 + r32];
    return tot;
}
__device__ __forceinline__ void sel_item2(const bf16_t* PROJ, unsigned* MASK, int b, int qt, int lane, int wave, LAS unsigned char* L) {
    asm volatile("" : "+v"(lane));
    const int r32 = lane & 31, hi = lane >> 5, tid = wave * 64 + lane;
    LAS unsigned* cntb = (LAS unsigned*)(L + SEL_CNT_OFF);
    const bf16_t* base = PROJ + (size_t)b * SEQ * LDP;
    unsigned* mrow = MASK + (((size_t)b * 64 + qt) * 64) * 32;
    if (qt < 8) {
#pragma unroll
        for (int i = 0; i < 8; ++i) {
            const int kt = wave + 8 * i;
            if (kt <= qt) {
                unsigned bits = 0u;
#pragma unroll
                for (int r = 0; r < 16; ++r) bits |= ((kt < qt) || (crow(r, hi) <= r32)) ? (1u << r) : 0u;
                const unsigned other = xhalf_other_u(bits, hi);
                if (hi == 0) mrow[kt * 32 + r32] = bits | (other << 16);
            }
        }
        return;
    }
    for (int n = tid; n < 1024; n += 512) { const int row = n >> 5, ch = n & 31;
        const v4u v = *(const v4u*)(base + (size_t)(32 * qt + row) * LDP + C_IDQ + ch * 8);
        *(LAS v4u*)(L + row * SEL_IQ_PITCH + ch * 16) = v; }
    float w8[8];
    { const v4u wv = *(const v4u*)(base + (size_t)(32 * qt + r32) * LDP + C_IDW);
      w8[0] = __uint_as_float(wv.x << 16) * 0.0625f; w8[1] = __uint_as_float(wv.x & 0xffff0000u) * 0.0625f; w8[2] = __uint_as_float(wv.y << 16) * 0.0625f; w8[3] = __uint_as_float(wv.y & 0xffff0000u) * 0.0625f;
      w8[4] = __uint_as_float(wv.z << 16) * 0.0625f; w8[5] = __uint_as_float(wv.z & 0xffff0000u) * 0.0625f; w8[6] = __uint_as_float(wv.w << 16) * 0.0625f; w8[7] = __uint_as_float(wv.w & 0xffff0000u) * 0.0625f; }
    __syncthreads();
    unsigned key[8][16];
    const LAS unsigned char* iqp = L + r32 * SEL_IQ_PITCH + 16 * hi;
    unsigned kmn = 0xffffffffu, kmx = 0u;
#pragma unroll
    for (int i = 0; i < 8; ++i) {
        const int kt = wave + 8 * i;
        if (kt <= qt) {
            const bf16_t* kp = base + (size_t)(32 * kt + r32) * LDP + C_IDK + 8 * hi;
            const bf16x8 k0 = *(const bf16x8*)kp, k1 = *(const bf16x8*)(kp + 16);
            float sc[16];
#pragma unroll
            for (int r = 0; r < 16; ++r) sc[r] = 0.f;
            unsigned iqo = 0; asm volatile("" : "+v"(iqo));
            const LAS unsigned char* iqt = iqp + iqo;
#pragma unroll
            for (int hp = 0; hp < 4; ++hp) {
                const int h = 2 * hp;
                bf16x8 q0 = *(const LAS bf16x8*)(iqt + h * 64), q1 = *(const LAS bf16x8*)(iqt + h * 64 + 32);
                bf16x8 q2 = *(const LAS bf16x8*)(iqt + h * 64 + 64), q3 = *(const LAS bf16x8*)(iqt + h * 64 + 96);
                asm volatile("" : "+v"(q0), "+v"(q1), "+v"(q2), "+v"(q3) : "v"(sc[15]));
                f32x16 Da = MFMA32(k0, q0, zero16());
                f32x16 Db = MFMA32(k0, q2, zero16());
                Da = MFMA32(k1, q1, Da);
                Db = MFMA32(k1, q3, Db);
#pragma unroll
                for (int r = 0; r < 16; ++r) sc[r] += w8[h] * fmaxf(Da[r], 0.f);
#pragma unroll
                for (int r = 0; r < 16; ++r) sc[r] += w8[h + 1] * fmaxf(Db[r], 0.f);
                asm volatile("" : "+v"(sc[0]), "+v"(sc[1]), "+v"(sc[2]), "+v"(sc[3]), "+v"(sc[4]), "+v"(sc[5]), "+v"(sc[6]), "+v"(sc[7]),
                                  "+v"(sc[8]), "+v"(sc[9]), "+v"(sc[10]), "+v"(sc[11]), "+v"(sc[12]), "+v"(sc[13]), "+v"(sc[14]), "+v"(sc[15]));
            }
            int thr = (kt < qt) ? 64 : (r32 - 4 * hi);
            asm volatile("" : "+v"(thr));
#pragma unroll
            for (int r = 0; r < 16; ++r) { const bool v = ((r & 3) + 8 * (r >> 2) <= thr); const unsigned k = ordkey(sc[r]); key[i][r] = v ? k : 0u; kmx = max(kmx, v ? k : 0u); kmn = min(kmn, v ? k : 0xffffffffu); }
        } else {
#pragma unroll
            for (int r = 0; r < 16; ++r) key[i][r] = 0u;
        }
    }
    unsigned lo_key, hi_key, clo, chi = 0u, nlo_l, nhi_l = 0u;
    {
        int nv = 0;
#pragma unroll
        for (int i = 0; i < 8; ++i) { const int kt = wave + 8 * i; nv += (kt < qt) ? 16 : 0; }
        if ((qt & 7) == wave) { const int thr = r32 - 4 * hi;
#pragma unroll
            for (int r = 0; r < 16; ++r) nv += ((r & 3) + 8 * (r >> 2) <= thr) ? 1 : 0; }
        nlo_l = (unsigned)nv;
        kmn = min(kmn, xhalf_other_u(kmn, hi)); kmx = max(kmx, xhalf_other_u(kmx, hi));
        if (hi == 0) { cntb[wave * 32 + r32] = kmn; cntb[256 + wave * 32 + r32] = kmx; }
        __syncthreads();
        unsigned a = 0xffffffffu, bmx = 0u;
#pragma unroll
        for (int w = 0; w < 8; ++w) { a = min(a, cntb[w * 32 + r32]); bmx = max(bmx, cntb[256 + w * 32 + r32]); }
        lo_key = a; hi_key = bmx + 1u; clo = (unsigned)(32 * qt + r32 + 1);
        __syncthreads();
    }
    int round = 0;
    for (;;) {
        const bool done = (clo - chi <= (unsigned)SEL_DONE) || (hi_key - lo_key <= 1u);
        if (__all(done)) break;
        unsigned p;
        if ((round & 3) == 3) p = lo_key + ((hi_key - lo_key) >> 1);
        else p = ordkey(0.5f * key2f(lo_key) + 0.5f * key2f(hi_key));
        p = min(max(p, lo_key + 1u), hi_key - 1u);
        if (done) p = lo_key;
        const unsigned nl = sel_count_lane(key, p);
        const unsigned tot = sel_exchange(nl, r32, hi, wave, cntb + (round & 1) * 256);
        if (!done) { if (tot >= 256u) { lo_key = p; clo = tot; nlo_l = nl; } else { hi_key = p; chi = tot; nhi_l = nl; } }
        ++round;
    }
    unsigned tau, cut;
    const bool many = (clo - chi > (unsigned)SEL_CAP);
    {
        LAS unsigned* lanecnt = (LAS unsigned*)L; LAS unsigned* meta = (LAS unsigned*)(L + 2048); LAS unsigned* result = (LAS unsigned*)(L + 2304); LAS unsigned* list = (LAS unsigned*)(L + 20480);
        const int slot = wave * 2 + hi;
        lanecnt[r32 * 16 + slot] = many ? 0u : (nlo_l - nhi_l);
        if (slot == 0) { meta[2 * r32] = many ? 0u : (clo - chi); meta[2 * r32 + 1] = 256u - chi; }
        __syncthreads();
        unsigned bs = 0u;
#pragma unroll
        for (int s2 = 0; s2 < 16; ++s2) { const unsigned v = lanecnt[r32 * 16 + s2]; bs += (s2 < slot) ? v : 0u; }
        if (!many) {
            const int idx0 = 32 * wave + 4 * hi;
            LAS unsigned* lp = list + (r32 * SEL_CAP + bs) * 2;
#pragma unroll
            for (int i = 0; i < 8; ++i)
#pragma unroll
                for (int r = 0; r < 16; ++r) {
                    const unsigned k = key[i][r];
                    if (k >= lo_key && k < hi_key) { lp[0] = k; lp[1] = (unsigned)(idx0 + 256 * i + (r & 3) + 8 * (r >> 2)); lp += 2; }
                }
        }
        __syncthreads();
        for (int j = 0; j < 4; ++j) {
            const int q = 4 * wave + j;
            const unsigned ncand = (unsigned)__builtin_amdgcn_readfirstlane((int)meta[2 * q]), need = (unsigned)__builtin_amdgcn_readfirstlane((int)meta[2 * q + 1]);
            const LAS unsigned* lq = list + q * SEL_CAP * 2;
            const bool mine = (unsigned)lane < ncand;
            const unsigned kc = mine ? lq[2 * lane] : 0u, ic = mine ? lq[2 * lane + 1] : 0u;
            unsigned rank = 0u;
            for (unsigned c2 = 0; c2 < ncand; ++c2) {
                const unsigned k2 = (unsigned)__builtin_amdgcn_readlane((int)kc, (int)c2), i2 = (unsigned)__builtin_amdgcn_readlane((int)ic, (int)c2);
                rank += (k2 > kc || (k2 == kc && i2 < ic)) ? 1u : 0u;
            }
            if (mine && rank == need - 1u) { result[2 * q] = kc; result[2 * q + 1] = ic; }
        }
        __syncthreads();
        tau = result[2 * r32]; cut = result[2 * r32 + 1];
    }
    if (__any(many)) {
        const unsigned need = 256u - chi;
        const int idx0 = 32 * wave + 4 * hi;
        unsigned lo_ = 0u, hi_ = 2047u;
        for (int it = 0; it < 11; ++it) {
            const unsigned mid = (lo_ + hi_) >> 1;
            const unsigned f = sel_count_round<2>(key, mid, lo_key, idx0, r32, hi, wave, cntb + (it & 1) * 256);
            if (f >= need) hi_ = mid; else lo_ = mid + 1;
        }
        if (many) { tau = lo_key; cut = hi_; }
    }
    {
        const int idx0 = 32 * wave + 4 * hi;
#pragma unroll
        for (int i = 0; i < 8; ++i) {
            const int kt = wave + 8 * i;
            if (kt <= qt) {
                unsigned bits = 0u;
#pragma unroll
                for (int r = 0; r < 16; ++r) {
                    const bool s = (key[i][r] > tau) || (key[i][r] == tau && (unsigned)(idx0 + 256 * i + (r & 3) + 8 * (r >> 2)) <= cut);
                    bits |= s ? (1u << r) : 0u;
                }
                const unsigned other = xhalf_other_u(bits, hi);
                if (hi == 0) mrow[kt * 32 + r32] = bits | (other << 16);
            }
        }
    }
    __syncthreads();
}

constexpr int WS_WUK = 0;
constexpr int WS_WUV = 256 * 1024;
constexpr int DSA_BIAS_OFF = 16384;
__device__ __forceinline__ unsigned dsa_off(unsigned row, unsigned ch) { return 256u * row + 16u * (ch ^ (((row & 3u) << 2) | ((row >> 2) & 3u))); }
constexpr int DSA_NBUF = 6, DSA_MASK_OFF = 49152, DSA_BIAS2_OFF = 114688;
__device__ __forceinline__ void glds16(const void* gsrc, unsigned lds_dst) { unsigned keep;
    asm volatile("s_mov_b32 %0, m0\n\ts_mov_b32 m0, %2\n\ts_nop 0\n\tglobal_load_lds_dwordx4 %1, off\n\ts_mov_b32 m0, %0" : "=&s"(keep) : "v"(gsrc), "s"(lds_dst) : "memory"); }
__device__ __forceinline__ void dsa_round(const bf16_t* PROJ, const bf16_t* CKVN, const unsigned* MASK, const bf16_t* WUKp  , const bf16_t* WUVp  ,
                                          const float* rel_bias, bf16_t* MIX, int b, int o, int h, int lane, int wave, LAS unsigned char* L) {
    asm volatile("" : "+v"(lane));
    float NINF; asm volatile("v_mov_b32 %0, 0xff800000" : "=v"(NINF));
    const int r32 = lane & 31, hi = lane >> 5, tid = wave * 64 + lane;
    const int qt = 8 * o + wave, KT = 8 * o + 7, t = 32 * qt + r32;
    LAS float* biasT = (LAS float*)(L + DSA_BIAS2_OFF);
    if (tid < 192) { const int bk = tid < 128 ? (int)T5TAB[tid] : 31; biasT[tid] = rel_bias[bk * 6 + h] * LOG2E; }
    const float bias31 = rel_bias[31 * 6 + h] * LOG2E;
    bf16x8 qlf[8];
    {
        const bf16_t* qrow = PROJ + ((size_t)b * SEQ + t) * LDP + C_DSQ + h * 64 + 8 * hi;
        bf16x8 qf[4];
#pragma unroll
        for (int ks = 0; ks < 4; ++ks) qf[ks] = *(const bf16x8*)(qrow + 16 * ks);
#pragma unroll
        for (int rt = 0; rt < 4; ++rt) {
            f32x16 X;
#pragma unroll
            for (int r = 0; r < 16; ++r) X[r] = 0.f;
            const GAS bf16_t* wp = (const GAS bf16_t*)WUKp + (rt * 32 + r32) * 64 + 8 * hi;
#pragma unroll
            for (int ks = 0; ks < 4; ++ks) X = MFMA32(*(const GAS bf16x8*)(wp + 16 * ks), qf[ks], X);
#pragma unroll
            for (int r = 0; r < 16; ++r) X[r] *= 0.125f * LOG2E;
            qlf[2 * rt] = pack8(X, 0); qlf[2 * rt + 1] = pack8(X, 1);
        }
    }
    f32x16 O[4];
#pragma unroll
    for (int c = 0; c < 4; ++c)
#pragma unroll
        for (int r = 0; r < 16; ++r) O[c][r] = 0.f;
    float mref = NINF, lrun = 0.f;
    const int srow = 8 * (wave >> 1) + ((lane >> 2) & 7);
    const int sch = 4 * (2 * (wave & 1) + (lane >> 5)) + ((lane & 3) ^ ((2 * (wave >> 1) + ((lane >> 4) & 1)) & 3));
    const bf16_t* csrc = CKVN + ((size_t)b * SEQ + srow) * 128 + 8 * sch;
    const unsigned ring0 = (unsigned)__builtin_amdgcn_readfirstlane((int)(unsigned)(size_t)L) + 1024u * (unsigned)wave;
    const unsigned x2 = ((unsigned)r32 >> 2) & 3u;
    const unsigned rb_e = 2048u * ((unsigned)r32 >> 3) + 64u * ((unsigned)r32 & 7u) + 16u * ((unsigned)hi ^ x2);
    const unsigned rb_o = 2048u * ((unsigned)r32 >> 3) + 64u * ((unsigned)r32 & 7u) + 16u * ((2u + (unsigned)hi) ^ x2);
    const unsigned tq = (lane & 15) >> 2, tp = lane & 3, tblk = (lane >> 4) & 1;
    const unsigned tb0 = 64u * (4u * hi + tq) + 16u * ((2u * tblk + (tp >> 1)) ^ ((unsigned)hi & 3u)) + 8u * (tp & 1);
    const unsigned tb1 = 64u * (4u * hi + tq) + 16u * ((2u * tblk + (tp >> 1)) ^ ((2u + (unsigned)hi) & 3u)) + 8u * (tp & 1);
    LAS unsigned* maskL = (LAS unsigned*)(L + DSA_MASK_OFF + wave * 8192);
    {
        const unsigned char* msrc = (const unsigned char*)(MASK + (((size_t)b * 64 + qt) * 64) * 32) + 16 * lane;
        const unsigned mdst = (unsigned)__builtin_amdgcn_readfirstlane((int)(unsigned)(size_t)maskL);
        asm volatile("s_waitcnt vmcnt(0) lgkmcnt(0)" ::: "memory");
        for (int p = 0; 8 * p <= qt; ++p) glds16(msrc + 1024 * p, mdst + 1024u * (unsigned)p);
    }
    __syncthreads();
    asm volatile("s_waitcnt vmcnt(0) lgkmcnt(0)" ::: "memory");
    glds16(csrc, ring0); glds16(csrc + (size_t)32 * 128, ring0 + 8192u); glds16(csrc + (size_t)64 * 128, ring0 + 16384u); glds16(csrc + (size_t)96 * 128, ring0 + 24576u);
    auto dsa_tile = [&](const int kt, const LAS unsigned char* Cb, const unsigned mwc) __attribute__((always_inline)) {
        if (kt <= qt) {
            f32x16 S;
#pragma unroll
            for (int r = 0; r < 16; ++r) S[r] = 0.f;
#pragma unroll
            for (int ks = 0; ks < 8; ++ks) {
                const bf16x8 a = *(const LAS bf16x8*)(Cb + ((ks & 1) ? rb_o : rb_e) + 512u * (ks >> 1));
                S = MFMA32(a, qlf[ks], S);
            }
            const unsigned mw = mwc >> (16 * hi);
            const int dq = qt - kt;
            float cb = bias31;
            if (__builtin_amdgcn_readfirstlane(dq) < 5) {
                asm volatile("" ::: "memory");
                cb = 0.f;
                const int rel0 = 32 * dq + r32 - 4 * hi;
#pragma unroll
                for (int r = 0; r < 16; ++r) { int rel = rel0 - ((r & 3) + 8 * (r >> 2)); rel = rel < 0 ? 0 : rel; S[r] += biasT[rel]; }
                asm volatile("" ::: "memory");
            }
            float mx = fmaxf(S[0], S[1]);
#pragma unroll
            for (int r = 2; r < 16; ++r) mx = fmaxf(mx, S[r]);
            mx = xhalf_max(mx) + cb;
            if (__any(mx > mref + 8.f)) {
                float mm = NINF;
                asm volatile("" : "+v"(mm));
#pragma unroll
                for (int r = 0; r < 16; ++r) mm = fmaxf(mm, ((mw >> r) & 1u) ? S[r] : NINF);
                mm = xhalf_max(mm) + cb;
                const float mn = fmaxf(mref, mm);
                const float alpha = (mn > mref) ? __builtin_amdgcn_exp2f(mref - mn) : 1.f;
                mref = mn; lrun *= alpha;
#pragma unroll
                for (int c = 0; c < 4; ++c)
#pragma unroll
                    for (int r = 0; r < 16; ++r) asm volatile("v_mul_f32 %0, %0, %1" : "+v"(O[c][r]) : "v"(alpha));
            }
            const float off = ((mref == NINF) ? 0.f : mref) - cb;
            float ps0 = 0.f, ps1 = 0.f;
#pragma unroll
            for (int r = 0; r < 16; ++r) {
                const float e = __builtin_amdgcn_exp2f(S[r] - off);
                int m1; asm("v_bfe_i32 %0, %1, %2, 1" : "=v"(m1) : "v"(mw), "n"(r));
                S[r] = __uint_as_float(__float_as_uint(e) & (unsigned)m1);
                if (r & 1) ps1 += S[r]; else ps0 += S[r];
            }
            lrun += ps0 + ps1;
            const bf16x8 p0 = pack8(S, 0), p1 = pack8(S, 1);
#pragma unroll
            for (int c = 0; c < 4; ++c) {
                s16x4 f[4];
#pragma unroll
                for (int st = 0; st < 4; ++st) {
                    f[st] = vtr(Cb + ((st & 1) ? tb1 : tb0) + 2048u * st + 512u * c);
                }
                O[c] = MFMA32(cat44(f[0], f[1]), p0, O[c]);
                O[c] = MFMA32(cat44(f[2], f[3]), p1, O[c]);
            }
        }
    };
    const int NS = (KT + 1) >> 1;
    int sl = 0;
    for (int st = 0; st < NS; ++st) {
        if (st + 1 < NS) asm volatile("s_waitcnt vmcnt(2)\n\ts_barrier" ::: "memory");
        else asm volatile("s_waitcnt vmcnt(0)\n\ts_barrier" ::: "memory");
        if (st + 2 < NS) { int s2 = sl + 4; s2 = s2 >= 6 ? s2 - 6 : s2;
            glds16(csrc + (size_t)(64 * (st + 2)) * 128, ring0 + 8192u * (unsigned)s2); glds16(csrc + (size_t)(64 * (st + 2) + 32) * 128, ring0 + 8192u * (unsigned)(s2 + 1)); }
        const unsigned mw0 = maskL[(2 * st) * 32 + r32], mw1 = maskL[(2 * st + 1) * 32 + r32];
        dsa_tile(2 * st, L + sl * 8192, mw0);
        dsa_tile(2 * st + 1, L + (sl + 1) * 8192, mw1);
        sl = (sl == 4) ? 0 : sl + 2;
    }
    const float lt = xhalf_sum(lrun);
    const float il = 1.f / lt;
    f32x16 Y[2];
#pragma unroll
    for (int r = 0; r < 16; ++r) { Y[0][r] = 0.f; Y[1][r] = 0.f; }
#pragma unroll
    for (int rt = 0; rt < 4; ++rt) {
#pragma unroll
        for (int r = 0; r < 16; ++r) O[rt][r] *= il;
        const bf16x8 x0 = pack8(O[rt], 0), x1 = pack8(O[rt], 1);
#pragma unroll
        for (int c = 0; c < 2; ++c) {
            int l3 = lane; asm volatile("" : "+v"(l3));
            const GAS bf16_t* wp = (const GAS bf16_t*)WUVp + ((((c * 4 + rt) * 2 + 0) * 32 + (l3 & 31)) * 2 + (l3 >> 5)) * 8;
            Y[c] = MFMA32(*(const GAS bf16x8*)wp, x0, Y[c]);
            Y[c] = MFMA32(*(const GAS bf16x8*)(wp + 32 * 2 * 8), x1, Y[c]);
        }
    }
    {
        int l2 = lane; asm volatile("" : "+v"(l2));
        const int t2 = 32 * qt + (l2 & 31);
        gate_store(Y, 1.f, PROJ + ((size_t)b * SEQ + t2) * LDP + C_DSG + h * 64, MIX + ((size_t)b * SEQ + t2) * DM + 384 + h * 64, l2 >> 5);
    }
    __syncthreads();
}

typedef GAS unsigned gu32;
#define RLX_AGENT __ATOMIC_RELAXED, __HIP_MEMORY_SCOPE_AGENT
constexpr size_t WS_BAR = 512 * 1024;
#define XB_TMO      128
#define XB_XCNT(j)  (256  + 64 * (j))
#define XB_XSUB(j)  (1280 + 64 * (j))
#define XB_XGEN(j)  (2304 + 64 * (j))
#define XB_TOP      3328
#define XB_TOPGEN   3392
#define XCD_BAR_WORDS 3456
#define XB_SPIN_CAP (1u << 18)

__device__ __forceinline__ unsigned xb_ld(unsigned* p)              { return __hip_atomic_load(p, __ATOMIC_RELAXED, __HIP_MEMORY_SCOPE_AGENT); }
__device__ __forceinline__ unsigned xb_add(unsigned* p, unsigned v) { return __hip_atomic_fetch_add(p, v, __ATOMIC_RELAXED, __HIP_MEMORY_SCOPE_AGENT); }
__device__ __forceinline__ unsigned xb_xcc_id() { return (unsigned)__builtin_amdgcn_s_getreg((3 << 11) | 20) & 0xFu; }
#define XB_SPIN(cond, bar) do { unsigned _sp = 0; while (cond) { __builtin_amdgcn_s_sleep(1); \
    if ((++_sp & 255u) == 0u) { if (xb_ld(&(bar)[XB_TMO])) break; if (_sp > XB_SPIN_CAP) { atomicAdd(&(bar)[XB_TMO], 1u); break; } } } } while (0)

struct XcdBarrier {
    unsigned* bar; unsigned x;
    volatile LAS unsigned* st;
};

__device__ __forceinline__ XcdBarrier xcd_barrier_post(unsigned* bar, volatile LAS unsigned* st) {
    XcdBarrier b; b.bar = bar; b.x = xb_xcc_id(); b.st = st;
    if (threadIdx.x == 0) (void)xb_add(&bar[XB_XCNT(b.x)], 1u);
    return b;
}
__device__ __forceinline__ void xcd_barrier_complete(unsigned* bar, unsigned x, unsigned& nloc, unsigned& nx) {
    const unsigned G = gridDim.x * gridDim.y * gridDim.z;
    unsigned sum, cnt, mine, sp = 0u;
    for (;;) {
        sum = 0u; cnt = 0u; mine = 0u;
#pragma unroll
        for (unsigned j = 0; j < 16; ++j) { const unsigned c = xb_ld(&bar[XB_XCNT(j)]); sum += c; cnt += (c > 0u) ? 1u : 0u; mine = (j == x) ? c : mine; }
        if (sum == G) break;
        __builtin_amdgcn_s_sleep(1);
        if ((++sp & 255u) == 0u) { if (xb_ld(&bar[XB_TMO])) break; if (sp > XB_SPIN_CAP) { atomicAdd(&bar[XB_TMO], 1u); break; } }
    }
    nloc = mine > 0u ? mine : 1u; nx = cnt > 0u ? cnt : 1u;
}

__device__ __forceinline__ void xcd_barrier(const XcdBarrier& b) {
    asm volatile("s_waitcnt vmcnt(0)" ::: "memory");
    __syncthreads();
    if (threadIdx.x == 0) {
        unsigned* bar = b.bar;
        __builtin_amdgcn_s_waitcnt(0);
        unsigned nloc = b.st[0], nx = b.st[1];
        if (nloc == 0u) { xcd_barrier_complete(bar, b.x, nloc, nx); b.st[0] = nloc; b.st[1] = nx; }
        const unsigned old = xb_add(&bar[XB_XSUB(b.x)], 1u);
        const unsigned gen = old / nloc;
        if (old + 1u == (gen + 1u) * nloc) {
            __builtin_amdgcn_fence(__ATOMIC_RELEASE, "agent");
            asm volatile("s_waitcnt vmcnt(0)" ::: "memory");
            const unsigned og = xb_add(&bar[XB_TOP], 1u);
            const unsigned tg = og / nx;
            if (og + 1u == (tg + 1u) * nx) xb_add(&bar[XB_TOPGEN], 1u);
            else XB_SPIN(xb_ld(&bar[XB_TOPGEN]) == tg, bar);
            __builtin_amdgcn_fence(__ATOMIC_ACQUIRE, "agent");
            xb_add(&bar[XB_XGEN(b.x)], 1u);
            asm volatile("s_waitcnt vmcnt(0)" ::: "memory");
        } else {
            XB_SPIN(xb_ld(&bar[XB_XGEN(b.x)]) == gen, bar);
            __builtin_amdgcn_fence(__ATOMIC_ACQUIRE, "agent");
            asm volatile("s_waitcnt vmcnt(0)" ::: "memory");
        }
    }
    __syncthreads();
}

#ifndef MK_MULTI
#define MK_MULTI 0
#endif
constexpr int NPHASE = 11;
__global__ void __launch_bounds__(NWAVES * 64, 2) mk_fwd(Args args) {
    extern __shared__ __attribute__((aligned(16))) unsigned char lds_raw[];
    LAS unsigned char* lds = (LAS unsigned char*)lds_raw;
    const int tid0 = threadIdx.x;
    int wave_ = __builtin_amdgcn_readfirstlane(tid0 >> 6); asm volatile("" : "+s"(wave_));
    const int wave = wave_;
    const int G = gridDim.x, bid = blockIdx.x;
    for (int u = tid0; u < 16; u += NWAVES * 64) ((LAS unsigned*)(lds + 131072))[u] = 0u;
    __syncthreads();
    const XcdBarrier xbar = xcd_barrier_post((unsigned*)(args.ws + WS_BAR), (volatile LAS unsigned*)(lds + 131072));
    const int lo = args.ph_lo, hi = args.ph_hi;
#define IN(k) (lo <= (k) && (k) < hi)
#define SEAM(k) do { if (IN(k) && IN((k) + 1)) { if ((k) == 0) cg::this_grid().sync(); else xcd_barrier(xbar); } } while (0)
#define PH_BEGIN int lane = lane_id_v(); unsigned char* ws_ = args.ws; asm volatile("" : "+s"(ws_)); GAS unsigned char* ws = (GAS unsigned char*)ws_;     \
    const int gw = bid * NWAVES + wave, NGW = G * NWAVES; (void)gw; (void)NGW;
#define VCU_LOOP for (int vcu = vcu0; vcu < 256; vcu += G)
#define VCU_IDS const int bb = vcu >> 3, w64 = (vcu & 7) * 8 + wave; (void)bb; (void)w64;
#define P_WIN ((bf16_t*)(ws + WS_WIN))
#define P_WOUT ((bf16_t*)(ws + WS_WOUT))
#define P_WMEM ((bf16_t*)(ws + WS_WMEM))
#define P_MEMB ((bf16_t*)(ws + WS_MEMB))
#define P_MEMKV ((bf16_t*)(ws + WS_MEMKV))
#define P_CKVN ((bf16_t*)(ws + WS_CKVN))
#define P_MASK ((unsigned*)(ws + WS_MASK))
#define P_H ((bf16_t*)(ws + WS_H))
#define P_MIX ((bf16_t*)(ws + WS_MIX))
#define P_PROJ ((bf16_t*)(ws + WS_PROJ))
#define P_Y ((bf16_t*)(ws + WS_Y))
    const int vcu0 = (G % 8 == 0) ? (bid & 7) * (G >> 3) + (bid >> 3) : bid;

    if (IN(0)) {
        PH_BEGIN
        const float* x = args.in[0]; const float* mem = args.in[1]; const float* pre_g = args.in[2];
        const float* w_in = args.in[4]; const float* w_mem = args.in[8]; const float* w_out = args.in[9];
        LAS float* scr = (LAS float*)(lds + wave * 16384);
        constexpr int I_IN = 16 * (LDP / 32), I_OUT = 16 * 32, I_MEM = 16 * 16;
        constexpr int NITEMS = 2 * I_IN + 2 * I_OUT + 2 * I_MEM;
        for (int it = gw; it < NITEMS; it += NGW) {
            int r = it;
            if (r < 2 * I_IN) { const int l = r / I_IN; r -= l * I_IN; p0_transpose_item(w_in + (size_t)l * DM * NCOL, DM, NCOL, LDP, P_WIN + (size_t)l * LDP * DM, pre_g + l * DM, scr, r, lane); continue; }
            r -= 2 * I_IN;
            if (r < 2 * I_OUT) { const int l = r / I_OUT; r -= l * I_OUT; p0_transpose_item(w_out + (size_t)l * DM * DM, DM, DM, DM, P_WOUT + (size_t)l * DM * DM, nullptr, scr, r, lane); continue; }
            r -= 2 * I_OUT;
            { const int l = r / I_MEM; r -= l * I_MEM; p0_transpose_item(w_mem + (size_t)l * DM * 512, DM, 512, 512, P_WMEM + (size_t)l * 512 * DM, nullptr, scr, r, lane); }
        }
        {
            const float* w_uk = args.in[5]; const float* w_uv = args.in[6];
            bf16_t* WUKp = (bf16_t*)(ws + WS_WUK); bf16_t* WUVp = (bf16_t*)(ws + WS_WUV);
            for (int e = gw * 64 + lane; e < 2 * 6 * 8192; e += NGW * 64) {
                const int lh = e >> 13, l = lh / 6, h = lh % 6, w = e & 8191;
                { const int rt = w >> 11, rho = (w >> 6) & 31, d = w & 63; const int r = 32 * rt + ((rho & 0x13) | ((rho & 4) << 1) | ((rho & 8) >> 1));
                  WUKp[e] = (bf16_t)f2bf(w_uk[(((size_t)l * 128 + r) * 6 + h) * 64 + d]); }
                { const int j = w & 7, hh = (w >> 3) & 1, d32 = (w >> 4) & 31, s = (w >> 9) & 1, rt = (w >> 10) & 3, c = (w >> 12) & 1;
                  const int r = 32 * rt + 16 * s + 8 * (j >> 2) + 4 * hh + (j & 3), d = 32 * c + d32;
                  WUVp[e] = (bf16_t)f2bf(w_uv[(((size_t)l * 128 + r) * 6 + h) * 64 + d]); }
            }
        }
        for (int m = gw; m < NB * NMEM; m += NGW) row_to_bf16<false>(mem + (size_t)m * DM, P_MEMB + (size_t)m * DM, lane);
        for (int m = gw * 2; m < NTOK; m += NGW * 2) { row_to_bf16<true>(x + (size_t)m * DM, P_H + (size_t)m * DM, lane); row_to_bf16<true>(x + (size_t)(m + 1) * DM, P_H + (size_t)(m + 1) * DM, lane); }
    }
    SEAM(0);
#pragma unroll 1
    for (int l = 0; l < 2; ++l) {
        const int pb = 1 + 5 * l;
        if (IN(pb)) {
            PH_BEGIN
            { pg8::Gemm g{P_H, P_WIN + (size_t)l * LDP * DM, NTOK, LDP, DM}; pg8::StaticOrder S; S.init(NTOK, LDP, G, bid);
              pg8::EpiBf16<0> E{P_PROJ, LDP, nullptr, 0, 0, 1.f};
              pg8::gemm_phase<pg8::EpiBf16<0>, pg8::StaticOrder, true, true>(lds, g, S, E, wave); }
            if (l == 0) {
              pg8::Gemm g{P_MEMB, P_WMEM, NB * NMEM, 1024, DM}; pg8::StaticOrder S; S.init(NB * NMEM, 1024, G, bid);
              pg8::EpiBf16<0> E{P_MEMKV, 1024, nullptr, 0, 0, 1.f};
              pg8::gemm_phase<pg8::EpiBf16<0>, pg8::StaticOrder, true, true>(lds, g, S, E, wave); }
        }
        SEAM(pb);
        if (IN(pb + 1)) {
            { PH_BEGIN
              const float* kv_g = args.in[7];
              for (int m = gw * 8; m < NTOK; m += NGW * 8) { ckvnorm4(P_PROJ, kv_g + l * 128, P_CKVN, m, lane); ckvnorm4(P_PROJ, kv_g + l * 128, P_CKVN, m + 4, lane); } }
            VCU_LOOP { PH_BEGIN VCU_IDS
              for (int i = 0; i < 6; ++i) { const int qt = (i & 1) ? 63 - w64 : w64; sb_item(P_PROJ, P_MIX, bb, i, qt, lane, lds + wave * 16384); } }
            __syncthreads();
            VCU_LOOP { PH_BEGIN VCU_IDS
              const int s8 = vcu & 7;
              for (int j = 0; j < 8; ++j) { const int qt = 8 * j + ((j & 1) ? 7 - s8 : s8); sel_item2(P_PROJ, P_MASK, bb, qt, lane, wave, lds); } }
            __syncthreads();
            VCU_LOOP { PH_BEGIN VCU_IDS
              for (int i = 0; i < 4; ++i) {
                  __syncthreads();
                  mem_stage(P_MEMKV + l * 512, bb, i, wave * 64 + lane, lds);
                  __syncthreads();
                  mem_item_lds(P_PROJ, P_MIX, bb, i, w64, lane, lds);
              } }
        }
        SEAM(pb + 1);
        if (IN(pb + 2)) {
            __syncthreads();
            VCU_LOOP { PH_BEGIN VCU_IDS
              const float* rel_bias = args.in[10];
              const int s8 = vcu & 7, hs = (s8 < 4) ? 0 : 3;
              for (int oi = 0; oi < 2; ++oi) {
                  const int o = oi ? 7 - (s8 & 3) : (s8 & 3);
                  for (int hh = 0; hh < 3; ++hh) {
                      const int h = hs + hh;
                      dsa_round(P_PROJ, P_CKVN, P_MASK, (const bf16_t*)(ws + WS_WUK) + (size_t)(l * 6 + h) * 8192, (const bf16_t*)(ws + WS_WUV) + (size_t)(l * 6 + h) * 8192,
                                rel_bias, P_MIX, bb, o, h, lane, wave, lds);
                  }
              } }
        }
        SEAM(pb + 2);
        if (IN(pb + 3)) {
            PH_BEGIN
            __syncthreads();
            pg8::Gemm g{P_MIX, P_WOUT + (size_t)l * DM * DM, NTOK, DM, DM}; pg8::StaticOrder S; S.init(NTOK, DM, G, bid);
            pg8::EpiBf16<0> E{P_Y, DM, nullptr, 0, 0, 1.f};
            pg8::gemm_phase<pg8::EpiBf16<0>, pg8::StaticOrder, true, true>(lds, g, S, E, wave);
        }
        SEAM(pb + 3);
        if (IN(pb + 4)) {
            PH_BEGIN
            const float* xin = (l == 0) ? args.in[0] : args.out; const float* post_g = args.in[3];
            for (int m = gw * 2; m < NTOK; m += NGW * 2) { post_row(xin, P_Y, post_g + l * DM, args.out, (l == 0) ? P_H : (bf16_t*)nullptr, m, lane); post_row(xin, P_Y, post_g + l * DM, args.out, (l == 0) ? P_H : (bf16_t*)nullptr, m + 1, lane); }
        }
        SEAM(pb + 4);
    }
#undef IN
#undef SEAM
}

extern "C" void kernel_launch(void* const* d_in, const int* in_sizes, int n_in, void* d_out, int out_size, void* d_ws, size_t ws_size, hipStream_t stream) {
    static int grid = 0;
    if (grid == 0) {
        if (n_in != 11 || ws_size < WS_END) { fprintf(stderr, "kernel_launch: unexpected n_in %d / ws_size %zu\n", n_in, ws_size); grid = -1; return; }
        int dev = 0, cus = 0, per_cu = 0;
        hipGetDevice(&dev);
        hipDeviceGetAttribute(&cus, hipDeviceAttributeMultiprocessorCount, dev);
        hipFuncSetAttribute((const void*)mk_fwd, hipFuncAttributeMaxDynamicSharedMemorySize, LDS_BYTES);
        hipOccupancyMaxActiveBlocksPerMultiprocessor(&per_cu, (const void*)mk_fwd, NWAVES * 64, LDS_BYTES);
        if (per_cu < 1) { fprintf(stderr, "kernel_launch: occupancy query says %d blocks per CU\n", per_cu); per_cu = 1; }
        grid = cus * 1;
        (void)hipGetLastError();
    }
    if (grid < 0) return;
    (void)hipMemsetAsync((char*)d_ws + WS_BAR, 0, 16384, stream);
    Args a{};
    for (int i = 0; i < 11; ++i) a.in[i] = (const float*)d_in[i];
    a.out = (float*)d_out; a.ws = (unsigned char*)d_ws;
#if MK_MULTI
    for (int p = 0; p < NPHASE; ++p) { a.ph_lo = p; a.ph_hi = p + 1; hipLaunchKernelGGL(mk_fwd, dim3(grid), dim3(NWAVES * 64), LDS_BYTES, stream, a); }
#else
    a.ph_lo = 0; a.ph_hi = NPHASE;
    void* kargs[] = {&a};
    hipError_t e = hipLaunchCooperativeKernel((const void*)mk_fwd, dim3(grid), dim3(NWAVES * 64), kargs, LDS_BYTES, stream);
    if (e != hipSuccess) fprintf(stderr, "cooperative launch failed: %s (grid %d)\n", hipGetErrorString(e), grid);
#endif
}
```

```cpp
#include <hip/hip_runtime.h>
#include <hip/hip_cooperative_groups.h>
#include <stdint.h>
#include <math.h>
#include <cstdio>
namespace cg = cooperative_groups;
__device__ __forceinline__ int lane_id_v() { int l; asm volatile("v_mbcnt_lo_u32_b32 %0, -1, 0\n\tv_mbcnt_hi_u32_b32 %0, -1, %0" : "=v"(l)); return l; }
namespace pg8 {
#define PG8_LAS __attribute__((address_space(3)))
typedef unsigned short bf16_t;
typedef short bf16x8 __attribute__((ext_vector_type(8)));
typedef float f32x4 __attribute__((ext_vector_type(4)));
typedef unsigned u32x4 __attribute__((ext_vector_type(4)));
constexpr int BM = 256, BK = 64, HALF = 128, HTB = HALF * BK * 2  , STAGE_BYTES = 8 * HTB, NXCD = 8, WGM = 8;

__host__ __device__ __forceinline__ int lds_byte(int r, int c) { const int st = (r >> 4) * 2 + (c >> 5), rr = r & 15, cc = c & 31, ob = rr * 64 + cc * 2; return st * 1024 + (ob ^ (((ob >> 9) & 1) << 5)); }
__host__ __device__ __forceinline__ void stage_rc(int b, int& R, int& C) { const int st = b / 1024, sb = b % 1024, swz = sb ^ (((sb >> 9) & 1) << 5); R = (st >> 1) * 16 + swz / 64; C = (st & 1) * 32 + (swz % 64) / 2; }
__host__ __device__ __forceinline__ int perm32(int rho) { const int n = rho >> 4, i = rho & 15; return 8 * (i >> 2) + 4 * n + (i & 3); }

struct Unit { int pm, pn; };
struct Gemm { const bf16_t* A; const bf16_t* Bt; int M, N, K; };

struct StaticOrder {
    int nM, nN, nwg, G, c;
    __host__ __device__ void init(int M, int N, int G_, int c_) { nM = M / BM; nN = N / BM; nwg = nM * nN; G = G_; c = c_; }
    __host__ __device__ bool next(int i, Unit& u) const {
        const long L = (long)i * G + c; if (L >= nwg) return false;
        int wgid = (int)L; { const int q = nwg / NXCD, r = nwg % NXCD, xcd = wgid % NXCD, off = wgid / NXCD; wgid = (xcd < r ? xcd * (q + 1) : r * (q + 1) + (xcd - r) * q) + off; }
        const int nig = WGM * nN, gid = wgid / nig, fm = gid * WGM, gsz = (nM - fm) < WGM ? (nM - fm) : WGM;
        u.pm = fm + ((wgid % nig) % gsz); u.pn = (wgid % nig) / gsz; return true;
    }
    __device__ __forceinline__ void a_ready(const Unit&) const {}
    __device__ __forceinline__ void done(const Unit&) const {}
};

__device__ __forceinline__ unsigned cvt_pk_bf16(float lo, float hi) { unsigned r; asm volatile("v_cvt_pk_bf16_f32 %0, %1, %2" : "=v"(r) : "v"(lo), "v"(hi)); return r; }
typedef float f32x2 __attribute__((ext_vector_type(2)));
__device__ __forceinline__ f32x2 gelu_pk(f32x2 v) {
    const f32x2 av = __builtin_elementwise_abs(v), d = av * 0.2316418882f + 1.0f;
    f32x2 t; t.x = __builtin_amdgcn_rcpf(d.x); t.y = __builtin_amdgcn_rcpf(d.y);
    f32x2 q = t * 0.5307027145f + (-0.7265760135f); q = q * t + 0.7107068705f; q = q * t + (-0.142248368f); q = q * t + 0.127414796f; q = q * t;
    const f32x2 s = (v * v) * (-0.72134752044f);
    f32x2 e; e.x = __builtin_amdgcn_exp2f(s.x); e.y = __builtin_amdgcn_exp2f(s.y);
    const f32x2 m = v * (q * e), r = v - m;
    f32x2 o; o.x = v.x < 0.f ? m.x : r.x; o.y = v.y < 0.f ? m.y : r.y; return o;
}

template <int ACT  > struct EpiBf16 {
    static constexpr bool PERM = true, AFTER_DRAIN = false; static_assert(ACT == 0 || ACT == 1, "EpiBf16: ACT is 0 (none) or 1 (gelu_pk)");
    bf16_t* O; int ldc; const float* bias; int split_cols; size_t split_stride; float scale0;
    __device__ __forceinline__ void operator()(const f32x4 (&acc)[2][2][4][2], const Unit& u, int wr, int wc, int fr, int fq) const {
        const int row0 = u.pm * BM + wr * 64 + fr; int colt = u.pn * BM; bf16_t* base = O;
        float sc = 1.f; if (split_cols) { const int t = colt / split_cols; base += (size_t)t * split_stride; colt -= t * split_cols; if (t == 0) sc = scale0; }
        const int col0 = colt + wc * 32 + 8 * fq, bcol0 = u.pn * BM + wc * 32 + 8 * fq;
        f32x4 bv[2][2];
#pragma unroll
        for (int bj = 0; bj < 2; ++bj)
#pragma unroll
            for (int n = 0; n < 2; ++n) bv[bj][n] = bias ? *(const f32x4*)(bias + bcol0 + bj * HALF + 4 * n) : (f32x4){0.f, 0.f, 0.f, 0.f};
#pragma unroll
        for (int ai = 0; ai < 2; ++ai)
#pragma unroll
            for (int m = 0; m < 4; ++m) { bf16_t* rowp = base + (size_t)(row0 + ai * HALF + m * 16) * ldc + col0;
#pragma unroll
                for (int bj = 0; bj < 2; ++bj) { f32x4 v0 = acc[ai][bj][m][0] + bv[bj][0], v1 = acc[ai][bj][m][1] + bv[bj][1];
                    if (ACT == 1) { f32x2 a = gelu_pk((f32x2){v0[0], v0[1]}), b = gelu_pk((f32x2){v0[2], v0[3]}), c = gelu_pk((f32x2){v1[0], v1[1]}), d = gelu_pk((f32x2){v1[2], v1[3]});
                        v0 = (f32x4){a.x, a.y, b.x, b.y}; v1 = (f32x4){c.x, c.y, d.x, d.y}; }
                    v0 = v0 * sc; v1 = v1 * sc; u32x4 w; w.x = cvt_pk_bf16(v0[0], v0[1]); w.y = cvt_pk_bf16(v0[2], v0[3]); w.z = cvt_pk_bf16(v1[0], v1[1]); w.w = cvt_pk_bf16(v1[2], v1[3]);
                    *(u32x4*)(rowp + bj * HALF) = w; } }
    }
};
template <class Epi, class Sched, bool ALIGN_EPI = false, bool SP2 = false>
__device__ __forceinline__ void gemm_phase(PG8_LAS unsigned char* lds, const Gemm g, const Sched& S, const Epi& E, int wave_id) {
    int tid_ = wave_id * 64 + lane_id_v();
    const int tid = tid_, wid = __builtin_amdgcn_readfirstlane(tid >> 6), lane = tid & 63, wr = wid >> 2, wc = wid & 3, fr = lane & 15, fq = lane >> 4;
    const int K = g.K, nt = K / BK;
    unsigned voffA[2], voffB[2];
#pragma unroll
    for (int i = 0; i < 2; ++i) { int R, C; stage_rc(tid * 16 + i * 8192, R, C); const int Rb = Epi::PERM ? ((R & ~31) + perm32(R & 31)) : R;
        voffA[i] = (unsigned)(R * K + C) * 2u; voffB[i] = (unsigned)(Rb * K + C) * 2u; }
    const size_t kstep = (size_t)(BK * 2);
    const size_t hstep = (size_t)HALF * K * 2;
    const size_t tstep = 2 * hstep;
    const unsigned ldsw = (unsigned)wid * 1024u;
    const int aoff = lds_byte(wr * 64 + fr, fq * 8), boff = lds_byte(wc * 32 + fr, fq * 8);
#define PG8_SA(b, h) (((b) * 2 + (h)) * HTB)
#define PG8_SB(b, h) ((4 + (b) * 2 + (h)) * HTB)
#define PG8_STAGE(bufoff, gbase, voff) do { _Pragma("unroll") for (int _i = 0; _i < 2; ++_i) \
        __builtin_amdgcn_global_load_lds((const unsigned*)((const char*)(gbase) + (voff)[_i]), (PG8_LAS unsigned*)(lds + (bufoff) + ldsw + _i * 8192), 16, 0, 0); } while (0)
#define PG8_LDA(dst, b, h) do { _Pragma("unroll") for (int m = 0; m < 4; ++m) _Pragma("unroll") for (int k = 0; k < 2; ++k) dst[m][k] = *(const PG8_LAS bf16x8*)(lds + PG8_SA(b, h) + aoff + m * 2048 + k * 1024); } while (0)
#define PG8_LDB(dst, b, h) do { _Pragma("unroll") for (int n = 0; n < 2; ++n) _Pragma("unroll") for (int k = 0; k < 2; ++k) dst[n][k] = *(const PG8_LAS bf16x8*)(lds + PG8_SB(b, h) + boff + n * 2048 + k * 1024); } while (0)
#define PG8_MMA(ai, bj, At, Bt) do { __builtin_amdgcn_s_setprio(1); _Pragma("unroll") for (int m = 0; m < 4; ++m) _Pragma("unroll") for (int n = 0; n < 2; ++n) _Pragma("unroll") for (int k = 0; k < 2; ++k) \
        acc[ai][bj][m][n] = __builtin_amdgcn_mfma_f32_16x16x32_bf16(Bt[n][k], At[m][k], acc[ai][bj][m][n], 0, 0, 0); __builtin_amdgcn_s_setprio(0); } while (0)
#define PG8_WAIT_V(n) asm volatile("s_waitcnt vmcnt(" #n ")" ::: "memory")
#define PG8_WAIT_L(n) asm volatile("s_waitcnt lgkmcnt(" #n ")" ::: "memory")
#define PG8_BAR __builtin_amdgcn_s_barrier()
#define PG8_SCHED __builtin_amdgcn_sched_barrier(0)
    Unit cur, nxt; int ui = 0;
    if (!S.next(0, cur)) return;
    f32x4 acc[2][2][4][2];
#pragma unroll
    for (int a = 0; a < 2; ++a)
#pragma unroll
        for (int b = 0; b < 2; ++b)
#pragma unroll
            for (int m = 0; m < 4; ++m)
#pragma unroll
                for (int n = 0; n < 2; ++n) acc[a][b][m][n] = (f32x4){0.f, 0.f, 0.f, 0.f};
    bf16x8 At[4][2], B0[2][2], B1[2][2];
    const char* cA = (const char*)g.A + (size_t)cur.pm * tstep; const char* cB = (const char*)g.Bt + (size_t)cur.pn * tstep;
    S.a_ready(cur);
    if constexpr (SP2) {
        PG8_STAGE(PG8_SB(0, 0), cB, voffB); PG8_STAGE(PG8_SB(0, 1), cB + hstep, voffB); PG8_STAGE(PG8_SA(0, 0), cA, voffA); PG8_STAGE(PG8_SA(0, 1), cA + hstep, voffA);
        if (wr == 1) PG8_BAR;
        PG8_WAIT_V(2); PG8_BAR;
        PG8_STAGE(PG8_SB(1, 0), cB + kstep, voffB); PG8_STAGE(PG8_SA(1, 0), cA + kstep, voffA); PG8_STAGE(PG8_SB(1, 1), cB + hstep + kstep, voffB);
        PG8_WAIT_V(6); PG8_BAR;
    } else {
        PG8_STAGE(PG8_SB(0, 0), cB, voffB); PG8_STAGE(PG8_SA(0, 0), cA, voffA); PG8_STAGE(PG8_SB(0, 1), cB + hstep, voffB); PG8_STAGE(PG8_SA(0, 1), cA + hstep, voffA);
        if (wr == 1) PG8_BAR;
        PG8_WAIT_V(4); PG8_BAR;
        PG8_STAGE(PG8_SB(1, 0), cB + kstep, voffB); PG8_STAGE(PG8_SA(1, 0), cA + kstep, voffA); PG8_STAGE(PG8_SB(1, 1), cB + hstep + kstep, voffB);
        PG8_WAIT_V(6); PG8_BAR;
    }
    for (;;) {
        const bool has_next = S.next(ui + 1, nxt);
        const char* nA = has_next ? (const char*)g.A + (size_t)nxt.pm * tstep : cA; const char* nB = has_next ? (const char*)g.Bt + (size_t)nxt.pn * tstep : cB;
        for (int t = 0; t < nt; t += 2) {
            const bool last = (t == nt - 2);
            const char* a1 = cA + (size_t)(t + 1) * kstep;
            const char* a2 = last ? nA : cA + (size_t)(t + 2) * kstep; const char* b2 = last ? nB : cB + (size_t)(t + 2) * kstep;
            const char* a3 = a2 + kstep; const char* b3 = b2 + kstep;
            if (last && has_next) S.a_ready(nxt);
            if constexpr (SP2) {
            PG8_LDB(B0, 0, 0); PG8_LDB(B1, 0, 1); PG8_SCHED; PG8_LDA(At, 0, 0); PG8_STAGE(PG8_SA(1, 1), a1 + hstep, voffA);
            PG8_WAIT_V(8); PG8_WAIT_L(0); PG8_BAR; PG8_MMA(0, 0, At, B0); PG8_MMA(0, 1, At, B1); PG8_BAR; PG8_SCHED;
            PG8_LDA(At, 0, 1); PG8_STAGE(PG8_SB(0, 0), b2, voffB); PG8_STAGE(PG8_SB(0, 1), b2 + hstep, voffB); PG8_STAGE(PG8_SA(0, 0), a2, voffA);
            PG8_WAIT_V(8); PG8_WAIT_L(0); PG8_BAR; PG8_MMA(1, 0, At, B0); PG8_MMA(1, 1, At, B1); PG8_BAR; PG8_SCHED;
            PG8_LDB(B0, 1, 0); PG8_LDB(B1, 1, 1); PG8_SCHED; PG8_LDA(At, 1, 0); PG8_STAGE(PG8_SA(0, 1), a2 + hstep, voffA);
            PG8_WAIT_V(8); PG8_WAIT_L(0); PG8_BAR; PG8_MMA(0, 0, At, B0); PG8_MMA(0, 1, At, B1); PG8_BAR; PG8_SCHED;
            PG8_LDA(At, 1, 1); PG8_STAGE(PG8_SB(1, 0), b3, voffB); PG8_STAGE(PG8_SB(1, 1), b3 + hstep, voffB); PG8_STAGE(PG8_SA(1, 0), a3, voffA);
            PG8_WAIT_V(8); PG8_WAIT_L(0); PG8_BAR; PG8_MMA(1, 0, At, B0); PG8_MMA(1, 1, At, B1); PG8_BAR; PG8_SCHED;
            } else {
            PG8_LDB(B0, 0, 0); PG8_SCHED; PG8_LDA(At, 0, 0); PG8_STAGE(PG8_SA(1, 1), a1 + hstep, voffA);
            PG8_WAIT_L(8); PG8_BAR; PG8_WAIT_L(0); PG8_MMA(0, 0, At, B0); PG8_BAR; PG8_SCHED;
            PG8_LDB(B1, 0, 1); PG8_STAGE(PG8_SB(0, 0), b2, voffB);
            PG8_BAR; PG8_WAIT_L(0); PG8_MMA(0, 1, At, B1); PG8_BAR;
            PG8_LDA(At, 0, 1); PG8_STAGE(PG8_SA(0, 0), a2, voffA);
            PG8_BAR; PG8_WAIT_L(0); PG8_MMA(1, 0, At, B0); PG8_BAR; PG8_SCHED;
            PG8_STAGE(PG8_SB(0, 1), b2 + hstep, voffB);
            PG8_WAIT_V(6); PG8_BAR; PG8_MMA(1, 1, At, B1); PG8_BAR;
            PG8_LDB(B0, 1, 0); PG8_SCHED; PG8_LDA(At, 1, 0); PG8_STAGE(PG8_SA(0, 1), a2 + hstep, voffA);
            PG8_WAIT_L(8); PG8_BAR; PG8_WAIT_L(0); PG8_MMA(0, 0, At, B0); PG8_BAR; PG8_SCHED;
            PG8_LDB(B1, 1, 1); PG8_STAGE(PG8_SB(1, 0), b3, voffB);
            PG8_BAR; PG8_WAIT_L(0); PG8_MMA(0, 1, At, B1); PG8_BAR;
            PG8_LDA(At, 1, 1); PG8_STAGE(PG8_SA(1, 0), a3, voffA);
            PG8_BAR; PG8_WAIT_L(0); PG8_MMA(1, 0, At, B0); PG8_BAR; PG8_SCHED;
            PG8_STAGE(PG8_SB(1, 1), b3 + hstep, voffB);
            PG8_WAIT_V(6); PG8_BAR; PG8_MMA(1, 1, At, B1); PG8_BAR;
            }
        }
        if constexpr (ALIGN_EPI) { if (wr == 0) PG8_BAR; }
        if constexpr (!Epi::AFTER_DRAIN) { E(acc, cur, wr, wc, fr, fq); S.done(cur); }
        if (!has_next) break;
#pragma unroll
        for (int a = 0; a < 2; ++a)
#pragma unroll
            for (int b = 0; b < 2; ++b)
#pragma unroll
                for (int m = 0; m < 4; ++m)
#pragma unroll
                    for (int n = 0; n < 2; ++n) acc[a][b][m][n] = (f32x4){0.f, 0.f, 0.f, 0.f};
        cur = nxt; cA = nA; cB = nB; ++ui;
        if constexpr (ALIGN_EPI) { if (wr == 1) PG8_BAR; }
    }
    PG8_WAIT_V(0);
    if constexpr (!ALIGN_EPI) { if (wr == 0) PG8_BAR; }
    PG8_BAR;
    if constexpr (Epi::AFTER_DRAIN) { E.fused(acc, cur, wr, wc, fr, fq, lds, wid, lane); S.done(cur); }
#undef PG8_SA
#undef PG8_SB
#undef PG8_STAGE
#undef PG8_LDA
#undef PG8_LDB
#undef PG8_MMA
#undef PG8_WAIT_V
#undef PG8_WAIT_L
#undef PG8_BAR
#undef PG8_SCHED
}
}
typedef unsigned short bf16_t;
#define LAS __attribute__((address_space(3)))
#define GAS __attribute__((address_space(1)))
typedef unsigned v4u __attribute__((ext_vector_type(4)));
typedef unsigned v2u __attribute__((ext_vector_type(2)));
typedef float f32x4 __attribute__((ext_vector_type(4)));
constexpr int DM = 1024, NB = 32, SEQ = 2048, NTOK = NB * SEQ, NMEM = 256;
constexpr int LDP = 3328;
constexpr int C_SBQ = 0, C_SBK = 384, C_SBV = 768, C_SBG = 1152, C_DSQ = 1536, C_CKV = 1920, C_DSG = 2048,
              C_IDQ = 2432, C_IDK = 2688, C_IDW = 2720, C_MQ = 2728, C_MG = 2984, NCOL = 3240;
constexpr float EPS = 1e-6f;
constexpr size_t MiB = 1u << 20;
constexpr size_t WS_CTL = 0;
constexpr size_t WS_WIN = 1 * MiB;
constexpr size_t WS_WOUT = 14 * MiB;
constexpr size_t WS_WMEM = 18 * MiB;
constexpr size_t WS_MEMB = 20 * MiB;
constexpr size_t WS_MEMKV = 36 * MiB;
constexpr size_t WS_CKVN = 52 * MiB;
constexpr size_t WS_MASK = 68 * MiB;
constexpr size_t WS_H = 84 * MiB;
constexpr size_t WS_MIX = WS_H;
constexpr size_t WS_PROJ = 212 * MiB;
constexpr size_t WS_Y = WS_PROJ;
constexpr size_t WS_END = 628 * MiB;
constexpr int LDS_BYTES = 135168;
constexpr int NWAVES = 8;

__device__ __forceinline__ float bf2f(bf16_t v) { return __uint_as_float(((unsigned)v) << 16); }
__device__ __forceinline__ unsigned f2bf(float f) { unsigned u = __float_as_uint(f); u += 0x7fffu + ((u >> 16) & 1u); return u >> 16; }
__device__ __forceinline__ unsigned pk2(float lo, float hi) { return f2bf(lo) | (f2bf(hi) << 16); }
#define WAVE_SYNC() do { asm volatile("s_waitcnt lgkmcnt(0)" ::: "memory"); __builtin_amdgcn_wave_barrier(); } while (0)
__device__ __forceinline__ float wave_sum(float v) {
#pragma unroll
    for (int o = 1; o < 64; o <<= 1) v += __shfl_xor(v, o);
    return v;
}

__device__ const unsigned char T5TAB[128] = {0, 1, 2, 3, 4, 5, 6, 7, 8, 9, 10, 11, 12, 13, 14, 15, 16, 16, 16, 17, 17, 18, 18, 18, 19, 19, 19, 20, 20, 20, 20, 21, 21, 21, 21, 22, 22, 22, 22, 22, 23, 23, 23, 23, 23, 23, 24, 24, 24, 24, 24, 24, 25, 25, 25, 25, 25, 25, 25, 26, 26, 26, 26, 26, 26, 26, 26, 27, 27, 27, 27, 27, 27, 27, 27, 27, 27, 28, 28, 28, 28, 28, 28, 28, 28, 28, 28, 29, 29, 29, 29, 29, 29, 29, 29, 29, 29, 29, 29, 30, 30, 30, 30, 30, 30, 30, 30, 30, 30, 30, 30, 30, 30, 31, 31, 31, 31, 31, 31, 31, 31, 31, 31, 31, 31, 31, 31, 31};

struct Args { const float* in[11]; float* out; unsigned char* ws; int ph_lo, ph_hi; };

__device__ __forceinline__ void p0_transpose_item(const float* W, int K, int N, int Npad, bf16_t* WT, const float* g, LAS float* scr, int item, int lane) {
    const int nblk = Npad / 32, kb = item / nblk, nb = item % nblk, k0 = 64 * kb, n0 = 32 * nb;
    const int nn = n0 + (lane & 31);
#pragma unroll 8
    for (int i = 0; i < 32; ++i) { const int kk = 2 * i + (lane >> 5); float v = (nn < N) ? W[(size_t)(k0 + kk) * N + nn] : 0.f; if (g) v *= g[k0 + kk]; scr[kk * 33 + (lane & 31)] = v; }
    WAVE_SYNC();
    const int c = lane & 7;
#pragma unroll
    for (int j = 0; j < 4; ++j) { const int n = (lane >> 3) + 8 * j; const LAS float* s = scr + (8 * c) * 33 + n;
        v4u o; o.x = pk2(s[0 * 33], s[1 * 33]); o.y = pk2(s[2 * 33], s[3 * 33]); o.z = pk2(s[4 * 33], s[5 * 33]); o.w = pk2(s[6 * 33], s[7 * 33]);
        *(v4u*)(WT + (size_t)(n0 + n) * K + k0 + 8 * c) = o; }
    WAVE_SYNC();
}
template <bool NORM> __device__ __forceinline__ void row_to_bf16(const float* xrow, bf16_t* orow, int lane) {
    const f32x4* xr = (const f32x4*)xrow + lane;
    f32x4 v[4]; float s = 0.f;
#pragma unroll
    for (int j = 0; j < 4; ++j) { v[j] = xr[64 * j]; s += (v[j].x * v[j].x + v[j].y * v[j].y) + (v[j].z * v[j].z + v[j].w * v[j].w); }
    float r = 1.f;
    if (NORM) r = 1.0f / sqrtf(wave_sum(s) * (1.f / DM) + EPS);
    v2u* o8 = (v2u*)orow + lane;
#pragma unroll
    for (int j = 0; j < 4; ++j) { v2u w; w.x = pk2(v[j].x * r, v[j].y * r); w.y = pk2(v[j].z * r, v[j].w * r); o8[64 * j] = w; }
}

__device__ __forceinline__ void ckvnorm4(const bf16_t* PROJ, const float* kvg, bf16_t* CKVN, int row0, int lane) {
    const int row = row0 + (lane >> 4), c8 = (lane & 15) * 8;
    const v4u v = *(const v4u*)(PROJ + (size_t)row * LDP + C_CKV + c8);
    float f[8] = {__uint_as_float(v.x << 16), __uint_as_float(v.x & 0xffff0000u), __uint_as_float(v.y << 16), __uint_as_float(v.y & 0xffff0000u),
                  __uint_as_float(v.z << 16), __uint_as_float(v.z & 0xffff0000u), __uint_as_float(v.w << 16), __uint_as_float(v.w & 0xffff0000u)};
    float s = 0.f;
#pragma unroll
    for (int j = 0; j < 8; ++j) s += f[j] * f[j];
    s += __shfl_xor(s, 1); s += __shfl_xor(s, 2); s += __shfl_xor(s, 4); s += __shfl_xor(s, 8);
    const float r = 1.0f / sqrtf(s * (1.0f / 128.f) + EPS);
    const f32x4 g0 = *(const f32x4*)(kvg + c8), g1 = *(const f32x4*)(kvg + c8 + 4);
    v4u o; o.x = pk2(f[0] * r * g0.x, f[1] * r * g0.y); o.y = pk2(f[2] * r * g0.z, f[3] * r * g0.w); o.z = pk2(f[4] * r * g1.x, f[5] * r * g1.y); o.w = pk2(f[6] * r * g1.z, f[7] * r * g1.w);
    *(v4u*)(CKVN + (size_t)row * 128 + c8) = o;
}
__device__ __forceinline__ unsigned ordkey(float f) { unsigned u = __float_as_uint(f); return (u & 0x80000000u) ? ~u : (u | 0x80000000u); }
__device__ __forceinline__ void post_row(const float* xin, const bf16_t* Y, const float* g, float* xout, bf16_t* Hn, int row, int lane) {
    const bf16_t* yp = Y + (size_t)row * DM;
    float yv[16]; float s = 0.f;
#pragma unroll
    for (int j = 0; j < 4; ++j) {
        const v2u v = *(const v2u*)(yp + (lane + 64 * j) * 4);
        yv[4 * j + 0] = __uint_as_float(v.x << 16); yv[4 * j + 1] = __uint_as_float(v.x & 0xffff0000u);
        yv[4 * j + 2] = __uint_as_float(v.y << 16); yv[4 * j + 3] = __uint_as_float(v.y & 0xffff0000u);
        s += yv[4 * j] * yv[4 * j] + yv[4 * j + 1] * yv[4 * j + 1] + yv[4 * j + 2] * yv[4 * j + 2] + yv[4 * j + 3] * yv[4 * j + 3];
    }
    const float r = 1.0f / sqrtf(wave_sum(s) * (1.0f / DM) + EPS);
    f32x4 ov[4]; float s2 = 0.f;
#pragma unroll
    for (int j = 0; j < 4; ++j) {
        const int c = (lane + 64 * j) * 4;
        const f32x4 xv = *(const f32x4*)(xin + (size_t)row * DM + c);
        const f32x4 gv = *(const f32x4*)(g + c);
        ov[j].x = xv.x + yv[4 * j] * r * gv.x; ov[j].y = xv.y + yv[4 * j + 1] * r * gv.y; ov[j].z = xv.z + yv[4 * j + 2] * r * gv.z; ov[j].w = xv.w + yv[4 * j + 3] * r * gv.w;
        *(f32x4*)(xout + (size_t)row * DM + c) = ov[j];
        s2 += (ov[j].x * ov[j].x + ov[j].y * ov[j].y) + (ov[j].z * ov[j].z + ov[j].w * ov[j].w);
    }
    if (Hn) {
        const float r2 = 1.0f / sqrtf(wave_sum(s2) * (1.f / DM) + EPS);
        v2u* o8 = (v2u*)(Hn + (size_t)row * DM) + lane;
#pragma unroll
        for (int j = 0; j < 4; ++j) { v2u w; w.x = pk2(ov[j].x * r2, ov[j].y * r2); w.y = pk2(ov[j].z * r2, ov[j].w * r2); o8[64 * j] = w; }
    }
}

typedef short bf16x8 __attribute__((ext_vector_type(8)));
typedef short s16x4 __attribute__((ext_vector_type(4)));
typedef float f32x16 __attribute__((ext_vector_type(16)));
typedef float f32x2_t __attribute__((ext_vector_type(2)));
typedef __bf16 bf16x2_t __attribute__((ext_vector_type(2)));
#define MFMA32(a, b, c) __builtin_amdgcn_mfma_f32_32x32x16_bf16((a), (b), (c), 0, 0, 0)
__device__ __forceinline__ unsigned cvtpk(float lo, float hi) { f32x2_t v = {lo, hi}; bf16x2_t b = __builtin_convertvector(v, bf16x2_t); return __builtin_bit_cast(unsigned, b); }
__device__ __forceinline__ s16x4 vtr(const LAS unsigned char* p) { return __builtin_bit_cast(s16x4, __builtin_amdgcn_ds_read_tr16_b64_v4i16((LAS s16x4*)p)); }
__device__ __forceinline__ int crow(int r, int hi) { return (r & 3) + 8 * (r >> 2) + 4 * hi; }
__device__ __forceinline__ bf16x8 pack8(const f32x16& x, int s) {
    v4u p; p.x = cvtpk(x[8 * s + 0], x[8 * s + 1]); p.y = cvtpk(x[8 * s + 2], x[8 * s + 3]); p.z = cvtpk(x[8 * s + 4], x[8 * s + 5]); p.w = cvtpk(x[8 * s + 6], x[8 * s + 7]);
    return __builtin_bit_cast(bf16x8, p);
}
__device__ __forceinline__ f32x16 zero16() { float z; asm volatile("v_mov_b32 %0, 0" : "=v"(z)); return (f32x16){z, z, z, z, z, z, z, z, z, z, z, z, z, z, z, z}; }
__device__ __forceinline__ bf16x8 cat44(s16x4 lo, s16x4 hi) { return __builtin_shufflevector(lo, hi, 0, 1, 2, 3, 4, 5, 6, 7); }
__device__ __forceinline__ float xhalf_max(float v) { auto rr = __builtin_amdgcn_permlane32_swap(__float_as_uint(v), __float_as_uint(v), false, false); return fmaxf(__uint_as_float(rr[0]), __uint_as_float(rr[1])); }
__device__ __forceinline__ float xhalf_sum(float v) { auto rr = __builtin_amdgcn_permlane32_swap(__float_as_uint(v), __float_as_uint(v), false, false); return __uint_as_float(rr[0]) + __uint_as_float(rr[1]); }
__device__ __forceinline__ unsigned xhalf_other_u(unsigned v, int hi) { auto rr = __builtin_amdgcn_permlane32_swap(v, v, false, false); return hi ? rr[0] : rr[1]; }
__device__ __forceinline__ float xhalf_other(float v, int hi) { return __uint_as_float(xhalf_other_u(__float_as_uint(v), hi)); }
constexpr int VT_PITCH = 192;
constexpr float LOG2E = 1.4426950408889634f;

__device__ __forceinline__ void pv_tile(f32x16 (&O)[2], const LAS unsigned char* vrd, bf16x8 p0, bf16x8 p1) {
#pragma unroll
    for (int c = 0; c < 2; ++c) {
        const bf16x8 a0 = cat44(vtr(vrd + 0 * VT_PITCH + 64 * c), vtr(vrd + 8 * VT_PITCH + 64 * c));
        const bf16x8 a1 = cat44(vtr(vrd + 16 * VT_PITCH + 64 * c), vtr(vrd + 24 * VT_PITCH + 64 * c));
        O[c] = MFMA32(a0, p0, O[c]);
        O[c] = MFMA32(a1, p1, O[c]);
    }
}
__device__ __forceinline__ void gate_store(const f32x16 (&O)[2], float scale, const bf16_t* grow, bf16_t* orow, int hi) {
#pragma unroll
    for (int c = 0; c < 2; ++c)
#pragma unroll
        for (int g = 0; g < 4; ++g) {
            const int d = 32 * c + 8 * g + 4 * hi;
            const v2u gv = *(const v2u*)(grow + d);
            float gt[4] = {__uint_as_float(gv.x << 16), __uint_as_float(gv.x & 0xffff0000u), __uint_as_float(gv.y << 16), __uint_as_float(gv.y & 0xffff0000u)};
            float ov[4];
#pragma unroll
            for (int j = 0; j < 4; ++j) ov[j] = O[c][4 * g + j] * scale * gt[j] * __builtin_amdgcn_rcpf(1.f + __builtin_amdgcn_exp2f(-gt[j] * LOG2E));
            v2u w; w.x = cvtpk(ov[0], ov[1]); w.y = cvtpk(ov[2], ov[3]);
            *(v2u*)(orow + d) = w;
        }
}

__device__ __forceinline__ void gate_load(v2u (&gw)[8], const bf16_t* grow, int hi) {
#pragma unroll
    for (int c = 0; c < 2; ++c)
#pragma unroll
        for (int g = 0; g < 4; ++g) gw[c * 4 + g] = *(const v2u*)(grow + 32 * c + 8 * g + 4 * hi);
}
__device__ __forceinline__ void gate_store_pre(const f32x16 (&O)[2], float scale, const v2u (&gw)[8], bf16_t* orow, int hi) {
#pragma unroll
    for (int c = 0; c < 2; ++c)
#pragma unroll
        for (int g = 0; g < 4; ++g) {
            const int d = 32 * c + 8 * g + 4 * hi;
            const v2u gv = gw[c * 4 + g];
            float gt[4] = {__uint_as_float(gv.x << 16), __uint_as_float(gv.x & 0xffff0000u), __uint_as_float(gv.y << 16), __uint_as_float(gv.y & 0xffff0000u)};
            float ov[4];
#pragma unroll
            for (int j = 0; j < 4; ++j) ov[j] = O[c][4 * g + j] * scale * gt[j] * __builtin_amdgcn_rcpf(1.f + __builtin_amdgcn_exp2f(-gt[j] * LOG2E));
            v2u w; w.x = cvtpk(ov[0], ov[1]); w.y = cvtpk(ov[2], ov[3]);
            *(v2u*)(orow + d) = w;
        }
}

__device__ __forceinline__ void sb_item(const bf16_t* PROJ, bf16_t* MIX, int b, int h, int qt, int lane, LAS unsigned char* wl) {
    asm volatile("" : "+v"(lane));
    const int r32 = lane & 31, hi = lane >> 5;
    const bf16_t* base = PROJ + (size_t)b * SEQ * LDP;
    const int t = 32 * qt + r32;
    bf16x8 qf[4];
#pragma unroll
    for (int ks = 0; ks < 4; ++ks) qf[ks] = *(const bf16x8*)(base + (size_t)t * LDP + C_SBQ + h * 64 + 16 * ks + 8 * hi);
    v2u gw[8]; gate_load(gw, base + (size_t)t * LDP + C_SBG + h * 64, hi);
    const int vrow = lane >> 3, vch = lane & 7;
    LAS unsigned char* vwr = wl + vrow * VT_PITCH + vch * 16;
    const LAS unsigned char* vrd = wl + (4 * hi + ((lane & 15) >> 2)) * VT_PITCH + (16 * ((lane >> 4) & 1) + 4 * (lane & 3)) * 2;
    bf16x8 kc[4], vc[4];
    {
        const bf16_t* kp = base + (size_t)(32 * qt + r32) * LDP + C_SBK + h * 64 + 8 * hi;
#pragma unroll
        for (int ks = 0; ks < 4; ++ks) kc[ks] = *(const bf16x8*)(kp + 16 * ks);
        const bf16_t* vp = base + (size_t)(32 * qt + vrow) * LDP + C_SBV + h * 64 + 8 * vch;
#pragma unroll
        for (int i = 0; i < 4; ++i) vc[i] = *(const bf16x8*)(vp + (size_t)(8 * i) * LDP);
    }
    f32x16 O[2];
#pragma unroll
    for (int r = 0; r < 16; ++r) { O[0][r] = 0.f; O[1][r] = 0.f; }
    float R = 1.f;
    for (int kt = qt; kt >= 0; --kt) {
        bf16x8 kn[4], vn[4];
        {
            const int ktn = kt > 0 ? kt - 1 : 0;
            const bf16_t* kp = base + (size_t)(32 * ktn + r32) * LDP + C_SBK + h * 64 + 8 * hi;
#pragma unroll
            for (int ks = 0; ks < 4; ++ks) kn[ks] = *(const bf16x8*)(kp + 16 * ks);
            const bf16_t* vp = base + (size_t)(32 * ktn + vrow) * LDP + C_SBV + h * 64 + 8 * vch;
#pragma unroll
            for (int i = 0; i < 4; ++i) vn[i] = *(const bf16x8*)(vp + (size_t)(8 * i) * LDP);
        }
        f32x16 acc;
#pragma unroll
        for (int r = 0; r < 16; ++r) acc[r] = 0.f;
#pragma unroll
        for (int ks = 0; ks < 4; ++ks) acc = MFMA32(kc[ks], qf[ks], acc);
#pragma unroll
        for (int i = 0; i < 4; ++i) *(LAS bf16x8*)(vwr + (8 * i) * VT_PITCH) = vc[i];
        float be[16], om[16];
        const bool diag = (kt == qt);
#pragma unroll
        for (int r = 0; r < 16; ++r) {
            const float e = __builtin_amdgcn_exp2f(fminf(acc[r] * (-0.125f * LOG2E), 115.f));
            float bt = __builtin_amdgcn_rcpf(1.f + e), o1 = e * bt;
            if (diag && !(crow(r, hi) < r32)) { bt = 0.f; o1 = 1.f; }
            be[r] = bt; om[r] = o1;
        }
        float Gp[4], Gq[4];
#pragma unroll
        for (int g = 0; g < 4; ++g) { Gp[g] = (om[4 * g] * om[4 * g + 1]) * (om[4 * g + 2] * om[4 * g + 3]); Gq[g] = xhalf_other(Gp[g], hi); }
        const float T1 = Gp[1] * Gq[1], T2 = Gp[2] * Gq[2], T3 = Gp[3] * Gq[3], T0 = Gp[0] * Gq[0];
        float tail[4]; tail[3] = R; tail[2] = R * T3; tail[1] = tail[2] * T2; tail[0] = tail[1] * T1;
        const float Rn = tail[0] * T0;
#pragma unroll
        for (int g = 0; g < 4; ++g) {
            float sfx = tail[g] * (hi == 0 ? Gq[g] : 1.f);
            acc[4 * g + 3] = be[4 * g + 3] * sfx; sfx *= om[4 * g + 3];
            acc[4 * g + 2] = be[4 * g + 2] * sfx; sfx *= om[4 * g + 2];
            acc[4 * g + 1] = be[4 * g + 1] * sfx; sfx *= om[4 * g + 1];
            acc[4 * g + 0] = be[4 * g + 0] * sfx;
        }
        R = Rn;
        const bf16x8 p0 = pack8(acc, 0), p1 = pack8(acc, 1);
        pv_tile(O, vrd, p0, p1);
        if (__all(R < 7.8886e-31f)) break;
#pragma unroll
        for (int i = 0; i < 4; ++i) { kc[i] = kn[i]; vc[i] = vn[i]; }
    }
    gate_store_pre(O, 1.f, gw, MIX + ((size_t)b * SEQ + t) * DM + h * 64, hi);
}

__device__ __forceinline__ void mem_item(const bf16_t* PROJ, const bf16_t* KV, bf16_t* MIX, int b, int h, int qt, int lane, LAS unsigned char* wl) {
    asm volatile("" : "+v"(lane));
    float NINF; asm volatile("v_mov_b32 %0, 0xff800000" : "=v"(NINF));
    const int r32 = lane & 31, hi = lane >> 5;
    const int t = 32 * qt + r32;
    const bf16_t* prow = PROJ + ((size_t)b * SEQ + t) * LDP;
    bf16x8 qf[4];
#pragma unroll
    for (int ks = 0; ks < 4; ++ks) qf[ks] = *(const bf16x8*)(prow + C_MQ + h * 64 + 16 * ks + 8 * hi);
    const int vrow = lane >> 3, vch = lane & 7;
    LAS unsigned char* vwr = wl + vrow * VT_PITCH + vch * 16;
    const LAS unsigned char* vrd = wl + (4 * hi + ((lane & 15) >> 2)) * VT_PITCH + (16 * ((lane >> 4) & 1) + 4 * (lane & 3)) * 2;
    const bf16_t* kvb = KV + (size_t)b * NMEM * 1024 + h * 64;
    f32x16 O[2];
#pragma unroll
    for (int r = 0; r < 16; ++r) { O[0][r] = 0.f; O[1][r] = 0.f; }
    float mrun = NINF, lrun = 0.f;
    v2u gw[8]; gate_load(gw, prow + C_MG + h * 64, hi);
    bf16x8 kc[4], vc[4];
    {
        const bf16_t* kp = kvb + (size_t)r32 * 1024 + 8 * hi;
#pragma unroll
        for (int ks = 0; ks < 4; ++ks) kc[ks] = *(const bf16x8*)(kp + 16 * ks);
        const bf16_t* vp = kvb + (size_t)vrow * 1024 + 256 + 8 * vch;
#pragma unroll
        for (int i = 0; i < 4; ++i) vc[i] = *(const bf16x8*)(vp + (size_t)(8 * i) * 1024);
    }
    for (int kt = 0; kt < NMEM / 32; ++kt) {
        bf16x8 kn[4], vn[4];
        {
            const int ktn = kt < NMEM / 32 - 1 ? kt + 1 : kt;
            const bf16_t* kp = kvb + (size_t)(32 * ktn + r32) * 1024 + 8 * hi;
#pragma unroll
            for (int ks = 0; ks < 4; ++ks) kn[ks] = *(const bf16x8*)(kp + 16 * ks);
            const bf16_t* vp = kvb + (size_t)(32 * ktn + vrow) * 1024 + 256 + 8 * vch;
#pragma unroll
            for (int i = 0; i < 4; ++i) vn[i] = *(const bf16x8*)(vp + (size_t)(8 * i) * 1024);
        }
        f32x16 acc;
#pragma unroll
        for (int r = 0; r < 16; ++r) acc[r] = 0.f;
#pragma unroll
        for (int ks = 0; ks < 4; ++ks) acc = MFMA32(kc[ks], qf[ks], acc);
#pragma unroll
        for (int i = 0; i < 4; ++i) *(LAS bf16x8*)(vwr + (8 * i) * VT_PITCH) = vc[i];
        float mx = acc[0];
#pragma unroll
        for (int r = 1; r < 16; ++r) mx = fmaxf(mx, acc[r]);
        mx *= 0.125f * LOG2E;
        mx = xhalf_max(mx);
        const float mn = fmaxf(mrun, mx), alpha = __builtin_amdgcn_exp2f(mrun - mn);
        float ps = 0.f;
#pragma unroll
        for (int r = 0; r < 16; ++r) { acc[r] = __builtin_amdgcn_exp2f(acc[r] * (0.125f * LOG2E) - mn); ps += acc[r]; }
        lrun = lrun * alpha + ps; mrun = mn;
#pragma unroll
        for (int r = 0; r < 16; ++r) { O[0][r] *= alpha; O[1][r] *= alpha; }
        const bf16x8 p0 = pack8(acc, 0), p1 = pack8(acc, 1);
        pv_tile(O, vrd, p0, p1);
#pragma unroll
        for (int i = 0; i < 4; ++i) { kc[i] = kn[i]; vc[i] = vn[i]; }
    }
    const float lt = xhalf_sum(lrun);
    gate_store_pre(O, 1.f / lt, gw, MIX + ((size_t)b * SEQ + t) * DM + 768 + h * 64, hi);
}

constexpr int MEML_V_OFF = 32768;
__device__ __forceinline__ void mem_stage(const bf16_t* KV, int b, int h, int tid, LAS unsigned char* L) {
    const bf16_t* kvb = KV + (size_t)b * NMEM * 1024 + h * 64;
#pragma unroll
    for (int i = 0; i < 4; ++i) {
        const int idx = tid + 512 * i, key = idx >> 3, ch = idx & 7;
        const v4u kx = *(const v4u*)(kvb + (size_t)key * 1024 + 8 * ch), vx = *(const v4u*)(kvb + (size_t)key * 1024 + 256 + 8 * ch);
        *(LAS v4u*)(L + 128 * key + 16 * (ch ^ ((key >> 1) & 7))) = kx;
        *(LAS v4u*)(L + MEML_V_OFF + (key >> 5) * (32 * VT_PITCH) + (key & 31) * VT_PITCH + 16 * ch) = vx;
    }
}
__device__ __forceinline__ void mem_item_lds(const bf16_t* PROJ, bf16_t* MIX, int b, int h, int qt, int lane, const LAS unsigned char* L) {
    asm volatile("" : "+v"(lane));
    float NINF; asm volatile("v_mov_b32 %0, 0xff800000" : "=v"(NINF));
    const int r32 = lane & 31, hi = lane >> 5;
    const int t = 32 * qt + r32;
    const bf16_t* prow = PROJ + ((size_t)b * SEQ + t) * LDP;
    bf16x8 qf[4];
#pragma unroll
    for (int ks = 0; ks < 4; ++ks) qf[ks] = *(const bf16x8*)(prow + C_MQ + h * 64 + 16 * ks + 8 * hi);
    v2u gw[8]; gate_load(gw, prow + C_MG + h * 64, hi);
    const unsigned kx = ((unsigned)r32 >> 1) & 7u;
    const LAS unsigned char* krd = L + 128 * r32;
    const LAS unsigned char* vrd = L + MEML_V_OFF + (4 * hi + ((lane & 15) >> 2)) * VT_PITCH + (16 * ((lane >> 4) & 1) + 4 * (lane & 3)) * 2;
    f32x16 O[2];
    O[0] = zero16(); O[1] = zero16();
    float mrun = NINF, lrun = 0.f;
#pragma unroll 2
    for (int kt = 0; kt < NMEM / 32; ++kt) {
        bf16x8 kc[4];
#pragma unroll
        for (int ks = 0; ks < 4; ++ks) kc[ks] = *(const LAS bf16x8*)(krd + 4096 * kt + 16 * ((unsigned)(2 * ks + hi) ^ kx));
        f32x16 acc = MFMA32(kc[0], qf[0], zero16());
#pragma unroll
        for (int ks = 1; ks < 4; ++ks) acc = MFMA32(kc[ks], qf[ks], acc);
        float mx = acc[0];
#pragma unroll
        for (int r = 1; r < 16; ++r) mx = fmaxf(mx, acc[r]);
        mx *= 0.125f * LOG2E;
        mx = xhalf_max(mx);
        const float mn = fmaxf(mrun, mx), alpha = __builtin_amdgcn_exp2f(mrun - mn);
        float ps = 0.f;
#pragma unroll
        for (int r = 0; r < 16; ++r) { acc[r] = __builtin_amdgcn_exp2f(acc[r] * (0.125f * LOG2E) - mn); ps += acc[r]; }
        lrun = lrun * alpha + ps; mrun = mn;
#pragma unroll
        for (int r = 0; r < 16; ++r) { O[0][r] *= alpha; O[1][r] *= alpha; }
        const bf16x8 p0 = pack8(acc, 0), p1 = pack8(acc, 1);
        pv_tile(O, vrd + kt * (32 * VT_PITCH), p0, p1);
    }
    const float lt = xhalf_sum(lrun);
    gate_store_pre(O, 1.f / lt, gw, MIX + ((size_t)b * SEQ + t) * DM + 768 + h * 64, hi);
}

constexpr int SEL_IQ_PITCH = 528, SEL_CNT_OFF = 17408;
__device__ __forceinline__ unsigned ordkey(float f);
template <int PRED  >
__device__ __forceinline__ unsigned sel_count_round(const unsigned (&key)[8][16], unsigned c, unsigned tau, int idx0, int r32, int hi, int wave, LAS unsigned* cb) {
    int n = 0;
#pragma unroll
    for (int i = 0; i < 8; ++i) {
#pragma unroll
        for (int r = 0; r < 16; ++r) {
            if (PRED == 0) n += (key[i][r] >= c) ? 1 : 0;
            else if (PRED == 1) n += (key[i][r] > c) ? 1 : 0;
            else n += (key[i][r] == tau && (unsigned)(idx0 + 256 * i + (r & 3) + 8 * (r >> 2)) <= c) ? 1 : 0;
            if ((r & 7) == 7) asm volatile("" : "+v"(n));
        }
    }
    n += __shfl_xor(n, 32);
    if (hi == 0) cb[wave * 32 + r32] = (unsigned)n;
    __syncthreads();
    unsigned tot = 0;
#pragma unroll
    for (int w = 0; w < 8; ++w) tot += cb[w * 32 + r32];
    return tot;
}
constexpr int SEL_CAP = 64, SEL_DONE = 16;
__device__ __forceinline__ float key2f(unsigned k) { return __uint_as_float((k & 0x80000000u) ? (k & 0x7fffffffu) : ~k); }
__device__ __forceinline__ unsigned sel_count_lane(const unsigned (&key)[8][16], unsigned c) {
    int n = 0;
#pragma unroll
    for (int i = 0; i < 8; ++i) {
#pragma unroll
        for (int r = 0; r < 16; ++r) {
            n += (key[i][r] >= c) ? 1 : 0;
            if ((r & 7) == 7) asm volatile("" : "+v"(n));
        }
    }
    return (unsigned)n;
}
__device__ __forceinline__ unsigned sel_exchange(unsigned nl, int r32, int hi, int wave, LAS unsigned* cb) {
    const unsigned n2 = nl + xhalf_other_u(nl, hi);
    if (hi == 0) cb[wave * 32 + r32] = n2;
    __syncthreads();
    unsigned tot = 0;
#pragma unroll
    for (int w = 0; w < 8; ++w) tot += cb[w * 32 + r32];
    return tot;
}
__device__ __forceinline__ void sel_item2(const bf16_t* PROJ, unsigned* MASK, int b, int qt, int lane, int wave, LAS unsigned char* L) {
    asm volatile("" : "+v"(lane));
    const int r32 = lane & 31, hi = lane >> 5, tid = wave * 64 + lane;
    LAS unsigned* cntb = (LAS unsigned*)(L + SEL_CNT_OFF);
    const bf16_t* base = PROJ + (size_t)b * SEQ * LDP;
    unsigned* mrow = MASK + (((size_t)b * 64 + qt) * 64) * 32;
    if (qt < 8) {
#pragma unroll
        for (int i = 0; i < 8; ++i) {
            const int kt = wave + 8 * i;
            if (kt <= qt) {
                unsigned bits = 0u;
#pragma unroll
                for (int r = 0; r < 16; ++r) bits |= ((kt < qt) || (crow(r, hi) <= r32)) ? (1u << r) : 0u;
                const unsigned other = xhalf_other_u(bits, hi);
                if (hi == 0) mrow[kt * 32 + r32] = bits | (other << 16);
            }
        }
        return;
    }
    for (int n = tid; n < 1024; n += 512) { const int row = n >> 5, ch = n & 31;
        const v4u v = *(const v4u*)(base + (size_t)(32 * qt + row) * LDP + C_IDQ + ch * 8);
        *(LAS v4u*)(L + row * SEL_IQ_PITCH + ch * 16) = v; }
    float w8[8];
    { const v4u wv = *(const v4u*)(base + (size_t)(32 * qt + r32) * LDP + C_IDW);
      w8[0] = __uint_as_float(wv.x << 16) * 0.0625f; w8[1] = __uint_as_float(wv.x & 0xffff0000u) * 0.0625f; w8[2] = __uint_as_float(wv.y << 16) * 0.0625f; w8[3] = __uint_as_float(wv.y & 0xffff0000u) * 0.0625f;
      w8[4] = __uint_as_float(wv.z << 16) * 0.0625f; w8[5] = __uint_as_float(wv.z & 0xffff0000u) * 0.0625f; w8[6] = __uint_as_float(wv.w << 16) * 0.0625f; w8[7] = __uint_as_float(wv.w & 0xffff0000u) * 0.0625f; }
    __syncthreads();
    unsigned key[8][16];
    const LAS unsigned char* iqp = L + r32 * SEL_IQ_PITCH + 16 * hi;
    unsigned kmn = 0xffffffffu, kmx = 0u;
#pragma unroll
    for (int i = 0; i < 8; ++i) {
        const int kt = wave + 8 * i;
        if (kt <= qt) {
            const bf16_t* kp = base + (size_t)(32 * kt + r32) * LDP + C_IDK + 8 * hi;
            const bf16x8 k0 = *(const bf16x8*)kp, k1 = *(const bf16x8*)(kp + 16);
            float sc[16];
#pragma unroll
            for (int r = 0; r < 16; ++r) sc[r] = 0.f;
            unsigned iqo = 0; asm volatile("" : "+v"(iqo));
            const LAS unsigned char* iqt = iqp + iqo;
#pragma unroll
            for (int hp = 0; hp < 4; ++hp) {
                const int h = 2 * hp;
                bf16x8 q0 = *(const LAS bf16x8*)(iqt + h * 64), q1 = *(const LAS bf16x8*)(iqt + h * 64 + 32);
                bf16x8 q2 = *(const LAS bf16x8*)(iqt + h * 64 + 64), q3 = *(const LAS bf16x8*)(iqt + h * 64 + 96);
                asm volatile("" : "+v"(q0), "+v"(q1), "+v"(q2), "+v"(q3) : "v"(sc[15]));
                f32x16 Da = MFMA32(k0, q0, zero16());
                f32x16 Db = MFMA32(k0, q2, zero16());
                Da = MFMA32(k1, q1, Da);
                Db = MFMA32(k1, q3, Db);
#pragma unroll
                for (int r = 0; r < 16; ++r) sc[r] += w8[h] * fmaxf(Da[r], 0.f);
#pragma unroll
                for (int r = 0; r < 16; ++r) sc[r] += w8[h + 1] * fmaxf(Db[r], 0.f);
                asm volatile("" : "+v"(sc[0]), "+v"(sc[1]), "+v"(sc[2]), "+v"(sc[3]), "+v"(sc[4]), "+v"(sc[5]), "+v"(sc[6]), "+v"(sc[7]),
                                  "+v"(sc[8]), "+v"(sc[9]), "+v"(sc[10]), "+v"(sc[11]), "+v"(sc[12]), "+v"(sc[13]), "+v"(sc[14]), "+v"(sc[15]));
            }
            int thr = (kt < qt) ? 64 : (r32 - 4 * hi);
            asm volatile("" : "+v"(thr));
#pragma unroll
            for (int r = 0; r < 16; ++r) { const bool v = ((r & 3) + 8 * (r >> 2) <= thr); const unsigned k = ordkey(sc[r]); key[i][r] = v ? k : 0u; kmx = max(kmx, v ? k : 0u); kmn = min(kmn, v ? k : 0xffffffffu); }
        } else {
#pragma unroll
            for (int r = 0; r < 16; ++r) key[i][r] = 0u;
        }
    }
    unsigned lo_key, hi_key, clo, chi = 0u, nlo_l, nhi_l = 0u;
    {
        int nv = 0;
#pragma unroll
        for (int i = 0; i < 8; ++i) { const int kt = wave + 8 * i; nv += (kt < qt) ? 16 : 0; }
        if ((qt & 7) == wave) { const int thr = r32 - 4 * hi;
#pragma unroll
            for (int r = 0; r < 16; ++r) nv += ((r & 3) + 8 * (r >> 2) <= thr) ? 1 : 0; }
        nlo_l = (unsigned)nv;
        kmn = min(kmn, xhalf_other_u(kmn, hi)); kmx = max(kmx, xhalf_other_u(kmx, hi));
        if (hi == 0) { cntb[wave * 32 + r32] = kmn; cntb[256 + wave * 32 + r32] = kmx; }
        __syncthreads();
        unsigned a = 0xffffffffu, bmx = 0u;
#pragma unroll
        for (int w = 0; w < 8; ++w) { a = min(a, cntb[w * 32 + r32]); bmx = max(bmx, cntb[256 + w * 32 + r32]); }
        lo_key = a; hi_key = bmx + 1u; clo = (unsigned)(32 * qt + r32 + 1);
        __syncthreads();
    }
    int round = 0;
    for (;;) {
        const bool done = (clo - chi <= (unsigned)SEL_DONE) || (hi_key - lo_key <= 1u);
        if (__all(done)) break;
        unsigned p;
        if ((round & 3) == 3) p = lo_key + ((hi_key - lo_key) >> 1);
        else p = ordkey(0.5f * key2f(lo_key) + 0.5f * key2f(hi_key));
        p = min(max(p, lo_key + 1u), hi_key - 1u);
        if (done) p = lo_key;
        const unsigned nl = sel_count_lane(key, p);
        const unsigned tot = sel_exchange(nl, r32, hi, wave, cntb + (round & 1) * 256);
        if (!done) { if (tot >= 256u) { lo_key = p; clo = tot; nlo_l = nl; } else { hi_key = p; chi = tot; nhi_l = nl; } }
        ++round;
    }
    unsigned tau, cut;
    const bool many = (clo - chi > (unsigned)SEL_CAP);
    {
        LAS unsigned* lanecnt = (LAS unsigned*)L; LAS unsigned* meta = (LAS unsigned*)(L + 2048); LAS unsigned* result = (LAS unsigned*)(L + 2304); LAS unsigned* list = (LAS unsigned*)(L + 20480);
        const int slot = wave * 2 + hi;
        lanecnt[r32 * 16 + slot] = many ? 0u : (nlo_l - nhi_l);
        if (slot == 0) { meta[2 * r32] = many ? 0u : (clo - chi); meta[2 * r32 + 1] = 256u - chi; }
        __syncthreads();
        unsigned bs = 0u;
#pragma unroll
        for (int s2 = 0; s2 < 16; ++s2) { const unsigned v = lanecnt[r32 * 16 + s2]; bs += (s2 < slot) ? v : 0u; }
        if (!many) {
            const int idx0 = 32 * wave + 4 * hi;
            LAS unsigned* lp = list + (r32 * SEL_CAP + bs) * 2;
#pragma unroll
            for (int i = 0; i < 8; ++i)
#pragma unroll
                for (int r = 0; r < 16; ++r) {
                    const unsigned k = key[i][r];
                    if (k >= lo_key && k < hi_key) { lp[0] = k; lp[1] = (unsigned)(idx0 + 256 * i + (r & 3) + 8 * (r >> 2)); lp += 2; }
                }
        }
        __syncthreads();
        for (int j = 0; j < 4; ++j) {
            const int q = 4 * wave + j;
            const unsigned ncand = (unsigned)__builtin_amdgcn_readfirstlane((int)meta[2 * q]), need = (unsigned)__builtin_amdgcn_readfirstlane((int)meta[2 * q + 1]);
            const LAS unsigned* lq = list + q * SEL_CAP * 2;
            const bool mine = (unsigned)lane < ncand;
            const unsigned kc = mine ? lq[2 * lane] : 0u, ic = mine ? lq[2 * lane + 1] : 0u;
            unsigned rank = 0u;
            for (unsigned c2 = 0; c2 < ncand; ++c2) {
                const unsigned k2 = (unsigned)__builtin_amdgcn_readlane((int)kc, (int)c2), i2 = (unsigned)__builtin_amdgcn_readlane((int)ic, (int)c2);
                rank += (k2 > kc || (k2 == kc && i2 < ic)) ? 1u : 0u;
            }
            if (mine && rank == need - 1u) { result[2 * q] = kc; result[2 * q + 1] = ic; }
        }
        __syncthreads();
        tau = result[2 * r32]; cut = result[2 * r32 + 1];
    }
    if (__any(many)) {
        const unsigned need = 256u - chi;
        const int idx0 = 32 * wave + 4 * hi;
        unsigned lo_ = 0u, hi_ = 2047u;
        for (int it = 0; it < 11; ++it) {
            const unsigned mid = (lo_ + hi_) >> 1;
            const unsigned f = sel_count_round<2>(key, mid, lo_key, idx0, r32, hi, wave, cntb + (it & 1) * 256);
            if (f >= need) hi_ = mid; else lo_ = mid + 1;
        }
        if (many) { tau = lo_key; cut = hi_; }
    }
    {
        const int idx0 = 32 * wave + 4 * hi;
#pragma unroll
        for (int i = 0; i < 8; ++i) {
            const int kt = wave + 8 * i;
            if (kt <= qt) {
                unsigned bits = 0u;
#pragma unroll
                for (int r = 0; r < 16; ++r) {
                    const bool s = (key[i][r] > tau) || (key[i][r] == tau && (unsigned)(idx0 + 256 * i + (r & 3) + 8 * (r >> 2)) <= cut);
                    bits |= s ? (1u << r) : 0u;
                }
                const unsigned other = xhalf_other_u(bits, hi);
                if (hi == 0) mrow[kt * 32 + r32] = bits | (other << 16);
            }
        }
    }
    __syncthreads();
}

constexpr int WS_WUK = 0;
constexpr int WS_WUV = 256 * 1024;
constexpr int DSA_BIAS_OFF = 16384;
__device__ __forceinline__ unsigned dsa_off(unsigned row, unsigned ch) { return 256u * row + 16u * (ch ^ (((row & 3u) << 2) | ((row >> 2) & 3u))); }
constexpr int DSA_NBUF = 6, DSA_MASK_OFF = 49152, DSA_BIAS2_OFF = 114688;
__device__ __forceinline__ void glds16(const void* gsrc, unsigned lds_dst) { unsigned keep;
    asm volatile("s_mov_b32 %0, m0\n\ts_mov_b32 m0, %2\n\ts_nop 0\n\tglobal_load_lds_dwordx4 %1, off\n\ts_mov_b32 m0, %0" : "=&s"(keep) : "v"(gsrc), "s"(lds_dst) : "memory"); }
__device__ __forceinline__ void lds_read8_b128(bf16x8 (&a)[8], unsigned be, unsigned bo) {
    asm volatile("ds_read_b128 %0, %8\n\tds_read_b128 %1, %9\n\tds_read_b128 %2, %8 offset:512\n\tds_read_b128 %3, %9 offset:512\n\t"
                 "ds_read_b128 %4, %8 offset:1024\n\tds_read_b128 %5, %9 offset:1024\n\tds_read_b128 %6, %8 offset:1536\n\tds_read_b128 %7, %9 offset:1536"
                 : "=&v"(a[0]), "=&v"(a[1]), "=&v"(a[2]), "=&v"(a[3]), "=&v"(a[4]), "=&v"(a[5]), "=&v"(a[6]), "=&v"(a[7]) : "v"(be), "v"(bo));
}
template <int N> __device__ __forceinline__ void lgkm_wait(bf16x8& a) { asm volatile("s_waitcnt lgkmcnt(%1)" : "+v"(a) : "n"(N)); }
__device__ __forceinline__ void lds_read16_tr(s16x4 (&f)[4][4], unsigned b0, unsigned b1) {
    asm volatile("ds_read_b64_tr_b16 %0, %16\n\tds_read_b64_tr_b16 %1, %17 offset:2048\n\tds_read_b64_tr_b16 %2, %16 offset:4096\n\tds_read_b64_tr_b16 %3, %17 offset:6144\n\t"
                 "ds_read_b64_tr_b16 %4, %16 offset:512\n\tds_read_b64_tr_b16 %5, %17 offset:2560\n\tds_read_b64_tr_b16 %6, %16 offset:4608\n\tds_read_b64_tr_b16 %7, %17 offset:6656\n\t"
                 "ds_read_b64_tr_b16 %8, %16 offset:1024\n\tds_read_b64_tr_b16 %9, %17 offset:3072\n\tds_read_b64_tr_b16 %10, %16 offset:5120\n\tds_read_b64_tr_b16 %11, %17 offset:7168\n\t"
                 "ds_read_b64_tr_b16 %12, %16 offset:1536\n\tds_read_b64_tr_b16 %13, %17 offset:3584\n\tds_read_b64_tr_b16 %14, %16 offset:5632\n\tds_read_b64_tr_b16 %15, %17 offset:7680"
                 : "=&v"(f[0][0]), "=&v"(f[0][1]), "=&v"(f[0][2]), "=&v"(f[0][3]), "=&v"(f[1][0]), "=&v"(f[1][1]), "=&v"(f[1][2]), "=&v"(f[1][3]),
                   "=&v"(f[2][0]), "=&v"(f[2][1]), "=&v"(f[2][2]), "=&v"(f[2][3]), "=&v"(f[3][0]), "=&v"(f[3][1]), "=&v"(f[3][2]), "=&v"(f[3][3]) : "v"(b0), "v"(b1));
}
__device__ __forceinline__ void lgkm_wait_all(s16x4 (&f)[4][4]) {
    asm volatile("s_waitcnt lgkmcnt(0)" : "+v"(f[0][0]), "+v"(f[0][1]), "+v"(f[0][2]), "+v"(f[0][3]), "+v"(f[1][0]), "+v"(f[1][1]), "+v"(f[1][2]), "+v"(f[1][3]),
                   "+v"(f[2][0]), "+v"(f[2][1]), "+v"(f[2][2]), "+v"(f[2][3]), "+v"(f[3][0]), "+v"(f[3][1]), "+v"(f[3][2]), "+v"(f[3][3]));
}
__device__ __forceinline__ void dsa_round(const bf16_t* PROJ, const bf16_t* CKVN, const unsigned* MASK, const bf16_t* WUKp  , const bf16_t* WUVp  ,
                                          const float* rel_bias, bf16_t* MIX, int b, int o, int h, int lane, int wave, LAS unsigned char* L) {
    asm volatile("" : "+v"(lane));
    float NINF; asm volatile("v_mov_b32 %0, 0xff800000" : "=v"(NINF));
    const int r32 = lane & 31, hi = lane >> 5, tid = wave * 64 + lane;
    const int qt = 8 * o + wave, KT = 8 * o + 7, t = 32 * qt + r32;
    const int srow = 8 * (wave >> 1) + ((lane >> 2) & 7);
    const int sch = 4 * (2 * (wave & 1) + (lane >> 5)) + ((lane & 3) ^ ((2 * (wave >> 1) + ((lane >> 4) & 1)) & 3));
    const bf16_t* csrc = CKVN + ((size_t)b * SEQ + srow) * 128 + 8 * sch;
    const unsigned ring0 = (unsigned)__builtin_amdgcn_readfirstlane((int)(unsigned)(size_t)L) + 1024u * (unsigned)wave;
    LAS unsigned* maskL = (LAS unsigned*)(L + DSA_MASK_OFF + wave * 8192);
    {
        const unsigned char* msrc = (const unsigned char*)(MASK + (((size_t)b * 64 + qt) * 64) * 32) + 16 * lane;
        const unsigned mdst = (unsigned)__builtin_amdgcn_readfirstlane((int)(unsigned)(size_t)maskL);
        for (int p = 0; 8 * p <= qt; ++p) glds16(msrc + 1024 * p, mdst + 1024u * (unsigned)p);
    }
    glds16(csrc, ring0); glds16(csrc + (size_t)32 * 128, ring0 + 8192u); glds16(csrc + (size_t)64 * 128, ring0 + 16384u); glds16(csrc + (size_t)96 * 128, ring0 + 24576u);
    LAS float* biasT = (LAS float*)(L + DSA_BIAS2_OFF);
    if (tid < 192) { const int bk = tid < 128 ? (int)T5TAB[tid] : 31; biasT[tid] = rel_bias[bk * 6 + h] * LOG2E; }
    const float bias31 = rel_bias[31 * 6 + h] * LOG2E;
    bf16x8 qlf[8];
    {
        const bf16_t* qrow = PROJ + ((size_t)b * SEQ + t) * LDP + C_DSQ + h * 64 + 8 * hi;
        bf16x8 qf[4];
#pragma unroll
        for (int ks = 0; ks < 4; ++ks) qf[ks] = *(const bf16x8*)(qrow + 16 * ks);
        bf16x8 wk[16];
#pragma unroll
        for (int rt = 0; rt < 4; ++rt) {
            const GAS bf16_t* wp = (const GAS bf16_t*)WUKp + (rt * 32 + r32) * 64 + 8 * hi;
#pragma unroll
            for (int ks = 0; ks < 4; ++ks) wk[rt * 4 + ks] = *(const GAS bf16x8*)(wp + 16 * ks);
        }
        asm volatile("" : "+v"(wk[0]), "+v"(wk[1]), "+v"(wk[2]), "+v"(wk[3]), "+v"(wk[4]), "+v"(wk[5]), "+v"(wk[6]), "+v"(wk[7]),
                          "+v"(wk[8]), "+v"(wk[9]), "+v"(wk[10]), "+v"(wk[11]), "+v"(wk[12]), "+v"(wk[13]), "+v"(wk[14]), "+v"(wk[15]));
#pragma unroll
        for (int rt = 0; rt < 4; ++rt) {
            f32x16 X;
#pragma unroll
            for (int r = 0; r < 16; ++r) X[r] = 0.f;
#pragma unroll
            for (int ks = 0; ks < 4; ++ks) X = MFMA32(wk[rt * 4 + ks], qf[ks], X);
#pragma unroll
            for (int r = 0; r < 16; ++r) X[r] *= 0.125f * LOG2E;
            qlf[2 * rt] = pack8(X, 0); qlf[2 * rt + 1] = pack8(X, 1);
        }
    }
    f32x16 O[4];
#pragma unroll
    for (int c = 0; c < 4; ++c)
#pragma unroll
        for (int r = 0; r < 16; ++r) O[c][r] = 0.f;
    float mref = NINF, lrun = 0.f;
    const unsigned x2 = ((unsigned)r32 >> 2) & 3u;
    const unsigned rb_e = 2048u * ((unsigned)r32 >> 3) + 64u * ((unsigned)r32 & 7u) + 16u * ((unsigned)hi ^ x2);
    const unsigned rb_o = 2048u * ((unsigned)r32 >> 3) + 64u * ((unsigned)r32 & 7u) + 16u * ((2u + (unsigned)hi) ^ x2);
    const unsigned tq = (lane & 15) >> 2, tp = lane & 3, tblk = (lane >> 4) & 1;
    const unsigned tb0 = 64u * (4u * hi + tq) + 16u * ((2u * tblk + (tp >> 1)) ^ ((unsigned)hi & 3u)) + 8u * (tp & 1);
    const unsigned tb1 = 64u * (4u * hi + tq) + 16u * ((2u * tblk + (tp >> 1)) ^ ((2u + (unsigned)hi) & 3u)) + 8u * (tp & 1);
    __syncthreads();
    asm volatile("s_waitcnt vmcnt(0) lgkmcnt(0)" ::: "memory");
    auto dsa_qk = [&](const int kt, f32x16& S, const LAS unsigned char* Cb) __attribute__((always_inline)) {
        if (kt <= qt) {
#pragma unroll
            for (int r = 0; r < 16; ++r) S[r] = 0.f;
            bf16x8 a[8];
            const unsigned cb32 = (unsigned)(size_t)Cb;
            lds_read8_b128(a, cb32 + rb_e, cb32 + rb_o);
            lgkm_wait<7>(a[0]); S = MFMA32(a[0], qlf[0], S);
            lgkm_wait<6>(a[1]); S = MFMA32(a[1], qlf[1], S);
            lgkm_wait<5>(a[2]); S = MFMA32(a[2], qlf[2], S);
            lgkm_wait<4>(a[3]); S = MFMA32(a[3], qlf[3], S);
            lgkm_wait<3>(a[4]); S = MFMA32(a[4], qlf[4], S);
            lgkm_wait<2>(a[5]); S = MFMA32(a[5], qlf[5], S);
            lgkm_wait<1>(a[6]); S = MFMA32(a[6], qlf[6], S);
            lgkm_wait<0>(a[7]); S = MFMA32(a[7], qlf[7], S);
        }
    };
    auto dsa_tile = [&](const int kt, f32x16& S, const LAS unsigned char* Cb, const unsigned mwc) __attribute__((always_inline)) {
        if (kt <= qt) {
            s16x4 f[4][4];
            lds_read16_tr(f, (unsigned)(size_t)Cb + tb0, (unsigned)(size_t)Cb + tb1);
            const unsigned mw = mwc;
            const int dq = qt - kt;
            float cb = bias31;
            if (__builtin_amdgcn_readfirstlane(dq) < 5) {
                asm volatile("" ::: "memory");
                cb = 0.f;
                const int rel0 = 32 * dq + r32 - 4 * hi;
#pragma unroll
                for (int r = 0; r < 16; ++r) { int rel = rel0 - ((r & 3) + 8 * (r >> 2)); rel = rel < 0 ? 0 : rel; S[r] += biasT[rel]; }
                asm volatile("" ::: "memory");
            }
            float mx = fmaxf(S[0], S[1]);
#pragma unroll
            for (int r = 2; r < 16; ++r) mx = fmaxf(mx, S[r]);
            mx = xhalf_max(mx) + cb;
            if (__any(mx > mref + 8.f)) {
                float mm = NINF;
                asm volatile("" : "+v"(mm));
#pragma unroll
                for (int r = 0; r < 16; ++r) mm = fmaxf(mm, ((mw >> r) & 1u) ? S[r] : NINF);
                mm = xhalf_max(mm) + cb;
                const float mn = fmaxf(mref, mm);
                const float alpha = (mn > mref) ? __builtin_amdgcn_exp2f(mref - mn) : 1.f;
                mref = mn; lrun *= alpha;
#pragma unroll
                for (int c = 0; c < 4; ++c)
#pragma unroll
                    for (int r = 0; r < 16; ++r) asm volatile("v_mul_f32 %0, %0, %1" : "+v"(O[c][r]) : "v"(alpha));
            }
            const float off = ((mref == NINF) ? 0.f : mref) - cb;
            float ps0 = 0.f, ps1 = 0.f;
#pragma unroll
            for (int r = 0; r < 16; ++r) {
                const float e = __builtin_amdgcn_exp2f(S[r] - off);
                int m1; asm("v_bfe_i32 %0, %1, %2, 1" : "=v"(m1) : "v"(mw), "n"(r));
                S[r] = __uint_as_float(__float_as_uint(e) & (unsigned)m1);
                if (r & 1) ps1 += S[r]; else ps0 += S[r];
            }
            lrun += ps0 + ps1;
            const bf16x8 p0 = pack8(S, 0), p1 = pack8(S, 1);
            lgkm_wait_all(f);
#pragma unroll
            for (int c = 0; c < 4; ++c) {
                O[c] = MFMA32(cat44(f[c][0], f[c][1]), p0, O[c]);
                O[c] = MFMA32(cat44(f[c][2], f[c][3]), p1, O[c]);
            }
        }
    };
    const int NS = (KT + 1) >> 1;
    v2u gatew[8];
#pragma unroll
    for (int i = 0; i < 8; ++i) { gatew[i].x = 0u; gatew[i].y = 0u; }
    int sl = 0;
    const bool late = (wave & 4) != 0;
    unsigned mwA = maskL[r32], mwB = maskL[32 + r32];
    for (int st = 0; st < NS; ++st) {
        if (st + 1 < NS) asm volatile("s_waitcnt vmcnt(2)\n\ts_barrier" ::: "memory");
        else asm volatile("s_waitcnt vmcnt(0)\n\ts_barrier" ::: "memory");
        if (st + 2 < NS) { int s2 = sl + 4; s2 = s2 >= 6 ? s2 - 6 : s2;
            glds16(csrc + (size_t)(64 * (st + 2)) * 128, ring0 + 8192u * (unsigned)s2); glds16(csrc + (size_t)(64 * (st + 2) + 32) * 128, ring0 + 8192u * (unsigned)(s2 + 1)); }
        if (st == NS - 1) gate_load(gatew, PROJ + ((size_t)b * SEQ + t) * LDP + C_DSG + h * 64, hi);
        unsigned mw0 = mwA >> (16 * hi), mw1 = mwB >> (16 * hi);
        asm volatile("" : "+v"(mw0), "+v"(mw1));
        f32x16 S0, S1;
        dsa_qk(2 * st, S0, L + sl * 8192);
        if (late) dsa_qk(2 * st + 1, S1, L + (sl + 1) * 8192);
        dsa_tile(2 * st, S0, L + sl * 8192, mw0);
        if (!late) dsa_qk(2 * st + 1, S1, L + (sl + 1) * 8192);
        dsa_tile(2 * st + 1, S1, L + (sl + 1) * 8192, mw1);
        if (st + 1 < NS) { mwA = maskL[(2 * st + 2) * 32 + r32]; mwB = maskL[(2 * st + 3) * 32 + r32]; }
        sl = (sl == 4) ? 0 : sl + 2;
    }
    const float lt = xhalf_sum(lrun);
    const float il = 1.f / lt;
    f32x16 Y[2];
#pragma unroll
    for (int r = 0; r < 16; ++r) { Y[0][r] = 0.f; Y[1][r] = 0.f; }
    bf16x8 wv[16];
    {
        int l3 = lane; asm volatile("" : "+v"(l3));
#pragma unroll
        for (int rt = 0; rt < 4; ++rt)
#pragma unroll
            for (int c = 0; c < 2; ++c) {
                const GAS bf16_t* wp = (const GAS bf16_t*)WUVp + ((((c * 4 + rt) * 2 + 0) * 32 + (l3 & 31)) * 2 + (l3 >> 5)) * 8;
                wv[(rt * 2 + c) * 2] = *(const GAS bf16x8*)wp; wv[(rt * 2 + c) * 2 + 1] = *(const GAS bf16x8*)(wp + 32 * 2 * 8);
            }
        asm volatile("" : "+v"(wv[0]), "+v"(wv[1]), "+v"(wv[2]), "+v"(wv[3]), "+v"(wv[4]), "+v"(wv[5]), "+v"(wv[6]), "+v"(wv[7]),
                          "+v"(wv[8]), "+v"(wv[9]), "+v"(wv[10]), "+v"(wv[11]), "+v"(wv[12]), "+v"(wv[13]), "+v"(wv[14]), "+v"(wv[15]));
    }
#pragma unroll
    for (int rt = 0; rt < 4; ++rt) {
#pragma unroll
        for (int r = 0; r < 16; ++r) O[rt][r] *= il;
        const bf16x8 x0 = pack8(O[rt], 0), x1 = pack8(O[rt], 1);
#pragma unroll
        for (int c = 0; c < 2; ++c) {
            Y[c] = MFMA32(wv[(rt * 2 + c) * 2], x0, Y[c]);
            Y[c] = MFMA32(wv[(rt * 2 + c) * 2 + 1], x1, Y[c]);
        }
    }
    {
        int l2 = lane; asm volatile("" : "+v"(l2));
        const int t2 = 32 * qt + (l2 & 31);
        gate_store_pre(Y, 1.f, gatew, MIX + ((size_t)b * SEQ + t2) * DM + 384 + h * 64, l2 >> 5);
    }
    asm volatile("s_waitcnt lgkmcnt(0)\n\ts_barrier" ::: "memory");
}

typedef GAS unsigned gu32;
#define RLX_AGENT __ATOMIC_RELAXED, __HIP_MEMORY_SCOPE_AGENT
constexpr size_t WS_BAR = 512 * 1024;
#define XB_TMO      128
#define XB_XCNT(j)  (256  + 64 * (j))
#define XB_XSUB(j)  (1280 + 64 * (j))
#define XB_XGEN(j)  (2304 + 64 * (j))
#define XB_TOP      3328
#define XB_TOPGEN   3392
#define XCD_BAR_WORDS 3456
#define XB_SPIN_CAP (1u << 18)

__device__ __forceinline__ unsigned xb_ld(unsigned* p)              { return __hip_atomic_load(p, __ATOMIC_RELAXED, __HIP_MEMORY_SCOPE_AGENT); }
__device__ __forceinline__ unsigned xb_add(unsigned* p, unsigned v) { return __hip_atomic_fetch_add(p, v, __ATOMIC_RELAXED, __HIP_MEMORY_SCOPE_AGENT); }
__device__ __forceinline__ unsigned xb_xcc_id() { return (unsigned)__builtin_amdgcn_s_getreg((3 << 11) | 20) & 0xFu; }
#define XB_SPIN(cond, bar) do { unsigned _sp = 0; while (cond) { __builtin_amdgcn_s_sleep(1); \
    if ((++_sp & 255u) == 0u) { if (xb_ld(&(bar)[XB_TMO])) break; if (_sp > XB_SPIN_CAP) { atomicAdd(&(bar)[XB_TMO], 1u); break; } } } } while (0)

struct XcdBarrier {
    unsigned* bar; unsigned x;
    volatile LAS unsigned* st;
};

__device__ __forceinline__ XcdBarrier xcd_barrier_post(unsigned* bar, volatile LAS unsigned* st) {
    XcdBarrier b; b.bar = bar; b.x = xb_xcc_id(); b.st = st;
    if (threadIdx.x == 0) (void)xb_add(&bar[XB_XCNT(b.x)], 1u);
    return b;
}
__device__ __forceinline__ void xcd_barrier_complete(unsigned* bar, unsigned x, unsigned& nloc, unsigned& nx) {
    const unsigned G = gridDim.x * gridDim.y * gridDim.z;
    unsigned sum, cnt, mine, sp = 0u;
    for (;;) {
        sum = 0u; cnt = 0u; mine = 0u;
#pragma unroll
        for (unsigned j = 0; j < 16; ++j) { const unsigned c = xb_ld(&bar[XB_XCNT(j)]); sum += c; cnt += (c > 0u) ? 1u : 0u; mine = (j == x) ? c : mine; }
        if (sum == G) break;
        __builtin_amdgcn_s_sleep(1);
        if ((++sp & 255u) == 0u) { if (xb_ld(&bar[XB_TMO])) break; if (sp > XB_SPIN_CAP) { atomicAdd(&bar[XB_TMO], 1u); break; } }
    }
    nloc = mine > 0u ? mine : 1u; nx = cnt > 0u ? cnt : 1u;
}

__device__ __forceinline__ void xcd_barrier(const XcdBarrier& b) {
    asm volatile("s_waitcnt vmcnt(0)" ::: "memory");
    __syncthreads();
    if (threadIdx.x == 0) {
        unsigned* bar = b.bar;
        __builtin_amdgcn_s_waitcnt(0);
        unsigned nloc = b.st[0], nx = b.st[1];
        if (nloc == 0u) { xcd_barrier_complete(bar, b.x, nloc, nx); b.st[0] = nloc; b.st[1] = nx; }
        const unsigned old = xb_add(&bar[XB_XSUB(b.x)], 1u);
        const unsigned gen = old / nloc;
        if (old + 1u == (gen + 1u) * nloc) {
            __builtin_amdgcn_fence(__ATOMIC_RELEASE, "agent");
            asm volatile("s_waitcnt vmcnt(0)" ::: "memory");
            const unsigned og = xb_add(&bar[XB_TOP], 1u);
            const unsigned tg = og / nx;
            if (og + 1u == (tg + 1u) * nx) xb_add(&bar[XB_TOPGEN], 1u);
            else XB_SPIN(xb_ld(&bar[XB_TOPGEN]) == tg, bar);
            __builtin_amdgcn_fence(__ATOMIC_ACQUIRE, "agent");
            xb_add(&bar[XB_XGEN(b.x)], 1u);
            asm volatile("s_waitcnt vmcnt(0)" ::: "memory");
        } else {
            XB_SPIN(xb_ld(&bar[XB_XGEN(b.x)]) == gen, bar);
            __builtin_amdgcn_fence(__ATOMIC_ACQUIRE, "agent");
            asm volatile("s_waitcnt vmcnt(0)" ::: "memory");
        }
    }
    __syncthreads();
}

#ifndef MK_MULTI
#define MK_MULTI 0
#endif
constexpr int NPHASE = 11;
__global__ void __launch_bounds__(NWAVES * 64, 2) mk_fwd(Args args) {
    extern __shared__ __attribute__((aligned(16))) unsigned char lds_raw[];
    LAS unsigned char* lds = (LAS unsigned char*)lds_raw;
    const int tid0 = threadIdx.x;
    int wave_ = __builtin_amdgcn_readfirstlane(tid0 >> 6); asm volatile("" : "+s"(wave_));
    const int wave = wave_;
    const int G = gridDim.x, bid = blockIdx.x;
    for (int u = tid0; u < 16; u += NWAVES * 64) ((LAS unsigned*)(lds + 131072))[u] = 0u;
    __syncthreads();
    const XcdBarrier xbar = xcd_barrier_post((unsigned*)(args.ws + WS_BAR), (volatile LAS unsigned*)(lds + 131072));
    const int lo = args.ph_lo, hi = args.ph_hi;
#define IN(k) (lo <= (k) && (k) < hi)
#define SEAM(k) do { if (IN(k) && IN((k) + 1)) { if ((k) == 0) cg::this_grid().sync(); else xcd_barrier(xbar); } } while (0)
#define PH_BEGIN int lane = lane_id_v(); unsigned char* ws_ = args.ws; asm volatile("" : "+s"(ws_)); GAS unsigned char* ws = (GAS unsigned char*)ws_;     \
    const int gw = bid * NWAVES + wave, NGW = G * NWAVES; (void)gw; (void)NGW;
#define VCU_LOOP for (int vcu = vcu0; vcu < 256; vcu += G)
#define VCU_IDS const int bb = vcu >> 3, w64 = (vcu & 7) * 8 + wave; (void)bb; (void)w64;
#define P_WIN ((bf16_t*)(ws + WS_WIN))
#define P_WOUT ((bf16_t*)(ws + WS_WOUT))
#define P_WMEM ((bf16_t*)(ws + WS_WMEM))
#define P_MEMB ((bf16_t*)(ws + WS_MEMB))
#define P_MEMKV ((bf16_t*)(ws + WS_MEMKV))
#define P_CKVN ((bf16_t*)(ws + WS_CKVN))
#define P_MASK ((unsigned*)(ws + WS_MASK))
#define P_H ((bf16_t*)(ws + WS_H))
#define P_MIX ((bf16_t*)(ws + WS_MIX))
#define P_PROJ ((bf16_t*)(ws + WS_PROJ))
#define P_Y ((bf16_t*)(ws + WS_Y))
    const int vcu0 = (G % 8 == 0) ? (bid & 7) * (G >> 3) + (bid >> 3) : bid;

    if (IN(0)) {
        PH_BEGIN
        const float* x = args.in[0]; const float* mem = args.in[1]; const float* pre_g = args.in[2];
        const float* w_in = args.in[4]; const float* w_mem = args.in[8]; const float* w_out = args.in[9];
        LAS float* scr = (LAS float*)(lds + wave * 16384);
        constexpr int I_IN = 16 * (LDP / 32), I_OUT = 16 * 32, I_MEM = 16 * 16;
        constexpr int NITEMS = 2 * I_IN + 2 * I_OUT + 2 * I_MEM;
        for (int it = gw; it < NITEMS; it += NGW) {
            int r = it;
            if (r < 2 * I_IN) { const int l = r / I_IN; r -= l * I_IN; p0_transpose_item(w_in + (size_t)l * DM * NCOL, DM, NCOL, LDP, P_WIN + (size_t)l * LDP * DM, pre_g + l * DM, scr, r, lane); continue; }
            r -= 2 * I_IN;
            if (r < 2 * I_OUT) { const int l = r / I_OUT; r -= l * I_OUT; p0_transpose_item(w_out + (size_t)l * DM * DM, DM, DM, DM, P_WOUT + (size_t)l * DM * DM, nullptr, scr, r, lane); continue; }
            r -= 2 * I_OUT;
            { const int l = r / I_MEM; r -= l * I_MEM; p0_transpose_item(w_mem + (size_t)l * DM * 512, DM, 512, 512, P_WMEM + (size_t)l * 512 * DM, nullptr, scr, r, lane); }
        }
        {
            const float* w_uk = args.in[5]; const float* w_uv = args.in[6];
            bf16_t* WUKp = (bf16_t*)(ws + WS_WUK); bf16_t* WUVp = (bf16_t*)(ws + WS_WUV);
            for (int e = gw * 64 + lane; e < 2 * 6 * 8192; e += NGW * 64) {
                const int lh = e >> 13, l = lh / 6, h = lh % 6, w = e & 8191;
                { const int rt = w >> 11, rho = (w >> 6) & 31, d = w & 63; const int r = 32 * rt + ((rho & 0x13) | ((rho & 4) << 1) | ((rho & 8) >> 1));
                  WUKp[e] = (bf16_t)f2bf(w_uk[(((size_t)l * 128 + r) * 6 + h) * 64 + d]); }
                { const int j = w & 7, hh = (w >> 3) & 1, d32 = (w >> 4) & 31, s = (w >> 9) & 1, rt = (w >> 10) & 3, c = (w >> 12) & 1;
                  const int r = 32 * rt + 16 * s + 8 * (j >> 2) + 4 * hh + (j & 3), d = 32 * c + d32;
                  WUVp[e] = (bf16_t)f2bf(w_uv[(((size_t)l * 128 + r) * 6 + h) * 64 + d]); }
            }
        }
        for (int m = gw; m < NB * NMEM; m += NGW) row_to_bf16<false>(mem + (size_t)m * DM, P_MEMB + (size_t)m * DM, lane);
        for (int m = gw * 2; m < NTOK; m += NGW * 2) { row_to_bf16<true>(x + (size_t)m * DM, P_H + (size_t)m * DM, lane); row_to_bf16<true>(x + (size_t)(m + 1) * DM, P_H + (size_t)(m + 1) * DM, lane); }
    }
    SEAM(0);
#pragma unroll 1
    for (int l = 0; l < 2; ++l) {
        const int pb = 1 + 5 * l;
        if (IN(pb)) {
            PH_BEGIN
            { pg8::Gemm g{P_H, P_WIN + (size_t)l * LDP * DM, NTOK, LDP, DM}; pg8::StaticOrder S; S.init(NTOK, LDP, G, bid);
              pg8::EpiBf16<0> E{P_PROJ, LDP, nullptr, 0, 0, 1.f};
              pg8::gemm_phase<pg8::EpiBf16<0>, pg8::StaticOrder, true, true>(lds, g, S, E, wave); }
            if (l == 0) {
              pg8::Gemm g{P_MEMB, P_WMEM, NB * NMEM, 1024, DM}; pg8::StaticOrder S; S.init(NB * NMEM, 1024, G, bid);
              pg8::EpiBf16<0> E{P_MEMKV, 1024, nullptr, 0, 0, 1.f};
              pg8::gemm_phase<pg8::EpiBf16<0>, pg8::StaticOrder, true, true>(lds, g, S, E, wave); }
        }
        SEAM(pb);
        if (IN(pb + 1)) {
            { PH_BEGIN
              const float* kv_g = args.in[7];
              for (int m = gw * 8; m < NTOK; m += NGW * 8) { ckvnorm4(P_PROJ, kv_g + l * 128, P_CKVN, m, lane); ckvnorm4(P_PROJ, kv_g + l * 128, P_CKVN, m + 4, lane); } }
            VCU_LOOP { PH_BEGIN VCU_IDS
              for (int i = 0; i < 6; ++i) { const int qt = (i & 1) ? 63 - w64 : w64; sb_item(P_PROJ, P_MIX, bb, i, qt, lane, lds + wave * 16384); } }
            __syncthreads();
            VCU_LOOP { PH_BEGIN VCU_IDS
              const int s8 = vcu & 7;
              for (int j = 0; j < 8; ++j) { const int qt = 8 * j + ((j & 1) ? 7 - s8 : s8); sel_item2(P_PROJ, P_MASK, bb, qt, lane, wave, lds); } }
            __syncthreads();
            VCU_LOOP { PH_BEGIN VCU_IDS
              for (int i = 0; i < 4; ++i) {
                  __syncthreads();
                  mem_stage(P_MEMKV + l * 512, bb, i, wave * 64 + lane, lds);
                  __syncthreads();
                  mem_item_lds(P_PROJ, P_MIX, bb, i, w64, lane, lds);
              } }
        }
        SEAM(pb + 1);
        if (IN(pb + 2)) {
            __syncthreads();
            VCU_LOOP { PH_BEGIN VCU_IDS
              const float* rel_bias = args.in[10];
              const int s8 = vcu & 7, hs = (s8 < 4) ? 0 : 3;
              for (int oi = 0; oi < 2; ++oi) {
                  const int o = oi ? 7 - (s8 & 3) : (s8 & 3);
                  for (int hh = 0; hh < 3; ++hh) {
                      const int h = hs + hh;
                      dsa_round(P_PROJ, P_CKVN, P_MASK, (const bf16_t*)(ws + WS_WUK) + (size_t)(l * 6 + h) * 8192, (const bf16_t*)(ws + WS_WUV) + (size_t)(l * 6 + h) * 8192,
                                rel_bias, P_MIX, bb, o, h, lane, wave, lds);
                  }
              } }
        }
        SEAM(pb + 2);
        if (IN(pb + 3)) {
            PH_BEGIN
            __syncthreads();
            pg8::Gemm g{P_MIX, P_WOUT + (size_t)l * DM * DM, NTOK, DM, DM}; pg8::StaticOrder S; S.init(NTOK, DM, G, bid);
            pg8::EpiBf16<0> E{P_Y, DM, nullptr, 0, 0, 1.f};
            pg8::gemm_phase<pg8::EpiBf16<0>, pg8::StaticOrder, true, true>(lds, g, S, E, wave);
        }
        SEAM(pb + 3);
        if (IN(pb + 4)) {
            PH_BEGIN
            const float* xin = (l == 0) ? args.in[0] : args.out; const float* post_g = args.in[3];
            for (int m = gw * 2; m < NTOK; m += NGW * 2) { post_row(xin, P_Y, post_g + l * DM, args.out, (l == 0) ? P_H : (bf16_t*)nullptr, m, lane); post_row(xin, P_Y, post_g + l * DM, args.out, (l == 0) ? P_H : (bf16_t*)nullptr, m + 1, lane); }
        }
        SEAM(pb + 4);
    }
#undef IN
#undef SEAM
}

extern "C" void kernel_launch(void* const* d_in, const int* in_sizes, int n_in, void* d_out, int out_size, void* d_ws, size_t ws_size, hipStream_t stream) {
    static int grid = 0;
    if (grid == 0) {
        if (n_in != 11 || ws_size < WS_END) { fprintf(stderr, "kernel_launch: unexpected n_in %d / ws_size %zu\n", n_in, ws_size); grid = -1; return; }
        int dev = 0, cus = 0, per_cu = 0;
        hipGetDevice(&dev);
        hipDeviceGetAttribute(&cus, hipDeviceAttributeMultiprocessorCount, dev);
        hipFuncSetAttribute((const void*)mk_fwd, hipFuncAttributeMaxDynamicSharedMemorySize, LDS_BYTES);
        hipOccupancyMaxActiveBlocksPerMultiprocessor(&per_cu, (const void*)mk_fwd, NWAVES * 64, LDS_BYTES);
        if (per_cu < 1) { fprintf(stderr, "kernel_launch: occupancy query says %d blocks per CU\n", per_cu); per_cu = 1; }
        grid = cus * 1;
        (void)hipGetLastError();
    }
    if (grid < 0) return;
    (void)hipMemsetAsync((char*)d_ws + WS_BAR, 0, 16384, stream);
    Args a{};
    for (int i = 0; i < 11; ++i) a.in[i] = (const float*)d_in[i];
    a.out = (float*)d_out; a.ws = (unsigned char*)d_ws;
#if MK_MULTI
    for (int p = 0; p < NPHASE; ++p) { a.ph_lo = p; a.ph_hi = p + 1; hipLaunchKernelGGL(mk_fwd, dim3(grid), dim3(NWAVES * 64), LDS_BYTES, stream, a); }
#else
    a.ph_lo = 0; a.ph_hi = NPHASE;
    void* kargs[] = {&a};
    hipError_t e = hipLaunchCooperativeKernel((const void*)mk_fwd, dim3(grid), dim3(NWAVES * 64), kargs, LDS_BYTES, stream);
    if (e != hipSuccess) fprintf(stderr, "cooperative launch failed: %s (grid %d)\n", hipGetErrorString(e), grid);
#endif
}
```

```cpp
#include <hip/hip_runtime.h>
#include <hip/hip_cooperative_groups.h>
#include <stdint.h>
#include <math.h>
#include <cstdio>
namespace cg = cooperative_groups;
__device__ __forceinline__ int lane_id_v() { int l; asm volatile("v_mbcnt_lo_u32_b32 %0, -1, 0\n\tv_mbcnt_hi_u32_b32 %0, -1, %0" : "=v"(l)); return l; }
namespace pg8 {
#define PG8_LAS __attribute__((address_space(3)))
typedef unsigned short bf16_t;
typedef short bf16x8 __attribute__((ext_vector_type(8)));
typedef float f32x4 __attribute__((ext_vector_type(4)));
typedef unsigned u32x4 __attribute__((ext_vector_type(4)));
constexpr int BM = 256, BK = 64, HALF = 128, HTB = HALF * BK * 2  , STAGE_BYTES = 8 * HTB, NXCD = 8, WGM = 8;

__host__ __device__ __forceinline__ int lds_byte(int r, int c) { const int st = (r >> 4) * 2 + (c >> 5), rr = r & 15, cc = c & 31, ob = rr * 64 + cc * 2; return st * 1024 + (ob ^ (((ob >> 9) & 1) << 5)); }
__host__ __device__ __forceinline__ void stage_rc(int b, int& R, int& C) { const int st = b / 1024, sb = b % 1024, swz = sb ^ (((sb >> 9) & 1) << 5); R = (st >> 1) * 16 + swz / 64; C = (st & 1) * 32 + (swz % 64) / 2; }
__host__ __device__ __forceinline__ int perm32(int rho) { const int n = rho >> 4, i = rho & 15; return 8 * (i >> 2) + 4 * n + (i & 3); }

struct Unit { int pm, pn; };
struct Gemm { const bf16_t* A; const bf16_t* Bt; int M, N, K; };

struct StaticOrder {
    int nM, nN, nwg, G, c;
    __host__ __device__ void init(int M, int N, int G_, int c_) { nM = M / BM; nN = N / BM; nwg = nM * nN; G = G_; c = c_; }
    __host__ __device__ bool next(int i, Unit& u) const {
        const long L = (long)i * G + c; if (L >= nwg) return false;
        int wgid = (int)L; { const int q = nwg / NXCD, r = nwg % NXCD, xcd = wgid % NXCD, off = wgid / NXCD; wgid = (xcd < r ? xcd * (q + 1) : r * (q + 1) + (xcd - r) * q) + off; }
        const int nig = WGM * nN, gid = wgid / nig, fm = gid * WGM, gsz = (nM - fm) < WGM ? (nM - fm) : WGM;
        u.pm = fm + ((wgid % nig) % gsz); u.pn = (wgid % nig) / gsz; return true;
    }
    __device__ __forceinline__ void a_ready(const Unit&) const {}
    __device__ __forceinline__ void done(const Unit&) const {}
};

__device__ __forceinline__ unsigned cvt_pk_bf16(float lo, float hi) { unsigned r; asm volatile("v_cvt_pk_bf16_f32 %0, %1, %2" : "=v"(r) : "v"(lo), "v"(hi)); return r; }
typedef float f32x2 __attribute__((ext_vector_type(2)));
__device__ __forceinline__ f32x2 gelu_pk(f32x2 v) {
    const f32x2 av = __builtin_elementwise_abs(v), d = av * 0.2316418882f + 1.0f;
    f32x2 t; t.x = __builtin_amdgcn_rcpf(d.x); t.y = __builtin_amdgcn_rcpf(d.y);
    f32x2 q = t * 0.5307027145f + (-0.7265760135f); q = q * t + 0.7107068705f; q = q * t + (-0.142248368f); q = q * t + 0.127414796f; q = q * t;
    const f32x2 s = (v * v) * (-0.72134752044f);
    f32x2 e; e.x = __builtin_amdgcn_exp2f(s.x); e.y = __builtin_amdgcn_exp2f(s.y);
    const f32x2 m = v * (q * e), r = v - m;
    f32x2 o; o.x = v.x < 0.f ? m.x : r.x; o.y = v.y < 0.f ? m.y : r.y; return o;
}

template <int ACT  > struct EpiBf16 {
    static constexpr bool PERM = true, AFTER_DRAIN = false; static_assert(ACT == 0 || ACT == 1, "EpiBf16: ACT is 0 (none) or 1 (gelu_pk)");
    bf16_t* O; int ldc; const float* bias; int split_cols; size_t split_stride; float scale0;
    __device__ __forceinline__ void operator()(const f32x4 (&acc)[2][2][4][2], const Unit& u, int wr, int wc, int fr, int fq) const {
        const int row0 = u.pm * BM + wr * 64 + fr; int colt = u.pn * BM; bf16_t* base = O;
        float sc = 1.f; if (split_cols) { const int t = colt / split_cols; base += (size_t)t * split_stride; colt -= t * split_cols; if (t == 0) sc = scale0; }
        const int col0 = colt + wc * 32 + 8 * fq, bcol0 = u.pn * BM + wc * 32 + 8 * fq;
        f32x4 bv[2][2];
#pragma unroll
        for (int bj = 0; bj < 2; ++bj)
#pragma unroll
            for (int n = 0; n < 2; ++n) bv[bj][n] = bias ? *(const f32x4*)(bias + bcol0 + bj * HALF + 4 * n) : (f32x4){0.f, 0.f, 0.f, 0.f};
#pragma unroll
        for (int ai = 0; ai < 2; ++ai)
#pragma unroll
            for (int m = 0; m < 4; ++m) { bf16_t* rowp = base + (size_t)(row0 + ai * HALF + m * 16) * ldc + col0;
#pragma unroll
                for (int bj = 0; bj < 2; ++bj) { f32x4 v0 = acc[ai][bj][m][0] + bv[bj][0], v1 = acc[ai][bj][m][1] + bv[bj][1];
                    if (ACT == 1) { f32x2 a = gelu_pk((f32x2){v0[0], v0[1]}), b = gelu_pk((f32x2){v0[2], v0[3]}), c = gelu_pk((f32x2){v1[0], v1[1]}), d = gelu_pk((f32x2){v1[2], v1[3]});
                        v0 = (f32x4){a.x, a.y, b.x, b.y}; v1 = (f32x4){c.x, c.y, d.x, d.y}; }
                    v0 = v0 * sc; v1 = v1 * sc; u32x4 w; w.x = cvt_pk_bf16(v0[0], v0[1]); w.y = cvt_pk_bf16(v0[2], v0[3]); w.z = cvt_pk_bf16(v1[0], v1[1]); w.w = cvt_pk_bf16(v1[2], v1[3]);
                    *(u32x4*)(rowp + bj * HALF) = w; } }
    }
};
template <class Epi, class Sched, bool ALIGN_EPI = false, bool SP2 = false>
__device__ __forceinline__ void gemm_phase(PG8_LAS unsigned char* lds, const Gemm g, const Sched& S, const Epi& E, int wave_id) {
    int tid_ = wave_id * 64 + lane_id_v();
    const int tid = tid_, wid = __builtin_amdgcn_readfirstlane(tid >> 6), lane = tid & 63, wr = wid >> 2, wc = wid & 3, fr = lane & 15, fq = lane >> 4;
    const int K = g.K, nt = K / BK;
    unsigned voffA[2], voffB[2];
#pragma unroll
    for (int i = 0; i < 2; ++i) { int R, C; stage_rc(tid * 16 + i * 8192, R, C); const int Rb = Epi::PERM ? ((R & ~31) + perm32(R & 31)) : R;
        voffA[i] = (unsigned)(R * K + C) * 2u; voffB[i] = (unsigned)(Rb * K + C) * 2u; }
    const size_t kstep = (size_t)(BK * 2);
    const size_t hstep = (size_t)HALF * K * 2;
    const size_t tstep = 2 * hstep;
    const unsigned ldsw = (unsigned)wid * 1024u;
    const int aoff = lds_byte(wr * 64 + fr, fq * 8), boff = lds_byte(wc * 32 + fr, fq * 8);
#define PG8_SA(b, h) (((b) * 2 + (h)) * HTB)
#define PG8_SB(b, h) ((4 + (b) * 2 + (h)) * HTB)
#define PG8_STAGE(bufoff, gbase, voff) do { _Pragma("unroll") for (int _i = 0; _i < 2; ++_i) \
        __builtin_amdgcn_global_load_lds((const unsigned*)((const char*)(gbase) + (voff)[_i]), (PG8_LAS unsigned*)(lds + (bufoff) + ldsw + _i * 8192), 16, 0, 0); } while (0)
#define PG8_LDA(dst, b, h) do { _Pragma("unroll") for (int m = 0; m < 4; ++m) _Pragma("unroll") for (int k = 0; k < 2; ++k) dst[m][k] = *(const PG8_LAS bf16x8*)(lds + PG8_SA(b, h) + aoff + m * 2048 + k * 1024); } while (0)
#define PG8_LDB(dst, b, h) do { _Pragma("unroll") for (int n = 0; n < 2; ++n) _Pragma("unroll") for (int k = 0; k < 2; ++k) dst[n][k] = *(const PG8_LAS bf16x8*)(lds + PG8_SB(b, h) + boff + n * 2048 + k * 1024); } while (0)
#define PG8_MMA(ai, bj, At, Bt) do { __builtin_amdgcn_s_setprio(1); _Pragma("unroll") for (int m = 0; m < 4; ++m) _Pragma("unroll") for (int n = 0; n < 2; ++n) _Pragma("unroll") for (int k = 0; k < 2; ++k) \
        acc[ai][bj][m][n] = __builtin_amdgcn_mfma_f32_16x16x32_bf16(Bt[n][k], At[m][k], acc[ai][bj][m][n], 0, 0, 0); __builtin_amdgcn_s_setprio(0); } while (0)
#define PG8_WAIT_V(n) asm volatile("s_waitcnt vmcnt(" #n ")" ::: "memory")
#define PG8_WAIT_L(n) asm volatile("s_waitcnt lgkmcnt(" #n ")" ::: "memory")
#define PG8_BAR __builtin_amdgcn_s_barrier()
#define PG8_SCHED __builtin_amdgcn_sched_barrier(0)
    Unit cur, nxt; int ui = 0;
    if (!S.next(0, cur)) return;
    f32x4 acc[2][2][4][2];
#pragma unroll
    for (int a = 0; a < 2; ++a)
#pragma unroll
        for (int b = 0; b < 2; ++b)
#pragma unroll
            for (int m = 0; m < 4; ++m)
#pragma unroll
                for (int n = 0; n < 2; ++n) acc[a][b][m][n] = (f32x4){0.f, 0.f, 0.f, 0.f};
    bf16x8 At[4][2], B0[2][2], B1[2][2];
    const char* cA = (const char*)g.A + (size_t)cur.pm * tstep; const char* cB = (const char*)g.Bt + (size_t)cur.pn * tstep;
    S.a_ready(cur);
    if constexpr (SP2) {
        PG8_STAGE(PG8_SB(0, 0), cB, voffB); PG8_STAGE(PG8_SB(0, 1), cB + hstep, voffB); PG8_STAGE(PG8_SA(0, 0), cA, voffA); PG8_STAGE(PG8_SA(0, 1), cA + hstep, voffA);
        if (wr == 1) PG8_BAR;
        PG8_WAIT_V(2); PG8_BAR;
        PG8_STAGE(PG8_SB(1, 0), cB + kstep, voffB); PG8_STAGE(PG8_SA(1, 0), cA + kstep, voffA); PG8_STAGE(PG8_SB(1, 1), cB + hstep + kstep, voffB);
        PG8_WAIT_V(6); PG8_BAR;
    } else {
        PG8_STAGE(PG8_SB(0, 0), cB, voffB); PG8_STAGE(PG8_SA(0, 0), cA, voffA); PG8_STAGE(PG8_SB(0, 1), cB + hstep, voffB); PG8_STAGE(PG8_SA(0, 1), cA + hstep, voffA);
        if (wr == 1) PG8_BAR;
        PG8_WAIT_V(4); PG8_BAR;
        PG8_STAGE(PG8_SB(1, 0), cB + kstep, voffB); PG8_STAGE(PG8_SA(1, 0), cA + kstep, voffA); PG8_STAGE(PG8_SB(1, 1), cB + hstep + kstep, voffB);
        PG8_WAIT_V(6); PG8_BAR;
    }
    for (;;) {
        const bool has_next = S.next(ui + 1, nxt);
        const char* nA = has_next ? (const char*)g.A + (size_t)nxt.pm * tstep : cA; const char* nB = has_next ? (const char*)g.Bt + (size_t)nxt.pn * tstep : cB;
        for (int t = 0; t < nt; t += 2) {
            const bool last = (t == nt - 2);
            const char* a1 = cA + (size_t)(t + 1) * kstep;
            const char* a2 = last ? nA : cA + (size_t)(t + 2) * kstep; const char* b2 = last ? nB : cB + (size_t)(t + 2) * kstep;
            const char* a3 = a2 + kstep; const char* b3 = b2 + kstep;
            if (last && has_next) S.a_ready(nxt);
            if constexpr (SP2) {
            PG8_LDB(B0, 0, 0); PG8_LDB(B1, 0, 1); PG8_SCHED; PG8_LDA(At, 0, 0); PG8_STAGE(PG8_SA(1, 1), a1 + hstep, voffA);
            PG8_WAIT_V(8); PG8_WAIT_L(0); PG8_BAR; PG8_MMA(0, 0, At, B0); PG8_MMA(0, 1, At, B1); PG8_BAR; PG8_SCHED;
            PG8_LDA(At, 0, 1); PG8_STAGE(PG8_SB(0, 0), b2, voffB); PG8_STAGE(PG8_SB(0, 1), b2 + hstep, voffB); PG8_STAGE(PG8_SA(0, 0), a2, voffA);
            PG8_WAIT_V(8); PG8_WAIT_L(0); PG8_BAR; PG8_MMA(1, 0, At, B0); PG8_MMA(1, 1, At, B1); PG8_BAR; PG8_SCHED;
            PG8_LDB(B0, 1, 0); PG8_LDB(B1, 1, 1); PG8_SCHED; PG8_LDA(At, 1, 0); PG8_STAGE(PG8_SA(0, 1), a2 + hstep, voffA);
            PG8_WAIT_V(8); PG8_WAIT_L(0); PG8_BAR; PG8_MMA(0, 0, At, B0); PG8_MMA(0, 1, At, B1); PG8_BAR; PG8_SCHED;
            PG8_LDA(At, 1, 1); PG8_STAGE(PG8_SB(1, 0), b3, voffB); PG8_STAGE(PG8_SB(1, 1), b3 + hstep, voffB); PG8_STAGE(PG8_SA(1, 0), a3, voffA);
            PG8_WAIT_V(8); PG8_WAIT_L(0); PG8_BAR; PG8_MMA(1, 0, At, B0); PG8_MMA(1, 1, At, B1); PG8_BAR; PG8_SCHED;
            } else {
            PG8_LDB(B0, 0, 0); PG8_SCHED; PG8_LDA(At, 0, 0); PG8_STAGE(PG8_SA(1, 1), a1 + hstep, voffA);
            PG8_WAIT_L(8); PG8_BAR; PG8_WAIT_L(0); PG8_MMA(0, 0, At, B0); PG8_BAR; PG8_SCHED;
            PG8_LDB(B1, 0, 1); PG8_STAGE(PG8_SB(0, 0), b2, voffB);
            PG8_BAR; PG8_WAIT_L(0); PG8_MMA(0, 1, At, B1); PG8_BAR;
            PG8_LDA(At, 0, 1); PG8_STAGE(PG8_SA(0, 0), a2, voffA);
            PG8_BAR; PG8_WAIT_L(0); PG8_MMA(1, 0, At, B0); PG8_BAR; PG8_SCHED;
            PG8_STAGE(PG8_SB(0, 1), b2 + hstep, voffB);
            PG8_WAIT_V(6); PG8_BAR; PG8_MMA(1, 1, At, B1); PG8_BAR;
            PG8_LDB(B0, 1, 0); PG8_SCHED; PG8_LDA(At, 1, 0); PG8_STAGE(PG8_SA(0, 1), a2 + hstep, voffA);
            PG8_WAIT_L(8); PG8_BAR; PG8_WAIT_L(0); PG8_MMA(0, 0, At, B0); PG8_BAR; PG8_SCHED;
            PG8_LDB(B1, 1, 1); PG8_STAGE(PG8_SB(1, 0), b3, voffB);
            PG8_BAR; PG8_WAIT_L(0); PG8_MMA(0, 1, At, B1); PG8_BAR;
            PG8_LDA(At, 1, 1); PG8_STAGE(PG8_SA(1, 0), a3, voffA);
            PG8_BAR; PG8_WAIT_L(0); PG8_MMA(1, 0, At, B0); PG8_BAR; PG8_SCHED;
            PG8_STAGE(PG8_SB(1, 1), b3 + hstep, voffB);
            PG8_WAIT_V(6); PG8_BAR; PG8_MMA(1, 1, At, B1); PG8_BAR;
            }
        }
        if constexpr (ALIGN_EPI) { if (wr == 0) PG8_BAR; }
        if constexpr (!Epi::AFTER_DRAIN) { E(acc, cur, wr, wc, fr, fq); S.done(cur); }
        if (!has_next) break;
#pragma unroll
        for (int a = 0; a < 2; ++a)
#pragma unroll
            for (int b = 0; b < 2; ++b)
#pragma unroll
                for (int m = 0; m < 4; ++m)
#pragma unroll
                    for (int n = 0; n < 2; ++n) acc[a][b][m][n] = (f32x4){0.f, 0.f, 0.f, 0.f};
        cur = nxt; cA = nA; cB = nB; ++ui;
        if constexpr (ALIGN_EPI) { if (wr == 1) PG8_BAR; }
    }
    PG8_WAIT_V(0);
    if constexpr (!ALIGN_EPI) { if (wr == 0) PG8_BAR; }
    PG8_BAR;
    if constexpr (Epi::AFTER_DRAIN) { E.fused(acc, cur, wr, wc, fr, fq, lds, wid, lane); S.done(cur); }
#undef PG8_SA
#undef PG8_SB
#undef PG8_STAGE
#undef PG8_LDA
#undef PG8_LDB
#undef PG8_MMA
#undef PG8_WAIT_V
#undef PG8_WAIT_L
#undef PG8_BAR
#undef PG8_SCHED
}
}
typedef unsigned short bf16_t;
#define LAS __attribute__((address_space(3)))
#define GAS __attribute__((address_space(1)))
typedef unsigned v4u __attribute__((ext_vector_type(4)));
typedef unsigned v2u __attribute__((ext_vector_type(2)));
typedef float f32x4 __attribute__((ext_vector_type(4)));
constexpr int DM = 1024, NB = 32, SEQ = 2048, NTOK = NB * SEQ, NMEM = 256;
constexpr int LDP = 3328;
constexpr int C_SBQ = 0, C_SBK = 384, C_SBV = 768, C_SBG = 1152, C_DSQ = 1536, C_CKV = 1920, C_DSG = 2048,
              C_IDQ = 2432, C_IDK = 2688, C_IDW = 2720, C_MQ = 2728, C_MG = 2984, NCOL = 3240;
constexpr float EPS = 1e-6f;
constexpr size_t MiB = 1u << 20;
constexpr size_t WS_CTL = 0;
constexpr size_t WS_WIN = 1 * MiB;
constexpr size_t WS_WOUT = 14 * MiB;
constexpr size_t WS_WMEM = 18 * MiB;
constexpr size_t WS_MEMB = 20 * MiB;
constexpr size_t WS_MEMKV = 36 * MiB;
constexpr size_t WS_CKVN = 52 * MiB;
constexpr size_t WS_MASK = 68 * MiB;
constexpr size_t WS_H = 84 * MiB;
constexpr size_t WS_MIX = WS_H;
constexpr size_t WS_PROJ = 212 * MiB;
constexpr size_t WS_Y = WS_PROJ;
constexpr size_t WS_X1 = 628 * MiB;
constexpr size_t WS_END = 756 * MiB;
constexpr int LDS_BYTES = 135168;
constexpr int NWAVES = 8;

__device__ __forceinline__ float bf2f(bf16_t v) { return __uint_as_float(((unsigned)v) << 16); }
__device__ __forceinline__ unsigned f2bf(float f) { unsigned u = __float_as_uint(f); u += 0x7fffu + ((u >> 16) & 1u); return u >> 16; }
__device__ __forceinline__ unsigned pk2(float lo, float hi) { return f2bf(lo) | (f2bf(hi) << 16); }
#define WAVE_SYNC() do { asm volatile("s_waitcnt lgkmcnt(0)" ::: "memory"); __builtin_amdgcn_wave_barrier(); } while (0)
template <int CTRL> __device__ __forceinline__ float dpp_f(float v) { return __uint_as_float((unsigned)__builtin_amdgcn_update_dpp(0, (int)__float_as_uint(v), CTRL, 0xF, 0xF, true)); }
__device__ __forceinline__ float row16_sum(float v) {
    v += dpp_f<0xB1>(v);
    v += dpp_f<0x4E>(v);
    v += dpp_f<0x141>(v);
    v += dpp_f<0x140>(v);
    return v;
}
__device__ __forceinline__ float wave_sum(float v) {
    v = row16_sum(v);
    v += __uint_as_float((unsigned)__builtin_amdgcn_ds_swizzle((int)__float_as_uint(v), 0x401F));
    auto rr = __builtin_amdgcn_permlane32_swap(__float_as_uint(v), __float_as_uint(v), false, false);
    return __uint_as_float(rr[0]) + __uint_as_float(rr[1]);
}

__device__ const unsigned char T5TAB[128] = {0, 1, 2, 3, 4, 5, 6, 7, 8, 9, 10, 11, 12, 13, 14, 15, 16, 16, 16, 17, 17, 18, 18, 18, 19, 19, 19, 20, 20, 20, 20, 21, 21, 21, 21, 22, 22, 22, 22, 22, 23, 23, 23, 23, 23, 23, 24, 24, 24, 24, 24, 24, 25, 25, 25, 25, 25, 25, 25, 26, 26, 26, 26, 26, 26, 26, 26, 27, 27, 27, 27, 27, 27, 27, 27, 27, 27, 28, 28, 28, 28, 28, 28, 28, 28, 28, 28, 29, 29, 29, 29, 29, 29, 29, 29, 29, 29, 29, 29, 30, 30, 30, 30, 30, 30, 30, 30, 30, 30, 30, 30, 30, 30, 31, 31, 31, 31, 31, 31, 31, 31, 31, 31, 31, 31, 31, 31, 31};

struct Args { const float* in[11]; float* out; unsigned char* ws; int ph_lo, ph_hi; };

__device__ __forceinline__ void p0_transpose_item(const float* W, int K, int N, int Npad, bf16_t* WT, const float* g, LAS float* scr, int item, int lane) {
    const int nblk = Npad / 32, kb = item / nblk, nb = item % nblk, k0 = 64 * kb, n0 = 32 * nb;
    const int nn = n0 + (lane & 31);
#pragma unroll 8
    for (int i = 0; i < 32; ++i) { const int kk = 2 * i + (lane >> 5); float v = (nn < N) ? W[(size_t)(k0 + kk) * N + nn] : 0.f; if (g) v *= g[k0 + kk]; scr[kk * 33 + (lane & 31)] = v; }
    WAVE_SYNC();
    const int c = lane & 7;
#pragma unroll
    for (int j = 0; j < 4; ++j) { const int n = (lane >> 3) + 8 * j; const LAS float* s = scr + (8 * c) * 33 + n;
        v4u o; o.x = pk2(s[0 * 33], s[1 * 33]); o.y = pk2(s[2 * 33], s[3 * 33]); o.z = pk2(s[4 * 33], s[5 * 33]); o.w = pk2(s[6 * 33], s[7 * 33]);
        *(v4u*)(WT + (size_t)(n0 + n) * K + k0 + 8 * c) = o; }
    WAVE_SYNC();
}
template <bool NORM> __device__ __forceinline__ void row_to_bf16(const float* xrow, bf16_t* orow, int lane) {
    const f32x4* xr = (const f32x4*)xrow + lane;
    f32x4 v[4]; float s = 0.f;
#pragma unroll
    for (int j = 0; j < 4; ++j) { v[j] = xr[64 * j]; s += (v[j].x * v[j].x + v[j].y * v[j].y) + (v[j].z * v[j].z + v[j].w * v[j].w); }
    float r = 1.f;
    if (NORM) r = 1.0f / sqrtf(wave_sum(s) * (1.f / DM) + EPS);
    v2u* o8 = (v2u*)orow + lane;
#pragma unroll
    for (int j = 0; j < 4; ++j) { v2u w; w.x = pk2(v[j].x * r, v[j].y * r); w.y = pk2(v[j].z * r, v[j].w * r); o8[64 * j] = w; }
}

__device__ __forceinline__ void ckvnorm4(const bf16_t* PROJ, const float* kvg, bf16_t* CKVN, int row0, int lane) {
    const int row = row0 + (lane >> 4), c8 = (lane & 15) * 8;
    const v4u v = *(const v4u*)(PROJ + (size_t)row * LDP + C_CKV + c8);
    float f[8] = {__uint_as_float(v.x << 16), __uint_as_float(v.x & 0xffff0000u), __uint_as_float(v.y << 16), __uint_as_float(v.y & 0xffff0000u),
                  __uint_as_float(v.z << 16), __uint_as_float(v.z & 0xffff0000u), __uint_as_float(v.w << 16), __uint_as_float(v.w & 0xffff0000u)};
    float s = 0.f;
#pragma unroll
    for (int j = 0; j < 8; ++j) s += f[j] * f[j];
    s = row16_sum(s);
    const float r = 1.0f / sqrtf(s * (1.0f / 128.f) + EPS);
    const f32x4 g0 = *(const f32x4*)(kvg + c8), g1 = *(const f32x4*)(kvg + c8 + 4);
    v4u o; o.x = pk2(f[0] * r * g0.x, f[1] * r * g0.y); o.y = pk2(f[2] * r * g0.z, f[3] * r * g0.w); o.z = pk2(f[4] * r * g1.x, f[5] * r * g1.y); o.w = pk2(f[6] * r * g1.z, f[7] * r * g1.w);
    *(v4u*)(CKVN + (size_t)row * 128 + c8) = o;
}
__device__ __forceinline__ unsigned ordkey(float f) { unsigned u = __float_as_uint(f); return (u & 0x80000000u) ? ~u : (u | 0x80000000u); }
template <bool L0> __device__ __forceinline__ void post_row(const float* xin, const bf16_t* Y, const float* g, float* xout, bf16_t* X1b, bf16_t* Hn, int row, int lane) {
    const bf16_t* yp = Y + (size_t)row * DM;
    float yv[16]; float s = 0.f;
#pragma unroll
    for (int j = 0; j < 4; ++j) {
        const v2u v = *(const v2u*)(yp + (lane + 64 * j) * 4);
        yv[4 * j + 0] = __uint_as_float(v.x << 16); yv[4 * j + 1] = __uint_as_float(v.x & 0xffff0000u);
        yv[4 * j + 2] = __uint_as_float(v.y << 16); yv[4 * j + 3] = __uint_as_float(v.y & 0xffff0000u);
        s += yv[4 * j] * yv[4 * j] + yv[4 * j + 1] * yv[4 * j + 1] + yv[4 * j + 2] * yv[4 * j + 2] + yv[4 * j + 3] * yv[4 * j + 3];
    }
    const float r = 1.0f / sqrtf(wave_sum(s) * (1.0f / DM) + EPS);
    f32x4 ov[4]; float s2 = 0.f;
#pragma unroll
    for (int j = 0; j < 4; ++j) {
        const int c = (lane + 64 * j) * 4;
        f32x4 xv;
        if (L0) xv = *(const f32x4*)(xin + (size_t)row * DM + c);
        else { const v2u xb = *(const v2u*)(X1b + (size_t)row * DM + c); xv.x = __uint_as_float(xb.x << 16); xv.y = __uint_as_float(xb.x & 0xffff0000u); xv.z = __uint_as_float(xb.y << 16); xv.w = __uint_as_float(xb.y & 0xffff0000u); }
        const f32x4 gv = *(const f32x4*)(g + c);
        ov[j].x = xv.x + yv[4 * j] * r * gv.x; ov[j].y = xv.y + yv[4 * j + 1] * r * gv.y; ov[j].z = xv.z + yv[4 * j + 2] * r * gv.z; ov[j].w = xv.w + yv[4 * j + 3] * r * gv.w;
        if (L0) { v2u w; w.x = pk2(ov[j].x, ov[j].y); w.y = pk2(ov[j].z, ov[j].w); *(v2u*)(X1b + (size_t)row * DM + c) = w; }
        else *(f32x4*)(xout + (size_t)row * DM + c) = ov[j];
        s2 += (ov[j].x * ov[j].x + ov[j].y * ov[j].y) + (ov[j].z * ov[j].z + ov[j].w * ov[j].w);
    }
    if (Hn) {
        const float r2 = 1.0f / sqrtf(wave_sum(s2) * (1.f / DM) + EPS);
        v2u* o8 = (v2u*)(Hn + (size_t)row * DM) + lane;
#pragma unroll
        for (int j = 0; j < 4; ++j) { v2u w; w.x = pk2(ov[j].x * r2, ov[j].y * r2); w.y = pk2(ov[j].z * r2, ov[j].w * r2); o8[64 * j] = w; }
    }
}

typedef short bf16x8 __attribute__((ext_vector_type(8)));
typedef short s16x4 __attribute__((ext_vector_type(4)));
typedef float f32x16 __attribute__((ext_vector_type(16)));
typedef float f32x2_t __attribute__((ext_vector_type(2)));
typedef __bf16 bf16x2_t __attribute__((ext_vector_type(2)));
#define MFMA32(a, b, c) __builtin_amdgcn_mfma_f32_32x32x16_bf16((a), (b), (c), 0, 0, 0)
__device__ __forceinline__ unsigned cvtpk(float lo, float hi) { f32x2_t v = {lo, hi}; bf16x2_t b = __builtin_convertvector(v, bf16x2_t); return __builtin_bit_cast(unsigned, b); }
__device__ __forceinline__ s16x4 vtr(const LAS unsigned char* p) { return __builtin_bit_cast(s16x4, __builtin_amdgcn_ds_read_tr16_b64_v4i16((LAS s16x4*)p)); }
__device__ __forceinline__ int crow(int r, int hi) { return (r & 3) + 8 * (r >> 2) + 4 * hi; }
__device__ __forceinline__ bf16x8 pack8(const f32x16& x, int s) {
    v4u p; p.x = cvtpk(x[8 * s + 0], x[8 * s + 1]); p.y = cvtpk(x[8 * s + 2], x[8 * s + 3]); p.z = cvtpk(x[8 * s + 4], x[8 * s + 5]); p.w = cvtpk(x[8 * s + 6], x[8 * s + 7]);
    return __builtin_bit_cast(bf16x8, p);
}
__device__ __forceinline__ f32x16 zero16() { float z; asm volatile("v_mov_b32 %0, 0" : "=v"(z)); return (f32x16){z, z, z, z, z, z, z, z, z, z, z, z, z, z, z, z}; }
__device__ __forceinline__ bf16x8 cat44(s16x4 lo, s16x4 hi) { return __builtin_shufflevector(lo, hi, 0, 1, 2, 3, 4, 5, 6, 7); }
__device__ __forceinline__ float xhalf_max(float v) { auto rr = __builtin_amdgcn_permlane32_swap(__float_as_uint(v), __float_as_uint(v), false, false); return fmaxf(__uint_as_float(rr[0]), __uint_as_float(rr[1])); }
__device__ __forceinline__ float xhalf_sum(float v) { auto rr = __builtin_amdgcn_permlane32_swap(__float_as_uint(v), __float_as_uint(v), false, false); return __uint_as_float(rr[0]) + __uint_as_float(rr[1]); }
__device__ __forceinline__ unsigned xhalf_other_u(unsigned v, int hi) { auto rr = __builtin_amdgcn_permlane32_swap(v, v, false, false); return hi ? rr[0] : rr[1]; }
__device__ __forceinline__ float xhalf_other(float v, int hi) { return __uint_as_float(xhalf_other_u(__float_as_uint(v), hi)); }
constexpr int VT_PITCH = 192;
constexpr float LOG2E = 1.4426950408889634f;

__device__ __forceinline__ void pv_tile(f32x16 (&O)[2], const LAS unsigned char* vrd, bf16x8 p0, bf16x8 p1) {
#pragma unroll
    for (int c = 0; c < 2; ++c) {
        const bf16x8 a0 = cat44(vtr(vrd + 0 * VT_PITCH + 64 * c), vtr(vrd + 8 * VT_PITCH + 64 * c));
        const bf16x8 a1 = cat44(vtr(vrd + 16 * VT_PITCH + 64 * c), vtr(vrd + 24 * VT_PITCH + 64 * c));
        O[c] = MFMA32(a0, p0, O[c]);
        O[c] = MFMA32(a1, p1, O[c]);
    }
}
__device__ __forceinline__ void gate_store(const f32x16 (&O)[2], float scale, const bf16_t* grow, bf16_t* orow, int hi) {
#pragma unroll
    for (int c = 0; c < 2; ++c)
#pragma unroll
        for (int g = 0; g < 4; ++g) {
            const int d = 32 * c + 8 * g + 4 * hi;
            const v2u gv = *(const v2u*)(grow + d);
            float gt[4] = {__uint_as_float(gv.x << 16), __uint_as_float(gv.x & 0xffff0000u), __uint_as_float(gv.y << 16), __uint_as_float(gv.y & 0xffff0000u)};
            float ov[4];
#pragma unroll
            for (int j = 0; j < 4; ++j) ov[j] = O[c][4 * g + j] * scale * gt[j] * __builtin_amdgcn_rcpf(1.f + __builtin_amdgcn_exp2f(-gt[j] * LOG2E));
            v2u w; w.x = cvtpk(ov[0], ov[1]); w.y = cvtpk(ov[2], ov[3]);
            *(v2u*)(orow + d) = w;
        }
}

__device__ __forceinline__ void gate_load(v2u (&gw)[8], const bf16_t* grow, int hi) {
#pragma unroll
    for (int c = 0; c < 2; ++c)
#pragma unroll
        for (int g = 0; g < 4; ++g) gw[c * 4 + g] = *(const v2u*)(grow + 32 * c + 8 * g + 4 * hi);
}
__device__ __forceinline__ void gate_store_pre(const f32x16 (&O)[2], float scale, const v2u (&gw)[8], bf16_t* orow, int hi) {
#pragma unroll
    for (int c = 0; c < 2; ++c)
#pragma unroll
        for (int g = 0; g < 4; ++g) {
            const int d = 32 * c + 8 * g + 4 * hi;
            const v2u gv = gw[c * 4 + g];
            float gt[4] = {__uint_as_float(gv.x << 16), __uint_as_float(gv.x & 0xffff0000u), __uint_as_float(gv.y << 16), __uint_as_float(gv.y & 0xffff0000u)};
            float ov[4];
#pragma unroll
            for (int j = 0; j < 4; ++j) ov[j] = O[c][4 * g + j] * scale * gt[j] * __builtin_amdgcn_rcpf(1.f + __builtin_amdgcn_exp2f(-gt[j] * LOG2E));
            v2u w; w.x = cvtpk(ov[0], ov[1]); w.y = cvtpk(ov[2], ov[3]);
            *(v2u*)(orow + d) = w;
        }
}

__device__ __forceinline__ void sb_item(const bf16_t* PROJ, bf16_t* MIX, int b, int h, int qt, int lane, LAS unsigned char* wl) {
    asm volatile("" : "+v"(lane));
    const int r32 = lane & 31, hi = lane >> 5;
    const bf16_t* base = PROJ + (size_t)b * SEQ * LDP;
    const int t = 32 * qt + r32;
    bf16x8 qf[4];
#pragma unroll
    for (int ks = 0; ks < 4; ++ks) qf[ks] = *(const bf16x8*)(base + (size_t)t * LDP + C_SBQ + h * 64 + 16 * ks + 8 * hi);
    v2u gw[8]; gate_load(gw, base + (size_t)t * LDP + C_SBG + h * 64, hi);
    const int vrow = lane >> 3, vch = lane & 7;
    LAS unsigned char* vwr = wl + vrow * VT_PITCH + vch * 16;
    const LAS unsigned char* vrd = wl + (4 * hi + ((lane & 15) >> 2)) * VT_PITCH + (16 * ((lane >> 4) & 1) + 4 * (lane & 3)) * 2;
    bf16x8 kc[4], vc[4];
    {
        const bf16_t* kp = base + (size_t)(32 * qt + r32) * LDP + C_SBK + h * 64 + 8 * hi;
#pragma unroll
        for (int ks = 0; ks < 4; ++ks) kc[ks] = *(const bf16x8*)(kp + 16 * ks);
        const bf16_t* vp = base + (size_t)(32 * qt + vrow) * LDP + C_SBV + h * 64 + 8 * vch;
#pragma unroll
        for (int i = 0; i < 4; ++i) vc[i] = *(const bf16x8*)(vp + (size_t)(8 * i) * LDP);
    }
    f32x16 O[2];
#pragma unroll
    for (int r = 0; r < 16; ++r) { O[0][r] = 0.f; O[1][r] = 0.f; }
    float R = 1.f;
    for (int kt = qt; kt >= 0; --kt) {
        bf16x8 kn[4], vn[4];
        {
            const int ktn = kt > 0 ? kt - 1 : 0;
            const bf16_t* kp = base + (size_t)(32 * ktn + r32) * LDP + C_SBK + h * 64 + 8 * hi;
#pragma unroll
            for (int ks = 0; ks < 4; ++ks) kn[ks] = *(const bf16x8*)(kp + 16 * ks);
            const bf16_t* vp = base + (size_t)(32 * ktn + vrow) * LDP + C_SBV + h * 64 + 8 * vch;
#pragma unroll
            for (int i = 0; i < 4; ++i) vn[i] = *(const bf16x8*)(vp + (size_t)(8 * i) * LDP);
        }
        f32x16 acc;
#pragma unroll
        for (int r = 0; r < 16; ++r) acc[r] = 0.f;
#pragma unroll
        for (int ks = 0; ks < 4; ++ks) acc = MFMA32(kc[ks], qf[ks], acc);
#pragma unroll
        for (int i = 0; i < 4; ++i) *(LAS bf16x8*)(vwr + (8 * i) * VT_PITCH) = vc[i];
        float be[16], om[16];
        const bool diag = (kt == qt);
#pragma unroll
        for (int r = 0; r < 16; ++r) {
            const float e = __builtin_amdgcn_exp2f(fminf(acc[r] * (-0.125f * LOG2E), 115.f));
            float bt = __builtin_amdgcn_rcpf(1.f + e), o1 = e * bt;
            if (diag && !(crow(r, hi) < r32)) { bt = 0.f; o1 = 1.f; }
            be[r] = bt; om[r] = o1;
        }
        float Gp[4], Gq[4];
#pragma unroll
        for (int g = 0; g < 4; ++g) { Gp[g] = (om[4 * g] * om[4 * g + 1]) * (om[4 * g + 2] * om[4 * g + 3]); Gq[g] = xhalf_other(Gp[g], hi); }
        const float T1 = Gp[1] * Gq[1], T2 = Gp[2] * Gq[2], T3 = Gp[3] * Gq[3], T0 = Gp[0] * Gq[0];
        float tail[4]; tail[3] = R; tail[2] = R * T3; tail[1] = tail[2] * T2; tail[0] = tail[1] * T1;
        const float Rn = tail[0] * T0;
#pragma unroll
        for (int g = 0; g < 4; ++g) {
            float sfx = tail[g] * (hi == 0 ? Gq[g] : 1.f);
            acc[4 * g + 3] = be[4 * g + 3] * sfx; sfx *= om[4 * g + 3];
            acc[4 * g + 2] = be[4 * g + 2] * sfx; sfx *= om[4 * g + 2];
            acc[4 * g + 1] = be[4 * g + 1] * sfx; sfx *= om[4 * g + 1];
            acc[4 * g + 0] = be[4 * g + 0] * sfx;
        }
        R = Rn;
        const bf16x8 p0 = pack8(acc, 0), p1 = pack8(acc, 1);
        pv_tile(O, vrd, p0, p1);
        if (__all(R < 7.8886e-31f)) break;
#pragma unroll
        for (int i = 0; i < 4; ++i) { kc[i] = kn[i]; vc[i] = vn[i]; }
    }
    gate_store_pre(O, 1.f, gw, MIX + ((size_t)b * SEQ + t) * DM + h * 64, hi);
}

__device__ __forceinline__ void mem_item(const bf16_t* PROJ, const bf16_t* KV, bf16_t* MIX, int b, int h, int qt, int lane, LAS unsigned char* wl) {
    asm volatile("" : "+v"(lane));
    float NINF; asm volatile("v_mov_b32 %0, 0xff800000" : "=v"(NINF));
    const int r32 = lane & 31, hi = lane >> 5;
    const int t = 32 * qt + r32;
    const bf16_t* prow = PROJ + ((size_t)b * SEQ + t) * LDP;
    bf16x8 qf[4];
#pragma unroll
    for (int ks = 0; ks < 4; ++ks) qf[ks] = *(const bf16x8*)(prow + C_MQ + h * 64 + 16 * ks + 8 * hi);
    const int vrow = lane >> 3, vch = lane & 7;
    LAS unsigned char* vwr = wl + vrow * VT_PITCH + vch * 16;
    const LAS unsigned char* vrd = wl + (4 * hi + ((lane & 15) >> 2)) * VT_PITCH + (16 * ((lane >> 4) & 1) + 4 * (lane & 3)) * 2;
    const bf16_t* kvb = KV + (size_t)b * NMEM * 1024 + h * 64;
    f32x16 O[2];
#pragma unroll
    for (int r = 0; r < 16; ++r) { O[0][r] = 0.f; O[1][r] = 0.f; }
    float mrun = NINF, lrun = 0.f;
    v2u gw[8]; gate_load(gw, prow + C_MG + h * 64, hi);
    bf16x8 kc[4], vc[4];
    {
        const bf16_t* kp = kvb + (size_t)r32 * 1024 + 8 * hi;
#pragma unroll
        for (int ks = 0; ks < 4; ++ks) kc[ks] = *(const bf16x8*)(kp + 16 * ks);
        const bf16_t* vp = kvb + (size_t)vrow * 1024 + 256 + 8 * vch;
#pragma unroll
        for (int i = 0; i < 4; ++i) vc[i] = *(const bf16x8*)(vp + (size_t)(8 * i) * 1024);
    }
    for (int kt = 0; kt < NMEM / 32; ++kt) {
        bf16x8 kn[4], vn[4];
        {
            const int ktn = kt < NMEM / 32 - 1 ? kt + 1 : kt;
            const bf16_t* kp = kvb + (size_t)(32 * ktn + r32) * 1024 + 8 * hi;
#pragma unroll
            for (int ks = 0; ks < 4; ++ks) kn[ks] = *(const bf16x8*)(kp + 16 * ks);
            const bf16_t* vp = kvb + (size_t)(32 * ktn + vrow) * 1024 + 256 + 8 * vch;
#pragma unroll
            for (int i = 0; i < 4; ++i) vn[i] = *(const bf16x8*)(vp + (size_t)(8 * i) * 1024);
        }
        f32x16 acc;
#pragma unroll
        for (int r = 0; r < 16; ++r) acc[r] = 0.f;
#pragma unroll
        for (int ks = 0; ks < 4; ++ks) acc = MFMA32(kc[ks], qf[ks], acc);
#pragma unroll
        for (int i = 0; i < 4; ++i) *(LAS bf16x8*)(vwr + (8 * i) * VT_PITCH) = vc[i];
        float mx = acc[0];
#pragma unroll
        for (int r = 1; r < 16; ++r) mx = fmaxf(mx, acc[r]);
        mx *= 0.125f * LOG2E;
        mx = xhalf_max(mx);
        const float mn = fmaxf(mrun, mx), alpha = __builtin_amdgcn_exp2f(mrun - mn);
        float ps = 0.f;
#pragma unroll
        for (int r = 0; r < 16; ++r) { acc[r] = __builtin_amdgcn_exp2f(acc[r] * (0.125f * LOG2E) - mn); ps += acc[r]; }
        lrun = lrun * alpha + ps; mrun = mn;
#pragma unroll
        for (int r = 0; r < 16; ++r) { O[0][r] *= alpha; O[1][r] *= alpha; }
        const bf16x8 p0 = pack8(acc, 0), p1 = pack8(acc, 1);
        pv_tile(O, vrd, p0, p1);
#pragma unroll
        for (int i = 0; i < 4; ++i) { kc[i] = kn[i]; vc[i] = vn[i]; }
    }
    const float lt = xhalf_sum(lrun);
    gate_store_pre(O, 1.f / lt, gw, MIX + ((size_t)b * SEQ + t) * DM + 768 + h * 64, hi);
}

constexpr int MEML_V_OFF = 32768;
__device__ __forceinline__ void mem_stage(const bf16_t* KV, int b, int h, int tid, LAS unsigned char* L) {
    const bf16_t* kvb = KV + (size_t)b * NMEM * 1024 + h * 64;
#pragma unroll
    for (int i = 0; i < 4; ++i) {
        const int idx = tid + 512 * i, key = idx >> 3, ch = idx & 7;
        const v4u kx = *(const v4u*)(kvb + (size_t)key * 1024 + 8 * ch), vx = *(const v4u*)(kvb + (size_t)key * 1024 + 256 + 8 * ch);
        *(LAS v4u*)(L + 128 * key + 16 * (ch ^ ((key >> 1) & 7))) = kx;
        *(LAS v4u*)(L + MEML_V_OFF + (key >> 5) * (32 * VT_PITCH) + (key & 31) * VT_PITCH + 16 * ch) = vx;
    }
}
__device__ __forceinline__ void mem_item_lds(const bf16_t* PROJ, bf16_t* MIX, int b, int h, int qt, int lane, const LAS unsigned char* L) {
    asm volatile("" : "+v"(lane));
    float NINF; asm volatile("v_mov_b32 %0, 0xff800000" : "=v"(NINF));
    const int r32 = lane & 31, hi = lane >> 5;
    const int t = 32 * qt + r32;
    const bf16_t* prow = PROJ + ((size_t)b * SEQ + t) * LDP;
    bf16x8 qf[4];
#pragma unroll
    for (int ks = 0; ks < 4; ++ks) qf[ks] = *(const bf16x8*)(prow + C_MQ + h * 64 + 16 * ks + 8 * hi);
    v2u gw[8]; gate_load(gw, prow + C_MG + h * 64, hi);
    const unsigned kx = ((unsigned)r32 >> 1) & 7u;
    const LAS unsigned char* krd = L + 128 * r32;
    const LAS unsigned char* vrd = L + MEML_V_OFF + (4 * hi + ((lane & 15) >> 2)) * VT_PITCH + (16 * ((lane >> 4) & 1) + 4 * (lane & 3)) * 2;
    f32x16 O[2];
    O[0] = zero16(); O[1] = zero16();
    float mrun = NINF, lrun = 0.f;
#pragma unroll 2
    for (int kt = 0; kt < NMEM / 32; ++kt) {
        bf16x8 kc[4];
#pragma unroll
        for (int ks = 0; ks < 4; ++ks) kc[ks] = *(const LAS bf16x8*)(krd + 4096 * kt + 16 * ((unsigned)(2 * ks + hi) ^ kx));
        f32x16 acc = MFMA32(kc[0], qf[0], zero16());
#pragma unroll
        for (int ks = 1; ks < 4; ++ks) acc = MFMA32(kc[ks], qf[ks], acc);
        float mx = acc[0];
#pragma unroll
        for (int r = 1; r < 16; ++r) mx = fmaxf(mx, acc[r]);
        mx *= 0.125f * LOG2E;
        mx = xhalf_max(mx);
        const float mn = fmaxf(mrun, mx), alpha = __builtin_amdgcn_exp2f(mrun - mn);
        float ps = 0.f;
#pragma unroll
        for (int r = 0; r < 16; ++r) { acc[r] = __builtin_amdgcn_exp2f(acc[r] * (0.125f * LOG2E) - mn); ps += acc[r]; }
        lrun = lrun * alpha + ps; mrun = mn;
#pragma unroll
        for (int r = 0; r < 16; ++r) { O[0][r] *= alpha; O[1][r] *= alpha; }
        const bf16x8 p0 = pack8(acc, 0), p1 = pack8(acc, 1);
        pv_tile(O, vrd + kt * (32 * VT_PITCH), p0, p1);
    }
    const float lt = xhalf_sum(lrun);
    gate_store_pre(O, 1.f / lt, gw, MIX + ((size_t)b * SEQ + t) * DM + 768 + h * 64, hi);
}

constexpr int SEL_IQ_PITCH = 528, SEL_CNT_OFF = 17408;
__device__ __forceinline__ unsigned ordkey(float f);
template <int PRED  >
__device__ __forceinline__ unsigned sel_count_round(const unsigned (&key)[8][16], unsigned c, unsigned tau, int idx0, int r32, int hi, int wave, LAS unsigned* cb) {
    int n = 0;
#pragma unroll
    for (int i = 0; i < 8; ++i) {
#pragma unroll
        for (int r = 0; r < 16; ++r) {
            if (PRED == 0) n += (key[i][r] >= c) ? 1 : 0;
            else if (PRED == 1) n += (key[i][r] > c) ? 1 : 0;
            else n += (key[i][r] == tau && (unsigned)(idx0 + 256 * i + (r & 3) + 8 * (r >> 2)) <= c) ? 1 : 0;
            if ((r & 7) == 7) asm volatile("" : "+v"(n));
        }
    }
    n += (int)xhalf_other_u((unsigned)n, hi);
    if (hi == 0) cb[wave * 32 + r32] = (unsigned)n;
    __syncthreads();
    unsigned tot = 0;
#pragma unroll
    for (int w = 0; w < 8; ++w) tot += cb[w * 32 + r32];
    return tot;
}
constexpr int SEL_CAP = 64, SEL_DONE = 16;
__device__ __forceinline__ float key2f(unsigned k) { return __uint_as_float((k & 0x80000000u) ? (k & 0x7fffffffu) : ~k); }
__device__ __forceinline__ unsigned sel_count_lane(const unsigned (&key)[8][16], unsigned c) {
    int n = 0;
#pragma unroll
    for (int i = 0; i < 8; ++i) {
#pragma unroll
        for (int r = 0; r < 16; ++r) {
            n += (key[i][r] >= c) ? 1 : 0;
            if ((r & 7) == 7) asm volatile("" : "+v"(n));
        }
    }
    return (unsigned)n;
}
__device__ __forceinline__ unsigned sel_exchange(unsigned nl, int r32, int hi, int wave, LAS unsigned* cb) {
    const unsigned n2 = nl + xhalf_other_u(nl, hi);
    if (hi == 0) cb[wave * 32 + r32] = n2;
    __syncthreads();
    unsigned tot = 0;
#pragma unroll
    for (int w = 0; w < 8; ++w) tot += cb[w * 32 + r32];
    return tot;
}
__device__ __forceinline__ void sel_item2(const bf16_t* PROJ, unsigned* MASK, int b, int qt, int lane, int wave, LAS unsigned char* L) {
    asm volatile("" : "+v"(lane));
    const int r32 = lane & 31, hi = lane >> 5, tid = wave * 64 + lane;
    LAS unsigned* cntb = (LAS unsigned*)(L + SEL_CNT_OFF);
    const bf16_t* base = PROJ + (size_t)b * SEQ * LDP;
    unsigned* mrow = MASK + (((size_t)b * 64 + qt) * 64) * 32;
    if (qt < 8) {
#pragma unroll
        for (int i = 0; i < 8; ++i) {
            const int kt = wave + 8 * i;
            if (kt <= qt) {
                unsigned bits = 0u;
#pragma unroll
                for (int r = 0; r < 16; ++r) bits |= ((kt < qt) || (crow(r, hi) <= r32)) ? (1u << r) : 0u;
                const unsigned other = xhalf_other_u(bits, hi);
                if (hi == 0) mrow[kt * 32 + r32] = bits | (other << 16);
            }
        }
        return;
    }
    for (int n = tid; n < 1024; n += 512) { const int row = n >> 5, ch = n & 31;
        const v4u v = *(const v4u*)(base + (size_t)(32 * qt + row) * LDP + C_IDQ + ch * 8);
        *(LAS v4u*)(L + row * SEL_IQ_PITCH + ch * 16) = v; }
    float w8[8];
    { const v4u wv = *(const v4u*)(base + (size_t)(32 * qt + r32) * LDP + C_IDW);
      w8[0] = __uint_as_float(wv.x << 16) * 0.0625f; w8[1] = __uint_as_float(wv.x & 0xffff0000u) * 0.0625f; w8[2] = __uint_as_float(wv.y << 16) * 0.0625f; w8[3] = __uint_as_float(wv.y & 0xffff0000u) * 0.0625f;
      w8[4] = __uint_as_float(wv.z << 16) * 0.0625f; w8[5] = __uint_as_float(wv.z & 0xffff0000u) * 0.0625f; w8[6] = __uint_as_float(wv.w << 16) * 0.0625f; w8[7] = __uint_as_float(wv.w & 0xffff0000u) * 0.0625f; }
    __syncthreads();
    unsigned key[8][16];
    const LAS unsigned char* iqp = L + r32 * SEL_IQ_PITCH + 16 * hi;
    unsigned kmn = 0xffffffffu, kmx = 0u;
#pragma unroll
    for (int i = 0; i < 8; ++i) {
        const int kt = wave + 8 * i;
        if (kt <= qt) {
            const bf16_t* kp = base + (size_t)(32 * kt + r32) * LDP + C_IDK + 8 * hi;
            const bf16x8 k0 = *(const bf16x8*)kp, k1 = *(const bf16x8*)(kp + 16);
            float sc[16];
#pragma unroll
            for (int r = 0; r < 16; ++r) sc[r] = 0.f;
            unsigned iqo = 0; asm volatile("" : "+v"(iqo));
            const LAS unsigned char* iqt = iqp + iqo;
#pragma unroll
            for (int hp = 0; hp < 4; ++hp) {
                const int h = 2 * hp;
                bf16x8 q0 = *(const LAS bf16x8*)(iqt + h * 64), q1 = *(const LAS bf16x8*)(iqt + h * 64 + 32);
                bf16x8 q2 = *(const LAS bf16x8*)(iqt + h * 64 + 64), q3 = *(const LAS bf16x8*)(iqt + h * 64 + 96);
                asm volatile("" : "+v"(q0), "+v"(q1), "+v"(q2), "+v"(q3) : "v"(sc[15]));
                f32x16 Da = MFMA32(k0, q0, zero16());
                f32x16 Db = MFMA32(k0, q2, zero16());
                Da = MFMA32(k1, q1, Da);
                Db = MFMA32(k1, q3, Db);
#pragma unroll
                for (int r = 0; r < 16; ++r) sc[r] += w8[h] * fmaxf(Da[r], 0.f);
#pragma unroll
                for (int r = 0; r < 16; ++r) sc[r] += w8[h + 1] * fmaxf(Db[r], 0.f);
                asm volatile("" : "+v"(sc[0]), "+v"(sc[1]), "+v"(sc[2]), "+v"(sc[3]), "+v"(sc[4]), "+v"(sc[5]), "+v"(sc[6]), "+v"(sc[7]),
                                  "+v"(sc[8]), "+v"(sc[9]), "+v"(sc[10]), "+v"(sc[11]), "+v"(sc[12]), "+v"(sc[13]), "+v"(sc[14]), "+v"(sc[15]));
            }
            int thr = (kt < qt) ? 64 : (r32 - 4 * hi);
            asm volatile("" : "+v"(thr));
#pragma unroll
            for (int r = 0; r < 16; ++r) { const bool v = ((r & 3) + 8 * (r >> 2) <= thr); const unsigned k = ordkey(sc[r]); key[i][r] = v ? k : 0u; kmx = max(kmx, v ? k : 0u); kmn = min(kmn, v ? k : 0xffffffffu); }
        } else {
#pragma unroll
            for (int r = 0; r < 16; ++r) key[i][r] = 0u;
        }
    }
    unsigned lo_key, hi_key, clo, chi = 0u, nlo_l, nhi_l = 0u;
    {
        int nv = 0;
#pragma unroll
        for (int i = 0; i < 8; ++i) { const int kt = wave + 8 * i; nv += (kt < qt) ? 16 : 0; }
        if ((qt & 7) == wave) { const int thr = r32 - 4 * hi;
#pragma unroll
            for (int r = 0; r < 16; ++r) nv += ((r & 3) + 8 * (r >> 2) <= thr) ? 1 : 0; }
        nlo_l = (unsigned)nv;
        kmn = min(kmn, xhalf_other_u(kmn, hi)); kmx = max(kmx, xhalf_other_u(kmx, hi));
        if (hi == 0) { cntb[wave * 32 + r32] = kmn; cntb[256 + wave * 32 + r32] = kmx; }
        __syncthreads();
        unsigned a = 0xffffffffu, bmx = 0u;
#pragma unroll
        for (int w = 0; w < 8; ++w) { a = min(a, cntb[w * 32 + r32]); bmx = max(bmx, cntb[256 + w * 32 + r32]); }
        lo_key = a; hi_key = bmx + 1u; clo = (unsigned)(32 * qt + r32 + 1);
        __syncthreads();
    }
    int round = 0;
    for (;;) {
        const bool done = (clo - chi <= (unsigned)SEL_DONE) || (hi_key - lo_key <= 1u);
        if (__all(done)) break;
        unsigned p;
        if ((round & 3) == 3) p = lo_key + ((hi_key - lo_key) >> 1);
        else p = ordkey(0.5f * key2f(lo_key) + 0.5f * key2f(hi_key));
        p = min(max(p, lo_key + 1u), hi_key - 1u);
        if (done) p = lo_key;
        const unsigned nl = sel_count_lane(key, p);
        const unsigned tot = sel_exchange(nl, r32, hi, wave, cntb + (round & 1) * 256);
        if (!done) { if (tot >= 256u) { lo_key = p; clo = tot; nlo_l = nl; } else { hi_key = p; chi = tot; nhi_l = nl; } }
        ++round;
    }
    unsigned tau, cut;
    const bool many = (clo - chi > (unsigned)SEL_CAP);
    {
        LAS unsigned* lanecnt = (LAS unsigned*)L; LAS unsigned* meta = (LAS unsigned*)(L + 2048); LAS unsigned* result = (LAS unsigned*)(L + 2304); LAS unsigned* list = (LAS unsigned*)(L + 20480);
        const int slot = wave * 2 + hi;
        lanecnt[r32 * 16 + slot] = many ? 0u : (nlo_l - nhi_l);
        if (slot == 0) { meta[2 * r32] = many ? 0u : (clo - chi); meta[2 * r32 + 1] = 256u - chi; }
        __syncthreads();
        unsigned bs = 0u;
#pragma unroll
        for (int s2 = 0; s2 < 16; ++s2) { const unsigned v = lanecnt[r32 * 16 + s2]; bs += (s2 < slot) ? v : 0u; }
        if (!many) {
            const int idx0 = 32 * wave + 4 * hi;
            LAS unsigned* lp = list + (r32 * SEL_CAP + bs) * 2;
#pragma unroll
            for (int i = 0; i < 8; ++i)
#pragma unroll
                for (int r = 0; r < 16; ++r) {
                    const unsigned k = key[i][r];
                    if (k >= lo_key && k < hi_key) { lp[0] = k; lp[1] = (unsigned)(idx0 + 256 * i + (r & 3) + 8 * (r >> 2)); lp += 2; }
                }
        }
        __syncthreads();
        for (int j = 0; j < 4; ++j) {
            const int q = 4 * wave + j;
            const unsigned ncand = (unsigned)__builtin_amdgcn_readfirstlane((int)meta[2 * q]), need = (unsigned)__builtin_amdgcn_readfirstlane((int)meta[2 * q + 1]);
            const LAS unsigned* lq = list + q * SEL_CAP * 2;
            const bool mine = (unsigned)lane < ncand;
            const unsigned kc = mine ? lq[2 * lane] : 0u, ic = mine ? lq[2 * lane + 1] : 0u;
            unsigned rank = 0u;
            for (unsigned c2 = 0; c2 < ncand; ++c2) {
                const unsigned k2 = (unsigned)__builtin_amdgcn_readlane((int)kc, (int)c2), i2 = (unsigned)__builtin_amdgcn_readlane((int)ic, (int)c2);
                rank += (k2 > kc || (k2 == kc && i2 < ic)) ? 1u : 0u;
            }
            if (mine && rank == need - 1u) { result[2 * q] = kc; result[2 * q + 1] = ic; }
        }
        __syncthreads();
        tau = result[2 * r32]; cut = result[2 * r32 + 1];
    }
    if (__any(many)) {
        const unsigned need = 256u - chi;
        const int idx0 = 32 * wave + 4 * hi;
        unsigned lo_ = 0u, hi_ = 2047u;
        for (int it = 0; it < 11; ++it) {
            const unsigned mid = (lo_ + hi_) >> 1;
            const unsigned f = sel_count_round<2>(key, mid, lo_key, idx0, r32, hi, wave, cntb + (it & 1) * 256);
            if (f >= need) hi_ = mid; else lo_ = mid + 1;
        }
        if (many) { tau = lo_key; cut = hi_; }
    }
    {
        const int idx0 = 32 * wave + 4 * hi;
#pragma unroll
        for (int i = 0; i < 8; ++i) {
            const int kt = wave + 8 * i;
            if (kt <= qt) {
                unsigned bits = 0u;
#pragma unroll
                for (int r = 0; r < 16; ++r) {
                    const bool s = (key[i][r] > tau) || (key[i][r] == tau && (unsigned)(idx0 + 256 * i + (r & 3) + 8 * (r >> 2)) <= cut);
                    bits |= s ? (1u << r) : 0u;
                }
                const unsigned other = xhalf_other_u(bits, hi);
                if (hi == 0) mrow[kt * 32 + r32] = bits | (other << 16);
            }
        }
    }
    __syncthreads();
}

constexpr int WS_WUK = 0;
constexpr int WS_WUV = 256 * 1024;
constexpr int DSA_BIAS_OFF = 16384;
__device__ __forceinline__ unsigned dsa_off(unsigned row, unsigned ch) { return 256u * row + 16u * (ch ^ (((row & 3u) << 2) | ((row >> 2) & 3u))); }
constexpr int DSA_NBUF = 6, DSA_MASK_OFF = 49152, DSA_BIAS2_OFF = 114688;
__device__ __forceinline__ void glds16(const void* gsrc, unsigned lds_dst) { unsigned keep;
    asm volatile("s_mov_b32 %0, m0\n\ts_mov_b32 m0, %2\n\ts_nop 0\n\tglobal_load_lds_dwordx4 %1, off\n\ts_mov_b32 m0, %0" : "=&s"(keep) : "v"(gsrc), "s"(lds_dst) : "memory"); }
__device__ __forceinline__ void lds_read8_b128(bf16x8 (&a)[8], unsigned be, unsigned bo) {
    asm volatile("ds_read_b128 %0, %8\n\tds_read_b128 %1, %9\n\tds_read_b128 %2, %8 offset:512\n\tds_read_b128 %3, %9 offset:512\n\t"
                 "ds_read_b128 %4, %8 offset:1024\n\tds_read_b128 %5, %9 offset:1024\n\tds_read_b128 %6, %8 offset:1536\n\tds_read_b128 %7, %9 offset:1536"
                 : "=&v"(a[0]), "=&v"(a[1]), "=&v"(a[2]), "=&v"(a[3]), "=&v"(a[4]), "=&v"(a[5]), "=&v"(a[6]), "=&v"(a[7]) : "v"(be), "v"(bo));
}
template <int N> __device__ __forceinline__ void lgkm_wait(bf16x8& a) { asm volatile("s_waitcnt lgkmcnt(%1)" : "+v"(a) : "n"(N)); }
__device__ __forceinline__ void lds_read16_tr(s16x4 (&f)[4][4], unsigned b0, unsigned b1) {
    asm volatile("ds_read_b64_tr_b16 %0, %16\n\tds_read_b64_tr_b16 %1, %17 offset:2048\n\tds_read_b64_tr_b16 %2, %16 offset:4096\n\tds_read_b64_tr_b16 %3, %17 offset:6144\n\t"
                 "ds_read_b64_tr_b16 %4, %16 offset:512\n\tds_read_b64_tr_b16 %5, %17 offset:2560\n\tds_read_b64_tr_b16 %6, %16 offset:4608\n\tds_read_b64_tr_b16 %7, %17 offset:6656\n\t"
                 "ds_read_b64_tr_b16 %8, %16 offset:1024\n\tds_read_b64_tr_b16 %9, %17 offset:3072\n\tds_read_b64_tr_b16 %10, %16 offset:5120\n\tds_read_b64_tr_b16 %11, %17 offset:7168\n\t"
                 "ds_read_b64_tr_b16 %12, %16 offset:1536\n\tds_read_b64_tr_b16 %13, %17 offset:3584\n\tds_read_b64_tr_b16 %14, %16 offset:5632\n\tds_read_b64_tr_b16 %15, %17 offset:7680"
                 : "=&v"(f[0][0]), "=&v"(f[0][1]), "=&v"(f[0][2]), "=&v"(f[0][3]), "=&v"(f[1][0]), "=&v"(f[1][1]), "=&v"(f[1][2]), "=&v"(f[1][3]),
                   "=&v"(f[2][0]), "=&v"(f[2][1]), "=&v"(f[2][2]), "=&v"(f[2][3]), "=&v"(f[3][0]), "=&v"(f[3][1]), "=&v"(f[3][2]), "=&v"(f[3][3]) : "v"(b0), "v"(b1));
}
__device__ __forceinline__ void lgkm_wait_all(s16x4 (&f)[4][4]) {
    asm volatile("s_waitcnt lgkmcnt(0)" : "+v"(f[0][0]), "+v"(f[0][1]), "+v"(f[0][2]), "+v"(f[0][3]), "+v"(f[1][0]), "+v"(f[1][1]), "+v"(f[1][2]), "+v"(f[1][3]),
                   "+v"(f[2][0]), "+v"(f[2][1]), "+v"(f[2][2]), "+v"(f[2][3]), "+v"(f[3][0]), "+v"(f[3][1]), "+v"(f[3][2]), "+v"(f[3][3]));
}
__device__ __forceinline__ void dsa_round(const bf16_t* PROJ, const bf16_t* CKVN, const unsigned* MASK, const bf16_t* WUKp  , const bf16_t* WUVp  ,
                                          const float* rel_bias, bf16_t* MIX, int b, int o, int h, int lane, int wave, LAS unsigned char* L) {
    asm volatile("" : "+v"(lane));
    float NINF; asm volatile("v_mov_b32 %0, 0xff800000" : "=v"(NINF));
    const int r32 = lane & 31, hi = lane >> 5, tid = wave * 64 + lane;
    const int qt = 8 * o + wave, KT = 8 * o + 7, t = 32 * qt + r32;
    const int srow = 8 * (wave >> 1) + ((lane >> 2) & 7);
    const int sch = 4 * (2 * (wave & 1) + (lane >> 5)) + ((lane & 3) ^ ((2 * (wave >> 1) + ((lane >> 4) & 1)) & 3));
    const bf16_t* csrc = CKVN + ((size_t)b * SEQ + srow) * 128 + 8 * sch;
    const unsigned ring0 = (unsigned)__builtin_amdgcn_readfirstlane((int)(unsigned)(size_t)L) + 1024u * (unsigned)wave;
    LAS unsigned* maskL = (LAS unsigned*)(L + DSA_MASK_OFF + wave * 8192);
    {
        const unsigned char* msrc = (const unsigned char*)(MASK + (((size_t)b * 64 + qt) * 64) * 32) + 16 * lane;
        const unsigned mdst = (unsigned)__builtin_amdgcn_readfirstlane((int)(unsigned)(size_t)maskL);
        for (int p = 0; 8 * p <= qt; ++p) glds16(msrc + 1024 * p, mdst + 1024u * (unsigned)p);
    }
    glds16(csrc, ring0); glds16(csrc + (size_t)32 * 128, ring0 + 8192u); glds16(csrc + (size_t)64 * 128, ring0 + 16384u); glds16(csrc + (size_t)96 * 128, ring0 + 24576u);
    LAS float* biasT = (LAS float*)(L + DSA_BIAS2_OFF);
    if (tid < 192) { const int bk = tid < 128 ? (int)T5TAB[tid] : 31; biasT[tid] = rel_bias[bk * 6 + h] * LOG2E; }
    const float bias31 = rel_bias[31 * 6 + h] * LOG2E;
    bf16x8 qlf[8];
    {
        const bf16_t* qrow = PROJ + ((size_t)b * SEQ + t) * LDP + C_DSQ + h * 64 + 8 * hi;
        bf16x8 qf[4];
#pragma unroll
        for (int ks = 0; ks < 4; ++ks) qf[ks] = *(const bf16x8*)(qrow + 16 * ks);
        bf16x8 wk[16];
#pragma unroll
        for (int rt = 0; rt < 4; ++rt) {
            const GAS bf16_t* wp = (const GAS bf16_t*)WUKp + (rt * 32 + r32) * 64 + 8 * hi;
#pragma unroll
            for (int ks = 0; ks < 4; ++ks) wk[rt * 4 + ks] = *(const GAS bf16x8*)(wp + 16 * ks);
        }
        asm volatile("" : "+v"(wk[0]), "+v"(wk[1]), "+v"(wk[2]), "+v"(wk[3]), "+v"(wk[4]), "+v"(wk[5]), "+v"(wk[6]), "+v"(wk[7]),
                          "+v"(wk[8]), "+v"(wk[9]), "+v"(wk[10]), "+v"(wk[11]), "+v"(wk[12]), "+v"(wk[13]), "+v"(wk[14]), "+v"(wk[15]));
#pragma unroll
        for (int rt = 0; rt < 4; ++rt) {
            f32x16 X;
#pragma unroll
            for (int r = 0; r < 16; ++r) X[r] = 0.f;
#pragma unroll
            for (int ks = 0; ks < 4; ++ks) X = MFMA32(wk[rt * 4 + ks], qf[ks], X);
#pragma unroll
            for (int r = 0; r < 16; ++r) X[r] *= 0.125f * LOG2E;
            qlf[2 * rt] = pack8(X, 0); qlf[2 * rt + 1] = pack8(X, 1);
        }
    }
    f32x16 O[4];
#pragma unroll
    for (int c = 0; c < 4; ++c)
#pragma unroll
        for (int r = 0; r < 16; ++r) O[c][r] = 0.f;
    float mref = NINF, lrun = 0.f;
    const unsigned x2 = ((unsigned)r32 >> 2) & 3u;
    const unsigned rb_e = 2048u * ((unsigned)r32 >> 3) + 64u * ((unsigned)r32 & 7u) + 16u * ((unsigned)hi ^ x2);
    const unsigned rb_o = 2048u * ((unsigned)r32 >> 3) + 64u * ((unsigned)r32 & 7u) + 16u * ((2u + (unsigned)hi) ^ x2);
    const unsigned tq = (lane & 15) >> 2, tp = lane & 3, tblk = (lane >> 4) & 1;
    const unsigned tb0 = 64u * (4u * hi + tq) + 16u * ((2u * tblk + (tp >> 1)) ^ ((unsigned)hi & 3u)) + 8u * (tp & 1);
    const unsigned tb1 = 64u * (4u * hi + tq) + 16u * ((2u * tblk + (tp >> 1)) ^ ((2u + (unsigned)hi) & 3u)) + 8u * (tp & 1);
    __syncthreads();
    asm volatile("s_waitcnt vmcnt(0) lgkmcnt(0)" ::: "memory");
    auto dsa_qk = [&](const int kt, f32x16& S, const LAS unsigned char* Cb) __attribute__((always_inline)) {
        if (kt <= qt) {
#pragma unroll
            for (int r = 0; r < 16; ++r) S[r] = 0.f;
            bf16x8 a[8];
            const unsigned cb32 = (unsigned)(size_t)Cb;
            lds_read8_b128(a, cb32 + rb_e, cb32 + rb_o);
            lgkm_wait<7>(a[0]); S = MFMA32(a[0], qlf[0], S);
            lgkm_wait<6>(a[1]); S = MFMA32(a[1], qlf[1], S);
            lgkm_wait<5>(a[2]); S = MFMA32(a[2], qlf[2], S);
            lgkm_wait<4>(a[3]); S = MFMA32(a[3], qlf[3], S);
            lgkm_wait<3>(a[4]); S = MFMA32(a[4], qlf[4], S);
            lgkm_wait<2>(a[5]); S = MFMA32(a[5], qlf[5], S);
            lgkm_wait<1>(a[6]); S = MFMA32(a[6], qlf[6], S);
            lgkm_wait<0>(a[7]); S = MFMA32(a[7], qlf[7], S);
        }
    };
    auto dsa_tile = [&](const int kt, f32x16& S, const LAS unsigned char* Cb, const unsigned mwc) __attribute__((always_inline)) {
        if (kt <= qt) {
            s16x4 f[4][4];
            lds_read16_tr(f, (unsigned)(size_t)Cb + tb0, (unsigned)(size_t)Cb + tb1);
            const unsigned mw = mwc;
            const int dq = qt - kt;
            float cb = bias31;
            if (__builtin_amdgcn_readfirstlane(dq) < 5) {
                asm volatile("" ::: "memory");
                cb = 0.f;
                const int rel0 = 32 * dq + r32 - 4 * hi;
#pragma unroll
                for (int r = 0; r < 16; ++r) { int rel = rel0 - ((r & 3) + 8 * (r >> 2)); rel = rel < 0 ? 0 : rel; S[r] += biasT[rel]; }
                asm volatile("" ::: "memory");
            }
            float mx = fmaxf(S[0], S[1]);
#pragma unroll
            for (int r = 2; r < 16; ++r) mx = fmaxf(mx, S[r]);
            mx = xhalf_max(mx) + cb;
            if (__any(mx > mref + 8.f)) {
                float mm = NINF;
                asm volatile("" : "+v"(mm));
#pragma unroll
                for (int r = 0; r < 16; ++r) mm = fmaxf(mm, ((mw >> r) & 1u) ? S[r] : NINF);
                mm = xhalf_max(mm) + cb;
                const float mn = fmaxf(mref, mm);
                const float alpha = (mn > mref) ? __builtin_amdgcn_exp2f(mref - mn) : 1.f;
                mref = mn; lrun *= alpha;
#pragma unroll
                for (int c = 0; c < 4; ++c)
#pragma unroll
                    for (int r = 0; r < 16; ++r) asm volatile("v_mul_f32 %0, %0, %1" : "+v"(O[c][r]) : "v"(alpha));
            }
            const float off = ((mref == NINF) ? 0.f : mref) - cb;
            float ps0 = 0.f, ps1 = 0.f;
#pragma unroll
            for (int r = 0; r < 16; ++r) {
                const float e = __builtin_amdgcn_exp2f(S[r] - off);
                int m1; asm("v_bfe_i32 %0, %1, %2, 1" : "=v"(m1) : "v"(mw), "n"(r));
                S[r] = __uint_as_float(__float_as_uint(e) & (unsigned)m1);
                if (r & 1) ps1 += S[r]; else ps0 += S[r];
            }
            lrun += ps0 + ps1;
            const bf16x8 p0 = pack8(S, 0), p1 = pack8(S, 1);
            lgkm_wait_all(f);
#pragma unroll
            for (int c = 0; c < 4; ++c) {
                O[c] = MFMA32(cat44(f[c][0], f[c][1]), p0, O[c]);
                O[c] = MFMA32(cat44(f[c][2], f[c][3]), p1, O[c]);
            }
        }
    };
    const int NS = (KT + 1) >> 1;
    v2u gatew[8];
#pragma unroll
    for (int i = 0; i < 8; ++i) { gatew[i].x = 0u; gatew[i].y = 0u; }
    int sl = 0;
    const bool late = (wave & 4) != 0;
    unsigned mwA = maskL[r32], mwB = maskL[32 + r32];
    for (int st = 0; st < NS; ++st) {
        if (st + 1 < NS) asm volatile("s_waitcnt vmcnt(2)\n\ts_barrier" ::: "memory");
        else asm volatile("s_waitcnt vmcnt(0)\n\ts_barrier" ::: "memory");
        if (st + 2 < NS) { int s2 = sl + 4; s2 = s2 >= 6 ? s2 - 6 : s2;
            glds16(csrc + (size_t)(64 * (st + 2)) * 128, ring0 + 8192u * (unsigned)s2); glds16(csrc + (size_t)(64 * (st + 2) + 32) * 128, ring0 + 8192u * (unsigned)(s2 + 1)); }
        if (st == NS - 1) gate_load(gatew, PROJ + ((size_t)b * SEQ + t) * LDP + C_DSG + h * 64, hi);
        unsigned mw0 = mwA >> (16 * hi), mw1 = mwB >> (16 * hi);
        asm volatile("" : "+v"(mw0), "+v"(mw1));
        f32x16 S0, S1;
        dsa_qk(2 * st, S0, L + sl * 8192);
        if (late) dsa_qk(2 * st + 1, S1, L + (sl + 1) * 8192);
        dsa_tile(2 * st, S0, L + sl * 8192, mw0);
        if (!late) dsa_qk(2 * st + 1, S1, L + (sl + 1) * 8192);
        dsa_tile(2 * st + 1, S1, L + (sl + 1) * 8192, mw1);
        if (st + 1 < NS) { mwA = maskL[(2 * st + 2) * 32 + r32]; mwB = maskL[(2 * st + 3) * 32 + r32]; }
        sl = (sl == 4) ? 0 : sl + 2;
    }
    const float lt = xhalf_sum(lrun);
    const float il = 1.f / lt;
    f32x16 Y[2];
#pragma unroll
    for (int r = 0; r < 16; ++r) { Y[0][r] = 0.f; Y[1][r] = 0.f; }
    bf16x8 wv[16];
    {
        int l3 = lane; asm volatile("" : "+v"(l3));
#pragma unroll
        for (int rt = 0; rt < 4; ++rt)
#pragma unroll
            for (int c = 0; c < 2; ++c) {
                const GAS bf16_t* wp = (const GAS bf16_t*)WUVp + ((((c * 4 + rt) * 2 + 0) * 32 + (l3 & 31)) * 2 + (l3 >> 5)) * 8;
                wv[(rt * 2 + c) * 2] = *(const GAS bf16x8*)wp; wv[(rt * 2 + c) * 2 + 1] = *(const GAS bf16x8*)(wp + 32 * 2 * 8);
            }
        asm volatile("" : "+v"(wv[0]), "+v"(wv[1]), "+v"(wv[2]), "+v"(wv[3]), "+v"(wv[4]), "+v"(wv[5]), "+v"(wv[6]), "+v"(wv[7]),
                          "+v"(wv[8]), "+v"(wv[9]), "+v"(wv[10]), "+v"(wv[11]), "+v"(wv[12]), "+v"(wv[13]), "+v"(wv[14]), "+v"(wv[15]));
    }
#pragma unroll
    for (int rt = 0; rt < 4; ++rt) {
#pragma unroll
        for (int r = 0; r < 16; ++r) O[rt][r] *= il;
        const bf16x8 x0 = pack8(O[rt], 0), x1 = pack8(O[rt], 1);
#pragma unroll
        for (int c = 0; c < 2; ++c) {
            Y[c] = MFMA32(wv[(rt * 2 + c) * 2], x0, Y[c]);
            Y[c] = MFMA32(wv[(rt * 2 + c) * 2 + 1], x1, Y[c]);
        }
    }
    {
        int l2 = lane; asm volatile("" : "+v"(l2));
        const int t2 = 32 * qt + (l2 & 31);
        gate_store_pre(Y, 1.f, gatew, MIX + ((size_t)b * SEQ + t2) * DM + 384 + h * 64, l2 >> 5);
    }
    asm volatile("s_waitcnt lgkmcnt(0)\n\ts_barrier" ::: "memory");
}

typedef GAS unsigned gu32;
#define RLX_AGENT __ATOMIC_RELAXED, __HIP_MEMORY_SCOPE_AGENT
constexpr size_t WS_BAR = 512 * 1024;
#define XB_TMO      128
#define XB_XCNT(j)  (256  + 64 * (j))
#define XB_XSUB(j)  (1280 + 64 * (j))
#define XB_XGEN(j)  (2304 + 64 * (j))
#define XB_TOP      3328
#define XB_TOPGEN   3392
#define XCD_BAR_WORDS 3456
#define XB_SPIN_CAP (1u << 18)

__device__ __forceinline__ unsigned xb_ld(unsigned* p)              { return __hip_atomic_load(p, __ATOMIC_RELAXED, __HIP_MEMORY_SCOPE_AGENT); }
__device__ __forceinline__ unsigned xb_add(unsigned* p, unsigned v) { return __hip_atomic_fetch_add(p, v, __ATOMIC_RELAXED, __HIP_MEMORY_SCOPE_AGENT); }
__device__ __forceinline__ unsigned xb_xcc_id() { return (unsigned)__builtin_amdgcn_s_getreg((3 << 11) | 20) & 0xFu; }
#define XB_SPIN(cond, bar) do { unsigned _sp = 0; while (cond) { __builtin_amdgcn_s_sleep(1); \
    if ((++_sp & 255u) == 0u) { if (xb_ld(&(bar)[XB_TMO])) break; if (_sp > XB_SPIN_CAP) { atomicAdd(&(bar)[XB_TMO], 1u); break; } } } } while (0)

struct XcdBarrier {
    unsigned* bar; unsigned x;
    volatile LAS unsigned* st;
};

__device__ __forceinline__ XcdBarrier xcd_barrier_post(unsigned* bar, volatile LAS unsigned* st) {
    XcdBarrier b; b.bar = bar; b.x = xb_xcc_id(); b.st = st;
    if (threadIdx.x == 0) (void)xb_add(&bar[XB_XCNT(b.x)], 1u);
    return b;
}
__device__ __forceinline__ void xcd_barrier_complete(unsigned* bar, unsigned x, unsigned& nloc, unsigned& nx) {
    const unsigned G = gridDim.x * gridDim.y * gridDim.z;
    unsigned sum, cnt, mine, sp = 0u;
    for (;;) {
        sum = 0u; cnt = 0u; mine = 0u;
#pragma unroll
        for (unsigned j = 0; j < 16; ++j) { const unsigned c = xb_ld(&bar[XB_XCNT(j)]); sum += c; cnt += (c > 0u) ? 1u : 0u; mine = (j == x) ? c : mine; }
        if (sum == G) break;
        __builtin_amdgcn_s_sleep(1);
        if ((++sp & 255u) == 0u) { if (xb_ld(&bar[XB_TMO])) break; if (sp > XB_SPIN_CAP) { atomicAdd(&bar[XB_TMO], 1u); break; } }
    }
    nloc = mine > 0u ? mine : 1u; nx = cnt > 0u ? cnt : 1u;
}

__device__ __forceinline__ void xcd_barrier(const XcdBarrier& b, const bool leader  ) {
    asm volatile("s_waitcnt vmcnt(0)" ::: "memory");
    __syncthreads();
    if (leader) {
        unsigned* bar = b.bar;
        __builtin_amdgcn_s_waitcnt(0);
        unsigned nloc = b.st[0], nx = b.st[1];
        if (nloc == 0u) { xcd_barrier_complete(bar, b.x, nloc, nx); b.st[0] = nloc; b.st[1] = nx; }
        const unsigned old = xb_add(&bar[XB_XSUB(b.x)], 1u);
        const unsigned gen = old / nloc;
        if (old + 1u == (gen + 1u) * nloc) {
            __builtin_amdgcn_fence(__ATOMIC_RELEASE, "agent");
            asm volatile("s_waitcnt vmcnt(0)" ::: "memory");
            const unsigned og = xb_add(&bar[XB_TOP], 1u);
            const unsigned tg = og / nx;
            if (og + 1u == (tg + 1u) * nx) xb_add(&bar[XB_TOPGEN], 1u);
            else XB_SPIN(xb_ld(&bar[XB_TOPGEN]) == tg, bar);
            __builtin_amdgcn_fence(__ATOMIC_ACQUIRE, "agent");
            xb_add(&bar[XB_XGEN(b.x)], 1u);
            asm volatile("s_waitcnt vmcnt(0)" ::: "memory");
        } else {
            XB_SPIN(xb_ld(&bar[XB_XGEN(b.x)]) == gen, bar);
            __builtin_amdgcn_fence(__ATOMIC_ACQUIRE, "agent");
            asm volatile("s_waitcnt vmcnt(0)" ::: "memory");
        }
    }
    __syncthreads();
}

#ifndef MK_MULTI
#define MK_MULTI 0
#endif
constexpr int NPHASE = 11;
__global__ void __launch_bounds__(NWAVES * 64, 2) mk_fwd(Args args) {
    extern __shared__ __attribute__((aligned(16))) unsigned char lds_raw[];
    LAS unsigned char* lds = (LAS unsigned char*)lds_raw;
    const int tid0 = threadIdx.x;
    int wave_ = __builtin_amdgcn_readfirstlane(tid0 >> 6); asm volatile("" : "+s"(wave_));
    const int wave = wave_;
    const int G = gridDim.x, bid = blockIdx.x;
    for (int u = tid0; u < 16; u += NWAVES * 64) ((LAS unsigned*)(lds + 131072))[u] = 0u;
    __syncthreads();
    const XcdBarrier xbar = xcd_barrier_post((unsigned*)(args.ws + WS_BAR), (volatile LAS unsigned*)(lds + 131072));
    const int lo = args.ph_lo, hi = args.ph_hi;
#define IN(k) (lo <= (k) && (k) < hi)
#define SEAM(k) do { if (IN(k) && IN((k) + 1)) { if ((k) == 0) cg::this_grid().sync(); else xcd_barrier(xbar, wave_ == 0 && lane_id_v() == 0); } } while (0)
#define PH_BEGIN int lane = lane_id_v(); unsigned char* ws_ = args.ws; asm volatile("" : "+s"(ws_)); GAS unsigned char* ws = (GAS unsigned char*)ws_;     \
    const int gw = bid * NWAVES + wave, NGW = G * NWAVES; (void)gw; (void)NGW;
#define VCU_LOOP for (int vcu = vcu0; vcu < 256; vcu += G)
#define VCU_IDS const int bb = vcu >> 3, w64 = (vcu & 7) * 8 + wave; (void)bb; (void)w64;
#define P_WIN ((bf16_t*)(ws + WS_WIN))
#define P_WOUT ((bf16_t*)(ws + WS_WOUT))
#define P_WMEM ((bf16_t*)(ws + WS_WMEM))
#define P_MEMB ((bf16_t*)(ws + WS_MEMB))
#define P_MEMKV ((bf16_t*)(ws + WS_MEMKV))
#define P_CKVN ((bf16_t*)(ws + WS_CKVN))
#define P_MASK ((unsigned*)(ws + WS_MASK))
#define P_H ((bf16_t*)(ws + WS_H))
#define P_MIX ((bf16_t*)(ws + WS_MIX))
#define P_PROJ ((bf16_t*)(ws + WS_PROJ))
#define P_Y ((bf16_t*)(ws + WS_Y))
    const int vcu0 = (G % 8 == 0) ? (bid & 7) * (G >> 3) + (bid >> 3) : bid;

    if (IN(0)) {
        PH_BEGIN
        const float* x = args.in[0]; const float* mem = args.in[1]; const float* pre_g = args.in[2];
        const float* w_in = args.in[4]; const float* w_mem = args.in[8]; const float* w_out = args.in[9];
        LAS float* scr = (LAS float*)(lds + wave * 16384);
        constexpr int I_IN = 16 * (LDP / 32), I_OUT = 16 * 32, I_MEM = 16 * 16;
        constexpr int NITEMS = 2 * I_IN + 2 * I_OUT + 2 * I_MEM;
        for (int it = gw; it < NITEMS; it += NGW) {
            int r = it;
            if (r < 2 * I_IN) { const int l = r / I_IN; r -= l * I_IN; p0_transpose_item(w_in + (size_t)l * DM * NCOL, DM, NCOL, LDP, P_WIN + (size_t)l * LDP * DM, pre_g + l * DM, scr, r, lane); continue; }
            r -= 2 * I_IN;
            if (r < 2 * I_OUT) { const int l = r / I_OUT; r -= l * I_OUT; p0_transpose_item(w_out + (size_t)l * DM * DM, DM, DM, DM, P_WOUT + (size_t)l * DM * DM, nullptr, scr, r, lane); continue; }
            r -= 2 * I_OUT;
            { const int l = r / I_MEM; r -= l * I_MEM; p0_transpose_item(w_mem + (size_t)l * DM * 512, DM, 512, 512, P_WMEM + (size_t)l * 512 * DM, nullptr, scr, r, lane); }
        }
        {
            const float* w_uk = args.in[5]; const float* w_uv = args.in[6];
            bf16_t* WUKp = (bf16_t*)(ws + WS_WUK); bf16_t* WUVp = (bf16_t*)(ws + WS_WUV);
            for (int e = gw * 64 + lane; e < 2 * 6 * 8192; e += NGW * 64) {
                const int lh = e >> 13, l = lh / 6, h = lh % 6, w = e & 8191;
                { const int rt = w >> 11, rho = (w >> 6) & 31, d = w & 63; const int r = 32 * rt + ((rho & 0x13) | ((rho & 4) << 1) | ((rho & 8) >> 1));
                  WUKp[e] = (bf16_t)f2bf(w_uk[(((size_t)l * 128 + r) * 6 + h) * 64 + d]); }
                { const int j = w & 7, hh = (w >> 3) & 1, d32 = (w >> 4) & 31, s = (w >> 9) & 1, rt = (w >> 10) & 3, c = (w >> 12) & 1;
                  const int r = 32 * rt + 16 * s + 8 * (j >> 2) + 4 * hh + (j & 3), d = 32 * c + d32;
                  WUVp[e] = (bf16_t)f2bf(w_uv[(((size_t)l * 128 + r) * 6 + h) * 64 + d]); }
            }
        }
        for (int m = gw; m < NB * NMEM; m += NGW) row_to_bf16<false>(mem + (size_t)m * DM, P_MEMB + (size_t)m * DM, lane);
        for (int m = gw * 2; m < NTOK; m += NGW * 2) { row_to_bf16<true>(x + (size_t)m * DM, P_H + (size_t)m * DM, lane); row_to_bf16<true>(x + (size_t)(m + 1) * DM, P_H + (size_t)(m + 1) * DM, lane); }
    }
    SEAM(0);
#pragma unroll 1
    for (int l = 0; l < 2; ++l) {
        const int pb = 1 + 5 * l;
        if (IN(pb)) {
            PH_BEGIN
            { pg8::Gemm g{P_H, P_WIN + (size_t)l * LDP * DM, NTOK, LDP, DM}; pg8::StaticOrder S; S.init(NTOK, LDP, G, bid);
              pg8::EpiBf16<0> E{P_PROJ, LDP, nullptr, 0, 0, 1.f};
              pg8::gemm_phase<pg8::EpiBf16<0>, pg8::StaticOrder, true, true>(lds, g, S, E, wave); }
            if (l == 0) {
              pg8::Gemm g{P_MEMB, P_WMEM, NB * NMEM, 1024, DM}; pg8::StaticOrder S; S.init(NB * NMEM, 1024, G, bid);
              pg8::EpiBf16<0> E{P_MEMKV, 1024, nullptr, 0, 0, 1.f};
              pg8::gemm_phase<pg8::EpiBf16<0>, pg8::StaticOrder, true, true>(lds, g, S, E, wave); }
        }
        SEAM(pb);
        if (IN(pb + 1)) {
            { PH_BEGIN
              const float* kv_g = args.in[7];
              for (int m = gw * 8; m < NTOK; m += NGW * 8) { ckvnorm4(P_PROJ, kv_g + l * 128, P_CKVN, m, lane); ckvnorm4(P_PROJ, kv_g + l * 128, P_CKVN, m + 4, lane); } }
            VCU_LOOP { PH_BEGIN VCU_IDS
              for (int i = 0; i < 6; ++i) { const int qt = (i & 1) ? 63 - w64 : w64; sb_item(P_PROJ, P_MIX, bb, i, qt, lane, lds + wave * 16384); } }
            __syncthreads();
            VCU_LOOP { PH_BEGIN VCU_IDS
              const int s8 = vcu & 7;
              for (int j = 0; j < 8; ++j) { const int qt = 8 * j + ((j & 1) ? 7 - s8 : s8); sel_item2(P_PROJ, P_MASK, bb, qt, lane, wave, lds); } }
            __syncthreads();
            VCU_LOOP { PH_BEGIN VCU_IDS
              for (int i = 0; i < 4; ++i) {
                  __syncthreads();
                  mem_stage(P_MEMKV + l * 512, bb, i, wave * 64 + lane, lds);
                  __syncthreads();
                  mem_item_lds(P_PROJ, P_MIX, bb, i, w64, lane, lds);
              } }
        }
        SEAM(pb + 1);
        if (IN(pb + 2)) {
            __syncthreads();
            VCU_LOOP { PH_BEGIN VCU_IDS
              const float* rel_bias = args.in[10];
              const int s8 = vcu & 7, hs = (s8 < 4) ? 0 : 3;
              for (int oi = 0; oi < 2; ++oi) {
                  const int o = oi ? 7 - (s8 & 3) : (s8 & 3);
                  for (int hh = 0; hh < 3; ++hh) {
                      const int h = hs + hh;
                      dsa_round(P_PROJ, P_CKVN, P_MASK, (const bf16_t*)(ws + WS_WUK) + (size_t)(l * 6 + h) * 8192, (const bf16_t*)(ws + WS_WUV) + (size_t)(l * 6 + h) * 8192,
                                rel_bias, P_MIX, bb, o, h, lane, wave, lds);
                  }
              } }
        }
        SEAM(pb + 2);
        if (IN(pb + 3)) {
            PH_BEGIN
            __syncthreads();
            pg8::Gemm g{P_MIX, P_WOUT + (size_t)l * DM * DM, NTOK, DM, DM}; pg8::StaticOrder S; S.init(NTOK, DM, G, bid);
            pg8::EpiBf16<0> E{P_Y, DM, nullptr, 0, 0, 1.f};
            pg8::gemm_phase<pg8::EpiBf16<0>, pg8::StaticOrder, true, true>(lds, g, S, E, wave);
        }
        SEAM(pb + 3);
        if (IN(pb + 4)) {
            PH_BEGIN
            const float* post_g = args.in[3]; bf16_t* X1b = (bf16_t*)(ws + WS_X1);
            if (l == 0) { for (int m = gw * 2; m < NTOK; m += NGW * 2) { post_row<true>(args.in[0], P_Y, post_g, args.out, X1b, P_H, m, lane); post_row<true>(args.in[0], P_Y, post_g, args.out, X1b, P_H, m + 1, lane); } }
            else { for (int m = gw * 2; m < NTOK; m += NGW * 2) { post_row<false>(nullptr, P_Y, post_g + DM, args.out, X1b, (bf16_t*)nullptr, m, lane); post_row<false>(nullptr, P_Y, post_g + DM, args.out, X1b, (bf16_t*)nullptr, m + 1, lane); } }
        }
        SEAM(pb + 4);
    }
#undef IN
#undef SEAM
}

extern "C" void kernel_launch(void* const* d_in, const int* in_sizes, int n_in, void* d_out, int out_size, void* d_ws, size_t ws_size, hipStream_t stream) {
    static int grid = 0;
    if (grid == 0) {
        if (n_in != 11 || ws_size < WS_END) { fprintf(stderr, "kernel_launch: unexpected n_in %d / ws_size %zu\n", n_in, ws_size); grid = -1; return; }
        int dev = 0, cus = 0, per_cu = 0;
        hipGetDevice(&dev);
        hipDeviceGetAttribute(&cus, hipDeviceAttributeMultiprocessorCount, dev);
        hipFuncSetAttribute((const void*)mk_fwd, hipFuncAttributeMaxDynamicSharedMemorySize, LDS_BYTES);
        hipOccupancyMaxActiveBlocksPerMultiprocessor(&per_cu, (const void*)mk_fwd, NWAVES * 64, LDS_BYTES);
        if (per_cu < 1) { fprintf(stderr, "kernel_launch: occupancy query says %d blocks per CU\n", per_cu); per_cu = 1; }
        grid = cus * 1;
        (void)hipGetLastError();
    }
    if (grid < 0) return;
    (void)hipMemsetAsync((char*)d_ws + WS_BAR, 0, 16384, stream);
    Args a{};
    for (int i = 0; i < 11; ++i) a.in[i] = (const float*)d_in[i];
    a.out = (float*)d_out; a.ws = (unsigned char*)d_ws;
#if MK_MULTI
    for (int p = 0; p < NPHASE; ++p) { a.ph_lo = p; a.ph_hi = p + 1; hipLaunchKernelGGL(mk_fwd, dim3(grid), dim3(NWAVES * 64), LDS_BYTES, stream, a); }
#else
    a.ph_lo = 0; a.ph_hi = NPHASE;
    void* kargs[] = {&a};
    hipError_t e = hipLaunchCooperativeKernel((const void*)mk_fwd, dim3(grid), dim3(NWAVES * 64), kargs, LDS_BYTES, stream);
    if (e != hipSuccess) fprintf(stderr, "cooperative launch failed: %s (grid %d)\n", hipGetErrorString(e), grid);
#endif
}
```

```cpp
#include <hip/hip_runtime.h>
#include <hip/hip_cooperative_groups.h>
#include <stdint.h>
#include <math.h>
#include <cstdio>
namespace cg = cooperative_groups;
__device__ __forceinline__ int lane_id_v() { int l; asm volatile("v_mbcnt_lo_u32_b32 %0, -1, 0\n\tv_mbcnt_hi_u32_b32 %0, -1, %0" : "=v"(l)); return l; }
namespace pg8 {
#define PG8_LAS __attribute__((address_space(3)))
typedef unsigned short bf16_t;
typedef short bf16x8 __attribute__((ext_vector_type(8)));
typedef float f32x4 __attribute__((ext_vector_type(4)));
typedef unsigned u32x4 __attribute__((ext_vector_type(4)));
constexpr int BM = 256, BK = 64, HALF = 128, HTB = HALF * BK * 2  , STAGE_BYTES = 8 * HTB, NXCD = 8, WGM = 8;

__host__ __device__ __forceinline__ int lds_byte(int r, int c) { const int st = (r >> 4) * 2 + (c >> 5), rr = r & 15, cc = c & 31, ob = rr * 64 + cc * 2; return st * 1024 + (ob ^ (((ob >> 9) & 1) << 5)); }
__host__ __device__ __forceinline__ void stage_rc(int b, int& R, int& C) { const int st = b / 1024, sb = b % 1024, swz = sb ^ (((sb >> 9) & 1) << 5); R = (st >> 1) * 16 + swz / 64; C = (st & 1) * 32 + (swz % 64) / 2; }
__host__ __device__ __forceinline__ int perm32(int rho) { const int n = rho >> 4, i = rho & 15; return 8 * (i >> 2) + 4 * n + (i & 3); }

struct Unit { int pm, pn; };
struct Gemm { const bf16_t* A; const bf16_t* Bt; int M, N, K; };

struct StaticOrder {
    int nM, nN, nwg, G, c;
    __host__ __device__ void init(int M, int N, int G_, int c_) { nM = M / BM; nN = N / BM; nwg = nM * nN; G = G_; c = c_; }
    __host__ __device__ bool next(int i, Unit& u) const {
        const long L = (long)i * G + c; if (L >= nwg) return false;
        int wgid = (int)L; { const int q = nwg / NXCD, r = nwg % NXCD, xcd = wgid % NXCD, off = wgid / NXCD; wgid = (xcd < r ? xcd * (q + 1) : r * (q + 1) + (xcd - r) * q) + off; }
        const int nig = WGM * nN, gid = wgid / nig, fm = gid * WGM, gsz = (nM - fm) < WGM ? (nM - fm) : WGM;
        u.pm = fm + ((wgid % nig) % gsz); u.pn = (wgid % nig) / gsz; return true;
    }
    __device__ __forceinline__ void a_ready(const Unit&) const {}
    __device__ __forceinline__ void done(const Unit&) const {}
};

__device__ __forceinline__ unsigned cvt_pk_bf16(float lo, float hi) { unsigned r; asm volatile("v_cvt_pk_bf16_f32 %0, %1, %2" : "=v"(r) : "v"(lo), "v"(hi)); return r; }
typedef float f32x2 __attribute__((ext_vector_type(2)));
__device__ __forceinline__ f32x2 gelu_pk(f32x2 v) {
    const f32x2 av = __builtin_elementwise_abs(v), d = av * 0.2316418882f + 1.0f;
    f32x2 t; t.x = __builtin_amdgcn_rcpf(d.x); t.y = __builtin_amdgcn_rcpf(d.y);
    f32x2 q = t * 0.5307027145f + (-0.7265760135f); q = q * t + 0.7107068705f; q = q * t + (-0.142248368f); q = q * t + 0.127414796f; q = q * t;
    const f32x2 s = (v * v) * (-0.72134752044f);
    f32x2 e; e.x = __builtin_amdgcn_exp2f(s.x); e.y = __builtin_amdgcn_exp2f(s.y);
    const f32x2 m = v * (q * e), r = v - m;
    f32x2 o; o.x = v.x < 0.f ? m.x : r.x; o.y = v.y < 0.f ? m.y : r.y; return o;
}

template <int ACT  > struct EpiBf16 {
    static constexpr bool PERM = true, AFTER_DRAIN = false; static_assert(ACT == 0 || ACT == 1, "EpiBf16: ACT is 0 (none) or 1 (gelu_pk)");
    bf16_t* O; int ldc; const float* bias; int split_cols; size_t split_stride; float scale0;
    __device__ __forceinline__ void operator()(const f32x4 (&acc)[2][2][4][2], const Unit& u, int wr, int wc, int fr, int fq) const {
        const int row0 = u.pm * BM + wr * 64 + fr; int colt = u.pn * BM; bf16_t* base = O;
        float sc = 1.f; if (split_cols) { const int t = colt / split_cols; base += (size_t)t * split_stride; colt -= t * split_cols; if (t == 0) sc = scale0; }
        const int col0 = colt + wc * 32 + 8 * fq, bcol0 = u.pn * BM + wc * 32 + 8 * fq;
        f32x4 bv[2][2];
#pragma unroll
        for (int bj = 0; bj < 2; ++bj)
#pragma unroll
            for (int n = 0; n < 2; ++n) bv[bj][n] = bias ? *(const f32x4*)(bias + bcol0 + bj * HALF + 4 * n) : (f32x4){0.f, 0.f, 0.f, 0.f};
#pragma unroll
        for (int ai = 0; ai < 2; ++ai)
#pragma unroll
            for (int m = 0; m < 4; ++m) { bf16_t* rowp = base + (size_t)(row0 + ai * HALF + m * 16) * ldc + col0;
#pragma unroll
                for (int bj = 0; bj < 2; ++bj) { f32x4 v0 = acc[ai][bj][m][0] + bv[bj][0], v1 = acc[ai][bj][m][1] + bv[bj][1];
                    if (ACT == 1) { f32x2 a = gelu_pk((f32x2){v0[0], v0[1]}), b = gelu_pk((f32x2){v0[2], v0[3]}), c = gelu_pk((f32x2){v1[0], v1[1]}), d = gelu_pk((f32x2){v1[2], v1[3]});
                        v0 = (f32x4){a.x, a.y, b.x, b.y}; v1 = (f32x4){c.x, c.y, d.x, d.y}; }
                    v0 = v0 * sc; v1 = v1 * sc; u32x4 w; w.x = cvt_pk_bf16(v0[0], v0[1]); w.y = cvt_pk_bf16(v0[2], v0[3]); w.z = cvt_pk_bf16(v1[0], v1[1]); w.w = cvt_pk_bf16(v1[2], v1[3]);
                    *(u32x4*)(rowp + bj * HALF) = w; } }
    }
};
template <class Epi, class Sched, bool ALIGN_EPI = false, bool SP2 = false>
__device__ __forceinline__ void gemm_phase(PG8_LAS unsigned char* lds, const Gemm g, const Sched& S, const Epi& E, int wave_id) {
    int tid_ = wave_id * 64 + lane_id_v();
    const int tid = tid_, wid = __builtin_amdgcn_readfirstlane(tid >> 6), lane = tid & 63, wr = wid >> 2, wc = wid & 3, fr = lane & 15, fq = lane >> 4;
    const int K = g.K, nt = K / BK;
    unsigned voffA[2], voffB[2];
#pragma unroll
    for (int i = 0; i < 2; ++i) { int R, C; stage_rc(tid * 16 + i * 8192, R, C); const int Rb = Epi::PERM ? ((R & ~31) + perm32(R & 31)) : R;
        voffA[i] = (unsigned)(R * K + C) * 2u; voffB[i] = (unsigned)(Rb * K + C) * 2u; }
    const size_t kstep = (size_t)(BK * 2);
    const size_t hstep = (size_t)HALF * K * 2;
    const size_t tstep = 2 * hstep;
    const unsigned ldsw = (unsigned)wid * 1024u;
    const int aoff = lds_byte(wr * 64 + fr, fq * 8), boff = lds_byte(wc * 32 + fr, fq * 8);
#define PG8_SA(b, h) (((b) * 2 + (h)) * HTB)
#define PG8_SB(b, h) ((4 + (b) * 2 + (h)) * HTB)
#define PG8_STAGE(bufoff, gbase, voff) do { _Pragma("unroll") for (int _i = 0; _i < 2; ++_i) \
        __builtin_amdgcn_global_load_lds((const unsigned*)((const char*)(gbase) + (voff)[_i]), (PG8_LAS unsigned*)(lds + (bufoff) + ldsw + _i * 8192), 16, 0, 0); } while (0)
#define PG8_LDA(dst, b, h) do { _Pragma("unroll") for (int m = 0; m < 4; ++m) _Pragma("unroll") for (int k = 0; k < 2; ++k) dst[m][k] = *(const PG8_LAS bf16x8*)(lds + PG8_SA(b, h) + aoff + m * 2048 + k * 1024); } while (0)
#define PG8_LDB(dst, b, h) do { _Pragma("unroll") for (int n = 0; n < 2; ++n) _Pragma("unroll") for (int k = 0; k < 2; ++k) dst[n][k] = *(const PG8_LAS bf16x8*)(lds + PG8_SB(b, h) + boff + n * 2048 + k * 1024); } while (0)
#define PG8_MMA(ai, bj, At, Bt) do { __builtin_amdgcn_s_setprio(1); _Pragma("unroll") for (int m = 0; m < 4; ++m) _Pragma("unroll") for (int n = 0; n < 2; ++n) _Pragma("unroll") for (int k = 0; k < 2; ++k) \
        acc[ai][bj][m][n] = __builtin_amdgcn_mfma_f32_16x16x32_bf16(Bt[n][k], At[m][k], acc[ai][bj][m][n], 0, 0, 0); __builtin_amdgcn_s_setprio(0); } while (0)
#define PG8_WAIT_V(n) asm volatile("s_waitcnt vmcnt(" #n ")" ::: "memory")
#define PG8_WAIT_L(n) asm volatile("s_waitcnt lgkmcnt(" #n ")" ::: "memory")
#define PG8_BAR __builtin_amdgcn_s_barrier()
#define PG8_SCHED __builtin_amdgcn_sched_barrier(0)
    Unit cur, nxt; int ui = 0;
    if (!S.next(0, cur)) return;
    f32x4 acc[2][2][4][2];
#pragma unroll
    for (int a = 0; a < 2; ++a)
#pragma unroll
        for (int b = 0; b < 2; ++b)
#pragma unroll
            for (int m = 0; m < 4; ++m)
#pragma unroll
                for (int n = 0; n < 2; ++n) acc[a][b][m][n] = (f32x4){0.f, 0.f, 0.f, 0.f};
    bf16x8 At[4][2], B0[2][2], B1[2][2];
    const char* cA = (const char*)g.A + (size_t)cur.pm * tstep; const char* cB = (const char*)g.Bt + (size_t)cur.pn * tstep;
    S.a_ready(cur);
    if constexpr (SP2) {
        PG8_STAGE(PG8_SB(0, 0), cB, voffB); PG8_STAGE(PG8_SB(0, 1), cB + hstep, voffB); PG8_STAGE(PG8_SA(0, 0), cA, voffA); PG8_STAGE(PG8_SA(0, 1), cA + hstep, voffA);
        if (wr == 1) PG8_BAR;
        PG8_WAIT_V(2); PG8_BAR;
        PG8_STAGE(PG8_SB(1, 0), cB + kstep, voffB); PG8_STAGE(PG8_SA(1, 0), cA + kstep, voffA); PG8_STAGE(PG8_SB(1, 1), cB + hstep + kstep, voffB);
        PG8_WAIT_V(6); PG8_BAR;
    } else {
        PG8_STAGE(PG8_SB(0, 0), cB, voffB); PG8_STAGE(PG8_SA(0, 0), cA, voffA); PG8_STAGE(PG8_SB(0, 1), cB + hstep, voffB); PG8_STAGE(PG8_SA(0, 1), cA + hstep, voffA);
        if (wr == 1) PG8_BAR;
        PG8_WAIT_V(4); PG8_BAR;
        PG8_STAGE(PG8_SB(1, 0), cB + kstep, voffB); PG8_STAGE(PG8_SA(1, 0), cA + kstep, voffA); PG8_STAGE(PG8_SB(1, 1), cB + hstep + kstep, voffB);
        PG8_WAIT_V(6); PG8_BAR;
    }
    for (;;) {
        const bool has_next = S.next(ui + 1, nxt);
        const char* nA = has_next ? (const char*)g.A + (size_t)nxt.pm * tstep : cA; const char* nB = has_next ? (const char*)g.Bt + (size_t)nxt.pn * tstep : cB;
        for (int t = 0; t < nt; t += 2) {
            const bool last = (t == nt - 2);
            const char* a1 = cA + (size_t)(t + 1) * kstep;
            const char* a2 = last ? nA : cA + (size_t)(t + 2) * kstep; const char* b2 = last ? nB : cB + (size_t)(t + 2) * kstep;
            const char* a3 = a2 + kstep; const char* b3 = b2 + kstep;
            if (last && has_next) S.a_ready(nxt);
            if constexpr (SP2) {
            PG8_LDB(B0, 0, 0); PG8_LDB(B1, 0, 1); PG8_SCHED; PG8_LDA(At, 0, 0); PG8_STAGE(PG8_SA(1, 1), a1 + hstep, voffA);
            PG8_WAIT_V(8); PG8_WAIT_L(0); PG8_BAR; PG8_MMA(0, 0, At, B0); PG8_MMA(0, 1, At, B1); PG8_BAR; PG8_SCHED;
            PG8_LDA(At, 0, 1); PG8_STAGE(PG8_SB(0, 0), b2, voffB); PG8_STAGE(PG8_SB(0, 1), b2 + hstep, voffB); PG8_STAGE(PG8_SA(0, 0), a2, voffA);
            PG8_WAIT_V(8); PG8_WAIT_L(0); PG8_BAR; PG8_MMA(1, 0, At, B0); PG8_MMA(1, 1, At, B1); PG8_BAR; PG8_SCHED;
            PG8_LDB(B0, 1, 0); PG8_LDB(B1, 1, 1); PG8_SCHED; PG8_LDA(At, 1, 0); PG8_STAGE(PG8_SA(0, 1), a2 + hstep, voffA);
            PG8_WAIT_V(8); PG8_WAIT_L(0); PG8_BAR; PG8_MMA(0, 0, At, B0); PG8_MMA(0, 1, At, B1); PG8_BAR; PG8_SCHED;
            PG8_LDA(At, 1, 1); PG8_STAGE(PG8_SB(1, 0), b3, voffB); PG8_STAGE(PG8_SB(1, 1), b3 + hstep, voffB); PG8_STAGE(PG8_SA(1, 0), a3, voffA);
            PG8_WAIT_V(8); PG8_WAIT_L(0); PG8_BAR; PG8_MMA(1, 0, At, B0); PG8_MMA(1, 1, At, B1); PG8_BAR; PG8_SCHED;
            } else {
            PG8_LDB(B0, 0, 0); PG8_SCHED; PG8_LDA(At, 0, 0); PG8_STAGE(PG8_SA(1, 1), a1 + hstep, voffA);
            PG8_WAIT_L(8); PG8_BAR; PG8_WAIT_L(0); PG8_MMA(0, 0, At, B0); PG8_BAR; PG8_SCHED;
            PG8_LDB(B1, 0, 1); PG8_STAGE(PG8_SB(0, 0), b2, voffB);
            PG8_BAR; PG8_WAIT_L(0); PG8_MMA(0, 1, At, B1); PG8_BAR;
            PG8_LDA(At, 0, 1); PG8_STAGE(PG8_SA(0, 0), a2, voffA);
            PG8_BAR; PG8_WAIT_L(0); PG8_MMA(1, 0, At, B0); PG8_BAR; PG8_SCHED;
            PG8_STAGE(PG8_SB(0, 1), b2 + hstep, voffB);
            PG8_WAIT_V(6); PG8_BAR; PG8_MMA(1, 1, At, B1); PG8_BAR;
            PG8_LDB(B0, 1, 0); PG8_SCHED; PG8_LDA(At, 1, 0); PG8_STAGE(PG8_SA(0, 1), a2 + hstep, voffA);
            PG8_WAIT_L(8); PG8_BAR; PG8_WAIT_L(0); PG8_MMA(0, 0, At, B0); PG8_BAR; PG8_SCHED;
            PG8_LDB(B1, 1, 1); PG8_STAGE(PG8_SB(1, 0), b3, voffB);
            PG8_BAR; PG8_WAIT_L(0); PG8_MMA(0, 1, At, B1); PG8_BAR;
            PG8_LDA(At, 1, 1); PG8_STAGE(PG8_SA(1, 0), a3, voffA);
            PG8_BAR; PG8_WAIT_L(0); PG8_MMA(1, 0, At, B0); PG8_BAR; PG8_SCHED;
            PG8_STAGE(PG8_SB(1, 1), b3 + hstep, voffB);
            PG8_WAIT_V(6); PG8_BAR; PG8_MMA(1, 1, At, B1); PG8_BAR;
            }
        }
        if constexpr (ALIGN_EPI) { if (wr == 0) PG8_BAR; }
        if constexpr (!Epi::AFTER_DRAIN) { E(acc, cur, wr, wc, fr, fq); S.done(cur); }
        if (!has_next) break;
#pragma unroll
        for (int a = 0; a < 2; ++a)
#pragma unroll
            for (int b = 0; b < 2; ++b)
#pragma unroll
                for (int m = 0; m < 4; ++m)
#pragma unroll
                    for (int n = 0; n < 2; ++n) acc[a][b][m][n] = (f32x4){0.f, 0.f, 0.f, 0.f};
        cur = nxt; cA = nA; cB = nB; ++ui;
        if constexpr (ALIGN_EPI) { if (wr == 1) PG8_BAR; }
    }
    PG8_WAIT_V(0);
    if constexpr (!ALIGN_EPI) { if (wr == 0) PG8_BAR; }
    PG8_BAR;
    if constexpr (Epi::AFTER_DRAIN) { E.fused(acc, cur, wr, wc, fr, fq, lds, wid, lane); S.done(cur); }
#undef PG8_SA
#undef PG8_SB
#undef PG8_STAGE
#undef PG8_LDA
#undef PG8_LDB
#undef PG8_MMA
#undef PG8_WAIT_V
#undef PG8_WAIT_L
#undef PG8_BAR
#undef PG8_SCHED
}
}
typedef unsigned short bf16_t;
#define LAS __attribute__((address_space(3)))
#define GAS __attribute__((address_space(1)))
typedef unsigned v4u __attribute__((ext_vector_type(4)));
typedef unsigned v2u __attribute__((ext_vector_type(2)));
typedef float f32x4 __attribute__((ext_vector_type(4)));
constexpr int DM = 1024, NB = 32, SEQ = 2048, NTOK = NB * SEQ, NMEM = 256;
constexpr int LDP = 3328;
constexpr int C_SBQ = 0, C_SBK = 384, C_SBV = 768, C_SBG = 1152, C_DSQ = 1536, C_CKV = 1920, C_DSG = 2048,
              C_IDQ = 2432, C_IDK = 2688, C_IDW = 2720, C_MQ = 2728, C_MG = 2984, NCOL = 3240;
constexpr float EPS = 1e-6f;
constexpr size_t MiB = 1u << 20;
constexpr size_t WS_CTL = 0;
constexpr size_t WS_WIN = 1 * MiB;
constexpr size_t WS_WOUT = 14 * MiB;
constexpr size_t WS_WMEM = 18 * MiB;
constexpr size_t WS_MEMB = 20 * MiB;
constexpr size_t WS_MEMKV = 36 * MiB;
constexpr size_t WS_CKVN = 52 * MiB;
constexpr size_t WS_MASK = 68 * MiB;
constexpr size_t WS_H = 84 * MiB;
constexpr size_t WS_MIX = WS_H;
constexpr size_t WS_PROJ = 212 * MiB;
constexpr size_t WS_Y = WS_PROJ;
constexpr size_t WS_X1 = 628 * MiB;
constexpr size_t WS_END = 756 * MiB;
constexpr int LDS_BYTES = 135168;
constexpr int NWAVES = 8;

__device__ __forceinline__ float bf2f(bf16_t v) { return __uint_as_float(((unsigned)v) << 16); }
__device__ __forceinline__ unsigned f2bf(float f) { unsigned u = __float_as_uint(f); u += 0x7fffu + ((u >> 16) & 1u); return u >> 16; }
__device__ __forceinline__ unsigned pk2(float lo, float hi) { return f2bf(lo) | (f2bf(hi) << 16); }
#define WAVE_SYNC() do { asm volatile("s_waitcnt lgkmcnt(0)" ::: "memory"); __builtin_amdgcn_wave_barrier(); } while (0)
template <int CTRL> __device__ __forceinline__ float dpp_f(float v) { return __uint_as_float((unsigned)__builtin_amdgcn_update_dpp(0, (int)__float_as_uint(v), CTRL, 0xF, 0xF, true)); }
__device__ __forceinline__ float row16_sum(float v) {
    v += dpp_f<0xB1>(v);
    v += dpp_f<0x4E>(v);
    v += dpp_f<0x141>(v);
    v += dpp_f<0x140>(v);
    return v;
}
__device__ __forceinline__ float wave_sum(float v) {
    v = row16_sum(v);
    v += __uint_as_float((unsigned)__builtin_amdgcn_ds_swizzle((int)__float_as_uint(v), 0x401F));
    auto rr = __builtin_amdgcn_permlane32_swap(__float_as_uint(v), __float_as_uint(v), false, false);
    return __uint_as_float(rr[0]) + __uint_as_float(rr[1]);
}

__device__ const unsigned char T5TAB[128] = {0, 1, 2, 3, 4, 5, 6, 7, 8, 9, 10, 11, 12, 13, 14, 15, 16, 16, 16, 17, 17, 18, 18, 18, 19, 19, 19, 20, 20, 20, 20, 21, 21, 21, 21, 22, 22, 22, 22, 22, 23, 23, 23, 23, 23, 23, 24, 24, 24, 24, 24, 24, 25, 25, 25, 25, 25, 25, 25, 26, 26, 26, 26, 26, 26, 26, 26, 27, 27, 27, 27, 27, 27, 27, 27, 27, 27, 28, 28, 28, 28, 28, 28, 28, 28, 28, 28, 29, 29, 29, 29, 29, 29, 29, 29, 29, 29, 29, 29, 30, 30, 30, 30, 30, 30, 30, 30, 30, 30, 30, 30, 30, 30, 31, 31, 31, 31, 31, 31, 31, 31, 31, 31, 31, 31, 31, 31, 31};

struct Args { const float* in[11]; float* out; unsigned char* ws; int ph_lo, ph_hi; };

__device__ __forceinline__ void p0_transpose_item(const float* W, int K, int N, int Npad, bf16_t* WT, const float* g, LAS float* scr, int item, int lane) {
    const int nblk = Npad / 32, kb = item / nblk, nb = item % nblk, k0 = 64 * kb, n0 = 32 * nb;
    const int nn = n0 + (lane & 31);
#pragma unroll 8
    for (int i = 0; i < 32; ++i) { const int kk = 2 * i + (lane >> 5); float v = (nn < N) ? W[(size_t)(k0 + kk) * N + nn] : 0.f; if (g) v *= g[k0 + kk]; scr[kk * 33 + (lane & 31)] = v; }
    WAVE_SYNC();
    const int c = lane & 7;
#pragma unroll
    for (int j = 0; j < 4; ++j) { const int n = (lane >> 3) + 8 * j; const LAS float* s = scr + (8 * c) * 33 + n;
        v4u o; o.x = pk2(s[0 * 33], s[1 * 33]); o.y = pk2(s[2 * 33], s[3 * 33]); o.z = pk2(s[4 * 33], s[5 * 33]); o.w = pk2(s[6 * 33], s[7 * 33]);
        *(v4u*)(WT + (size_t)(n0 + n) * K + k0 + 8 * c) = o; }
    WAVE_SYNC();
}
template <bool NORM> __device__ __forceinline__ void row_to_bf16(const float* xrow, bf16_t* orow, int lane) {
    const f32x4* xr = (const f32x4*)xrow + lane;
    f32x4 v[4]; float s = 0.f;
#pragma unroll
    for (int j = 0; j < 4; ++j) { v[j] = xr[64 * j]; s += (v[j].x * v[j].x + v[j].y * v[j].y) + (v[j].z * v[j].z + v[j].w * v[j].w); }
    float r = 1.f;
    if (NORM) r = 1.0f / sqrtf(wave_sum(s) * (1.f / DM) + EPS);
    v2u* o8 = (v2u*)orow + lane;
#pragma unroll
    for (int j = 0; j < 4; ++j) { v2u w; w.x = pk2(v[j].x * r, v[j].y * r); w.y = pk2(v[j].z * r, v[j].w * r); o8[64 * j] = w; }
}

__device__ __forceinline__ void ckvnorm4(const bf16_t* PROJ, const float* kvg, bf16_t* CKVN, int row0, int lane) {
    const int row = row0 + (lane >> 4), c8 = (lane & 15) * 8;
    const v4u v = *(const v4u*)(PROJ + (size_t)row * LDP + C_CKV + c8);
    float f[8] = {__uint_as_float(v.x << 16), __uint_as_float(v.x & 0xffff0000u), __uint_as_float(v.y << 16), __uint_as_float(v.y & 0xffff0000u),
                  __uint_as_float(v.z << 16), __uint_as_float(v.z & 0xffff0000u), __uint_as_float(v.w << 16), __uint_as_float(v.w & 0xffff0000u)};
    float s = 0.f;
#pragma unroll
    for (int j = 0; j < 8; ++j) s += f[j] * f[j];
    s = row16_sum(s);
    const float r = 1.0f / sqrtf(s * (1.0f / 128.f) + EPS);
    const f32x4 g0 = *(const f32x4*)(kvg + c8), g1 = *(const f32x4*)(kvg + c8 + 4);
    v4u o; o.x = pk2(f[0] * r * g0.x, f[1] * r * g0.y); o.y = pk2(f[2] * r * g0.z, f[3] * r * g0.w); o.z = pk2(f[4] * r * g1.x, f[5] * r * g1.y); o.w = pk2(f[6] * r * g1.z, f[7] * r * g1.w);
    *(v4u*)(CKVN + (size_t)row * 128 + c8) = o;
}
__device__ __forceinline__ unsigned ordkey(float f) { unsigned u = __float_as_uint(f); return (u & 0x80000000u) ? ~u : (u | 0x80000000u); }
template <bool L0> __device__ __forceinline__ void post_row(const float* xin, const bf16_t* Y, const float* g, float* xout, bf16_t* X1b, bf16_t* Hn, int row, int lane) {
    const bf16_t* yp = Y + (size_t)row * DM;
    float yv[16]; float s = 0.f;
#pragma unroll
    for (int j = 0; j < 4; ++j) {
        const v2u v = *(const v2u*)(yp + (lane + 64 * j) * 4);
        yv[4 * j + 0] = __uint_as_float(v.x << 16); yv[4 * j + 1] = __uint_as_float(v.x & 0xffff0000u);
        yv[4 * j + 2] = __uint_as_float(v.y << 16); yv[4 * j + 3] = __uint_as_float(v.y & 0xffff0000u);
        s += yv[4 * j] * yv[4 * j] + yv[4 * j + 1] * yv[4 * j + 1] + yv[4 * j + 2] * yv[4 * j + 2] + yv[4 * j + 3] * yv[4 * j + 3];
    }
    const float r = 1.0f / sqrtf(wave_sum(s) * (1.0f / DM) + EPS);
    f32x4 ov[4]; float s2 = 0.f;
#pragma unroll
    for (int j = 0; j < 4; ++j) {
        const int c = (lane + 64 * j) * 4;
        f32x4 xv;
        if (L0) xv = *(const f32x4*)(xin + (size_t)row * DM + c);
        else { const v2u xb = *(const v2u*)(X1b + (size_t)row * DM + c); xv.x = __uint_as_float(xb.x << 16); xv.y = __uint_as_float(xb.x & 0xffff0000u); xv.z = __uint_as_float(xb.y << 16); xv.w = __uint_as_float(xb.y & 0xffff0000u); }
        const f32x4 gv = *(const f32x4*)(g + c);
        ov[j].x = xv.x + yv[4 * j] * r * gv.x; ov[j].y = xv.y + yv[4 * j + 1] * r * gv.y; ov[j].z = xv.z + yv[4 * j + 2] * r * gv.z; ov[j].w = xv.w + yv[4 * j + 3] * r * gv.w;
        if (L0) { v2u w; w.x = pk2(ov[j].x, ov[j].y); w.y = pk2(ov[j].z, ov[j].w); *(v2u*)(X1b + (size_t)row * DM + c) = w; }
        else *(f32x4*)(xout + (size_t)row * DM + c) = ov[j];
        s2 += (ov[j].x * ov[j].x + ov[j].y * ov[j].y) + (ov[j].z * ov[j].z + ov[j].w * ov[j].w);
    }
    if (Hn) {
        const float r2 = 1.0f / sqrtf(wave_sum(s2) * (1.f / DM) + EPS);
        v2u* o8 = (v2u*)(Hn + (size_t)row * DM) + lane;
#pragma unroll
        for (int j = 0; j < 4; ++j) { v2u w; w.x = pk2(ov[j].x * r2, ov[j].y * r2); w.y = pk2(ov[j].z * r2, ov[j].w * r2); o8[64 * j] = w; }
    }
}

typedef short bf16x8 __attribute__((ext_vector_type(8)));
typedef short s16x4 __attribute__((ext_vector_type(4)));
typedef float f32x16 __attribute__((ext_vector_type(16)));
typedef float f32x2_t __attribute__((ext_vector_type(2)));
typedef __bf16 bf16x2_t __attribute__((ext_vector_type(2)));
#define MFMA32(a, b, c) __builtin_amdgcn_mfma_f32_32x32x16_bf16((a), (b), (c), 0, 0, 0)
__device__ __forceinline__ unsigned cvtpk(float lo, float hi) { f32x2_t v = {lo, hi}; bf16x2_t b = __builtin_convertvector(v, bf16x2_t); return __builtin_bit_cast(unsigned, b); }
__device__ __forceinline__ s16x4 vtr(const LAS unsigned char* p) { return __builtin_bit_cast(s16x4, __builtin_amdgcn_ds_read_tr16_b64_v4i16((LAS s16x4*)p)); }
__device__ __forceinline__ int crow(int r, int hi) { return (r & 3) + 8 * (r >> 2) + 4 * hi; }
__device__ __forceinline__ bf16x8 pack8(const f32x16& x, int s) {
    v4u p; p.x = cvtpk(x[8 * s + 0], x[8 * s + 1]); p.y = cvtpk(x[8 * s + 2], x[8 * s + 3]); p.z = cvtpk(x[8 * s + 4], x[8 * s + 5]); p.w = cvtpk(x[8 * s + 6], x[8 * s + 7]);
    return __builtin_bit_cast(bf16x8, p);
}
__device__ __forceinline__ f32x16 zero16() { float z; asm volatile("v_mov_b32 %0, 0" : "=v"(z)); return (f32x16){z, z, z, z, z, z, z, z, z, z, z, z, z, z, z, z}; }
__device__ __forceinline__ bf16x8 cat44(s16x4 lo, s16x4 hi) { return __builtin_shufflevector(lo, hi, 0, 1, 2, 3, 4, 5, 6, 7); }
__device__ __forceinline__ float xhalf_max(float v) { auto rr = __builtin_amdgcn_permlane32_swap(__float_as_uint(v), __float_as_uint(v), false, false); return fmaxf(__uint_as_float(rr[0]), __uint_as_float(rr[1])); }
__device__ __forceinline__ float xhalf_sum(float v) { auto rr = __builtin_amdgcn_permlane32_swap(__float_as_uint(v), __float_as_uint(v), false, false); return __uint_as_float(rr[0]) + __uint_as_float(rr[1]); }
__device__ __forceinline__ unsigned xhalf_other_u(unsigned v, int hi) { auto rr = __builtin_amdgcn_permlane32_swap(v, v, false, false); return hi ? rr[0] : rr[1]; }
__device__ __forceinline__ float xhalf_other(float v, int hi) { return __uint_as_float(xhalf_other_u(__float_as_uint(v), hi)); }
constexpr int VT_PITCH = 192;
constexpr float LOG2E = 1.4426950408889634f;

__device__ __forceinline__ void pv_tile(f32x16 (&O)[2], const LAS unsigned char* vrd, bf16x8 p0, bf16x8 p1) {
#pragma unroll
    for (int c = 0; c < 2; ++c) {
        const bf16x8 a0 = cat44(vtr(vrd + 0 * VT_PITCH + 64 * c), vtr(vrd + 8 * VT_PITCH + 64 * c));
        const bf16x8 a1 = cat44(vtr(vrd + 16 * VT_PITCH + 64 * c), vtr(vrd + 24 * VT_PITCH + 64 * c));
        O[c] = MFMA32(a0, p0, O[c]);
        O[c] = MFMA32(a1, p1, O[c]);
    }
}
__device__ __forceinline__ void gate_store(const f32x16 (&O)[2], float scale, const bf16_t* grow, bf16_t* orow, int hi) {
#pragma unroll
    for (int c = 0; c < 2; ++c)
#pragma unroll
        for (int g = 0; g < 4; ++g) {
            const int d = 32 * c + 8 * g + 4 * hi;
            const v2u gv = *(const v2u*)(grow + d);
            float gt[4] = {__uint_as_float(gv.x << 16), __uint_as_float(gv.x & 0xffff0000u), __uint_as_float(gv.y << 16), __uint_as_float(gv.y & 0xffff0000u)};
            float ov[4];
#pragma unroll
            for (int j = 0; j < 4; ++j) ov[j] = O[c][4 * g + j] * scale * gt[j] * __builtin_amdgcn_rcpf(1.f + __builtin_amdgcn_exp2f(-gt[j] * LOG2E));
            v2u w; w.x = cvtpk(ov[0], ov[1]); w.y = cvtpk(ov[2], ov[3]);
            *(v2u*)(orow + d) = w;
        }
}

__device__ __forceinline__ void gate_load(v2u (&gw)[8], const bf16_t* grow, int hi) {
#pragma unroll
    for (int c = 0; c < 2; ++c)
#pragma unroll
        for (int g = 0; g < 4; ++g) gw[c * 4 + g] = *(const v2u*)(grow + 32 * c + 8 * g + 4 * hi);
}
__device__ __forceinline__ void gate_store_pre(const f32x16 (&O)[2], float scale, const v2u (&gw)[8], bf16_t* orow, int hi) {
#pragma unroll
    for (int c = 0; c < 2; ++c)
#pragma unroll
        for (int g = 0; g < 4; ++g) {
            const int d = 32 * c + 8 * g + 4 * hi;
            const v2u gv = gw[c * 4 + g];
            float gt[4] = {__uint_as_float(gv.x << 16), __uint_as_float(gv.x & 0xffff0000u), __uint_as_float(gv.y << 16), __uint_as_float(gv.y & 0xffff0000u)};
            float ov[4];
#pragma unroll
            for (int j = 0; j < 4; ++j) ov[j] = O[c][4 * g + j] * scale * gt[j] * __builtin_amdgcn_rcpf(1.f + __builtin_amdgcn_exp2f(-gt[j] * LOG2E));
            v2u w; w.x = cvtpk(ov[0], ov[1]); w.y = cvtpk(ov[2], ov[3]);
            *(v2u*)(orow + d) = w;
        }
}

__device__ __forceinline__ void sb_item(const bf16_t* PROJ, bf16_t* MIX, int b, int h, int qt, int lane, LAS unsigned char* wl) {
    asm volatile("" : "+v"(lane));
    const int r32 = lane & 31, hi = lane >> 5;
    const bf16_t* base = PROJ + (size_t)b * SEQ * LDP;
    const int t = 32 * qt + r32;
    bf16x8 qf[4];
#pragma unroll
    for (int ks = 0; ks < 4; ++ks) qf[ks] = *(const bf16x8*)(base + (size_t)t * LDP + C_SBQ + h * 64 + 16 * ks + 8 * hi);
    v2u gw[8]; gate_load(gw, base + (size_t)t * LDP + C_SBG + h * 64, hi);
    const int vrow = lane >> 3, vch = lane & 7;
    LAS unsigned char* vwr = wl + vrow * VT_PITCH + vch * 16;
    const LAS unsigned char* vrd = wl + (4 * hi + ((lane & 15) >> 2)) * VT_PITCH + (16 * ((lane >> 4) & 1) + 4 * (lane & 3)) * 2;
    bf16x8 kc[4], vc[4];
    {
        const bf16_t* kp = base + (size_t)(32 * qt + r32) * LDP + C_SBK + h * 64 + 8 * hi;
#pragma unroll
        for (int ks = 0; ks < 4; ++ks) kc[ks] = *(const bf16x8*)(kp + 16 * ks);
        const bf16_t* vp = base + (size_t)(32 * qt + vrow) * LDP + C_SBV + h * 64 + 8 * vch;
#pragma unroll
        for (int i = 0; i < 4; ++i) vc[i] = *(const bf16x8*)(vp + (size_t)(8 * i) * LDP);
    }
    f32x16 O[2];
#pragma unroll
    for (int r = 0; r < 16; ++r) { O[0][r] = 0.f; O[1][r] = 0.f; }
    float R = 1.f;
    for (int kt = qt; kt >= 0; --kt) {
        bf16x8 kn[4], vn[4];
        {
            const int ktn = kt > 0 ? kt - 1 : 0;
            const bf16_t* kp = base + (size_t)(32 * ktn + r32) * LDP + C_SBK + h * 64 + 8 * hi;
#pragma unroll
            for (int ks = 0; ks < 4; ++ks) kn[ks] = *(const bf16x8*)(kp + 16 * ks);
            const bf16_t* vp = base + (size_t)(32 * ktn + vrow) * LDP + C_SBV + h * 64 + 8 * vch;
#pragma unroll
            for (int i = 0; i < 4; ++i) vn[i] = *(const bf16x8*)(vp + (size_t)(8 * i) * LDP);
        }
        f32x16 acc;
#pragma unroll
        for (int r = 0; r < 16; ++r) acc[r] = 0.f;
#pragma unroll
        for (int ks = 0; ks < 4; ++ks) acc = MFMA32(kc[ks], qf[ks], acc);
#pragma unroll
        for (int i = 0; i < 4; ++i) *(LAS bf16x8*)(vwr + (8 * i) * VT_PITCH) = vc[i];
        float be[16], om[16];
        const bool diag = (kt == qt);
#pragma unroll
        for (int r = 0; r < 16; ++r) {
            const float e = __builtin_amdgcn_exp2f(fminf(acc[r] * (-0.125f * LOG2E), 115.f));
            float bt = __builtin_amdgcn_rcpf(1.f + e), o1 = e * bt;
            if (diag && !(crow(r, hi) < r32)) { bt = 0.f; o1 = 1.f; }
            be[r] = bt; om[r] = o1;
        }
        float Gp[4], Gq[4];
#pragma unroll
        for (int g = 0; g < 4; ++g) { Gp[g] = (om[4 * g] * om[4 * g + 1]) * (om[4 * g + 2] * om[4 * g + 3]); Gq[g] = xhalf_other(Gp[g], hi); }
        const float T1 = Gp[1] * Gq[1], T2 = Gp[2] * Gq[2], T3 = Gp[3] * Gq[3], T0 = Gp[0] * Gq[0];
        float tail[4]; tail[3] = R; tail[2] = R * T3; tail[1] = tail[2] * T2; tail[0] = tail[1] * T1;
        const float Rn = tail[0] * T0;
#pragma unroll
        for (int g = 0; g < 4; ++g) {
            float sfx = tail[g] * (hi == 0 ? Gq[g] : 1.f);
            acc[4 * g + 3] = be[4 * g + 3] * sfx; sfx *= om[4 * g + 3];
            acc[4 * g + 2] = be[4 * g + 2] * sfx; sfx *= om[4 * g + 2];
            acc[4 * g + 1] = be[4 * g + 1] * sfx; sfx *= om[4 * g + 1];
            acc[4 * g + 0] = be[4 * g + 0] * sfx;
        }
        R = Rn;
        const bf16x8 p0 = pack8(acc, 0), p1 = pack8(acc, 1);
        pv_tile(O, vrd, p0, p1);
        if (__all(R < 7.8886e-31f)) break;
#pragma unroll
        for (int i = 0; i < 4; ++i) { kc[i] = kn[i]; vc[i] = vn[i]; }
    }
    gate_store_pre(O, 1.f, gw, MIX + ((size_t)b * SEQ + t) * DM + h * 64, hi);
}

__device__ __forceinline__ void mem_item(const bf16_t* PROJ, const bf16_t* KV, bf16_t* MIX, int b, int h, int qt, int lane, LAS unsigned char* wl) {
    asm volatile("" : "+v"(lane));
    float NINF; asm volatile("v_mov_b32 %0, 0xff800000" : "=v"(NINF));
    const int r32 = lane & 31, hi = lane >> 5;
    const int t = 32 * qt + r32;
    const bf16_t* prow = PROJ + ((size_t)b * SEQ + t) * LDP;
    bf16x8 qf[4];
#pragma unroll
    for (int ks = 0; ks < 4; ++ks) qf[ks] = *(const bf16x8*)(prow + C_MQ + h * 64 + 16 * ks + 8 * hi);
    const int vrow = lane >> 3, vch = lane & 7;
    LAS unsigned char* vwr = wl + vrow * VT_PITCH + vch * 16;
    const LAS unsigned char* vrd = wl + (4 * hi + ((lane & 15) >> 2)) * VT_PITCH + (16 * ((lane >> 4) & 1) + 4 * (lane & 3)) * 2;
    const bf16_t* kvb = KV + (size_t)b * NMEM * 1024 + h * 64;
    f32x16 O[2];
#pragma unroll
    for (int r = 0; r < 16; ++r) { O[0][r] = 0.f; O[1][r] = 0.f; }
    float mrun = NINF, lrun = 0.f;
    v2u gw[8]; gate_load(gw, prow + C_MG + h * 64, hi);
    bf16x8 kc[4], vc[4];
    {
        const bf16_t* kp = kvb + (size_t)r32 * 1024 + 8 * hi;
#pragma unroll
        for (int ks = 0; ks < 4; ++ks) kc[ks] = *(const bf16x8*)(kp + 16 * ks);
        const bf16_t* vp = kvb + (size_t)vrow * 1024 + 256 + 8 * vch;
#pragma unroll
        for (int i = 0; i < 4; ++i) vc[i] = *(const bf16x8*)(vp + (size_t)(8 * i) * 1024);
    }
    for (int kt = 0; kt < NMEM / 32; ++kt) {
        bf16x8 kn[4], vn[4];
        {
            const int ktn = kt < NMEM / 32 - 1 ? kt + 1 : kt;
            const bf16_t* kp = kvb + (size_t)(32 * ktn + r32) * 1024 + 8 * hi;
#pragma unroll
            for (int ks = 0; ks < 4; ++ks) kn[ks] = *(const bf16x8*)(kp + 16 * ks);
            const bf16_t* vp = kvb + (size_t)(32 * ktn + vrow) * 1024 + 256 + 8 * vch;
#pragma unroll
            for (int i = 0; i < 4; ++i) vn[i] = *(const bf16x8*)(vp + (size_t)(8 * i) * 1024);
        }
        f32x16 acc;
#pragma unroll
        for (int r = 0; r < 16; ++r) acc[r] = 0.f;
#pragma unroll
        for (int ks = 0; ks < 4; ++ks) acc = MFMA32(kc[ks], qf[ks], acc);
#pragma unroll
        for (int i = 0; i < 4; ++i) *(LAS bf16x8*)(vwr + (8 * i) * VT_PITCH) = vc[i];
        float mx = acc[0];
#pragma unroll
        for (int r = 1; r < 16; ++r) mx = fmaxf(mx, acc[r]);
        mx *= 0.125f * LOG2E;
        mx = xhalf_max(mx);
        const float mn = fmaxf(mrun, mx), alpha = __builtin_amdgcn_exp2f(mrun - mn);
        float ps = 0.f;
#pragma unroll
        for (int r = 0; r < 16; ++r) { acc[r] = __builtin_amdgcn_exp2f(acc[r] * (0.125f * LOG2E) - mn); ps += acc[r]; }
        lrun = lrun * alpha + ps; mrun = mn;
#pragma unroll
        for (int r = 0; r < 16; ++r) { O[0][r] *= alpha; O[1][r] *= alpha; }
        const bf16x8 p0 = pack8(acc, 0), p1 = pack8(acc, 1);
        pv_tile(O, vrd, p0, p1);
#pragma unroll
        for (int i = 0; i < 4; ++i) { kc[i] = kn[i]; vc[i] = vn[i]; }
    }
    const float lt = xhalf_sum(lrun);
    gate_store_pre(O, 1.f / lt, gw, MIX + ((size_t)b * SEQ + t) * DM + 768 + h * 64, hi);
}

constexpr int MEML_V_OFF = 32768;
__device__ __forceinline__ void mem_stage(const bf16_t* KV, int b, int h, int tid, LAS unsigned char* L) {
    const bf16_t* kvb = KV + (size_t)b * NMEM * 1024 + h * 64;
#pragma unroll
    for (int i = 0; i < 4; ++i) {
        const int idx = tid + 512 * i, key = idx >> 3, ch = idx & 7;
        const v4u kx = *(const v4u*)(kvb + (size_t)key * 1024 + 8 * ch), vx = *(const v4u*)(kvb + (size_t)key * 1024 + 256 + 8 * ch);
        *(LAS v4u*)(L + 128 * key + 16 * (ch ^ ((key >> 1) & 7))) = kx;
        *(LAS v4u*)(L + MEML_V_OFF + (key >> 5) * (32 * VT_PITCH) + (key & 31) * VT_PITCH + 16 * ch) = vx;
    }
}
__device__ __forceinline__ void mem_item_lds(const bf16_t* PROJ, bf16_t* MIX, int b, int h, int qt, int lane, const LAS unsigned char* L) {
    asm volatile("" : "+v"(lane));
    float NINF; asm volatile("v_mov_b32 %0, 0xff800000" : "=v"(NINF));
    const int r32 = lane & 31, hi = lane >> 5;
    const int t = 32 * qt + r32;
    const bf16_t* prow = PROJ + ((size_t)b * SEQ + t) * LDP;
    bf16x8 qf[4];
#pragma unroll
    for (int ks = 0; ks < 4; ++ks) qf[ks] = *(const bf16x8*)(prow + C_MQ + h * 64 + 16 * ks + 8 * hi);
    v2u gw[8]; gate_load(gw, prow + C_MG + h * 64, hi);
    const unsigned kx = ((unsigned)r32 >> 1) & 7u;
    const LAS unsigned char* krd = L + 128 * r32;
    const LAS unsigned char* vrd = L + MEML_V_OFF + (4 * hi + ((lane & 15) >> 2)) * VT_PITCH + (16 * ((lane >> 4) & 1) + 4 * (lane & 3)) * 2;
    f32x16 O[2];
    O[0] = zero16(); O[1] = zero16();
    float mrun = NINF, lrun = 0.f;
#pragma unroll 2
    for (int kt = 0; kt < NMEM / 32; ++kt) {
        bf16x8 kc[4];
#pragma unroll
        for (int ks = 0; ks < 4; ++ks) kc[ks] = *(const LAS bf16x8*)(krd + 4096 * kt + 16 * ((unsigned)(2 * ks + hi) ^ kx));
        f32x16 acc = MFMA32(kc[0], qf[0], zero16());
#pragma unroll
        for (int ks = 1; ks < 4; ++ks) acc = MFMA32(kc[ks], qf[ks], acc);
        float mx = acc[0];
#pragma unroll
        for (int r = 1; r < 16; ++r) mx = fmaxf(mx, acc[r]);
        mx *= 0.125f * LOG2E;
        mx = xhalf_max(mx);
        const float mn = fmaxf(mrun, mx), alpha = __builtin_amdgcn_exp2f(mrun - mn);
        float ps = 0.f;
#pragma unroll
        for (int r = 0; r < 16; ++r) { acc[r] = __builtin_amdgcn_exp2f(acc[r] * (0.125f * LOG2E) - mn); ps += acc[r]; }
        lrun = lrun * alpha + ps; mrun = mn;
#pragma unroll
        for (int r = 0; r < 16; ++r) { O[0][r] *= alpha; O[1][r] *= alpha; }
        const bf16x8 p0 = pack8(acc, 0), p1 = pack8(acc, 1);
        pv_tile(O, vrd + kt * (32 * VT_PITCH), p0, p1);
    }
    const float lt = xhalf_sum(lrun);
    gate_store_pre(O, 1.f / lt, gw, MIX + ((size_t)b * SEQ + t) * DM + 768 + h * 64, hi);
}

constexpr int SEL_IQ_PITCH = 528, SEL_CNT_OFF = 17408;
__device__ __forceinline__ unsigned ordkey(float f);
template <int PRED  >
__device__ __forceinline__ unsigned sel_count_round(const unsigned (&key)[8][16], unsigned c, unsigned tau, int idx0, int r32, int hi, int wave, LAS unsigned* cb) {
    int n = 0;
#pragma unroll
    for (int i = 0; i < 8; ++i) {
#pragma unroll
        for (int r = 0; r < 16; ++r) {
            if (PRED == 0) n += (key[i][r] >= c) ? 1 : 0;
            else if (PRED == 1) n += (key[i][r] > c) ? 1 : 0;
            else n += (key[i][r] == tau && (unsigned)(idx0 + 256 * i + (r & 3) + 8 * (r >> 2)) <= c) ? 1 : 0;
            if ((r & 7) == 7) asm volatile("" : "+v"(n));
        }
    }
    n += (int)xhalf_other_u((unsigned)n, hi);
    if (hi == 0) cb[wave * 32 + r32] = (unsigned)n;
    __syncthreads();
    unsigned tot = 0;
#pragma unroll
    for (int w = 0; w < 8; ++w) tot += cb[w * 32 + r32];
    return tot;
}
constexpr int SEL_CAP = 64, SEL_DONE = 16;
__device__ __forceinline__ float key2f(unsigned k) { return __uint_as_float((k & 0x80000000u) ? (k & 0x7fffffffu) : ~k); }
__device__ __forceinline__ unsigned sel_count_lane(const unsigned (&key)[8][16], unsigned c) {
    int n = 0;
#pragma unroll
    for (int i = 0; i < 8; ++i) {
#pragma unroll
        for (int r = 0; r < 16; ++r) {
            n += (key[i][r] >= c) ? 1 : 0;
            if ((r & 7) == 7) asm volatile("" : "+v"(n));
        }
    }
    return (unsigned)n;
}
__device__ __forceinline__ unsigned sel_exchange(unsigned nl, int r32, int hi, int wave, LAS unsigned* cb) {
    const unsigned n2 = nl + xhalf_other_u(nl, hi);
    if (hi == 0) cb[wave * 32 + r32] = n2;
    __syncthreads();
    unsigned tot = 0;
#pragma unroll
    for (int w = 0; w < 8; ++w) tot += cb[w * 32 + r32];
    return tot;
}
__device__ __forceinline__ void sel_item2(const bf16_t* PROJ, unsigned* MASK, int b, int qt, int lane, int wave, LAS unsigned char* L) {
    asm volatile("" : "+v"(lane));
    const int r32 = lane & 31, hi = lane >> 5, tid = wave * 64 + lane;
    LAS unsigned* cntb = (LAS unsigned*)(L + SEL_CNT_OFF);
    const bf16_t* base = PROJ + (size_t)b * SEQ * LDP;
    unsigned* mrow = MASK + (((size_t)b * 64 + qt) * 64) * 32;
    if (qt < 8) {
#pragma unroll
        for (int i = 0; i < 8; ++i) {
            const int kt = wave + 8 * i;
            if (kt <= qt) {
                unsigned bits = 0u;
#pragma unroll
                for (int r = 0; r < 16; ++r) bits |= ((kt < qt) || (crow(r, hi) <= r32)) ? (1u << r) : 0u;
                const unsigned other = xhalf_other_u(bits, hi);
                if (hi == 0) mrow[kt * 32 + r32] = bits | (other << 16);
            }
        }
        return;
    }
    for (int n = tid; n < 1024; n += 512) { const int row = n >> 5, ch = n & 31;
        const v4u v = *(const v4u*)(base + (size_t)(32 * qt + row) * LDP + C_IDQ + ch * 8);
        *(LAS v4u*)(L + row * SEL_IQ_PITCH + ch * 16) = v; }
    float w8[8];
    { const v4u wv = *(const v4u*)(base + (size_t)(32 * qt + r32) * LDP + C_IDW);
      w8[0] = __uint_as_float(wv.x << 16) * 0.0625f; w8[1] = __uint_as_float(wv.x & 0xffff0000u) * 0.0625f; w8[2] = __uint_as_float(wv.y << 16) * 0.0625f; w8[3] = __uint_as_float(wv.y & 0xffff0000u) * 0.0625f;
      w8[4] = __uint_as_float(wv.z << 16) * 0.0625f; w8[5] = __uint_as_float(wv.z & 0xffff0000u) * 0.0625f; w8[6] = __uint_as_float(wv.w << 16) * 0.0625f; w8[7] = __uint_as_float(wv.w & 0xffff0000u) * 0.0625f; }
    __syncthreads();
    unsigned key[8][16];
    const LAS unsigned char* iqp = L + r32 * SEL_IQ_PITCH + 16 * hi;
    unsigned kmn = 0xffffffffu, kmx = 0u;
#pragma unroll
    for (int i = 0; i < 8; ++i) {
        const int kt = wave + 8 * i;
        if (kt <= qt) {
            const bf16_t* kp = base + (size_t)(32 * kt + r32) * LDP + C_IDK + 8 * hi;
            const bf16x8 k0 = *(const bf16x8*)kp, k1 = *(const bf16x8*)(kp + 16);
            float sc[16];
#pragma unroll
            for (int r = 0; r < 16; ++r) sc[r] = 0.f;
            unsigned iqo = 0; asm volatile("" : "+v"(iqo));
            const LAS unsigned char* iqt = iqp + iqo;
#pragma unroll
            for (int hp = 0; hp < 4; ++hp) {
                const int h = 2 * hp;
                bf16x8 q0 = *(const LAS bf16x8*)(iqt + h * 64), q1 = *(const LAS bf16x8*)(iqt + h * 64 + 32);
                bf16x8 q2 = *(const LAS bf16x8*)(iqt + h * 64 + 64), q3 = *(const LAS bf16x8*)(iqt + h * 64 + 96);
                asm volatile("" : "+v"(q0), "+v"(q1), "+v"(q2), "+v"(q3) : "v"(sc[15]));
                f32x16 Da, Db;
#pragma unroll
                for (int r = 0; r < 16; ++r) { Da[r] = 0.f; Db[r] = 0.f; }
                Da = MFMA32(k0, q0, Da);
                Db = MFMA32(k0, q2, Db);
                Da = MFMA32(k1, q1, Da);
                Db = MFMA32(k1, q3, Db);
#pragma unroll
                for (int r = 0; r < 16; ++r) sc[r] = __builtin_fmaf(w8[h], __int_as_float(max(__float_as_int(Da[r]), 0)), sc[r]);
#pragma unroll
                for (int r = 0; r < 16; ++r) sc[r] = __builtin_fmaf(w8[h + 1], __int_as_float(max(__float_as_int(Db[r]), 0)), sc[r]);
                asm volatile("" : "+v"(sc[0]), "+v"(sc[1]), "+v"(sc[2]), "+v"(sc[3]), "+v"(sc[4]), "+v"(sc[5]), "+v"(sc[6]), "+v"(sc[7]),
                                  "+v"(sc[8]), "+v"(sc[9]), "+v"(sc[10]), "+v"(sc[11]), "+v"(sc[12]), "+v"(sc[13]), "+v"(sc[14]), "+v"(sc[15]));
            }
            int thr = (kt < qt) ? 64 : (r32 - 4 * hi);
            asm volatile("" : "+v"(thr));
#pragma unroll
            for (int r = 0; r < 16; ++r) { const bool v = ((r & 3) + 8 * (r >> 2) <= thr); const unsigned k = ordkey(sc[r]); key[i][r] = v ? k : 0u; kmx = max(kmx, v ? k : 0u); kmn = min(kmn, v ? k : 0xffffffffu); }
        } else {
#pragma unroll
            for (int r = 0; r < 16; ++r) key[i][r] = 0u;
        }
    }
    unsigned lo_key, hi_key, clo, chi = 0u, nlo_l, nhi_l = 0u;
    {
        int nv = 0;
#pragma unroll
        for (int i = 0; i < 8; ++i) { const int kt = wave + 8 * i; nv += (kt < qt) ? 16 : 0; }
        if ((qt & 7) == wave) { const int thr = r32 - 4 * hi;
#pragma unroll
            for (int r = 0; r < 16; ++r) nv += ((r & 3) + 8 * (r >> 2) <= thr) ? 1 : 0; }
        nlo_l = (unsigned)nv;
        kmn = min(kmn, xhalf_other_u(kmn, hi)); kmx = max(kmx, xhalf_other_u(kmx, hi));
        if (hi == 0) { cntb[wave * 32 + r32] = kmn; cntb[256 + wave * 32 + r32] = kmx; }
        __syncthreads();
        unsigned a = 0xffffffffu, bmx = 0u;
#pragma unroll
        for (int w = 0; w < 8; ++w) { a = min(a, cntb[w * 32 + r32]); bmx = max(bmx, cntb[256 + w * 32 + r32]); }
        lo_key = a; hi_key = bmx + 1u; clo = (unsigned)(32 * qt + r32 + 1);
        __syncthreads();
    }
    int round = 0;
    for (;;) {
        const bool done = (clo - chi <= (unsigned)SEL_DONE) || (hi_key - lo_key <= 1u);
        if (__all(done)) break;
        unsigned p;
        if ((round & 3) == 3) p = lo_key + ((hi_key - lo_key) >> 1);
        else p = ordkey(0.5f * key2f(lo_key) + 0.5f * key2f(hi_key));
        p = min(max(p, lo_key + 1u), hi_key - 1u);
        if (done) p = lo_key;
        const unsigned nl = sel_count_lane(key, p);
        const unsigned tot = sel_exchange(nl, r32, hi, wave, cntb + (round & 1) * 256);
        if (!done) { if (tot >= 256u) { lo_key = p; clo = tot; nlo_l = nl; } else { hi_key = p; chi = tot; nhi_l = nl; } }
        ++round;
    }
    unsigned tau, cut;
    const bool many = (clo - chi > (unsigned)SEL_CAP);
    {
        LAS unsigned* lanecnt = (LAS unsigned*)L; LAS unsigned* meta = (LAS unsigned*)(L + 2048); LAS unsigned* result = (LAS unsigned*)(L + 2304); LAS unsigned* list = (LAS unsigned*)(L + 20480);
        const int slot = wave * 2 + hi;
        lanecnt[r32 * 16 + slot] = many ? 0u : (nlo_l - nhi_l);
        if (slot == 0) { meta[2 * r32] = many ? 0u : (clo - chi); meta[2 * r32 + 1] = 256u - chi; }
        __syncthreads();
        unsigned bs = 0u;
#pragma unroll
        for (int s2 = 0; s2 < 16; ++s2) { const unsigned v = lanecnt[r32 * 16 + s2]; bs += (s2 < slot) ? v : 0u; }
        if (!many) {
            const int idx0 = 32 * wave + 4 * hi;
            LAS unsigned* lp = list + (r32 * SEL_CAP + bs) * 2;
#pragma unroll
            for (int i = 0; i < 8; ++i)
#pragma unroll
                for (int r = 0; r < 16; ++r) {
                    const unsigned k = key[i][r];
                    if (k >= lo_key && k < hi_key) { lp[0] = k; lp[1] = (unsigned)(idx0 + 256 * i + (r & 3) + 8 * (r >> 2)); lp += 2; }
                }
        }
        __syncthreads();
        for (int j = 0; j < 4; ++j) {
            const int q = 4 * wave + j;
            const unsigned ncand = (unsigned)__builtin_amdgcn_readfirstlane((int)meta[2 * q]), need = (unsigned)__builtin_amdgcn_readfirstlane((int)meta[2 * q + 1]);
            const LAS unsigned* lq = list + q * SEL_CAP * 2;
            const bool mine = (unsigned)lane < ncand;
            const unsigned kc = mine ? lq[2 * lane] : 0u, ic = mine ? lq[2 * lane + 1] : 0u;
            unsigned rank = 0u;
            for (unsigned c2 = 0; c2 < ncand; ++c2) {
                const unsigned k2 = (unsigned)__builtin_amdgcn_readlane((int)kc, (int)c2), i2 = (unsigned)__builtin_amdgcn_readlane((int)ic, (int)c2);
                rank += (k2 > kc || (k2 == kc && i2 < ic)) ? 1u : 0u;
            }
            if (mine && rank == need - 1u) { result[2 * q] = kc; result[2 * q + 1] = ic; }
        }
        __syncthreads();
        tau = result[2 * r32]; cut = result[2 * r32 + 1];
    }
    if (__any(many)) {
        const unsigned need = 256u - chi;
        const int idx0 = 32 * wave + 4 * hi;
        unsigned lo_ = 0u, hi_ = 2047u;
        for (int it = 0; it < 11; ++it) {
            const unsigned mid = (lo_ + hi_) >> 1;
            const unsigned f = sel_count_round<2>(key, mid, lo_key, idx0, r32, hi, wave, cntb + (it & 1) * 256);
            if (f >= need) hi_ = mid; else lo_ = mid + 1;
        }
        if (many) { tau = lo_key; cut = hi_; }
    }
    {
        const int idx0 = 32 * wave + 4 * hi;
#pragma unroll
        for (int i = 0; i < 8; ++i) {
            const int kt = wave + 8 * i;
            if (kt <= qt) {
                unsigned bits = 0u;
#pragma unroll
                for (int r = 0; r < 16; ++r) {
                    const bool s = (key[i][r] > tau) || (key[i][r] == tau && (unsigned)(idx0 + 256 * i + (r & 3) + 8 * (r >> 2)) <= cut);
                    bits |= s ? (1u << r) : 0u;
                }
                const unsigned other = xhalf_other_u(bits, hi);
                if (hi == 0) mrow[kt * 32 + r32] = bits | (other << 16);
            }
        }
    }
    __syncthreads();
}

constexpr int WS_WUK = 0;
constexpr int WS_WUV = 256 * 1024;
constexpr int DSA_BIAS_OFF = 16384;
__device__ __forceinline__ unsigned dsa_off(unsigned row, unsigned ch) { return 256u * row + 16u * (ch ^ (((row & 3u) << 2) | ((row >> 2) & 3u))); }
constexpr int DSA_NBUF = 6, DSA_MASK_OFF = 49152, DSA_BIAS2_OFF = 114688;
__device__ __forceinline__ void glds16(const void* gsrc, unsigned lds_dst) { unsigned keep;
    asm volatile("s_mov_b32 %0, m0\n\ts_mov_b32 m0, %2\n\ts_nop 0\n\tglobal_load_lds_dwordx4 %1, off\n\ts_mov_b32 m0, %0" : "=&s"(keep) : "v"(gsrc), "s"(lds_dst) : "memory"); }
__device__ __forceinline__ void lds_read8_b128(bf16x8 (&a)[8], unsigned be, unsigned bo) {
    asm volatile("ds_read_b128 %0, %8\n\tds_read_b128 %1, %9\n\tds_read_b128 %2, %8 offset:512\n\tds_read_b128 %3, %9 offset:512\n\t"
                 "ds_read_b128 %4, %8 offset:1024\n\tds_read_b128 %5, %9 offset:1024\n\tds_read_b128 %6, %8 offset:1536\n\tds_read_b128 %7, %9 offset:1536"
                 : "=&v"(a[0]), "=&v"(a[1]), "=&v"(a[2]), "=&v"(a[3]), "=&v"(a[4]), "=&v"(a[5]), "=&v"(a[6]), "=&v"(a[7]) : "v"(be), "v"(bo));
}
template <int N> __device__ __forceinline__ void lgkm_wait(bf16x8& a) { asm volatile("s_waitcnt lgkmcnt(%1)" : "+v"(a) : "n"(N)); }
__device__ __forceinline__ void lds_read16_tr(s16x4 (&f)[4][4], unsigned b0, unsigned b1) {
    asm volatile("ds_read_b64_tr_b16 %0, %16\n\tds_read_b64_tr_b16 %1, %17 offset:2048\n\tds_read_b64_tr_b16 %2, %16 offset:4096\n\tds_read_b64_tr_b16 %3, %17 offset:6144\n\t"
                 "ds_read_b64_tr_b16 %4, %16 offset:512\n\tds_read_b64_tr_b16 %5, %17 offset:2560\n\tds_read_b64_tr_b16 %6, %16 offset:4608\n\tds_read_b64_tr_b16 %7, %17 offset:6656\n\t"
                 "ds_read_b64_tr_b16 %8, %16 offset:1024\n\tds_read_b64_tr_b16 %9, %17 offset:3072\n\tds_read_b64_tr_b16 %10, %16 offset:5120\n\tds_read_b64_tr_b16 %11, %17 offset:7168\n\t"
                 "ds_read_b64_tr_b16 %12, %16 offset:1536\n\tds_read_b64_tr_b16 %13, %17 offset:3584\n\tds_read_b64_tr_b16 %14, %16 offset:5632\n\tds_read_b64_tr_b16 %15, %17 offset:7680"
                 : "=&v"(f[0][0]), "=&v"(f[0][1]), "=&v"(f[0][2]), "=&v"(f[0][3]), "=&v"(f[1][0]), "=&v"(f[1][1]), "=&v"(f[1][2]), "=&v"(f[1][3]),
                   "=&v"(f[2][0]), "=&v"(f[2][1]), "=&v"(f[2][2]), "=&v"(f[2][3]), "=&v"(f[3][0]), "=&v"(f[3][1]), "=&v"(f[3][2]), "=&v"(f[3][3]) : "v"(b0), "v"(b1));
}
__device__ __forceinline__ void lgkm_wait_all(s16x4 (&f)[4][4]) {
    asm volatile("s_waitcnt lgkmcnt(0)" : "+v"(f[0][0]), "+v"(f[0][1]), "+v"(f[0][2]), "+v"(f[0][3]), "+v"(f[1][0]), "+v"(f[1][1]), "+v"(f[1][2]), "+v"(f[1][3]),
                   "+v"(f[2][0]), "+v"(f[2][1]), "+v"(f[2][2]), "+v"(f[2][3]), "+v"(f[3][0]), "+v"(f[3][1]), "+v"(f[3][2]), "+v"(f[3][3]));
}
__device__ __forceinline__ void dsa_round(const bf16_t* PROJ, const bf16_t* CKVN, const unsigned* MASK, const bf16_t* WUKp  , const bf16_t* WUVp  ,
                                          const float* rel_bias, bf16_t* MIX, int b, int o, int h, int lane, int wave, LAS unsigned char* L) {
    asm volatile("" : "+v"(lane));
    float NINF; asm volatile("v_mov_b32 %0, 0xff800000" : "=v"(NINF));
    const int r32 = lane & 31, hi = lane >> 5, tid = wave * 64 + lane;
    const int qt = 8 * o + wave, KT = 8 * o + 7, t = 32 * qt + r32;
    const int srow = 8 * (wave >> 1) + ((lane >> 2) & 7);
    const int sch = 4 * (2 * (wave & 1) + (lane >> 5)) + ((lane & 3) ^ ((2 * (wave >> 1) + ((lane >> 4) & 1)) & 3));
    const bf16_t* csrc = CKVN + ((size_t)b * SEQ + srow) * 128 + 8 * sch;
    const unsigned ring0 = (unsigned)__builtin_amdgcn_readfirstlane((int)(unsigned)(size_t)L) + 1024u * (unsigned)wave;
    LAS unsigned* maskL = (LAS unsigned*)(L + DSA_MASK_OFF + wave * 8192);
    {
        const unsigned char* msrc = (const unsigned char*)(MASK + (((size_t)b * 64 + qt) * 64) * 32) + 16 * lane;
        const unsigned mdst = (unsigned)__builtin_amdgcn_readfirstlane((int)(unsigned)(size_t)maskL);
        for (int p = 0; 8 * p <= qt; ++p) glds16(msrc + 1024 * p, mdst + 1024u * (unsigned)p);
    }
    glds16(csrc, ring0); glds16(csrc + (size_t)32 * 128, ring0 + 8192u); glds16(csrc + (size_t)64 * 128, ring0 + 16384u); glds16(csrc + (size_t)96 * 128, ring0 + 24576u);
    LAS float* biasT = (LAS float*)(L + DSA_BIAS2_OFF);
    if (tid < 192) { const int bk = tid < 128 ? (int)T5TAB[tid] : 31; biasT[tid] = rel_bias[bk * 6 + h] * LOG2E; }
    const float bias31 = rel_bias[31 * 6 + h] * LOG2E;
    bf16x8 qlf[8];
    {
        const bf16_t* qrow = PROJ + ((size_t)b * SEQ + t) * LDP + C_DSQ + h * 64 + 8 * hi;
        bf16x8 qf[4];
#pragma unroll
        for (int ks = 0; ks < 4; ++ks) qf[ks] = *(const bf16x8*)(qrow + 16 * ks);
        bf16x8 wk[16];
#pragma unroll
        for (int rt = 0; rt < 4; ++rt) {
            const GAS bf16_t* wp = (const GAS bf16_t*)WUKp + (rt * 32 + r32) * 64 + 8 * hi;
#pragma unroll
            for (int ks = 0; ks < 4; ++ks) wk[rt * 4 + ks] = *(const GAS bf16x8*)(wp + 16 * ks);
        }
        asm volatile("" : "+v"(wk[0]), "+v"(wk[1]), "+v"(wk[2]), "+v"(wk[3]), "+v"(wk[4]), "+v"(wk[5]), "+v"(wk[6]), "+v"(wk[7]),
                          "+v"(wk[8]), "+v"(wk[9]), "+v"(wk[10]), "+v"(wk[11]), "+v"(wk[12]), "+v"(wk[13]), "+v"(wk[14]), "+v"(wk[15]));
#pragma unroll
        for (int rt = 0; rt < 4; ++rt) {
            f32x16 X;
#pragma unroll
            for (int r = 0; r < 16; ++r) X[r] = 0.f;
#pragma unroll
            for (int ks = 0; ks < 4; ++ks) X = MFMA32(wk[rt * 4 + ks], qf[ks], X);
#pragma unroll
            for (int r = 0; r < 16; ++r) X[r] *= 0.125f * LOG2E;
            qlf[2 * rt] = pack8(X, 0); qlf[2 * rt + 1] = pack8(X, 1);
        }
    }
    f32x16 O[4];
#pragma unroll
    for (int c = 0; c < 4; ++c)
#pragma unroll
        for (int r = 0; r < 16; ++r) O[c][r] = 0.f;
    float mref = NINF, lrun = 0.f;
    const unsigned x2 = ((unsigned)r32 >> 2) & 3u;
    const unsigned rb_e = 2048u * ((unsigned)r32 >> 3) + 64u * ((unsigned)r32 & 7u) + 16u * ((unsigned)hi ^ x2);
    const unsigned rb_o = 2048u * ((unsigned)r32 >> 3) + 64u * ((unsigned)r32 & 7u) + 16u * ((2u + (unsigned)hi) ^ x2);
    const unsigned tq = (lane & 15) >> 2, tp = lane & 3, tblk = (lane >> 4) & 1;
    const unsigned tb0 = 64u * (4u * hi + tq) + 16u * ((2u * tblk + (tp >> 1)) ^ ((unsigned)hi & 3u)) + 8u * (tp & 1);
    const unsigned tb1 = 64u * (4u * hi + tq) + 16u * ((2u * tblk + (tp >> 1)) ^ ((2u + (unsigned)hi) & 3u)) + 8u * (tp & 1);
    __syncthreads();
    asm volatile("s_waitcnt vmcnt(0) lgkmcnt(0)" ::: "memory");
    auto dsa_qk = [&](const int kt, f32x16& S, const LAS unsigned char* Cb) __attribute__((always_inline)) {
        if (kt <= qt) {
#pragma unroll
            for (int r = 0; r < 16; ++r) S[r] = 0.f;
            bf16x8 a[8];
            const unsigned cb32 = (unsigned)(size_t)Cb;
            lds_read8_b128(a, cb32 + rb_e, cb32 + rb_o);
            lgkm_wait<7>(a[0]); S = MFMA32(a[0], qlf[0], S);
            lgkm_wait<6>(a[1]); S = MFMA32(a[1], qlf[1], S);
            lgkm_wait<5>(a[2]); S = MFMA32(a[2], qlf[2], S);
            lgkm_wait<4>(a[3]); S = MFMA32(a[3], qlf[3], S);
            lgkm_wait<3>(a[4]); S = MFMA32(a[4], qlf[4], S);
            lgkm_wait<2>(a[5]); S = MFMA32(a[5], qlf[5], S);
            lgkm_wait<1>(a[6]); S = MFMA32(a[6], qlf[6], S);
            lgkm_wait<0>(a[7]); S = MFMA32(a[7], qlf[7], S);
        }
    };
    auto dsa_tile = [&](const int kt, f32x16& S, const LAS unsigned char* Cb, const unsigned mwc) __attribute__((always_inline)) {
        if (kt <= qt) {
            s16x4 f[4][4];
            lds_read16_tr(f, (unsigned)(size_t)Cb + tb0, (unsigned)(size_t)Cb + tb1);
            const unsigned mw = mwc;
            const int dq = qt - kt;
            float cb = bias31;
            if (__builtin_amdgcn_readfirstlane(dq) < 5) {
                asm volatile("" ::: "memory");
                cb = 0.f;
                const int rel0 = 32 * dq + r32 - 4 * hi;
#pragma unroll
                for (int r = 0; r < 16; ++r) { int rel = rel0 - ((r & 3) + 8 * (r >> 2)); rel = rel < 0 ? 0 : rel; S[r] += biasT[rel]; }
                asm volatile("" ::: "memory");
            }
            float mx = fmaxf(S[0], S[1]);
#pragma unroll
            for (int r = 2; r < 16; ++r) mx = fmaxf(mx, S[r]);
            mx = xhalf_max(mx) + cb;
            if (__any(mx > mref + 8.f)) {
                float mm = NINF;
                asm volatile("" : "+v"(mm));
#pragma unroll
                for (int r = 0; r < 16; ++r) mm = fmaxf(mm, ((mw >> r) & 1u) ? S[r] : NINF);
                mm = xhalf_max(mm) + cb;
                const float mn = fmaxf(mref, mm);
                const float alpha = (mn > mref) ? __builtin_amdgcn_exp2f(mref - mn) : 1.f;
                mref = mn; lrun *= alpha;
#pragma unroll
                for (int c = 0; c < 4; ++c)
#pragma unroll
                    for (int r = 0; r < 16; ++r) asm volatile("v_mul_f32 %0, %0, %1" : "+v"(O[c][r]) : "v"(alpha));
            }
            const float off = ((mref == NINF) ? 0.f : mref) - cb;
            float ps0 = 0.f, ps1 = 0.f;
#pragma unroll
            for (int r = 0; r < 16; ++r) {
                const float e = __builtin_amdgcn_exp2f(S[r] - off);
                int m1; asm("v_bfe_i32 %0, %1, %2, 1" : "=v"(m1) : "v"(mw), "n"(r));
                S[r] = __uint_as_float(__float_as_uint(e) & (unsigned)m1);
                if (r & 1) ps1 += S[r]; else ps0 += S[r];
            }
            lrun += ps0 + ps1;
            const bf16x8 p0 = pack8(S, 0), p1 = pack8(S, 1);
            lgkm_wait_all(f);
#pragma unroll
            for (int c = 0; c < 4; ++c) {
                O[c] = MFMA32(cat44(f[c][0], f[c][1]), p0, O[c]);
                O[c] = MFMA32(cat44(f[c][2], f[c][3]), p1, O[c]);
            }
        }
    };
    const int NS = (KT + 1) >> 1;
    v2u gatew[8];
#pragma unroll
    for (int i = 0; i < 8; ++i) { gatew[i].x = 0u; gatew[i].y = 0u; }
    int sl = 0;
    const bool late = (wave & 4) != 0;
    unsigned mwA = maskL[r32], mwB = maskL[32 + r32];
    for (int st = 0; st < NS; ++st) {
        if (st + 1 < NS) asm volatile("s_waitcnt vmcnt(2)\n\ts_barrier" ::: "memory");
        else asm volatile("s_waitcnt vmcnt(0)\n\ts_barrier" ::: "memory");
        if (st + 2 < NS) { int s2 = sl + 4; s2 = s2 >= 6 ? s2 - 6 : s2;
            glds16(csrc + (size_t)(64 * (st + 2)) * 128, ring0 + 8192u * (unsigned)s2); glds16(csrc + (size_t)(64 * (st + 2) + 32) * 128, ring0 + 8192u * (unsigned)(s2 + 1)); }
        if (st == NS - 1) gate_load(gatew, PROJ + ((size_t)b * SEQ + t) * LDP + C_DSG + h * 64, hi);
        unsigned mw0 = mwA >> (16 * hi), mw1 = mwB >> (16 * hi);
        asm volatile("" : "+v"(mw0), "+v"(mw1));
        f32x16 S0, S1;
        dsa_qk(2 * st, S0, L + sl * 8192);
        if (late) dsa_qk(2 * st + 1, S1, L + (sl + 1) * 8192);
        dsa_tile(2 * st, S0, L + sl * 8192, mw0);
        if (!late) dsa_qk(2 * st + 1, S1, L + (sl + 1) * 8192);
        dsa_tile(2 * st + 1, S1, L + (sl + 1) * 8192, mw1);
        if (st + 1 < NS) { mwA = maskL[(2 * st + 2) * 32 + r32]; mwB = maskL[(2 * st + 3) * 32 + r32]; }
        sl = (sl == 4) ? 0 : sl + 2;
    }
    const float lt = xhalf_sum(lrun);
    const float il = 1.f / lt;
    f32x16 Y[2];
#pragma unroll
    for (int r = 0; r < 16; ++r) { Y[0][r] = 0.f; Y[1][r] = 0.f; }
    bf16x8 wv[16];
    {
        int l3 = lane; asm volatile("" : "+v"(l3));
#pragma unroll
        for (int rt = 0; rt < 4; ++rt)
#pragma unroll
            for (int c = 0; c < 2; ++c) {
                const GAS bf16_t* wp = (const GAS bf16_t*)WUVp + ((((c * 4 + rt) * 2 + 0) * 32 + (l3 & 31)) * 2 + (l3 >> 5)) * 8;
                wv[(rt * 2 + c) * 2] = *(const GAS bf16x8*)wp; wv[(rt * 2 + c) * 2 + 1] = *(const GAS bf16x8*)(wp + 32 * 2 * 8);
            }
        asm volatile("" : "+v"(wv[0]), "+v"(wv[1]), "+v"(wv[2]), "+v"(wv[3]), "+v"(wv[4]), "+v"(wv[5]), "+v"(wv[6]), "+v"(wv[7]),
                          "+v"(wv[8]), "+v"(wv[9]), "+v"(wv[10]), "+v"(wv[11]), "+v"(wv[12]), "+v"(wv[13]), "+v"(wv[14]), "+v"(wv[15]));
    }
#pragma unroll
    for (int rt = 0; rt < 4; ++rt) {
#pragma unroll
        for (int r = 0; r < 16; ++r) O[rt][r] *= il;
        const bf16x8 x0 = pack8(O[rt], 0), x1 = pack8(O[rt], 1);
#pragma unroll
        for (int c = 0; c < 2; ++c) {
            Y[c] = MFMA32(wv[(rt * 2 + c) * 2], x0, Y[c]);
            Y[c] = MFMA32(wv[(rt * 2 + c) * 2 + 1], x1, Y[c]);
        }
    }
    {
        int l2 = lane; asm volatile("" : "+v"(l2));
        const int t2 = 32 * qt + (l2 & 31);
        gate_store_pre(Y, 1.f, gatew, MIX + ((size_t)b * SEQ + t2) * DM + 384 + h * 64, l2 >> 5);
    }
    asm volatile("s_waitcnt lgkmcnt(0)\n\ts_barrier" ::: "memory");
}

typedef GAS unsigned gu32;
#define RLX_AGENT __ATOMIC_RELAXED, __HIP_MEMORY_SCOPE_AGENT
constexpr size_t WS_BAR = 512 * 1024;
#define XB_TMO      128
#define XB_XCNT(j)  (256  + 64 * (j))
#define XB_XSUB(j)  (1280 + 64 * (j))
#define XB_XGEN(j)  (2304 + 64 * (j))
#define XB_TOP      3328
#define XB_TOPGEN   3392
#define XCD_BAR_WORDS 3456
#define XB_SPIN_CAP (1u << 18)

__device__ __forceinline__ unsigned xb_ld(unsigned* p)              { return __hip_atomic_load(p, __ATOMIC_RELAXED, __HIP_MEMORY_SCOPE_AGENT); }
__device__ __forceinline__ unsigned xb_add(unsigned* p, unsigned v) { return __hip_atomic_fetch_add(p, v, __ATOMIC_RELAXED, __HIP_MEMORY_SCOPE_AGENT); }
__device__ __forceinline__ unsigned xb_xcc_id() { return (unsigned)__builtin_amdgcn_s_getreg((3 << 11) | 20) & 0xFu; }
#define XB_SPIN(cond, bar) do { unsigned _sp = 0; while (cond) { __builtin_amdgcn_s_sleep(1); \
    if ((++_sp & 255u) == 0u) { if (xb_ld(&(bar)[XB_TMO])) break; if (_sp > XB_SPIN_CAP) { atomicAdd(&(bar)[XB_TMO], 1u); break; } } } } while (0)

struct XcdBarrier {
    unsigned* bar; unsigned x;
    volatile LAS unsigned* st;
};

__device__ __forceinline__ XcdBarrier xcd_barrier_post(unsigned* bar, volatile LAS unsigned* st) {
    XcdBarrier b; b.bar = bar; b.x = xb_xcc_id(); b.st = st;
    if (threadIdx.x == 0) (void)xb_add(&bar[XB_XCNT(b.x)], 1u);
    return b;
}
__device__ __forceinline__ void xcd_barrier_complete(unsigned* bar, unsigned x, unsigned& nloc, unsigned& nx) {
    const unsigned G = gridDim.x * gridDim.y * gridDim.z;
    unsigned sum, cnt, mine, sp = 0u;
    for (;;) {
        sum = 0u; cnt = 0u; mine = 0u;
#pragma unroll
        for (unsigned j = 0; j < 16; ++j) { const unsigned c = xb_ld(&bar[XB_XCNT(j)]); sum += c; cnt += (c > 0u) ? 1u : 0u; mine = (j == x) ? c : mine; }
        if (sum == G) break;
        __builtin_amdgcn_s_sleep(1);
        if ((++sp & 255u) == 0u) { if (xb_ld(&bar[XB_TMO])) break; if (sp > XB_SPIN_CAP) { atomicAdd(&bar[XB_TMO], 1u); break; } }
    }
    nloc = mine > 0u ? mine : 1u; nx = cnt > 0u ? cnt : 1u;
}

__device__ __forceinline__ void xcd_barrier(const XcdBarrier& b, const bool leader  ) {
    asm volatile("s_waitcnt vmcnt(0)" ::: "memory");
    __syncthreads();
    if (leader) {
        unsigned* bar = b.bar;
        __builtin_amdgcn_s_waitcnt(0);
        unsigned nloc = b.st[0], nx = b.st[1];
        if (nloc == 0u) { xcd_barrier_complete(bar, b.x, nloc, nx); b.st[0] = nloc; b.st[1] = nx; }
        const unsigned old = xb_add(&bar[XB_XSUB(b.x)], 1u);
        const unsigned gen = old / nloc;
        if (old + 1u == (gen + 1u) * nloc) {
            __builtin_amdgcn_fence(__ATOMIC_RELEASE, "agent");
            asm volatile("s_waitcnt vmcnt(0)" ::: "memory");
            const unsigned og = xb_add(&bar[XB_TOP], 1u);
            const unsigned tg = og / nx;
            if (og + 1u == (tg + 1u) * nx) xb_add(&bar[XB_TOPGEN], 1u);
            else XB_SPIN(xb_ld(&bar[XB_TOPGEN]) == tg, bar);
            __builtin_amdgcn_fence(__ATOMIC_ACQUIRE, "agent");
            xb_add(&bar[XB_XGEN(b.x)], 1u);
            asm volatile("s_waitcnt vmcnt(0)" ::: "memory");
        } else {
            XB_SPIN(xb_ld(&bar[XB_XGEN(b.x)]) == gen, bar);
            __builtin_amdgcn_fence(__ATOMIC_ACQUIRE, "agent");
            asm volatile("s_waitcnt vmcnt(0)" ::: "memory");
        }
    }
    __syncthreads();
}

#ifndef MK_MULTI
#define MK_MULTI 0
#endif
constexpr int NPHASE = 11;
__global__ void __launch_bounds__(NWAVES * 64, 2) mk_fwd(Args args) {
    extern __shared__ __attribute__((aligned(16))) unsigned char lds_raw[];
    LAS unsigned char* lds = (LAS unsigned char*)lds_raw;
    const int tid0 = threadIdx.x;
    int wave_ = __builtin_amdgcn_readfirstlane(tid0 >> 6); asm volatile("" : "+s"(wave_));
    const int wave = wave_;
    const int G = gridDim.x, bid = blockIdx.x;
    for (int u = tid0; u < 16; u += NWAVES * 64) ((LAS unsigned*)(lds + 131072))[u] = 0u;
    __syncthreads();
    const XcdBarrier xbar = xcd_barrier_post((unsigned*)(args.ws + WS_BAR), (volatile LAS unsigned*)(lds + 131072));
    const int lo = args.ph_lo, hi = args.ph_hi;
#define IN(k) (lo <= (k) && (k) < hi)
#define SEAM(k) do { if (IN(k) && IN((k) + 1)) { if ((k) == 0) cg::this_grid().sync(); else xcd_barrier(xbar, wave_ == 0 && lane_id_v() == 0); } } while (0)
#define PH_BEGIN int lane = lane_id_v(); unsigned char* ws_ = args.ws; asm volatile("" : "+s"(ws_)); GAS unsigned char* ws = (GAS unsigned char*)ws_;     \
    const int gw = bid * NWAVES + wave, NGW = G * NWAVES; (void)gw; (void)NGW;
#define VCU_LOOP for (int vcu = vcu0; vcu < 256; vcu += G)
#define VCU_IDS const int bb = vcu >> 3, w64 = (vcu & 7) * 8 + wave; (void)bb; (void)w64;
#define P_WIN ((bf16_t*)(ws + WS_WIN))
#define P_WOUT ((bf16_t*)(ws + WS_WOUT))
#define P_WMEM ((bf16_t*)(ws + WS_WMEM))
#define P_MEMB ((bf16_t*)(ws + WS_MEMB))
#define P_MEMKV ((bf16_t*)(ws + WS_MEMKV))
#define P_CKVN ((bf16_t*)(ws + WS_CKVN))
#define P_MASK ((unsigned*)(ws + WS_MASK))
#define P_H ((bf16_t*)(ws + WS_H))
#define P_MIX ((bf16_t*)(ws + WS_MIX))
#define P_PROJ ((bf16_t*)(ws + WS_PROJ))
#define P_Y ((bf16_t*)(ws + WS_Y))
    const int vcu0 = (G % 8 == 0) ? (bid & 7) * (G >> 3) + (bid >> 3) : bid;

    if (IN(0)) {
        PH_BEGIN
        const float* x = args.in[0]; const float* mem = args.in[1]; const float* pre_g = args.in[2];
        const float* w_in = args.in[4]; const float* w_mem = args.in[8]; const float* w_out = args.in[9];
        LAS float* scr = (LAS float*)(lds + wave * 16384);
        constexpr int I_IN = 16 * (LDP / 32), I_OUT = 16 * 32, I_MEM = 16 * 16;
        constexpr int NITEMS = 2 * I_IN + 2 * I_OUT + 2 * I_MEM;
        for (int it = gw; it < NITEMS; it += NGW) {
            int r = it;
            if (r < 2 * I_IN) { const int l = r / I_IN; r -= l * I_IN; p0_transpose_item(w_in + (size_t)l * DM * NCOL, DM, NCOL, LDP, P_WIN + (size_t)l * LDP * DM, pre_g + l * DM, scr, r, lane); continue; }
            r -= 2 * I_IN;
            if (r < 2 * I_OUT) { const int l = r / I_OUT; r -= l * I_OUT; p0_transpose_item(w_out + (size_t)l * DM * DM, DM, DM, DM, P_WOUT + (size_t)l * DM * DM, nullptr, scr, r, lane); continue; }
            r -= 2 * I_OUT;
            { const int l = r / I_MEM; r -= l * I_MEM; p0_transpose_item(w_mem + (size_t)l * DM * 512, DM, 512, 512, P_WMEM + (size_t)l * 512 * DM, nullptr, scr, r, lane); }
        }
        {
            const float* w_uk = args.in[5]; const float* w_uv = args.in[6];
            bf16_t* WUKp = (bf16_t*)(ws + WS_WUK); bf16_t* WUVp = (bf16_t*)(ws + WS_WUV);
            for (int e = gw * 64 + lane; e < 2 * 6 * 8192; e += NGW * 64) {
                const int lh = e >> 13, l = lh / 6, h = lh % 6, w = e & 8191;
                { const int rt = w >> 11, rho = (w >> 6) & 31, d = w & 63; const int r = 32 * rt + ((rho & 0x13) | ((rho & 4) << 1) | ((rho & 8) >> 1));
                  WUKp[e] = (bf16_t)f2bf(w_uk[(((size_t)l * 128 + r) * 6 + h) * 64 + d]); }
                { const int j = w & 7, hh = (w >> 3) & 1, d32 = (w >> 4) & 31, s = (w >> 9) & 1, rt = (w >> 10) & 3, c = (w >> 12) & 1;
                  const int r = 32 * rt + 16 * s + 8 * (j >> 2) + 4 * hh + (j & 3), d = 32 * c + d32;
                  WUVp[e] = (bf16_t)f2bf(w_uv[(((size_t)l * 128 + r) * 6 + h) * 64 + d]); }
            }
        }
        for (int m = gw; m < NB * NMEM; m += NGW) row_to_bf16<false>(mem + (size_t)m * DM, P_MEMB + (size_t)m * DM, lane);
        for (int m = gw * 2; m < NTOK; m += NGW * 2) { row_to_bf16<true>(x + (size_t)m * DM, P_H + (size_t)m * DM, lane); row_to_bf16<true>(x + (size_t)(m + 1) * DM, P_H + (size_t)(m + 1) * DM, lane); }
    }
    SEAM(0);
#pragma unroll 1
    for (int l = 0; l < 2; ++l) {
        const int pb = 1 + 5 * l;
        if (IN(pb)) {
            PH_BEGIN
            { pg8::Gemm g{P_H, P_WIN + (size_t)l * LDP * DM, NTOK, LDP, DM}; pg8::StaticOrder S; S.init(NTOK, LDP, G, bid);
              pg8::EpiBf16<0> E{P_PROJ, LDP, nullptr, 0, 0, 1.f};
              pg8::gemm_phase<pg8::EpiBf16<0>, pg8::StaticOrder, true, true>(lds, g, S, E, wave); }
            if (l == 0) {
              pg8::Gemm g{P_MEMB, P_WMEM, NB * NMEM, 1024, DM}; pg8::StaticOrder S; S.init(NB * NMEM, 1024, G, bid);
              pg8::EpiBf16<0> E{P_MEMKV, 1024, nullptr, 0, 0, 1.f};
              pg8::gemm_phase<pg8::EpiBf16<0>, pg8::StaticOrder, true, true>(lds, g, S, E, wave); }
        }
        SEAM(pb);
        if (IN(pb + 1)) {
            { PH_BEGIN
              const float* kv_g = args.in[7];
              for (int m = gw * 8; m < NTOK; m += NGW * 8) { ckvnorm4(P_PROJ, kv_g + l * 128, P_CKVN, m, lane); ckvnorm4(P_PROJ, kv_g + l * 128, P_CKVN, m + 4, lane); } }
            VCU_LOOP { PH_BEGIN VCU_IDS
              for (int i = 0; i < 6; ++i) { const int qt = (i & 1) ? 63 - w64 : w64; sb_item(P_PROJ, P_MIX, bb, i, qt, lane, lds + wave * 16384); } }
            __syncthreads();
            VCU_LOOP { PH_BEGIN VCU_IDS
              const int s8 = vcu & 7;
              for (int j = 0; j < 8; ++j) { const int qt = 8 * j + ((j & 1) ? 7 - s8 : s8); sel_item2(P_PROJ, P_MASK, bb, qt, lane, wave, lds); } }
            __syncthreads();
            VCU_LOOP { PH_BEGIN VCU_IDS
              for (int i = 0; i < 4; ++i) {
                  __syncthreads();
                  mem_stage(P_MEMKV + l * 512, bb, i, wave * 64 + lane, lds);
                  __syncthreads();
                  mem_item_lds(P_PROJ, P_MIX, bb, i, w64, lane, lds);
              } }
        }
        SEAM(pb + 1);
        if (IN(pb + 2)) {
            __syncthreads();
            VCU_LOOP { PH_BEGIN VCU_IDS
              const float* rel_bias = args.in[10];
              const int s8 = vcu & 7, hs = (s8 < 4) ? 0 : 3;
              for (int oi = 0; oi < 2; ++oi) {
                  const int o = oi ? 7 - (s8 & 3) : (s8 & 3);
                  for (int hh = 0; hh < 3; ++hh) {
                      const int h = hs + hh;
                      dsa_round(P_PROJ, P_CKVN, P_MASK, (const bf16_t*)(ws + WS_WUK) + (size_t)(l * 6 + h) * 8192, (const bf16_t*)(ws + WS_WUV) + (size_t)(l * 6 + h) * 8192,
                                rel_bias, P_MIX, bb, o, h, lane, wave, lds);
                  }
              } }
        }
        SEAM(pb + 2);
        if (IN(pb + 3)) {
            PH_BEGIN
            __syncthreads();
            pg8::Gemm g{P_MIX, P_WOUT + (size_t)l * DM * DM, NTOK, DM, DM}; pg8::StaticOrder S; S.init(NTOK, DM, G, bid);
            pg8::EpiBf16<0> E{P_Y, DM, nullptr, 0, 0, 1.f};
            pg8::gemm_phase<pg8::EpiBf16<0>, pg8::StaticOrder, true, true>(lds, g, S, E, wave);
        }
        SEAM(pb + 3);
        if (IN(pb + 4)) {
            PH_BEGIN
            const float* post_g = args.in[3]; bf16_t* X1b = (bf16_t*)(ws + WS_X1);
            if (l == 0) { for (int m = gw * 2; m < NTOK; m += NGW * 2) { post_row<true>(args.in[0], P_Y, post_g, args.out, X1b, P_H, m, lane); post_row<true>(args.in[0], P_Y, post_g, args.out, X1b, P_H, m + 1, lane); } }
            else { for (int m = gw * 2; m < NTOK; m += NGW * 2) { post_row<false>(nullptr, P_Y, post_g + DM, args.out, X1b, (bf16_t*)nullptr, m, lane); post_row<false>(nullptr, P_Y, post_g + DM, args.out, X1b, (bf16_t*)nullptr, m + 1, lane); } }
        }
        SEAM(pb + 4);
    }
#undef IN
#undef SEAM
}

extern "C" void kernel_launch(void* const* d_in, const int* in_sizes, int n_in, void* d_out, int out_size, void* d_ws, size_t ws_size, hipStream_t stream) {
    static int grid = 0;
    if (grid == 0) {
        if (n_in != 11 || ws_size < WS_END) { fprintf(stderr, "kernel_launch: unexpected n_in %d / ws_size %zu\n", n_in, ws_size); grid = -1; return; }
        int dev = 0, cus = 0, per_cu = 0;
        hipGetDevice(&dev);
        hipDeviceGetAttribute(&cus, hipDeviceAttributeMultiprocessorCount, dev);
        hipFuncSetAttribute((const void*)mk_fwd, hipFuncAttributeMaxDynamicSharedMemorySize, LDS_BYTES);
        hipOccupancyMaxActiveBlocksPerMultiprocessor(&per_cu, (const void*)mk_fwd, NWAVES * 64, LDS_BYTES);
        if (per_cu < 1) { fprintf(stderr, "kernel_launch: occupancy query says %d blocks per CU\n", per_cu); per_cu = 1; }
        grid = cus * 1;
        (void)hipGetLastError();
    }
    if (grid < 0) return;
    (void)hipMemsetAsync((char*)d_ws + WS_BAR, 0, 16384, stream);
    Args a{};
    for (int i = 0; i < 11; ++i) a.in[i] = (const float*)d_in[i];
    a.out = (float*)d_out; a.ws = (unsigned char*)d_ws;
#if MK_MULTI
    for (int p = 0; p < NPHASE; ++p) { a.ph_lo = p; a.ph_hi = p + 1; hipLaunchKernelGGL(mk_fwd, dim3(grid), dim3(NWAVES * 64), LDS_BYTES, stream, a); }
#else
    a.ph_lo = 0; a.ph_hi = NPHASE;
    void* kargs[] = {&a};
    hipError_t e = hipLaunchCooperativeKernel((const void*)mk_fwd, dim3(grid), dim3(NWAVES * 64), kargs, LDS_BYTES, stream);
    if (e != hipSuccess) fprintf(stderr, "cooperative launch failed: %s (grid %d)\n", hipGetErrorString(e), grid);
#endif
}
```

```cpp
#include <hip/hip_runtime.h>
#include <hip/hip_cooperative_groups.h>
#include <stdint.h>
#include <math.h>
#include <cstdio>
namespace cg = cooperative_groups;
__device__ __forceinline__ int lane_id_v() { int l; asm volatile("v_mbcnt_lo_u32_b32 %0, -1, 0\n\tv_mbcnt_hi_u32_b32 %0, -1, %0" : "=v"(l)); return l; }
namespace pg8 {
#define PG8_LAS __attribute__((address_space(3)))
typedef unsigned short bf16_t;
typedef short bf16x8 __attribute__((ext_vector_type(8)));
typedef float f32x4 __attribute__((ext_vector_type(4)));
typedef unsigned u32x4 __attribute__((ext_vector_type(4)));
constexpr int BM = 256, BK = 64, HALF = 128, HTB = HALF * BK * 2  , STAGE_BYTES = 8 * HTB, NXCD = 8, WGM = 8;

__host__ __device__ __forceinline__ int lds_byte(int r, int c) { const int st = (r >> 4) * 2 + (c >> 5), rr = r & 15, cc = c & 31, ob = rr * 64 + cc * 2; return st * 1024 + (ob ^ (((ob >> 9) & 1) << 5)); }
__host__ __device__ __forceinline__ void stage_rc(int b, int& R, int& C) { const int st = b / 1024, sb = b % 1024, swz = sb ^ (((sb >> 9) & 1) << 5); R = (st >> 1) * 16 + swz / 64; C = (st & 1) * 32 + (swz % 64) / 2; }
__host__ __device__ __forceinline__ int perm32(int rho) { const int n = rho >> 4, i = rho & 15; return 8 * (i >> 2) + 4 * n + (i & 3); }

struct Unit { int pm, pn; };
struct Gemm { const bf16_t* A; const bf16_t* Bt; int M, N, K; };

struct StaticOrder {
    int nM, nN, nwg, G, c;
    __host__ __device__ void init(int M, int N, int G_, int c_) { nM = M / BM; nN = N / BM; nwg = nM * nN; G = G_; c = c_; }
    __host__ __device__ bool next(int i, Unit& u) const {
        const long L = (long)i * G + c; if (L >= nwg) return false;
        int wgid = (int)L; { const int q = nwg / NXCD, r = nwg % NXCD, xcd = wgid % NXCD, off = wgid / NXCD; wgid = (xcd < r ? xcd * (q + 1) : r * (q + 1) + (xcd - r) * q) + off; }
        const int nig = WGM * nN, gid = wgid / nig, fm = gid * WGM, gsz = (nM - fm) < WGM ? (nM - fm) : WGM;
        u.pm = fm + ((wgid % nig) % gsz); u.pn = (wgid % nig) / gsz; return true;
    }
    __device__ __forceinline__ void a_ready(const Unit&) const {}
    __device__ __forceinline__ void done(const Unit&) const {}
};

__device__ __forceinline__ unsigned cvt_pk_bf16(float lo, float hi) { unsigned r; asm volatile("v_cvt_pk_bf16_f32 %0, %1, %2" : "=v"(r) : "v"(lo), "v"(hi)); return r; }
typedef float f32x2 __attribute__((ext_vector_type(2)));
__device__ __forceinline__ f32x2 gelu_pk(f32x2 v) {
    const f32x2 av = __builtin_elementwise_abs(v), d = av * 0.2316418882f + 1.0f;
    f32x2 t; t.x = __builtin_amdgcn_rcpf(d.x); t.y = __builtin_amdgcn_rcpf(d.y);
    f32x2 q = t * 0.5307027145f + (-0.7265760135f); q = q * t + 0.7107068705f; q = q * t + (-0.142248368f); q = q * t + 0.127414796f; q = q * t;
    const f32x2 s = (v * v) * (-0.72134752044f);
    f32x2 e; e.x = __builtin_amdgcn_exp2f(s.x); e.y = __builtin_amdgcn_exp2f(s.y);
    const f32x2 m = v * (q * e), r = v - m;
    f32x2 o; o.x = v.x < 0.f ? m.x : r.x; o.y = v.y < 0.f ? m.y : r.y; return o;
}

template <int ACT  > struct EpiBf16 {
    static constexpr bool PERM = true, AFTER_DRAIN = false; static_assert(ACT == 0 || ACT == 1, "EpiBf16: ACT is 0 (none) or 1 (gelu_pk)");
    bf16_t* O; int ldc; const float* bias; int split_cols; size_t split_stride; float scale0;
    __device__ __forceinline__ void operator()(const f32x4 (&acc)[2][2][4][2], const Unit& u, int wr, int wc, int fr, int fq) const {
        const int row0 = u.pm * BM + wr * 64 + fr; int colt = u.pn * BM; bf16_t* base = O;
        float sc = 1.f; if (split_cols) { const int t = colt / split_cols; base += (size_t)t * split_stride; colt -= t * split_cols; if (t == 0) sc = scale0; }
        const int col0 = colt + wc * 32 + 8 * fq, bcol0 = u.pn * BM + wc * 32 + 8 * fq;
        f32x4 bv[2][2];
#pragma unroll
        for (int bj = 0; bj < 2; ++bj)
#pragma unroll
            for (int n = 0; n < 2; ++n) bv[bj][n] = bias ? *(const f32x4*)(bias + bcol0 + bj * HALF + 4 * n) : (f32x4){0.f, 0.f, 0.f, 0.f};
#pragma unroll
        for (int ai = 0; ai < 2; ++ai)
#pragma unroll
            for (int m = 0; m < 4; ++m) { bf16_t* rowp = base + (size_t)(row0 + ai * HALF + m * 16) * ldc + col0;
#pragma unroll
                for (int bj = 0; bj < 2; ++bj) { f32x4 v0 = acc[ai][bj][m][0] + bv[bj][0], v1 = acc[ai][bj][m][1] + bv[bj][1];
                    if (ACT == 1) { f32x2 a = gelu_pk((f32x2){v0[0], v0[1]}), b = gelu_pk((f32x2){v0[2], v0[3]}), c = gelu_pk((f32x2){v1[0], v1[1]}), d = gelu_pk((f32x2){v1[2], v1[3]});
                        v0 = (f32x4){a.x, a.y, b.x, b.y}; v1 = (f32x4){c.x, c.y, d.x, d.y}; }
                    v0 = v0 * sc; v1 = v1 * sc; u32x4 w; w.x = cvt_pk_bf16(v0[0], v0[1]); w.y = cvt_pk_bf16(v0[2], v0[3]); w.z = cvt_pk_bf16(v1[0], v1[1]); w.w = cvt_pk_bf16(v1[2], v1[3]);
                    *(u32x4*)(rowp + bj * HALF) = w; } }
    }
};
template <class Epi, class Sched, bool ALIGN_EPI = false, bool SP2 = false>
__device__ __forceinline__ void gemm_phase(PG8_LAS unsigned char* lds, const Gemm g, const Sched& S, const Epi& E, int wave_id) {
    int tid_ = wave_id * 64 + lane_id_v();
    const int tid = tid_, wid = __builtin_amdgcn_readfirstlane(tid >> 6), lane = tid & 63, wr = wid >> 2, wc = wid & 3, fr = lane & 15, fq = lane >> 4;
    const int K = g.K, nt = K / BK;
    unsigned voffA[2], voffB[2];
#pragma unroll
    for (int i = 0; i < 2; ++i) { int R, C; stage_rc(tid * 16 + i * 8192, R, C); const int Rb = Epi::PERM ? ((R & ~31) + perm32(R & 31)) : R;
        voffA[i] = (unsigned)(R * K + C) * 2u; voffB[i] = (unsigned)(Rb * K + C) * 2u; }
    const size_t kstep = (size_t)(BK * 2);
    const size_t hstep = (size_t)HALF * K * 2;
    const size_t tstep = 2 * hstep;
    const unsigned ldsw = (unsigned)wid * 1024u;
    const int aoff = lds_byte(wr * 64 + fr, fq * 8), boff = lds_byte(wc * 32 + fr, fq * 8);
#define PG8_SA(b, h) (((b) * 2 + (h)) * HTB)
#define PG8_SB(b, h) ((4 + (b) * 2 + (h)) * HTB)
#define PG8_STAGE(bufoff, gbase, voff) do { _Pragma("unroll") for (int _i = 0; _i < 2; ++_i) \
        __builtin_amdgcn_global_load_lds((const unsigned*)((const char*)(gbase) + (voff)[_i]), (PG8_LAS unsigned*)(lds + (bufoff) + ldsw + _i * 8192), 16, 0, 0); } while (0)
#define PG8_LDA(dst, b, h) do { _Pragma("unroll") for (int m = 0; m < 4; ++m) _Pragma("unroll") for (int k = 0; k < 2; ++k) dst[m][k] = *(const PG8_LAS bf16x8*)(lds + PG8_SA(b, h) + aoff + m * 2048 + k * 1024); } while (0)
#define PG8_LDB(dst, b, h) do { _Pragma("unroll") for (int n = 0; n < 2; ++n) _Pragma("unroll") for (int k = 0; k < 2; ++k) dst[n][k] = *(const PG8_LAS bf16x8*)(lds + PG8_SB(b, h) + boff + n * 2048 + k * 1024); } while (0)
#define PG8_MMA(ai, bj, At, Bt) do { __builtin_amdgcn_s_setprio(1); _Pragma("unroll") for (int m = 0; m < 4; ++m) _Pragma("unroll") for (int n = 0; n < 2; ++n) _Pragma("unroll") for (int k = 0; k < 2; ++k) \
        acc[ai][bj][m][n] = __builtin_amdgcn_mfma_f32_16x16x32_bf16(Bt[n][k], At[m][k], acc[ai][bj][m][n], 0, 0, 0); __builtin_amdgcn_s_setprio(0); } while (0)
#define PG8_WAIT_V(n) asm volatile("s_waitcnt vmcnt(" #n ")" ::: "memory")
#define PG8_WAIT_L(n) asm volatile("s_waitcnt lgkmcnt(" #n ")" ::: "memory")
#define PG8_BAR __builtin_amdgcn_s_barrier()
#define PG8_SCHED __builtin_amdgcn_sched_barrier(0)
    Unit cur, nxt; int ui = 0;
    if (!S.next(0, cur)) return;
    f32x4 acc[2][2][4][2];
#pragma unroll
    for (int a = 0; a < 2; ++a)
#pragma unroll
        for (int b = 0; b < 2; ++b)
#pragma unroll
            for (int m = 0; m < 4; ++m)
#pragma unroll
                for (int n = 0; n < 2; ++n) acc[a][b][m][n] = (f32x4){0.f, 0.f, 0.f, 0.f};
    bf16x8 At[4][2], B0[2][2], B1[2][2];
    const char* cA = (const char*)g.A + (size_t)cur.pm * tstep; const char* cB = (const char*)g.Bt + (size_t)cur.pn * tstep;
    S.a_ready(cur);
    if constexpr (SP2) {
        PG8_STAGE(PG8_SB(0, 0), cB, voffB); PG8_STAGE(PG8_SB(0, 1), cB + hstep, voffB); PG8_STAGE(PG8_SA(0, 0), cA, voffA); PG8_STAGE(PG8_SA(0, 1), cA + hstep, voffA);
        if (wr == 1) PG8_BAR;
        PG8_WAIT_V(2); PG8_BAR;
        PG8_STAGE(PG8_SB(1, 0), cB + kstep, voffB); PG8_STAGE(PG8_SA(1, 0), cA + kstep, voffA); PG8_STAGE(PG8_SB(1, 1), cB + hstep + kstep, voffB);
        PG8_WAIT_V(6); PG8_BAR;
    } else {
        PG8_STAGE(PG8_SB(0, 0), cB, voffB); PG8_STAGE(PG8_SA(0, 0), cA, voffA); PG8_STAGE(PG8_SB(0, 1), cB + hstep, voffB); PG8_STAGE(PG8_SA(0, 1), cA + hstep, voffA);
        if (wr == 1) PG8_BAR;
        PG8_WAIT_V(4); PG8_BAR;
        PG8_STAGE(PG8_SB(1, 0), cB + kstep, voffB); PG8_STAGE(PG8_SA(1, 0), cA + kstep, voffA); PG8_STAGE(PG8_SB(1, 1), cB + hstep + kstep, voffB);
        PG8_WAIT_V(6); PG8_BAR;
    }
    for (;;) {
        const bool has_next = S.next(ui + 1, nxt);
        const char* nA = has_next ? (const char*)g.A + (size_t)nxt.pm * tstep : cA; const char* nB = has_next ? (const char*)g.Bt + (size_t)nxt.pn * tstep : cB;
        for (int t = 0; t < nt; t += 2) {
            const bool last = (t == nt - 2);
            const char* a1 = cA + (size_t)(t + 1) * kstep;
            const char* a2 = last ? nA : cA + (size_t)(t + 2) * kstep; const char* b2 = last ? nB : cB + (size_t)(t + 2) * kstep;
            const char* a3 = a2 + kstep; const char* b3 = b2 + kstep;
            if (last && has_next) S.a_ready(nxt);
            if constexpr (SP2) {
            PG8_LDB(B0, 0, 0); PG8_LDB(B1, 0, 1); PG8_SCHED; PG8_LDA(At, 0, 0); PG8_STAGE(PG8_SA(1, 1), a1 + hstep, voffA);
            PG8_WAIT_V(8); PG8_WAIT_L(0); PG8_BAR; PG8_MMA(0, 0, At, B0); PG8_MMA(0, 1, At, B1); PG8_BAR; PG8_SCHED;
            PG8_LDA(At, 0, 1); PG8_STAGE(PG8_SB(0, 0), b2, voffB); PG8_STAGE(PG8_SB(0, 1), b2 + hstep, voffB); PG8_STAGE(PG8_SA(0, 0), a2, voffA);
            PG8_WAIT_V(8); PG8_WAIT_L(0); PG8_BAR; PG8_MMA(1, 0, At, B0); PG8_MMA(1, 1, At, B1); PG8_BAR; PG8_SCHED;
            PG8_LDB(B0, 1, 0); PG8_LDB(B1, 1, 1); PG8_SCHED; PG8_LDA(At, 1, 0); PG8_STAGE(PG8_SA(0, 1), a2 + hstep, voffA);
            PG8_WAIT_V(8); PG8_WAIT_L(0); PG8_BAR; PG8_MMA(0, 0, At, B0); PG8_MMA(0, 1, At, B1); PG8_BAR; PG8_SCHED;
            PG8_LDA(At, 1, 1); PG8_STAGE(PG8_SB(1, 0), b3, voffB); PG8_STAGE(PG8_SB(1, 1), b3 + hstep, voffB); PG8_STAGE(PG8_SA(1, 0), a3, voffA);
            PG8_WAIT_V(8); PG8_WAIT_L(0); PG8_BAR; PG8_MMA(1, 0, At, B0); PG8_MMA(1, 1, At, B1); PG8_BAR; PG8_SCHED;
            } else {
            PG8_LDB(B0, 0, 0); PG8_SCHED; PG8_LDA(At, 0, 0); PG8_STAGE(PG8_SA(1, 1), a1 + hstep, voffA);
            PG8_WAIT_L(8); PG8_BAR; PG8_WAIT_L(0); PG8_MMA(0, 0, At, B0); PG8_BAR; PG8_SCHED;
            PG8_LDB(B1, 0, 1); PG8_STAGE(PG8_SB(0, 0), b2, voffB);
            PG8_BAR; PG8_WAIT_L(0); PG8_MMA(0, 1, At, B1); PG8_BAR;
            PG8_LDA(At, 0, 1); PG8_STAGE(PG8_SA(0, 0), a2, voffA);
            PG8_BAR; PG8_WAIT_L(0); PG8_MMA(1, 0, At, B0); PG8_BAR; PG8_SCHED;
            PG8_STAGE(PG8_SB(0, 1), b2 + hstep, voffB);
            PG8_WAIT_V(6); PG8_BAR; PG8_MMA(1, 1, At, B1); PG8_BAR;
            PG8_LDB(B0, 1, 0); PG8_SCHED; PG8_LDA(At, 1, 0); PG8_STAGE(PG8_SA(0, 1), a2 + hstep, voffA);
            PG8_WAIT_L(8); PG8_BAR; PG8_WAIT_L(0); PG8_MMA(0, 0, At, B0); PG8_BAR; PG8_SCHED;
            PG8_LDB(B1, 1, 1); PG8_STAGE(PG8_SB(1, 0), b3, voffB);
            PG8_BAR; PG8_WAIT_L(0); PG8_MMA(0, 1, At, B1); PG8_BAR;
            PG8_LDA(At, 1, 1); PG8_STAGE(PG8_SA(1, 0), a3, voffA);
            PG8_BAR; PG8_WAIT_L(0); PG8_MMA(1, 0, At, B0); PG8_BAR; PG8_SCHED;
            PG8_STAGE(PG8_SB(1, 1), b3 + hstep, voffB);
            PG8_WAIT_V(6); PG8_BAR; PG8_MMA(1, 1, At, B1); PG8_BAR;
            }
        }
        if constexpr (ALIGN_EPI) { if (wr == 0) PG8_BAR; }
        if constexpr (!Epi::AFTER_DRAIN) { E(acc, cur, wr, wc, fr, fq); S.done(cur); }
        if (!has_next) break;
#pragma unroll
        for (int a = 0; a < 2; ++a)
#pragma unroll
            for (int b = 0; b < 2; ++b)
#pragma unroll
                for (int m = 0; m < 4; ++m)
#pragma unroll
                    for (int n = 0; n < 2; ++n) acc[a][b][m][n] = (f32x4){0.f, 0.f, 0.f, 0.f};
        cur = nxt; cA = nA; cB = nB; ++ui;
        if constexpr (ALIGN_EPI) { if (wr == 1) PG8_BAR; }
    }
    PG8_WAIT_V(0);
    if constexpr (!ALIGN_EPI) { if (wr == 0) PG8_BAR; }
    PG8_BAR;
    if constexpr (Epi::AFTER_DRAIN) { E.fused(acc, cur, wr, wc, fr, fq, lds, wid, lane); S.done(cur); }
#undef PG8_SA
#undef PG8_SB
#undef PG8_STAGE
#undef PG8_LDA
#undef PG8_LDB
#undef PG8_MMA
#undef PG8_WAIT_V
#undef PG8_WAIT_L
#undef PG8_BAR
#undef PG8_SCHED
}
}
typedef unsigned short bf16_t;
#define LAS __attribute__((address_space(3)))
#define GAS __attribute__((address_space(1)))
typedef unsigned v4u __attribute__((ext_vector_type(4)));
typedef unsigned v2u __attribute__((ext_vector_type(2)));
typedef float f32x4 __attribute__((ext_vector_type(4)));
constexpr int DM = 1024, NB = 32, SEQ = 2048, NTOK = NB * SEQ, NMEM = 256;
constexpr int LDP = 3328;
constexpr int C_SBQ = 0, C_SBK = 384, C_SBV = 768, C_SBG = 1152, C_DSQ = 1536, C_CKV = 1920, C_DSG = 2048,
              C_IDQ = 2432, C_IDK = 2688, C_IDW = 2720, C_MQ = 2728, C_MG = 2984, NCOL = 3240;
constexpr float EPS = 1e-6f;
constexpr size_t MiB = 1u << 20;
constexpr size_t WS_CTL = 0;
constexpr size_t WS_WIN = 1 * MiB;
constexpr size_t WS_WOUT = 14 * MiB;
constexpr size_t WS_WMEM = 18 * MiB;
constexpr size_t WS_MEMB = 20 * MiB;
constexpr size_t WS_MEMKV = 36 * MiB;
constexpr size_t WS_CKVN = 52 * MiB;
constexpr size_t WS_MASK = 68 * MiB;
constexpr size_t WS_H = 84 * MiB;
constexpr size_t WS_MIX = WS_H;
constexpr size_t WS_PROJ = 212 * MiB;
constexpr size_t WS_Y = WS_PROJ;
constexpr size_t WS_X1 = 628 * MiB;
constexpr size_t WS_END = 756 * MiB;
constexpr int LDS_BYTES = 135168;
constexpr int NWAVES = 8;

__device__ __forceinline__ float bf2f(bf16_t v) { return __uint_as_float(((unsigned)v) << 16); }
__device__ __forceinline__ unsigned f2bf(float f) { unsigned u = __float_as_uint(f); u += 0x7fffu + ((u >> 16) & 1u); return u >> 16; }
__device__ __forceinline__ unsigned pk2(float lo, float hi) { return f2bf(lo) | (f2bf(hi) << 16); }
#define WAVE_SYNC() do { asm volatile("s_waitcnt lgkmcnt(0)" ::: "memory"); __builtin_amdgcn_wave_barrier(); } while (0)
template <int CTRL> __device__ __forceinline__ float dpp_f(float v) { return __uint_as_float((unsigned)__builtin_amdgcn_update_dpp(0, (int)__float_as_uint(v), CTRL, 0xF, 0xF, true)); }
__device__ __forceinline__ float row16_sum(float v) {
    v += dpp_f<0xB1>(v);
    v += dpp_f<0x4E>(v);
    v += dpp_f<0x141>(v);
    v += dpp_f<0x140>(v);
    return v;
}
__device__ __forceinline__ float wave_sum(float v) {
    v = row16_sum(v);
    v += __uint_as_float((unsigned)__builtin_amdgcn_ds_swizzle((int)__float_as_uint(v), 0x401F));
    auto rr = __builtin_amdgcn_permlane32_swap(__float_as_uint(v), __float_as_uint(v), false, false);
    return __uint_as_float(rr[0]) + __uint_as_float(rr[1]);
}

__device__ const unsigned char T5TAB[128] = {0, 1, 2, 3, 4, 5, 6, 7, 8, 9, 10, 11, 12, 13, 14, 15, 16, 16, 16, 17, 17, 18, 18, 18, 19, 19, 19, 20, 20, 20, 20, 21, 21, 21, 21, 22, 22, 22, 22, 22, 23, 23, 23, 23, 23, 23, 24, 24, 24, 24, 24, 24, 25, 25, 25, 25, 25, 25, 25, 26, 26, 26, 26, 26, 26, 26, 26, 27, 27, 27, 27, 27, 27, 27, 27, 27, 27, 28, 28, 28, 28, 28, 28, 28, 28, 28, 28, 29, 29, 29, 29, 29, 29, 29, 29, 29, 29, 29, 29, 30, 30, 30, 30, 30, 30, 30, 30, 30, 30, 30, 30, 30, 30, 31, 31, 31, 31, 31, 31, 31, 31, 31, 31, 31, 31, 31, 31, 31};

struct Args { const float* in[11]; float* out; unsigned char* ws; int ph_lo, ph_hi; };

__device__ __forceinline__ void p0_transpose_item(const float* W, int K, int N, int Npad, bf16_t* WT, const float* g, LAS float* scr, int item, int lane) {
    const int nblk = Npad / 32, kb = item / nblk, nb = item % nblk, k0 = 64 * kb, n0 = 32 * nb;
    const int nn = n0 + (lane & 31);
#pragma unroll 8
    for (int i = 0; i < 32; ++i) { const int kk = 2 * i + (lane >> 5); float v = (nn < N) ? W[(size_t)(k0 + kk) * N + nn] : 0.f; if (g) v *= g[k0 + kk]; scr[kk * 33 + (lane & 31)] = v; }
    WAVE_SYNC();
    const int c = lane & 7;
#pragma unroll
    for (int j = 0; j < 4; ++j) { const int n = (lane >> 3) + 8 * j; const LAS float* s = scr + (8 * c) * 33 + n;
        v4u o; o.x = pk2(s[0 * 33], s[1 * 33]); o.y = pk2(s[2 * 33], s[3 * 33]); o.z = pk2(s[4 * 33], s[5 * 33]); o.w = pk2(s[6 * 33], s[7 * 33]);
        *(v4u*)(WT + (size_t)(n0 + n) * K + k0 + 8 * c) = o; }
    WAVE_SYNC();
}
template <bool NORM> __device__ __forceinline__ void row_to_bf16(const float* xrow, bf16_t* orow, int lane) {
    const f32x4* xr = (const f32x4*)xrow + lane;
    f32x4 v[4]; float s = 0.f;
#pragma unroll
    for (int j = 0; j < 4; ++j) { v[j] = xr[64 * j]; s += (v[j].x * v[j].x + v[j].y * v[j].y) + (v[j].z * v[j].z + v[j].w * v[j].w); }
    float r = 1.f;
    if (NORM) r = 1.0f / sqrtf(wave_sum(s) * (1.f / DM) + EPS);
    v2u* o8 = (v2u*)orow + lane;
#pragma unroll
    for (int j = 0; j < 4; ++j) { v2u w; w.x = pk2(v[j].x * r, v[j].y * r); w.y = pk2(v[j].z * r, v[j].w * r); o8[64 * j] = w; }
}

__device__ __forceinline__ void ckvnorm4(const bf16_t* PROJ, const float* kvg, bf16_t* CKVN, int row0, int lane) {
    const int row = row0 + (lane >> 4), c8 = (lane & 15) * 8;
    const v4u v = *(const v4u*)(PROJ + (size_t)row * LDP + C_CKV + c8);
    float f[8] = {__uint_as_float(v.x << 16), __uint_as_float(v.x & 0xffff0000u), __uint_as_float(v.y << 16), __uint_as_float(v.y & 0xffff0000u),
                  __uint_as_float(v.z << 16), __uint_as_float(v.z & 0xffff0000u), __uint_as_float(v.w << 16), __uint_as_float(v.w & 0xffff0000u)};
    float s = 0.f;
#pragma unroll
    for (int j = 0; j < 8; ++j) s += f[j] * f[j];
    s = row16_sum(s);
    const float r = 1.0f / sqrtf(s * (1.0f / 128.f) + EPS);
    const f32x4 g0 = *(const f32x4*)(kvg + c8), g1 = *(const f32x4*)(kvg + c8 + 4);
    v4u o; o.x = pk2(f[0] * r * g0.x, f[1] * r * g0.y); o.y = pk2(f[2] * r * g0.z, f[3] * r * g0.w); o.z = pk2(f[4] * r * g1.x, f[5] * r * g1.y); o.w = pk2(f[6] * r * g1.z, f[7] * r * g1.w);
    *(v4u*)(CKVN + (size_t)row * 128 + c8) = o;
}
__device__ __forceinline__ unsigned ordkey(float f) { unsigned u = __float_as_uint(f); return (u & 0x80000000u) ? ~u : (u | 0x80000000u); }
template <bool L0> __device__ __forceinline__ void post_row(const float* xin, const bf16_t* Y, const float* g, float* xout, bf16_t* X1b, bf16_t* Hn, int row, int lane) {
    const bf16_t* yp = Y + (size_t)row * DM;
    float yv[16]; float s = 0.f;
#pragma unroll
    for (int j = 0; j < 4; ++j) {
        const v2u v = *(const v2u*)(yp + (lane + 64 * j) * 4);
        yv[4 * j + 0] = __uint_as_float(v.x << 16); yv[4 * j + 1] = __uint_as_float(v.x & 0xffff0000u);
        yv[4 * j + 2] = __uint_as_float(v.y << 16); yv[4 * j + 3] = __uint_as_float(v.y & 0xffff0000u);
        s += yv[4 * j] * yv[4 * j] + yv[4 * j + 1] * yv[4 * j + 1] + yv[4 * j + 2] * yv[4 * j + 2] + yv[4 * j + 3] * yv[4 * j + 3];
    }
    const float r = 1.0f / sqrtf(wave_sum(s) * (1.0f / DM) + EPS);
    f32x4 ov[4]; float s2 = 0.f;
#pragma unroll
    for (int j = 0; j < 4; ++j) {
        const int c = (lane + 64 * j) * 4;
        f32x4 xv;
        if (L0) xv = *(const f32x4*)(xin + (size_t)row * DM + c);
        else { const v2u xb = *(const v2u*)(X1b + (size_t)row * DM + c); xv.x = __uint_as_float(xb.x << 16); xv.y = __uint_as_float(xb.x & 0xffff0000u); xv.z = __uint_as_float(xb.y << 16); xv.w = __uint_as_float(xb.y & 0xffff0000u); }
        const f32x4 gv = *(const f32x4*)(g + c);
        ov[j].x = xv.x + yv[4 * j] * r * gv.x; ov[j].y = xv.y + yv[4 * j + 1] * r * gv.y; ov[j].z = xv.z + yv[4 * j + 2] * r * gv.z; ov[j].w = xv.w + yv[4 * j + 3] * r * gv.w;
        if (L0) { v2u w; w.x = pk2(ov[j].x, ov[j].y); w.y = pk2(ov[j].z, ov[j].w); *(v2u*)(X1b + (size_t)row * DM + c) = w; }
        else *(f32x4*)(xout + (size_t)row * DM + c) = ov[j];
        s2 += (ov[j].x * ov[j].x + ov[j].y * ov[j].y) + (ov[j].z * ov[j].z + ov[j].w * ov[j].w);
    }
    if (Hn) {
        const float r2 = 1.0f / sqrtf(wave_sum(s2) * (1.f / DM) + EPS);
        v2u* o8 = (v2u*)(Hn + (size_t)row * DM) + lane;
#pragma unroll
        for (int j = 0; j < 4; ++j) { v2u w; w.x = pk2(ov[j].x * r2, ov[j].y * r2); w.y = pk2(ov[j].z * r2, ov[j].w * r2); o8[64 * j] = w; }
    }
}

typedef short bf16x8 __attribute__((ext_vector_type(8)));
typedef short s16x4 __attribute__((ext_vector_type(4)));
typedef float f32x16 __attribute__((ext_vector_type(16)));
typedef float f32x2_t __attribute__((ext_vector_type(2)));
typedef __bf16 bf16x2_t __attribute__((ext_vector_type(2)));
#define MFMA32(a, b, c) __builtin_amdgcn_mfma_f32_32x32x16_bf16((a), (b), (c), 0, 0, 0)
__device__ __forceinline__ unsigned cvtpk(float lo, float hi) { f32x2_t v = {lo, hi}; bf16x2_t b = __builtin_convertvector(v, bf16x2_t); return __builtin_bit_cast(unsigned, b); }
__device__ __forceinline__ s16x4 vtr(const LAS unsigned char* p) { return __builtin_bit_cast(s16x4, __builtin_amdgcn_ds_read_tr16_b64_v4i16((LAS s16x4*)p)); }
__device__ __forceinline__ int crow(int r, int hi) { return (r & 3) + 8 * (r >> 2) + 4 * hi; }
__device__ __forceinline__ bf16x8 pack8(const f32x16& x, int s) {
    v4u p; p.x = cvtpk(x[8 * s + 0], x[8 * s + 1]); p.y = cvtpk(x[8 * s + 2], x[8 * s + 3]); p.z = cvtpk(x[8 * s + 4], x[8 * s + 5]); p.w = cvtpk(x[8 * s + 6], x[8 * s + 7]);
    return __builtin_bit_cast(bf16x8, p);
}
__device__ __forceinline__ f32x16 zero16() { float z; asm volatile("v_mov_b32 %0, 0" : "=v"(z)); return (f32x16){z, z, z, z, z, z, z, z, z, z, z, z, z, z, z, z}; }
__device__ __forceinline__ bf16x8 cat44(s16x4 lo, s16x4 hi) { return __builtin_shufflevector(lo, hi, 0, 1, 2, 3, 4, 5, 6, 7); }
__device__ __forceinline__ float xhalf_max(float v) { auto rr = __builtin_amdgcn_permlane32_swap(__float_as_uint(v), __float_as_uint(v), false, false); return fmaxf(__uint_as_float(rr[0]), __uint_as_float(rr[1])); }
__device__ __forceinline__ float xhalf_sum(float v) { auto rr = __builtin_amdgcn_permlane32_swap(__float_as_uint(v), __float_as_uint(v), false, false); return __uint_as_float(rr[0]) + __uint_as_float(rr[1]); }
__device__ __forceinline__ unsigned xhalf_other_u(unsigned v, int hi) { auto rr = __builtin_amdgcn_permlane32_swap(v, v, false, false); return hi ? rr[0] : rr[1]; }
__device__ __forceinline__ float xhalf_other(float v, int hi) { return __uint_as_float(xhalf_other_u(__float_as_uint(v), hi)); }
constexpr int VT_PITCH = 192;
constexpr float LOG2E = 1.4426950408889634f;

__device__ __forceinline__ void pv_tile(f32x16 (&O)[2], const LAS unsigned char* vrd, bf16x8 p0, bf16x8 p1) {
#pragma unroll
    for (int c = 0; c < 2; ++c) {
        const bf16x8 a0 = cat44(vtr(vrd + 0 * VT_PITCH + 64 * c), vtr(vrd + 8 * VT_PITCH + 64 * c));
        const bf16x8 a1 = cat44(vtr(vrd + 16 * VT_PITCH + 64 * c), vtr(vrd + 24 * VT_PITCH + 64 * c));
        O[c] = MFMA32(a0, p0, O[c]);
        O[c] = MFMA32(a1, p1, O[c]);
    }
}
__device__ __forceinline__ void gate_store(const f32x16 (&O)[2], float scale, const bf16_t* grow, bf16_t* orow, int hi) {
#pragma unroll
    for (int c = 0; c < 2; ++c)
#pragma unroll
        for (int g = 0; g < 4; ++g) {
            const int d = 32 * c + 8 * g + 4 * hi;
            const v2u gv = *(const v2u*)(grow + d);
            float gt[4] = {__uint_as_float(gv.x << 16), __uint_as_float(gv.x & 0xffff0000u), __uint_as_float(gv.y << 16), __uint_as_float(gv.y & 0xffff0000u)};
            float ov[4];
#pragma unroll
            for (int j = 0; j < 4; ++j) ov[j] = O[c][4 * g + j] * scale * gt[j] * __builtin_amdgcn_rcpf(1.f + __builtin_amdgcn_exp2f(-gt[j] * LOG2E));
            v2u w; w.x = cvtpk(ov[0], ov[1]); w.y = cvtpk(ov[2], ov[3]);
            *(v2u*)(orow + d) = w;
        }
}

__device__ __forceinline__ void gate_load(v2u (&gw)[8], const bf16_t* grow, int hi) {
#pragma unroll
    for (int c = 0; c < 2; ++c)
#pragma unroll
        for (int g = 0; g < 4; ++g) gw[c * 4 + g] = *(const v2u*)(grow + 32 * c + 8 * g + 4 * hi);
}
__device__ __forceinline__ void gate_store_pre(const f32x16 (&O)[2], float scale, const v2u (&gw)[8], bf16_t* orow, int hi) {
#pragma unroll
    for (int c = 0; c < 2; ++c)
#pragma unroll
        for (int g = 0; g < 4; ++g) {
            const int d = 32 * c + 8 * g + 4 * hi;
            const v2u gv = gw[c * 4 + g];
            float gt[4] = {__uint_as_float(gv.x << 16), __uint_as_float(gv.x & 0xffff0000u), __uint_as_float(gv.y << 16), __uint_as_float(gv.y & 0xffff0000u)};
            float ov[4];
#pragma unroll
            for (int j = 0; j < 4; ++j) ov[j] = O[c][4 * g + j] * scale * gt[j] * __builtin_amdgcn_rcpf(1.f + __builtin_amdgcn_exp2f(-gt[j] * LOG2E));
            v2u w; w.x = cvtpk(ov[0], ov[1]); w.y = cvtpk(ov[2], ov[3]);
            *(v2u*)(orow + d) = w;
        }
}

__device__ __forceinline__ void sb_item(const bf16_t* PROJ, bf16_t* MIX, int b, int h, int qt, int lane, LAS unsigned char* wl) {
    asm volatile("" : "+v"(lane));
    const int r32 = lane & 31, hi = lane >> 5;
    const bf16_t* base = PROJ + (size_t)b * SEQ * LDP;
    const int t = 32 * qt + r32;
    bf16x8 qf[4];
#pragma unroll
    for (int ks = 0; ks < 4; ++ks) qf[ks] = *(const bf16x8*)(base + (size_t)t * LDP + C_SBQ + h * 64 + 16 * ks + 8 * hi);
    v2u gw[8]; gate_load(gw, base + (size_t)t * LDP + C_SBG + h * 64, hi);
    const int vrow = lane >> 3, vch = lane & 7;
    LAS unsigned char* vwr = wl + vrow * VT_PITCH + vch * 16;
    const LAS unsigned char* vrd = wl + (4 * hi + ((lane & 15) >> 2)) * VT_PITCH + (16 * ((lane >> 4) & 1) + 4 * (lane & 3)) * 2;
    bf16x8 kc[4], vc[4];
    {
        const bf16_t* kp = base + (size_t)(32 * qt + r32) * LDP + C_SBK + h * 64 + 8 * hi;
#pragma unroll
        for (int ks = 0; ks < 4; ++ks) kc[ks] = *(const bf16x8*)(kp + 16 * ks);
        const bf16_t* vp = base + (size_t)(32 * qt + vrow) * LDP + C_SBV + h * 64 + 8 * vch;
#pragma unroll
        for (int i = 0; i < 4; ++i) vc[i] = *(const bf16x8*)(vp + (size_t)(8 * i) * LDP);
    }
    f32x16 O[2];
#pragma unroll
    for (int r = 0; r < 16; ++r) { O[0][r] = 0.f; O[1][r] = 0.f; }
    float R = 1.f;
    for (int kt = qt; kt >= 0; --kt) {
        bf16x8 kn[4], vn[4];
        {
            const int ktn = kt > 0 ? kt - 1 : 0;
            const bf16_t* kp = base + (size_t)(32 * ktn + r32) * LDP + C_SBK + h * 64 + 8 * hi;
#pragma unroll
            for (int ks = 0; ks < 4; ++ks) kn[ks] = *(const bf16x8*)(kp + 16 * ks);
            const bf16_t* vp = base + (size_t)(32 * ktn + vrow) * LDP + C_SBV + h * 64 + 8 * vch;
#pragma unroll
            for (int i = 0; i < 4; ++i) vn[i] = *(const bf16x8*)(vp + (size_t)(8 * i) * LDP);
        }
        f32x16 acc;
#pragma unroll
        for (int r = 0; r < 16; ++r) acc[r] = 0.f;
#pragma unroll
        for (int ks = 0; ks < 4; ++ks) acc = MFMA32(kc[ks], qf[ks], acc);
#pragma unroll
        for (int i = 0; i < 4; ++i) *(LAS bf16x8*)(vwr + (8 * i) * VT_PITCH) = vc[i];
        float be[16], om[16];
        const bool diag = (kt == qt);
#pragma unroll
        for (int r = 0; r < 16; ++r) {
            const float e = __builtin_amdgcn_exp2f(fminf(acc[r] * (-0.125f * LOG2E), 115.f));
            float bt = __builtin_amdgcn_rcpf(1.f + e), o1 = e * bt;
            if (diag && !(crow(r, hi) < r32)) { bt = 0.f; o1 = 1.f; }
            be[r] = bt; om[r] = o1;
        }
        float Gp[4], Gq[4];
#pragma unroll
        for (int g = 0; g < 4; ++g) { Gp[g] = (om[4 * g] * om[4 * g + 1]) * (om[4 * g + 2] * om[4 * g + 3]); Gq[g] = xhalf_other(Gp[g], hi); }
        const float T1 = Gp[1] * Gq[1], T2 = Gp[2] * Gq[2], T3 = Gp[3] * Gq[3], T0 = Gp[0] * Gq[0];
        float tail[4]; tail[3] = R; tail[2] = R * T3; tail[1] = tail[2] * T2; tail[0] = tail[1] * T1;
        const float Rn = tail[0] * T0;
#pragma unroll
        for (int g = 0; g < 4; ++g) {
            float sfx = tail[g] * (hi == 0 ? Gq[g] : 1.f);
            acc[4 * g + 3] = be[4 * g + 3] * sfx; sfx *= om[4 * g + 3];
            acc[4 * g + 2] = be[4 * g + 2] * sfx; sfx *= om[4 * g + 2];
            acc[4 * g + 1] = be[4 * g + 1] * sfx; sfx *= om[4 * g + 1];
            acc[4 * g + 0] = be[4 * g + 0] * sfx;
        }
        R = Rn;
        const bf16x8 p0 = pack8(acc, 0), p1 = pack8(acc, 1);
        pv_tile(O, vrd, p0, p1);
        if (__all(R < 7.8886e-31f)) break;
#pragma unroll
        for (int i = 0; i < 4; ++i) { kc[i] = kn[i]; vc[i] = vn[i]; }
    }
    gate_store_pre(O, 1.f, gw, MIX + ((size_t)b * SEQ + t) * DM + h * 64, hi);
}

__device__ __forceinline__ void mem_item(const bf16_t* PROJ, const bf16_t* KV, bf16_t* MIX, int b, int h, int qt, int lane, LAS unsigned char* wl) {
    asm volatile("" : "+v"(lane));
    float NINF; asm volatile("v_mov_b32 %0, 0xff800000" : "=v"(NINF));
    const int r32 = lane & 31, hi = lane >> 5;
    const int t = 32 * qt + r32;
    const bf16_t* prow = PROJ + ((size_t)b * SEQ + t) * LDP;
    bf16x8 qf[4];
#pragma unroll
    for (int ks = 0; ks < 4; ++ks) qf[ks] = *(const bf16x8*)(prow + C_MQ + h * 64 + 16 * ks + 8 * hi);
    const int vrow = lane >> 3, vch = lane & 7;
    LAS unsigned char* vwr = wl + vrow * VT_PITCH + vch * 16;
    const LAS unsigned char* vrd = wl + (4 * hi + ((lane & 15) >> 2)) * VT_PITCH + (16 * ((lane >> 4) & 1) + 4 * (lane & 3)) * 2;
    const bf16_t* kvb = KV + (size_t)b * NMEM * 1024 + h * 64;
    f32x16 O[2];
#pragma unroll
    for (int r = 0; r < 16; ++r) { O[0][r] = 0.f; O[1][r] = 0.f; }
    float mrun = NINF, lrun = 0.f;
    v2u gw[8]; gate_load(gw, prow + C_MG + h * 64, hi);
    bf16x8 kc[4], vc[4];
    {
        const bf16_t* kp = kvb + (size_t)r32 * 1024 + 8 * hi;
#pragma unroll
        for (int ks = 0; ks < 4; ++ks) kc[ks] = *(const bf16x8*)(kp + 16 * ks);
        const bf16_t* vp = kvb + (size_t)vrow * 1024 + 256 + 8 * vch;
#pragma unroll
        for (int i = 0; i < 4; ++i) vc[i] = *(const bf16x8*)(vp + (size_t)(8 * i) * 1024);
    }
    for (int kt = 0; kt < NMEM / 32; ++kt) {
        bf16x8 kn[4], vn[4];
        {
            const int ktn = kt < NMEM / 32 - 1 ? kt + 1 : kt;
            const bf16_t* kp = kvb + (size_t)(32 * ktn + r32) * 1024 + 8 * hi;
#pragma unroll
            for (int ks = 0; ks < 4; ++ks) kn[ks] = *(const bf16x8*)(kp + 16 * ks);
            const bf16_t* vp = kvb + (size_t)(32 * ktn + vrow) * 1024 + 256 + 8 * vch;
#pragma unroll
            for (int i = 0; i < 4; ++i) vn[i] = *(const bf16x8*)(vp + (size_t)(8 * i) * 1024);
        }
        f32x16 acc;
#pragma unroll
        for (int r = 0; r < 16; ++r) acc[r] = 0.f;
#pragma unroll
        for (int ks = 0; ks < 4; ++ks) acc = MFMA32(kc[ks], qf[ks], acc);
#pragma unroll
        for (int i = 0; i < 4; ++i) *(LAS bf16x8*)(vwr + (8 * i) * VT_PITCH) = vc[i];
        float mx = acc[0];
#pragma unroll
        for (int r = 1; r < 16; ++r) mx = fmaxf(mx, acc[r]);
        mx *= 0.125f * LOG2E;
        mx = xhalf_max(mx);
        const float mn = fmaxf(mrun, mx), alpha = __builtin_amdgcn_exp2f(mrun - mn);
        float ps = 0.f;
#pragma unroll
        for (int r = 0; r < 16; ++r) { acc[r] = __builtin_amdgcn_exp2f(acc[r] * (0.125f * LOG2E) - mn); ps += acc[r]; }
        lrun = lrun * alpha + ps; mrun = mn;
#pragma unroll
        for (int r = 0; r < 16; ++r) { O[0][r] *= alpha; O[1][r] *= alpha; }
        const bf16x8 p0 = pack8(acc, 0), p1 = pack8(acc, 1);
        pv_tile(O, vrd, p0, p1);
#pragma unroll
        for (int i = 0; i < 4; ++i) { kc[i] = kn[i]; vc[i] = vn[i]; }
    }
    const float lt = xhalf_sum(lrun);
    gate_store_pre(O, 1.f / lt, gw, MIX + ((size_t)b * SEQ + t) * DM + 768 + h * 64, hi);
}

constexpr int MEML_V_OFF = 32768;
__device__ __forceinline__ void mem_stage(const bf16_t* KV, int b, int h, int tid, LAS unsigned char* L) {
    const bf16_t* kvb = KV + (size_t)b * NMEM * 1024 + h * 64;
#pragma unroll
    for (int i = 0; i < 4; ++i) {
        const int idx = tid + 512 * i, key = idx >> 3, ch = idx & 7;
        const v4u kx = *(const v4u*)(kvb + (size_t)key * 1024 + 8 * ch), vx = *(const v4u*)(kvb + (size_t)key * 1024 + 256 + 8 * ch);
        *(LAS v4u*)(L + 128 * key + 16 * (ch ^ ((key >> 1) & 7))) = kx;
        *(LAS v4u*)(L + MEML_V_OFF + (key >> 5) * (32 * VT_PITCH) + (key & 31) * VT_PITCH + 16 * ch) = vx;
    }
}
__device__ __forceinline__ void mem_item_lds(const bf16_t* PROJ, bf16_t* MIX, int b, int h, int qt, int lane, const LAS unsigned char* L) {
    asm volatile("" : "+v"(lane));
    float NINF; asm volatile("v_mov_b32 %0, 0xff800000" : "=v"(NINF));
    const int r32 = lane & 31, hi = lane >> 5;
    const int t = 32 * qt + r32;
    const bf16_t* prow = PROJ + ((size_t)b * SEQ + t) * LDP;
    bf16x8 qf[4];
#pragma unroll
    for (int ks = 0; ks < 4; ++ks) qf[ks] = *(const bf16x8*)(prow + C_MQ + h * 64 + 16 * ks + 8 * hi);
    v2u gw[8]; gate_load(gw, prow + C_MG + h * 64, hi);
    const unsigned kx = ((unsigned)r32 >> 1) & 7u;
    const LAS unsigned char* krd = L + 128 * r32;
    const LAS unsigned char* vrd = L + MEML_V_OFF + (4 * hi + ((lane & 15) >> 2)) * VT_PITCH + (16 * ((lane >> 4) & 1) + 4 * (lane & 3)) * 2;
    f32x16 O[2];
    O[0] = zero16(); O[1] = zero16();
    float mrun = NINF, lrun = 0.f;
#pragma unroll 2
    for (int kt = 0; kt < NMEM / 32; ++kt) {
        bf16x8 kc[4];
#pragma unroll
        for (int ks = 0; ks < 4; ++ks) kc[ks] = *(const LAS bf16x8*)(krd + 4096 * kt + 16 * ((unsigned)(2 * ks + hi) ^ kx));
        f32x16 acc = MFMA32(kc[0], qf[0], zero16());
#pragma unroll
        for (int ks = 1; ks < 4; ++ks) acc = MFMA32(kc[ks], qf[ks], acc);
        float mx = acc[0];
#pragma unroll
        for (int r = 1; r < 16; ++r) mx = fmaxf(mx, acc[r]);
        mx *= 0.125f * LOG2E;
        mx = xhalf_max(mx);
        const float mn = fmaxf(mrun, mx), alpha = __builtin_amdgcn_exp2f(mrun - mn);
        float ps = 0.f;
#pragma unroll
        for (int r = 0; r < 16; ++r) { acc[r] = __builtin_amdgcn_exp2f(acc[r] * (0.125f * LOG2E) - mn); ps += acc[r]; }
        lrun = lrun * alpha + ps; mrun = mn;
#pragma unroll
        for (int r = 0; r < 16; ++r) { O[0][r] *= alpha; O[1][r] *= alpha; }
        const bf16x8 p0 = pack8(acc, 0), p1 = pack8(acc, 1);
        pv_tile(O, vrd + kt * (32 * VT_PITCH), p0, p1);
    }
    const float lt = xhalf_sum(lrun);
    gate_store_pre(O, 1.f / lt, gw, MIX + ((size_t)b * SEQ + t) * DM + 768 + h * 64, hi);
}

constexpr int SEL_IQ_PITCH = 528, SEL_CNT_OFF = 17408;
__device__ __forceinline__ unsigned ordkey(float f);
template <int PRED  >
__device__ __forceinline__ unsigned sel_count_round(const unsigned (&key)[8][16], unsigned c, unsigned tau, int idx0, int r32, int hi, int wave, LAS unsigned* cb) {
    int n = 0;
#pragma unroll
    for (int i = 0; i < 8; ++i) {
#pragma unroll
        for (int r = 0; r < 16; ++r) {
            if (PRED == 0) n += (key[i][r] >= c) ? 1 : 0;
            else if (PRED == 1) n += (key[i][r] > c) ? 1 : 0;
            else n += (key[i][r] == tau && (unsigned)(idx0 + 256 * i + (r & 3) + 8 * (r >> 2)) <= c) ? 1 : 0;
            if ((r & 7) == 7) asm volatile("" : "+v"(n));
        }
    }
    n += (int)xhalf_other_u((unsigned)n, hi);
    if (hi == 0) cb[wave * 32 + r32] = (unsigned)n;
    __syncthreads();
    unsigned tot = 0;
#pragma unroll
    for (int w = 0; w < 8; ++w) tot += cb[w * 32 + r32];
    return tot;
}
constexpr int SEL_CAP = 64, SEL_DONE = 16;
__device__ __forceinline__ float key2f(unsigned k) { return __uint_as_float((k & 0x80000000u) ? (k & 0x7fffffffu) : ~k); }
__device__ __forceinline__ void sel_cnt4(unsigned& n, unsigned k0, unsigned k1, unsigned k2, unsigned k3, unsigned c) {
    unsigned long long s0, s1, s2, s3;
    asm("v_cmp_ge_u32_e64 %1, %5, %9\n\tv_cmp_ge_u32_e64 %2, %6, %9\n\tv_cmp_ge_u32_e64 %3, %7, %9\n\tv_cmp_ge_u32_e64 %4, %8, %9\n\t"
        "v_addc_co_u32_e64 %0, %1, %0, 0, %1\n\tv_addc_co_u32_e64 %0, %2, %0, 0, %2\n\tv_addc_co_u32_e64 %0, %3, %0, 0, %3\n\tv_addc_co_u32_e64 %0, %4, %0, 0, %4"
        : "+v"(n), "=&s"(s0), "=&s"(s1), "=&s"(s2), "=&s"(s3) : "v"(k0), "v"(k1), "v"(k2), "v"(k3), "v"(c));
}
template <int O3, int O2, int O1, int O0> __device__ __forceinline__ void sel_bits4(unsigned& bits, unsigned k3, unsigned k2, unsigned k1, unsigned k0, int cl, unsigned tau) {
    unsigned long long s0, s1, s2, s3; unsigned t0, t1, t2, t3;
    asm("v_cmp_lt_i32_e64 %5, %13, %15\n\tv_cmp_lt_i32_e64 %6, %13, %16\n\tv_cmp_lt_i32_e64 %7, %13, %17\n\tv_cmp_lt_i32_e64 %8, %13, %18\n\t"
        "v_addc_co_u32_e64 %1, %5, %14, 0, %5\n\tv_addc_co_u32_e64 %2, %6, %14, 0, %6\n\tv_addc_co_u32_e64 %3, %7, %14, 0, %7\n\tv_addc_co_u32_e64 %4, %8, %14, 0, %8\n\t"
        "v_cmp_ge_u32_e64 %5, %9, %1\n\tv_cmp_ge_u32_e64 %6, %10, %2\n\tv_cmp_ge_u32_e64 %7, %11, %3\n\tv_cmp_ge_u32_e64 %8, %12, %4\n\t"
        "v_addc_co_u32_e64 %0, %5, %0, %0, %5\n\tv_addc_co_u32_e64 %0, %6, %0, %0, %6\n\tv_addc_co_u32_e64 %0, %7, %0, %0, %7\n\tv_addc_co_u32_e64 %0, %8, %0, %0, %8"
        : "+v"(bits), "=&v"(t3), "=&v"(t2), "=&v"(t1), "=&v"(t0), "=&s"(s0), "=&s"(s1), "=&s"(s2), "=&s"(s3)
        : "v"(k3), "v"(k2), "v"(k1), "v"(k0), "v"(cl), "v"(tau), "n"(O3), "n"(O2), "n"(O1), "n"(O0));
}
__device__ __forceinline__ unsigned sel_count_lane(const unsigned (&key)[8][16], unsigned c) {
    unsigned n = 0;
#pragma unroll
    for (int i = 0; i < 8; ++i) {
#pragma unroll
        for (int r = 0; r < 16; r += 4) sel_cnt4(n, key[i][r], key[i][r + 1], key[i][r + 2], key[i][r + 3], c);
    }
    return n;
}
__device__ __forceinline__ unsigned sel_exchange(unsigned nl, int r32, int hi, int wave, LAS unsigned* cb) {
    const unsigned n2 = nl + xhalf_other_u(nl, hi);
    if (hi == 0) cb[wave * 32 + r32] = n2;
    __syncthreads();
    unsigned tot = 0;
#pragma unroll
    for (int w = 0; w < 8; ++w) tot += cb[w * 32 + r32];
    return tot;
}
__device__ __forceinline__ void sel_item2(const bf16_t* PROJ, unsigned* MASK, int b, int qt, int lane, int wave, LAS unsigned char* L) {
    asm volatile("" : "+v"(lane));
    const int r32 = lane & 31, hi = lane >> 5, tid = wave * 64 + lane;
    LAS unsigned* cntb = (LAS unsigned*)(L + SEL_CNT_OFF);
    const bf16_t* base = PROJ + (size_t)b * SEQ * LDP;
    unsigned* mrow = MASK + (((size_t)b * 64 + qt) * 64) * 32;
    if (qt < 8) {
#pragma unroll
        for (int i = 0; i < 8; ++i) {
            const int kt = wave + 8 * i;
            if (kt <= qt) {
                unsigned bits = 0u;
#pragma unroll
                for (int r = 0; r < 16; ++r) bits |= ((kt < qt) || (crow(r, hi) <= r32)) ? (1u << r) : 0u;
                const unsigned other = xhalf_other_u(bits, hi);
                if (hi == 0) mrow[kt * 32 + r32] = bits | (other << 16);
            }
        }
        return;
    }
    for (int n = tid; n < 1024; n += 512) { const int row = n >> 5, ch = n & 31;
        const v4u v = *(const v4u*)(base + (size_t)(32 * qt + row) * LDP + C_IDQ + ch * 8);
        *(LAS v4u*)(L + row * SEL_IQ_PITCH + ch * 16) = v; }
    float w8[8];
    { const v4u wv = *(const v4u*)(base + (size_t)(32 * qt + r32) * LDP + C_IDW);
      w8[0] = __uint_as_float(wv.x << 16) * 0.0625f; w8[1] = __uint_as_float(wv.x & 0xffff0000u) * 0.0625f; w8[2] = __uint_as_float(wv.y << 16) * 0.0625f; w8[3] = __uint_as_float(wv.y & 0xffff0000u) * 0.0625f;
      w8[4] = __uint_as_float(wv.z << 16) * 0.0625f; w8[5] = __uint_as_float(wv.z & 0xffff0000u) * 0.0625f; w8[6] = __uint_as_float(wv.w << 16) * 0.0625f; w8[7] = __uint_as_float(wv.w & 0xffff0000u) * 0.0625f; }
    __syncthreads();
    unsigned key[8][16];
    const LAS unsigned char* iqp = L + r32 * SEL_IQ_PITCH + 16 * hi;
    unsigned kmn = 0xffffffffu, kmx = 0u;
#pragma unroll
    for (int i = 0; i < 8; ++i) {
        const int kt = wave + 8 * i;
        if (kt <= qt) {
            const bf16_t* kp = base + (size_t)(32 * kt + r32) * LDP + C_IDK + 8 * hi;
            const bf16x8 k0 = *(const bf16x8*)kp, k1 = *(const bf16x8*)(kp + 16);
            float sc[16];
#pragma unroll
            for (int r = 0; r < 16; ++r) sc[r] = 0.f;
            unsigned iqo = 0; asm volatile("" : "+v"(iqo));
            const LAS unsigned char* iqt = iqp + iqo;
#pragma unroll
            for (int hp = 0; hp < 4; ++hp) {
                const int h = 2 * hp;
                bf16x8 q0 = *(const LAS bf16x8*)(iqt + h * 64), q1 = *(const LAS bf16x8*)(iqt + h * 64 + 32);
                bf16x8 q2 = *(const LAS bf16x8*)(iqt + h * 64 + 64), q3 = *(const LAS bf16x8*)(iqt + h * 64 + 96);
                asm volatile("" : "+v"(q0), "+v"(q1), "+v"(q2), "+v"(q3) : "v"(sc[15]));
                f32x16 Da, Db;
#pragma unroll
                for (int r = 0; r < 16; ++r) { Da[r] = 0.f; Db[r] = 0.f; }
                Da = MFMA32(k0, q0, Da);
                Db = MFMA32(k0, q2, Db);
                Da = MFMA32(k1, q1, Da);
                Db = MFMA32(k1, q3, Db);
#pragma unroll
                for (int r = 0; r < 16; ++r) sc[r] = __builtin_fmaf(w8[h], __int_as_float(max(__float_as_int(Da[r]), 0)), sc[r]);
#pragma unroll
                for (int r = 0; r < 16; ++r) sc[r] = __builtin_fmaf(w8[h + 1], __int_as_float(max(__float_as_int(Db[r]), 0)), sc[r]);
                asm volatile("" : "+v"(sc[0]), "+v"(sc[1]), "+v"(sc[2]), "+v"(sc[3]), "+v"(sc[4]), "+v"(sc[5]), "+v"(sc[6]), "+v"(sc[7]),
                                  "+v"(sc[8]), "+v"(sc[9]), "+v"(sc[10]), "+v"(sc[11]), "+v"(sc[12]), "+v"(sc[13]), "+v"(sc[14]), "+v"(sc[15]));
            }
            int thr = (kt < qt) ? 64 : (r32 - 4 * hi);
            asm volatile("" : "+v"(thr));
#pragma unroll
            for (int r = 0; r < 16; ++r) { const bool v = ((r & 3) + 8 * (r >> 2) <= thr); const unsigned k = ordkey(sc[r]); key[i][r] = v ? k : 0u; kmx = max(kmx, v ? k : 0u); kmn = min(kmn, v ? k : 0xffffffffu); }
        } else {
#pragma unroll
            for (int r = 0; r < 16; ++r) key[i][r] = 0u;
        }
    }
    unsigned lo_key, hi_key, clo, chi = 0u, nlo_l, nhi_l = 0u;
    {
        int nv = 0;
#pragma unroll
        for (int i = 0; i < 8; ++i) { const int kt = wave + 8 * i; nv += (kt < qt) ? 16 : 0; }
        if ((qt & 7) == wave) { const int thr = r32 - 4 * hi;
#pragma unroll
            for (int r = 0; r < 16; ++r) nv += ((r & 3) + 8 * (r >> 2) <= thr) ? 1 : 0; }
        nlo_l = (unsigned)nv;
        kmn = min(kmn, xhalf_other_u(kmn, hi)); kmx = max(kmx, xhalf_other_u(kmx, hi));
        if (hi == 0) { cntb[wave * 32 + r32] = kmn; cntb[256 + wave * 32 + r32] = kmx; }
        __syncthreads();
        unsigned a = 0xffffffffu, bmx = 0u;
#pragma unroll
        for (int w = 0; w < 8; ++w) { a = min(a, cntb[w * 32 + r32]); bmx = max(bmx, cntb[256 + w * 32 + r32]); }
        lo_key = a; hi_key = bmx + 1u; clo = (unsigned)(32 * qt + r32 + 1);
        __syncthreads();
    }
    int round = 0;
    for (;;) {
        const bool done = (clo - chi <= (unsigned)SEL_DONE) || (hi_key - lo_key <= 1u);
        if (__all(done)) break;
        unsigned p;
        if ((round & 3) == 3) p = lo_key + ((hi_key - lo_key) >> 1);
        else p = ordkey(0.5f * key2f(lo_key) + 0.5f * key2f(hi_key));
        p = min(max(p, lo_key + 1u), hi_key - 1u);
        if (done) p = lo_key;
        const unsigned nl = sel_count_lane(key, p);
        const unsigned tot = sel_exchange(nl, r32, hi, wave, cntb + (round & 1) * 256);
        if (!done) { if (tot >= 256u) { lo_key = p; clo = tot; nlo_l = nl; } else { hi_key = p; chi = tot; nhi_l = nl; } }
        ++round;
    }
    unsigned tau, cut;
    const bool many = (clo - chi > (unsigned)SEL_CAP);
    {
        LAS unsigned* lanecnt = (LAS unsigned*)L; LAS unsigned* meta = (LAS unsigned*)(L + 2048); LAS unsigned* result = (LAS unsigned*)(L + 2304); LAS unsigned* list = (LAS unsigned*)(L + 20480);
        const int slot = wave * 2 + hi;
        lanecnt[r32 * 16 + slot] = many ? 0u : (nlo_l - nhi_l);
        if (slot == 0) { meta[2 * r32] = many ? 0u : (clo - chi); meta[2 * r32 + 1] = 256u - chi; }
        __syncthreads();
        unsigned bs = 0u;
#pragma unroll
        for (int s2 = 0; s2 < 16; ++s2) { const unsigned v = lanecnt[r32 * 16 + s2]; bs += (s2 < slot) ? v : 0u; }
        if (!many) {
            const int idx0 = 32 * wave + 4 * hi;
            LAS unsigned* lp = list + (r32 * SEL_CAP + bs) * 2;
#pragma unroll
            for (int i = 0; i < 8; ++i)
#pragma unroll
                for (int r = 0; r < 16; ++r) {
                    const unsigned k = key[i][r];
                    if (k >= lo_key && k < hi_key) { lp[0] = k; lp[1] = (unsigned)(idx0 + 256 * i + (r & 3) + 8 * (r >> 2)); lp += 2; }
                }
        }
        __syncthreads();
        for (int j = 0; j < 4; ++j) {
            const int q = 4 * wave + j;
            const unsigned ncand = (unsigned)__builtin_amdgcn_readfirstlane((int)meta[2 * q]), need = (unsigned)__builtin_amdgcn_readfirstlane((int)meta[2 * q + 1]);
            const LAS unsigned* lq = list + q * SEL_CAP * 2;
            const bool mine = (unsigned)lane < ncand;
            const unsigned kc = mine ? lq[2 * lane] : 0u, ic = mine ? lq[2 * lane + 1] : 0u;
            unsigned rank = 0u;
            for (unsigned c2 = 0; c2 < ncand; ++c2) {
                const unsigned k2 = (unsigned)__builtin_amdgcn_readlane((int)kc, (int)c2), i2 = (unsigned)__builtin_amdgcn_readlane((int)ic, (int)c2);
                rank += (k2 > kc || (k2 == kc && i2 < ic)) ? 1u : 0u;
            }
            if (mine && rank == need - 1u) { result[2 * q] = kc; result[2 * q + 1] = ic; }
        }
        __syncthreads();
        tau = result[2 * r32]; cut = result[2 * r32 + 1];
    }
    if (__any(many)) {
        const unsigned need = 256u - chi;
        const int idx0 = 32 * wave + 4 * hi;
        unsigned lo_ = 0u, hi_ = 2047u;
        for (int it = 0; it < 11; ++it) {
            const unsigned mid = (lo_ + hi_) >> 1;
            const unsigned f = sel_count_round<2>(key, mid, lo_key, idx0, r32, hi, wave, cntb + (it & 1) * 256);
            if (f >= need) hi_ = mid; else lo_ = mid + 1;
        }
        if (many) { tau = lo_key; cut = hi_; }
    }
    {
        const int idx0 = 32 * wave + 4 * hi;
#pragma unroll
        for (int i = 0; i < 8; ++i) {
            const int kt = wave + 8 * i;
            if (kt <= qt) {
                unsigned bits = 0u;
                const int cl = (int)cut - idx0 - 256 * i;
                sel_bits4<27, 26, 25, 24>(bits, key[i][15], key[i][14], key[i][13], key[i][12], cl, tau);
                sel_bits4<19, 18, 17, 16>(bits, key[i][11], key[i][10], key[i][9], key[i][8], cl, tau);
                sel_bits4<11, 10, 9, 8>(bits, key[i][7], key[i][6], key[i][5], key[i][4], cl, tau);
                sel_bits4<3, 2, 1, 0>(bits, key[i][3], key[i][2], key[i][1], key[i][0], cl, tau);
                const unsigned other = xhalf_other_u(bits, hi);
                if (hi == 0) mrow[kt * 32 + r32] = bits | (other << 16);
            }
        }
    }
    __syncthreads();
}

constexpr int WS_WUK = 0;
constexpr int WS_WUV = 256 * 1024;
constexpr int DSA_BIAS_OFF = 16384;
__device__ __forceinline__ unsigned dsa_off(unsigned row, unsigned ch) { return 256u * row + 16u * (ch ^ (((row & 3u) << 2) | ((row >> 2) & 3u))); }
constexpr int DSA_NBUF = 6, DSA_MASK_OFF = 49152, DSA_BIAS2_OFF = 114688;
__device__ __forceinline__ void glds16(const void* gsrc, unsigned lds_dst) { unsigned keep;
    asm volatile("s_mov_b32 %0, m0\n\ts_mov_b32 m0, %2\n\ts_nop 0\n\tglobal_load_lds_dwordx4 %1, off\n\ts_mov_b32 m0, %0" : "=&s"(keep) : "v"(gsrc), "s"(lds_dst) : "memory"); }
__device__ __forceinline__ void lds_read8_b128(bf16x8 (&a)[8], unsigned be, unsigned bo) {
    asm volatile("ds_read_b128 %0, %8\n\tds_read_b128 %1, %9\n\tds_read_b128 %2, %8 offset:512\n\tds_read_b128 %3, %9 offset:512\n\t"
                 "ds_read_b128 %4, %8 offset:1024\n\tds_read_b128 %5, %9 offset:1024\n\tds_read_b128 %6, %8 offset:1536\n\tds_read_b128 %7, %9 offset:1536"
                 : "=&v"(a[0]), "=&v"(a[1]), "=&v"(a[2]), "=&v"(a[3]), "=&v"(a[4]), "=&v"(a[5]), "=&v"(a[6]), "=&v"(a[7]) : "v"(be), "v"(bo));
}
template <int N> __device__ __forceinline__ void lgkm_wait(bf16x8& a) { asm volatile("s_waitcnt lgkmcnt(%1)" : "+v"(a) : "n"(N)); }
__device__ __forceinline__ void lds_read16_tr(s16x4 (&f)[4][4], unsigned b0, unsigned b1) {
    asm volatile("ds_read_b64_tr_b16 %0, %16\n\tds_read_b64_tr_b16 %1, %17 offset:2048\n\tds_read_b64_tr_b16 %2, %16 offset:4096\n\tds_read_b64_tr_b16 %3, %17 offset:6144\n\t"
                 "ds_read_b64_tr_b16 %4, %16 offset:512\n\tds_read_b64_tr_b16 %5, %17 offset:2560\n\tds_read_b64_tr_b16 %6, %16 offset:4608\n\tds_read_b64_tr_b16 %7, %17 offset:6656\n\t"
                 "ds_read_b64_tr_b16 %8, %16 offset:1024\n\tds_read_b64_tr_b16 %9, %17 offset:3072\n\tds_read_b64_tr_b16 %10, %16 offset:5120\n\tds_read_b64_tr_b16 %11, %17 offset:7168\n\t"
                 "ds_read_b64_tr_b16 %12, %16 offset:1536\n\tds_read_b64_tr_b16 %13, %17 offset:3584\n\tds_read_b64_tr_b16 %14, %16 offset:5632\n\tds_read_b64_tr_b16 %15, %17 offset:7680"
                 : "=&v"(f[0][0]), "=&v"(f[0][1]), "=&v"(f[0][2]), "=&v"(f[0][3]), "=&v"(f[1][0]), "=&v"(f[1][1]), "=&v"(f[1][2]), "=&v"(f[1][3]),
                   "=&v"(f[2][0]), "=&v"(f[2][1]), "=&v"(f[2][2]), "=&v"(f[2][3]), "=&v"(f[3][0]), "=&v"(f[3][1]), "=&v"(f[3][2]), "=&v"(f[3][3]) : "v"(b0), "v"(b1));
}
__device__ __forceinline__ void lgkm_wait_all(s16x4 (&f)[4][4]) {
    asm volatile("s_waitcnt lgkmcnt(0)" : "+v"(f[0][0]), "+v"(f[0][1]), "+v"(f[0][2]), "+v"(f[0][3]), "+v"(f[1][0]), "+v"(f[1][1]), "+v"(f[1][2]), "+v"(f[1][3]),
                   "+v"(f[2][0]), "+v"(f[2][1]), "+v"(f[2][2]), "+v"(f[2][3]), "+v"(f[3][0]), "+v"(f[3][1]), "+v"(f[3][2]), "+v"(f[3][3]));
}
__device__ __forceinline__ void dsa_round(const bf16_t* PROJ, const bf16_t* CKVN, const unsigned* MASK, const bf16_t* WUKp  , const bf16_t* WUVp  ,
                                          const float* rel_bias, bf16_t* MIX, int b, int o, int h, int lane, int wave, LAS unsigned char* L) {
    asm volatile("" : "+v"(lane));
    float NINF; asm volatile("v_mov_b32 %0, 0xff800000" : "=v"(NINF));
    const int r32 = lane & 31, hi = lane >> 5, tid = wave * 64 + lane;
    const int qt = 8 * o + wave, KT = 8 * o + 7, t = 32 * qt + r32;
    const int srow = 8 * (wave >> 1) + ((lane >> 2) & 7);
    const int sch = 4 * (2 * (wave & 1) + (lane >> 5)) + ((lane & 3) ^ ((2 * (wave >> 1) + ((lane >> 4) & 1)) & 3));
    const bf16_t* csrc = CKVN + ((size_t)b * SEQ + srow) * 128 + 8 * sch;
    const unsigned ring0 = (unsigned)__builtin_amdgcn_readfirstlane((int)(unsigned)(size_t)L) + 1024u * (unsigned)wave;
    LAS unsigned* maskL = (LAS unsigned*)(L + DSA_MASK_OFF + wave * 8192);
    {
        const unsigned char* msrc = (const unsigned char*)(MASK + (((size_t)b * 64 + qt) * 64) * 32) + 16 * lane;
        const unsigned mdst = (unsigned)__builtin_amdgcn_readfirstlane((int)(unsigned)(size_t)maskL);
        for (int p = 0; 8 * p <= qt; ++p) glds16(msrc + 1024 * p, mdst + 1024u * (unsigned)p);
    }
    glds16(csrc, ring0); glds16(csrc + (size_t)32 * 128, ring0 + 8192u); glds16(csrc + (size_t)64 * 128, ring0 + 16384u); glds16(csrc + (size_t)96 * 128, ring0 + 24576u);
    LAS float* biasT = (LAS float*)(L + DSA_BIAS2_OFF);
    if (tid < 192) { const int bk = tid < 128 ? (int)T5TAB[tid] : 31; biasT[tid] = rel_bias[bk * 6 + h] * LOG2E; }
    const float bias31 = rel_bias[31 * 6 + h] * LOG2E;
    bf16x8 qlf[8];
    {
        const bf16_t* qrow = PROJ + ((size_t)b * SEQ + t) * LDP + C_DSQ + h * 64 + 8 * hi;
        bf16x8 qf[4];
#pragma unroll
        for (int ks = 0; ks < 4; ++ks) qf[ks] = *(const bf16x8*)(qrow + 16 * ks);
        bf16x8 wk[16];
#pragma unroll
        for (int rt = 0; rt < 4; ++rt) {
            const GAS bf16_t* wp = (const GAS bf16_t*)WUKp + (rt * 32 + r32) * 64 + 8 * hi;
#pragma unroll
            for (int ks = 0; ks < 4; ++ks) wk[rt * 4 + ks] = *(const GAS bf16x8*)(wp + 16 * ks);
        }
        asm volatile("" : "+v"(wk[0]), "+v"(wk[1]), "+v"(wk[2]), "+v"(wk[3]), "+v"(wk[4]), "+v"(wk[5]), "+v"(wk[6]), "+v"(wk[7]),
                          "+v"(wk[8]), "+v"(wk[9]), "+v"(wk[10]), "+v"(wk[11]), "+v"(wk[12]), "+v"(wk[13]), "+v"(wk[14]), "+v"(wk[15]));
#pragma unroll
        for (int rt = 0; rt < 4; ++rt) {
            f32x16 X;
#pragma unroll
            for (int r = 0; r < 16; ++r) X[r] = 0.f;
#pragma unroll
            for (int ks = 0; ks < 4; ++ks) X = MFMA32(wk[rt * 4 + ks], qf[ks], X);
#pragma unroll
            for (int r = 0; r < 16; ++r) X[r] *= 0.125f * LOG2E;
            qlf[2 * rt] = pack8(X, 0); qlf[2 * rt + 1] = pack8(X, 1);
        }
    }
    f32x16 O[4];
#pragma unroll
    for (int c = 0; c < 4; ++c)
#pragma unroll
        for (int r = 0; r < 16; ++r) O[c][r] = 0.f;
    float mref = NINF, lrun = 0.f;
    const unsigned x2 = ((unsigned)r32 >> 2) & 3u;
    const unsigned rb_e = 2048u * ((unsigned)r32 >> 3) + 64u * ((unsigned)r32 & 7u) + 16u * ((unsigned)hi ^ x2);
    const unsigned rb_o = 2048u * ((unsigned)r32 >> 3) + 64u * ((unsigned)r32 & 7u) + 16u * ((2u + (unsigned)hi) ^ x2);
    const unsigned tq = (lane & 15) >> 2, tp = lane & 3, tblk = (lane >> 4) & 1;
    const unsigned tb0 = 64u * (4u * hi + tq) + 16u * ((2u * tblk + (tp >> 1)) ^ ((unsigned)hi & 3u)) + 8u * (tp & 1);
    const unsigned tb1 = 64u * (4u * hi + tq) + 16u * ((2u * tblk + (tp >> 1)) ^ ((2u + (unsigned)hi) & 3u)) + 8u * (tp & 1);
    __syncthreads();
    asm volatile("s_waitcnt vmcnt(0) lgkmcnt(0)" ::: "memory");
    auto dsa_qk = [&](const int kt, f32x16& S, const LAS unsigned char* Cb) __attribute__((always_inline)) {
        if (kt <= qt) {
#pragma unroll
            for (int r = 0; r < 16; ++r) S[r] = 0.f;
            bf16x8 a[8];
            const unsigned cb32 = (unsigned)(size_t)Cb;
            lds_read8_b128(a, cb32 + rb_e, cb32 + rb_o);
            lgkm_wait<7>(a[0]); S = MFMA32(a[0], qlf[0], S);
            lgkm_wait<6>(a[1]); S = MFMA32(a[1], qlf[1], S);
            lgkm_wait<5>(a[2]); S = MFMA32(a[2], qlf[2], S);
            lgkm_wait<4>(a[3]); S = MFMA32(a[3], qlf[3], S);
            lgkm_wait<3>(a[4]); S = MFMA32(a[4], qlf[4], S);
            lgkm_wait<2>(a[5]); S = MFMA32(a[5], qlf[5], S);
            lgkm_wait<1>(a[6]); S = MFMA32(a[6], qlf[6], S);
            lgkm_wait<0>(a[7]); S = MFMA32(a[7], qlf[7], S);
        }
    };
    auto dsa_tile = [&](const int kt, f32x16& S, const LAS unsigned char* Cb, const unsigned mwc) __attribute__((always_inline)) {
        if (kt <= qt) {
            s16x4 f[4][4];
            lds_read16_tr(f, (unsigned)(size_t)Cb + tb0, (unsigned)(size_t)Cb + tb1);
            const unsigned mw = mwc;
            const int dq = qt - kt;
            float cb = bias31;
            if (__builtin_amdgcn_readfirstlane(dq) < 5) {
                asm volatile("" ::: "memory");
                cb = 0.f;
                const int rel0 = 32 * dq + r32 - 4 * hi;
#pragma unroll
                for (int r = 0; r < 16; ++r) { int rel = rel0 - ((r & 3) + 8 * (r >> 2)); rel = rel < 0 ? 0 : rel; S[r] += biasT[rel]; }
                asm volatile("" ::: "memory");
            }
            float mx = fmaxf(S[0], S[1]);
#pragma unroll
            for (int r = 2; r < 16; ++r) mx = fmaxf(mx, S[r]);
            mx = xhalf_max(mx) + cb;
            if (__any(mx > mref + 8.f)) {
                float mm = NINF;
                asm volatile("" : "+v"(mm));
#pragma unroll
                for (int r = 0; r < 16; ++r) mm = fmaxf(mm, ((mw >> r) & 1u) ? S[r] : NINF);
                mm = xhalf_max(mm) + cb;
                const float mn = fmaxf(mref, mm);
                const float alpha = (mn > mref) ? __builtin_amdgcn_exp2f(mref - mn) : 1.f;
                mref = mn; lrun *= alpha;
#pragma unroll
                for (int c = 0; c < 4; ++c)
#pragma unroll
                    for (int r = 0; r < 16; ++r) asm volatile("v_mul_f32 %0, %0, %1" : "+v"(O[c][r]) : "v"(alpha));
            }
            const float off = ((mref == NINF) ? 0.f : mref) - cb;
            float ps0 = 0.f, ps1 = 0.f;
#pragma unroll
            for (int r = 0; r < 16; ++r) {
                const float e = __builtin_amdgcn_exp2f(S[r] - off);
                int m1; asm("v_bfe_i32 %0, %1, %2, 1" : "=v"(m1) : "v"(mw), "n"(r));
                S[r] = __uint_as_float(__float_as_uint(e) & (unsigned)m1);
                if (r & 1) ps1 += S[r]; else ps0 += S[r];
            }
            lrun += ps0 + ps1;
            const bf16x8 p0 = pack8(S, 0), p1 = pack8(S, 1);
            lgkm_wait_all(f);
#pragma unroll
            for (int c = 0; c < 4; ++c) {
                O[c] = MFMA32(cat44(f[c][0], f[c][1]), p0, O[c]);
                O[c] = MFMA32(cat44(f[c][2], f[c][3]), p1, O[c]);
            }
        }
    };
    const int NS = (KT + 1) >> 1;
    v2u gatew[8];
#pragma unroll
    for (int i = 0; i < 8; ++i) { gatew[i].x = 0u; gatew[i].y = 0u; }
    int sl = 0;
    const bool late = (wave & 4) != 0;
    unsigned mwA = maskL[r32], mwB = maskL[32 + r32];
    for (int st = 0; st < NS; ++st) {
        if (st + 1 < NS) asm volatile("s_waitcnt vmcnt(2)\n\ts_barrier" ::: "memory");
        else asm volatile("s_waitcnt vmcnt(0)\n\ts_barrier" ::: "memory");
        if (st + 2 < NS) { int s2 = sl + 4; s2 = s2 >= 6 ? s2 - 6 : s2;
            glds16(csrc + (size_t)(64 * (st + 2)) * 128, ring0 + 8192u * (unsigned)s2); glds16(csrc + (size_t)(64 * (st + 2) + 32) * 128, ring0 + 8192u * (unsigned)(s2 + 1)); }
        if (st == NS - 1) gate_load(gatew, PROJ + ((size_t)b * SEQ + t) * LDP + C_DSG + h * 64, hi);
        unsigned mw0 = mwA >> (16 * hi), mw1 = mwB >> (16 * hi);
        asm volatile("" : "+v"(mw0), "+v"(mw1));
        f32x16 S0, S1;
        dsa_qk(2 * st, S0, L + sl * 8192);
        if (late) dsa_qk(2 * st + 1, S1, L + (sl + 1) * 8192);
        dsa_tile(2 * st, S0, L + sl * 8192, mw0);
        if (!late) dsa_qk(2 * st + 1, S1, L + (sl + 1) * 8192);
        dsa_tile(2 * st + 1, S1, L + (sl + 1) * 8192, mw1);
        if (st + 1 < NS) { mwA = maskL[(2 * st + 2) * 32 + r32]; mwB = maskL[(2 * st + 3) * 32 + r32]; }
        sl = (sl == 4) ? 0 : sl + 2;
    }
    const float lt = xhalf_sum(lrun);
    const float il = 1.f / lt;
    f32x16 Y[2];
#pragma unroll
    for (int r = 0; r < 16; ++r) { Y[0][r] = 0.f; Y[1][r] = 0.f; }
    bf16x8 wv[16];
    {
        int l3 = lane; asm volatile("" : "+v"(l3));
#pragma unroll
        for (int rt = 0; rt < 4; ++rt)
#pragma unroll
            for (int c = 0; c < 2; ++c) {
                const GAS bf16_t* wp = (const GAS bf16_t*)WUVp + ((((c * 4 + rt) * 2 + 0) * 32 + (l3 & 31)) * 2 + (l3 >> 5)) * 8;
                wv[(rt * 2 + c) * 2] = *(const GAS bf16x8*)wp; wv[(rt * 2 + c) * 2 + 1] = *(const GAS bf16x8*)(wp + 32 * 2 * 8);
            }
        asm volatile("" : "+v"(wv[0]), "+v"(wv[1]), "+v"(wv[2]), "+v"(wv[3]), "+v"(wv[4]), "+v"(wv[5]), "+v"(wv[6]), "+v"(wv[7]),
                          "+v"(wv[8]), "+v"(wv[9]), "+v"(wv[10]), "+v"(wv[11]), "+v"(wv[12]), "+v"(wv[13]), "+v"(wv[14]), "+v"(wv[15]));
    }
#pragma unroll
    for (int rt = 0; rt < 4; ++rt) {
#pragma unroll
        for (int r = 0; r < 16; ++r) O[rt][r] *= il;
        const bf16x8 x0 = pack8(O[rt], 0), x1 = pack8(O[rt], 1);
#pragma unroll
        for (int c = 0; c < 2; ++c) {
            Y[c] = MFMA32(wv[(rt * 2 + c) * 2], x0, Y[c]);
            Y[c] = MFMA32(wv[(rt * 2 + c) * 2 + 1], x1, Y[c]);
        }
    }
    {
        int l2 = lane; asm volatile("" : "+v"(l2));
        const int t2 = 32 * qt + (l2 & 31);
        gate_store_pre(Y, 1.f, gatew, MIX + ((size_t)b * SEQ + t2) * DM + 384 + h * 64, l2 >> 5);
    }
    asm volatile("s_waitcnt lgkmcnt(0)\n\ts_barrier" ::: "memory");
}

typedef GAS unsigned gu32;
#define RLX_AGENT __ATOMIC_RELAXED, __HIP_MEMORY_SCOPE_AGENT
constexpr size_t WS_BAR = 512 * 1024;
#define XB_TMO      128
#define XB_XCNT(j)  (256  + 64 * (j))
#define XB_XSUB(j)  (1280 + 64 * (j))
#define XB_XGEN(j)  (2304 + 64 * (j))
#define XB_TOP      3328
#define XB_TOPGEN   3392
#define XCD_BAR_WORDS 3456
#define XB_SPIN_CAP (1u << 18)

__device__ __forceinline__ unsigned xb_ld(unsigned* p)              { return __hip_atomic_load(p, __ATOMIC_RELAXED, __HIP_MEMORY_SCOPE_AGENT); }
__device__ __forceinline__ unsigned xb_add(unsigned* p, unsigned v) { return __hip_atomic_fetch_add(p, v, __ATOMIC_RELAXED, __HIP_MEMORY_SCOPE_AGENT); }
__device__ __forceinline__ unsigned xb_xcc_id() { return (unsigned)__builtin_amdgcn_s_getreg((3 << 11) | 20) & 0xFu; }
#define XB_SPIN(cond, bar) do { unsigned _sp = 0; while (cond) { __builtin_amdgcn_s_sleep(1); \
    if ((++_sp & 255u) == 0u) { if (xb_ld(&(bar)[XB_TMO])) break; if (_sp > XB_SPIN_CAP) { atomicAdd(&(bar)[XB_TMO], 1u); break; } } } } while (0)

struct XcdBarrier {
    unsigned* bar; unsigned x;
    volatile LAS unsigned* st;
};

__device__ __forceinline__ XcdBarrier xcd_barrier_post(unsigned* bar, volatile LAS unsigned* st) {
    XcdBarrier b; b.bar = bar; b.x = xb_xcc_id(); b.st = st;
    if (threadIdx.x == 0) (void)xb_add(&bar[XB_XCNT(b.x)], 1u);
    return b;
}
__device__ __forceinline__ void xcd_barrier_complete(unsigned* bar, unsigned x, unsigned& nloc, unsigned& nx) {
    const unsigned G = gridDim.x * gridDim.y * gridDim.z;
    unsigned sum, cnt, mine, sp = 0u;
    for (;;) {
        sum = 0u; cnt = 0u; mine = 0u;
#pragma unroll
        for (unsigned j = 0; j < 16; ++j) { const unsigned c = xb_ld(&bar[XB_XCNT(j)]); sum += c; cnt += (c > 0u) ? 1u : 0u; mine = (j == x) ? c : mine; }
        if (sum == G) break;
        __builtin_amdgcn_s_sleep(1);
        if ((++sp & 255u) == 0u) { if (xb_ld(&bar[XB_TMO])) break; if (sp > XB_SPIN_CAP) { atomicAdd(&bar[XB_TMO], 1u); break; } }
    }
    nloc = mine > 0u ? mine : 1u; nx = cnt > 0u ? cnt : 1u;
}

__device__ __forceinline__ void xcd_barrier(const XcdBarrier& b, const bool leader  ) {
    asm volatile("s_waitcnt vmcnt(0)" ::: "memory");
    __syncthreads();
    if (leader) {
        unsigned* bar = b.bar;
        __builtin_amdgcn_s_waitcnt(0);
        unsigned nloc = b.st[0], nx = b.st[1];
        if (nloc == 0u) { xcd_barrier_complete(bar, b.x, nloc, nx); b.st[0] = nloc; b.st[1] = nx; }
        const unsigned old = xb_add(&bar[XB_XSUB(b.x)], 1u);
        const unsigned gen = old / nloc;
        if (old + 1u == (gen + 1u) * nloc) {
            __builtin_amdgcn_fence(__ATOMIC_RELEASE, "agent");
            asm volatile("s_waitcnt vmcnt(0)" ::: "memory");
            const unsigned og = xb_add(&bar[XB_TOP], 1u);
            const unsigned tg = og / nx;
            if (og + 1u == (tg + 1u) * nx) xb_add(&bar[XB_TOPGEN], 1u);
            else XB_SPIN(xb_ld(&bar[XB_TOPGEN]) == tg, bar);
            __builtin_amdgcn_fence(__ATOMIC_ACQUIRE, "agent");
            xb_add(&bar[XB_XGEN(b.x)], 1u);
            asm volatile("s_waitcnt vmcnt(0)" ::: "memory");
        } else {
            XB_SPIN(xb_ld(&bar[XB_XGEN(b.x)]) == gen, bar);
            __builtin_amdgcn_fence(__ATOMIC_ACQUIRE, "agent");
            asm volatile("s_waitcnt vmcnt(0)" ::: "memory");
        }
    }
    __syncthreads();
}

#ifndef MK_MULTI
#define MK_MULTI 0
#endif
constexpr int NPHASE = 11;
__global__ void __launch_bounds__(NWAVES * 64, 2) mk_fwd(Args args) {
    extern __shared__ __attribute__((aligned(16))) unsigned char lds_raw[];
    LAS unsigned char* lds = (LAS unsigned char*)lds_raw;
    const int tid0 = threadIdx.x;
    int wave_ = __builtin_amdgcn_readfirstlane(tid0 >> 6); asm volatile("" : "+s"(wave_));
    const int wave = wave_;
    const int G = gridDim.x, bid = blockIdx.x;
    for (int u = tid0; u < 16; u += NWAVES * 64) ((LAS unsigned*)(lds + 131072))[u] = 0u;
    __syncthreads();
    const XcdBarrier xbar = xcd_barrier_post((unsigned*)(args.ws + WS_BAR), (volatile LAS unsigned*)(lds + 131072));
    const int lo = args.ph_lo, hi = args.ph_hi;
#define IN(k) (lo <= (k) && (k) < hi)
#define SEAM(k) do { if (IN(k) && IN((k) + 1)) { if ((k) == 0) cg::this_grid().sync(); else xcd_barrier(xbar, wave_ == 0 && lane_id_v() == 0); } } while (0)
#define PH_BEGIN int lane = lane_id_v(); unsigned char* ws_ = args.ws; asm volatile("" : "+s"(ws_)); GAS unsigned char* ws = (GAS unsigned char*)ws_;     \
    const int gw = bid * NWAVES + wave, NGW = G * NWAVES; (void)gw; (void)NGW;
#define VCU_LOOP for (int vcu = vcu0; vcu < 256; vcu += G)
#define VCU_IDS const int bb = vcu >> 3, w64 = (vcu & 7) * 8 + wave; (void)bb; (void)w64;
#define P_WIN ((bf16_t*)(ws + WS_WIN))
#define P_WOUT ((bf16_t*)(ws + WS_WOUT))
#define P_WMEM ((bf16_t*)(ws + WS_WMEM))
#define P_MEMB ((bf16_t*)(ws + WS_MEMB))
#define P_MEMKV ((bf16_t*)(ws + WS_MEMKV))
#define P_CKVN ((bf16_t*)(ws + WS_CKVN))
#define P_MASK ((unsigned*)(ws + WS_MASK))
#define P_H ((bf16_t*)(ws + WS_H))
#define P_MIX ((bf16_t*)(ws + WS_MIX))
#define P_PROJ ((bf16_t*)(ws + WS_PROJ))
#define P_Y ((bf16_t*)(ws + WS_Y))
    const int vcu0 = (G % 8 == 0) ? (bid & 7) * (G >> 3) + (bid >> 3) : bid;

    if (IN(0)) {
        PH_BEGIN
        const float* x = args.in[0]; const float* mem = args.in[1]; const float* pre_g = args.in[2];
        const float* w_in = args.in[4]; const float* w_mem = args.in[8]; const float* w_out = args.in[9];
        LAS float* scr = (LAS float*)(lds + wave * 16384);
        constexpr int I_IN = 16 * (LDP / 32), I_OUT = 16 * 32, I_MEM = 16 * 16;
        constexpr int NITEMS = 2 * I_IN + 2 * I_OUT + 2 * I_MEM;
        for (int it = gw; it < NITEMS; it += NGW) {
            int r = it;
            if (r < 2 * I_IN) { const int l = r / I_IN; r -= l * I_IN; p0_transpose_item(w_in + (size_t)l * DM * NCOL, DM, NCOL, LDP, P_WIN + (size_t)l * LDP * DM, pre_g + l * DM, scr, r, lane); continue; }
            r -= 2 * I_IN;
            if (r < 2 * I_OUT) { const int l = r / I_OUT; r -= l * I_OUT; p0_transpose_item(w_out + (size_t)l * DM * DM, DM, DM, DM, P_WOUT + (size_t)l * DM * DM, nullptr, scr, r, lane); continue; }
            r -= 2 * I_OUT;
            { const int l = r / I_MEM; r -= l * I_MEM; p0_transpose_item(w_mem + (size_t)l * DM * 512, DM, 512, 512, P_WMEM + (size_t)l * 512 * DM, nullptr, scr, r, lane); }
        }
        {
            const float* w_uk = args.in[5]; const float* w_uv = args.in[6];
            bf16_t* WUKp = (bf16_t*)(ws + WS_WUK); bf16_t* WUVp = (bf16_t*)(ws + WS_WUV);
            for (int e = gw * 64 + lane; e < 2 * 6 * 8192; e += NGW * 64) {
                const int lh = e >> 13, l = lh / 6, h = lh % 6, w = e & 8191;
                { const int rt = w >> 11, rho = (w >> 6) & 31, d = w & 63; const int r = 32 * rt + ((rho & 0x13) | ((rho & 4) << 1) | ((rho & 8) >> 1));
                  WUKp[e] = (bf16_t)f2bf(w_uk[(((size_t)l * 128 + r) * 6 + h) * 64 + d]); }
                { const int j = w & 7, hh = (w >> 3) & 1, d32 = (w >> 4) & 31, s = (w >> 9) & 1, rt = (w >> 10) & 3, c = (w >> 12) & 1;
                  const int r = 32 * rt + 16 * s + 8 * (j >> 2) + 4 * hh + (j & 3), d = 32 * c + d32;
                  WUVp[e] = (bf16_t)f2bf(w_uv[(((size_t)l * 128 + r) * 6 + h) * 64 + d]); }
            }
        }
        for (int m = gw; m < NB * NMEM; m += NGW) row_to_bf16<false>(mem + (size_t)m * DM, P_MEMB + (size_t)m * DM, lane);
        for (int m = gw * 2; m < NTOK; m += NGW * 2) { row_to_bf16<true>(x + (size_t)m * DM, P_H + (size_t)m * DM, lane); row_to_bf16<true>(x + (size_t)(m + 1) * DM, P_H + (size_t)(m + 1) * DM, lane); }
    }
    SEAM(0);
#pragma unroll 1
    for (int l = 0; l < 2; ++l) {
        const int pb = 1 + 5 * l;
        if (IN(pb)) {
            PH_BEGIN
            { pg8::Gemm g{P_H, P_WIN + (size_t)l * LDP * DM, NTOK, LDP, DM}; pg8::StaticOrder S; S.init(NTOK, LDP, G, bid);
              pg8::EpiBf16<0> E{P_PROJ, LDP, nullptr, 0, 0, 1.f};
              pg8::gemm_phase<pg8::EpiBf16<0>, pg8::StaticOrder, true, true>(lds, g, S, E, wave); }
            if (l == 0) {
              pg8::Gemm g{P_MEMB, P_WMEM, NB * NMEM, 1024, DM}; pg8::StaticOrder S; S.init(NB * NMEM, 1024, G, bid);
              pg8::EpiBf16<0> E{P_MEMKV, 1024, nullptr, 0, 0, 1.f};
              pg8::gemm_phase<pg8::EpiBf16<0>, pg8::StaticOrder, true, true>(lds, g, S, E, wave); }
        }
        SEAM(pb);
        if (IN(pb + 1)) {
            { PH_BEGIN
              const float* kv_g = args.in[7];
              for (int m = gw * 8; m < NTOK; m += NGW * 8) { ckvnorm4(P_PROJ, kv_g + l * 128, P_CKVN, m, lane); ckvnorm4(P_PROJ, kv_g + l * 128, P_CKVN, m + 4, lane); } }
            VCU_LOOP { PH_BEGIN VCU_IDS
              for (int i = 0; i < 6; ++i) { const int qt = (i & 1) ? 63 - w64 : w64; sb_item(P_PROJ, P_MIX, bb, i, qt, lane, lds + wave * 16384); } }
            __syncthreads();
            VCU_LOOP { PH_BEGIN VCU_IDS
              const int s8 = vcu & 7;
              for (int j = 0; j < 8; ++j) { const int qt = 8 * j + ((j & 1) ? 7 - s8 : s8); sel_item2(P_PROJ, P_MASK, bb, qt, lane, wave, lds); } }
            __syncthreads();
            VCU_LOOP { PH_BEGIN VCU_IDS
              for (int i = 0; i < 4; ++i) {
                  __syncthreads();
                  mem_stage(P_MEMKV + l * 512, bb, i, wave * 64 + lane, lds);
                  __syncthreads();
                  mem_item_lds(P_PROJ, P_MIX, bb, i, w64, lane, lds);
              } }
        }
        SEAM(pb + 1);
        if (IN(pb + 2)) {
            __syncthreads();
            VCU_LOOP { PH_BEGIN VCU_IDS
              const float* rel_bias = args.in[10];
              const int s8 = vcu & 7, hs = (s8 < 4) ? 0 : 3;
              for (int oi = 0; oi < 2; ++oi) {
                  const int o = oi ? 7 - (s8 & 3) : (s8 & 3);
                  for (int hh = 0; hh < 3; ++hh) {
                      const int h = hs + hh;
                      dsa_round(P_PROJ, P_CKVN, P_MASK, (const bf16_t*)(ws + WS_WUK) + (size_t)(l * 6 + h) * 8192, (const bf16_t*)(ws + WS_WUV) + (size_t)(l * 6 + h) * 8192,
                                rel_bias, P_MIX, bb, o, h, lane, wave, lds);
                  }
              } }
        }
        SEAM(pb + 2);
        if (IN(pb + 3)) {
            PH_BEGIN
            __syncthreads();
            pg8::Gemm g{P_MIX, P_WOUT + (size_t)l * DM * DM, NTOK, DM, DM}; pg8::StaticOrder S; S.init(NTOK, DM, G, bid);
            pg8::EpiBf16<0> E{P_Y, DM, nullptr, 0, 0, 1.f};
            pg8::gemm_phase<pg8::EpiBf16<0>, pg8::StaticOrder, true, true>(lds, g, S, E, wave);
        }
        SEAM(pb + 3);
        if (IN(pb + 4)) {
            PH_BEGIN
            const float* post_g = args.in[3]; bf16_t* X1b = (bf16_t*)(ws + WS_X1);
            if (l == 0) { for (int m = gw * 2; m < NTOK; m += NGW * 2) { post_row<true>(args.in[0], P_Y, post_g, args.out, X1b, P_H, m, lane); post_row<true>(args.in[0], P_Y, post_g, args.out, X1b, P_H, m + 1, lane); } }
            else { for (int m = gw * 2; m < NTOK; m += NGW * 2) { post_row<false>(nullptr, P_Y, post_g + DM, args.out, X1b, (bf16_t*)nullptr, m, lane); post_row<false>(nullptr, P_Y, post_g + DM, args.out, X1b, (bf16_t*)nullptr, m + 1, lane); } }
        }
        SEAM(pb + 4);
    }
#undef IN
#undef SEAM
}

extern "C" void kernel_launch(void* const* d_in, const int* in_sizes, int n_in, void* d_out, int out_size, void* d_ws, size_t ws_size, hipStream_t stream) {
    static int grid = 0;
    if (grid == 0) {
        if (n_in != 11 || ws_size < WS_END) { fprintf(stderr, "kernel_launch: unexpected n_in %d / ws_size %zu\n", n_in, ws_size); grid = -1; return; }
        int dev = 0, cus = 0, per_cu = 0;
        hipGetDevice(&dev);
        hipDeviceGetAttribute(&cus, hipDeviceAttributeMultiprocessorCount, dev);
        hipFuncSetAttribute((const void*)mk_fwd, hipFuncAttributeMaxDynamicSharedMemorySize, LDS_BYTES);
        hipOccupancyMaxActiveBlocksPerMultiprocessor(&per_cu, (const void*)mk_fwd, NWAVES * 64, LDS_BYTES);
        if (per_cu < 1) { fprintf(stderr, "kernel_launch: occupancy query says %d blocks per CU\n", per_cu); per_cu = 1; }
        grid = cus * 1;
        (void)hipGetLastError();
    }
    if (grid < 0) return;
    (void)hipMemsetAsync((char*)d_ws + WS_BAR, 0, 16384, stream);
    Args a{};
    for (int i = 0; i < 11; ++i) a.in[i] = (const float*)d_in[i];
    a.out = (float*)d_out; a.ws = (unsigned char*)d_ws;
#if MK_MULTI
    for (int p = 0; p < NPHASE; ++p) { a.ph_lo = p; a.ph_hi = p + 1; hipLaunchKernelGGL(mk_fwd, dim3(grid), dim3(NWAVES * 64), LDS_BYTES, stream, a); }
#else
    a.ph_lo = 0; a.ph_hi = NPHASE;
    void* kargs[] = {&a};
    hipError_t e = hipLaunchCooperativeKernel((const void*)mk_fwd, dim3(grid), dim3(NWAVES * 64), kargs, LDS_BYTES, stream);
    if (e != hipSuccess) fprintf(stderr, "cooperative launch failed: %s (grid %d)\n", hipGetErrorString(e), grid);
#endif
}
```

```cpp
#include <hip/hip_runtime.h>
#include <hip/hip_cooperative_groups.h>
#include <stdint.h>
#include <math.h>
#include <cstdio>
namespace cg = cooperative_groups;
__device__ __forceinline__ int lane_id_v() { int l; asm volatile("v_mbcnt_lo_u32_b32 %0, -1, 0\n\tv_mbcnt_hi_u32_b32 %0, -1, %0" : "=v"(l)); return l; }
namespace pg8 {
#define PG8_LAS __attribute__((address_space(3)))
typedef unsigned short bf16_t;
typedef short bf16x8 __attribute__((ext_vector_type(8)));
typedef float f32x4 __attribute__((ext_vector_type(4)));
typedef unsigned u32x4 __attribute__((ext_vector_type(4)));
constexpr int BM = 256, BK = 64, HALF = 128, HTB = HALF * BK * 2  , STAGE_BYTES = 8 * HTB, NXCD = 8, WGM = 8;

__host__ __device__ __forceinline__ int lds_byte(int r, int c) { const int st = (r >> 4) * 2 + (c >> 5), rr = r & 15, cc = c & 31, ob = rr * 64 + cc * 2; return st * 1024 + (ob ^ (((ob >> 9) & 1) << 5)); }
__host__ __device__ __forceinline__ void stage_rc(int b, int& R, int& C) { const int st = b / 1024, sb = b % 1024, swz = sb ^ (((sb >> 9) & 1) << 5); R = (st >> 1) * 16 + swz / 64; C = (st & 1) * 32 + (swz % 64) / 2; }
__host__ __device__ __forceinline__ int perm32(int rho) { const int n = rho >> 4, i = rho & 15; return 8 * (i >> 2) + 4 * n + (i & 3); }

struct Unit { int pm, pn; };
struct Gemm { const bf16_t* A; const bf16_t* Bt; int M, N, K; };

struct StaticOrder {
    int nM, nN, nwg, G, c;
    __host__ __device__ void init(int M, int N, int G_, int c_) { nM = M / BM; nN = N / BM; nwg = nM * nN; G = G_; c = c_; }
    __host__ __device__ bool next(int i, Unit& u) const {
        const long L = (long)i * G + c; if (L >= nwg) return false;
        int wgid = (int)L; { const int q = nwg / NXCD, r = nwg % NXCD, xcd = wgid % NXCD, off = wgid / NXCD; wgid = (xcd < r ? xcd * (q + 1) : r * (q + 1) + (xcd - r) * q) + off; }
        const int nig = WGM * nN, gid = wgid / nig, fm = gid * WGM, gsz = (nM - fm) < WGM ? (nM - fm) : WGM;
        u.pm = fm + ((wgid % nig) % gsz); u.pn = (wgid % nig) / gsz; return true;
    }
    __device__ __forceinline__ void a_ready(const Unit&) const {}
    __device__ __forceinline__ void done(const Unit&) const {}
};

__device__ __forceinline__ unsigned cvt_pk_bf16(float lo, float hi) { unsigned r; asm volatile("v_cvt_pk_bf16_f32 %0, %1, %2" : "=v"(r) : "v"(lo), "v"(hi)); return r; }
typedef float f32x2 __attribute__((ext_vector_type(2)));
__device__ __forceinline__ f32x2 gelu_pk(f32x2 v) {
    const f32x2 av = __builtin_elementwise_abs(v), d = av * 0.2316418882f + 1.0f;
    f32x2 t; t.x = __builtin_amdgcn_rcpf(d.x); t.y = __builtin_amdgcn_rcpf(d.y);
    f32x2 q = t * 0.5307027145f + (-0.7265760135f); q = q * t + 0.7107068705f; q = q * t + (-0.142248368f); q = q * t + 0.127414796f; q = q * t;
    const f32x2 s = (v * v) * (-0.72134752044f);
    f32x2 e; e.x = __builtin_amdgcn_exp2f(s.x); e.y = __builtin_amdgcn_exp2f(s.y);
    const f32x2 m = v * (q * e), r = v - m;
    f32x2 o; o.x = v.x < 0.f ? m.x : r.x; o.y = v.y < 0.f ? m.y : r.y; return o;
}

template <int ACT  > struct EpiBf16 {
    static constexpr bool PERM = true, AFTER_DRAIN = false; static_assert(ACT == 0 || ACT == 1, "EpiBf16: ACT is 0 (none) or 1 (gelu_pk)");
    bf16_t* O; int ldc; const float* bias; int split_cols; size_t split_stride; float scale0;
    __device__ __forceinline__ void operator()(const f32x4 (&acc)[2][2][4][2], const Unit& u, int wr, int wc, int fr, int fq) const {
        const int row0 = u.pm * BM + wr * 64 + fr; int colt = u.pn * BM; bf16_t* base = O;
        float sc = 1.f; if (split_cols) { const int t = colt / split_cols; base += (size_t)t * split_stride; colt -= t * split_cols; if (t == 0) sc = scale0; }
        const int col0 = colt + wc * 32 + 8 * fq, bcol0 = u.pn * BM + wc * 32 + 8 * fq;
        f32x4 bv[2][2];
#pragma unroll
        for (int bj = 0; bj < 2; ++bj)
#pragma unroll
            for (int n = 0; n < 2; ++n) bv[bj][n] = bias ? *(const f32x4*)(bias + bcol0 + bj * HALF + 4 * n) : (f32x4){0.f, 0.f, 0.f, 0.f};
#pragma unroll
        for (int ai = 0; ai < 2; ++ai)
#pragma unroll
            for (int m = 0; m < 4; ++m) { bf16_t* rowp = base + (size_t)(row0 + ai * HALF + m * 16) * ldc + col0;
#pragma unroll
                for (int bj = 0; bj < 2; ++bj) { f32x4 v0 = acc[ai][bj][m][0] + bv[bj][0], v1 = acc[ai][bj][m][1] + bv[bj][1];
                    if (ACT == 1) { f32x2 a = gelu_pk((f32x2){v0[0], v0[1]}), b = gelu_pk((f32x2){v0[2], v0[3]}), c = gelu_pk((f32x2){v1[0], v1[1]}), d = gelu_pk((f32x2){v1[2], v1[3]});
                        v0 = (f32x4){a.x, a.y, b.x, b.y}; v1 = (f32x4){c.x, c.y, d.x, d.y}; }
                    v0 = v0 * sc; v1 = v1 * sc; u32x4 w; w.x = cvt_pk_bf16(v0[0], v0[1]); w.y = cvt_pk_bf16(v0[2], v0[3]); w.z = cvt_pk_bf16(v1[0], v1[1]); w.w = cvt_pk_bf16(v1[2], v1[3]);
                    *(u32x4*)(rowp + bj * HALF) = w; } }
    }
};
template <class Epi, class Sched, bool ALIGN_EPI = false, bool SP2 = false>
__device__ __forceinline__ void gemm_phase(PG8_LAS unsigned char* lds, const Gemm g, const Sched& S, const Epi& E, int wave_id) {
    int tid_ = wave_id * 64 + lane_id_v();
    const int tid = tid_, wid = __builtin_amdgcn_readfirstlane(tid >> 6), lane = tid & 63, wr = wid >> 2, wc = wid & 3, fr = lane & 15, fq = lane >> 4;
    const int K = g.K, nt = K / BK;
    unsigned voffA[2], voffB[2];
#pragma unroll
    for (int i = 0; i < 2; ++i) { int R, C; stage_rc(tid * 16 + i * 8192, R, C); const int Rb = Epi::PERM ? ((R & ~31) + perm32(R & 31)) : R;
        voffA[i] = (unsigned)(R * K + C) * 2u; voffB[i] = (unsigned)(Rb * K + C) * 2u; }
    const size_t kstep = (size_t)(BK * 2);
    const size_t hstep = (size_t)HALF * K * 2;
    const size_t tstep = 2 * hstep;
    const unsigned ldsw = (unsigned)wid * 1024u;
    const int aoff = lds_byte(wr * 64 + fr, fq * 8), boff = lds_byte(wc * 32 + fr, fq * 8);
#define PG8_SA(b, h) (((b) * 2 + (h)) * HTB)
#define PG8_SB(b, h) ((4 + (b) * 2 + (h)) * HTB)
#define PG8_STAGE(bufoff, gbase, voff) do { _Pragma("unroll") for (int _i = 0; _i < 2; ++_i) \
        __builtin_amdgcn_global_load_lds((const unsigned*)((const char*)(gbase) + (voff)[_i]), (PG8_LAS unsigned*)(lds + (bufoff) + ldsw + _i * 8192), 16, 0, 0); } while (0)
#define PG8_LDA(dst, b, h) do { _Pragma("unroll") for (int m = 0; m < 4; ++m) _Pragma("unroll") for (int k = 0; k < 2; ++k) dst[m][k] = *(const PG8_LAS bf16x8*)(lds + PG8_SA(b, h) + aoff + m * 2048 + k * 1024); } while (0)
#define PG8_LDB(dst, b, h) do { _Pragma("unroll") for (int n = 0; n < 2; ++n) _Pragma("unroll") for (int k = 0; k < 2; ++k) dst[n][k] = *(const PG8_LAS bf16x8*)(lds + PG8_SB(b, h) + boff + n * 2048 + k * 1024); } while (0)
#define PG8_MMA(ai, bj, At, Bt) do { __builtin_amdgcn_s_setprio(1); _Pragma("unroll") for (int m = 0; m < 4; ++m) _Pragma("unroll") for (int n = 0; n < 2; ++n) _Pragma("unroll") for (int k = 0; k < 2; ++k) \
        acc[ai][bj][m][n] = __builtin_amdgcn_mfma_f32_16x16x32_bf16(Bt[n][k], At[m][k], acc[ai][bj][m][n], 0, 0, 0); __builtin_amdgcn_s_setprio(0); } while (0)
#define PG8_WAIT_V(n) asm volatile("s_waitcnt vmcnt(" #n ")" ::: "memory")
#define PG8_WAIT_L(n) asm volatile("s_waitcnt lgkmcnt(" #n ")" ::: "memory")
#define PG8_BAR __builtin_amdgcn_s_barrier()
#define PG8_SCHED __builtin_amdgcn_sched_barrier(0)
    Unit cur, nxt; int ui = 0;
    if (!S.next(0, cur)) return;
    f32x4 acc[2][2][4][2];
#pragma unroll
    for (int a = 0; a < 2; ++a)
#pragma unroll
        for (int b = 0; b < 2; ++b)
#pragma unroll
            for (int m = 0; m < 4; ++m)
#pragma unroll
                for (int n = 0; n < 2; ++n) acc[a][b][m][n] = (f32x4){0.f, 0.f, 0.f, 0.f};
    bf16x8 At[4][2], B0[2][2], B1[2][2];
    const char* cA = (const char*)g.A + (size_t)cur.pm * tstep; const char* cB = (const char*)g.Bt + (size_t)cur.pn * tstep;
    S.a_ready(cur);
    if constexpr (SP2) {
        PG8_STAGE(PG8_SB(0, 0), cB, voffB); PG8_STAGE(PG8_SB(0, 1), cB + hstep, voffB); PG8_STAGE(PG8_SA(0, 0), cA, voffA); PG8_STAGE(PG8_SA(0, 1), cA + hstep, voffA);
        if (wr == 1) PG8_BAR;
        PG8_WAIT_V(2); PG8_BAR;
        PG8_STAGE(PG8_SB(1, 0), cB + kstep, voffB); PG8_STAGE(PG8_SA(1, 0), cA + kstep, voffA); PG8_STAGE(PG8_SB(1, 1), cB + hstep + kstep, voffB);
        PG8_WAIT_V(6); PG8_BAR;
    } else {
        PG8_STAGE(PG8_SB(0, 0), cB, voffB); PG8_STAGE(PG8_SA(0, 0), cA, voffA); PG8_STAGE(PG8_SB(0, 1), cB + hstep, voffB); PG8_STAGE(PG8_SA(0, 1), cA + hstep, voffA);
        if (wr == 1) PG8_BAR;
        PG8_WAIT_V(4); PG8_BAR;
        PG8_STAGE(PG8_SB(1, 0), cB + kstep, voffB); PG8_STAGE(PG8_SA(1, 0), cA + kstep, voffA); PG8_STAGE(PG8_SB(1, 1), cB + hstep + kstep, voffB);
        PG8_WAIT_V(6); PG8_BAR;
    }
    for (;;) {
        const bool has_next = S.next(ui + 1, nxt);
        const char* nA = has_next ? (const char*)g.A + (size_t)nxt.pm * tstep : cA; const char* nB = has_next ? (const char*)g.Bt + (size_t)nxt.pn * tstep : cB;
        for (int t = 0; t < nt; t += 2) {
            const bool last = (t == nt - 2);
            const char* a1 = cA + (size_t)(t + 1) * kstep;
            const char* a2 = last ? nA : cA + (size_t)(t + 2) * kstep; const char* b2 = last ? nB : cB + (size_t)(t + 2) * kstep;
            const char* a3 = a2 + kstep; const char* b3 = b2 + kstep;
            if (last && has_next) S.a_ready(nxt);
            if constexpr (SP2) {
            PG8_LDB(B0, 0, 0); PG8_LDB(B1, 0, 1); PG8_SCHED; PG8_LDA(At, 0, 0); PG8_STAGE(PG8_SA(1, 1), a1 + hstep, voffA);
            PG8_WAIT_V(8); PG8_WAIT_L(0); PG8_BAR; PG8_MMA(0, 0, At, B0); PG8_MMA(0, 1, At, B1); PG8_BAR; PG8_SCHED;
            PG8_LDA(At, 0, 1); PG8_STAGE(PG8_SB(0, 0), b2, voffB); PG8_STAGE(PG8_SB(0, 1), b2 + hstep, voffB); PG8_STAGE(PG8_SA(0, 0), a2, voffA);
            PG8_WAIT_V(8); PG8_WAIT_L(0); PG8_BAR; PG8_MMA(1, 0, At, B0); PG8_MMA(1, 1, At, B1); PG8_BAR; PG8_SCHED;
            PG8_LDB(B0, 1, 0); PG8_LDB(B1, 1, 1); PG8_SCHED; PG8_LDA(At, 1, 0); PG8_STAGE(PG8_SA(0, 1), a2 + hstep, voffA);
            PG8_WAIT_V(8); PG8_WAIT_L(0); PG8_BAR; PG8_MMA(0, 0, At, B0); PG8_MMA(0, 1, At, B1); PG8_BAR; PG8_SCHED;
            PG8_LDA(At, 1, 1); PG8_STAGE(PG8_SB(1, 0), b3, voffB); PG8_STAGE(PG8_SB(1, 1), b3 + hstep, voffB); PG8_STAGE(PG8_SA(1, 0), a3, voffA);
            PG8_WAIT_V(8); PG8_WAIT_L(0); PG8_BAR; PG8_MMA(1, 0, At, B0); PG8_MMA(1, 1, At, B1); PG8_BAR; PG8_SCHED;
            } else {
            PG8_LDB(B0, 0, 0); PG8_SCHED; PG8_LDA(At, 0, 0); PG8_STAGE(PG8_SA(1, 1), a1 + hstep, voffA);
            PG8_WAIT_L(8); PG8_BAR; PG8_WAIT_L(0); PG8_MMA(0, 0, At, B0); PG8_BAR; PG8_SCHED;
            PG8_LDB(B1, 0, 1); PG8_STAGE(PG8_SB(0, 0), b2, voffB);
            PG8_BAR; PG8_WAIT_L(0); PG8_MMA(0, 1, At, B1); PG8_BAR;
            PG8_LDA(At, 0, 1); PG8_STAGE(PG8_SA(0, 0), a2, voffA);
            PG8_BAR; PG8_WAIT_L(0); PG8_MMA(1, 0, At, B0); PG8_BAR; PG8_SCHED;
            PG8_STAGE(PG8_SB(0, 1), b2 + hstep, voffB);
            PG8_WAIT_V(6); PG8_BAR; PG8_MMA(1, 1, At, B1); PG8_BAR;
            PG8_LDB(B0, 1, 0); PG8_SCHED; PG8_LDA(At, 1, 0); PG8_STAGE(PG8_SA(0, 1), a2 + hstep, voffA);
            PG8_WAIT_L(8); PG8_BAR; PG8_WAIT_L(0); PG8_MMA(0, 0, At, B0); PG8_BAR; PG8_SCHED;
            PG8_LDB(B1, 1, 1); PG8_STAGE(PG8_SB(1, 0), b3, voffB);
            PG8_BAR; PG8_WAIT_L(0); PG8_MMA(0, 1, At, B1); PG8_BAR;
            PG8_LDA(At, 1, 1); PG8_STAGE(PG8_SA(1, 0), a3, voffA);
            PG8_BAR; PG8_WAIT_L(0); PG8_MMA(1, 0, At, B0); PG8_BAR; PG8_SCHED;
            PG8_STAGE(PG8_SB(1, 1), b3 + hstep, voffB);
            PG8_WAIT_V(6); PG8_BAR; PG8_MMA(1, 1, At, B1); PG8_BAR;
            }
        }
        if constexpr (ALIGN_EPI) { if (wr == 0) PG8_BAR; }
        if constexpr (!Epi::AFTER_DRAIN) { E(acc, cur, wr, wc, fr, fq); S.done(cur); }
        if (!has_next) break;
#pragma unroll
        for (int a = 0; a < 2; ++a)
#pragma unroll
            for (int b = 0; b < 2; ++b)
#pragma unroll
                for (int m = 0; m < 4; ++m)
#pragma unroll
                    for (int n = 0; n < 2; ++n) acc[a][b][m][n] = (f32x4){0.f, 0.f, 0.f, 0.f};
        cur = nxt; cA = nA; cB = nB; ++ui;
        if constexpr (ALIGN_EPI) { if (wr == 1) PG8_BAR; }
    }
    PG8_WAIT_V(0);
    if constexpr (!ALIGN_EPI) { if (wr == 0) PG8_BAR; }
    PG8_BAR;
    if constexpr (Epi::AFTER_DRAIN) { E.fused(acc, cur, wr, wc, fr, fq, lds, wid, lane); S.done(cur); }
#undef PG8_SA
#undef PG8_SB
#undef PG8_STAGE
#undef PG8_LDA
#undef PG8_LDB
#undef PG8_MMA
#undef PG8_WAIT_V
#undef PG8_WAIT_L
#undef PG8_BAR
#undef PG8_SCHED
}
}
typedef unsigned short bf16_t;
#define LAS __attribute__((address_space(3)))
#define GAS __attribute__((address_space(1)))
typedef unsigned v4u __attribute__((ext_vector_type(4)));
typedef unsigned v2u __attribute__((ext_vector_type(2)));
typedef float f32x4 __attribute__((ext_vector_type(4)));
constexpr int DM = 1024, NB = 32, SEQ = 2048, NTOK = NB * SEQ, NMEM = 256;
constexpr int LDP = 3328;
constexpr int C_SBQ = 0, C_SBK = 384, C_SBV = 768, C_SBG = 1152, C_DSQ = 1536, C_CKV = 1920, C_DSG = 2048,
              C_IDQ = 2432, C_IDK = 2688, C_IDW = 2720, C_MQ = 2728, C_MG = 2984, NCOL = 3240;
constexpr float EPS = 1e-6f;
constexpr size_t MiB = 1u << 20;
constexpr size_t WS_CTL = 0;
constexpr size_t WS_WIN = 1 * MiB;
constexpr size_t WS_WOUT = 14 * MiB;
constexpr size_t WS_WMEM = 18 * MiB;
constexpr size_t WS_MEMB = 20 * MiB;
constexpr size_t WS_MEMKV = 36 * MiB;
constexpr size_t WS_CKVN = 52 * MiB;
constexpr size_t WS_MASK = 68 * MiB;
constexpr size_t WS_H = 84 * MiB;
constexpr size_t WS_MIX = WS_H;
constexpr size_t WS_PROJ = 212 * MiB;
constexpr size_t WS_Y = WS_PROJ;
constexpr size_t WS_X1 = 628 * MiB;
constexpr size_t WS_END = 756 * MiB;
constexpr int LDS_BYTES = 135168;
constexpr int NWAVES = 8;

__device__ __forceinline__ float bf2f(bf16_t v) { return __uint_as_float(((unsigned)v) << 16); }
__device__ __forceinline__ unsigned f2bf(float f) { unsigned u = __float_as_uint(f); u += 0x7fffu + ((u >> 16) & 1u); return u >> 16; }
__device__ __forceinline__ unsigned pk2(float lo, float hi) { return f2bf(lo) | (f2bf(hi) << 16); }
#define WAVE_SYNC() do { asm volatile("s_waitcnt lgkmcnt(0)" ::: "memory"); __builtin_amdgcn_wave_barrier(); } while (0)
template <int CTRL> __device__ __forceinline__ float dpp_f(float v) { return __uint_as_float((unsigned)__builtin_amdgcn_update_dpp(0, (int)__float_as_uint(v), CTRL, 0xF, 0xF, true)); }
__device__ __forceinline__ float row16_sum(float v) {
    v += dpp_f<0xB1>(v);
    v += dpp_f<0x4E>(v);
    v += dpp_f<0x141>(v);
    v += dpp_f<0x140>(v);
    return v;
}
__device__ __forceinline__ float wave_sum(float v) {
    v = row16_sum(v);
    v += __uint_as_float((unsigned)__builtin_amdgcn_ds_swizzle((int)__float_as_uint(v), 0x401F));
    auto rr = __builtin_amdgcn_permlane32_swap(__float_as_uint(v), __float_as_uint(v), false, false);
    return __uint_as_float(rr[0]) + __uint_as_float(rr[1]);
}

__device__ const unsigned char T5TAB[128] = {0, 1, 2, 3, 4, 5, 6, 7, 8, 9, 10, 11, 12, 13, 14, 15, 16, 16, 16, 17, 17, 18, 18, 18, 19, 19, 19, 20, 20, 20, 20, 21, 21, 21, 21, 22, 22, 22, 22, 22, 23, 23, 23, 23, 23, 23, 24, 24, 24, 24, 24, 24, 25, 25, 25, 25, 25, 25, 25, 26, 26, 26, 26, 26, 26, 26, 26, 27, 27, 27, 27, 27, 27, 27, 27, 27, 27, 28, 28, 28, 28, 28, 28, 28, 28, 28, 28, 29, 29, 29, 29, 29, 29, 29, 29, 29, 29, 29, 29, 30, 30, 30, 30, 30, 30, 30, 30, 30, 30, 30, 30, 30, 30, 31, 31, 31, 31, 31, 31, 31, 31, 31, 31, 31, 31, 31, 31, 31};

struct Args { const float* in[11]; float* out; unsigned char* ws; int ph_lo, ph_hi; };

__device__ __forceinline__ void p0_transpose_item(const float* W, int K, int N, int Npad, bf16_t* WT, const float* g, LAS float* scr, int item, int lane) {
    const int nblk = Npad / 32, kb = item / nblk, nb = item % nblk, k0 = 64 * kb, n0 = 32 * nb;
    const int nn = n0 + (lane & 31);
#pragma unroll 8
    for (int i = 0; i < 32; ++i) { const int kk = 2 * i + (lane >> 5); float v = (nn < N) ? W[(size_t)(k0 + kk) * N + nn] : 0.f; if (g) v *= g[k0 + kk]; scr[kk * 33 + (lane & 31)] = v; }
    WAVE_SYNC();
    const int c = lane & 7;
#pragma unroll
    for (int j = 0; j < 4; ++j) { const int n = (lane >> 3) + 8 * j; const LAS float* s = scr + (8 * c) * 33 + n;
        v4u o; o.x = pk2(s[0 * 33], s[1 * 33]); o.y = pk2(s[2 * 33], s[3 * 33]); o.z = pk2(s[4 * 33], s[5 * 33]); o.w = pk2(s[6 * 33], s[7 * 33]);
        *(v4u*)(WT + (size_t)(n0 + n) * K + k0 + 8 * c) = o; }
    WAVE_SYNC();
}
template <bool NORM> __device__ __forceinline__ void row_to_bf16(const float* xrow, bf16_t* orow, int lane) {
    const f32x4* xr = (const f32x4*)xrow + lane;
    f32x4 v[4]; float s = 0.f;
#pragma unroll
    for (int j = 0; j < 4; ++j) { v[j] = xr[64 * j]; s += (v[j].x * v[j].x + v[j].y * v[j].y) + (v[j].z * v[j].z + v[j].w * v[j].w); }
    float r = 1.f;
    if (NORM) r = 1.0f / sqrtf(wave_sum(s) * (1.f / DM) + EPS);
    v2u* o8 = (v2u*)orow + lane;
#pragma unroll
    for (int j = 0; j < 4; ++j) { v2u w; w.x = pk2(v[j].x * r, v[j].y * r); w.y = pk2(v[j].z * r, v[j].w * r); o8[64 * j] = w; }
}

__device__ __forceinline__ void ckvnorm4(const bf16_t* PROJ, const float* kvg, bf16_t* CKVN, int row0, int lane) {
    const int row = row0 + (lane >> 4), c8 = (lane & 15) * 8;
    const v4u v = *(const v4u*)(PROJ + (size_t)row * LDP + C_CKV + c8);
    float f[8] = {__uint_as_float(v.x << 16), __uint_as_float(v.x & 0xffff0000u), __uint_as_float(v.y << 16), __uint_as_float(v.y & 0xffff0000u),
                  __uint_as_float(v.z << 16), __uint_as_float(v.z & 0xffff0000u), __uint_as_float(v.w << 16), __uint_as_float(v.w & 0xffff0000u)};
    float s = 0.f;
#pragma unroll
    for (int j = 0; j < 8; ++j) s += f[j] * f[j];
    s = row16_sum(s);
    const float r = 1.0f / sqrtf(s * (1.0f / 128.f) + EPS);
    const f32x4 g0 = *(const f32x4*)(kvg + c8), g1 = *(const f32x4*)(kvg + c8 + 4);
    v4u o; o.x = pk2(f[0] * r * g0.x, f[1] * r * g0.y); o.y = pk2(f[2] * r * g0.z, f[3] * r * g0.w); o.z = pk2(f[4] * r * g1.x, f[5] * r * g1.y); o.w = pk2(f[6] * r * g1.z, f[7] * r * g1.w);
    *(v4u*)(CKVN + (size_t)row * 128 + c8) = o;
}
__device__ __forceinline__ unsigned ordkey(float f) { unsigned u = __float_as_uint(f); return (u & 0x80000000u) ? ~u : (u | 0x80000000u); }
template <bool L0> __device__ __forceinline__ void post_row(const float* xin, const bf16_t* Y, const float* g, float* xout, bf16_t* X1b, bf16_t* Hn, int row, int lane) {
    const bf16_t* yp = Y + (size_t)row * DM;
    float yv[16]; float s = 0.f;
#pragma unroll
    for (int j = 0; j < 4; ++j) {
        const v2u v = *(const v2u*)(yp + (lane + 64 * j) * 4);
        yv[4 * j + 0] = __uint_as_float(v.x << 16); yv[4 * j + 1] = __uint_as_float(v.x & 0xffff0000u);
        yv[4 * j + 2] = __uint_as_float(v.y << 16); yv[4 * j + 3] = __uint_as_float(v.y & 0xffff0000u);
        s += yv[4 * j] * yv[4 * j] + yv[4 * j + 1] * yv[4 * j + 1] + yv[4 * j + 2] * yv[4 * j + 2] + yv[4 * j + 3] * yv[4 * j + 3];
    }
    const float r = 1.0f / sqrtf(wave_sum(s) * (1.0f / DM) + EPS);
    f32x4 ov[4]; float s2 = 0.f;
#pragma unroll
    for (int j = 0; j < 4; ++j) {
        const int c = (lane + 64 * j) * 4;
        f32x4 xv;
        if (L0) xv = *(const f32x4*)(xin + (size_t)row * DM + c);
        else { const v2u xb = *(const v2u*)(X1b + (size_t)row * DM + c); xv.x = __uint_as_float(xb.x << 16); xv.y = __uint_as_float(xb.x & 0xffff0000u); xv.z = __uint_as_float(xb.y << 16); xv.w = __uint_as_float(xb.y & 0xffff0000u); }
        const f32x4 gv = *(const f32x4*)(g + c);
        ov[j].x = xv.x + yv[4 * j] * r * gv.x; ov[j].y = xv.y + yv[4 * j + 1] * r * gv.y; ov[j].z = xv.z + yv[4 * j + 2] * r * gv.z; ov[j].w = xv.w + yv[4 * j + 3] * r * gv.w;
        if (L0) { v2u w; w.x = pk2(ov[j].x, ov[j].y); w.y = pk2(ov[j].z, ov[j].w); *(v2u*)(X1b + (size_t)row * DM + c) = w; }
        else *(f32x4*)(xout + (size_t)row * DM + c) = ov[j];
        s2 += (ov[j].x * ov[j].x + ov[j].y * ov[j].y) + (ov[j].z * ov[j].z + ov[j].w * ov[j].w);
    }
    if (Hn) {
        const float r2 = 1.0f / sqrtf(wave_sum(s2) * (1.f / DM) + EPS);
        v2u* o8 = (v2u*)(Hn + (size_t)row * DM) + lane;
#pragma unroll
        for (int j = 0; j < 4; ++j) { v2u w; w.x = pk2(ov[j].x * r2, ov[j].y * r2); w.y = pk2(ov[j].z * r2, ov[j].w * r2); o8[64 * j] = w; }
    }
}

typedef short bf16x8 __attribute__((ext_vector_type(8)));
typedef short s16x4 __attribute__((ext_vector_type(4)));
typedef float f32x16 __attribute__((ext_vector_type(16)));
typedef float f32x2_t __attribute__((ext_vector_type(2)));
typedef __bf16 bf16x2_t __attribute__((ext_vector_type(2)));
#define MFMA32(a, b, c) __builtin_amdgcn_mfma_f32_32x32x16_bf16((a), (b), (c), 0, 0, 0)
__device__ __forceinline__ unsigned cvtpk(float lo, float hi) { f32x2_t v = {lo, hi}; bf16x2_t b = __builtin_convertvector(v, bf16x2_t); return __builtin_bit_cast(unsigned, b); }
__device__ __forceinline__ s16x4 vtr(const LAS unsigned char* p) { return __builtin_bit_cast(s16x4, __builtin_amdgcn_ds_read_tr16_b64_v4i16((LAS s16x4*)p)); }
__device__ __forceinline__ int crow(int r, int hi) { return (r & 3) + 8 * (r >> 2) + 4 * hi; }
__device__ __forceinline__ bf16x8 pack8(const f32x16& x, int s) {
    v4u p; p.x = cvtpk(x[8 * s + 0], x[8 * s + 1]); p.y = cvtpk(x[8 * s + 2], x[8 * s + 3]); p.z = cvtpk(x[8 * s + 4], x[8 * s + 5]); p.w = cvtpk(x[8 * s + 6], x[8 * s + 7]);
    return __builtin_bit_cast(bf16x8, p);
}
__device__ __forceinline__ f32x16 zero16() { float z; asm volatile("v_mov_b32 %0, 0" : "=v"(z)); return (f32x16){z, z, z, z, z, z, z, z, z, z, z, z, z, z, z, z}; }
__device__ __forceinline__ bf16x8 cat44(s16x4 lo, s16x4 hi) { return __builtin_shufflevector(lo, hi, 0, 1, 2, 3, 4, 5, 6, 7); }
__device__ __forceinline__ float xhalf_max(float v) { auto rr = __builtin_amdgcn_permlane32_swap(__float_as_uint(v), __float_as_uint(v), false, false); return fmaxf(__uint_as_float(rr[0]), __uint_as_float(rr[1])); }
__device__ __forceinline__ float xhalf_sum(float v) { auto rr = __builtin_amdgcn_permlane32_swap(__float_as_uint(v), __float_as_uint(v), false, false); return __uint_as_float(rr[0]) + __uint_as_float(rr[1]); }
__device__ __forceinline__ unsigned xhalf_other_u(unsigned v, int hi) { auto rr = __builtin_amdgcn_permlane32_swap(v, v, false, false); return hi ? rr[0] : rr[1]; }
__device__ __forceinline__ float xhalf_other(float v, int hi) { return __uint_as_float(xhalf_other_u(__float_as_uint(v), hi)); }
constexpr int VT_PITCH = 192;
constexpr float LOG2E = 1.4426950408889634f;

__device__ __forceinline__ void pv_tile(f32x16 (&O)[2], const LAS unsigned char* vrd, bf16x8 p0, bf16x8 p1) {
#pragma unroll
    for (int c = 0; c < 2; ++c) {
        const bf16x8 a0 = cat44(vtr(vrd + 0 * VT_PITCH + 64 * c), vtr(vrd + 8 * VT_PITCH + 64 * c));
        const bf16x8 a1 = cat44(vtr(vrd + 16 * VT_PITCH + 64 * c), vtr(vrd + 24 * VT_PITCH + 64 * c));
        O[c] = MFMA32(a0, p0, O[c]);
        O[c] = MFMA32(a1, p1, O[c]);
    }
}
__device__ __forceinline__ void gate_store(const f32x16 (&O)[2], float scale, const bf16_t* grow, bf16_t* orow, int hi) {
#pragma unroll
    for (int c = 0; c < 2; ++c)
#pragma unroll
        for (int g = 0; g < 4; ++g) {
            const int d = 32 * c + 8 * g + 4 * hi;
            const v2u gv = *(const v2u*)(grow + d);
            float gt[4] = {__uint_as_float(gv.x << 16), __uint_as_float(gv.x & 0xffff0000u), __uint_as_float(gv.y << 16), __uint_as_float(gv.y & 0xffff0000u)};
            float ov[4];
#pragma unroll
            for (int j = 0; j < 4; ++j) ov[j] = O[c][4 * g + j] * scale * gt[j] * __builtin_amdgcn_rcpf(1.f + __builtin_amdgcn_exp2f(-gt[j] * LOG2E));
            v2u w; w.x = cvtpk(ov[0], ov[1]); w.y = cvtpk(ov[2], ov[3]);
            *(v2u*)(orow + d) = w;
        }
}

__device__ __forceinline__ void gate_load(v2u (&gw)[8], const bf16_t* grow, int hi) {
#pragma unroll
    for (int c = 0; c < 2; ++c)
#pragma unroll
        for (int g = 0; g < 4; ++g) gw[c * 4 + g] = *(const v2u*)(grow + 32 * c + 8 * g + 4 * hi);
}
__device__ __forceinline__ void gate_store_pre(const f32x16 (&O)[2], float scale, const v2u (&gw)[8], bf16_t* orow, int hi) {
#pragma unroll
    for (int c = 0; c < 2; ++c)
#pragma unroll
        for (int g = 0; g < 4; ++g) {
            const int d = 32 * c + 8 * g + 4 * hi;
            const v2u gv = gw[c * 4 + g];
            float gt[4] = {__uint_as_float(gv.x << 16), __uint_as_float(gv.x & 0xffff0000u), __uint_as_float(gv.y << 16), __uint_as_float(gv.y & 0xffff0000u)};
            float ov[4];
#pragma unroll
            for (int j = 0; j < 4; ++j) ov[j] = O[c][4 * g + j] * scale * gt[j] * __builtin_amdgcn_rcpf(1.f + __builtin_amdgcn_exp2f(-gt[j] * LOG2E));
            v2u w; w.x = cvtpk(ov[0], ov[1]); w.y = cvtpk(ov[2], ov[3]);
            *(v2u*)(orow + d) = w;
        }
}

__device__ __forceinline__ void sb_item(const bf16_t* PROJ, bf16_t* MIX, int b, int h, int qt, int lane, LAS unsigned char* wl) {
    asm volatile("" : "+v"(lane));
    const int r32 = lane & 31, hi = lane >> 5;
    const bf16_t* base = PROJ + (size_t)b * SEQ * LDP;
    const int t = 32 * qt + r32;
    bf16x8 qf[4];
#pragma unroll
    for (int ks = 0; ks < 4; ++ks) qf[ks] = *(const bf16x8*)(base + (size_t)t * LDP + C_SBQ + h * 64 + 16 * ks + 8 * hi);
    v2u gw[8]; gate_load(gw, base + (size_t)t * LDP + C_SBG + h * 64, hi);
    const int vrow = lane >> 3, vch = lane & 7;
    LAS unsigned char* vwr = wl + vrow * VT_PITCH + vch * 16;
    const LAS unsigned char* vrd = wl + (4 * hi + ((lane & 15) >> 2)) * VT_PITCH + (16 * ((lane >> 4) & 1) + 4 * (lane & 3)) * 2;
    bf16x8 kc[4], vc[4];
    {
        const bf16_t* kp = base + (size_t)(32 * qt + r32) * LDP + C_SBK + h * 64 + 8 * hi;
#pragma unroll
        for (int ks = 0; ks < 4; ++ks) kc[ks] = *(const bf16x8*)(kp + 16 * ks);
        const bf16_t* vp = base + (size_t)(32 * qt + vrow) * LDP + C_SBV + h * 64 + 8 * vch;
#pragma unroll
        for (int i = 0; i < 4; ++i) vc[i] = *(const bf16x8*)(vp + (size_t)(8 * i) * LDP);
    }
    f32x16 O[2];
#pragma unroll
    for (int r = 0; r < 16; ++r) { O[0][r] = 0.f; O[1][r] = 0.f; }
    float R = 1.f;
    for (int kt = qt; kt >= 0; --kt) {
        bf16x8 kn[4], vn[4];
        {
            const int ktn = kt > 0 ? kt - 1 : 0;
            const bf16_t* kp = base + (size_t)(32 * ktn + r32) * LDP + C_SBK + h * 64 + 8 * hi;
#pragma unroll
            for (int ks = 0; ks < 4; ++ks) kn[ks] = *(const bf16x8*)(kp + 16 * ks);
            const bf16_t* vp = base + (size_t)(32 * ktn + vrow) * LDP + C_SBV + h * 64 + 8 * vch;
#pragma unroll
            for (int i = 0; i < 4; ++i) vn[i] = *(const bf16x8*)(vp + (size_t)(8 * i) * LDP);
        }
        f32x16 acc;
#pragma unroll
        for (int r = 0; r < 16; ++r) acc[r] = 0.f;
#pragma unroll
        for (int ks = 0; ks < 4; ++ks) acc = MFMA32(kc[ks], qf[ks], acc);
#pragma unroll
        for (int i = 0; i < 4; ++i) *(LAS bf16x8*)(vwr + (8 * i) * VT_PITCH) = vc[i];
        float be[16], om[16];
        const bool diag = (kt == qt);
#pragma unroll
        for (int r = 0; r < 16; ++r) {
            const float e = __builtin_amdgcn_exp2f(fminf(acc[r] * (-0.125f * LOG2E), 115.f));
            float bt = __builtin_amdgcn_rcpf(1.f + e), o1 = e * bt;
            if (diag && !(crow(r, hi) < r32)) { bt = 0.f; o1 = 1.f; }
            be[r] = bt; om[r] = o1;
        }
        float Gp[4], Gq[4];
#pragma unroll
        for (int g = 0; g < 4; ++g) { Gp[g] = (om[4 * g] * om[4 * g + 1]) * (om[4 * g + 2] * om[4 * g + 3]); Gq[g] = xhalf_other(Gp[g], hi); }
        const float T1 = Gp[1] * Gq[1], T2 = Gp[2] * Gq[2], T3 = Gp[3] * Gq[3], T0 = Gp[0] * Gq[0];
        float tail[4]; tail[3] = R; tail[2] = R * T3; tail[1] = tail[2] * T2; tail[0] = tail[1] * T1;
        const float Rn = tail[0] * T0;
#pragma unroll
        for (int g = 0; g < 4; ++g) {
            float sfx = tail[g] * (hi == 0 ? Gq[g] : 1.f);
            acc[4 * g + 3] = be[4 * g + 3] * sfx; sfx *= om[4 * g + 3];
            acc[4 * g + 2] = be[4 * g + 2] * sfx; sfx *= om[4 * g + 2];
            acc[4 * g + 1] = be[4 * g + 1] * sfx; sfx *= om[4 * g + 1];
            acc[4 * g + 0] = be[4 * g + 0] * sfx;
        }
        R = Rn;
        const bf16x8 p0 = pack8(acc, 0), p1 = pack8(acc, 1);
        pv_tile(O, vrd, p0, p1);
        if (__all(R < 5.4210109e-20f)) break;
#pragma unroll
        for (int i = 0; i < 4; ++i) { kc[i] = kn[i]; vc[i] = vn[i]; }
    }
    gate_store_pre(O, 1.f, gw, MIX + ((size_t)b * SEQ + t) * DM + h * 64, hi);
}

__device__ __forceinline__ void mem_item(const bf16_t* PROJ, const bf16_t* KV, bf16_t* MIX, int b, int h, int qt, int lane, LAS unsigned char* wl) {
    asm volatile("" : "+v"(lane));
    float NINF; asm volatile("v_mov_b32 %0, 0xff800000" : "=v"(NINF));
    const int r32 = lane & 31, hi = lane >> 5;
    const int t = 32 * qt + r32;
    const bf16_t* prow = PROJ + ((size_t)b * SEQ + t) * LDP;
    bf16x8 qf[4];
#pragma unroll
    for (int ks = 0; ks < 4; ++ks) qf[ks] = *(const bf16x8*)(prow + C_MQ + h * 64 + 16 * ks + 8 * hi);
    const int vrow = lane >> 3, vch = lane & 7;
    LAS unsigned char* vwr = wl + vrow * VT_PITCH + vch * 16;
    const LAS unsigned char* vrd = wl + (4 * hi + ((lane & 15) >> 2)) * VT_PITCH + (16 * ((lane >> 4) & 1) + 4 * (lane & 3)) * 2;
    const bf16_t* kvb = KV + (size_t)b * NMEM * 1024 + h * 64;
    f32x16 O[2];
#pragma unroll
    for (int r = 0; r < 16; ++r) { O[0][r] = 0.f; O[1][r] = 0.f; }
    float mrun = NINF, lrun = 0.f;
    v2u gw[8]; gate_load(gw, prow + C_MG + h * 64, hi);
    bf16x8 kc[4], vc[4];
    {
        const bf16_t* kp = kvb + (size_t)r32 * 1024 + 8 * hi;
#pragma unroll
        for (int ks = 0; ks < 4; ++ks) kc[ks] = *(const bf16x8*)(kp + 16 * ks);
        const bf16_t* vp = kvb + (size_t)vrow * 1024 + 256 + 8 * vch;
#pragma unroll
        for (int i = 0; i < 4; ++i) vc[i] = *(const bf16x8*)(vp + (size_t)(8 * i) * 1024);
    }
    for (int kt = 0; kt < NMEM / 32; ++kt) {
        bf16x8 kn[4], vn[4];
        {
            const int ktn = kt < NMEM / 32 - 1 ? kt + 1 : kt;
            const bf16_t* kp = kvb + (size_t)(32 * ktn + r32) * 1024 + 8 * hi;
#pragma unroll
            for (int ks = 0; ks < 4; ++ks) kn[ks] = *(const bf16x8*)(kp + 16 * ks);
            const bf16_t* vp = kvb + (size_t)(32 * ktn + vrow) * 1024 + 256 + 8 * vch;
#pragma unroll
            for (int i = 0; i < 4; ++i) vn[i] = *(const bf16x8*)(vp + (size_t)(8 * i) * 1024);
        }
        f32x16 acc;
#pragma unroll
        for (int r = 0; r < 16; ++r) acc[r] = 0.f;
#pragma unroll
        for (int ks = 0; ks < 4; ++ks) acc = MFMA32(kc[ks], qf[ks], acc);
#pragma unroll
        for (int i = 0; i < 4; ++i) *(LAS bf16x8*)(vwr + (8 * i) * VT_PITCH) = vc[i];
        float mx = acc[0];
#pragma unroll
        for (int r = 1; r < 16; ++r) mx = fmaxf(mx, acc[r]);
        mx *= 0.125f * LOG2E;
        mx = xhalf_max(mx);
        const float mn = fmaxf(mrun, mx), alpha = __builtin_amdgcn_exp2f(mrun - mn);
        float ps = 0.f;
#pragma unroll
        for (int r = 0; r < 16; ++r) { acc[r] = __builtin_amdgcn_exp2f(acc[r] * (0.125f * LOG2E) - mn); ps += acc[r]; }
        lrun = lrun * alpha + ps; mrun = mn;
#pragma unroll
        for (int r = 0; r < 16; ++r) { O[0][r] *= alpha; O[1][r] *= alpha; }
        const bf16x8 p0 = pack8(acc, 0), p1 = pack8(acc, 1);
        pv_tile(O, vrd, p0, p1);
#pragma unroll
        for (int i = 0; i < 4; ++i) { kc[i] = kn[i]; vc[i] = vn[i]; }
    }
    const float lt = xhalf_sum(lrun);
    gate_store_pre(O, 1.f / lt, gw, MIX + ((size_t)b * SEQ + t) * DM + 768 + h * 64, hi);
}

constexpr int MEML_V_OFF = 32768;
__device__ __forceinline__ void mem_stage(const bf16_t* KV, int b, int h, int tid, LAS unsigned char* L) {
    const bf16_t* kvb = KV + (size_t)b * NMEM * 1024 + h * 64;
#pragma unroll
    for (int i = 0; i < 4; ++i) {
        const int idx = tid + 512 * i, key = idx >> 3, ch = idx & 7;
        const v4u kx = *(const v4u*)(kvb + (size_t)key * 1024 + 8 * ch), vx = *(const v4u*)(kvb + (size_t)key * 1024 + 256 + 8 * ch);
        *(LAS v4u*)(L + 128 * key + 16 * (ch ^ ((key >> 1) & 7))) = kx;
        *(LAS v4u*)(L + MEML_V_OFF + (key >> 5) * (32 * VT_PITCH) + (key & 31) * VT_PITCH + 16 * ch) = vx;
    }
}
__device__ __forceinline__ void mem_item_lds(const bf16_t* PROJ, bf16_t* MIX, int b, int h, int qt, int lane, const LAS unsigned char* L) {
    asm volatile("" : "+v"(lane));
    float NINF; asm volatile("v_mov_b32 %0, 0xff800000" : "=v"(NINF));
    const int r32 = lane & 31, hi = lane >> 5;
    const int t = 32 * qt + r32;
    const bf16_t* prow = PROJ + ((size_t)b * SEQ + t) * LDP;
    bf16x8 qf[4];
#pragma unroll
    for (int ks = 0; ks < 4; ++ks) qf[ks] = *(const bf16x8*)(prow + C_MQ + h * 64 + 16 * ks + 8 * hi);
    v2u gw[8]; gate_load(gw, prow + C_MG + h * 64, hi);
    const unsigned kx = ((unsigned)r32 >> 1) & 7u;
    const LAS unsigned char* krd = L + 128 * r32;
    const LAS unsigned char* vrd = L + MEML_V_OFF + (4 * hi + ((lane & 15) >> 2)) * VT_PITCH + (16 * ((lane >> 4) & 1) + 4 * (lane & 3)) * 2;
    f32x16 O[2];
    O[0] = zero16(); O[1] = zero16();
    float mrun = NINF, lrun = 0.f;
#pragma unroll 2
    for (int kt = 0; kt < NMEM / 32; ++kt) {
        bf16x8 kc[4];
#pragma unroll
        for (int ks = 0; ks < 4; ++ks) kc[ks] = *(const LAS bf16x8*)(krd + 4096 * kt + 16 * ((unsigned)(2 * ks + hi) ^ kx));
        f32x16 acc;
#pragma unroll
        for (int r = 0; r < 16; ++r) acc[r] = 0.f;
#pragma unroll
        for (int ks = 0; ks < 4; ++ks) acc = MFMA32(kc[ks], qf[ks], acc);
        float mx = acc[0];
#pragma unroll
        for (int r = 1; r < 16; ++r) mx = fmaxf(mx, acc[r]);
        mx *= 0.125f * LOG2E;
        mx = xhalf_max(mx);
        const float mn = fmaxf(mrun, mx), alpha = __builtin_amdgcn_exp2f(mrun - mn);
        float ps = 0.f;
#pragma unroll
        for (int r = 0; r < 16; ++r) { acc[r] = __builtin_amdgcn_exp2f(acc[r] * (0.125f * LOG2E) - mn); ps += acc[r]; }
        lrun = lrun * alpha + ps; mrun = mn;
#pragma unroll
        for (int r = 0; r < 16; ++r) { O[0][r] *= alpha; O[1][r] *= alpha; }
        const bf16x8 p0 = pack8(acc, 0), p1 = pack8(acc, 1);
        pv_tile(O, vrd + kt * (32 * VT_PITCH), p0, p1);
    }
    const float lt = xhalf_sum(lrun);
    gate_store_pre(O, 1.f / lt, gw, MIX + ((size_t)b * SEQ + t) * DM + 768 + h * 64, hi);
}

constexpr int SEL_IQ_PITCH = 528, SEL_CNT_OFF = 17408;
__device__ __forceinline__ unsigned ordkey(float f);
template <int PRED  >
__device__ __forceinline__ unsigned sel_count_round(const unsigned (&key)[8][16], unsigned c, unsigned tau, int idx0, int r32, int hi, int wave, LAS unsigned* cb) {
    int n = 0;
#pragma unroll
    for (int i = 0; i < 8; ++i) {
#pragma unroll
        for (int r = 0; r < 16; ++r) {
            if (PRED == 0) n += (key[i][r] >= c) ? 1 : 0;
            else if (PRED == 1) n += (key[i][r] > c) ? 1 : 0;
            else n += (key[i][r] == tau && (unsigned)(idx0 + 256 * i + (r & 3) + 8 * (r >> 2)) <= c) ? 1 : 0;
            if ((r & 7) == 7) asm volatile("" : "+v"(n));
        }
    }
    n += (int)xhalf_other_u((unsigned)n, hi);
    if (hi == 0) cb[wave * 32 + r32] = (unsigned)n;
    __syncthreads();
    unsigned tot = 0;
#pragma unroll
    for (int w = 0; w < 8; ++w) tot += cb[w * 32 + r32];
    return tot;
}
constexpr int SEL_CAP = 64, SEL_DONE = 16;
__device__ __forceinline__ float key2f(unsigned k) { return __uint_as_float((k & 0x80000000u) ? (k & 0x7fffffffu) : ~k); }
__device__ __forceinline__ void sel_cnt4(unsigned& n, unsigned k0, unsigned k1, unsigned k2, unsigned k3, unsigned c) {
    unsigned long long s0, s1, s2, s3;
    asm("v_cmp_ge_u32_e64 %1, %5, %9\n\tv_cmp_ge_u32_e64 %2, %6, %9\n\tv_cmp_ge_u32_e64 %3, %7, %9\n\tv_cmp_ge_u32_e64 %4, %8, %9\n\t"
        "v_addc_co_u32_e64 %0, %1, %0, 0, %1\n\tv_addc_co_u32_e64 %0, %2, %0, 0, %2\n\tv_addc_co_u32_e64 %0, %3, %0, 0, %3\n\tv_addc_co_u32_e64 %0, %4, %0, 0, %4"
        : "+v"(n), "=&s"(s0), "=&s"(s1), "=&s"(s2), "=&s"(s3) : "v"(k0), "v"(k1), "v"(k2), "v"(k3), "v"(c));
}
template <int O3, int O2, int O1, int O0> __device__ __forceinline__ void sel_bits4(unsigned& bits, unsigned k3, unsigned k2, unsigned k1, unsigned k0, int cl, unsigned tau) {
    unsigned long long s0, s1, s2, s3; unsigned t0, t1, t2, t3;
    asm("v_cmp_lt_i32_e64 %5, %13, %15\n\tv_cmp_lt_i32_e64 %6, %13, %16\n\tv_cmp_lt_i32_e64 %7, %13, %17\n\tv_cmp_lt_i32_e64 %8, %13, %18\n\t"
        "v_addc_co_u32_e64 %1, %5, %14, 0, %5\n\tv_addc_co_u32_e64 %2, %6, %14, 0, %6\n\tv_addc_co_u32_e64 %3, %7, %14, 0, %7\n\tv_addc_co_u32_e64 %4, %8, %14, 0, %8\n\t"
        "v_cmp_ge_u32_e64 %5, %9, %1\n\tv_cmp_ge_u32_e64 %6, %10, %2\n\tv_cmp_ge_u32_e64 %7, %11, %3\n\tv_cmp_ge_u32_e64 %8, %12, %4\n\t"
        "v_addc_co_u32_e64 %0, %5, %0, %0, %5\n\tv_addc_co_u32_e64 %0, %6, %0, %0, %6\n\tv_addc_co_u32_e64 %0, %7, %0, %0, %7\n\tv_addc_co_u32_e64 %0, %8, %0, %0, %8"
        : "+v"(bits), "=&v"(t3), "=&v"(t2), "=&v"(t1), "=&v"(t0), "=&s"(s0), "=&s"(s1), "=&s"(s2), "=&s"(s3)
        : "v"(k3), "v"(k2), "v"(k1), "v"(k0), "v"(cl), "v"(tau), "n"(O3), "n"(O2), "n"(O1), "n"(O0));
}
__device__ __forceinline__ unsigned sel_count_lane(const unsigned (&key)[8][16], unsigned c) {
    unsigned n = 0;
#pragma unroll
    for (int i = 0; i < 8; ++i) {
#pragma unroll
        for (int r = 0; r < 16; r += 4) sel_cnt4(n, key[i][r], key[i][r + 1], key[i][r + 2], key[i][r + 3], c);
    }
    return n;
}
__device__ __forceinline__ unsigned sel_exchange(unsigned nl, int r32, int hi, int wave, LAS unsigned* cb) {
    const unsigned n2 = nl + xhalf_other_u(nl, hi);
    if (hi == 0) cb[wave * 32 + r32] = n2;
    __syncthreads();
    unsigned tot = 0;
#pragma unroll
    for (int w = 0; w < 8; ++w) tot += cb[w * 32 + r32];
    return tot;
}
__device__ __forceinline__ void sel_item2(const bf16_t* PROJ, unsigned* MASK, int b, int qt, int lane, int wave, LAS unsigned char* L) {
    asm volatile("" : "+v"(lane));
    const int r32 = lane & 31, hi = lane >> 5, tid = wave * 64 + lane;
    LAS unsigned* cntb = (LAS unsigned*)(L + SEL_CNT_OFF);
    const bf16_t* base = PROJ + (size_t)b * SEQ * LDP;
    unsigned* mrow = MASK + (((size_t)b * 64 + qt) * 64) * 32;
    if (qt < 8) {
#pragma unroll
        for (int i = 0; i < 8; ++i) {
            const int kt = wave + 8 * i;
            if (kt <= qt) {
                unsigned bits = 0u;
#pragma unroll
                for (int r = 0; r < 16; ++r) bits |= ((kt < qt) || (crow(r, hi) <= r32)) ? (1u << r) : 0u;
                const unsigned other = xhalf_other_u(bits, hi);
                if (hi == 0) mrow[kt * 32 + r32] = bits | (other << 16);
            }
        }
        return;
    }
    for (int n = tid; n < 1024; n += 512) { const int row = n >> 5, ch = n & 31;
        const v4u v = *(const v4u*)(base + (size_t)(32 * qt + row) * LDP + C_IDQ + ch * 8);
        *(LAS v4u*)(L + row * SEL_IQ_PITCH + ch * 16) = v; }
    float w8[8];
    { const v4u wv = *(const v4u*)(base + (size_t)(32 * qt + r32) * LDP + C_IDW);
      w8[0] = __uint_as_float(wv.x << 16) * 0.0625f; w8[1] = __uint_as_float(wv.x & 0xffff0000u) * 0.0625f; w8[2] = __uint_as_float(wv.y << 16) * 0.0625f; w8[3] = __uint_as_float(wv.y & 0xffff0000u) * 0.0625f;
      w8[4] = __uint_as_float(wv.z << 16) * 0.0625f; w8[5] = __uint_as_float(wv.z & 0xffff0000u) * 0.0625f; w8[6] = __uint_as_float(wv.w << 16) * 0.0625f; w8[7] = __uint_as_float(wv.w & 0xffff0000u) * 0.0625f; }
    __syncthreads();
    unsigned key[8][16];
    const LAS unsigned char* iqp = L + r32 * SEL_IQ_PITCH + 16 * hi;
    unsigned kmn = 0xffffffffu, kmx = 0u;
#pragma unroll
    for (int i = 0; i < 8; ++i) {
        const int kt = wave + 8 * i;
        if (kt <= qt) {
            const bf16_t* kp = base + (size_t)(32 * kt + r32) * LDP + C_IDK + 8 * hi;
            const bf16x8 k0 = *(const bf16x8*)kp, k1 = *(const bf16x8*)(kp + 16);
            float sc[16];
#pragma unroll
            for (int r = 0; r < 16; ++r) sc[r] = 0.f;
            unsigned iqo = 0; asm volatile("" : "+v"(iqo));
            const LAS unsigned char* iqt = iqp + iqo;
#pragma unroll
            for (int hp = 0; hp < 4; ++hp) {
                const int h = 2 * hp;
                bf16x8 q0 = *(const LAS bf16x8*)(iqt + h * 64), q1 = *(const LAS bf16x8*)(iqt + h * 64 + 32);
                bf16x8 q2 = *(const LAS bf16x8*)(iqt + h * 64 + 64), q3 = *(const LAS bf16x8*)(iqt + h * 64 + 96);
                asm volatile("" : "+v"(q0), "+v"(q1), "+v"(q2), "+v"(q3) : "v"(sc[15]));
                f32x16 Da, Db;
#pragma unroll
                for (int r = 0; r < 16; ++r) { Da[r] = 0.f; Db[r] = 0.f; }
                Da = MFMA32(k0, q0, Da);
                Db = MFMA32(k0, q2, Db);
                Da = MFMA32(k1, q1, Da);
                Db = MFMA32(k1, q3, Db);
#pragma unroll
                for (int r = 0; r < 16; ++r) sc[r] = __builtin_fmaf(w8[h], __int_as_float(max(__float_as_int(Da[r]), 0)), sc[r]);
#pragma unroll
                for (int r = 0; r < 16; ++r) sc[r] = __builtin_fmaf(w8[h + 1], __int_as_float(max(__float_as_int(Db[r]), 0)), sc[r]);
                asm volatile("" : "+v"(sc[0]), "+v"(sc[1]), "+v"(sc[2]), "+v"(sc[3]), "+v"(sc[4]), "+v"(sc[5]), "+v"(sc[6]), "+v"(sc[7]),
                                  "+v"(sc[8]), "+v"(sc[9]), "+v"(sc[10]), "+v"(sc[11]), "+v"(sc[12]), "+v"(sc[13]), "+v"(sc[14]), "+v"(sc[15]));
            }
            int thr = (kt < qt) ? 64 : (r32 - 4 * hi);
            asm volatile("" : "+v"(thr));
#pragma unroll
            for (int r = 0; r < 16; ++r) { const bool v = ((r & 3) + 8 * (r >> 2) <= thr); const unsigned k = ordkey(sc[r]); key[i][r] = v ? k : 0u; kmx = max(kmx, v ? k : 0u); kmn = min(kmn, v ? k : 0xffffffffu); }
        } else {
#pragma unroll
            for (int r = 0; r < 16; ++r) key[i][r] = 0u;
        }
    }
    unsigned lo_key, hi_key, clo, chi = 0u, nlo_l, nhi_l = 0u;
    {
        int nv = 0;
#pragma unroll
        for (int i = 0; i < 8; ++i) { const int kt = wave + 8 * i; nv += (kt < qt) ? 16 : 0; }
        if ((qt & 7) == wave) { const int thr = r32 - 4 * hi;
#pragma unroll
            for (int r = 0; r < 16; ++r) nv += ((r & 3) + 8 * (r >> 2) <= thr) ? 1 : 0; }
        nlo_l = (unsigned)nv;
        kmn = min(kmn, xhalf_other_u(kmn, hi)); kmx = max(kmx, xhalf_other_u(kmx, hi));
        if (hi == 0) { cntb[wave * 32 + r32] = kmn; cntb[256 + wave * 32 + r32] = kmx; }
        __syncthreads();
        unsigned a = 0xffffffffu, bmx = 0u;
#pragma unroll
        for (int w = 0; w < 8; ++w) { a = min(a, cntb[w * 32 + r32]); bmx = max(bmx, cntb[256 + w * 32 + r32]); }
        lo_key = a; hi_key = bmx + 1u; clo = (unsigned)(32 * qt + r32 + 1);
        __syncthreads();
    }
    int round = 0;
    for (;;) {
        const bool done = (clo - chi <= (unsigned)SEL_DONE) || (hi_key - lo_key <= 1u);
        if (__all(done)) break;
        unsigned p;
        if ((round & 3) == 3) p = lo_key + ((hi_key - lo_key) >> 1);
        else p = ordkey(0.5f * key2f(lo_key) + 0.5f * key2f(hi_key));
        p = min(max(p, lo_key + 1u), hi_key - 1u);
        if (done) p = lo_key;
        const unsigned nl = sel_count_lane(key, p);
        const unsigned tot = sel_exchange(nl, r32, hi, wave, cntb + (round & 1) * 256);
        if (!done) { if (tot >= 256u) { lo_key = p; clo = tot; nlo_l = nl; } else { hi_key = p; chi = tot; nhi_l = nl; } }
        ++round;
    }
    unsigned tau, cut;
    const bool many = (clo - chi > (unsigned)SEL_CAP);
    {
        LAS unsigned* lanecnt = (LAS unsigned*)L; LAS unsigned* meta = (LAS unsigned*)(L + 2048); LAS unsigned* result = (LAS unsigned*)(L + 2304); LAS unsigned* list = (LAS unsigned*)(L + 20480);
        const int slot = wave * 2 + hi;
        lanecnt[r32 * 16 + slot] = many ? 0u : (nlo_l - nhi_l);
        if (slot == 0) { meta[2 * r32] = many ? 0u : (clo - chi); meta[2 * r32 + 1] = 256u - chi; }
        __syncthreads();
        unsigned bs = 0u;
#pragma unroll
        for (int s2 = 0; s2 < 16; ++s2) { const unsigned v = lanecnt[r32 * 16 + s2]; bs += (s2 < slot) ? v : 0u; }
        if (!many) {
            const int idx0 = 32 * wave + 4 * hi;
            LAS unsigned* lp = list + (r32 * SEL_CAP + bs) * 2;
#pragma unroll
            for (int i = 0; i < 8; ++i)
#pragma unroll
                for (int r = 0; r < 16; ++r) {
                    const unsigned k = key[i][r];
                    if (k >= lo_key && k < hi_key) { lp[0] = k; lp[1] = (unsigned)(idx0 + 256 * i + (r & 3) + 8 * (r >> 2)); lp += 2; }
                }
        }
        __syncthreads();
        for (int j = 0; j < 4; ++j) {
            const int q = 4 * wave + j;
            const unsigned ncand = (unsigned)__builtin_amdgcn_readfirstlane((int)meta[2 * q]), need = (unsigned)__builtin_amdgcn_readfirstlane((int)meta[2 * q + 1]);
            const LAS unsigned* lq = list + q * SEL_CAP * 2;
            const bool mine = (unsigned)lane < ncand;
            const unsigned kc = mine ? lq[2 * lane] : 0u, ic = mine ? lq[2 * lane + 1] : 0u;
            unsigned rank = 0u;
            for (unsigned c2 = 0; c2 < ncand; ++c2) {
                const unsigned k2 = (unsigned)__builtin_amdgcn_readlane((int)kc, (int)c2), i2 = (unsigned)__builtin_amdgcn_readlane((int)ic, (int)c2);
                rank += (k2 > kc || (k2 == kc && i2 < ic)) ? 1u : 0u;
            }
            if (mine && rank == need - 1u) { result[2 * q] = kc; result[2 * q + 1] = ic; }
        }
        __syncthreads();
        tau = result[2 * r32]; cut = result[2 * r32 + 1];
    }
    if (__any(many)) {
        const unsigned need = 256u - chi;
        const int idx0 = 32 * wave + 4 * hi;
        unsigned lo_ = 0u, hi_ = 2047u;
        for (int it = 0; it < 11; ++it) {
            const unsigned mid = (lo_ + hi_) >> 1;
            const unsigned f = sel_count_round<2>(key, mid, lo_key, idx0, r32, hi, wave, cntb + (it & 1) * 256);
            if (f >= need) hi_ = mid; else lo_ = mid + 1;
        }
        if (many) { tau = lo_key; cut = hi_; }
    }
    {
        const int idx0 = 32 * wave + 4 * hi;
#pragma unroll
        for (int i = 0; i < 8; ++i) {
            const int kt = wave + 8 * i;
            if (kt <= qt) {
                unsigned bits = 0u;
                const int cl = (int)cut - idx0 - 256 * i;
                sel_bits4<27, 26, 25, 24>(bits, key[i][15], key[i][14], key[i][13], key[i][12], cl, tau);
                sel_bits4<19, 18, 17, 16>(bits, key[i][11], key[i][10], key[i][9], key[i][8], cl, tau);
                sel_bits4<11, 10, 9, 8>(bits, key[i][7], key[i][6], key[i][5], key[i][4], cl, tau);
                sel_bits4<3, 2, 1, 0>(bits, key[i][3], key[i][2], key[i][1], key[i][0], cl, tau);
                const unsigned other = xhalf_other_u(bits, hi);
                if (hi == 0) mrow[kt * 32 + r32] = bits | (other << 16);
            }
        }
    }
    __syncthreads();
}

constexpr int WS_WUK = 0;
constexpr int WS_WUV = 256 * 1024;
constexpr int DSA_BIAS_OFF = 16384;
__device__ __forceinline__ unsigned dsa_off(unsigned row, unsigned ch) { return 256u * row + 16u * (ch ^ (((row & 3u) << 2) | ((row >> 2) & 3u))); }
constexpr int DSA_NBUF = 6, DSA_MASK_OFF = 49152, DSA_BIAS2_OFF = 114688;
__device__ __forceinline__ void glds16(const void* gsrc, unsigned lds_dst) { unsigned keep;
    asm volatile("s_mov_b32 %0, m0\n\ts_mov_b32 m0, %2\n\ts_nop 0\n\tglobal_load_lds_dwordx4 %1, off\n\ts_mov_b32 m0, %0" : "=&s"(keep) : "v"(gsrc), "s"(lds_dst) : "memory"); }
__device__ __forceinline__ void lds_read8_b128(bf16x8 (&a)[8], unsigned be, unsigned bo) {
    asm volatile("ds_read_b128 %0, %8\n\tds_read_b128 %1, %9\n\tds_read_b128 %2, %8 offset:512\n\tds_read_b128 %3, %9 offset:512\n\t"
                 "ds_read_b128 %4, %8 offset:1024\n\tds_read_b128 %5, %9 offset:1024\n\tds_read_b128 %6, %8 offset:1536\n\tds_read_b128 %7, %9 offset:1536"
                 : "=&v"(a[0]), "=&v"(a[1]), "=&v"(a[2]), "=&v"(a[3]), "=&v"(a[4]), "=&v"(a[5]), "=&v"(a[6]), "=&v"(a[7]) : "v"(be), "v"(bo));
}
template <int N> __device__ __forceinline__ void lgkm_wait(bf16x8& a) { asm volatile("s_waitcnt lgkmcnt(%1)" : "+v"(a) : "n"(N)); }
__device__ __forceinline__ void lds_read16_tr(s16x4 (&f)[4][4], unsigned b0, unsigned b1) {
    asm volatile("ds_read_b64_tr_b16 %0, %16\n\tds_read_b64_tr_b16 %1, %17 offset:2048\n\tds_read_b64_tr_b16 %2, %16 offset:4096\n\tds_read_b64_tr_b16 %3, %17 offset:6144\n\t"
                 "ds_read_b64_tr_b16 %4, %16 offset:512\n\tds_read_b64_tr_b16 %5, %17 offset:2560\n\tds_read_b64_tr_b16 %6, %16 offset:4608\n\tds_read_b64_tr_b16 %7, %17 offset:6656\n\t"
                 "ds_read_b64_tr_b16 %8, %16 offset:1024\n\tds_read_b64_tr_b16 %9, %17 offset:3072\n\tds_read_b64_tr_b16 %10, %16 offset:5120\n\tds_read_b64_tr_b16 %11, %17 offset:7168\n\t"
                 "ds_read_b64_tr_b16 %12, %16 offset:1536\n\tds_read_b64_tr_b16 %13, %17 offset:3584\n\tds_read_b64_tr_b16 %14, %16 offset:5632\n\tds_read_b64_tr_b16 %15, %17 offset:7680"
                 : "=&v"(f[0][0]), "=&v"(f[0][1]), "=&v"(f[0][2]), "=&v"(f[0][3]), "=&v"(f[1][0]), "=&v"(f[1][1]), "=&v"(f[1][2]), "=&v"(f[1][3]),
                   "=&v"(f[2][0]), "=&v"(f[2][1]), "=&v"(f[2][2]), "=&v"(f[2][3]), "=&v"(f[3][0]), "=&v"(f[3][1]), "=&v"(f[3][2]), "=&v"(f[3][3]) : "v"(b0), "v"(b1));
}
__device__ __forceinline__ void lgkm_wait_all(s16x4 (&f)[4][4]) {
    asm volatile("s_waitcnt lgkmcnt(0)" : "+v"(f[0][0]), "+v"(f[0][1]), "+v"(f[0][2]), "+v"(f[0][3]), "+v"(f[1][0]), "+v"(f[1][1]), "+v"(f[1][2]), "+v"(f[1][3]),
                   "+v"(f[2][0]), "+v"(f[2][1]), "+v"(f[2][2]), "+v"(f[2][3]), "+v"(f[3][0]), "+v"(f[3][1]), "+v"(f[3][2]), "+v"(f[3][3]));
}
__device__ __forceinline__ void dsa_round(const bf16_t* PROJ, const bf16_t* CKVN, const unsigned* MASK, const bf16_t* WUKp  , const bf16_t* WUVp  ,
                                          const float* rel_bias, bf16_t* MIX, int b, int o, int h, int lane, int wave, LAS unsigned char* L, const int bkq) {
    asm volatile("" : "+v"(lane));
    float NINF; asm volatile("v_mov_b32 %0, 0xff800000" : "=v"(NINF));
    const int r32 = lane & 31, hi = lane >> 5, tid = wave * 64 + lane;
    const int qt = 8 * o + wave, KT = 8 * o + 7, t = 32 * qt + r32;
    const int srow = 8 * (wave >> 1) + ((lane >> 2) & 7);
    const int sch = 4 * (2 * (wave & 1) + (lane >> 5)) + ((lane & 3) ^ ((2 * (wave >> 1) + ((lane >> 4) & 1)) & 3));
    const bf16_t* csrc = CKVN + ((size_t)b * SEQ + srow) * 128 + 8 * sch;
    const unsigned ring0 = (unsigned)__builtin_amdgcn_readfirstlane((int)(unsigned)(size_t)L) + 1024u * (unsigned)wave;
    LAS unsigned* maskL = (LAS unsigned*)(L + DSA_MASK_OFF + wave * 8192);
    {
        const unsigned char* msrc = (const unsigned char*)(MASK + (((size_t)b * 64 + qt) * 64) * 32) + 16 * lane;
        const unsigned mdst = (unsigned)__builtin_amdgcn_readfirstlane((int)(unsigned)(size_t)maskL);
        for (int p = 0; 8 * p <= qt; ++p) glds16(msrc + 1024 * p, mdst + 1024u * (unsigned)p);
    }
    glds16(csrc, ring0); glds16(csrc + (size_t)32 * 128, ring0 + 8192u); glds16(csrc + (size_t)64 * 128, ring0 + 16384u); glds16(csrc + (size_t)96 * 128, ring0 + 24576u);
    LAS float* biasT = (LAS float*)(L + DSA_BIAS2_OFF);
    if (tid < 192) biasT[tid] = rel_bias[bkq * 6 + h] * LOG2E;
    const float bias31 = rel_bias[31 * 6 + h] * LOG2E;
    bf16x8 qlf[8];
    {
        const bf16_t* qrow = PROJ + ((size_t)b * SEQ + t) * LDP + C_DSQ + h * 64 + 8 * hi;
        bf16x8 qf[4];
#pragma unroll
        for (int ks = 0; ks < 4; ++ks) qf[ks] = *(const bf16x8*)(qrow + 16 * ks);
        bf16x8 wk[16];
#pragma unroll
        for (int rt = 0; rt < 4; ++rt) {
            const GAS bf16_t* wp = (const GAS bf16_t*)WUKp + (rt * 32 + r32) * 64 + 8 * hi;
#pragma unroll
            for (int ks = 0; ks < 4; ++ks) wk[rt * 4 + ks] = *(const GAS bf16x8*)(wp + 16 * ks);
        }
        asm volatile("" : "+v"(wk[0]), "+v"(wk[1]), "+v"(wk[2]), "+v"(wk[3]), "+v"(wk[4]), "+v"(wk[5]), "+v"(wk[6]), "+v"(wk[7]),
                          "+v"(wk[8]), "+v"(wk[9]), "+v"(wk[10]), "+v"(wk[11]), "+v"(wk[12]), "+v"(wk[13]), "+v"(wk[14]), "+v"(wk[15]));
#pragma unroll
        for (int rt = 0; rt < 4; ++rt) {
            f32x16 X;
#pragma unroll
            for (int r = 0; r < 16; ++r) X[r] = 0.f;
#pragma unroll
            for (int ks = 0; ks < 4; ++ks) X = MFMA32(wk[rt * 4 + ks], qf[ks], X);
#pragma unroll
            for (int r = 0; r < 16; ++r) X[r] *= 0.125f * LOG2E;
            qlf[2 * rt] = pack8(X, 0); qlf[2 * rt + 1] = pack8(X, 1);
        }
    }
    f32x16 O[4];
#pragma unroll
    for (int c = 0; c < 4; ++c)
#pragma unroll
        for (int r = 0; r < 16; ++r) O[c][r] = 0.f;
    float mref = NINF, lrun = 0.f;
    const unsigned x2 = ((unsigned)r32 >> 2) & 3u;
    const unsigned rb_e = 2048u * ((unsigned)r32 >> 3) + 64u * ((unsigned)r32 & 7u) + 16u * ((unsigned)hi ^ x2);
    const unsigned rb_o = 2048u * ((unsigned)r32 >> 3) + 64u * ((unsigned)r32 & 7u) + 16u * ((2u + (unsigned)hi) ^ x2);
    const unsigned tq = (lane & 15) >> 2, tp = lane & 3, tblk = (lane >> 4) & 1;
    const unsigned tb0 = 64u * (4u * hi + tq) + 16u * ((2u * tblk + (tp >> 1)) ^ ((unsigned)hi & 3u)) + 8u * (tp & 1);
    const unsigned tb1 = 64u * (4u * hi + tq) + 16u * ((2u * tblk + (tp >> 1)) ^ ((2u + (unsigned)hi) & 3u)) + 8u * (tp & 1);
    __syncthreads();
    asm volatile("s_waitcnt vmcnt(0) lgkmcnt(0)" ::: "memory");
    auto dsa_qk = [&](const int kt, f32x16& S, const LAS unsigned char* Cb) __attribute__((always_inline)) {
        if (kt <= qt) {
#pragma unroll
            for (int r = 0; r < 16; ++r) S[r] = 0.f;
            bf16x8 a[8];
            const unsigned cb32 = (unsigned)(size_t)Cb;
            lds_read8_b128(a, cb32 + rb_e, cb32 + rb_o);
            lgkm_wait<7>(a[0]); S = MFMA32(a[0], qlf[0], S);
            lgkm_wait<6>(a[1]); S = MFMA32(a[1], qlf[1], S);
            lgkm_wait<5>(a[2]); S = MFMA32(a[2], qlf[2], S);
            lgkm_wait<4>(a[3]); S = MFMA32(a[3], qlf[3], S);
            lgkm_wait<3>(a[4]); S = MFMA32(a[4], qlf[4], S);
            lgkm_wait<2>(a[5]); S = MFMA32(a[5], qlf[5], S);
            lgkm_wait<1>(a[6]); S = MFMA32(a[6], qlf[6], S);
            lgkm_wait<0>(a[7]); S = MFMA32(a[7], qlf[7], S);
        }
    };
    auto dsa_tile = [&](const int kt, f32x16& S, const LAS unsigned char* Cb, const unsigned mwc) __attribute__((always_inline)) {
        if (kt <= qt) {
            s16x4 f[4][4];
            lds_read16_tr(f, (unsigned)(size_t)Cb + tb0, (unsigned)(size_t)Cb + tb1);
            const unsigned mw = mwc;
            const int dq = qt - kt;
            float cb = bias31;
            if (__builtin_amdgcn_readfirstlane(dq) < 5) {
                asm volatile("" ::: "memory");
                cb = 0.f;
                const int rel0 = 32 * dq + r32 - 4 * hi;
#pragma unroll
                for (int r = 0; r < 16; ++r) { int rel = rel0 - ((r & 3) + 8 * (r >> 2)); rel = rel < 0 ? 0 : rel; S[r] += biasT[rel]; }
                asm volatile("" ::: "memory");
            }
            float mx = fmaxf(S[0], S[1]);
#pragma unroll
            for (int r = 2; r < 16; ++r) mx = fmaxf(mx, S[r]);
            mx = xhalf_max(mx) + cb;
            if (__any(mx > mref + 8.f)) {
                float mm = NINF;
                asm volatile("" : "+v"(mm));
#pragma unroll
                for (int r = 0; r < 16; ++r) mm = fmaxf(mm, ((mw >> r) & 1u) ? S[r] : NINF);
                mm = xhalf_max(mm) + cb;
                const float mn = fmaxf(mref, mm);
                const float alpha = (mn > mref) ? __builtin_amdgcn_exp2f(mref - mn) : 1.f;
                mref = mn; lrun *= alpha;
#pragma unroll
                for (int c = 0; c < 4; ++c)
#pragma unroll
                    for (int r = 0; r < 16; ++r) asm volatile("v_mul_f32 %0, %0, %1" : "+v"(O[c][r]) : "v"(alpha));
            }
            const float off = ((mref == NINF) ? 0.f : mref) - cb;
            float ps0 = 0.f, ps1 = 0.f;
#pragma unroll
            for (int r = 0; r < 16; ++r) {
                const float e = __builtin_amdgcn_exp2f(S[r] - off);
                int m1; asm("v_bfe_i32 %0, %1, %2, 1" : "=v"(m1) : "v"(mw), "n"(r));
                S[r] = __uint_as_float(__float_as_uint(e) & (unsigned)m1);
                if (r & 1) ps1 += S[r]; else ps0 += S[r];
            }
            lrun += ps0 + ps1;
            const bf16x8 p0 = pack8(S, 0), p1 = pack8(S, 1);
            lgkm_wait_all(f);
#pragma unroll
            for (int c = 0; c < 4; ++c) {
                O[c] = MFMA32(cat44(f[c][0], f[c][1]), p0, O[c]);
                O[c] = MFMA32(cat44(f[c][2], f[c][3]), p1, O[c]);
            }
        }
    };
    const int NS = (KT + 1) >> 1;
    v2u gatew[8];
#pragma unroll
    for (int i = 0; i < 8; ++i) { gatew[i].x = 0u; gatew[i].y = 0u; }
    int sl = 0;
    const bool late = (wave & 4) != 0;
    unsigned mwA = maskL[r32], mwB = maskL[32 + r32];
    for (int st = 0; st < NS; ++st) {
        if (st + 1 < NS) asm volatile("s_waitcnt vmcnt(2)\n\ts_barrier" ::: "memory");
        else asm volatile("s_waitcnt vmcnt(0)\n\ts_barrier" ::: "memory");
        if (st + 2 < NS) { int s2 = sl + 4; s2 = s2 >= 6 ? s2 - 6 : s2;
            glds16(csrc + (size_t)(64 * (st + 2)) * 128, ring0 + 8192u * (unsigned)s2); glds16(csrc + (size_t)(64 * (st + 2) + 32) * 128, ring0 + 8192u * (unsigned)(s2 + 1)); }
        if (st == NS - 1) gate_load(gatew, PROJ + ((size_t)b * SEQ + t) * LDP + C_DSG + h * 64, hi);
        unsigned mw0 = mwA >> (16 * hi), mw1 = mwB >> (16 * hi);
        asm volatile("" : "+v"(mw0), "+v"(mw1));
        f32x16 S0, S1;
        dsa_qk(2 * st, S0, L + sl * 8192);
        if (late) dsa_qk(2 * st + 1, S1, L + (sl + 1) * 8192);
        dsa_tile(2 * st, S0, L + sl * 8192, mw0);
        if (!late) dsa_qk(2 * st + 1, S1, L + (sl + 1) * 8192);
        dsa_tile(2 * st + 1, S1, L + (sl + 1) * 8192, mw1);
        if (st + 1 < NS) { mwA = maskL[(2 * st + 2) * 32 + r32]; mwB = maskL[(2 * st + 3) * 32 + r32]; }
        sl = (sl == 4) ? 0 : sl + 2;
    }
    const float lt = xhalf_sum(lrun);
    const float il = 1.f / lt;
    f32x16 Y[2];
#pragma unroll
    for (int r = 0; r < 16; ++r) { Y[0][r] = 0.f; Y[1][r] = 0.f; }
    bf16x8 wv[16];
    {
        int l3 = lane; asm volatile("" : "+v"(l3));
#pragma unroll
        for (int rt = 0; rt < 4; ++rt)
#pragma unroll
            for (int c = 0; c < 2; ++c) {
                const GAS bf16_t* wp = (const GAS bf16_t*)WUVp + ((((c * 4 + rt) * 2 + 0) * 32 + (l3 & 31)) * 2 + (l3 >> 5)) * 8;
                wv[(rt * 2 + c) * 2] = *(const GAS bf16x8*)wp; wv[(rt * 2 + c) * 2 + 1] = *(const GAS bf16x8*)(wp + 32 * 2 * 8);
            }
        asm volatile("" : "+v"(wv[0]), "+v"(wv[1]), "+v"(wv[2]), "+v"(wv[3]), "+v"(wv[4]), "+v"(wv[5]), "+v"(wv[6]), "+v"(wv[7]),
                          "+v"(wv[8]), "+v"(wv[9]), "+v"(wv[10]), "+v"(wv[11]), "+v"(wv[12]), "+v"(wv[13]), "+v"(wv[14]), "+v"(wv[15]));
    }
#pragma unroll
    for (int rt = 0; rt < 4; ++rt) {
#pragma unroll
        for (int r = 0; r < 16; ++r) O[rt][r] *= il;
        const bf16x8 x0 = pack8(O[rt], 0), x1 = pack8(O[rt], 1);
#pragma unroll
        for (int c = 0; c < 2; ++c) {
            Y[c] = MFMA32(wv[(rt * 2 + c) * 2], x0, Y[c]);
            Y[c] = MFMA32(wv[(rt * 2 + c) * 2 + 1], x1, Y[c]);
        }
    }
    {
        int l2 = lane; asm volatile("" : "+v"(l2));
        const int t2 = 32 * qt + (l2 & 31);
        gate_store_pre(Y, 1.f, gatew, MIX + ((size_t)b * SEQ + t2) * DM + 384 + h * 64, l2 >> 5);
    }
    asm volatile("s_waitcnt lgkmcnt(0)\n\ts_barrier" ::: "memory");
}

typedef GAS unsigned gu32;
#define RLX_AGENT __ATOMIC_RELAXED, __HIP_MEMORY_SCOPE_AGENT
constexpr size_t WS_BAR = 512 * 1024;
#define XB_TMO      128
#define XB_XCNT(j)  (256  + 64 * (j))
#define XB_XSUB(j)  (1280 + 64 * (j))
#define XB_XGEN(j)  (2304 + 64 * (j))
#define XB_TOP      3328
#define XB_TOPGEN   3392
#define XCD_BAR_WORDS 3456
#define XB_SPIN_CAP (1u << 18)

__device__ __forceinline__ unsigned xb_ld(unsigned* p)              { return __hip_atomic_load(p, __ATOMIC_RELAXED, __HIP_MEMORY_SCOPE_AGENT); }
__device__ __forceinline__ unsigned xb_add(unsigned* p, unsigned v) { return __hip_atomic_fetch_add(p, v, __ATOMIC_RELAXED, __HIP_MEMORY_SCOPE_AGENT); }
__device__ __forceinline__ unsigned xb_xcc_id() { return (unsigned)__builtin_amdgcn_s_getreg((3 << 11) | 20) & 0xFu; }
#define XB_SPIN(cond, bar) do { unsigned _sp = 0; while (cond) { __builtin_amdgcn_s_sleep(1); \
    if ((++_sp & 255u) == 0u) { if (xb_ld(&(bar)[XB_TMO])) break; if (_sp > XB_SPIN_CAP) { atomicAdd(&(bar)[XB_TMO], 1u); break; } } } } while (0)

struct XcdBarrier {
    unsigned* bar; unsigned x;
    volatile LAS unsigned* st;
};

__device__ __forceinline__ XcdBarrier xcd_barrier_post(unsigned* bar, volatile LAS unsigned* st) {
    XcdBarrier b; b.bar = bar; b.x = xb_xcc_id(); b.st = st;
    if (threadIdx.x == 0) (void)xb_add(&bar[XB_XCNT(b.x)], 1u);
    return b;
}
__device__ __forceinline__ void xcd_barrier_complete(unsigned* bar, unsigned x, unsigned& nloc, unsigned& nx) {
    const unsigned G = gridDim.x * gridDim.y * gridDim.z;
    unsigned sum, cnt, mine, sp = 0u;
    for (;;) {
        sum = 0u; cnt = 0u; mine = 0u;
#pragma unroll
        for (unsigned j = 0; j < 16; ++j) { const unsigned c = xb_ld(&bar[XB_XCNT(j)]); sum += c; cnt += (c > 0u) ? 1u : 0u; mine = (j == x) ? c : mine; }
        if (sum == G) break;
        __builtin_amdgcn_s_sleep(1);
        if ((++sp & 255u) == 0u) { if (xb_ld(&bar[XB_TMO])) break; if (sp > XB_SPIN_CAP) { atomicAdd(&bar[XB_TMO], 1u); break; } }
    }
    nloc = mine > 0u ? mine : 1u; nx = cnt > 0u ? cnt : 1u;
}

__device__ __forceinline__ void xcd_barrier(const XcdBarrier& b, const bool leader  ) {
    asm volatile("s_waitcnt vmcnt(0)" ::: "memory");
    __syncthreads();
    if (leader) {
        unsigned* bar = b.bar;
        __builtin_amdgcn_s_waitcnt(0);
        unsigned nloc = b.st[0], nx = b.st[1];
        if (nloc == 0u) { xcd_barrier_complete(bar, b.x, nloc, nx); b.st[0] = nloc; b.st[1] = nx; }
        const unsigned old = xb_add(&bar[XB_XSUB(b.x)], 1u);
        const unsigned gen = old / nloc;
        if (old + 1u == (gen + 1u) * nloc) {
            __builtin_amdgcn_fence(__ATOMIC_RELEASE, "agent");
            asm volatile("s_waitcnt vmcnt(0)" ::: "memory");
            const unsigned og = xb_add(&bar[XB_TOP], 1u);
            const unsigned tg = og / nx;
            if (og + 1u == (tg + 1u) * nx) xb_add(&bar[XB_TOPGEN], 1u);
            else XB_SPIN(xb_ld(&bar[XB_TOPGEN]) == tg, bar);
            __builtin_amdgcn_fence(__ATOMIC_ACQUIRE, "agent");
            xb_add(&bar[XB_XGEN(b.x)], 1u);
            asm volatile("s_waitcnt vmcnt(0)" ::: "memory");
        } else {
            XB_SPIN(xb_ld(&bar[XB_XGEN(b.x)]) == gen, bar);
            __builtin_amdgcn_fence(__ATOMIC_ACQUIRE, "agent");
            asm volatile("s_waitcnt vmcnt(0)" ::: "memory");
        }
    }
    __syncthreads();
}

#ifndef MK_MULTI
#define MK_MULTI 0
#endif
constexpr int NPHASE = 11;
__global__ void __launch_bounds__(NWAVES * 64, 2) mk_fwd(Args args) {
    extern __shared__ __attribute__((aligned(16))) unsigned char lds_raw[];
    LAS unsigned char* lds = (LAS unsigned char*)lds_raw;
    const int tid0 = threadIdx.x;
    int wave_ = __builtin_amdgcn_readfirstlane(tid0 >> 6); asm volatile("" : "+s"(wave_));
    const int wave = wave_;
    const int G = gridDim.x, bid = blockIdx.x;
    for (int u = tid0; u < 16; u += NWAVES * 64) ((LAS unsigned*)(lds + 131072))[u] = 0u;
    __syncthreads();
    const XcdBarrier xbar = xcd_barrier_post((unsigned*)(args.ws + WS_BAR), (volatile LAS unsigned*)(lds + 131072));
    const int lo = args.ph_lo, hi = args.ph_hi;
#define IN(k) (lo <= (k) && (k) < hi)
#define SEAM(k) do { if (IN(k) && IN((k) + 1)) { if ((k) == 0) cg::this_grid().sync(); else xcd_barrier(xbar, wave_ == 0 && lane_id_v() == 0); } } while (0)
#define PH_BEGIN int lane = lane_id_v(); unsigned char* ws_ = args.ws; asm volatile("" : "+s"(ws_)); GAS unsigned char* ws = (GAS unsigned char*)ws_;     \
    const int gw = bid * NWAVES + wave, NGW = G * NWAVES; (void)gw; (void)NGW;
#define VCU_LOOP for (int vcu = vcu0; vcu < 256; vcu += G)
#define VCU_IDS const int bb = vcu >> 3, w64 = (vcu & 7) * 8 + wave; (void)bb; (void)w64;
#define P_WIN ((bf16_t*)(ws + WS_WIN))
#define P_WOUT ((bf16_t*)(ws + WS_WOUT))
#define P_WMEM ((bf16_t*)(ws + WS_WMEM))
#define P_MEMB ((bf16_t*)(ws + WS_MEMB))
#define P_MEMKV ((bf16_t*)(ws + WS_MEMKV))
#define P_CKVN ((bf16_t*)(ws + WS_CKVN))
#define P_MASK ((unsigned*)(ws + WS_MASK))
#define P_H ((bf16_t*)(ws + WS_H))
#define P_MIX ((bf16_t*)(ws + WS_MIX))
#define P_PROJ ((bf16_t*)(ws + WS_PROJ))
#define P_Y ((bf16_t*)(ws + WS_Y))
    const int vcu0 = (G % 8 == 0) ? (bid & 7) * (G >> 3) + (bid >> 3) : bid;

    if (IN(0)) {
        PH_BEGIN
        const float* x = args.in[0]; const float* mem = args.in[1]; const float* pre_g = args.in[2];
        const float* w_in = args.in[4]; const float* w_mem = args.in[8]; const float* w_out = args.in[9];
        LAS float* scr = (LAS float*)(lds + wave * 16384);
        constexpr int I_IN = 16 * (LDP / 32), I_OUT = 16 * 32, I_MEM = 16 * 16;
        constexpr int NITEMS = 2 * I_IN + 2 * I_OUT + 2 * I_MEM;
        for (int it = gw; it < NITEMS; it += NGW) {
            int r = it;
            if (r < 2 * I_IN) { const int l = r / I_IN; r -= l * I_IN; p0_transpose_item(w_in + (size_t)l * DM * NCOL, DM, NCOL, LDP, P_WIN + (size_t)l * LDP * DM, pre_g + l * DM, scr, r, lane); continue; }
            r -= 2 * I_IN;
            if (r < 2 * I_OUT) { const int l = r / I_OUT; r -= l * I_OUT; p0_transpose_item(w_out + (size_t)l * DM * DM, DM, DM, DM, P_WOUT + (size_t)l * DM * DM, nullptr, scr, r, lane); continue; }
            r -= 2 * I_OUT;
            { const int l = r / I_MEM; r -= l * I_MEM; p0_transpose_item(w_mem + (size_t)l * DM * 512, DM, 512, 512, P_WMEM + (size_t)l * 512 * DM, nullptr, scr, r, lane); }
        }
        {
            const float* w_uk = args.in[5]; const float* w_uv = args.in[6];
            bf16_t* WUKp = (bf16_t*)(ws + WS_WUK); bf16_t* WUVp = (bf16_t*)(ws + WS_WUV);
            for (int e = gw * 64 + lane; e < 2 * 6 * 8192; e += NGW * 64) {
                const int lh = e >> 13, l = lh / 6, h = lh % 6, w = e & 8191;
                { const int rt = w >> 11, rho = (w >> 6) & 31, d = w & 63; const int r = 32 * rt + ((rho & 0x13) | ((rho & 4) << 1) | ((rho & 8) >> 1));
                  WUKp[e] = (bf16_t)f2bf(w_uk[(((size_t)l * 128 + r) * 6 + h) * 64 + d]); }
                { const int j = w & 7, hh = (w >> 3) & 1, d32 = (w >> 4) & 31, s = (w >> 9) & 1, rt = (w >> 10) & 3, c = (w >> 12) & 1;
                  const int r = 32 * rt + 16 * s + 8 * (j >> 2) + 4 * hh + (j & 3), d = 32 * c + d32;
                  WUVp[e] = (bf16_t)f2bf(w_uv[(((size_t)l * 128 + r) * 6 + h) * 64 + d]); }
            }
        }
        for (int m = gw; m < NB * NMEM; m += NGW) row_to_bf16<false>(mem + (size_t)m * DM, P_MEMB + (size_t)m * DM, lane);
        for (int m = gw * 2; m < NTOK; m += NGW * 2) { row_to_bf16<true>(x + (size_t)m * DM, P_H + (size_t)m * DM, lane); row_to_bf16<true>(x + (size_t)(m + 1) * DM, P_H + (size_t)(m + 1) * DM, lane); }
    }
    SEAM(0);
#pragma unroll 1
    for (int l = 0; l < 2; ++l) {
        const int pb = 1 + 5 * l;
        if (IN(pb)) {
            PH_BEGIN
            { pg8::Gemm g{P_H, P_WIN + (size_t)l * LDP * DM, NTOK, LDP, DM}; pg8::StaticOrder S; S.init(NTOK, LDP, G, bid);
              pg8::EpiBf16<0> E{P_PROJ, LDP, nullptr, 0, 0, 1.f};
              pg8::gemm_phase<pg8::EpiBf16<0>, pg8::StaticOrder, true, true>(lds, g, S, E, wave); }
            if (l == 0) {
              pg8::Gemm g{P_MEMB, P_WMEM, NB * NMEM, 1024, DM}; pg8::StaticOrder S; S.init(NB * NMEM, 1024, G, bid);
              pg8::EpiBf16<0> E{P_MEMKV, 1024, nullptr, 0, 0, 1.f};
              pg8::gemm_phase<pg8::EpiBf16<0>, pg8::StaticOrder, true, true>(lds, g, S, E, wave); }
        }
        SEAM(pb);
        if (IN(pb + 1)) {
            { PH_BEGIN
              const float* kv_g = args.in[7];
              for (int m = gw * 8; m < NTOK; m += NGW * 8) { ckvnorm4(P_PROJ, kv_g + l * 128, P_CKVN, m, lane); ckvnorm4(P_PROJ, kv_g + l * 128, P_CKVN, m + 4, lane); } }
            VCU_LOOP { PH_BEGIN VCU_IDS
              for (int i = 0; i < 6; ++i) { const int qt = (i & 1) ? 63 - w64 : w64; sb_item(P_PROJ, P_MIX, bb, i, qt, lane, lds + wave * 16384); } }
            __syncthreads();
            VCU_LOOP { PH_BEGIN VCU_IDS
              const int s8 = vcu & 7;
              for (int j = 0; j < 8; ++j) { const int qt = 8 * j + ((j & 1) ? 7 - s8 : s8); sel_item2(P_PROJ, P_MASK, bb, qt, lane, wave, lds); } }
            __syncthreads();
            VCU_LOOP { PH_BEGIN VCU_IDS
              for (int i = 0; i < 4; ++i) {
                  __syncthreads();
                  mem_stage(P_MEMKV + l * 512, bb, i, wave * 64 + lane, lds);
                  __syncthreads();
                  mem_item_lds(P_PROJ, P_MIX, bb, i, w64, lane, lds);
              } }
        }
        SEAM(pb + 1);
        if (IN(pb + 2)) {
            __syncthreads();
            VCU_LOOP { PH_BEGIN VCU_IDS
              const float* rel_bias = args.in[10];
              const int s8 = vcu & 7, hs = (s8 < 4) ? 0 : 3;
              const int tidq = wave * 64 + lane;
              const int bkq = tidq < 128 ? (int)T5TAB[tidq] : 31;
              for (int oi = 0; oi < 2; ++oi) {
                  const int o = oi ? 7 - (s8 & 3) : (s8 & 3);
                  for (int hh = 0; hh < 3; ++hh) {
                      const int h = hs + hh;
                      dsa_round(P_PROJ, P_CKVN, P_MASK, (const bf16_t*)(ws + WS_WUK) + (size_t)(l * 6 + h) * 8192, (const bf16_t*)(ws + WS_WUV) + (size_t)(l * 6 + h) * 8192,
                                rel_bias, P_MIX, bb, o, h, lane, wave, lds, bkq);
                  }
              } }
        }
        SEAM(pb + 2);
        if (IN(pb + 3)) {
            PH_BEGIN
            __syncthreads();
            pg8::Gemm g{P_MIX, P_WOUT + (size_t)l * DM * DM, NTOK, DM, DM}; pg8::StaticOrder S; S.init(NTOK, DM, G, bid);
            pg8::EpiBf16<0> E{P_Y, DM, nullptr, 0, 0, 1.f};
            pg8::gemm_phase<pg8::EpiBf16<0>, pg8::StaticOrder, true, true>(lds, g, S, E, wave);
        }
        SEAM(pb + 3);
        if (IN(pb + 4)) {
            PH_BEGIN
            const float* post_g = args.in[3]; bf16_t* X1b = (bf16_t*)(ws + WS_X1);
            if (l == 0) { for (int m = gw * 2; m < NTOK; m += NGW * 2) { post_row<true>(args.in[0], P_Y, post_g, args.out, X1b, P_H, m, lane); post_row<true>(args.in[0], P_Y, post_g, args.out, X1b, P_H, m + 1, lane); } }
            else { for (int m = gw * 2; m < NTOK; m += NGW * 2) { post_row<false>(nullptr, P_Y, post_g + DM, args.out, X1b, (bf16_t*)nullptr, m, lane); post_row<false>(nullptr, P_Y, post_g + DM, args.out, X1b, (bf16_t*)nullptr, m + 1, lane); } }
        }
        SEAM(pb + 4);
    }
#undef IN
#undef SEAM
}

extern "C" void kernel_launch(void* const* d_in, const int* in_sizes, int n_in, void* d_out, int out_size, void* d_ws, size_t ws_size, hipStream_t stream) {
    static int grid = 0;
    if (grid == 0) {
        if (n_in != 11 || ws_size < WS_END) { fprintf(stderr, "kernel_launch: unexpected n_in %d / ws_size %zu\n", n_in, ws_size); grid = -1; return; }
        int dev = 0, cus = 0, per_cu = 0;
        hipGetDevice(&dev);
        hipDeviceGetAttribute(&cus, hipDeviceAttributeMultiprocessorCount, dev);
        hipFuncSetAttribute((const void*)mk_fwd, hipFuncAttributeMaxDynamicSharedMemorySize, LDS_BYTES);
        hipOccupancyMaxActiveBlocksPerMultiprocessor(&per_cu, (const void*)mk_fwd, NWAVES * 64, LDS_BYTES);
        if (per_cu < 1) { fprintf(stderr, "kernel_launch: occupancy query says %d blocks per CU\n", per_cu); per_cu = 1; }
        grid = cus * 1;
        (void)hipGetLastError();
    }
    if (grid < 0) return;
    (void)hipMemsetAsync((char*)d_ws + WS_BAR, 0, 16384, stream);
    Args a{};
    for (int i = 0; i < 11; ++i) a.in[i] = (const float*)d_in[i];
    a.out = (float*)d_out; a.ws = (unsigned char*)d_ws;
#if MK_MULTI
    for (int p = 0; p < NPHASE; ++p) { a.ph_lo = p; a.ph_hi = p + 1; hipLaunchKernelGGL(mk_fwd, dim3(grid), dim3(NWAVES * 64), LDS_BYTES, stream, a); }
#else
    a.ph_lo = 0; a.ph_hi = NPHASE;
    void* kargs[] = {&a};
    hipError_t e = hipLaunchCooperativeKernel((const void*)mk_fwd, dim3(grid), dim3(NWAVES * 64), kargs, LDS_BYTES, stream);
    if (e != hipSuccess) fprintf(stderr, "cooperative launch failed: %s (grid %d)\n", hipGetErrorString(e), grid);
#endif
}
```

```cpp
#include <hip/hip_runtime.h>
#include <hip/hip_cooperative_groups.h>
#include <stdint.h>
#include <math.h>
#include <cstdio>
namespace cg = cooperative_groups;
__device__ __forceinline__ int lane_id_v() { int l; asm volatile("v_mbcnt_lo_u32_b32 %0, -1, 0\n\tv_mbcnt_hi_u32_b32 %0, -1, %0" : "=v"(l)); return l; }
namespace pg8 {
#define PG8_LAS __attribute__((address_space(3)))
typedef unsigned short bf16_t;
typedef short bf16x8 __attribute__((ext_vector_type(8)));
typedef float f32x4 __attribute__((ext_vector_type(4)));
typedef unsigned u32x4 __attribute__((ext_vector_type(4)));
constexpr int BM = 256, BK = 64, HALF = 128, HTB = HALF * BK * 2  , STAGE_BYTES = 8 * HTB, NXCD = 8, WGM = 8;

__host__ __device__ __forceinline__ int lds_byte(int r, int c) { const int st = (r >> 4) * 2 + (c >> 5), rr = r & 15, cc = c & 31, ob = rr * 64 + cc * 2; return st * 1024 + (ob ^ (((ob >> 9) & 1) << 5)); }
__host__ __device__ __forceinline__ void stage_rc(int b, int& R, int& C) { const int st = b / 1024, sb = b % 1024, swz = sb ^ (((sb >> 9) & 1) << 5); R = (st >> 1) * 16 + swz / 64; C = (st & 1) * 32 + (swz % 64) / 2; }
__host__ __device__ __forceinline__ int perm32(int rho) { const int n = rho >> 4, i = rho & 15; return 8 * (i >> 2) + 4 * n + (i & 3); }

struct Unit { int pm, pn; };
struct Gemm { const bf16_t* A; const bf16_t* Bt; int M, N, K; };

struct StaticOrder {
    int nM, nN, nwg, G, c;
    __host__ __device__ void init(int M, int N, int G_, int c_) { nM = M / BM; nN = N / BM; nwg = nM * nN; G = G_; c = c_; }
    __host__ __device__ bool next(int i, Unit& u) const {
        const long L = (long)i * G + c; if (L >= nwg) return false;
        int wgid = (int)L; { const int q = nwg / NXCD, r = nwg % NXCD, xcd = wgid % NXCD, off = wgid / NXCD; wgid = (xcd < r ? xcd * (q + 1) : r * (q + 1) + (xcd - r) * q) + off; }
        const int nig = WGM * nN, gid = wgid / nig, fm = gid * WGM, gsz = (nM - fm) < WGM ? (nM - fm) : WGM;
        u.pm = fm + ((wgid % nig) % gsz); u.pn = (wgid % nig) / gsz; return true;
    }
    __device__ __forceinline__ void a_ready(const Unit&) const {}
    __device__ __forceinline__ void done(const Unit&) const {}
};

__device__ __forceinline__ unsigned cvt_pk_bf16(float lo, float hi) { unsigned r; asm volatile("v_cvt_pk_bf16_f32 %0, %1, %2" : "=v"(r) : "v"(lo), "v"(hi)); return r; }
typedef float f32x2 __attribute__((ext_vector_type(2)));
__device__ __forceinline__ f32x2 gelu_pk(f32x2 v) {
    const f32x2 av = __builtin_elementwise_abs(v), d = av * 0.2316418882f + 1.0f;
    f32x2 t; t.x = __builtin_amdgcn_rcpf(d.x); t.y = __builtin_amdgcn_rcpf(d.y);
    f32x2 q = t * 0.5307027145f + (-0.7265760135f); q = q * t + 0.7107068705f; q = q * t + (-0.142248368f); q = q * t + 0.127414796f; q = q * t;
    const f32x2 s = (v * v) * (-0.72134752044f);
    f32x2 e; e.x = __builtin_amdgcn_exp2f(s.x); e.y = __builtin_amdgcn_exp2f(s.y);
    const f32x2 m = v * (q * e), r = v - m;
    f32x2 o; o.x = v.x < 0.f ? m.x : r.x; o.y = v.y < 0.f ? m.y : r.y; return o;
}

template <int ACT  > struct EpiBf16 {
    static constexpr bool PERM = true, AFTER_DRAIN = false; static_assert(ACT == 0 || ACT == 1, "EpiBf16: ACT is 0 (none) or 1 (gelu_pk)");
    bf16_t* O; int ldc; const float* bias; int split_cols; size_t split_stride; float scale0;
    __device__ __forceinline__ void operator()(const f32x4 (&acc)[2][2][4][2], const Unit& u, int wr, int wc, int fr, int fq) const {
        const int row0 = u.pm * BM + wr * 64 + fr; int colt = u.pn * BM; bf16_t* base = O;
        float sc = 1.f; if (split_cols) { const int t = colt / split_cols; base += (size_t)t * split_stride; colt -= t * split_cols; if (t == 0) sc = scale0; }
        const int col0 = colt + wc * 32 + 8 * fq, bcol0 = u.pn * BM + wc * 32 + 8 * fq;
        f32x4 bv[2][2];
#pragma unroll
        for (int bj = 0; bj < 2; ++bj)
#pragma unroll
            for (int n = 0; n < 2; ++n) bv[bj][n] = bias ? *(const f32x4*)(bias + bcol0 + bj * HALF + 4 * n) : (f32x4){0.f, 0.f, 0.f, 0.f};
#pragma unroll
        for (int ai = 0; ai < 2; ++ai)
#pragma unroll
            for (int m = 0; m < 4; ++m) { bf16_t* rowp = base + (size_t)(row0 + ai * HALF + m * 16) * ldc + col0;
#pragma unroll
                for (int bj = 0; bj < 2; ++bj) { f32x4 v0 = acc[ai][bj][m][0] + bv[bj][0], v1 = acc[ai][bj][m][1] + bv[bj][1];
                    if (ACT == 1) { f32x2 a = gelu_pk((f32x2){v0[0], v0[1]}), b = gelu_pk((f32x2){v0[2], v0[3]}), c = gelu_pk((f32x2){v1[0], v1[1]}), d = gelu_pk((f32x2){v1[2], v1[3]});
                        v0 = (f32x4){a.x, a.y, b.x, b.y}; v1 = (f32x4){c.x, c.y, d.x, d.y}; }
                    v0 = v0 * sc; v1 = v1 * sc; u32x4 w; w.x = cvt_pk_bf16(v0[0], v0[1]); w.y = cvt_pk_bf16(v0[2], v0[3]); w.z = cvt_pk_bf16(v1[0], v1[1]); w.w = cvt_pk_bf16(v1[2], v1[3]);
                    *(u32x4*)(rowp + bj * HALF) = w; } }
    }
};
template <class Epi, class Sched, bool ALIGN_EPI = false, bool SP2 = false>
__device__ __forceinline__ void gemm_phase(PG8_LAS unsigned char* lds, const Gemm g, const Sched& S, const Epi& E, int wave_id) {
    int tid_ = wave_id * 64 + lane_id_v();
    const int tid = tid_, wid = __builtin_amdgcn_readfirstlane(tid >> 6), lane = tid & 63, wr = wid >> 2, wc = wid & 3, fr = lane & 15, fq = lane >> 4;
    const int K = g.K, nt = K / BK;
    unsigned voffA[2], voffB[2];
#pragma unroll
    for (int i = 0; i < 2; ++i) { int R, C; stage_rc(tid * 16 + i * 8192, R, C); const int Rb = Epi::PERM ? ((R & ~31) + perm32(R & 31)) : R;
        voffA[i] = (unsigned)(R * K + C) * 2u; voffB[i] = (unsigned)(Rb * K + C) * 2u; }
    const size_t kstep = (size_t)(BK * 2);
    const size_t hstep = (size_t)HALF * K * 2;
    const size_t tstep = 2 * hstep;
    const unsigned ldsw = (unsigned)wid * 1024u;
    const int aoff = lds_byte(wr * 64 + fr, fq * 8), boff = lds_byte(wc * 32 + fr, fq * 8);
#define PG8_SA(b, h) (((b) * 2 + (h)) * HTB)
#define PG8_SB(b, h) ((4 + (b) * 2 + (h)) * HTB)
#define PG8_STAGE(bufoff, gbase, voff) do { _Pragma("unroll") for (int _i = 0; _i < 2; ++_i) \
        __builtin_amdgcn_global_load_lds((const unsigned*)((const char*)(gbase) + (voff)[_i]), (PG8_LAS unsigned*)(lds + (bufoff) + ldsw + _i * 8192), 16, 0, 0); } while (0)
#define PG8_LDA(dst, b, h) do { _Pragma("unroll") for (int m = 0; m < 4; ++m) _Pragma("unroll") for (int k = 0; k < 2; ++k) dst[m][k] = *(const PG8_LAS bf16x8*)(lds + PG8_SA(b, h) + aoff + m * 2048 + k * 1024); } while (0)
#define PG8_LDB(dst, b, h) do { _Pragma("unroll") for (int n = 0; n < 2; ++n) _Pragma("unroll") for (int k = 0; k < 2; ++k) dst[n][k] = *(const PG8_LAS bf16x8*)(lds + PG8_SB(b, h) + boff + n * 2048 + k * 1024); } while (0)
#define PG8_MMA(ai, bj, At, Bt) do { __builtin_amdgcn_s_setprio(1); _Pragma("unroll") for (int m = 0; m < 4; ++m) _Pragma("unroll") for (int n = 0; n < 2; ++n) _Pragma("unroll") for (int k = 0; k < 2; ++k) \
        acc[ai][bj][m][n] = __builtin_amdgcn_mfma_f32_16x16x32_bf16(Bt[n][k], At[m][k], acc[ai][bj][m][n], 0, 0, 0); __builtin_amdgcn_s_setprio(0); } while (0)
#define PG8_WAIT_V(n) asm volatile("s_waitcnt vmcnt(" #n ")" ::: "memory")
#define PG8_WAIT_L(n) asm volatile("s_waitcnt lgkmcnt(" #n ")" ::: "memory")
#define PG8_BAR __builtin_amdgcn_s_barrier()
#define PG8_SCHED __builtin_amdgcn_sched_barrier(0)
    Unit cur, nxt; int ui = 0;
    if (!S.next(0, cur)) return;
    f32x4 acc[2][2][4][2];
#pragma unroll
    for (int a = 0; a < 2; ++a)
#pragma unroll
        for (int b = 0; b < 2; ++b)
#pragma unroll
            for (int m = 0; m < 4; ++m)
#pragma unroll
                for (int n = 0; n < 2; ++n) acc[a][b][m][n] = (f32x4){0.f, 0.f, 0.f, 0.f};
    bf16x8 At[4][2], B0[2][2], B1[2][2];
    const char* cA = (const char*)g.A + (size_t)cur.pm * tstep; const char* cB = (const char*)g.Bt + (size_t)cur.pn * tstep;
    S.a_ready(cur);
    if constexpr (SP2) {
        PG8_STAGE(PG8_SB(0, 0), cB, voffB); PG8_STAGE(PG8_SB(0, 1), cB + hstep, voffB); PG8_STAGE(PG8_SA(0, 0), cA, voffA); PG8_STAGE(PG8_SA(0, 1), cA + hstep, voffA);
        if (wr == 1) PG8_BAR;
        PG8_WAIT_V(2); PG8_BAR;
        PG8_STAGE(PG8_SB(1, 0), cB + kstep, voffB); PG8_STAGE(PG8_SA(1, 0), cA + kstep, voffA); PG8_STAGE(PG8_SB(1, 1), cB + hstep + kstep, voffB);
        PG8_WAIT_V(6); PG8_BAR;
    } else {
        PG8_STAGE(PG8_SB(0, 0), cB, voffB); PG8_STAGE(PG8_SA(0, 0), cA, voffA); PG8_STAGE(PG8_SB(0, 1), cB + hstep, voffB); PG8_STAGE(PG8_SA(0, 1), cA + hstep, voffA);
        if (wr == 1) PG8_BAR;
        PG8_WAIT_V(4); PG8_BAR;
        PG8_STAGE(PG8_SB(1, 0), cB + kstep, voffB); PG8_STAGE(PG8_SA(1, 0), cA + kstep, voffA); PG8_STAGE(PG8_SB(1, 1), cB + hstep + kstep, voffB);
        PG8_WAIT_V(6); PG8_BAR;
    }
    for (;;) {
        const bool has_next = S.next(ui + 1, nxt);
        const char* nA = has_next ? (const char*)g.A + (size_t)nxt.pm * tstep : cA; const char* nB = has_next ? (const char*)g.Bt + (size_t)nxt.pn * tstep : cB;
        for (int t = 0; t < nt; t += 2) {
            const bool last = (t == nt - 2);
            const char* a1 = cA + (size_t)(t + 1) * kstep;
            const char* a2 = last ? nA : cA + (size_t)(t + 2) * kstep; const char* b2 = last ? nB : cB + (size_t)(t + 2) * kstep;
            const char* a3 = a2 + kstep; const char* b3 = b2 + kstep;
            if (last && has_next) S.a_ready(nxt);
            if constexpr (SP2) {
            PG8_LDB(B0, 0, 0); PG8_LDB(B1, 0, 1); PG8_SCHED; PG8_LDA(At, 0, 0); PG8_STAGE(PG8_SA(1, 1), a1 + hstep, voffA);
            PG8_WAIT_V(8); PG8_WAIT_L(0); PG8_BAR; PG8_MMA(0, 0, At, B0); PG8_MMA(0, 1, At, B1); PG8_BAR; PG8_SCHED;
            PG8_LDA(At, 0, 1); PG8_STAGE(PG8_SB(0, 0), b2, voffB); PG8_STAGE(PG8_SB(0, 1), b2 + hstep, voffB); PG8_STAGE(PG8_SA(0, 0), a2, voffA);
            PG8_WAIT_V(8); PG8_WAIT_L(0); PG8_BAR; PG8_MMA(1, 0, At, B0); PG8_MMA(1, 1, At, B1); PG8_BAR; PG8_SCHED;
            PG8_LDB(B0, 1, 0); PG8_LDB(B1, 1, 1); PG8_SCHED; PG8_LDA(At, 1, 0); PG8_STAGE(PG8_SA(0, 1), a2 + hstep, voffA);
            PG8_WAIT_V(8); PG8_WAIT_L(0); PG8_BAR; PG8_MMA(0, 0, At, B0); PG8_MMA(0, 1, At, B1); PG8_BAR; PG8_SCHED;
            PG8_LDA(At, 1, 1); PG8_STAGE(PG8_SB(1, 0), b3, voffB); PG8_STAGE(PG8_SB(1, 1), b3 + hstep, voffB); PG8_STAGE(PG8_SA(1, 0), a3, voffA);
            PG8_WAIT_V(8); PG8_WAIT_L(0); PG8_BAR; PG8_MMA(1, 0, At, B0); PG8_MMA(1, 1, At, B1); PG8_BAR; PG8_SCHED;
            } else {
            PG8_LDB(B0, 0, 0); PG8_SCHED; PG8_LDA(At, 0, 0); PG8_STAGE(PG8_SA(1, 1), a1 + hstep, voffA);
            PG8_WAIT_L(8); PG8_BAR; PG8_WAIT_L(0); PG8_MMA(0, 0, At, B0); PG8_BAR; PG8_SCHED;
            PG8_LDB(B1, 0, 1); PG8_STAGE(PG8_SB(0, 0), b2, voffB);
            PG8_BAR; PG8_WAIT_L(0); PG8_MMA(0, 1, At, B1); PG8_BAR;
            PG8_LDA(At, 0, 1); PG8_STAGE(PG8_SA(0, 0), a2, voffA);
            PG8_BAR; PG8_WAIT_L(0); PG8_MMA(1, 0, At, B0); PG8_BAR; PG8_SCHED;
            PG8_STAGE(PG8_SB(0, 1), b2 + hstep, voffB);
            PG8_WAIT_V(6); PG8_BAR; PG8_MMA(1, 1, At, B1); PG8_BAR;
            PG8_LDB(B0, 1, 0); PG8_SCHED; PG8_LDA(At, 1, 0); PG8_STAGE(PG8_SA(0, 1), a2 + hstep, voffA);
            PG8_WAIT_L(8); PG8_BAR; PG8_WAIT_L(0); PG8_MMA(0, 0, At, B0); PG8_BAR; PG8_SCHED;
            PG8_LDB(B1, 1, 1); PG8_STAGE(PG8_SB(1, 0), b3, voffB);
            PG8_BAR; PG8_WAIT_L(0); PG8_MMA(0, 1, At, B1); PG8_BAR;
            PG8_LDA(At, 1, 1); PG8_STAGE(PG8_SA(1, 0), a3, voffA);
            PG8_BAR; PG8_WAIT_L(0); PG8_MMA(1, 0, At, B0); PG8_BAR; PG8_SCHED;
            PG8_STAGE(PG8_SB(1, 1), b3 + hstep, voffB);
            PG8_WAIT_V(6); PG8_BAR; PG8_MMA(1, 1, At, B1); PG8_BAR;
            }
        }
        if constexpr (ALIGN_EPI) { if (wr == 0) PG8_BAR; }
        if constexpr (!Epi::AFTER_DRAIN) { E(acc, cur, wr, wc, fr, fq); S.done(cur); }
        if (!has_next) break;
#pragma unroll
        for (int a = 0; a < 2; ++a)
#pragma unroll
            for (int b = 0; b < 2; ++b)
#pragma unroll
                for (int m = 0; m < 4; ++m)
#pragma unroll
                    for (int n = 0; n < 2; ++n) acc[a][b][m][n] = (f32x4){0.f, 0.f, 0.f, 0.f};
        cur = nxt; cA = nA; cB = nB; ++ui;
        if constexpr (ALIGN_EPI) { if (wr == 1) PG8_BAR; }
    }
    PG8_WAIT_V(0);
    if constexpr (!ALIGN_EPI) { if (wr == 0) PG8_BAR; }
    PG8_BAR;
    if constexpr (Epi::AFTER_DRAIN) { E.fused(acc, cur, wr, wc, fr, fq, lds, wid, lane); S.done(cur); }
#undef PG8_SA
#undef PG8_SB
#undef PG8_STAGE
#undef PG8_LDA
#undef PG8_LDB
#undef PG8_MMA
#undef PG8_WAIT_V
#undef PG8_WAIT_L
#undef PG8_BAR
#undef PG8_SCHED
}
}
typedef unsigned short bf16_t;
#define LAS __attribute__((address_space(3)))
#define GAS __attribute__((address_space(1)))
typedef unsigned v4u __attribute__((ext_vector_type(4)));
typedef unsigned v2u __attribute__((ext_vector_type(2)));
typedef float f32x4 __attribute__((ext_vector_type(4)));
constexpr int DM = 1024, NB = 32, SEQ = 2048, NTOK = NB * SEQ, NMEM = 256;
constexpr int LDP = 3328;
constexpr int C_SBQ = 0, C_SBK = 384, C_SBV = 768, C_SBG = 1152, C_DSQ = 1536, C_CKV = 1920, C_DSG = 2048,
              C_IDQ = 2432, C_IDK = 2688, C_IDW = 2720, C_MQ = 2728, C_MG = 2984, NCOL = 3240;
constexpr float EPS = 1e-6f;
constexpr size_t MiB = 1u << 20;
constexpr size_t WS_CTL = 0;
constexpr size_t WS_WIN = 1 * MiB;
constexpr size_t WS_WOUT = 14 * MiB;
constexpr size_t WS_WMEM = 18 * MiB;
constexpr size_t WS_MEMB = 20 * MiB;
constexpr size_t WS_MEMKV = 36 * MiB;
constexpr size_t WS_CKVN = 52 * MiB;
constexpr size_t WS_MASK = 68 * MiB;
constexpr size_t WS_H = 84 * MiB;
constexpr size_t WS_MIX = WS_H;
constexpr size_t WS_PROJ = 212 * MiB;
constexpr size_t WS_Y = WS_PROJ;
constexpr size_t WS_X1 = 628 * MiB;
constexpr size_t WS_END = 756 * MiB;
constexpr int LDS_BYTES = 135168;
constexpr int NWAVES = 8;

__device__ __forceinline__ float bf2f(bf16_t v) { return __uint_as_float(((unsigned)v) << 16); }
__device__ __forceinline__ unsigned f2bf(float f) { unsigned u = __float_as_uint(f); u += 0x7fffu + ((u >> 16) & 1u); return u >> 16; }
__device__ __forceinline__ unsigned pk2(float lo, float hi) { return f2bf(lo) | (f2bf(hi) << 16); }
#define WAVE_SYNC() do { asm volatile("s_waitcnt lgkmcnt(0)" ::: "memory"); __builtin_amdgcn_wave_barrier(); } while (0)
template <int CTRL> __device__ __forceinline__ float dpp_f(float v) { return __uint_as_float((unsigned)__builtin_amdgcn_update_dpp(0, (int)__float_as_uint(v), CTRL, 0xF, 0xF, true)); }
__device__ __forceinline__ float row16_sum(float v) {
    v += dpp_f<0xB1>(v);
    v += dpp_f<0x4E>(v);
    v += dpp_f<0x141>(v);
    v += dpp_f<0x140>(v);
    return v;
}
__device__ __forceinline__ float wave_sum(float v) {
    v = row16_sum(v);
    v += __uint_as_float((unsigned)__builtin_amdgcn_ds_swizzle((int)__float_as_uint(v), 0x401F));
    auto rr = __builtin_amdgcn_permlane32_swap(__float_as_uint(v), __float_as_uint(v), false, false);
    return __uint_as_float(rr[0]) + __uint_as_float(rr[1]);
}

__device__ const unsigned char T5TAB[128] = {0, 1, 2, 3, 4, 5, 6, 7, 8, 9, 10, 11, 12, 13, 14, 15, 16, 16, 16, 17, 17, 18, 18, 18, 19, 19, 19, 20, 20, 20, 20, 21, 21, 21, 21, 22, 22, 22, 22, 22, 23, 23, 23, 23, 23, 23, 24, 24, 24, 24, 24, 24, 25, 25, 25, 25, 25, 25, 25, 26, 26, 26, 26, 26, 26, 26, 26, 27, 27, 27, 27, 27, 27, 27, 27, 27, 27, 28, 28, 28, 28, 28, 28, 28, 28, 28, 28, 29, 29, 29, 29, 29, 29, 29, 29, 29, 29, 29, 29, 30, 30, 30, 30, 30, 30, 30, 30, 30, 30, 30, 30, 30, 30, 31, 31, 31, 31, 31, 31, 31, 31, 31, 31, 31, 31, 31, 31, 31};

struct Args { const float* in[11]; float* out; unsigned char* ws; int ph_lo, ph_hi; };

__device__ __forceinline__ void p0_transpose_item(const float* W, int K, int N, int Npad, bf16_t* WT, const float* g, LAS float* scr, int item, int lane) {
    const int nblk = Npad / 32, kb = item / nblk, nb = item % nblk, k0 = 64 * kb, n0 = 32 * nb;
    const int nn = n0 + (lane & 31);
#pragma unroll 8
    for (int i = 0; i < 32; ++i) { const int kk = 2 * i + (lane >> 5); float v = (nn < N) ? W[(size_t)(k0 + kk) * N + nn] : 0.f; if (g) v *= g[k0 + kk]; scr[kk * 33 + (lane & 31)] = v; }
    WAVE_SYNC();
    const int c = lane & 7;
#pragma unroll
    for (int j = 0; j < 4; ++j) { const int n = (lane >> 3) + 8 * j; const LAS float* s = scr + (8 * c) * 33 + n;
        v4u o; o.x = pk2(s[0 * 33], s[1 * 33]); o.y = pk2(s[2 * 33], s[3 * 33]); o.z = pk2(s[4 * 33], s[5 * 33]); o.w = pk2(s[6 * 33], s[7 * 33]);
        *(v4u*)(WT + (size_t)(n0 + n) * K + k0 + 8 * c) = o; }
    WAVE_SYNC();
}
template <bool NORM> __device__ __forceinline__ void row_to_bf16(const float* xrow, bf16_t* orow, int lane) {
    const f32x4* xr = (const f32x4*)xrow + lane;
    f32x4 v[4]; float s = 0.f;
#pragma unroll
    for (int j = 0; j < 4; ++j) { v[j] = xr[64 * j]; s += (v[j].x * v[j].x + v[j].y * v[j].y) + (v[j].z * v[j].z + v[j].w * v[j].w); }
    float r = 1.f;
    if (NORM) r = 1.0f / sqrtf(wave_sum(s) * (1.f / DM) + EPS);
    v2u* o8 = (v2u*)orow + lane;
#pragma unroll
    for (int j = 0; j < 4; ++j) { v2u w; w.x = pk2(v[j].x * r, v[j].y * r); w.y = pk2(v[j].z * r, v[j].w * r); o8[64 * j] = w; }
}

__device__ __forceinline__ void ckvnorm4(const bf16_t* PROJ, const float* kvg, bf16_t* CKVN, int row0, int lane) {
    const int row = row0 + (lane >> 4), c8 = (lane & 15) * 8;
    const v4u v = *(const v4u*)(PROJ + (size_t)row * LDP + C_CKV + c8);
    float f[8] = {__uint_as_float(v.x << 16), __uint_as_float(v.x & 0xffff0000u), __uint_as_float(v.y << 16), __uint_as_float(v.y & 0xffff0000u),
                  __uint_as_float(v.z << 16), __uint_as_float(v.z & 0xffff0000u), __uint_as_float(v.w << 16), __uint_as_float(v.w & 0xffff0000u)};
    float s = 0.f;
#pragma unroll
    for (int j = 0; j < 8; ++j) s += f[j] * f[j];
    s = row16_sum(s);
    const float r = 1.0f / sqrtf(s * (1.0f / 128.f) + EPS);
    const f32x4 g0 = *(const f32x4*)(kvg + c8), g1 = *(const f32x4*)(kvg + c8 + 4);
    v4u o; o.x = pk2(f[0] * r * g0.x, f[1] * r * g0.y); o.y = pk2(f[2] * r * g0.z, f[3] * r * g0.w); o.z = pk2(f[4] * r * g1.x, f[5] * r * g1.y); o.w = pk2(f[6] * r * g1.z, f[7] * r * g1.w);
    *(v4u*)(CKVN + (size_t)row * 128 + c8) = o;
}
__device__ __forceinline__ unsigned ordkey(float f) { unsigned u = __float_as_uint(f); return (u & 0x80000000u) ? ~u : (u | 0x80000000u); }
template <bool L0> __device__ __forceinline__ void post_row(const float* xin, const bf16_t* Y, const float* g, float* xout, bf16_t* X1b, bf16_t* Hn, int row, int lane) {
    const bf16_t* yp = Y + (size_t)row * DM;
    float yv[16]; float s = 0.f;
#pragma unroll
    for (int j = 0; j < 4; ++j) {
        const v2u v = *(const v2u*)(yp + (lane + 64 * j) * 4);
        yv[4 * j + 0] = __uint_as_float(v.x << 16); yv[4 * j + 1] = __uint_as_float(v.x & 0xffff0000u);
        yv[4 * j + 2] = __uint_as_float(v.y << 16); yv[4 * j + 3] = __uint_as_float(v.y & 0xffff0000u);
        s += yv[4 * j] * yv[4 * j] + yv[4 * j + 1] * yv[4 * j + 1] + yv[4 * j + 2] * yv[4 * j + 2] + yv[4 * j + 3] * yv[4 * j + 3];
    }
    const float r = 1.0f / sqrtf(wave_sum(s) * (1.0f / DM) + EPS);
    f32x4 ov[4]; float s2 = 0.f;
#pragma unroll
    for (int j = 0; j < 4; ++j) {
        const int c = (lane + 64 * j) * 4;
        f32x4 xv;
        if (L0) xv = *(const f32x4*)(xin + (size_t)row * DM + c);
        else { const v2u xb = *(const v2u*)(X1b + (size_t)row * DM + c); xv.x = __uint_as_float(xb.x << 16); xv.y = __uint_as_float(xb.x & 0xffff0000u); xv.z = __uint_as_float(xb.y << 16); xv.w = __uint_as_float(xb.y & 0xffff0000u); }
        const f32x4 gv = *(const f32x4*)(g + c);
        ov[j].x = xv.x + yv[4 * j] * r * gv.x; ov[j].y = xv.y + yv[4 * j + 1] * r * gv.y; ov[j].z = xv.z + yv[4 * j + 2] * r * gv.z; ov[j].w = xv.w + yv[4 * j + 3] * r * gv.w;
        if (L0) { v2u w; w.x = pk2(ov[j].x, ov[j].y); w.y = pk2(ov[j].z, ov[j].w); *(v2u*)(X1b + (size_t)row * DM + c) = w; }
        else *(f32x4*)(xout + (size_t)row * DM + c) = ov[j];
        s2 += (ov[j].x * ov[j].x + ov[j].y * ov[j].y) + (ov[j].z * ov[j].z + ov[j].w * ov[j].w);
    }
    if (Hn) {
        const float r2 = 1.0f / sqrtf(wave_sum(s2) * (1.f / DM) + EPS);
        v2u* o8 = (v2u*)(Hn + (size_t)row * DM) + lane;
#pragma unroll
        for (int j = 0; j < 4; ++j) { v2u w; w.x = pk2(ov[j].x * r2, ov[j].y * r2); w.y = pk2(ov[j].z * r2, ov[j].w * r2); o8[64 * j] = w; }
    }
}
template <bool L0> __device__ __forceinline__ void post_rows2(const float* xin, const bf16_t* Y, const float* g, float* xout, bf16_t* X1b, bf16_t* Hn, int row, int lane) {
    v2u yq[2][4], xb[2][4]; f32x4 xf[2][4], gq[4];
#pragma unroll
    for (int q = 0; q < 2; ++q)
#pragma unroll
        for (int j = 0; j < 4; ++j) {
            const int c = (lane + 64 * j) * 4;
            yq[q][j] = *(const v2u*)(Y + (size_t)(row + q) * DM + c);
            if (L0) xf[q][j] = *(const f32x4*)(xin + (size_t)(row + q) * DM + c);
            else xb[q][j] = *(const v2u*)(X1b + (size_t)(row + q) * DM + c);
        }
#pragma unroll
    for (int j = 0; j < 4; ++j) gq[j] = *(const f32x4*)(g + (lane + 64 * j) * 4);
    if (L0) asm volatile("" : "+v"(yq[0][0]), "+v"(yq[0][1]), "+v"(yq[0][2]), "+v"(yq[0][3]), "+v"(yq[1][0]), "+v"(yq[1][1]), "+v"(yq[1][2]), "+v"(yq[1][3]),
                              "+v"(xf[0][0]), "+v"(xf[0][1]), "+v"(xf[0][2]), "+v"(xf[0][3]), "+v"(xf[1][0]), "+v"(xf[1][1]), "+v"(xf[1][2]), "+v"(xf[1][3]),
                              "+v"(gq[0]), "+v"(gq[1]), "+v"(gq[2]), "+v"(gq[3]));
    else asm volatile("" : "+v"(yq[0][0]), "+v"(yq[0][1]), "+v"(yq[0][2]), "+v"(yq[0][3]), "+v"(yq[1][0]), "+v"(yq[1][1]), "+v"(yq[1][2]), "+v"(yq[1][3]),
                           "+v"(xb[0][0]), "+v"(xb[0][1]), "+v"(xb[0][2]), "+v"(xb[0][3]), "+v"(xb[1][0]), "+v"(xb[1][1]), "+v"(xb[1][2]), "+v"(xb[1][3]),
                           "+v"(gq[0]), "+v"(gq[1]), "+v"(gq[2]), "+v"(gq[3]));
#pragma unroll
    for (int q = 0; q < 2; ++q) {
        float yv[16]; float s = 0.f;
#pragma unroll
        for (int j = 0; j < 4; ++j) {
            const v2u v = yq[q][j];
            yv[4 * j + 0] = __uint_as_float(v.x << 16); yv[4 * j + 1] = __uint_as_float(v.x & 0xffff0000u);
            yv[4 * j + 2] = __uint_as_float(v.y << 16); yv[4 * j + 3] = __uint_as_float(v.y & 0xffff0000u);
            s += yv[4 * j] * yv[4 * j] + yv[4 * j + 1] * yv[4 * j + 1] + yv[4 * j + 2] * yv[4 * j + 2] + yv[4 * j + 3] * yv[4 * j + 3];
        }
        const float r = 1.0f / sqrtf(wave_sum(s) * (1.0f / DM) + EPS);
        f32x4 ov[4]; float s2 = 0.f;
#pragma unroll
        for (int j = 0; j < 4; ++j) {
            const int c = (lane + 64 * j) * 4;
            f32x4 xv;
            if (L0) xv = xf[q][j];
            else { const v2u b2 = xb[q][j]; xv.x = __uint_as_float(b2.x << 16); xv.y = __uint_as_float(b2.x & 0xffff0000u); xv.z = __uint_as_float(b2.y << 16); xv.w = __uint_as_float(b2.y & 0xffff0000u); }
            const f32x4 gv = gq[j];
            ov[j].x = xv.x + yv[4 * j] * r * gv.x; ov[j].y = xv.y + yv[4 * j + 1] * r * gv.y; ov[j].z = xv.z + yv[4 * j + 2] * r * gv.z; ov[j].w = xv.w + yv[4 * j + 3] * r * gv.w;
            if (L0) { v2u w; w.x = pk2(ov[j].x, ov[j].y); w.y = pk2(ov[j].z, ov[j].w); *(v2u*)(X1b + (size_t)(row + q) * DM + c) = w; }
            else *(f32x4*)(xout + (size_t)(row + q) * DM + c) = ov[j];
            s2 += (ov[j].x * ov[j].x + ov[j].y * ov[j].y) + (ov[j].z * ov[j].z + ov[j].w * ov[j].w);
        }
        if (Hn) {
            const float r2 = 1.0f / sqrtf(wave_sum(s2) * (1.f / DM) + EPS);
            v2u* o8 = (v2u*)(Hn + (size_t)(row + q) * DM) + lane;
#pragma unroll
            for (int j = 0; j < 4; ++j) { v2u w; w.x = pk2(ov[j].x * r2, ov[j].y * r2); w.y = pk2(ov[j].z * r2, ov[j].w * r2); o8[64 * j] = w; }
        }
    }
}
__device__ __forceinline__ void rows2_norm_bf16(const float* xrow, bf16_t* orow, int lane) {
    f32x4 v[2][4];
#pragma unroll
    for (int q = 0; q < 2; ++q)
#pragma unroll
        for (int j = 0; j < 4; ++j) v[q][j] = ((const f32x4*)(xrow + (size_t)q * DM) + lane)[64 * j];
    asm volatile("" : "+v"(v[0][0]), "+v"(v[0][1]), "+v"(v[0][2]), "+v"(v[0][3]), "+v"(v[1][0]), "+v"(v[1][1]), "+v"(v[1][2]), "+v"(v[1][3]));
#pragma unroll
    for (int q = 0; q < 2; ++q) {
        float s = 0.f;
#pragma unroll
        for (int j = 0; j < 4; ++j) s += (v[q][j].x * v[q][j].x + v[q][j].y * v[q][j].y) + (v[q][j].z * v[q][j].z + v[q][j].w * v[q][j].w);
        const float r = 1.0f / sqrtf(wave_sum(s) * (1.f / DM) + EPS);
        v2u* o8 = (v2u*)(orow + (size_t)q * DM) + lane;
#pragma unroll
        for (int j = 0; j < 4; ++j) { v2u w; w.x = pk2(v[q][j].x * r, v[q][j].y * r); w.y = pk2(v[q][j].z * r, v[q][j].w * r); o8[64 * j] = w; }
    }
}

typedef short bf16x8 __attribute__((ext_vector_type(8)));
typedef short s16x4 __attribute__((ext_vector_type(4)));
typedef float f32x16 __attribute__((ext_vector_type(16)));
typedef float f32x2_t __attribute__((ext_vector_type(2)));
typedef __bf16 bf16x2_t __attribute__((ext_vector_type(2)));
#define MFMA32(a, b, c) __builtin_amdgcn_mfma_f32_32x32x16_bf16((a), (b), (c), 0, 0, 0)
__device__ __forceinline__ unsigned cvtpk(float lo, float hi) { f32x2_t v = {lo, hi}; bf16x2_t b = __builtin_convertvector(v, bf16x2_t); return __builtin_bit_cast(unsigned, b); }
__device__ __forceinline__ s16x4 vtr(const LAS unsigned char* p) { return __builtin_bit_cast(s16x4, __builtin_amdgcn_ds_read_tr16_b64_v4i16((LAS s16x4*)p)); }
__device__ __forceinline__ int crow(int r, int hi) { return (r & 3) + 8 * (r >> 2) + 4 * hi; }
__device__ __forceinline__ bf16x8 pack8(const f32x16& x, int s) {
    v4u p; p.x = cvtpk(x[8 * s + 0], x[8 * s + 1]); p.y = cvtpk(x[8 * s + 2], x[8 * s + 3]); p.z = cvtpk(x[8 * s + 4], x[8 * s + 5]); p.w = cvtpk(x[8 * s + 6], x[8 * s + 7]);
    return __builtin_bit_cast(bf16x8, p);
}
__device__ __forceinline__ f32x16 zero16() { float z; asm volatile("v_mov_b32 %0, 0" : "=v"(z)); return (f32x16){z, z, z, z, z, z, z, z, z, z, z, z, z, z, z, z}; }
__device__ __forceinline__ bf16x8 cat44(s16x4 lo, s16x4 hi) { return __builtin_shufflevector(lo, hi, 0, 1, 2, 3, 4, 5, 6, 7); }
__device__ __forceinline__ float xhalf_max(float v) { auto rr = __builtin_amdgcn_permlane32_swap(__float_as_uint(v), __float_as_uint(v), false, false); return fmaxf(__uint_as_float(rr[0]), __uint_as_float(rr[1])); }
__device__ __forceinline__ float xhalf_sum(float v) { auto rr = __builtin_amdgcn_permlane32_swap(__float_as_uint(v), __float_as_uint(v), false, false); return __uint_as_float(rr[0]) + __uint_as_float(rr[1]); }
__device__ __forceinline__ unsigned xhalf_other_u(unsigned v, int hi) { auto rr = __builtin_amdgcn_permlane32_swap(v, v, false, false); return hi ? rr[0] : rr[1]; }
__device__ __forceinline__ float xhalf_other(float v, int hi) { return __uint_as_float(xhalf_other_u(__float_as_uint(v), hi)); }
constexpr int VT_PITCH = 192;
constexpr float LOG2E = 1.4426950408889634f;

__device__ __forceinline__ void pv_tile(f32x16 (&O)[2], const LAS unsigned char* vrd, bf16x8 p0, bf16x8 p1) {
#pragma unroll
    for (int c = 0; c < 2; ++c) {
        const bf16x8 a0 = cat44(vtr(vrd + 0 * VT_PITCH + 64 * c), vtr(vrd + 8 * VT_PITCH + 64 * c));
        const bf16x8 a1 = cat44(vtr(vrd + 16 * VT_PITCH + 64 * c), vtr(vrd + 24 * VT_PITCH + 64 * c));
        O[c] = MFMA32(a0, p0, O[c]);
        O[c] = MFMA32(a1, p1, O[c]);
    }
}
__device__ __forceinline__ void gate_store(const f32x16 (&O)[2], float scale, const bf16_t* grow, bf16_t* orow, int hi) {
#pragma unroll
    for (int c = 0; c < 2; ++c)
#pragma unroll
        for (int g = 0; g < 4; ++g) {
            const int d = 32 * c + 8 * g + 4 * hi;
            const v2u gv = *(const v2u*)(grow + d);
            float gt[4] = {__uint_as_float(gv.x << 16), __uint_as_float(gv.x & 0xffff0000u), __uint_as_float(gv.y << 16), __uint_as_float(gv.y & 0xffff0000u)};
            float ov[4];
#pragma unroll
            for (int j = 0; j < 4; ++j) ov[j] = O[c][4 * g + j] * scale * gt[j] * __builtin_amdgcn_rcpf(1.f + __builtin_amdgcn_exp2f(-gt[j] * LOG2E));
            v2u w; w.x = cvtpk(ov[0], ov[1]); w.y = cvtpk(ov[2], ov[3]);
            *(v2u*)(orow + d) = w;
        }
}

__device__ __forceinline__ void gate_load(v2u (&gw)[8], const bf16_t* grow, int hi) {
#pragma unroll
    for (int c = 0; c < 2; ++c)
#pragma unroll
        for (int g = 0; g < 4; ++g) gw[c * 4 + g] = *(const v2u*)(grow + 32 * c + 8 * g + 4 * hi);
}
__device__ __forceinline__ void gate_store_pre(const f32x16 (&O)[2], float scale, const v2u (&gw)[8], bf16_t* orow, int hi) {
#pragma unroll
    for (int c = 0; c < 2; ++c)
#pragma unroll
        for (int g = 0; g < 4; ++g) {
            const int d = 32 * c + 8 * g + 4 * hi;
            const v2u gv = gw[c * 4 + g];
            float gt[4] = {__uint_as_float(gv.x << 16), __uint_as_float(gv.x & 0xffff0000u), __uint_as_float(gv.y << 16), __uint_as_float(gv.y & 0xffff0000u)};
            float ov[4];
#pragma unroll
            for (int j = 0; j < 4; ++j) ov[j] = O[c][4 * g + j] * scale * gt[j] * __builtin_amdgcn_rcpf(1.f + __builtin_amdgcn_exp2f(-gt[j] * LOG2E));
            v2u w; w.x = cvtpk(ov[0], ov[1]); w.y = cvtpk(ov[2], ov[3]);
            *(v2u*)(orow + d) = w;
        }
}

__device__ __forceinline__ void sb_item(const bf16_t* PROJ, bf16_t* MIX, int b, int h, int qt, int lane, LAS unsigned char* wl) {
    asm volatile("" : "+v"(lane));
    const int r32 = lane & 31, hi = lane >> 5;
    const bf16_t* base = PROJ + (size_t)b * SEQ * LDP;
    const int t = 32 * qt + r32;
    bf16x8 qf[4];
#pragma unroll
    for (int ks = 0; ks < 4; ++ks) qf[ks] = *(const bf16x8*)(base + (size_t)t * LDP + C_SBQ + h * 64 + 16 * ks + 8 * hi);
    v2u gw[8]; gate_load(gw, base + (size_t)t * LDP + C_SBG + h * 64, hi);
    const int vrow = lane >> 3, vch = lane & 7;
    LAS unsigned char* vwr = wl + vrow * VT_PITCH + vch * 16;
    const LAS unsigned char* vrd = wl + (4 * hi + ((lane & 15) >> 2)) * VT_PITCH + (16 * ((lane >> 4) & 1) + 4 * (lane & 3)) * 2;
    bf16x8 kc[4], vc[4];
    {
        const bf16_t* kp = base + (size_t)(32 * qt + r32) * LDP + C_SBK + h * 64 + 8 * hi;
#pragma unroll
        for (int ks = 0; ks < 4; ++ks) kc[ks] = *(const bf16x8*)(kp + 16 * ks);
        const bf16_t* vp = base + (size_t)(32 * qt + vrow) * LDP + C_SBV + h * 64 + 8 * vch;
#pragma unroll
        for (int i = 0; i < 4; ++i) vc[i] = *(const bf16x8*)(vp + (size_t)(8 * i) * LDP);
    }
    f32x16 O[2];
#pragma unroll
    for (int r = 0; r < 16; ++r) { O[0][r] = 0.f; O[1][r] = 0.f; }
    float R = 1.f;
    for (int kt = qt; kt >= 0; --kt) {
        bf16x8 kn[4], vn[4];
        {
            const int ktn = kt > 0 ? kt - 1 : 0;
            const bf16_t* kp = base + (size_t)(32 * ktn + r32) * LDP + C_SBK + h * 64 + 8 * hi;
#pragma unroll
            for (int ks = 0; ks < 4; ++ks) kn[ks] = *(const bf16x8*)(kp + 16 * ks);
            const bf16_t* vp = base + (size_t)(32 * ktn + vrow) * LDP + C_SBV + h * 64 + 8 * vch;
#pragma unroll
            for (int i = 0; i < 4; ++i) vn[i] = *(const bf16x8*)(vp + (size_t)(8 * i) * LDP);
        }
        f32x16 acc;
#pragma unroll
        for (int r = 0; r < 16; ++r) acc[r] = 0.f;
#pragma unroll
        for (int ks = 0; ks < 4; ++ks) acc = MFMA32(kc[ks], qf[ks], acc);
#pragma unroll
        for (int i = 0; i < 4; ++i) *(LAS bf16x8*)(vwr + (8 * i) * VT_PITCH) = vc[i];
        float be[16], om[16];
        const bool diag = (kt == qt);
#pragma unroll
        for (int r = 0; r < 16; ++r) {
            const float e = __builtin_amdgcn_exp2f(fminf(acc[r] * (-0.125f * LOG2E), 115.f));
            float bt = __builtin_amdgcn_rcpf(1.f + e), o1 = e * bt;
            if (diag && !(crow(r, hi) < r32)) { bt = 0.f; o1 = 1.f; }
            be[r] = bt; om[r] = o1;
        }
        float Gp[4], Gq[4];
#pragma unroll
        for (int g = 0; g < 4; ++g) { Gp[g] = (om[4 * g] * om[4 * g + 1]) * (om[4 * g + 2] * om[4 * g + 3]); Gq[g] = xhalf_other(Gp[g], hi); }
        const float T1 = Gp[1] * Gq[1], T2 = Gp[2] * Gq[2], T3 = Gp[3] * Gq[3], T0 = Gp[0] * Gq[0];
        float tail[4]; tail[3] = R; tail[2] = R * T3; tail[1] = tail[2] * T2; tail[0] = tail[1] * T1;
        const float Rn = tail[0] * T0;
#pragma unroll
        for (int g = 0; g < 4; ++g) {
            float sfx = tail[g] * (hi == 0 ? Gq[g] : 1.f);
            acc[4 * g + 3] = be[4 * g + 3] * sfx; sfx *= om[4 * g + 3];
            acc[4 * g + 2] = be[4 * g + 2] * sfx; sfx *= om[4 * g + 2];
            acc[4 * g + 1] = be[4 * g + 1] * sfx; sfx *= om[4 * g + 1];
            acc[4 * g + 0] = be[4 * g + 0] * sfx;
        }
        R = Rn;
        const bf16x8 p0 = pack8(acc, 0), p1 = pack8(acc, 1);
        pv_tile(O, vrd, p0, p1);
        if (__all(R < 5.4210109e-20f)) break;
#pragma unroll
        for (int i = 0; i < 4; ++i) { kc[i] = kn[i]; vc[i] = vn[i]; }
    }
    gate_store_pre(O, 1.f, gw, MIX + ((size_t)b * SEQ + t) * DM + h * 64, hi);
}

__device__ __forceinline__ void mem_item(const bf16_t* PROJ, const bf16_t* KV, bf16_t* MIX, int b, int h, int qt, int lane, LAS unsigned char* wl) {
    asm volatile("" : "+v"(lane));
    float NINF; asm volatile("v_mov_b32 %0, 0xff800000" : "=v"(NINF));
    const int r32 = lane & 31, hi = lane >> 5;
    const int t = 32 * qt + r32;
    const bf16_t* prow = PROJ + ((size_t)b * SEQ + t) * LDP;
    bf16x8 qf[4];
#pragma unroll
    for (int ks = 0; ks < 4; ++ks) qf[ks] = *(const bf16x8*)(prow + C_MQ + h * 64 + 16 * ks + 8 * hi);
    const int vrow = lane >> 3, vch = lane & 7;
    LAS unsigned char* vwr = wl + vrow * VT_PITCH + vch * 16;
    const LAS unsigned char* vrd = wl + (4 * hi + ((lane & 15) >> 2)) * VT_PITCH + (16 * ((lane >> 4) & 1) + 4 * (lane & 3)) * 2;
    const bf16_t* kvb = KV + (size_t)b * NMEM * 1024 + h * 64;
    f32x16 O[2];
#pragma unroll
    for (int r = 0; r < 16; ++r) { O[0][r] = 0.f; O[1][r] = 0.f; }
    float mrun = NINF, lrun = 0.f;
    v2u gw[8]; gate_load(gw, prow + C_MG + h * 64, hi);
    bf16x8 kc[4], vc[4];
    {
        const bf16_t* kp = kvb + (size_t)r32 * 1024 + 8 * hi;
#pragma unroll
        for (int ks = 0; ks < 4; ++ks) kc[ks] = *(const bf16x8*)(kp + 16 * ks);
        const bf16_t* vp = kvb + (size_t)vrow * 1024 + 256 + 8 * vch;
#pragma unroll
        for (int i = 0; i < 4; ++i) vc[i] = *(const bf16x8*)(vp + (size_t)(8 * i) * 1024);
    }
    for (int kt = 0; kt < NMEM / 32; ++kt) {
        bf16x8 kn[4], vn[4];
        {
            const int ktn = kt < NMEM / 32 - 1 ? kt + 1 : kt;
            const bf16_t* kp = kvb + (size_t)(32 * ktn + r32) * 1024 + 8 * hi;
#pragma unroll
            for (int ks = 0; ks < 4; ++ks) kn[ks] = *(const bf16x8*)(kp + 16 * ks);
            const bf16_t* vp = kvb + (size_t)(32 * ktn + vrow) * 1024 + 256 + 8 * vch;
#pragma unroll
            for (int i = 0; i < 4; ++i) vn[i] = *(const bf16x8*)(vp + (size_t)(8 * i) * 1024);
        }
        f32x16 acc;
#pragma unroll
        for (int r = 0; r < 16; ++r) acc[r] = 0.f;
#pragma unroll
        for (int ks = 0; ks < 4; ++ks) acc = MFMA32(kc[ks], qf[ks], acc);
#pragma unroll
        for (int i = 0; i < 4; ++i) *(LAS bf16x8*)(vwr + (8 * i) * VT_PITCH) = vc[i];
        float mx = acc[0];
#pragma unroll
        for (int r = 1; r < 16; ++r) mx = fmaxf(mx, acc[r]);
        mx *= 0.125f * LOG2E;
        mx = xhalf_max(mx);
        const float mn = fmaxf(mrun, mx), alpha = __builtin_amdgcn_exp2f(mrun - mn);
        float ps = 0.f;
#pragma unroll
        for (int r = 0; r < 16; ++r) { acc[r] = __builtin_amdgcn_exp2f(acc[r] * (0.125f * LOG2E) - mn); ps += acc[r]; }
        lrun = lrun * alpha + ps; mrun = mn;
#pragma unroll
        for (int r = 0; r < 16; ++r) { O[0][r] *= alpha; O[1][r] *= alpha; }
        const bf16x8 p0 = pack8(acc, 0), p1 = pack8(acc, 1);
        pv_tile(O, vrd, p0, p1);
#pragma unroll
        for (int i = 0; i < 4; ++i) { kc[i] = kn[i]; vc[i] = vn[i]; }
    }
    const float lt = xhalf_sum(lrun);
    gate_store_pre(O, 1.f / lt, gw, MIX + ((size_t)b * SEQ + t) * DM + 768 + h * 64, hi);
}

constexpr int MEML_V_OFF = 32768;
__device__ __forceinline__ void mem_stage(const bf16_t* KV, int b, int h, int tid, LAS unsigned char* L) {
    const bf16_t* kvb = KV + (size_t)b * NMEM * 1024 + h * 64;
#pragma unroll
    for (int i = 0; i < 4; ++i) {
        const int idx = tid + 512 * i, key = idx >> 3, ch = idx & 7;
        const v4u kx = *(const v4u*)(kvb + (size_t)key * 1024 + 8 * ch), vx = *(const v4u*)(kvb + (size_t)key * 1024 + 256 + 8 * ch);
        *(LAS v4u*)(L + 128 * key + 16 * (ch ^ ((key >> 1) & 7))) = kx;
        *(LAS v4u*)(L + MEML_V_OFF + (key >> 5) * (32 * VT_PITCH) + (key & 31) * VT_PITCH + 16 * ch) = vx;
    }
}
__device__ __forceinline__ void mem_item_lds(const bf16_t* PROJ, bf16_t* MIX, int b, int h, int qt, int lane, const LAS unsigned char* L) {
    asm volatile("" : "+v"(lane));
    float NINF; asm volatile("v_mov_b32 %0, 0xff800000" : "=v"(NINF));
    const int r32 = lane & 31, hi = lane >> 5;
    const int t = 32 * qt + r32;
    const bf16_t* prow = PROJ + ((size_t)b * SEQ + t) * LDP;
    bf16x8 qf[4];
#pragma unroll
    for (int ks = 0; ks < 4; ++ks) qf[ks] = *(const bf16x8*)(prow + C_MQ + h * 64 + 16 * ks + 8 * hi);
    v2u gw[8]; gate_load(gw, prow + C_MG + h * 64, hi);
    const unsigned kx = ((unsigned)r32 >> 1) & 7u;
    const LAS unsigned char* krd = L + 128 * r32;
    const LAS unsigned char* vrd = L + MEML_V_OFF + (4 * hi + ((lane & 15) >> 2)) * VT_PITCH + (16 * ((lane >> 4) & 1) + 4 * (lane & 3)) * 2;
    f32x16 O[2];
    O[0] = zero16(); O[1] = zero16();
    float mrun = NINF, lrun = 0.f;
#pragma unroll 2
    for (int kt = 0; kt < NMEM / 32; ++kt) {
        bf16x8 kc[4];
#pragma unroll
        for (int ks = 0; ks < 4; ++ks) kc[ks] = *(const LAS bf16x8*)(krd + 4096 * kt + 16 * ((unsigned)(2 * ks + hi) ^ kx));
        f32x16 acc;
#pragma unroll
        for (int r = 0; r < 16; ++r) acc[r] = 0.f;
#pragma unroll
        for (int ks = 0; ks < 4; ++ks) acc = MFMA32(kc[ks], qf[ks], acc);
        float mx = acc[0];
#pragma unroll
        for (int r = 1; r < 16; ++r) mx = fmaxf(mx, acc[r]);
        mx *= 0.125f * LOG2E;
        mx = xhalf_max(mx);
        const float mn = fmaxf(mrun, mx), alpha = __builtin_amdgcn_exp2f(mrun - mn);
        float ps = 0.f;
#pragma unroll
        for (int r = 0; r < 16; ++r) { acc[r] = __builtin_amdgcn_exp2f(acc[r] * (0.125f * LOG2E) - mn); ps += acc[r]; }
        lrun = lrun * alpha + ps; mrun = mn;
#pragma unroll
        for (int r = 0; r < 16; ++r) { O[0][r] *= alpha; O[1][r] *= alpha; }
        const bf16x8 p0 = pack8(acc, 0), p1 = pack8(acc, 1);
        pv_tile(O, vrd + kt * (32 * VT_PITCH), p0, p1);
    }
    const float lt = xhalf_sum(lrun);
    gate_store_pre(O, 1.f / lt, gw, MIX + ((size_t)b * SEQ + t) * DM + 768 + h * 64, hi);
}

constexpr int SEL_IQ_PITCH = 528, SEL_CNT_OFF = 17408;
__device__ __forceinline__ unsigned ordkey(float f);
template <int PRED  >
__device__ __forceinline__ unsigned sel_count_round(const unsigned (&key)[8][16], unsigned c, unsigned tau, int idx0, int r32, int hi, int wave, LAS unsigned* cb) {
    int n = 0;
#pragma unroll
    for (int i = 0; i < 8; ++i) {
#pragma unroll
        for (int r = 0; r < 16; ++r) {
            if (PRED == 0) n += (key[i][r] >= c) ? 1 : 0;
            else if (PRED == 1) n += (key[i][r] > c) ? 1 : 0;
            else n += (key[i][r] == tau && (unsigned)(idx0 + 256 * i + (r & 3) + 8 * (r >> 2)) <= c) ? 1 : 0;
            if ((r & 7) == 7) asm volatile("" : "+v"(n));
        }
    }
    n += (int)xhalf_other_u((unsigned)n, hi);
    if (hi == 0) cb[wave * 32 + r32] = (unsigned)n;
    __syncthreads();
    unsigned tot = 0;
#pragma unroll
    for (int w = 0; w < 8; ++w) tot += cb[w * 32 + r32];
    return tot;
}
constexpr int SEL_CAP = 64, SEL_DONE = 16;
__device__ __forceinline__ float key2f(unsigned k) { return __uint_as_float((k & 0x80000000u) ? (k & 0x7fffffffu) : ~k); }
__device__ __forceinline__ void sel_cnt4(unsigned& n, unsigned k0, unsigned k1, unsigned k2, unsigned k3, unsigned c) {
    unsigned long long s0, s1, s2, s3;
    asm("v_cmp_ge_u32_e64 %1, %5, %9\n\tv_cmp_ge_u32_e64 %2, %6, %9\n\tv_cmp_ge_u32_e64 %3, %7, %9\n\tv_cmp_ge_u32_e64 %4, %8, %9\n\t"
        "v_addc_co_u32_e64 %0, %1, %0, 0, %1\n\tv_addc_co_u32_e64 %0, %2, %0, 0, %2\n\tv_addc_co_u32_e64 %0, %3, %0, 0, %3\n\tv_addc_co_u32_e64 %0, %4, %0, 0, %4"
        : "+v"(n), "=&s"(s0), "=&s"(s1), "=&s"(s2), "=&s"(s3) : "v"(k0), "v"(k1), "v"(k2), "v"(k3), "v"(c));
}
template <int O3, int O2, int O1, int O0> __device__ __forceinline__ void sel_bits4(unsigned& bits, unsigned k3, unsigned k2, unsigned k1, unsigned k0, int cl, unsigned tau) {
    unsigned long long s0, s1, s2, s3; unsigned t0, t1, t2, t3;
    asm("v_cmp_lt_i32_e64 %5, %13, %15\n\tv_cmp_lt_i32_e64 %6, %13, %16\n\tv_cmp_lt_i32_e64 %7, %13, %17\n\tv_cmp_lt_i32_e64 %8, %13, %18\n\t"
        "v_addc_co_u32_e64 %1, %5, %14, 0, %5\n\tv_addc_co_u32_e64 %2, %6, %14, 0, %6\n\tv_addc_co_u32_e64 %3, %7, %14, 0, %7\n\tv_addc_co_u32_e64 %4, %8, %14, 0, %8\n\t"
        "v_cmp_ge_u32_e64 %5, %9, %1\n\tv_cmp_ge_u32_e64 %6, %10, %2\n\tv_cmp_ge_u32_e64 %7, %11, %3\n\tv_cmp_ge_u32_e64 %8, %12, %4\n\t"
        "v_addc_co_u32_e64 %0, %5, %0, %0, %5\n\tv_addc_co_u32_e64 %0, %6, %0, %0, %6\n\tv_addc_co_u32_e64 %0, %7, %0, %0, %7\n\tv_addc_co_u32_e64 %0, %8, %0, %0, %8"
        : "+v"(bits), "=&v"(t3), "=&v"(t2), "=&v"(t1), "=&v"(t0), "=&s"(s0), "=&s"(s1), "=&s"(s2), "=&s"(s3)
        : "v"(k3), "v"(k2), "v"(k1), "v"(k0), "v"(cl), "v"(tau), "n"(O3), "n"(O2), "n"(O1), "n"(O0));
}
__device__ __forceinline__ unsigned sel_count_lane(const unsigned (&key)[8][16], unsigned c) {
    unsigned n = 0;
#pragma unroll
    for (int i = 0; i < 8; ++i) {
#pragma unroll
        for (int r = 0; r < 16; r += 4) sel_cnt4(n, key[i][r], key[i][r + 1], key[i][r + 2], key[i][r + 3], c);
    }
    return n;
}
__device__ __forceinline__ unsigned sel_exchange(unsigned nl, int r32, int hi, int wave, LAS unsigned* cb) {
    const unsigned n2 = nl + xhalf_other_u(nl, hi);
    if (hi == 0) cb[wave * 32 + r32] = n2;
    __syncthreads();
    unsigned tot = 0;
#pragma unroll
    for (int w = 0; w < 8; ++w) tot += cb[w * 32 + r32];
    return tot;
}
__device__ __forceinline__ void sel_item2(const bf16_t* PROJ, unsigned* MASK, int b, int qt, int lane, int wave, LAS unsigned char* L) {
    asm volatile("" : "+v"(lane));
    const int r32 = lane & 31, hi = lane >> 5, tid = wave * 64 + lane;
    LAS unsigned* cntb = (LAS unsigned*)(L + SEL_CNT_OFF);
    const bf16_t* base = PROJ + (size_t)b * SEQ * LDP;
    unsigned* mrow = MASK + (((size_t)b * 64 + qt) * 64) * 32;
    if (qt < 8) {
#pragma unroll
        for (int i = 0; i < 8; ++i) {
            const int kt = wave + 8 * i;
            if (kt <= qt) {
                unsigned bits = 0u;
#pragma unroll
                for (int r = 0; r < 16; ++r) bits |= ((kt < qt) || (crow(r, hi) <= r32)) ? (1u << r) : 0u;
                const unsigned other = xhalf_other_u(bits, hi);
                if (hi == 0) mrow[kt * 32 + r32] = bits | (other << 16);
            }
        }
        return;
    }
    for (int n = tid; n < 1024; n += 512) { const int row = n >> 5, ch = n & 31;
        const v4u v = *(const v4u*)(base + (size_t)(32 * qt + row) * LDP + C_IDQ + ch * 8);
        *(LAS v4u*)(L + row * SEL_IQ_PITCH + ch * 16) = v; }
    float w8[8];
    { const v4u wv = *(const v4u*)(base + (size_t)(32 * qt + r32) * LDP + C_IDW);
      w8[0] = __uint_as_float(wv.x << 16) * 0.0625f; w8[1] = __uint_as_float(wv.x & 0xffff0000u) * 0.0625f; w8[2] = __uint_as_float(wv.y << 16) * 0.0625f; w8[3] = __uint_as_float(wv.y & 0xffff0000u) * 0.0625f;
      w8[4] = __uint_as_float(wv.z << 16) * 0.0625f; w8[5] = __uint_as_float(wv.z & 0xffff0000u) * 0.0625f; w8[6] = __uint_as_float(wv.w << 16) * 0.0625f; w8[7] = __uint_as_float(wv.w & 0xffff0000u) * 0.0625f; }
    __syncthreads();
    unsigned key[8][16];
    const LAS unsigned char* iqp = L + r32 * SEL_IQ_PITCH + 16 * hi;
    unsigned kmn = 0xffffffffu, kmx = 0u;
#pragma unroll
    for (int i = 0; i < 8; ++i) {
        const int kt = wave + 8 * i;
        if (kt <= qt) {
            const bf16_t* kp = base + (size_t)(32 * kt + r32) * LDP + C_IDK + 8 * hi;
            const bf16x8 k0 = *(const bf16x8*)kp, k1 = *(const bf16x8*)(kp + 16);
            float sc[16];
#pragma unroll
            for (int r = 0; r < 16; ++r) sc[r] = 0.f;
            unsigned iqo = 0; asm volatile("" : "+v"(iqo));
            const LAS unsigned char* iqt = iqp + iqo;
#pragma unroll
            for (int hp = 0; hp < 4; ++hp) {
                const int h = 2 * hp;
                bf16x8 q0 = *(const LAS bf16x8*)(iqt + h * 64), q1 = *(const LAS bf16x8*)(iqt + h * 64 + 32);
                bf16x8 q2 = *(const LAS bf16x8*)(iqt + h * 64 + 64), q3 = *(const LAS bf16x8*)(iqt + h * 64 + 96);
                asm volatile("" : "+v"(q0), "+v"(q1), "+v"(q2), "+v"(q3) : "v"(sc[15]));
                f32x16 Da, Db;
#pragma unroll
                for (int r = 0; r < 16; ++r) { Da[r] = 0.f; Db[r] = 0.f; }
                Da = MFMA32(k0, q0, Da);
                Db = MFMA32(k0, q2, Db);
                Da = MFMA32(k1, q1, Da);
                Db = MFMA32(k1, q3, Db);
#pragma unroll
                for (int r = 0; r < 16; ++r) sc[r] = __builtin_fmaf(w8[h], __int_as_float(max(__float_as_int(Da[r]), 0)), sc[r]);
#pragma unroll
                for (int r = 0; r < 16; ++r) sc[r] = __builtin_fmaf(w8[h + 1], __int_as_float(max(__float_as_int(Db[r]), 0)), sc[r]);
                asm volatile("" : "+v"(sc[0]), "+v"(sc[1]), "+v"(sc[2]), "+v"(sc[3]), "+v"(sc[4]), "+v"(sc[5]), "+v"(sc[6]), "+v"(sc[7]),
                                  "+v"(sc[8]), "+v"(sc[9]), "+v"(sc[10]), "+v"(sc[11]), "+v"(sc[12]), "+v"(sc[13]), "+v"(sc[14]), "+v"(sc[15]));
            }
            int thr = (kt < qt) ? 64 : (r32 - 4 * hi);
            asm volatile("" : "+v"(thr));
#pragma unroll
            for (int r = 0; r < 16; ++r) { const bool v = ((r & 3) + 8 * (r >> 2) <= thr); const unsigned k = ordkey(sc[r]); key[i][r] = v ? k : 0u; kmx = max(kmx, v ? k : 0u); kmn = min(kmn, v ? k : 0xffffffffu); }
        } else {
#pragma unroll
            for (int r = 0; r < 16; ++r) key[i][r] = 0u;
        }
    }
    unsigned lo_key, hi_key, clo, chi = 0u, nlo_l, nhi_l = 0u;
    {
        int nv = 0;
#pragma unroll
        for (int i = 0; i < 8; ++i) { const int kt = wave + 8 * i; nv += (kt < qt) ? 16 : 0; }
        if ((qt & 7) == wave) { const int thr = r32 - 4 * hi;
#pragma unroll
            for (int r = 0; r < 16; ++r) nv += ((r & 3) + 8 * (r >> 2) <= thr) ? 1 : 0; }
        nlo_l = (unsigned)nv;
        kmn = min(kmn, xhalf_other_u(kmn, hi)); kmx = max(kmx, xhalf_other_u(kmx, hi));
        if (hi == 0) { cntb[wave * 32 + r32] = kmn; cntb[256 + wave * 32 + r32] = kmx; }
        __syncthreads();
        unsigned a = 0xffffffffu, bmx = 0u;
#pragma unroll
        for (int w = 0; w < 8; ++w) { a = min(a, cntb[w * 32 + r32]); bmx = max(bmx, cntb[256 + w * 32 + r32]); }
        lo_key = a; hi_key = bmx + 1u; clo = (unsigned)(32 * qt + r32 + 1);
        __syncthreads();
    }
    int round = 0;
    for (;;) {
        const bool done = (clo - chi <= (unsigned)SEL_DONE) || (hi_key - lo_key <= 1u);
        if (__all(done)) break;
        unsigned p;
        if ((round & 3) == 3) p = lo_key + ((hi_key - lo_key) >> 1);
        else p = ordkey(0.5f * key2f(lo_key) + 0.5f * key2f(hi_key));
        p = min(max(p, lo_key + 1u), hi_key - 1u);
        if (done) p = lo_key;
        const unsigned nl = sel_count_lane(key, p);
        const unsigned tot = sel_exchange(nl, r32, hi, wave, cntb + (round & 1) * 256);
        if (!done) { if (tot >= 256u) { lo_key = p; clo = tot; nlo_l = nl; } else { hi_key = p; chi = tot; nhi_l = nl; } }
        ++round;
    }
    unsigned tau, cut;
    const bool many = (clo - chi > (unsigned)SEL_CAP);
    {
        LAS unsigned* lanecnt = (LAS unsigned*)L; LAS unsigned* meta = (LAS unsigned*)(L + 2048); LAS unsigned* result = (LAS unsigned*)(L + 2304); LAS unsigned* list = (LAS unsigned*)(L + 20480);
        const int slot = wave * 2 + hi;
        lanecnt[r32 * 16 + slot] = many ? 0u : (nlo_l - nhi_l);
        if (slot == 0) { meta[2 * r32] = many ? 0u : (clo - chi); meta[2 * r32 + 1] = 256u - chi; }
        __syncthreads();
        unsigned bs = 0u;
#pragma unroll
        for (int s2 = 0; s2 < 16; ++s2) { const unsigned v = lanecnt[r32 * 16 + s2]; bs += (s2 < slot) ? v : 0u; }
        if (!many) {
            const int idx0 = 32 * wave + 4 * hi;
            LAS unsigned* lp = list + (r32 * SEL_CAP + bs) * 2;
#pragma unroll
            for (int i = 0; i < 8; ++i)
#pragma unroll
                for (int r = 0; r < 16; ++r) {
                    const unsigned k = key[i][r];
                    if (k >= lo_key && k < hi_key) { lp[0] = k; lp[1] = (unsigned)(idx0 + 256 * i + (r & 3) + 8 * (r >> 2)); lp += 2; }
                }
        }
        __syncthreads();
        for (int j = 0; j < 4; ++j) {
            const int q = 4 * wave + j;
            const unsigned ncand = (unsigned)__builtin_amdgcn_readfirstlane((int)meta[2 * q]), need = (unsigned)__builtin_amdgcn_readfirstlane((int)meta[2 * q + 1]);
            const LAS unsigned* lq = list + q * SEL_CAP * 2;
            const bool mine = (unsigned)lane < ncand;
            const unsigned kc = mine ? lq[2 * lane] : 0u, ic = mine ? lq[2 * lane + 1] : 0u;
            unsigned rank = 0u;
            for (unsigned c2 = 0; c2 < ncand; ++c2) {
                const unsigned k2 = (unsigned)__builtin_amdgcn_readlane((int)kc, (int)c2), i2 = (unsigned)__builtin_amdgcn_readlane((int)ic, (int)c2);
                rank += (k2 > kc || (k2 == kc && i2 < ic)) ? 1u : 0u;
            }
            if (mine && rank == need - 1u) { result[2 * q] = kc; result[2 * q + 1] = ic; }
        }
        __syncthreads();
        tau = result[2 * r32]; cut = result[2 * r32 + 1];
    }
    if (__any(many)) {
        const unsigned need = 256u - chi;
        const int idx0 = 32 * wave + 4 * hi;
        unsigned lo_ = 0u, hi_ = 2047u;
        for (int it = 0; it < 11; ++it) {
            const unsigned mid = (lo_ + hi_) >> 1;
            const unsigned f = sel_count_round<2>(key, mid, lo_key, idx0, r32, hi, wave, cntb + (it & 1) * 256);
            if (f >= need) hi_ = mid; else lo_ = mid + 1;
        }
        if (many) { tau = lo_key; cut = hi_; }
    }
    {
        const int idx0 = 32 * wave + 4 * hi;
#pragma unroll
        for (int i = 0; i < 8; ++i) {
            const int kt = wave + 8 * i;
            if (kt <= qt) {
                unsigned bits = 0u;
                const int cl = (int)cut - idx0 - 256 * i;
                sel_bits4<27, 26, 25, 24>(bits, key[i][15], key[i][14], key[i][13], key[i][12], cl, tau);
                sel_bits4<19, 18, 17, 16>(bits, key[i][11], key[i][10], key[i][9], key[i][8], cl, tau);
                sel_bits4<11, 10, 9, 8>(bits, key[i][7], key[i][6], key[i][5], key[i][4], cl, tau);
                sel_bits4<3, 2, 1, 0>(bits, key[i][3], key[i][2], key[i][1], key[i][0], cl, tau);
                const unsigned other = xhalf_other_u(bits, hi);
                if (hi == 0) mrow[kt * 32 + r32] = bits | (other << 16);
            }
        }
    }
    __syncthreads();
}

constexpr int WS_WUK = 0;
constexpr int WS_WUV = 256 * 1024;
constexpr int DSA_BIAS_OFF = 16384;
__device__ __forceinline__ unsigned dsa_off(unsigned row, unsigned ch) { return 256u * row + 16u * (ch ^ (((row & 3u) << 2) | ((row >> 2) & 3u))); }
constexpr int DSA_NBUF = 6, DSA_MASK_OFF = 49152, DSA_BIAS2_OFF = 114688;
__device__ __forceinline__ void glds16(const void* gsrc, unsigned lds_dst) { unsigned keep;
    asm volatile("s_mov_b32 %0, m0\n\ts_mov_b32 m0, %2\n\ts_nop 0\n\tglobal_load_lds_dwordx4 %1, off\n\ts_mov_b32 m0, %0" : "=&s"(keep) : "v"(gsrc), "s"(lds_dst) : "memory"); }
__device__ __forceinline__ void lds_read8_b128(bf16x8 (&a)[8], unsigned be, unsigned bo) {
    asm volatile("ds_read_b128 %0, %8\n\tds_read_b128 %1, %9\n\tds_read_b128 %2, %8 offset:512\n\tds_read_b128 %3, %9 offset:512\n\t"
                 "ds_read_b128 %4, %8 offset:1024\n\tds_read_b128 %5, %9 offset:1024\n\tds_read_b128 %6, %8 offset:1536\n\tds_read_b128 %7, %9 offset:1536"
                 : "=&v"(a[0]), "=&v"(a[1]), "=&v"(a[2]), "=&v"(a[3]), "=&v"(a[4]), "=&v"(a[5]), "=&v"(a[6]), "=&v"(a[7]) : "v"(be), "v"(bo));
}
template <int N> __device__ __forceinline__ void lgkm_wait(bf16x8& a) { asm volatile("s_waitcnt lgkmcnt(%1)" : "+v"(a) : "n"(N)); }
__device__ __forceinline__ void lds_read16_tr(s16x4 (&f)[4][4], unsigned b0, unsigned b1) {
    asm volatile("ds_read_b64_tr_b16 %0, %16\n\tds_read_b64_tr_b16 %1, %17 offset:2048\n\tds_read_b64_tr_b16 %2, %16 offset:4096\n\tds_read_b64_tr_b16 %3, %17 offset:6144\n\t"
                 "ds_read_b64_tr_b16 %4, %16 offset:512\n\tds_read_b64_tr_b16 %5, %17 offset:2560\n\tds_read_b64_tr_b16 %6, %16 offset:4608\n\tds_read_b64_tr_b16 %7, %17 offset:6656\n\t"
                 "ds_read_b64_tr_b16 %8, %16 offset:1024\n\tds_read_b64_tr_b16 %9, %17 offset:3072\n\tds_read_b64_tr_b16 %10, %16 offset:5120\n\tds_read_b64_tr_b16 %11, %17 offset:7168\n\t"
                 "ds_read_b64_tr_b16 %12, %16 offset:1536\n\tds_read_b64_tr_b16 %13, %17 offset:3584\n\tds_read_b64_tr_b16 %14, %16 offset:5632\n\tds_read_b64_tr_b16 %15, %17 offset:7680"
                 : "=&v"(f[0][0]), "=&v"(f[0][1]), "=&v"(f[0][2]), "=&v"(f[0][3]), "=&v"(f[1][0]), "=&v"(f[1][1]), "=&v"(f[1][2]), "=&v"(f[1][3]),
                   "=&v"(f[2][0]), "=&v"(f[2][1]), "=&v"(f[2][2]), "=&v"(f[2][3]), "=&v"(f[3][0]), "=&v"(f[3][1]), "=&v"(f[3][2]), "=&v"(f[3][3]) : "v"(b0), "v"(b1));
}
__device__ __forceinline__ void lgkm_wait_all(s16x4 (&f)[4][4]) {
    asm volatile("s_waitcnt lgkmcnt(0)" : "+v"(f[0][0]), "+v"(f[0][1]), "+v"(f[0][2]), "+v"(f[0][3]), "+v"(f[1][0]), "+v"(f[1][1]), "+v"(f[1][2]), "+v"(f[1][3]),
                   "+v"(f[2][0]), "+v"(f[2][1]), "+v"(f[2][2]), "+v"(f[2][3]), "+v"(f[3][0]), "+v"(f[3][1]), "+v"(f[3][2]), "+v"(f[3][3]));
}
__device__ __forceinline__ void dsa_round(const bf16_t* PROJ, const bf16_t* CKVN, const unsigned* MASK, const bf16_t* WUKp  , const bf16_t* WUVp  ,
                                          const float* rel_bias, bf16_t* MIX, int b, int o, int h, int lane, int wave, LAS unsigned char* L, const int bkq) {
    asm volatile("" : "+v"(lane));
    float NINF; asm volatile("v_mov_b32 %0, 0xff800000" : "=v"(NINF));
    const int r32 = lane & 31, hi = lane >> 5, tid = wave * 64 + lane;
    const int qt = 8 * o + wave, KT = 8 * o + 7, t = 32 * qt + r32;
    const int srow = 8 * (wave >> 1) + ((lane >> 2) & 7);
    const int sch = 4 * (2 * (wave & 1) + (lane >> 5)) + ((lane & 3) ^ ((2 * (wave >> 1) + ((lane >> 4) & 1)) & 3));
    const bf16_t* csrc = CKVN + ((size_t)b * SEQ + srow) * 128 + 8 * sch;
    const unsigned ring0 = (unsigned)__builtin_amdgcn_readfirstlane((int)(unsigned)(size_t)L) + 1024u * (unsigned)wave;
    LAS unsigned* maskL = (LAS unsigned*)(L + DSA_MASK_OFF + wave * 8192);
    {
        const unsigned char* msrc = (const unsigned char*)(MASK + (((size_t)b * 64 + qt) * 64) * 32) + 16 * lane;
        const unsigned mdst = (unsigned)__builtin_amdgcn_readfirstlane((int)(unsigned)(size_t)maskL);
        for (int p = 0; 8 * p <= qt; ++p) glds16(msrc + 1024 * p, mdst + 1024u * (unsigned)p);
    }
    glds16(csrc, ring0); glds16(csrc + (size_t)32 * 128, ring0 + 8192u); glds16(csrc + (size_t)64 * 128, ring0 + 16384u); glds16(csrc + (size_t)96 * 128, ring0 + 24576u);
    LAS float* biasT = (LAS float*)(L + DSA_BIAS2_OFF);
    if (tid < 192) biasT[tid] = rel_bias[bkq * 6 + h] * LOG2E;
    const float bias31 = rel_bias[31 * 6 + h] * LOG2E;
    bf16x8 qlf[8];
    {
        const bf16_t* qrow = PROJ + ((size_t)b * SEQ + t) * LDP + C_DSQ + h * 64 + 8 * hi;
        bf16x8 qf[4];
#pragma unroll
        for (int ks = 0; ks < 4; ++ks) qf[ks] = *(const bf16x8*)(qrow + 16 * ks);
        bf16x8 wk[16];
#pragma unroll
        for (int rt = 0; rt < 4; ++rt) {
            const GAS bf16_t* wp = (const GAS bf16_t*)WUKp + (rt * 32 + r32) * 64 + 8 * hi;
#pragma unroll
            for (int ks = 0; ks < 4; ++ks) wk[rt * 4 + ks] = *(const GAS bf16x8*)(wp + 16 * ks);
        }
        asm volatile("" : "+v"(wk[0]), "+v"(wk[1]), "+v"(wk[2]), "+v"(wk[3]), "+v"(wk[4]), "+v"(wk[5]), "+v"(wk[6]), "+v"(wk[7]),
                          "+v"(wk[8]), "+v"(wk[9]), "+v"(wk[10]), "+v"(wk[11]), "+v"(wk[12]), "+v"(wk[13]), "+v"(wk[14]), "+v"(wk[15]));
#pragma unroll
        for (int rt = 0; rt < 4; ++rt) {
            f32x16 X;
#pragma unroll
            for (int r = 0; r < 16; ++r) X[r] = 0.f;
#pragma unroll
            for (int ks = 0; ks < 4; ++ks) X = MFMA32(wk[rt * 4 + ks], qf[ks], X);
#pragma unroll
            for (int r = 0; r < 16; ++r) X[r] *= 0.125f * LOG2E;
            qlf[2 * rt] = pack8(X, 0); qlf[2 * rt + 1] = pack8(X, 1);
        }
    }
    f32x16 O[4];
#pragma unroll
    for (int c = 0; c < 4; ++c)
#pragma unroll
        for (int r = 0; r < 16; ++r) O[c][r] = 0.f;
    float mref = NINF, lrun = 0.f;
    const unsigned x2 = ((unsigned)r32 >> 2) & 3u;
    const unsigned rb_e = 2048u * ((unsigned)r32 >> 3) + 64u * ((unsigned)r32 & 7u) + 16u * ((unsigned)hi ^ x2);
    const unsigned rb_o = 2048u * ((unsigned)r32 >> 3) + 64u * ((unsigned)r32 & 7u) + 16u * ((2u + (unsigned)hi) ^ x2);
    const unsigned tq = (lane & 15) >> 2, tp = lane & 3, tblk = (lane >> 4) & 1;
    const unsigned tb0 = 64u * (4u * hi + tq) + 16u * ((2u * tblk + (tp >> 1)) ^ ((unsigned)hi & 3u)) + 8u * (tp & 1);
    const unsigned tb1 = 64u * (4u * hi + tq) + 16u * ((2u * tblk + (tp >> 1)) ^ ((2u + (unsigned)hi) & 3u)) + 8u * (tp & 1);
    __syncthreads();
    asm volatile("s_waitcnt vmcnt(0) lgkmcnt(0)" ::: "memory");
    auto dsa_qk = [&](const int kt, f32x16& S, const LAS unsigned char* Cb) __attribute__((always_inline)) {
        if (kt <= qt) {
#pragma unroll
            for (int r = 0; r < 16; ++r) S[r] = 0.f;
            bf16x8 a[8];
            const unsigned cb32 = (unsigned)(size_t)Cb;
            lds_read8_b128(a, cb32 + rb_e, cb32 + rb_o);
            lgkm_wait<7>(a[0]); S = MFMA32(a[0], qlf[0], S);
            lgkm_wait<6>(a[1]); S = MFMA32(a[1], qlf[1], S);
            lgkm_wait<5>(a[2]); S = MFMA32(a[2], qlf[2], S);
            lgkm_wait<4>(a[3]); S = MFMA32(a[3], qlf[3], S);
            lgkm_wait<3>(a[4]); S = MFMA32(a[4], qlf[4], S);
            lgkm_wait<2>(a[5]); S = MFMA32(a[5], qlf[5], S);
            lgkm_wait<1>(a[6]); S = MFMA32(a[6], qlf[6], S);
            lgkm_wait<0>(a[7]); S = MFMA32(a[7], qlf[7], S);
        }
    };
    auto dsa_tile = [&](const int kt, f32x16& S, const LAS unsigned char* Cb, const unsigned mwc) __attribute__((always_inline)) {
        if (kt <= qt) {
            s16x4 f[4][4];
            lds_read16_tr(f, (unsigned)(size_t)Cb + tb0, (unsigned)(size_t)Cb + tb1);
            const unsigned mw = mwc;
            const int dq = qt - kt;
            float cb = bias31;
            if (__builtin_amdgcn_readfirstlane(dq) < 5) {
                asm volatile("" ::: "memory");
                cb = 0.f;
                const int rel0 = 32 * dq + r32 - 4 * hi;
#pragma unroll
                for (int r = 0; r < 16; ++r) { int rel = rel0 - ((r & 3) + 8 * (r >> 2)); rel = rel < 0 ? 0 : rel; S[r] += biasT[rel]; }
                asm volatile("" ::: "memory");
            }
            float mx = fmaxf(S[0], S[1]);
#pragma unroll
            for (int r = 2; r < 16; ++r) mx = fmaxf(mx, S[r]);
            mx = xhalf_max(mx) + cb;
            if (__any(mx > mref + 8.f)) {
                float mm = NINF;
                asm volatile("" : "+v"(mm));
#pragma unroll
                for (int r = 0; r < 16; ++r) mm = fmaxf(mm, ((mw >> r) & 1u) ? S[r] : NINF);
                mm = xhalf_max(mm) + cb;
                const float mn = fmaxf(mref, mm);
                const float alpha = (mn > mref) ? __builtin_amdgcn_exp2f(mref - mn) : 1.f;
                mref = mn; lrun *= alpha;
#pragma unroll
                for (int c = 0; c < 4; ++c)
#pragma unroll
                    for (int r = 0; r < 16; ++r) asm volatile("v_mul_f32 %0, %0, %1" : "+v"(O[c][r]) : "v"(alpha));
            }
            const float off = ((mref == NINF) ? 0.f : mref) - cb;
            float ps0 = 0.f, ps1 = 0.f;
#pragma unroll
            for (int r = 0; r < 16; ++r) {
                const float e = __builtin_amdgcn_exp2f(S[r] - off);
                int m1; asm("v_bfe_i32 %0, %1, %2, 1" : "=v"(m1) : "v"(mw), "n"(r));
                S[r] = __uint_as_float(__float_as_uint(e) & (unsigned)m1);
                if (r & 1) ps1 += S[r]; else ps0 += S[r];
            }
            lrun += ps0 + ps1;
            const bf16x8 p0 = pack8(S, 0), p1 = pack8(S, 1);
            lgkm_wait_all(f);
#pragma unroll
            for (int c = 0; c < 4; ++c) {
                O[c] = MFMA32(cat44(f[c][0], f[c][1]), p0, O[c]);
                O[c] = MFMA32(cat44(f[c][2], f[c][3]), p1, O[c]);
            }
        }
    };
    const int NS = (KT + 1) >> 1;
    v2u gatew[8];
#pragma unroll
    for (int i = 0; i < 8; ++i) { gatew[i].x = 0u; gatew[i].y = 0u; }
    int sl = 0;
    const bool late = (wave & 4) != 0;
    unsigned mwA = maskL[r32], mwB = maskL[32 + r32];
    for (int st = 0; st < NS; ++st) {
        if (st + 1 < NS) asm volatile("s_waitcnt vmcnt(2)\n\ts_barrier" ::: "memory");
        else asm volatile("s_waitcnt vmcnt(0)\n\ts_barrier" ::: "memory");
        if (st + 2 < NS) { int s2 = sl + 4; s2 = s2 >= 6 ? s2 - 6 : s2;
            glds16(csrc + (size_t)(64 * (st + 2)) * 128, ring0 + 8192u * (unsigned)s2); glds16(csrc + (size_t)(64 * (st + 2) + 32) * 128, ring0 + 8192u * (unsigned)(s2 + 1)); }
        if (st == NS - 1) gate_load(gatew, PROJ + ((size_t)b * SEQ + t) * LDP + C_DSG + h * 64, hi);
        unsigned mw0 = mwA >> (16 * hi), mw1 = mwB >> (16 * hi);
        asm volatile("" : "+v"(mw0), "+v"(mw1));
        f32x16 S0, S1;
        dsa_qk(2 * st, S0, L + sl * 8192);
        if (late) dsa_qk(2 * st + 1, S1, L + (sl + 1) * 8192);
        dsa_tile(2 * st, S0, L + sl * 8192, mw0);
        if (!late) dsa_qk(2 * st + 1, S1, L + (sl + 1) * 8192);
        dsa_tile(2 * st + 1, S1, L + (sl + 1) * 8192, mw1);
        if (st + 1 < NS) { mwA = maskL[(2 * st + 2) * 32 + r32]; mwB = maskL[(2 * st + 3) * 32 + r32]; }
        sl = (sl == 4) ? 0 : sl + 2;
    }
    const float lt = xhalf_sum(lrun);
    const float il = 1.f / lt;
    f32x16 Y[2];
#pragma unroll
    for (int r = 0; r < 16; ++r) { Y[0][r] = 0.f; Y[1][r] = 0.f; }
    bf16x8 wv[16];
    {
        int l3 = lane; asm volatile("" : "+v"(l3));
#pragma unroll
        for (int rt = 0; rt < 4; ++rt)
#pragma unroll
            for (int c = 0; c < 2; ++c) {
                const GAS bf16_t* wp = (const GAS bf16_t*)WUVp + ((((c * 4 + rt) * 2 + 0) * 32 + (l3 & 31)) * 2 + (l3 >> 5)) * 8;
                wv[(rt * 2 + c) * 2] = *(const GAS bf16x8*)wp; wv[(rt * 2 + c) * 2 + 1] = *(const GAS bf16x8*)(wp + 32 * 2 * 8);
            }
        asm volatile("" : "+v"(wv[0]), "+v"(wv[1]), "+v"(wv[2]), "+v"(wv[3]), "+v"(wv[4]), "+v"(wv[5]), "+v"(wv[6]), "+v"(wv[7]),
                          "+v"(wv[8]), "+v"(wv[9]), "+v"(wv[10]), "+v"(wv[11]), "+v"(wv[12]), "+v"(wv[13]), "+v"(wv[14]), "+v"(wv[15]));
    }
#pragma unroll
    for (int rt = 0; rt < 4; ++rt) {
#pragma unroll
        for (int r = 0; r < 16; ++r) O[rt][r] *= il;
        const bf16x8 x0 = pack8(O[rt], 0), x1 = pack8(O[rt], 1);
#pragma unroll
        for (int c = 0; c < 2; ++c) {
            Y[c] = MFMA32(wv[(rt * 2 + c) * 2], x0, Y[c]);
            Y[c] = MFMA32(wv[(rt * 2 + c) * 2 + 1], x1, Y[c]);
        }
    }
    {
        int l2 = lane; asm volatile("" : "+v"(l2));
        const int t2 = 32 * qt + (l2 & 31);
        gate_store_pre(Y, 1.f, gatew, MIX + ((size_t)b * SEQ + t2) * DM + 384 + h * 64, l2 >> 5);
    }
    asm volatile("s_waitcnt lgkmcnt(0)\n\ts_barrier" ::: "memory");
}

typedef GAS unsigned gu32;
#define RLX_AGENT __ATOMIC_RELAXED, __HIP_MEMORY_SCOPE_AGENT
constexpr size_t WS_BAR = 512 * 1024;
#define XB_TMO      128
#define XB_XCNT(j)  (256  + 64 * (j))
#define XB_XSUB(j)  (1280 + 64 * (j))
#define XB_XGEN(j)  (2304 + 64 * (j))
#define XB_TOP      3328
#define XB_TOPGEN   3392
#define XCD_BAR_WORDS 3456
#define XB_SPIN_CAP (1u << 18)

__device__ __forceinline__ unsigned xb_ld(unsigned* p)              { return __hip_atomic_load(p, __ATOMIC_RELAXED, __HIP_MEMORY_SCOPE_AGENT); }
__device__ __forceinline__ unsigned xb_add(unsigned* p, unsigned v) { return __hip_atomic_fetch_add(p, v, __ATOMIC_RELAXED, __HIP_MEMORY_SCOPE_AGENT); }
__device__ __forceinline__ unsigned xb_xcc_id() { return (unsigned)__builtin_amdgcn_s_getreg((3 << 11) | 20) & 0xFu; }
#define XB_SPIN(cond, bar) do { unsigned _sp = 0; while (cond) { __builtin_amdgcn_s_sleep(1); \
    if ((++_sp & 255u) == 0u) { if (xb_ld(&(bar)[XB_TMO])) break; if (_sp > XB_SPIN_CAP) { atomicAdd(&(bar)[XB_TMO], 1u); break; } } } } while (0)

struct XcdBarrier {
    unsigned* bar; unsigned x;
    volatile LAS unsigned* st;
};

__device__ __forceinline__ XcdBarrier xcd_barrier_post(unsigned* bar, volatile LAS unsigned* st) {
    XcdBarrier b; b.bar = bar; b.x = xb_xcc_id(); b.st = st;
    if (threadIdx.x == 0) (void)xb_add(&bar[XB_XCNT(b.x)], 1u);
    return b;
}
__device__ __forceinline__ void xcd_barrier_complete(unsigned* bar, unsigned x, unsigned& nloc, unsigned& nx) {
    const unsigned G = gridDim.x * gridDim.y * gridDim.z;
    unsigned sum, cnt, mine, sp = 0u;
    for (;;) {
        sum = 0u; cnt = 0u; mine = 0u;
#pragma unroll
        for (unsigned j = 0; j < 16; ++j) { const unsigned c = xb_ld(&bar[XB_XCNT(j)]); sum += c; cnt += (c > 0u) ? 1u : 0u; mine = (j == x) ? c : mine; }
        if (sum == G) break;
        __builtin_amdgcn_s_sleep(1);
        if ((++sp & 255u) == 0u) { if (xb_ld(&bar[XB_TMO])) break; if (sp > XB_SPIN_CAP) { atomicAdd(&bar[XB_TMO], 1u); break; } }
    }
    nloc = mine > 0u ? mine : 1u; nx = cnt > 0u ? cnt : 1u;
}

__device__ __forceinline__ void xcd_barrier(const XcdBarrier& b, const bool leader  ) {
    asm volatile("s_waitcnt vmcnt(0)" ::: "memory");
    __syncthreads();
    if (leader) {
        unsigned* bar = b.bar;
        __builtin_amdgcn_s_waitcnt(0);
        unsigned nloc = b.st[0], nx = b.st[1];
        if (nloc == 0u) { xcd_barrier_complete(bar, b.x, nloc, nx); b.st[0] = nloc; b.st[1] = nx; }
        const unsigned old = xb_add(&bar[XB_XSUB(b.x)], 1u);
        const unsigned gen = old / nloc;
        if (old + 1u == (gen + 1u) * nloc) {
            __builtin_amdgcn_fence(__ATOMIC_RELEASE, "agent");
            asm volatile("s_waitcnt vmcnt(0)" ::: "memory");
            const unsigned og = xb_add(&bar[XB_TOP], 1u);
            const unsigned tg = og / nx;
            if (og + 1u == (tg + 1u) * nx) xb_add(&bar[XB_TOPGEN], 1u);
            else XB_SPIN(xb_ld(&bar[XB_TOPGEN]) == tg, bar);
            __builtin_amdgcn_fence(__ATOMIC_ACQUIRE, "agent");
            xb_add(&bar[XB_XGEN(b.x)], 1u);
            asm volatile("s_waitcnt vmcnt(0)" ::: "memory");
        } else {
            XB_SPIN(xb_ld(&bar[XB_XGEN(b.x)]) == gen, bar);
            __builtin_amdgcn_fence(__ATOMIC_ACQUIRE, "agent");
            asm volatile("s_waitcnt vmcnt(0)" ::: "memory");
        }
    }
    __syncthreads();
}

#ifndef MK_MULTI
#define MK_MULTI 0
#endif
constexpr int NPHASE = 11;
__global__ void __launch_bounds__(NWAVES * 64, 2) mk_fwd(Args args) {
    extern __shared__ __attribute__((aligned(16))) unsigned char lds_raw[];
    LAS unsigned char* lds = (LAS unsigned char*)lds_raw;
    const int tid0 = threadIdx.x;
    int wave_ = __builtin_amdgcn_readfirstlane(tid0 >> 6); asm volatile("" : "+s"(wave_));
    const int wave = wave_;
    const int G = gridDim.x, bid = blockIdx.x;
    for (int u = tid0; u < 16; u += NWAVES * 64) ((LAS unsigned*)(lds + 131072))[u] = 0u;
    __syncthreads();
    const XcdBarrier xbar = xcd_barrier_post((unsigned*)(args.ws + WS_BAR), (volatile LAS unsigned*)(lds + 131072));
    const int lo = args.ph_lo, hi = args.ph_hi;
#define IN(k) (lo <= (k) && (k) < hi)
#define SEAM(k) do { if (IN(k) && IN((k) + 1)) { if ((k) == 0) cg::this_grid().sync(); else xcd_barrier(xbar, wave_ == 0 && lane_id_v() == 0); } } while (0)
#define PH_BEGIN int lane = lane_id_v(); unsigned char* ws_ = args.ws; asm volatile("" : "+s"(ws_)); GAS unsigned char* ws = (GAS unsigned char*)ws_;     \
    const int gw = bid * NWAVES + wave, NGW = G * NWAVES; (void)gw; (void)NGW;
#define VCU_LOOP for (int vcu = vcu0; vcu < 256; vcu += G)
#define VCU_IDS const int bb = vcu >> 3, w64 = (vcu & 7) * 8 + wave; (void)bb; (void)w64;
#define P_WIN ((bf16_t*)(ws + WS_WIN))
#define P_WOUT ((bf16_t*)(ws + WS_WOUT))
#define P_WMEM ((bf16_t*)(ws + WS_WMEM))
#define P_MEMB ((bf16_t*)(ws + WS_MEMB))
#define P_MEMKV ((bf16_t*)(ws + WS_MEMKV))
#define P_CKVN ((bf16_t*)(ws + WS_CKVN))
#define P_MASK ((unsigned*)(ws + WS_MASK))
#define P_H ((bf16_t*)(ws + WS_H))
#define P_MIX ((bf16_t*)(ws + WS_MIX))
#define P_PROJ ((bf16_t*)(ws + WS_PROJ))
#define P_Y ((bf16_t*)(ws + WS_Y))
    const int vcu0 = (G % 8 == 0) ? (bid & 7) * (G >> 3) + (bid >> 3) : bid;

    if (IN(0)) {
        PH_BEGIN
        const float* x = args.in[0]; const float* mem = args.in[1]; const float* pre_g = args.in[2];
        const float* w_in = args.in[4]; const float* w_mem = args.in[8]; const float* w_out = args.in[9];
        LAS float* scr = (LAS float*)(lds + wave * 16384);
        constexpr int I_IN = 16 * (LDP / 32), I_OUT = 16 * 32, I_MEM = 16 * 16;
        constexpr int NITEMS = 2 * I_IN + 2 * I_OUT + 2 * I_MEM;
        for (int it = gw; it < NITEMS; it += NGW) {
            int r = it;
            if (r < 2 * I_IN) { const int l = r / I_IN; r -= l * I_IN; p0_transpose_item(w_in + (size_t)l * DM * NCOL, DM, NCOL, LDP, P_WIN + (size_t)l * LDP * DM, pre_g + l * DM, scr, r, lane); continue; }
            r -= 2 * I_IN;
            if (r < 2 * I_OUT) { const int l = r / I_OUT; r -= l * I_OUT; p0_transpose_item(w_out + (size_t)l * DM * DM, DM, DM, DM, P_WOUT + (size_t)l * DM * DM, nullptr, scr, r, lane); continue; }
            r -= 2 * I_OUT;
            { const int l = r / I_MEM; r -= l * I_MEM; p0_transpose_item(w_mem + (size_t)l * DM * 512, DM, 512, 512, P_WMEM + (size_t)l * 512 * DM, nullptr, scr, r, lane); }
        }
        {
            const float* w_uk = args.in[5]; const float* w_uv = args.in[6];
            bf16_t* WUKp = (bf16_t*)(ws + WS_WUK); bf16_t* WUVp = (bf16_t*)(ws + WS_WUV);
            for (int e = gw * 64 + lane; e < 2 * 6 * 8192; e += NGW * 64) {
                const int lh = e >> 13, l = lh / 6, h = lh % 6, w = e & 8191;
                { const int rt = w >> 11, rho = (w >> 6) & 31, d = w & 63; const int r = 32 * rt + ((rho & 0x13) | ((rho & 4) << 1) | ((rho & 8) >> 1));
                  WUKp[e] = (bf16_t)f2bf(w_uk[(((size_t)l * 128 + r) * 6 + h) * 64 + d]); }
                { const int j = w & 7, hh = (w >> 3) & 1, d32 = (w >> 4) & 31, s = (w >> 9) & 1, rt = (w >> 10) & 3, c = (w >> 12) & 1;
                  const int r = 32 * rt + 16 * s + 8 * (j >> 2) + 4 * hh + (j & 3), d = 32 * c + d32;
                  WUVp[e] = (bf16_t)f2bf(w_uv[(((size_t)l * 128 + r) * 6 + h) * 64 + d]); }
            }
        }
        for (int m = gw; m < NB * NMEM; m += NGW) row_to_bf16<false>(mem + (size_t)m * DM, P_MEMB + (size_t)m * DM, lane);
        for (int m = gw * 2; m < NTOK; m += NGW * 2) rows2_norm_bf16(x + (size_t)m * DM, P_H + (size_t)m * DM, lane);
    }
    SEAM(0);
#pragma unroll 1
    for (int l = 0; l < 2; ++l) {
        const int pb = 1 + 5 * l;
        if (IN(pb)) {
            PH_BEGIN
            { pg8::Gemm g{P_H, P_WIN + (size_t)l * LDP * DM, NTOK, LDP, DM}; pg8::StaticOrder S; S.init(NTOK, LDP, G, bid);
              pg8::EpiBf16<0> E{P_PROJ, LDP, nullptr, 0, 0, 1.f};
              pg8::gemm_phase<pg8::EpiBf16<0>, pg8::StaticOrder, true, true>(lds, g, S, E, wave); }
            if (l == 0) {
              pg8::Gemm g{P_MEMB, P_WMEM, NB * NMEM, 1024, DM}; pg8::StaticOrder S; S.init(NB * NMEM, 1024, G, bid);
              pg8::EpiBf16<0> E{P_MEMKV, 1024, nullptr, 0, 0, 1.f};
              pg8::gemm_phase<pg8::EpiBf16<0>, pg8::StaticOrder, true, true>(lds, g, S, E, wave); }
        }
        SEAM(pb);
        if (IN(pb + 1)) {
            { PH_BEGIN
              const float* kv_g = args.in[7];
              for (int m = gw * 8; m < NTOK; m += NGW * 8) { ckvnorm4(P_PROJ, kv_g + l * 128, P_CKVN, m, lane); ckvnorm4(P_PROJ, kv_g + l * 128, P_CKVN, m + 4, lane); } }
            VCU_LOOP { PH_BEGIN VCU_IDS
              for (int i = 0; i < 6; ++i) { const int qt = (i & 1) ? 63 - w64 : w64; sb_item(P_PROJ, P_MIX, bb, i, qt, lane, lds + wave * 16384); } }
            __syncthreads();
            VCU_LOOP { PH_BEGIN VCU_IDS
              const int s8 = vcu & 7;
              for (int j = 0; j < 8; ++j) { const int qt = 8 * j + ((j & 1) ? 7 - s8 : s8); sel_item2(P_PROJ, P_MASK, bb, qt, lane, wave, lds); } }
            __syncthreads();
            VCU_LOOP { PH_BEGIN VCU_IDS
              for (int i = 0; i < 4; ++i) {
                  __syncthreads();
                  mem_stage(P_MEMKV + l * 512, bb, i, wave * 64 + lane, lds);
                  __syncthreads();
                  mem_item_lds(P_PROJ, P_MIX, bb, i, w64, lane, lds);
              } }
        }
        SEAM(pb + 1);
        if (IN(pb + 2)) {
            __syncthreads();
            VCU_LOOP { PH_BEGIN VCU_IDS
              const float* rel_bias = args.in[10];
              const int s8 = vcu & 7, hs = (s8 < 4) ? 0 : 3;
              const int tidq = wave * 64 + lane;
              const int bkq = tidq < 128 ? (int)T5TAB[tidq] : 31;
              for (int oi = 0; oi < 2; ++oi) {
                  const int o = oi ? 7 - (s8 & 3) : (s8 & 3);
                  for (int hh = 0; hh < 3; ++hh) {
                      const int h = hs + hh;
                      dsa_round(P_PROJ, P_CKVN, P_MASK, (const bf16_t*)(ws + WS_WUK) + (size_t)(l * 6 + h) * 8192, (const bf16_t*)(ws + WS_WUV) + (size_t)(l * 6 + h) * 8192,
                                rel_bias, P_MIX, bb, o, h, lane, wave, lds, bkq);
                  }
              } }
        }
        SEAM(pb + 2);
        if (IN(pb + 3)) {
            PH_BEGIN
            __syncthreads();
            pg8::Gemm g{P_MIX, P_WOUT + (size_t)l * DM * DM, NTOK, DM, DM}; pg8::StaticOrder S; S.init(NTOK, DM, G, bid);
            pg8::EpiBf16<0> E{P_Y, DM, nullptr, 0, 0, 1.f};
            pg8::gemm_phase<pg8::EpiBf16<0>, pg8::StaticOrder, true, true>(lds, g, S, E, wave);
        }
        SEAM(pb + 3);
        if (IN(pb + 4)) {
            PH_BEGIN
            const float* post_g = args.in[3]; bf16_t* X1b = (bf16_t*)(ws + WS_X1);
            if (l == 0) { for (int m = gw * 2; m < NTOK; m += NGW * 2) post_rows2<true>(args.in[0], P_Y, post_g, args.out, X1b, P_H, m, lane); }
            else { for (int m = gw * 2; m < NTOK; m += NGW * 2) post_rows2<false>(nullptr, P_Y, post_g + DM, args.out, X1b, (bf16_t*)nullptr, m, lane); }
        }
        SEAM(pb + 4);
    }
#undef IN
#undef SEAM
}

extern "C" void kernel_launch(void* const* d_in, const int* in_sizes, int n_in, void* d_out, int out_size, void* d_ws, size_t ws_size, hipStream_t stream) {
    static int grid = 0;
    if (grid == 0) {
        if (n_in != 11 || ws_size < WS_END) { fprintf(stderr, "kernel_launch: unexpected n_in %d / ws_size %zu\n", n_in, ws_size); grid = -1; return; }
        int dev = 0, cus = 0, per_cu = 0;
        hipGetDevice(&dev);
        hipDeviceGetAttribute(&cus, hipDeviceAttributeMultiprocessorCount, dev);
        hipFuncSetAttribute((const void*)mk_fwd, hipFuncAttributeMaxDynamicSharedMemorySize, LDS_BYTES);
        hipOccupancyMaxActiveBlocksPerMultiprocessor(&per_cu, (const void*)mk_fwd, NWAVES * 64, LDS_BYTES);
        if (per_cu < 1) { fprintf(stderr, "kernel_launch: occupancy query says %d blocks per CU\n", per_cu); per_cu = 1; }
        grid = cus * 1;
        (void)hipGetLastError();
    }
    if (grid < 0) return;
    (void)hipMemsetAsync((char*)d_ws + WS_BAR, 0, 16384, stream);
    Args a{};
    for (int i = 0; i < 11; ++i) a.in[i] = (const float*)d_in[i];
    a.out = (float*)d_out; a.ws = (unsigned char*)d_ws;
#if MK_MULTI
    for (int p = 0; p < NPHASE; ++p) { a.ph_lo = p; a.ph_hi = p + 1; hipLaunchKernelGGL(mk_fwd, dim3(grid), dim3(NWAVES * 64), LDS_BYTES, stream, a); }
#else
    a.ph_lo = 0; a.ph_hi = NPHASE;
    void* kargs[] = {&a};
    hipError_t e = hipLaunchCooperativeKernel((const void*)mk_fwd, dim3(grid), dim3(NWAVES * 64), kargs, LDS_BYTES, stream);
    if (e != hipSuccess) fprintf(stderr, "cooperative launch failed: %s (grid %d)\n", hipGetErrorString(e), grid);
#endif
}
```

```cpp
#include <hip/hip_runtime.h>
#include <hip/hip_cooperative_groups.h>
#include <stdint.h>
#include <math.h>
#include <cstdio>
namespace cg = cooperative_groups;
__device__ __forceinline__ int lane_id_v() { int l; asm volatile("v_mbcnt_lo_u32_b32 %0, -1, 0\n\tv_mbcnt_hi_u32_b32 %0, -1, %0" : "=v"(l)); return l; }
namespace pg8 {
#define PG8_LAS __attribute__((address_space(3)))
typedef unsigned short bf16_t;
typedef short bf16x8 __attribute__((ext_vector_type(8)));
typedef float f32x4 __attribute__((ext_vector_type(4)));
typedef unsigned u32x4 __attribute__((ext_vector_type(4)));
constexpr int BM = 256, BK = 64, HALF = 128, HTB = HALF * BK * 2  , STAGE_BYTES = 8 * HTB, NXCD = 8, WGM = 8;

__host__ __device__ __forceinline__ int lds_byte(int r, int c) { const int st = (r >> 4) * 2 + (c >> 5), rr = r & 15, cc = c & 31, ob = rr * 64 + cc * 2; return st * 1024 + (ob ^ (((ob >> 9) & 1) << 5)); }
__host__ __device__ __forceinline__ void stage_rc(int b, int& R, int& C) { const int st = b / 1024, sb = b % 1024, swz = sb ^ (((sb >> 9) & 1) << 5); R = (st >> 1) * 16 + swz / 64; C = (st & 1) * 32 + (swz % 64) / 2; }
__host__ __device__ __forceinline__ int perm32(int rho) { const int n = rho >> 4, i = rho & 15; return 8 * (i >> 2) + 4 * n + (i & 3); }

struct Unit { int pm, pn; };
struct Gemm { const bf16_t* A; const bf16_t* Bt; int M, N, K; };

struct StaticOrder {
    int nM, nN, nwg, G, c;
    __host__ __device__ void init(int M, int N, int G_, int c_) { nM = M / BM; nN = N / BM; nwg = nM * nN; G = G_; c = c_; }
    __host__ __device__ bool next(int i, Unit& u) const {
        const long L = (long)i * G + c; if (L >= nwg) return false;
        int wgid = (int)L; { const int q = nwg / NXCD, r = nwg % NXCD, xcd = wgid % NXCD, off = wgid / NXCD; wgid = (xcd < r ? xcd * (q + 1) : r * (q + 1) + (xcd - r) * q) + off; }
        const int nig = WGM * nN, gid = wgid / nig, fm = gid * WGM, gsz = (nM - fm) < WGM ? (nM - fm) : WGM;
        u.pm = fm + ((wgid % nig) % gsz); u.pn = (wgid % nig) / gsz; return true;
    }
    __device__ __forceinline__ void a_ready(const Unit&) const {}
    __device__ __forceinline__ void done(const Unit&) const {}
};

__device__ __forceinline__ unsigned cvt_pk_bf16(float lo, float hi) { unsigned r; asm volatile("v_cvt_pk_bf16_f32 %0, %1, %2" : "=v"(r) : "v"(lo), "v"(hi)); return r; }
typedef float f32x2 __attribute__((ext_vector_type(2)));
__device__ __forceinline__ f32x2 gelu_pk(f32x2 v) {
    const f32x2 av = __builtin_elementwise_abs(v), d = av * 0.2316418882f + 1.0f;
    f32x2 t; t.x = __builtin_amdgcn_rcpf(d.x); t.y = __builtin_amdgcn_rcpf(d.y);
    f32x2 q = t * 0.5307027145f + (-0.7265760135f); q = q * t + 0.7107068705f; q = q * t + (-0.142248368f); q = q * t + 0.127414796f; q = q * t;
    const f32x2 s = (v * v) * (-0.72134752044f);
    f32x2 e; e.x = __builtin_amdgcn_exp2f(s.x); e.y = __builtin_amdgcn_exp2f(s.y);
    const f32x2 m = v * (q * e), r = v - m;
    f32x2 o; o.x = v.x < 0.f ? m.x : r.x; o.y = v.y < 0.f ? m.y : r.y; return o;
}

template <int ACT  > struct EpiBf16 {
    static constexpr bool PERM = true, AFTER_DRAIN = false; static_assert(ACT == 0 || ACT == 1, "EpiBf16: ACT is 0 (none) or 1 (gelu_pk)");
    bf16_t* O; int ldc; const float* bias; int split_cols; size_t split_stride; float scale0;
    __device__ __forceinline__ void operator()(const f32x4 (&acc)[2][2][4][2], const Unit& u, int wr, int wc, int fr, int fq) const {
        const int row0 = u.pm * BM + wr * 64 + fr; int colt = u.pn * BM; bf16_t* base = O;
        float sc = 1.f; if (split_cols) { const int t = colt / split_cols; base += (size_t)t * split_stride; colt -= t * split_cols; if (t == 0) sc = scale0; }
        const int col0 = colt + wc * 32 + 8 * fq, bcol0 = u.pn * BM + wc * 32 + 8 * fq;
        f32x4 bv[2][2];
#pragma unroll
        for (int bj = 0; bj < 2; ++bj)
#pragma unroll
            for (int n = 0; n < 2; ++n) bv[bj][n] = bias ? *(const f32x4*)(bias + bcol0 + bj * HALF + 4 * n) : (f32x4){0.f, 0.f, 0.f, 0.f};
#pragma unroll
        for (int ai = 0; ai < 2; ++ai)
#pragma unroll
            for (int m = 0; m < 4; ++m) { bf16_t* rowp = base + (size_t)(row0 + ai * HALF + m * 16) * ldc + col0;
#pragma unroll
                for (int bj = 0; bj < 2; ++bj) { f32x4 v0 = acc[ai][bj][m][0] + bv[bj][0], v1 = acc[ai][bj][m][1] + bv[bj][1];
                    if (ACT == 1) { f32x2 a = gelu_pk((f32x2){v0[0], v0[1]}), b = gelu_pk((f32x2){v0[2], v0[3]}), c = gelu_pk((f32x2){v1[0], v1[1]}), d = gelu_pk((f32x2){v1[2], v1[3]});
                        v0 = (f32x4){a.x, a.y, b.x, b.y}; v1 = (f32x4){c.x, c.y, d.x, d.y}; }
                    v0 = v0 * sc; v1 = v1 * sc; u32x4 w; w.x = cvt_pk_bf16(v0[0], v0[1]); w.y = cvt_pk_bf16(v0[2], v0[3]); w.z = cvt_pk_bf16(v1[0], v1[1]); w.w = cvt_pk_bf16(v1[2], v1[3]);
                    *(u32x4*)(rowp + bj * HALF) = w; } }
    }
};
template <class Epi, class Sched, bool ALIGN_EPI = false, bool SP2 = false>
__device__ __forceinline__ void gemm_phase(PG8_LAS unsigned char* lds, const Gemm g, const Sched& S, const Epi& E, int wave_id) {
    int tid_ = wave_id * 64 + lane_id_v();
    const int tid = tid_, wid = __builtin_amdgcn_readfirstlane(tid >> 6), lane = tid & 63, wr = wid >> 2, wc = wid & 3, fr = lane & 15, fq = lane >> 4;
    const int K = g.K, nt = K / BK;
    unsigned voffA[2], voffB[2];
#pragma unroll
    for (int i = 0; i < 2; ++i) { int R, C; stage_rc(tid * 16 + i * 8192, R, C); const int Rb = Epi::PERM ? ((R & ~31) + perm32(R & 31)) : R;
        voffA[i] = (unsigned)(R * K + C) * 2u; voffB[i] = (unsigned)(Rb * K + C) * 2u; }
    const size_t kstep = (size_t)(BK * 2);
    const size_t hstep = (size_t)HALF * K * 2;
    const size_t tstep = 2 * hstep;
    const unsigned ldsw = (unsigned)wid * 1024u;
    const int aoff = lds_byte(wr * 64 + fr, fq * 8), boff = lds_byte(wc * 32 + fr, fq * 8);
#define PG8_SA(b, h) (((b) * 2 + (h)) * HTB)
#define PG8_SB(b, h) ((4 + (b) * 2 + (h)) * HTB)
#define PG8_STAGE(bufoff, gbase, voff) do { _Pragma("unroll") for (int _i = 0; _i < 2; ++_i) \
        __builtin_amdgcn_global_load_lds((const unsigned*)((const char*)(gbase) + (voff)[_i]), (PG8_LAS unsigned*)(lds + (bufoff) + ldsw + _i * 8192), 16, 0, 0); } while (0)
#define PG8_LDA(dst, b, h) do { _Pragma("unroll") for (int m = 0; m < 4; ++m) _Pragma("unroll") for (int k = 0; k < 2; ++k) dst[m][k] = *(const PG8_LAS bf16x8*)(lds + PG8_SA(b, h) + aoff + m * 2048 + k * 1024); } while (0)
#define PG8_LDB(dst, b, h) do { _Pragma("unroll") for (int n = 0; n < 2; ++n) _Pragma("unroll") for (int k = 0; k < 2; ++k) dst[n][k] = *(const PG8_LAS bf16x8*)(lds + PG8_SB(b, h) + boff + n * 2048 + k * 1024); } while (0)
#define PG8_MMA(ai, bj, At, Bt) do { __builtin_amdgcn_s_setprio(1); _Pragma("unroll") for (int m = 0; m < 4; ++m) _Pragma("unroll") for (int n = 0; n < 2; ++n) _Pragma("unroll") for (int k = 0; k < 2; ++k) \
        acc[ai][bj][m][n] = __builtin_amdgcn_mfma_f32_16x16x32_bf16(Bt[n][k], At[m][k], acc[ai][bj][m][n], 0, 0, 0); __builtin_amdgcn_s_setprio(0); } while (0)
#define PG8_WAIT_V(n) asm volatile("s_waitcnt vmcnt(" #n ")" ::: "memory")
#define PG8_WAIT_L(n) asm volatile("s_waitcnt lgkmcnt(" #n ")" ::: "memory")
#define PG8_BAR __builtin_amdgcn_s_barrier()
#define PG8_SCHED __builtin_amdgcn_sched_barrier(0)
    Unit cur, nxt; int ui = 0;
    if (!S.next(0, cur)) return;
    f32x4 acc[2][2][4][2];
#pragma unroll
    for (int a = 0; a < 2; ++a)
#pragma unroll
        for (int b = 0; b < 2; ++b)
#pragma unroll
            for (int m = 0; m < 4; ++m)
#pragma unroll
                for (int n = 0; n < 2; ++n) acc[a][b][m][n] = (f32x4){0.f, 0.f, 0.f, 0.f};
    bf16x8 At[4][2], B0[2][2], B1[2][2];
    const char* cA = (const char*)g.A + (size_t)cur.pm * tstep; const char* cB = (const char*)g.Bt + (size_t)cur.pn * tstep;
    S.a_ready(cur);
    if constexpr (SP2) {
        PG8_STAGE(PG8_SB(0, 0), cB, voffB); PG8_STAGE(PG8_SB(0, 1), cB + hstep, voffB); PG8_STAGE(PG8_SA(0, 0), cA, voffA); PG8_STAGE(PG8_SA(0, 1), cA + hstep, voffA);
        if (wr == 1) PG8_BAR;
        PG8_WAIT_V(2); PG8_BAR;
        PG8_STAGE(PG8_SB(1, 0), cB + kstep, voffB); PG8_STAGE(PG8_SA(1, 0), cA + kstep, voffA); PG8_STAGE(PG8_SB(1, 1), cB + hstep + kstep, voffB);
        PG8_WAIT_V(6); PG8_BAR;
    } else {
        PG8_STAGE(PG8_SB(0, 0), cB, voffB); PG8_STAGE(PG8_SA(0, 0), cA, voffA); PG8_STAGE(PG8_SB(0, 1), cB + hstep, voffB); PG8_STAGE(PG8_SA(0, 1), cA + hstep, voffA);
        if (wr == 1) PG8_BAR;
        PG8_WAIT_V(4); PG8_BAR;
        PG8_STAGE(PG8_SB(1, 0), cB + kstep, voffB); PG8_STAGE(PG8_SA(1, 0), cA + kstep, voffA); PG8_STAGE(PG8_SB(1, 1), cB + hstep + kstep, voffB);
        PG8_WAIT_V(6); PG8_BAR;
    }
    for (;;) {
        const bool has_next = S.next(ui + 1, nxt);
        const char* nA = has_next ? (const char*)g.A + (size_t)nxt.pm * tstep : cA; const char* nB = has_next ? (const char*)g.Bt + (size_t)nxt.pn * tstep : cB;
        for (int t = 0; t < nt; t += 2) {
            const bool last = (t == nt - 2);
            const char* a1 = cA + (size_t)(t + 1) * kstep;
            const char* a2 = last ? nA : cA + (size_t)(t + 2) * kstep; const char* b2 = last ? nB : cB + (size_t)(t + 2) * kstep;
            const char* a3 = a2 + kstep; const char* b3 = b2 + kstep;
            if (last && has_next) S.a_ready(nxt);
            if constexpr (SP2) {
            PG8_LDB(B0, 0, 0); PG8_LDB(B1, 0, 1); PG8_SCHED; PG8_LDA(At, 0, 0); PG8_STAGE(PG8_SA(1, 1), a1 + hstep, voffA);
            PG8_WAIT_V(8); PG8_WAIT_L(0); PG8_BAR; PG8_MMA(0, 0, At, B0); PG8_MMA(0, 1, At, B1); PG8_BAR; PG8_SCHED;
            PG8_LDA(At, 0, 1); PG8_STAGE(PG8_SB(0, 0), b2, voffB); PG8_STAGE(PG8_SB(0, 1), b2 + hstep, voffB); PG8_STAGE(PG8_SA(0, 0), a2, voffA);
            PG8_WAIT_V(8); PG8_WAIT_L(0); PG8_BAR; PG8_MMA(1, 0, At, B0); PG8_MMA(1, 1, At, B1); PG8_BAR; PG8_SCHED;
            PG8_LDB(B0, 1, 0); PG8_LDB(B1, 1, 1); PG8_SCHED; PG8_LDA(At, 1, 0); PG8_STAGE(PG8_SA(0, 1), a2 + hstep, voffA);
            PG8_WAIT_V(8); PG8_WAIT_L(0); PG8_BAR; PG8_MMA(0, 0, At, B0); PG8_MMA(0, 1, At, B1); PG8_BAR; PG8_SCHED;
            PG8_LDA(At, 1, 1); PG8_STAGE(PG8_SB(1, 0), b3, voffB); PG8_STAGE(PG8_SB(1, 1), b3 + hstep, voffB); PG8_STAGE(PG8_SA(1, 0), a3, voffA);
            PG8_WAIT_V(8); PG8_WAIT_L(0); PG8_BAR; PG8_MMA(1, 0, At, B0); PG8_MMA(1, 1, At, B1); PG8_BAR; PG8_SCHED;
            } else {
            PG8_LDB(B0, 0, 0); PG8_SCHED; PG8_LDA(At, 0, 0); PG8_STAGE(PG8_SA(1, 1), a1 + hstep, voffA);
            PG8_WAIT_L(8); PG8_BAR; PG8_WAIT_L(0); PG8_MMA(0, 0, At, B0); PG8_BAR; PG8_SCHED;
            PG8_LDB(B1, 0, 1); PG8_STAGE(PG8_SB(0, 0), b2, voffB);
            PG8_BAR; PG8_WAIT_L(0); PG8_MMA(0, 1, At, B1); PG8_BAR;
            PG8_LDA(At, 0, 1); PG8_STAGE(PG8_SA(0, 0), a2, voffA);
            PG8_BAR; PG8_WAIT_L(0); PG8_MMA(1, 0, At, B0); PG8_BAR; PG8_SCHED;
            PG8_STAGE(PG8_SB(0, 1), b2 + hstep, voffB);
            PG8_WAIT_V(6); PG8_BAR; PG8_MMA(1, 1, At, B1); PG8_BAR;
            PG8_LDB(B0, 1, 0); PG8_SCHED; PG8_LDA(At, 1, 0); PG8_STAGE(PG8_SA(0, 1), a2 + hstep, voffA);
            PG8_WAIT_L(8); PG8_BAR; PG8_WAIT_L(0); PG8_MMA(0, 0, At, B0); PG8_BAR; PG8_SCHED;
            PG8_LDB(B1, 1, 1); PG8_STAGE(PG8_SB(1, 0), b3, voffB);
            PG8_BAR; PG8_WAIT_L(0); PG8_MMA(0, 1, At, B1); PG8_BAR;
            PG8_LDA(At, 1, 1); PG8_STAGE(PG8_SA(1, 0), a3, voffA);
            PG8_BAR; PG8_WAIT_L(0); PG8_MMA(1, 0, At, B0); PG8_BAR; PG8_SCHED;
            PG8_STAGE(PG8_SB(1, 1), b3 + hstep, voffB);
            PG8_WAIT_V(6); PG8_BAR; PG8_MMA(1, 1, At, B1); PG8_BAR;
            }
        }
        if constexpr (ALIGN_EPI) { if (wr == 0) PG8_BAR; }
        if constexpr (!Epi::AFTER_DRAIN) { E(acc, cur, wr, wc, fr, fq); S.done(cur); }
        if (!has_next) break;
#pragma unroll
        for (int a = 0; a < 2; ++a)
#pragma unroll
            for (int b = 0; b < 2; ++b)
#pragma unroll
                for (int m = 0; m < 4; ++m)
#pragma unroll
                    for (int n = 0; n < 2; ++n) acc[a][b][m][n] = (f32x4){0.f, 0.f, 0.f, 0.f};
        cur = nxt; cA = nA; cB = nB; ++ui;
        if constexpr (ALIGN_EPI) { if (wr == 1) PG8_BAR; }
    }
    PG8_WAIT_V(0);
    if constexpr (!ALIGN_EPI) { if (wr == 0) PG8_BAR; }
    PG8_BAR;
    if constexpr (Epi::AFTER_DRAIN) { E.fused(acc, cur, wr, wc, fr, fq, lds, wid, lane); S.done(cur); }
#undef PG8_SA
#undef PG8_SB
#undef PG8_STAGE
#undef PG8_LDA
#undef PG8_LDB
#undef PG8_MMA
#undef PG8_WAIT_V
#undef PG8_WAIT_L
#undef PG8_BAR
#undef PG8_SCHED
}
}
typedef unsigned short bf16_t;
#define LAS __attribute__((address_space(3)))
#define GAS __attribute__((address_space(1)))
typedef unsigned v4u __attribute__((ext_vector_type(4)));
typedef unsigned v2u __attribute__((ext_vector_type(2)));
typedef float f32x4 __attribute__((ext_vector_type(4)));
constexpr int DM = 1024, NB = 32, SEQ = 2048, NTOK = NB * SEQ, NMEM = 256;
constexpr int LDP = 3328;
constexpr int C_SBQ = 0, C_SBK = 384, C_SBV = 768, C_SBG = 1152, C_DSQ = 1536, C_CKV = 1920, C_DSG = 2048,
              C_IDQ = 2432, C_IDK = 2688, C_IDW = 2720, C_MQ = 2728, C_MG = 2984, NCOL = 3240;
constexpr float EPS = 1e-6f;
constexpr size_t MiB = 1u << 20;
constexpr size_t WS_CTL = 0;
constexpr size_t WS_WIN = 1 * MiB;
constexpr size_t WS_WOUT = 14 * MiB;
constexpr size_t WS_WMEM = 18 * MiB;
constexpr size_t WS_MEMB = 20 * MiB;
constexpr size_t WS_MEMKV = 36 * MiB;
constexpr size_t WS_CKVN = 52 * MiB;
constexpr size_t WS_MASK = 68 * MiB;
constexpr size_t WS_H = 84 * MiB;
constexpr size_t WS_MIX = WS_H;
constexpr size_t WS_PROJ = 212 * MiB;
constexpr size_t WS_Y = WS_PROJ;
constexpr size_t WS_X1 = 628 * MiB;
constexpr size_t WS_XNRM = 756 * MiB;
constexpr size_t WS_END = 757 * MiB;
constexpr int LDS_BYTES = 135168;
constexpr int NWAVES = 8;

__device__ __forceinline__ float bf2f(bf16_t v) { return __uint_as_float(((unsigned)v) << 16); }
__device__ __forceinline__ unsigned f2bf(float f) { unsigned u = __float_as_uint(f); u += 0x7fffu + ((u >> 16) & 1u); return u >> 16; }
__device__ __forceinline__ unsigned pk2(float lo, float hi) { return f2bf(lo) | (f2bf(hi) << 16); }
#define WAVE_SYNC() do { asm volatile("s_waitcnt lgkmcnt(0)" ::: "memory"); __builtin_amdgcn_wave_barrier(); } while (0)
template <int CTRL> __device__ __forceinline__ float dpp_f(float v) { return __uint_as_float((unsigned)__builtin_amdgcn_update_dpp(0, (int)__float_as_uint(v), CTRL, 0xF, 0xF, true)); }
__device__ __forceinline__ float row16_sum(float v) {
    v += dpp_f<0xB1>(v);
    v += dpp_f<0x4E>(v);
    v += dpp_f<0x141>(v);
    v += dpp_f<0x140>(v);
    return v;
}
__device__ __forceinline__ float wave_sum(float v) {
    v = row16_sum(v);
    v += __uint_as_float((unsigned)__builtin_amdgcn_ds_swizzle((int)__float_as_uint(v), 0x401F));
    auto rr = __builtin_amdgcn_permlane32_swap(__float_as_uint(v), __float_as_uint(v), false, false);
    return __uint_as_float(rr[0]) + __uint_as_float(rr[1]);
}

__device__ const unsigned char T5TAB[128] = {0, 1, 2, 3, 4, 5, 6, 7, 8, 9, 10, 11, 12, 13, 14, 15, 16, 16, 16, 17, 17, 18, 18, 18, 19, 19, 19, 20, 20, 20, 20, 21, 21, 21, 21, 22, 22, 22, 22, 22, 23, 23, 23, 23, 23, 23, 24, 24, 24, 24, 24, 24, 25, 25, 25, 25, 25, 25, 25, 26, 26, 26, 26, 26, 26, 26, 26, 27, 27, 27, 27, 27, 27, 27, 27, 27, 27, 28, 28, 28, 28, 28, 28, 28, 28, 28, 28, 29, 29, 29, 29, 29, 29, 29, 29, 29, 29, 29, 29, 30, 30, 30, 30, 30, 30, 30, 30, 30, 30, 30, 30, 30, 30, 31, 31, 31, 31, 31, 31, 31, 31, 31, 31, 31, 31, 31, 31, 31};

struct Args { const float* in[11]; float* out; unsigned char* ws; int ph_lo, ph_hi; };

__device__ __forceinline__ void p0_transpose_item(const float* W, int K, int N, int Npad, bf16_t* WT, const float* g, LAS float* scr, int item, int lane) {
    const int nblk = Npad / 32, kb = item / nblk, nb = item % nblk, k0 = 64 * kb, n0 = 32 * nb;
    const int nn = n0 + (lane & 31);
    float wv[32];
#pragma unroll
    for (int i = 0; i < 32; ++i) { const int kk = 2 * i + (lane >> 5); wv[i] = (nn < N) ? W[(size_t)(k0 + kk) * N + nn] : 0.f; }
    asm volatile("" : "+v"(wv[0]), "+v"(wv[1]), "+v"(wv[2]), "+v"(wv[3]), "+v"(wv[4]), "+v"(wv[5]), "+v"(wv[6]), "+v"(wv[7]), "+v"(wv[8]), "+v"(wv[9]), "+v"(wv[10]), "+v"(wv[11]), "+v"(wv[12]), "+v"(wv[13]), "+v"(wv[14]), "+v"(wv[15]));
    asm volatile("" : "+v"(wv[16]), "+v"(wv[17]), "+v"(wv[18]), "+v"(wv[19]), "+v"(wv[20]), "+v"(wv[21]), "+v"(wv[22]), "+v"(wv[23]), "+v"(wv[24]), "+v"(wv[25]), "+v"(wv[26]), "+v"(wv[27]), "+v"(wv[28]), "+v"(wv[29]), "+v"(wv[30]), "+v"(wv[31]));
#pragma unroll
    for (int i = 0; i < 32; ++i) { const int kk = 2 * i + (lane >> 5); float v = wv[i]; if (g) v *= g[k0 + kk]; scr[kk * 33 + (lane & 31)] = v; }
    WAVE_SYNC();
    const int c = lane & 7;
#pragma unroll
    for (int j = 0; j < 4; ++j) { const int n = (lane >> 3) + 8 * j; const LAS float* s = scr + (8 * c) * 33 + n;
        v4u o; o.x = pk2(s[0 * 33], s[1 * 33]); o.y = pk2(s[2 * 33], s[3 * 33]); o.z = pk2(s[4 * 33], s[5 * 33]); o.w = pk2(s[6 * 33], s[7 * 33]);
        *(v4u*)(WT + (size_t)(n0 + n) * K + k0 + 8 * c) = o; }
    WAVE_SYNC();
}
template <bool NORM> __device__ __forceinline__ void row_to_bf16(const float* xrow, bf16_t* orow, int lane) {
    const f32x4* xr = (const f32x4*)xrow + lane;
    f32x4 v[4]; float s = 0.f;
#pragma unroll
    for (int j = 0; j < 4; ++j) { v[j] = xr[64 * j]; s += (v[j].x * v[j].x + v[j].y * v[j].y) + (v[j].z * v[j].z + v[j].w * v[j].w); }
    float r = 1.f;
    if (NORM) r = 1.0f / sqrtf(wave_sum(s) * (1.f / DM) + EPS);
    v2u* o8 = (v2u*)orow + lane;
#pragma unroll
    for (int j = 0; j < 4; ++j) { v2u w; w.x = pk2(v[j].x * r, v[j].y * r); w.y = pk2(v[j].z * r, v[j].w * r); o8[64 * j] = w; }
}

__device__ __forceinline__ v4u ckv_load(const bf16_t* PROJ, int row0, int lane) { return *(const v4u*)(PROJ + (size_t)(row0 + (lane >> 4)) * LDP + C_CKV + (lane & 15) * 8); }
__device__ __forceinline__ void ckv_finish(const v4u v, const float* kvg, bf16_t* CKVN, int row0, int lane) {
    const int row = row0 + (lane >> 4), c8 = (lane & 15) * 8;
    float f[8] = {__uint_as_float(v.x << 16), __uint_as_float(v.x & 0xffff0000u), __uint_as_float(v.y << 16), __uint_as_float(v.y & 0xffff0000u),
                  __uint_as_float(v.z << 16), __uint_as_float(v.z & 0xffff0000u), __uint_as_float(v.w << 16), __uint_as_float(v.w & 0xffff0000u)};
    float s = 0.f;
#pragma unroll
    for (int j = 0; j < 8; ++j) s += f[j] * f[j];
    s = row16_sum(s);
    const float r = 1.0f / sqrtf(s * (1.0f / 128.f) + EPS);
    const f32x4 g0 = *(const f32x4*)(kvg + c8), g1 = *(const f32x4*)(kvg + c8 + 4);
    v4u o; o.x = pk2(f[0] * r * g0.x, f[1] * r * g0.y); o.y = pk2(f[2] * r * g0.z, f[3] * r * g0.w); o.z = pk2(f[4] * r * g1.x, f[5] * r * g1.y); o.w = pk2(f[6] * r * g1.z, f[7] * r * g1.w);
    *(v4u*)(CKVN + (size_t)row * 128 + c8) = o;
}
__device__ __forceinline__ void ckvnorm4(const bf16_t* PROJ, const float* kvg, bf16_t* CKVN, int row0, int lane) {
    const int row = row0 + (lane >> 4), c8 = (lane & 15) * 8;
    const v4u v = *(const v4u*)(PROJ + (size_t)row * LDP + C_CKV + c8);
    float f[8] = {__uint_as_float(v.x << 16), __uint_as_float(v.x & 0xffff0000u), __uint_as_float(v.y << 16), __uint_as_float(v.y & 0xffff0000u),
                  __uint_as_float(v.z << 16), __uint_as_float(v.z & 0xffff0000u), __uint_as_float(v.w << 16), __uint_as_float(v.w & 0xffff0000u)};
    float s = 0.f;
#pragma unroll
    for (int j = 0; j < 8; ++j) s += f[j] * f[j];
    s = row16_sum(s);
    const float r = 1.0f / sqrtf(s * (1.0f / 128.f) + EPS);
    const f32x4 g0 = *(const f32x4*)(kvg + c8), g1 = *(const f32x4*)(kvg + c8 + 4);
    v4u o; o.x = pk2(f[0] * r * g0.x, f[1] * r * g0.y); o.y = pk2(f[2] * r * g0.z, f[3] * r * g0.w); o.z = pk2(f[4] * r * g1.x, f[5] * r * g1.y); o.w = pk2(f[6] * r * g1.z, f[7] * r * g1.w);
    *(v4u*)(CKVN + (size_t)row * 128 + c8) = o;
}
__device__ __forceinline__ unsigned ordkey(float f) { unsigned u = __float_as_uint(f); return (u & 0x80000000u) ? ~u : (u | 0x80000000u); }
template <bool L0> __device__ __forceinline__ void post_row(const float* xin, const bf16_t* Y, const float* g, float* xout, bf16_t* X1b, bf16_t* Hn, int row, int lane) {
    const bf16_t* yp = Y + (size_t)row * DM;
    float yv[16]; float s = 0.f;
#pragma unroll
    for (int j = 0; j < 4; ++j) {
        const v2u v = *(const v2u*)(yp + (lane + 64 * j) * 4);
        yv[4 * j + 0] = __uint_as_float(v.x << 16); yv[4 * j + 1] = __uint_as_float(v.x & 0xffff0000u);
        yv[4 * j + 2] = __uint_as_float(v.y << 16); yv[4 * j + 3] = __uint_as_float(v.y & 0xffff0000u);
        s += yv[4 * j] * yv[4 * j] + yv[4 * j + 1] * yv[4 * j + 1] + yv[4 * j + 2] * yv[4 * j + 2] + yv[4 * j + 3] * yv[4 * j + 3];
    }
    const float r = 1.0f / sqrtf(wave_sum(s) * (1.0f / DM) + EPS);
    f32x4 ov[4]; float s2 = 0.f;
#pragma unroll
    for (int j = 0; j < 4; ++j) {
        const int c = (lane + 64 * j) * 4;
        f32x4 xv;
        if (L0) xv = *(const f32x4*)(xin + (size_t)row * DM + c);
        else { const v2u xb = *(const v2u*)(X1b + (size_t)row * DM + c); xv.x = __uint_as_float(xb.x << 16); xv.y = __uint_as_float(xb.x & 0xffff0000u); xv.z = __uint_as_float(xb.y << 16); xv.w = __uint_as_float(xb.y & 0xffff0000u); }
        const f32x4 gv = *(const f32x4*)(g + c);
        ov[j].x = xv.x + yv[4 * j] * r * gv.x; ov[j].y = xv.y + yv[4 * j + 1] * r * gv.y; ov[j].z = xv.z + yv[4 * j + 2] * r * gv.z; ov[j].w = xv.w + yv[4 * j + 3] * r * gv.w;
        if (L0) { v2u w; w.x = pk2(ov[j].x, ov[j].y); w.y = pk2(ov[j].z, ov[j].w); *(v2u*)(X1b + (size_t)row * DM + c) = w; }
        else *(f32x4*)(xout + (size_t)row * DM + c) = ov[j];
        s2 += (ov[j].x * ov[j].x + ov[j].y * ov[j].y) + (ov[j].z * ov[j].z + ov[j].w * ov[j].w);
    }
    if (Hn) {
        const float r2 = 1.0f / sqrtf(wave_sum(s2) * (1.f / DM) + EPS);
        v2u* o8 = (v2u*)(Hn + (size_t)row * DM) + lane;
#pragma unroll
        for (int j = 0; j < 4; ++j) { v2u w; w.x = pk2(ov[j].x * r2, ov[j].y * r2); w.y = pk2(ov[j].z * r2, ov[j].w * r2); o8[64 * j] = w; }
    }
}
template <bool L0, int NR> __device__ __forceinline__ void post_rowsN(const float* xin, const bf16_t* Y, const float* g, float* xout, bf16_t* X1b, bf16_t* Hn, int row, int lane, float* XNRM  ) {
    v2u yq[NR][4], xb[NR][4]; f32x4 gq[4];
#pragma unroll
    for (int q = 0; q < NR; ++q)
#pragma unroll
        for (int j = 0; j < 4; ++j) {
            const int c = (lane + 64 * j) * 4;
            yq[q][j] = *(const v2u*)(Y + (size_t)(row + q) * DM + c);
            xb[q][j] = *(const v2u*)(X1b + (size_t)(row + q) * DM + c);
        }
#pragma unroll
    for (int j = 0; j < 4; ++j) gq[j] = *(const f32x4*)(g + (lane + 64 * j) * 4);
    float xs[NR];
#pragma unroll
    for (int q = 0; q < NR; ++q) xs[q] = XNRM[row + q];
    asm volatile("" : "+v"(gq[0]), "+v"(gq[1]), "+v"(gq[2]), "+v"(gq[3]));
#pragma unroll
    for (int q = 0; q < NR; q += 2)
        asm volatile("" : "+v"(yq[q][0]), "+v"(yq[q][1]), "+v"(yq[q][2]), "+v"(yq[q][3]), "+v"(yq[q + 1][0]), "+v"(yq[q + 1][1]), "+v"(yq[q + 1][2]), "+v"(yq[q + 1][3]),
                          "+v"(xb[q][0]), "+v"(xb[q][1]), "+v"(xb[q][2]), "+v"(xb[q][3]), "+v"(xb[q + 1][0]), "+v"(xb[q + 1][1]), "+v"(xb[q + 1][2]), "+v"(xb[q + 1][3]), "+v"(xs[q]), "+v"(xs[q + 1]));
#pragma unroll
    for (int q = 0; q < NR; ++q) {
        float yv[16]; float s = 0.f;
#pragma unroll
        for (int j = 0; j < 4; ++j) {
            const v2u v = yq[q][j];
            yv[4 * j + 0] = __uint_as_float(v.x << 16); yv[4 * j + 1] = __uint_as_float(v.x & 0xffff0000u);
            yv[4 * j + 2] = __uint_as_float(v.y << 16); yv[4 * j + 3] = __uint_as_float(v.y & 0xffff0000u);
            s += yv[4 * j] * yv[4 * j] + yv[4 * j + 1] * yv[4 * j + 1] + yv[4 * j + 2] * yv[4 * j + 2] + yv[4 * j + 3] * yv[4 * j + 3];
        }
        const float r = 1.0f / sqrtf(wave_sum(s) * (1.0f / DM) + EPS);
        f32x4 ov[4]; float s2 = 0.f;
#pragma unroll
        for (int j = 0; j < 4; ++j) {
            const int c = (lane + 64 * j) * 4;
            f32x4 xv;
            { const v2u b2 = xb[q][j]; xv.x = __uint_as_float(b2.x << 16) * xs[q]; xv.y = __uint_as_float(b2.x & 0xffff0000u) * xs[q]; xv.z = __uint_as_float(b2.y << 16) * xs[q]; xv.w = __uint_as_float(b2.y & 0xffff0000u) * xs[q]; }
            const f32x4 gv = gq[j];
            ov[j].x = xv.x + yv[4 * j] * r * gv.x; ov[j].y = xv.y + yv[4 * j + 1] * r * gv.y; ov[j].z = xv.z + yv[4 * j + 2] * r * gv.z; ov[j].w = xv.w + yv[4 * j + 3] * r * gv.w;
            if (!L0) *(f32x4*)(xout + (size_t)(row + q) * DM + c) = ov[j];
            s2 += (ov[j].x * ov[j].x + ov[j].y * ov[j].y) + (ov[j].z * ov[j].z + ov[j].w * ov[j].w);
        }
        if (Hn) {
            const float nrm = sqrtf(wave_sum(s2) * (1.f / DM) + EPS), r2 = 1.0f / nrm;
            if (lane == 0) XNRM[row + q] = nrm;
            v2u* o8 = (v2u*)(Hn + (size_t)(row + q) * DM) + lane;
#pragma unroll
            for (int j = 0; j < 4; ++j) { v2u w; w.x = pk2(ov[j].x * r2, ov[j].y * r2); w.y = pk2(ov[j].z * r2, ov[j].w * r2); o8[64 * j] = w; }
        }
    }
}
__device__ __forceinline__ void rows4_cvt_bf16(const float* xrow, bf16_t* orow, int lane) {
    f32x4 v[4][4];
#pragma unroll
    for (int q = 0; q < 4; ++q)
#pragma unroll
        for (int j = 0; j < 4; ++j) v[q][j] = ((const f32x4*)(xrow + (size_t)q * DM) + lane)[64 * j];
#pragma unroll
    for (int q = 0; q < 4; q += 2) asm volatile("" : "+v"(v[q][0]), "+v"(v[q][1]), "+v"(v[q][2]), "+v"(v[q][3]), "+v"(v[q + 1][0]), "+v"(v[q + 1][1]), "+v"(v[q + 1][2]), "+v"(v[q + 1][3]));
#pragma unroll
    for (int q = 0; q < 4; ++q) {
        v2u* o8 = (v2u*)(orow + (size_t)q * DM) + lane;
#pragma unroll
        for (int j = 0; j < 4; ++j) { v2u w; w.x = pk2(v[q][j].x, v[q][j].y); w.y = pk2(v[q][j].z, v[q][j].w); o8[64 * j] = w; }
    }
}
template <int NR> __device__ __forceinline__ void rowsN_norm_bf16(const float* xrow, bf16_t* orow, int lane, float* nrm_out  ) {
    f32x4 v[NR][4];
#pragma unroll
    for (int q = 0; q < NR; ++q)
#pragma unroll
        for (int j = 0; j < 4; ++j) v[q][j] = ((const f32x4*)(xrow + (size_t)q * DM) + lane)[64 * j];
#pragma unroll
    for (int q = 0; q < NR; q += 2) asm volatile("" : "+v"(v[q][0]), "+v"(v[q][1]), "+v"(v[q][2]), "+v"(v[q][3]), "+v"(v[q + 1][0]), "+v"(v[q + 1][1]), "+v"(v[q + 1][2]), "+v"(v[q + 1][3]));
#pragma unroll
    for (int q = 0; q < NR; ++q) {
        float s = 0.f;
#pragma unroll
        for (int j = 0; j < 4; ++j) s += (v[q][j].x * v[q][j].x + v[q][j].y * v[q][j].y) + (v[q][j].z * v[q][j].z + v[q][j].w * v[q][j].w);
        const float nrm = sqrtf(wave_sum(s) * (1.f / DM) + EPS), r = 1.0f / nrm;
        if (lane == 0) nrm_out[q] = nrm;
        v2u* o8 = (v2u*)(orow + (size_t)q * DM) + lane;
#pragma unroll
        for (int j = 0; j < 4; ++j) { v2u w; w.x = pk2(v[q][j].x * r, v[q][j].y * r); w.y = pk2(v[q][j].z * r, v[q][j].w * r); o8[64 * j] = w; }
    }
}

typedef short bf16x8 __attribute__((ext_vector_type(8)));
typedef short s16x4 __attribute__((ext_vector_type(4)));
typedef float f32x16 __attribute__((ext_vector_type(16)));
typedef float f32x2_t __attribute__((ext_vector_type(2)));
typedef __bf16 bf16x2_t __attribute__((ext_vector_type(2)));
#define MFMA32(a, b, c) __builtin_amdgcn_mfma_f32_32x32x16_bf16((a), (b), (c), 0, 0, 0)
__device__ __forceinline__ unsigned cvtpk(float lo, float hi) { f32x2_t v = {lo, hi}; bf16x2_t b = __builtin_convertvector(v, bf16x2_t); return __builtin_bit_cast(unsigned, b); }
__device__ __forceinline__ s16x4 vtr(const LAS unsigned char* p) { return __builtin_bit_cast(s16x4, __builtin_amdgcn_ds_read_tr16_b64_v4i16((LAS s16x4*)p)); }
__device__ __forceinline__ int crow(int r, int hi) { return (r & 3) + 8 * (r >> 2) + 4 * hi; }
__device__ __forceinline__ bf16x8 pack8(const f32x16& x, int s) {
    v4u p; p.x = cvtpk(x[8 * s + 0], x[8 * s + 1]); p.y = cvtpk(x[8 * s + 2], x[8 * s + 3]); p.z = cvtpk(x[8 * s + 4], x[8 * s + 5]); p.w = cvtpk(x[8 * s + 6], x[8 * s + 7]);
    return __builtin_bit_cast(bf16x8, p);
}
__device__ __forceinline__ f32x16 zero16() { float z; asm volatile("v_mov_b32 %0, 0" : "=v"(z)); return (f32x16){z, z, z, z, z, z, z, z, z, z, z, z, z, z, z, z}; }
__device__ __forceinline__ bf16x8 cat44(s16x4 lo, s16x4 hi) { return __builtin_shufflevector(lo, hi, 0, 1, 2, 3, 4, 5, 6, 7); }
__device__ __forceinline__ float xhalf_max(float v) { auto rr = __builtin_amdgcn_permlane32_swap(__float_as_uint(v), __float_as_uint(v), false, false); return fmaxf(__uint_as_float(rr[0]), __uint_as_float(rr[1])); }
__device__ __forceinline__ float xhalf_sum(float v) { auto rr = __builtin_amdgcn_permlane32_swap(__float_as_uint(v), __float_as_uint(v), false, false); return __uint_as_float(rr[0]) + __uint_as_float(rr[1]); }
__device__ __forceinline__ unsigned xhalf_other_u(unsigned v, int hi) { auto rr = __builtin_amdgcn_permlane32_swap(v, v, false, false); return hi ? rr[0] : rr[1]; }
__device__ __forceinline__ float xhalf_other(float v, int hi) { return __uint_as_float(xhalf_other_u(__float_as_uint(v), hi)); }
constexpr int VT_PITCH = 192;
constexpr float LOG2E = 1.4426950408889634f;

__device__ __forceinline__ void pv_tile(f32x16 (&O)[2], const LAS unsigned char* vrd, bf16x8 p0, bf16x8 p1) {
#pragma unroll
    for (int c = 0; c < 2; ++c) {
        const bf16x8 a0 = cat44(vtr(vrd + 0 * VT_PITCH + 64 * c), vtr(vrd + 8 * VT_PITCH + 64 * c));
        const bf16x8 a1 = cat44(vtr(vrd + 16 * VT_PITCH + 64 * c), vtr(vrd + 24 * VT_PITCH + 64 * c));
        O[c] = MFMA32(a0, p0, O[c]);
        O[c] = MFMA32(a1, p1, O[c]);
    }
}
__device__ __forceinline__ void gate_store(const f32x16 (&O)[2], float scale, const bf16_t* grow, bf16_t* orow, int hi) {
#pragma unroll
    for (int c = 0; c < 2; ++c)
#pragma unroll
        for (int g = 0; g < 4; ++g) {
            const int d = 32 * c + 8 * g + 4 * hi;
            const v2u gv = *(const v2u*)(grow + d);
            float gt[4] = {__uint_as_float(gv.x << 16), __uint_as_float(gv.x & 0xffff0000u), __uint_as_float(gv.y << 16), __uint_as_float(gv.y & 0xffff0000u)};
            float ov[4];
#pragma unroll
            for (int j = 0; j < 4; ++j) ov[j] = O[c][4 * g + j] * scale * gt[j] * __builtin_amdgcn_rcpf(1.f + __builtin_amdgcn_exp2f(-gt[j] * LOG2E));
            v2u w; w.x = cvtpk(ov[0], ov[1]); w.y = cvtpk(ov[2], ov[3]);
            *(v2u*)(orow + d) = w;
        }
}

__device__ __forceinline__ void gate_load(v2u (&gw)[8], const bf16_t* grow, int hi) {
#pragma unroll
    for (int c = 0; c < 2; ++c)
#pragma unroll
        for (int g = 0; g < 4; ++g) gw[c * 4 + g] = *(const v2u*)(grow + 32 * c + 8 * g + 4 * hi);
}
__device__ __forceinline__ void gate_store_pre(const f32x16 (&O)[2], float scale, const v2u (&gw)[8], bf16_t* orow, int hi) {
#pragma unroll
    for (int c = 0; c < 2; ++c)
#pragma unroll
        for (int g = 0; g < 4; ++g) {
            const int d = 32 * c + 8 * g + 4 * hi;
            const v2u gv = gw[c * 4 + g];
            float gt[4] = {__uint_as_float(gv.x << 16), __uint_as_float(gv.x & 0xffff0000u), __uint_as_float(gv.y << 16), __uint_as_float(gv.y & 0xffff0000u)};
            float ov[4];
#pragma unroll
            for (int j = 0; j < 4; ++j) ov[j] = O[c][4 * g + j] * scale * gt[j] * __builtin_amdgcn_rcpf(1.f + __builtin_amdgcn_exp2f(-gt[j] * LOG2E));
            v2u w; w.x = cvtpk(ov[0], ov[1]); w.y = cvtpk(ov[2], ov[3]);
            *(v2u*)(orow + d) = w;
        }
}

__device__ __forceinline__ void sb_item(const bf16_t* PROJ, bf16_t* MIX, int b, int h, int qt, int lane, LAS unsigned char* wl) {
    asm volatile("" : "+v"(lane));
    const int r32 = lane & 31, hi = lane >> 5;
    const bf16_t* base = PROJ + (size_t)b * SEQ * LDP;
    const int t = 32 * qt + r32;
    bf16x8 qf[4];
#pragma unroll
    for (int ks = 0; ks < 4; ++ks) qf[ks] = *(const bf16x8*)(base + (size_t)t * LDP + C_SBQ + h * 64 + 16 * ks + 8 * hi);
    v2u gw[8]; gate_load(gw, base + (size_t)t * LDP + C_SBG + h * 64, hi);
    const int vrow = lane >> 3, vch = lane & 7;
    LAS unsigned char* vwr = wl + vrow * VT_PITCH + vch * 16;
    const LAS unsigned char* vrd = wl + (4 * hi + ((lane & 15) >> 2)) * VT_PITCH + (16 * ((lane >> 4) & 1) + 4 * (lane & 3)) * 2;
    bf16x8 kc[4], vc[4];
    {
        const bf16_t* kp = base + (size_t)(32 * qt + r32) * LDP + C_SBK + h * 64 + 8 * hi;
#pragma unroll
        for (int ks = 0; ks < 4; ++ks) kc[ks] = *(const bf16x8*)(kp + 16 * ks);
        const bf16_t* vp = base + (size_t)(32 * qt + vrow) * LDP + C_SBV + h * 64 + 8 * vch;
#pragma unroll
        for (int i = 0; i < 4; ++i) vc[i] = *(const bf16x8*)(vp + (size_t)(8 * i) * LDP);
    }
    f32x16 O[2];
#pragma unroll
    for (int r = 0; r < 16; ++r) { O[0][r] = 0.f; O[1][r] = 0.f; }
    float R = 1.f;
    for (int kt = qt; kt >= 0; --kt) {
        bf16x8 kn[4], vn[4];
        {
            const int ktn = kt > 0 ? kt - 1 : 0;
            const bf16_t* kp = base + (size_t)(32 * ktn + r32) * LDP + C_SBK + h * 64 + 8 * hi;
#pragma unroll
            for (int ks = 0; ks < 4; ++ks) kn[ks] = *(const bf16x8*)(kp + 16 * ks);
            const bf16_t* vp = base + (size_t)(32 * ktn + vrow) * LDP + C_SBV + h * 64 + 8 * vch;
#pragma unroll
            for (int i = 0; i < 4; ++i) vn[i] = *(const bf16x8*)(vp + (size_t)(8 * i) * LDP);
        }
        f32x16 acc;
#pragma unroll
        for (int r = 0; r < 16; ++r) acc[r] = 0.f;
#pragma unroll
        for (int ks = 0; ks < 4; ++ks) acc = MFMA32(kc[ks], qf[ks], acc);
#pragma unroll
        for (int i = 0; i < 4; ++i) *(LAS bf16x8*)(vwr + (8 * i) * VT_PITCH) = vc[i];
        float be[16], om[16];
        const bool diag = (kt == qt);
#pragma unroll
        for (int r = 0; r < 16; ++r) {
            const float e = __builtin_amdgcn_exp2f(fminf(acc[r] * (-0.125f * LOG2E), 115.f));
            float bt = __builtin_amdgcn_rcpf(1.f + e), o1 = e * bt;
            if (diag && !(crow(r, hi) < r32)) { bt = 0.f; o1 = 1.f; }
            be[r] = bt; om[r] = o1;
        }
        float Gp[4], Gq[4];
#pragma unroll
        for (int g = 0; g < 4; ++g) { Gp[g] = (om[4 * g] * om[4 * g + 1]) * (om[4 * g + 2] * om[4 * g + 3]); Gq[g] = xhalf_other(Gp[g], hi); }
        const float T1 = Gp[1] * Gq[1], T2 = Gp[2] * Gq[2], T3 = Gp[3] * Gq[3], T0 = Gp[0] * Gq[0];
        float tail[4]; tail[3] = R; tail[2] = R * T3; tail[1] = tail[2] * T2; tail[0] = tail[1] * T1;
        const float Rn = tail[0] * T0;
#pragma unroll
        for (int g = 0; g < 4; ++g) {
            float sfx = tail[g] * (hi == 0 ? Gq[g] : 1.f);
            acc[4 * g + 3] = be[4 * g + 3] * sfx; sfx *= om[4 * g + 3];
            acc[4 * g + 2] = be[4 * g + 2] * sfx; sfx *= om[4 * g + 2];
            acc[4 * g + 1] = be[4 * g + 1] * sfx; sfx *= om[4 * g + 1];
            acc[4 * g + 0] = be[4 * g + 0] * sfx;
        }
        R = Rn;
        const bf16x8 p0 = pack8(acc, 0), p1 = pack8(acc, 1);
        pv_tile(O, vrd, p0, p1);
        if (__all(R < 5.4210109e-20f)) break;
#pragma unroll
        for (int i = 0; i < 4; ++i) { kc[i] = kn[i]; vc[i] = vn[i]; }
    }
    gate_store_pre(O, 1.f, gw, MIX + ((size_t)b * SEQ + t) * DM + h * 64, hi);
}

__device__ __forceinline__ void mem_item(const bf16_t* PROJ, const bf16_t* KV, bf16_t* MIX, int b, int h, int qt, int lane, LAS unsigned char* wl) {
    asm volatile("" : "+v"(lane));
    float NINF; asm volatile("v_mov_b32 %0, 0xff800000" : "=v"(NINF));
    const int r32 = lane & 31, hi = lane >> 5;
    const int t = 32 * qt + r32;
    const bf16_t* prow = PROJ + ((size_t)b * SEQ + t) * LDP;
    bf16x8 qf[4];
#pragma unroll
    for (int ks = 0; ks < 4; ++ks) qf[ks] = *(const bf16x8*)(prow + C_MQ + h * 64 + 16 * ks + 8 * hi);
    const int vrow = lane >> 3, vch = lane & 7;
    LAS unsigned char* vwr = wl + vrow * VT_PITCH + vch * 16;
    const LAS unsigned char* vrd = wl + (4 * hi + ((lane & 15) >> 2)) * VT_PITCH + (16 * ((lane >> 4) & 1) + 4 * (lane & 3)) * 2;
    const bf16_t* kvb = KV + (size_t)b * NMEM * 1024 + h * 64;
    f32x16 O[2];
#pragma unroll
    for (int r = 0; r < 16; ++r) { O[0][r] = 0.f; O[1][r] = 0.f; }
    float mrun = NINF, lrun = 0.f;
    v2u gw[8]; gate_load(gw, prow + C_MG + h * 64, hi);
    bf16x8 kc[4], vc[4];
    {
        const bf16_t* kp = kvb + (size_t)r32 * 1024 + 8 * hi;
#pragma unroll
        for (int ks = 0; ks < 4; ++ks) kc[ks] = *(const bf16x8*)(kp + 16 * ks);
        const bf16_t* vp = kvb + (size_t)vrow * 1024 + 256 + 8 * vch;
#pragma unroll
        for (int i = 0; i < 4; ++i) vc[i] = *(const bf16x8*)(vp + (size_t)(8 * i) * 1024);
    }
    for (int kt = 0; kt < NMEM / 32; ++kt) {
        bf16x8 kn[4], vn[4];
        {
            const int ktn = kt < NMEM / 32 - 1 ? kt + 1 : kt;
            const bf16_t* kp = kvb + (size_t)(32 * ktn + r32) * 1024 + 8 * hi;
#pragma unroll
            for (int ks = 0; ks < 4; ++ks) kn[ks] = *(const bf16x8*)(kp + 16 * ks);
            const bf16_t* vp = kvb + (size_t)(32 * ktn + vrow) * 1024 + 256 + 8 * vch;
#pragma unroll
            for (int i = 0; i < 4; ++i) vn[i] = *(const bf16x8*)(vp + (size_t)(8 * i) * 1024);
        }
        f32x16 acc;
#pragma unroll
        for (int r = 0; r < 16; ++r) acc[r] = 0.f;
#pragma unroll
        for (int ks = 0; ks < 4; ++ks) acc = MFMA32(kc[ks], qf[ks], acc);
#pragma unroll
        for (int i = 0; i < 4; ++i) *(LAS bf16x8*)(vwr + (8 * i) * VT_PITCH) = vc[i];
        float mx = acc[0];
#pragma unroll
        for (int r = 1; r < 16; ++r) mx = fmaxf(mx, acc[r]);
        mx *= 0.125f * LOG2E;
        mx = xhalf_max(mx);
        const float mn = fmaxf(mrun, mx), alpha = __builtin_amdgcn_exp2f(mrun - mn);
        float ps = 0.f;
#pragma unroll
        for (int r = 0; r < 16; ++r) { acc[r] = __builtin_amdgcn_exp2f(acc[r] * (0.125f * LOG2E) - mn); ps += acc[r]; }
        lrun = lrun * alpha + ps; mrun = mn;
#pragma unroll
        for (int r = 0; r < 16; ++r) { O[0][r] *= alpha; O[1][r] *= alpha; }
        const bf16x8 p0 = pack8(acc, 0), p1 = pack8(acc, 1);
        pv_tile(O, vrd, p0, p1);
#pragma unroll
        for (int i = 0; i < 4; ++i) { kc[i] = kn[i]; vc[i] = vn[i]; }
    }
    const float lt = xhalf_sum(lrun);
    gate_store_pre(O, 1.f / lt, gw, MIX + ((size_t)b * SEQ + t) * DM + 768 + h * 64, hi);
}

constexpr int MEML_V_OFF = 32768;
__device__ __forceinline__ void mem_stage(const bf16_t* KV, int b, int h, int tid, LAS unsigned char* L) {
    const bf16_t* kvb = KV + (size_t)b * NMEM * 1024 + h * 64;
#pragma unroll
    for (int i = 0; i < 4; ++i) {
        const int idx = tid + 512 * i, key = idx >> 3, ch = idx & 7;
        const v4u kx = *(const v4u*)(kvb + (size_t)key * 1024 + 8 * ch), vx = *(const v4u*)(kvb + (size_t)key * 1024 + 256 + 8 * ch);
        *(LAS v4u*)(L + 128 * key + 16 * (ch ^ ((key >> 1) & 7))) = kx;
        *(LAS v4u*)(L + MEML_V_OFF + (key >> 5) * (32 * VT_PITCH) + (key & 31) * VT_PITCH + 16 * ch) = vx;
    }
}
__device__ __forceinline__ void mem_item_lds(const bf16_t* PROJ, bf16_t* MIX, int b, int h, int qt, int lane, const LAS unsigned char* L) {
    asm volatile("" : "+v"(lane));
    float NINF; asm volatile("v_mov_b32 %0, 0xff800000" : "=v"(NINF));
    const int r32 = lane & 31, hi = lane >> 5;
    const int t = 32 * qt + r32;
    const bf16_t* prow = PROJ + ((size_t)b * SEQ + t) * LDP;
    bf16x8 qf[4];
#pragma unroll
    for (int ks = 0; ks < 4; ++ks) qf[ks] = *(const bf16x8*)(prow + C_MQ + h * 64 + 16 * ks + 8 * hi);
    v2u gw[8]; gate_load(gw, prow + C_MG + h * 64, hi);
    const unsigned kx = ((unsigned)r32 >> 1) & 7u;
    const LAS unsigned char* krd = L + 128 * r32;
    const LAS unsigned char* vrd = L + MEML_V_OFF + (4 * hi + ((lane & 15) >> 2)) * VT_PITCH + (16 * ((lane >> 4) & 1) + 4 * (lane & 3)) * 2;
    f32x16 O[2];
    O[0] = zero16(); O[1] = zero16();
    float mrun = NINF, lrun = 0.f;
#pragma unroll 2
    for (int kt = 0; kt < NMEM / 32; ++kt) {
        bf16x8 kc[4];
#pragma unroll
        for (int ks = 0; ks < 4; ++ks) kc[ks] = *(const LAS bf16x8*)(krd + 4096 * kt + 16 * ((unsigned)(2 * ks + hi) ^ kx));
        f32x16 acc;
#pragma unroll
        for (int r = 0; r < 16; ++r) acc[r] = 0.f;
#pragma unroll
        for (int ks = 0; ks < 4; ++ks) acc = MFMA32(kc[ks], qf[ks], acc);
        float mx = acc[0];
#pragma unroll
        for (int r = 1; r < 16; ++r) mx = fmaxf(mx, acc[r]);
        mx *= 0.125f * LOG2E;
        mx = xhalf_max(mx);
        const float mn = fmaxf(mrun, mx), alpha = __builtin_amdgcn_exp2f(mrun - mn);
        float ps = 0.f;
#pragma unroll
        for (int r = 0; r < 16; ++r) { acc[r] = __builtin_amdgcn_exp2f(acc[r] * (0.125f * LOG2E) - mn); ps += acc[r]; }
        lrun = lrun * alpha + ps; mrun = mn;
#pragma unroll
        for (int r = 0; r < 16; ++r) { O[0][r] *= alpha; O[1][r] *= alpha; }
        const bf16x8 p0 = pack8(acc, 0), p1 = pack8(acc, 1);
        pv_tile(O, vrd + kt * (32 * VT_PITCH), p0, p1);
    }
    const float lt = xhalf_sum(lrun);
    gate_store_pre(O, 1.f / lt, gw, MIX + ((size_t)b * SEQ + t) * DM + 768 + h * 64, hi);
}

constexpr int SEL_IQ_PITCH = 528, SEL_CNT_OFF = 17408;
__device__ __forceinline__ unsigned ordkey(float f);
template <int PRED  >
__device__ __forceinline__ unsigned sel_count_round(const unsigned (&key)[8][16], unsigned c, unsigned tau, int idx0, int r32, int hi, int wave, LAS unsigned* cb) {
    int n = 0;
#pragma unroll
    for (int i = 0; i < 8; ++i) {
#pragma unroll
        for (int r = 0; r < 16; ++r) {
            if (PRED == 0) n += (key[i][r] >= c) ? 1 : 0;
            else if (PRED == 1) n += (key[i][r] > c) ? 1 : 0;
            else n += (key[i][r] == tau && (unsigned)(idx0 + 256 * i + (r & 3) + 8 * (r >> 2)) <= c) ? 1 : 0;
            if ((r & 7) == 7) asm volatile("" : "+v"(n));
        }
    }
    n += (int)xhalf_other_u((unsigned)n, hi);
    if (hi == 0) cb[wave * 32 + r32] = (unsigned)n;
    __syncthreads();
    unsigned tot = 0;
#pragma unroll
    for (int w = 0; w < 8; ++w) tot += cb[w * 32 + r32];
    return tot;
}
constexpr int SEL_CAP = 64, SEL_DONE = 16;
__device__ __forceinline__ float key2f(unsigned k) { return __uint_as_float((k & 0x80000000u) ? (k & 0x7fffffffu) : ~k); }
__device__ __forceinline__ void sel_cnt4(unsigned& n, unsigned k0, unsigned k1, unsigned k2, unsigned k3, unsigned c) {
    unsigned long long s0, s1, s2, s3;
    asm("v_cmp_ge_u32_e64 %1, %5, %9\n\tv_cmp_ge_u32_e64 %2, %6, %9\n\tv_cmp_ge_u32_e64 %3, %7, %9\n\tv_cmp_ge_u32_e64 %4, %8, %9\n\t"
        "v_addc_co_u32_e64 %0, %1, %0, 0, %1\n\tv_addc_co_u32_e64 %0, %2, %0, 0, %2\n\tv_addc_co_u32_e64 %0, %3, %0, 0, %3\n\tv_addc_co_u32_e64 %0, %4, %0, 0, %4"
        : "+v"(n), "=&s"(s0), "=&s"(s1), "=&s"(s2), "=&s"(s3) : "v"(k0), "v"(k1), "v"(k2), "v"(k3), "v"(c));
}
template <int O3, int O2, int O1, int O0> __device__ __forceinline__ void sel_bits4(unsigned& bits, unsigned k3, unsigned k2, unsigned k1, unsigned k0, int cl, unsigned tau) {
    unsigned long long s0, s1, s2, s3; unsigned t0, t1, t2, t3;
    asm("v_cmp_lt_i32_e64 %5, %13, %15\n\tv_cmp_lt_i32_e64 %6, %13, %16\n\tv_cmp_lt_i32_e64 %7, %13, %17\n\tv_cmp_lt_i32_e64 %8, %13, %18\n\t"
        "v_addc_co_u32_e64 %1, %5, %14, 0, %5\n\tv_addc_co_u32_e64 %2, %6, %14, 0, %6\n\tv_addc_co_u32_e64 %3, %7, %14, 0, %7\n\tv_addc_co_u32_e64 %4, %8, %14, 0, %8\n\t"
        "v_cmp_ge_u32_e64 %5, %9, %1\n\tv_cmp_ge_u32_e64 %6, %10, %2\n\tv_cmp_ge_u32_e64 %7, %11, %3\n\tv_cmp_ge_u32_e64 %8, %12, %4\n\t"
        "v_addc_co_u32_e64 %0, %5, %0, %0, %5\n\tv_addc_co_u32_e64 %0, %6, %0, %0, %6\n\tv_addc_co_u32_e64 %0, %7, %0, %0, %7\n\tv_addc_co_u32_e64 %0, %8, %0, %0, %8"
        : "+v"(bits), "=&v"(t3), "=&v"(t2), "=&v"(t1), "=&v"(t0), "=&s"(s0), "=&s"(s1), "=&s"(s2), "=&s"(s3)
        : "v"(k3), "v"(k2), "v"(k1), "v"(k0), "v"(cl), "v"(tau), "n"(O3), "n"(O2), "n"(O1), "n"(O0));
}
__device__ __forceinline__ unsigned sel_count_lane(const unsigned (&key)[8][16], unsigned c) {
    unsigned n = 0;
#pragma unroll
    for (int i = 0; i < 8; ++i) {
#pragma unroll
        for (int r = 0; r < 16; r += 4) sel_cnt4(n, key[i][r], key[i][r + 1], key[i][r + 2], key[i][r + 3], c);
    }
    return n;
}
__device__ __forceinline__ unsigned sel_exchange(unsigned nl, int r32, int hi, int wave, LAS unsigned* cb) {
    const unsigned n2 = nl + xhalf_other_u(nl, hi);
    if (hi == 0) cb[wave * 32 + r32] = n2;
    __syncthreads();
    unsigned tot = 0;
#pragma unroll
    for (int w = 0; w < 8; ++w) tot += cb[w * 32 + r32];
    return tot;
}
__device__ __forceinline__ void sel_item2(const bf16_t* PROJ, unsigned* MASK, int b, int qt, int lane, int wave, LAS unsigned char* L) {
    asm volatile("" : "+v"(lane));
    const int r32 = lane & 31, hi = lane >> 5, tid = wave * 64 + lane;
    LAS unsigned* cntb = (LAS unsigned*)(L + SEL_CNT_OFF);
    const bf16_t* base = PROJ + (size_t)b * SEQ * LDP;
    unsigned* mrow = MASK + (((size_t)b * 64 + qt) * 64) * 32;
    if (qt < 8) {
#pragma unroll
        for (int i = 0; i < 8; ++i) {
            const int kt = wave + 8 * i;
            if (kt <= qt) {
                unsigned bits = 0u;
#pragma unroll
                for (int r = 0; r < 16; ++r) bits |= ((kt < qt) || (crow(r, hi) <= r32)) ? (1u << r) : 0u;
                const unsigned other = xhalf_other_u(bits, hi);
                if (hi == 0) mrow[kt * 32 + r32] = bits | (other << 16);
            }
        }
        return;
    }
    for (int n = tid; n < 1024; n += 512) { const int row = n >> 5, ch = n & 31;
        const v4u v = *(const v4u*)(base + (size_t)(32 * qt + row) * LDP + C_IDQ + ch * 8);
        *(LAS v4u*)(L + row * SEL_IQ_PITCH + ch * 16) = v; }
    float w8[8];
    { const v4u wv = *(const v4u*)(base + (size_t)(32 * qt + r32) * LDP + C_IDW);
      w8[0] = __uint_as_float(wv.x << 16) * 0.0625f; w8[1] = __uint_as_float(wv.x & 0xffff0000u) * 0.0625f; w8[2] = __uint_as_float(wv.y << 16) * 0.0625f; w8[3] = __uint_as_float(wv.y & 0xffff0000u) * 0.0625f;
      w8[4] = __uint_as_float(wv.z << 16) * 0.0625f; w8[5] = __uint_as_float(wv.z & 0xffff0000u) * 0.0625f; w8[6] = __uint_as_float(wv.w << 16) * 0.0625f; w8[7] = __uint_as_float(wv.w & 0xffff0000u) * 0.0625f; }
    __syncthreads();
    unsigned key[8][16];
    const LAS unsigned char* iqp = L + r32 * SEL_IQ_PITCH + 16 * hi;
    unsigned kmn = 0xffffffffu, kmx = 0u;
#pragma unroll
    for (int i = 0; i < 8; ++i) {
        const int kt = wave + 8 * i;
        if (kt <= qt) {
            const bf16_t* kp = base + (size_t)(32 * kt + r32) * LDP + C_IDK + 8 * hi;
            const bf16x8 k0 = *(const bf16x8*)kp, k1 = *(const bf16x8*)(kp + 16);
            float sc[16];
#pragma unroll
            for (int r = 0; r < 16; ++r) sc[r] = 0.f;
            unsigned iqo = 0; asm volatile("" : "+v"(iqo));
            const LAS unsigned char* iqt = iqp + iqo;
#pragma unroll
            for (int hp = 0; hp < 4; ++hp) {
                const int h = 2 * hp;
                bf16x8 q0 = *(const LAS bf16x8*)(iqt + h * 64), q1 = *(const LAS bf16x8*)(iqt + h * 64 + 32);
                bf16x8 q2 = *(const LAS bf16x8*)(iqt + h * 64 + 64), q3 = *(const LAS bf16x8*)(iqt + h * 64 + 96);
                asm volatile("" : "+v"(q0), "+v"(q1), "+v"(q2), "+v"(q3) : "v"(sc[15]));
                f32x16 Da, Db;
#pragma unroll
                for (int r = 0; r < 16; ++r) { Da[r] = 0.f; Db[r] = 0.f; }
                Da = MFMA32(k0, q0, Da);
                Db = MFMA32(k0, q2, Db);
                Da = MFMA32(k1, q1, Da);
                Db = MFMA32(k1, q3, Db);
#pragma unroll
                for (int r = 0; r < 16; ++r) sc[r] = __builtin_fmaf(w8[h], __int_as_float(max(__float_as_int(Da[r]), 0)), sc[r]);
#pragma unroll
                for (int r = 0; r < 16; ++r) sc[r] = __builtin_fmaf(w8[h + 1], __int_as_float(max(__float_as_int(Db[r]), 0)), sc[r]);
                asm volatile("" : "+v"(sc[0]), "+v"(sc[1]), "+v"(sc[2]), "+v"(sc[3]), "+v"(sc[4]), "+v"(sc[5]), "+v"(sc[6]), "+v"(sc[7]),
                                  "+v"(sc[8]), "+v"(sc[9]), "+v"(sc[10]), "+v"(sc[11]), "+v"(sc[12]), "+v"(sc[13]), "+v"(sc[14]), "+v"(sc[15]));
            }
#pragma unroll
            for (int r = 0; r < 16; ++r) { const unsigned u = __float_as_uint(sc[r]); key[i][r] = u ^ ((unsigned)((int)u >> 31) | 0x80000000u); }
#pragma unroll
            for (int r = 0; r < 16; r += 2) { kmx = max(kmx, max(key[i][r], key[i][r + 1])); kmn = min(kmn, min(key[i][r], key[i][r + 1])); }
        } else {
#pragma unroll
            for (int r = 0; r < 16; ++r) key[i][r] = 0u;
        }
    }
    if ((qt & 7) == wave) {
        const int thr = r32 - 4 * hi;
#pragma unroll
        for (int i = 0; i < 8; ++i)
            if (i == (qt >> 3)) {
#pragma unroll
                for (int r = 0; r < 16; ++r) key[i][r] = ((r & 3) + 8 * (r >> 2) <= thr) ? key[i][r] : 0u;
            }
    }
    unsigned lo_key, hi_key, clo, chi = 0u, nlo_l, nhi_l = 0u;
    {
        int nv = 0;
#pragma unroll
        for (int i = 0; i < 8; ++i) { const int kt = wave + 8 * i; nv += (kt < qt) ? 16 : 0; }
        if ((qt & 7) == wave) { const int thr = r32 - 4 * hi;
#pragma unroll
            for (int r = 0; r < 16; ++r) nv += ((r & 3) + 8 * (r >> 2) <= thr) ? 1 : 0; }
        nlo_l = (unsigned)nv;
        kmn = min(kmn, xhalf_other_u(kmn, hi)); kmx = max(kmx, xhalf_other_u(kmx, hi));
        if (hi == 0) { cntb[wave * 32 + r32] = kmn; cntb[256 + wave * 32 + r32] = kmx; }
        __syncthreads();
        unsigned a = 0xffffffffu, bmx = 0u;
#pragma unroll
        for (int w = 0; w < 8; ++w) { a = min(a, cntb[w * 32 + r32]); bmx = max(bmx, cntb[256 + w * 32 + r32]); }
        lo_key = a; hi_key = bmx + 1u; clo = (unsigned)(32 * qt + r32 + 1);
        __syncthreads();
    }
    int round = 0;
    for (;;) {
        const bool done = (clo - chi <= (unsigned)SEL_DONE) || (hi_key - lo_key <= 1u);
        if (__all(done)) break;
        unsigned p;
        if ((round & 3) == 3) p = lo_key + ((hi_key - lo_key) >> 1);
        else p = ordkey(0.5f * key2f(lo_key) + 0.5f * key2f(hi_key));
        p = min(max(p, lo_key + 1u), hi_key - 1u);
        if (done) p = lo_key;
        const unsigned nl = sel_count_lane(key, p);
        const unsigned tot = sel_exchange(nl, r32, hi, wave, cntb + (round & 1) * 256);
        if (!done) { if (tot >= 256u) { lo_key = p; clo = tot; nlo_l = nl; } else { hi_key = p; chi = tot; nhi_l = nl; } }
        ++round;
    }
    unsigned tau, cut;
    const bool many = (clo - chi > (unsigned)SEL_CAP);
    {
        LAS unsigned* lanecnt = (LAS unsigned*)L; LAS unsigned* meta = (LAS unsigned*)(L + 2048); LAS unsigned* result = (LAS unsigned*)(L + 2304); LAS unsigned* list = (LAS unsigned*)(L + 20480);
        const int slot = wave * 2 + hi;
        lanecnt[r32 * 16 + slot] = many ? 0u : (nlo_l - nhi_l);
        if (slot == 0) { meta[2 * r32] = many ? 0u : (clo - chi); meta[2 * r32 + 1] = 256u - chi; }
        __syncthreads();
        unsigned bs = 0u;
#pragma unroll
        for (int s2 = 0; s2 < 16; ++s2) { const unsigned v = lanecnt[r32 * 16 + s2]; bs += (s2 < slot) ? v : 0u; }
        if (!many) {
            const int idx0 = 32 * wave + 4 * hi;
            LAS unsigned* lp = list + (r32 * SEL_CAP + bs) * 2;
#pragma unroll
            for (int i = 0; i < 8; ++i)
#pragma unroll
                for (int r = 0; r < 16; ++r) {
                    const unsigned k = key[i][r];
                    if (k >= lo_key && k < hi_key) { lp[0] = k; lp[1] = (unsigned)(idx0 + 256 * i + (r & 3) + 8 * (r >> 2)); lp += 2; }
                }
        }
        __syncthreads();
        for (int j = 0; j < 4; ++j) {
            const int q = 4 * wave + j;
            const unsigned ncand = (unsigned)__builtin_amdgcn_readfirstlane((int)meta[2 * q]), need = (unsigned)__builtin_amdgcn_readfirstlane((int)meta[2 * q + 1]);
            const LAS unsigned* lq = list + q * SEL_CAP * 2;
            const bool mine = (unsigned)lane < ncand;
            const unsigned kc = mine ? lq[2 * lane] : 0u, ic = mine ? lq[2 * lane + 1] : 0u;
            unsigned rank = 0u;
            for (unsigned c2 = 0; c2 < ncand; ++c2) {
                const unsigned k2 = (unsigned)__builtin_amdgcn_readlane((int)kc, (int)c2), i2 = (unsigned)__builtin_amdgcn_readlane((int)ic, (int)c2);
                rank += (k2 > kc || (k2 == kc && i2 < ic)) ? 1u : 0u;
            }
            if (mine && rank == need - 1u) { result[2 * q] = kc; result[2 * q + 1] = ic; }
        }
        __syncthreads();
        tau = result[2 * r32]; cut = result[2 * r32 + 1];
    }
    if (__any(many)) {
        const unsigned need = 256u - chi;
        const int idx0 = 32 * wave + 4 * hi;
        unsigned lo_ = 0u, hi_ = 2047u;
        for (int it = 0; it < 11; ++it) {
            const unsigned mid = (lo_ + hi_) >> 1;
            const unsigned f = sel_count_round<2>(key, mid, lo_key, idx0, r32, hi, wave, cntb + (it & 1) * 256);
            if (f >= need) hi_ = mid; else lo_ = mid + 1;
        }
        if (many) { tau = lo_key; cut = hi_; }
    }
    {
        const int idx0 = 32 * wave + 4 * hi;
#pragma unroll
        for (int i = 0; i < 8; ++i) {
            const int kt = wave + 8 * i;
            if (kt <= qt) {
                unsigned bits = 0u;
                const int cl = (int)cut - idx0 - 256 * i;
                sel_bits4<27, 26, 25, 24>(bits, key[i][15], key[i][14], key[i][13], key[i][12], cl, tau);
                sel_bits4<19, 18, 17, 16>(bits, key[i][11], key[i][10], key[i][9], key[i][8], cl, tau);
                sel_bits4<11, 10, 9, 8>(bits, key[i][7], key[i][6], key[i][5], key[i][4], cl, tau);
                sel_bits4<3, 2, 1, 0>(bits, key[i][3], key[i][2], key[i][1], key[i][0], cl, tau);
                const unsigned other = xhalf_other_u(bits, hi);
                if (hi == 0) mrow[kt * 32 + r32] = bits | (other << 16);
            }
        }
    }
    __syncthreads();
}

constexpr int WS_WUK = 0;
constexpr int WS_WUV = 256 * 1024;
constexpr int DSA_BIAS_OFF = 16384;
__device__ __forceinline__ unsigned dsa_off(unsigned row, unsigned ch) { return 256u * row + 16u * (ch ^ (((row & 3u) << 2) | ((row >> 2) & 3u))); }
constexpr int DSA_NBUF = 6, DSA_MASK_OFF = 49152, DSA_BIAS2_OFF = 114688;
__device__ __forceinline__ void glds16(const void* gsrc, unsigned lds_dst) { unsigned keep;
    asm volatile("s_mov_b32 %0, m0\n\ts_mov_b32 m0, %2\n\ts_nop 0\n\tglobal_load_lds_dwordx4 %1, off\n\ts_mov_b32 m0, %0" : "=&s"(keep) : "v"(gsrc), "s"(lds_dst) : "memory"); }
__device__ __forceinline__ void lds_read8_b128(bf16x8 (&a)[8], unsigned be, unsigned bo) {
    asm volatile("ds_read_b128 %0, %8\n\tds_read_b128 %1, %9\n\tds_read_b128 %2, %8 offset:512\n\tds_read_b128 %3, %9 offset:512\n\t"
                 "ds_read_b128 %4, %8 offset:1024\n\tds_read_b128 %5, %9 offset:1024\n\tds_read_b128 %6, %8 offset:1536\n\tds_read_b128 %7, %9 offset:1536"
                 : "=&v"(a[0]), "=&v"(a[1]), "=&v"(a[2]), "=&v"(a[3]), "=&v"(a[4]), "=&v"(a[5]), "=&v"(a[6]), "=&v"(a[7]) : "v"(be), "v"(bo));
}
template <int N> __device__ __forceinline__ void lgkm_wait(bf16x8& a) { asm volatile("s_waitcnt lgkmcnt(%1)" : "+v"(a) : "n"(N)); }
__device__ __forceinline__ void lds_read16_tr(s16x4 (&f)[4][4], unsigned b0, unsigned b1) {
    asm volatile("ds_read_b64_tr_b16 %0, %16\n\tds_read_b64_tr_b16 %1, %17 offset:2048\n\tds_read_b64_tr_b16 %2, %16 offset:4096\n\tds_read_b64_tr_b16 %3, %17 offset:6144\n\t"
                 "ds_read_b64_tr_b16 %4, %16 offset:512\n\tds_read_b64_tr_b16 %5, %17 offset:2560\n\tds_read_b64_tr_b16 %6, %16 offset:4608\n\tds_read_b64_tr_b16 %7, %17 offset:6656\n\t"
                 "ds_read_b64_tr_b16 %8, %16 offset:1024\n\tds_read_b64_tr_b16 %9, %17 offset:3072\n\tds_read_b64_tr_b16 %10, %16 offset:5120\n\tds_read_b64_tr_b16 %11, %17 offset:7168\n\t"
                 "ds_read_b64_tr_b16 %12, %16 offset:1536\n\tds_read_b64_tr_b16 %13, %17 offset:3584\n\tds_read_b64_tr_b16 %14, %16 offset:5632\n\tds_read_b64_tr_b16 %15, %17 offset:7680"
                 : "=&v"(f[0][0]), "=&v"(f[0][1]), "=&v"(f[0][2]), "=&v"(f[0][3]), "=&v"(f[1][0]), "=&v"(f[1][1]), "=&v"(f[1][2]), "=&v"(f[1][3]),
                   "=&v"(f[2][0]), "=&v"(f[2][1]), "=&v"(f[2][2]), "=&v"(f[2][3]), "=&v"(f[3][0]), "=&v"(f[3][1]), "=&v"(f[3][2]), "=&v"(f[3][3]) : "v"(b0), "v"(b1));
}
__device__ __forceinline__ void lgkm_wait_all(s16x4 (&f)[4][4]) {
    asm volatile("s_waitcnt lgkmcnt(0)" : "+v"(f[0][0]), "+v"(f[0][1]), "+v"(f[0][2]), "+v"(f[0][3]), "+v"(f[1][0]), "+v"(f[1][1]), "+v"(f[1][2]), "+v"(f[1][3]),
                   "+v"(f[2][0]), "+v"(f[2][1]), "+v"(f[2][2]), "+v"(f[2][3]), "+v"(f[3][0]), "+v"(f[3][1]), "+v"(f[3][2]), "+v"(f[3][3]));
}
__device__ __forceinline__ void dsa_round(const bf16_t* PROJ, const bf16_t* CKVN, const unsigned* MASK, const bf16_t* WUKp  , const bf16_t* WUVp  ,
                                          const float* rel_bias, bf16_t* MIX, int b, int o, int h, int lane, int wave, LAS unsigned char* L, const int bkq) {
    asm volatile("" : "+v"(lane));
    float NINF; asm volatile("v_mov_b32 %0, 0xff800000" : "=v"(NINF));
    const int r32 = lane & 31, hi = lane >> 5, tid = wave * 64 + lane;
    const int qt = 8 * o + wave, KT = 8 * o + 7, t = 32 * qt + r32;
    const int srow = 8 * (wave >> 1) + ((lane >> 2) & 7);
    const int sch = 4 * (2 * (wave & 1) + (lane >> 5)) + ((lane & 3) ^ ((2 * (wave >> 1) + ((lane >> 4) & 1)) & 3));
    const bf16_t* csrc = CKVN + ((size_t)b * SEQ + srow) * 128 + 8 * sch;
    const unsigned ring0 = (unsigned)__builtin_amdgcn_readfirstlane((int)(unsigned)(size_t)L) + 1024u * (unsigned)wave;
    LAS unsigned* maskL = (LAS unsigned*)(L + DSA_MASK_OFF + wave * 8192);
    {
        const unsigned char* msrc = (const unsigned char*)(MASK + (((size_t)b * 64 + qt) * 64) * 32) + 16 * lane;
        const unsigned mdst = (unsigned)__builtin_amdgcn_readfirstlane((int)(unsigned)(size_t)maskL);
        for (int p = 0; 8 * p <= qt; ++p) glds16(msrc + 1024 * p, mdst + 1024u * (unsigned)p);
    }
    glds16(csrc, ring0); glds16(csrc + (size_t)32 * 128, ring0 + 8192u); glds16(csrc + (size_t)64 * 128, ring0 + 16384u); glds16(csrc + (size_t)96 * 128, ring0 + 24576u);
    LAS float* biasT = (LAS float*)(L + DSA_BIAS2_OFF);
    if (tid < 224) biasT[tid] = (rel_bias[bkq * 6 + h] - rel_bias[31 * 6 + h]) * LOG2E;
    const float bias31 = rel_bias[31 * 6 + h] * LOG2E;
    bf16x8 qlf[8];
    {
        const bf16_t* qrow = PROJ + ((size_t)b * SEQ + t) * LDP + C_DSQ + h * 64 + 8 * hi;
        bf16x8 qf[4];
#pragma unroll
        for (int ks = 0; ks < 4; ++ks) qf[ks] = *(const bf16x8*)(qrow + 16 * ks);
        bf16x8 wk[16];
#pragma unroll
        for (int rt = 0; rt < 4; ++rt) {
            const GAS bf16_t* wp = (const GAS bf16_t*)WUKp + (rt * 32 + r32) * 64 + 8 * hi;
#pragma unroll
            for (int ks = 0; ks < 4; ++ks) wk[rt * 4 + ks] = *(const GAS bf16x8*)(wp + 16 * ks);
        }
        asm volatile("" : "+v"(wk[0]), "+v"(wk[1]), "+v"(wk[2]), "+v"(wk[3]), "+v"(wk[4]), "+v"(wk[5]), "+v"(wk[6]), "+v"(wk[7]),
                          "+v"(wk[8]), "+v"(wk[9]), "+v"(wk[10]), "+v"(wk[11]), "+v"(wk[12]), "+v"(wk[13]), "+v"(wk[14]), "+v"(wk[15]));
#pragma unroll
        for (int rt = 0; rt < 4; ++rt) {
            f32x16 X;
#pragma unroll
            for (int r = 0; r < 16; ++r) X[r] = 0.f;
#pragma unroll
            for (int ks = 0; ks < 4; ++ks) X = MFMA32(wk[rt * 4 + ks], qf[ks], X);
#pragma unroll
            for (int r = 0; r < 16; ++r) X[r] *= 0.125f * LOG2E;
            qlf[2 * rt] = pack8(X, 0); qlf[2 * rt + 1] = pack8(X, 1);
        }
    }
    f32x16 O[4];
#pragma unroll
    for (int c = 0; c < 4; ++c)
#pragma unroll
        for (int r = 0; r < 16; ++r) O[c][r] = 0.f;
    float mref = NINF, lrun = 0.f;
    f32x16 NOFF;
#pragma unroll
    for (int r = 0; r < 16; ++r) NOFF[r] = bias31;
    int thr8i = (int)0x80000000;
    const unsigned x2 = ((unsigned)r32 >> 2) & 3u;
    const unsigned rb_e = 2048u * ((unsigned)r32 >> 3) + 64u * ((unsigned)r32 & 7u) + 16u * ((unsigned)hi ^ x2);
    const unsigned rb_o = 2048u * ((unsigned)r32 >> 3) + 64u * ((unsigned)r32 & 7u) + 16u * ((2u + (unsigned)hi) ^ x2);
    const unsigned tq = (lane & 15) >> 2, tp = lane & 3, tblk = (lane >> 4) & 1;
    const unsigned tb0 = 64u * (4u * hi + tq) + 16u * ((2u * tblk + (tp >> 1)) ^ ((unsigned)hi & 3u)) + 8u * (tp & 1);
    const unsigned tb1 = 64u * (4u * hi + tq) + 16u * ((2u * tblk + (tp >> 1)) ^ ((2u + (unsigned)hi) & 3u)) + 8u * (tp & 1);
    __syncthreads();
    asm volatile("s_waitcnt vmcnt(0) lgkmcnt(0)" ::: "memory");
    auto dsa_qk = [&](const int kt, f32x16& S, const LAS unsigned char* Cb) __attribute__((always_inline)) {
        if (kt <= qt) {
            bf16x8 a[8];
            const unsigned cb32 = (unsigned)(size_t)Cb;
            lds_read8_b128(a, cb32 + rb_e, cb32 + rb_o);
            lgkm_wait<7>(a[0]); S = MFMA32(a[0], qlf[0], NOFF);
            lgkm_wait<6>(a[1]); S = MFMA32(a[1], qlf[1], S);
            lgkm_wait<5>(a[2]); S = MFMA32(a[2], qlf[2], S);
            lgkm_wait<4>(a[3]); S = MFMA32(a[3], qlf[3], S);
            lgkm_wait<3>(a[4]); S = MFMA32(a[4], qlf[4], S);
            lgkm_wait<2>(a[5]); S = MFMA32(a[5], qlf[5], S);
            lgkm_wait<1>(a[6]); S = MFMA32(a[6], qlf[6], S);
            lgkm_wait<0>(a[7]); S = MFMA32(a[7], qlf[7], S);
        }
    };
    auto dsa_tile = [&](const int kt, f32x16& S, const LAS unsigned char* Cb, const unsigned mwc, f32x16& Spend, const bool adj) __attribute__((always_inline)) {
        if (kt <= qt) {
            s16x4 f[4][4];
            lds_read16_tr(f, (unsigned)(size_t)Cb + tb0, (unsigned)(size_t)Cb + tb1);
            const unsigned mw = mwc;
            const int dq = qt - kt;
            if (__builtin_amdgcn_readfirstlane(dq) < 5) {
                asm volatile("" ::: "memory");
                const LAS float* bp = biasT + (32 * dq + r32 - 4 * hi + 5);
#pragma unroll
                for (int r = 0; r < 16; ++r) S[r] += bp[27 - ((r & 3) + 8 * (r >> 2))];
                asm volatile("" ::: "memory");
            }
            int mxi = max(__float_as_int(S[0]), __float_as_int(S[1]));
#pragma unroll
            for (int r = 2; r < 16; ++r) mxi = max(mxi, __float_as_int(S[r]));
            if (__any(mxi >= thr8i)) {
                float mm = NINF;
                asm volatile("" : "+v"(mm));
#pragma unroll
                for (int r = 0; r < 16; ++r) mm = fmaxf(mm, ((mw >> r) & 1u) ? S[r] : NINF);
                const float mzo = (mref == NINF) ? 0.f : mref;
                mm = xhalf_max(mm) + mzo;
                const float mn = fmaxf(mref, mm);
                const float alpha = (mn > mref) ? __builtin_amdgcn_exp2f(mref - mn) : 1.f;
                mref = mn; lrun *= alpha;
                const float mzn = (mref == NINF) ? 0.f : mref;
                float dlt = mzo - mzn, nof = bias31 - mzn;
                thr8i = (mref == NINF) ? (int)0x80000000 : 0x41000001;
                asm volatile("" : "+v"(dlt), "+v"(nof), "+v"(thr8i));
#pragma unroll
                for (int r = 0; r < 16; ++r) { asm volatile("v_add_f32 %0, %0, %1" : "+v"(S[r]) : "v"(dlt)); asm volatile("v_mov_b32 %0, %1" : "=v"(NOFF[r]) : "v"(nof)); }
                if (adj) {
#pragma unroll
                    for (int r = 0; r < 16; ++r) asm volatile("v_add_f32 %0, %0, %1" : "+v"(Spend[r]) : "v"(dlt));
                }
#pragma unroll
                for (int c = 0; c < 4; ++c)
#pragma unroll
                    for (int r = 0; r < 16; ++r) asm volatile("v_mul_f32 %0, %0, %1" : "+v"(O[c][r]) : "v"(alpha));
            }
            float ps0 = 0.f, ps1 = 0.f;
#pragma unroll
            for (int r = 0; r < 16; ++r) {
                const float e = __builtin_amdgcn_exp2f(S[r]);
                int m1; asm("v_bfe_i32 %0, %1, %2, 1" : "=v"(m1) : "v"(mw), "n"(r));
                S[r] = __uint_as_float(__float_as_uint(e) & (unsigned)m1);
                if (r & 1) ps1 += S[r]; else ps0 += S[r];
            }
            lrun += ps0 + ps1;
            const bf16x8 p0 = pack8(S, 0), p1 = pack8(S, 1);
            lgkm_wait_all(f);
#pragma unroll
            for (int c = 0; c < 4; ++c) {
                O[c] = MFMA32(cat44(f[c][0], f[c][1]), p0, O[c]);
                O[c] = MFMA32(cat44(f[c][2], f[c][3]), p1, O[c]);
            }
        }
    };
    const int NS = (KT + 1) >> 1;
    v2u gatew[8];
#pragma unroll
    for (int i = 0; i < 8; ++i) { gatew[i].x = 0u; gatew[i].y = 0u; }
    int sl = 0;
    const bool late = (wave & 4) != 0;
    unsigned mwA = maskL[r32], mwB = maskL[32 + r32];
    for (int st = 0; st < NS; ++st) {
        if (st + 1 < NS) asm volatile("s_waitcnt vmcnt(2)\n\ts_barrier" ::: "memory");
        else asm volatile("s_waitcnt vmcnt(0)\n\ts_barrier" ::: "memory");
        if (st + 2 < NS) { int s2 = sl + 4; s2 = s2 >= 6 ? s2 - 6 : s2;
            glds16(csrc + (size_t)(64 * (st + 2)) * 128, ring0 + 8192u * (unsigned)s2); glds16(csrc + (size_t)(64 * (st + 2) + 32) * 128, ring0 + 8192u * (unsigned)(s2 + 1)); }
        if (st == NS - 1) gate_load(gatew, PROJ + ((size_t)b * SEQ + t) * LDP + C_DSG + h * 64, hi);
        unsigned mw0 = mwA >> (16 * hi), mw1 = mwB >> (16 * hi);
        asm volatile("" : "+v"(mw0), "+v"(mw1));
        f32x16 S0, S1;
        dsa_qk(2 * st, S0, L + sl * 8192);
        if (late) dsa_qk(2 * st + 1, S1, L + (sl + 1) * 8192);
        dsa_tile(2 * st, S0, L + sl * 8192, mw0, S1, late && (2 * st + 1 <= qt));
        if (!late) dsa_qk(2 * st + 1, S1, L + (sl + 1) * 8192);
        dsa_tile(2 * st + 1, S1, L + (sl + 1) * 8192, mw1, S0, false);
        if (st + 1 < NS) { mwA = maskL[(2 * st + 2) * 32 + r32]; mwB = maskL[(2 * st + 3) * 32 + r32]; }
        sl = (sl == 4) ? 0 : sl + 2;
    }
    const float lt = xhalf_sum(lrun);
    const float il = 1.f / lt;
    f32x16 Y[2];
#pragma unroll
    for (int r = 0; r < 16; ++r) { Y[0][r] = 0.f; Y[1][r] = 0.f; }
    bf16x8 wv[16];
    {
        int l3 = lane; asm volatile("" : "+v"(l3));
#pragma unroll
        for (int rt = 0; rt < 4; ++rt)
#pragma unroll
            for (int c = 0; c < 2; ++c) {
                const GAS bf16_t* wp = (const GAS bf16_t*)WUVp + ((((c * 4 + rt) * 2 + 0) * 32 + (l3 & 31)) * 2 + (l3 >> 5)) * 8;
                wv[(rt * 2 + c) * 2] = *(const GAS bf16x8*)wp; wv[(rt * 2 + c) * 2 + 1] = *(const GAS bf16x8*)(wp + 32 * 2 * 8);
            }
        asm volatile("" : "+v"(wv[0]), "+v"(wv[1]), "+v"(wv[2]), "+v"(wv[3]), "+v"(wv[4]), "+v"(wv[5]), "+v"(wv[6]), "+v"(wv[7]),
                          "+v"(wv[8]), "+v"(wv[9]), "+v"(wv[10]), "+v"(wv[11]), "+v"(wv[12]), "+v"(wv[13]), "+v"(wv[14]), "+v"(wv[15]));
    }
#pragma unroll
    for (int rt = 0; rt < 4; ++rt) {
#pragma unroll
        for (int r = 0; r < 16; ++r) O[rt][r] *= il;
        const bf16x8 x0 = pack8(O[rt], 0), x1 = pack8(O[rt], 1);
#pragma unroll
        for (int c = 0; c < 2; ++c) {
            Y[c] = MFMA32(wv[(rt * 2 + c) * 2], x0, Y[c]);
            Y[c] = MFMA32(wv[(rt * 2 + c) * 2 + 1], x1, Y[c]);
        }
    }
    {
        int l2 = lane; asm volatile("" : "+v"(l2));
        const int t2 = 32 * qt + (l2 & 31);
        gate_store_pre(Y, 1.f, gatew, MIX + ((size_t)b * SEQ + t2) * DM + 384 + h * 64, l2 >> 5);
    }
    asm volatile("s_waitcnt lgkmcnt(0)\n\ts_barrier" ::: "memory");
}

typedef GAS unsigned gu32;
#define RLX_AGENT __ATOMIC_RELAXED, __HIP_MEMORY_SCOPE_AGENT
constexpr size_t WS_BAR = 512 * 1024;
#define XB_TMO      128
#define XB_XCNT(j)  (256  + 64 * (j))
#define XB_XSUB(j)  (1280 + 64 * (j))
#define XB_XGEN(j)  (2304 + 64 * (j))
#define XB_TOP      3328
#define XB_TOPGEN   3392
#define XCD_BAR_WORDS 3456
#define XB_SPIN_CAP (1u << 18)

__device__ __forceinline__ unsigned xb_ld(unsigned* p)              { return __hip_atomic_load(p, __ATOMIC_RELAXED, __HIP_MEMORY_SCOPE_AGENT); }
__device__ __forceinline__ unsigned xb_add(unsigned* p, unsigned v) { return __hip_atomic_fetch_add(p, v, __ATOMIC_RELAXED, __HIP_MEMORY_SCOPE_AGENT); }
__device__ __forceinline__ unsigned xb_xcc_id() { return (unsigned)__builtin_amdgcn_s_getreg((3 << 11) | 20) & 0xFu; }
#define XB_SPIN(cond, bar) do { unsigned _sp = 0; while (cond) { __builtin_amdgcn_s_sleep(1); \
    if ((++_sp & 255u) == 0u) { if (xb_ld(&(bar)[XB_TMO])) break; if (_sp > XB_SPIN_CAP) { atomicAdd(&(bar)[XB_TMO], 1u); break; } } } } while (0)

struct XcdBarrier {
    unsigned* bar; unsigned x;
    volatile LAS unsigned* st;
};

__device__ __forceinline__ XcdBarrier xcd_barrier_post(unsigned* bar, volatile LAS unsigned* st) {
    XcdBarrier b; b.bar = bar; b.x = xb_xcc_id(); b.st = st;
    return b;
}
__device__ __forceinline__ void xcd_barrier_complete(unsigned* bar, unsigned x, unsigned& nloc, unsigned& nx) {
    const unsigned G = gridDim.x * gridDim.y * gridDim.z;
    unsigned sum, cnt, mine, sp = 0u;
    for (;;) {
        sum = 0u; cnt = 0u; mine = 0u;
#pragma unroll
        for (unsigned j = 0; j < 16; ++j) { const unsigned c = xb_ld(&bar[XB_XCNT(j)]); sum += c; cnt += (c > 0u) ? 1u : 0u; mine = (j == x) ? c : mine; }
        if (sum == G) break;
        __builtin_amdgcn_s_sleep(1);
        if ((++sp & 255u) == 0u) { if (xb_ld(&bar[XB_TMO])) break; if (sp > XB_SPIN_CAP) { atomicAdd(&bar[XB_TMO], 1u); break; } }
    }
    nloc = mine > 0u ? mine : 1u; nx = cnt > 0u ? cnt : 1u;
}

__device__ __forceinline__ void xcd_barrier(const XcdBarrier& b, const bool leader  ) {
    asm volatile("s_waitcnt vmcnt(0)" ::: "memory");
    __syncthreads();
    if (leader) {
        unsigned* bar = b.bar;
        __builtin_amdgcn_s_waitcnt(0);
        unsigned nloc = b.st[0], nx = b.st[1];
        if (nloc == 0u) { xcd_barrier_complete(bar, b.x, nloc, nx); b.st[0] = nloc; b.st[1] = nx; }
        const unsigned old = xb_add(&bar[XB_XSUB(b.x)], 1u);
        const unsigned gen = old / nloc;
        if (old + 1u == (gen + 1u) * nloc) {
            __builtin_amdgcn_fence(__ATOMIC_RELEASE, "agent");
            asm volatile("s_waitcnt vmcnt(0)" ::: "memory");
            const unsigned og = xb_add(&bar[XB_TOP], 1u);
            const unsigned tg = og / nx;
            if (og + 1u == (tg + 1u) * nx) xb_add(&bar[XB_TOPGEN], 1u);
            else XB_SPIN(xb_ld(&bar[XB_TOPGEN]) == tg, bar);
            __builtin_amdgcn_fence(__ATOMIC_ACQUIRE, "agent");
            xb_add(&bar[XB_XGEN(b.x)], 1u);
            asm volatile("s_waitcnt vmcnt(0)" ::: "memory");
        } else {
            XB_SPIN(xb_ld(&bar[XB_XGEN(b.x)]) == gen, bar);
            __builtin_amdgcn_fence(__ATOMIC_ACQUIRE, "agent");
            asm volatile("s_waitcnt vmcnt(0)" ::: "memory");
        }
    }
    __syncthreads();
}

#ifndef MK_MULTI
#define MK_MULTI 0
#endif
constexpr int NPHASE = 11;
__global__ void __launch_bounds__(NWAVES * 64, 2) mk_fwd(Args args) {
    extern __shared__ __attribute__((aligned(16))) unsigned char lds_raw[];
    LAS unsigned char* lds = (LAS unsigned char*)lds_raw;
    const int tid0 = threadIdx.x;
    int wave_ = __builtin_amdgcn_readfirstlane(tid0 >> 6); asm volatile("" : "+s"(wave_));
    const int wave = wave_;
    const int G = gridDim.x, bid = blockIdx.x;
    for (int u = tid0; u < 16; u += NWAVES * 64) ((LAS unsigned*)(lds + 131072))[u] = 0u;
    __syncthreads();
    const XcdBarrier xbar = xcd_barrier_post((unsigned*)(args.ws + WS_BAR), (volatile LAS unsigned*)(lds + 131072));
    const int lo = args.ph_lo, hi = args.ph_hi;
    if (lo <= 0 && 1 < hi && wave_ == 0 && lane_id_v() == 0) (void)xb_add(&xbar.bar[XB_XCNT(xbar.x)], 1u);
#define IN(k) (lo <= (k) && (k) < hi)
#define SEAM(k) do { if (IN(k) && IN((k) + 1)) { if (hi == 0x7fffffff) cg::this_grid().sync(); xcd_barrier(xbar, wave_ == 0 && lane_id_v() == 0); } } while (0)
#define PH_BEGIN int lane = lane_id_v(); unsigned char* ws_ = args.ws; asm volatile("" : "+s"(ws_)); GAS unsigned char* ws = (GAS unsigned char*)ws_;     \
    const int gw = bid * NWAVES + wave, NGW = G * NWAVES; (void)gw; (void)NGW;
#define VCU_LOOP for (int vcu = vcu0; vcu < 256; vcu += G)
#define VCU_IDS const int bb = vcu >> 3, w64 = (vcu & 7) * 8 + wave; (void)bb; (void)w64;
#define P_WIN ((bf16_t*)(ws + WS_WIN))
#define P_WOUT ((bf16_t*)(ws + WS_WOUT))
#define P_WMEM ((bf16_t*)(ws + WS_WMEM))
#define P_MEMB ((bf16_t*)(ws + WS_MEMB))
#define P_MEMKV ((bf16_t*)(ws + WS_MEMKV))
#define P_CKVN ((bf16_t*)(ws + WS_CKVN))
#define P_MASK ((unsigned*)(ws + WS_MASK))
#define P_H ((bf16_t*)(ws + WS_H))
#define P_MIX ((bf16_t*)(ws + WS_MIX))
#define P_PROJ ((bf16_t*)(ws + WS_PROJ))
#define P_Y ((bf16_t*)(ws + WS_Y))
    const int vcu0 = (G % 8 == 0) ? (bid & 7) * (G >> 3) + (bid >> 3) : bid;

    if (IN(0)) {
        PH_BEGIN
        const float* x = args.in[0]; const float* mem = args.in[1]; const float* pre_g = args.in[2];
        const float* w_in = args.in[4]; const float* w_mem = args.in[8]; const float* w_out = args.in[9];
        LAS float* scr = (LAS float*)(lds + wave * 16384);
        constexpr int I_IN = 16 * (LDP / 32), I_OUT = 16 * 32, I_MEM = 16 * 16;
        constexpr int NITEMS = 2 * I_IN + 2 * I_OUT + 2 * I_MEM;
        for (int it = gw; it < NITEMS; it += NGW) {
            int r = it;
            if (r < 2 * I_IN) { const int l = r / I_IN; r -= l * I_IN; p0_transpose_item(w_in + (size_t)l * DM * NCOL, DM, NCOL, LDP, P_WIN + (size_t)l * LDP * DM, pre_g + l * DM, scr, r, lane); continue; }
            r -= 2 * I_IN;
            if (r < 2 * I_OUT) { const int l = r / I_OUT; r -= l * I_OUT; p0_transpose_item(w_out + (size_t)l * DM * DM, DM, DM, DM, P_WOUT + (size_t)l * DM * DM, nullptr, scr, r, lane); continue; }
            r -= 2 * I_OUT;
            { const int l = r / I_MEM; r -= l * I_MEM; p0_transpose_item(w_mem + (size_t)l * DM * 512, DM, 512, 512, P_WMEM + (size_t)l * 512 * DM, nullptr, scr, r, lane); }
        }
        {
            const float* w_uk = args.in[5]; const float* w_uv = args.in[6];
            bf16_t* WUKp = (bf16_t*)(ws + WS_WUK); bf16_t* WUVp = (bf16_t*)(ws + WS_WUV);
            for (int e = gw * 64 + lane; e < 2 * 6 * 8192; e += NGW * 64) {
                const int lh = e >> 13, l = lh / 6, h = lh % 6, w = e & 8191;
                { const int rt = w >> 11, rho = (w >> 6) & 31, d = w & 63; const int r = 32 * rt + ((rho & 0x13) | ((rho & 4) << 1) | ((rho & 8) >> 1));
                  WUKp[e] = (bf16_t)f2bf(w_uk[(((size_t)l * 128 + r) * 6 + h) * 64 + d]); }
                { const int j = w & 7, hh = (w >> 3) & 1, d32 = (w >> 4) & 31, s = (w >> 9) & 1, rt = (w >> 10) & 3, c = (w >> 12) & 1;
                  const int r = 32 * rt + 16 * s + 8 * (j >> 2) + 4 * hh + (j & 3), d = 32 * c + d32;
                  WUVp[e] = (bf16_t)f2bf(w_uv[(((size_t)l * 128 + r) * 6 + h) * 64 + d]); }
            }
        }
        for (int m = gw * 4; m < NB * NMEM; m += NGW * 4) rows4_cvt_bf16(mem + (size_t)m * DM, P_MEMB + (size_t)m * DM, lane);
        for (int m = gw * 4; m < NTOK; m += NGW * 4) rowsN_norm_bf16<4>(x + (size_t)m * DM, (bf16_t*)(ws + WS_X1) + (size_t)m * DM, lane, (float*)(ws + WS_XNRM) + m);
    }
    SEAM(0);
#pragma unroll 1
    for (int l = 0; l < 2; ++l) {
        const int pb = 1 + 5 * l;
        if (IN(pb)) {
            PH_BEGIN
            { pg8::Gemm g{(bf16_t*)(ws + WS_X1), P_WIN + (size_t)l * LDP * DM, NTOK, LDP, DM}; pg8::StaticOrder S; S.init(NTOK, LDP, G, bid);
              pg8::EpiBf16<0> E{P_PROJ, LDP, nullptr, 0, 0, 1.f};
              pg8::gemm_phase<pg8::EpiBf16<0>, pg8::StaticOrder, true, true>(lds, g, S, E, wave); }
            if (l == 0) {
              pg8::Gemm g{P_MEMB, P_WMEM, NB * NMEM, 1024, DM}; pg8::StaticOrder S; S.init(NB * NMEM, 1024, G, bid);
              pg8::EpiBf16<0> E{P_MEMKV, 1024, nullptr, 0, 0, 1.f};
              pg8::gemm_phase<pg8::EpiBf16<0>, pg8::StaticOrder, true, true>(lds, g, S, E, wave); }
        }
        SEAM(pb);
        if (IN(pb + 1)) {
            const bool ck_fused = (G == 256);
            if (!ck_fused) { PH_BEGIN
              const float* kv_g = args.in[7];
              for (int m = gw * 8; m < NTOK; m += NGW * 8) { ckvnorm4(P_PROJ, kv_g + l * 128, P_CKVN, m, lane); ckvnorm4(P_PROJ, kv_g + l * 128, P_CKVN, m + 4, lane); } }
            VCU_LOOP { PH_BEGIN VCU_IDS
              const float* kv_g = args.in[7];
              for (int i = 0; i < 6; ++i) { const int qt = (i & 1) ? 63 - w64 : w64;
                  const int ra = gw * 8 + (i >> 1) * NGW * 8 + (i & 1) * 4, rb = gw * 8 + 3 * NGW * 8 + (i & 1) * 4;
                  v4u va, vb;
                  if (ck_fused) { va = ckv_load(P_PROJ, ra, lane); if (i < 2) vb = ckv_load(P_PROJ, rb, lane); }
                  sb_item(P_PROJ, P_MIX, bb, i, qt, lane, lds + wave * 16384);
                  if (ck_fused) { int l4 = lane; asm volatile("" : "+v"(l4)); ckv_finish(va, kv_g + l * 128, P_CKVN, ra, l4); if (i < 2) ckv_finish(vb, kv_g + l * 128, P_CKVN, rb, l4); }
              } }
            __syncthreads();
            VCU_LOOP { PH_BEGIN VCU_IDS
              const int s8 = vcu & 7;
              for (int j = 0; j < 8; ++j) { const int qt = 8 * j + ((j & 1) ? 7 - s8 : s8); sel_item2(P_PROJ, P_MASK, bb, qt, lane, wave, lds); } }
            __syncthreads();
            VCU_LOOP { PH_BEGIN VCU_IDS
              for (int i = 0; i < 4; ++i) {
                  __syncthreads();
                  mem_stage(P_MEMKV + l * 512, bb, i, wave * 64 + lane, lds);
                  __syncthreads();
                  mem_item_lds(P_PROJ, P_MIX, bb, i, w64, lane, lds);
              } }
        }
        SEAM(pb + 1);
        if (IN(pb + 2)) {
            __syncthreads();
            VCU_LOOP { PH_BEGIN VCU_IDS
              const float* rel_bias = args.in[10];
              const int s8 = vcu & 7, hs = (s8 < 4) ? 0 : 3;
              const int tidq = wave * 64 + lane;
              const int bkq = tidq < 32 ? 0 : (tidq < 160 ? (int)T5TAB[tidq - 32] : 31);
              for (int oi = 0; oi < 2; ++oi) {
                  const int o = oi ? 7 - (s8 & 3) : (s8 & 3);
                  for (int hh = 0; hh < 3; ++hh) {
                      const int h = hs + hh;
                      dsa_round(P_PROJ, P_CKVN, P_MASK, (const bf16_t*)(ws + WS_WUK) + (size_t)(l * 6 + h) * 8192, (const bf16_t*)(ws + WS_WUV) + (size_t)(l * 6 + h) * 8192,
                                rel_bias, P_MIX, bb, o, h, lane, wave, lds, bkq);
                  }
              } }
        }
        SEAM(pb + 2);
        if (IN(pb + 3)) {
            PH_BEGIN
            __syncthreads();
            pg8::Gemm g{P_MIX, P_WOUT + (size_t)l * DM * DM, NTOK, DM, DM}; pg8::StaticOrder S; S.init(NTOK, DM, G, bid);
            pg8::EpiBf16<0> E{P_Y, DM, nullptr, 0, 0, 1.f};
            pg8::gemm_phase<pg8::EpiBf16<0>, pg8::StaticOrder, true, true>(lds, g, S, E, wave);
        }
        SEAM(pb + 3);
        if (IN(pb + 4)) {
            PH_BEGIN
            const float* post_g = args.in[3]; bf16_t* X1b = (bf16_t*)(ws + WS_X1);
            if (l == 0) { for (int m = gw * 4; m < NTOK; m += NGW * 4) post_rowsN<true, 4>(args.in[0], P_Y, post_g, args.out, X1b, X1b  , m, lane, (float*)(ws + WS_XNRM)); }
            else { for (int m = gw * 4; m < NTOK; m += NGW * 4) post_rowsN<false, 4>(nullptr, P_Y, post_g + DM, args.out, X1b, (bf16_t*)nullptr, m, lane, (float*)(ws + WS_XNRM)); }
        }
        SEAM(pb + 4);
    }
#undef IN
#undef SEAM
}

extern "C" void kernel_launch(void* const* d_in, const int* in_sizes, int n_in, void* d_out, int out_size, void* d_ws, size_t ws_size, hipStream_t stream) {
    static int grid = 0;
    if (grid == 0) {
        if (n_in != 11 || ws_size < WS_END) { fprintf(stderr, "kernel_launch: unexpected n_in %d / ws_size %zu\n", n_in, ws_size); grid = -1; return; }
        int dev = 0, cus = 0, per_cu = 0;
        hipGetDevice(&dev);
        hipDeviceGetAttribute(&cus, hipDeviceAttributeMultiprocessorCount, dev);
        hipFuncSetAttribute((const void*)mk_fwd, hipFuncAttributeMaxDynamicSharedMemorySize, LDS_BYTES);
        hipOccupancyMaxActiveBlocksPerMultiprocessor(&per_cu, (const void*)mk_fwd, NWAVES * 64, LDS_BYTES);
        if (per_cu < 1) { fprintf(stderr, "kernel_launch: occupancy query says %d blocks per CU\n", per_cu); per_cu = 1; }
        grid = cus * 1;
        (void)hipGetLastError();
    }
    if (grid < 0) return;
    (void)hipMemsetAsync((char*)d_ws + WS_BAR, 0, 16384, stream);
    Args a{};
    for (int i = 0; i < 11; ++i) a.in[i] = (const float*)d_in[i];
    a.out = (float*)d_out; a.ws = (unsigned char*)d_ws;
#if MK_MULTI
    for (int p = 0; p < NPHASE; ++p) { a.ph_lo = p; a.ph_hi = p + 1; hipLaunchKernelGGL(mk_fwd, dim3(grid), dim3(NWAVES * 64), LDS_BYTES, stream, a); }
#else
    a.ph_lo = 0; a.ph_hi = NPHASE;
    void* kargs[] = {&a};
    hipError_t e = hipLaunchCooperativeKernel((const void*)mk_fwd, dim3(grid), dim3(NWAVES * 64), kargs, LDS_BYTES, stream);
    if (e != hipSuccess) fprintf(stderr, "cooperative launch failed: %s (grid %d)\n", hipGetErrorString(e), grid);
#endif
}
```
